# Optimizing an MI355X kernel written in HIP

```python
import jax, jax.numpy as jnp
from jax import lax
import numpy as np

D_MODEL = 1024
BATCH = 2
SEQ = 8192
DEPTH = 2

HEAD_DIM = 64
N_HEADS_MOBA = D_MODEL // 128
N_HEADS_SB = D_MODEL // 128
WIDTH_MOBA = N_HEADS_MOBA * HEAD_DIM
WIDTH_SB = N_HEADS_SB * HEAD_DIM
WIDTH_CONV = D_MODEL // 2
CONV_K = 3
MOBA_BLOCK = 256
MOBA_TOPK = 3
Q_BLOCK = 128
D_FF = -(-8 * D_MODEL // (3 * 256)) * 256
RMS_EPS = 1e-6
IN_SPLITS = (WIDTH_MOBA, WIDTH_MOBA, WIDTH_MOBA, WIDTH_SB, WIDTH_SB, WIDTH_SB,
             WIDTH_CONV, WIDTH_CONV, WIDTH_CONV, 3 * D_MODEL)
IN_WIDTH = sum(IN_SPLITS)

kernel_name = "hybrid_moba_stickbreak_shortconv_block"


def rms_norm(x, g):
    xf = x.astype(jnp.float32)
    y = xf * lax.rsqrt(jnp.mean(xf * xf, axis=-1, keepdims=True) + RMS_EPS)
    return (y * g.astype(jnp.float32)).astype(x.dtype)


def alibi_slopes(n_heads):
    return jnp.exp2(-8.0 * (jnp.arange(n_heads, dtype=jnp.float32) + 1.0) / n_heads)


def moba_attention(q, k, v):
    B, S, H, d = q.shape
    nq = S // Q_BLOCK
    nb = -(-S // MOBA_BLOCK)
    s_pad = nb * MOBA_BLOCK
    topk = min(MOBA_TOPK, nb)
    scale = d ** -0.5
    slopes = alibi_slopes(H)
    pad = ((0, 0), (0, 0), (0, s_pad - S), (0, 0))
    kt = jnp.pad(k.transpose(0, 2, 1, 3), pad)
    vt = jnp.pad(v.transpose(0, 2, 1, 3), pad)
    kb = kt.reshape(B, H, nb, MOBA_BLOCK, d)
    vb = vt.reshape(B, H, nb, MOBA_BLOCK, d)
    kmean = jnp.mean(kb.astype(jnp.float32), axis=3).astype(k.dtype)
    qc_all = q.reshape(B, nq, Q_BLOCK, H, d).transpose(1, 0, 3, 2, 4)
    bi = jnp.arange(B)[:, None, None, None]
    hi = jnp.arange(H)[None, :, None, None]
    offs = jnp.arange(MOBA_BLOCK)
    blk_ids = jnp.arange(nb)

    def chunk(args):
        c, qc = args
        t = c * Q_BLOCK + jnp.arange(Q_BLOCK)
        blk = (c * Q_BLOCK) // MOBA_BLOCK
        gate = jnp.einsum('bhqd,bhnd->bhqn', qc, kmean).astype(jnp.float32)
        gate = jnp.where(blk_ids < blk, gate, -jnp.inf)
        _, idx = lax.top_k(gate, topk)
        kg = kb[bi, hi, idx]
        vg = vb[bi, hi, idx]
        s_sel = jnp.einsum('bhqd,bhqrld->bhqrl', qc, kg).astype(jnp.float32) * scale
        pos_sel = idx[..., None] * MOBA_BLOCK + offs
        dist_sel = (t[None, None, :, None, None] - pos_sel).astype(jnp.float32)
        s_sel = s_sel - slopes[None, :, None, None, None] * dist_sel
        valid = jnp.arange(topk) < blk
        s_sel = jnp.where(valid[:, None], s_sel, -jnp.inf)
        ko = lax.dynamic_index_in_dim(kb, blk, axis=2, keepdims=False)
        vo = lax.dynamic_index_in_dim(vb, blk, axis=2, keepdims=False)
        s_own = jnp.einsum('bhqd,bhld->bhql', qc, ko).astype(jnp.float32) * scale
        dist_own = t[:, None] - (blk * MOBA_BLOCK + offs)[None, :]
        s_own = s_own - slopes[None, :, None, None] * dist_own.astype(jnp.float32)
        s_own = jnp.where(dist_own >= 0, s_own, -jnp.inf)
        n_sel = topk * MOBA_BLOCK
        scores = jnp.concatenate([s_sel.reshape(B, H, Q_BLOCK, n_sel), s_own], axis=-1)
        p = jax.nn.softmax(scores, axis=-1).astype(v.dtype)
        p_sel = p[..., :n_sel].reshape(B, H, Q_BLOCK, topk, MOBA_BLOCK)
        p_own = p[..., n_sel:]
        return (jnp.einsum('bhqrl,bhqrld->bhqd', p_sel, vg)
                + jnp.einsum('bhql,bhld->bhqd', p_own, vo))

    out = lax.map(chunk, (jnp.arange(nq), qc_all))
    return out.transpose(1, 0, 3, 2, 4).reshape(B, S, H * d)


def stick_breaking_attention(q, k, v):
    B, S, H, d = q.shape
    nq = S // Q_BLOCK
    scale = d ** -0.5
    kt = k.transpose(0, 2, 1, 3)
    vt = v.transpose(0, 2, 1, 3)
    qc_all = q.reshape(B, nq, Q_BLOCK, H, d).transpose(1, 0, 3, 2, 4)
    s_pos = jnp.arange(S)

    def chunk(args):
        c, qc = args
        t = c * Q_BLOCK + jnp.arange(Q_BLOCK)
        z = jnp.einsum('bhqd,bhsd->bhqs', qc, kt).astype(jnp.float32) * scale
        strict = s_pos[None, :] < t[:, None]
        log_not = jnp.where(strict, jax.nn.log_sigmoid(-z), 0.0)
        after = lax.cumsum(log_not, axis=3, reverse=True) - log_not
        w = jnp.where(strict, jnp.exp(jax.nn.log_sigmoid(z) + after), 0.0)
        return jnp.einsum('bhqs,bhsd->bhqd', w.astype(v.dtype), vt)

    out = lax.map(chunk, (jnp.arange(nq), qc_all))
    return out.transpose(1, 0, 3, 2, 4).reshape(B, S, H * d)


def short_conv_mixer(xc, bg, cg, conv_w):
    u = cg * xc
    S = u.shape[1]
    up = jnp.pad(u, ((0, 0), (CONV_K - 1, 0), (0, 0)))
    y = up[:, 0:S] * conv_w[0]
    for j in range(1, CONV_K):
        y = y + up[:, j:j + S] * conv_w[j]
    return bg * y


def hybrid_layer(x, g_mix, w_in, b_gate, conv_w, w_proj_moba, w_proj_sb, w_proj_conv,
                 w_out, g_ffn, w_ffn_gate, w_ffn_up, w_ffn_down):
    B, S, _ = x.shape
    h = rms_norm(x, g_mix)
    proj = jnp.einsum('bsd,de->bse', h, w_in)
    offsets = np.cumsum(IN_SPLITS)[:-1].tolist()
    qa, ka, va, qs, ks, vs, xc, bc, cc, gates = jnp.split(proj, offsets, axis=-1)
    o_a = moba_attention(qa.reshape(B, S, N_HEADS_MOBA, HEAD_DIM),
                         ka.reshape(B, S, N_HEADS_MOBA, HEAD_DIM),
                         va.reshape(B, S, N_HEADS_MOBA, HEAD_DIM))
    o_b = stick_breaking_attention(qs.reshape(B, S, N_HEADS_SB, HEAD_DIM),
                                   ks.reshape(B, S, N_HEADS_SB, HEAD_DIM),
                                   vs.reshape(B, S, N_HEADS_SB, HEAD_DIM))
    o_c = short_conv_mixer(xc, bc, cc, conv_w)
    g = jax.nn.sigmoid((gates + b_gate).astype(jnp.float32)).astype(x.dtype)
    g_a, g_b, g_c = jnp.split(g, 3, axis=-1)
    merged = (g_a * (o_a @ w_proj_moba) + g_b * (o_b @ w_proj_sb)
              + g_c * (o_c @ w_proj_conv))
    x = x + merged @ w_out
    h2 = rms_norm(x, g_ffn)
    x = x + (jax.nn.silu(h2 @ w_ffn_gate) * (h2 @ w_ffn_up)) @ w_ffn_down
    return x


def setup_inputs(seed: int = 0) -> dict:
    key = jax.random.key(seed)
    ks = jax.random.split(key, 16)

    def nrm(k, shape, fan_in):
        return jax.random.normal(k, shape, jnp.float32) * (fan_in ** -0.5)

    def gain(k, shape):
        return 1.0 + 0.02 * jax.random.normal(k, shape, jnp.float32)

    return {
        "x": jax.random.normal(ks[0], (BATCH, SEQ, D_MODEL), jnp.float32),
        "norm_mix_g": gain(ks[1], (DEPTH, D_MODEL)),
        "w_in": nrm(ks[2], (DEPTH, D_MODEL, IN_WIDTH), D_MODEL),
        "b_gate": 0.02 * jax.random.normal(ks[3], (DEPTH, 3 * D_MODEL), jnp.float32),
        "conv_w": nrm(ks[4], (DEPTH, CONV_K, WIDTH_CONV), CONV_K),
        "w_proj_moba": nrm(ks[5], (DEPTH, WIDTH_MOBA, D_MODEL), WIDTH_MOBA),
        "w_proj_sb": nrm(ks[6], (DEPTH, WIDTH_SB, D_MODEL), WIDTH_SB),
        "w_proj_conv": nrm(ks[7], (DEPTH, WIDTH_CONV, D_MODEL), WIDTH_CONV),
        "w_out": nrm(ks[8], (DEPTH, D_MODEL, D_MODEL), D_MODEL),
        "norm_ffn_g": gain(ks[9], (DEPTH, D_MODEL)),
        "w_ffn_gate": nrm(ks[10], (DEPTH, D_MODEL, D_FF), D_MODEL),
        "w_ffn_up": nrm(ks[11], (DEPTH, D_MODEL, D_FF), D_MODEL),
        "w_ffn_down": nrm(ks[12], (DEPTH, D_FF, D_MODEL), D_FF),
        "norm_final_g": gain(ks[13], (D_MODEL,)),
    }


def reference(x, norm_mix_g, w_in, b_gate, conv_w, w_proj_moba, w_proj_sb, w_proj_conv,
              w_out, norm_ffn_g, w_ffn_gate, w_ffn_up, w_ffn_down, norm_final_g):
    for l in range(DEPTH):
        x = hybrid_layer(x, norm_mix_g[l], w_in[l], b_gate[l], conv_w[l],
                         w_proj_moba[l], w_proj_sb[l], w_proj_conv[l], w_out[l],
                         norm_ffn_g[l], w_ffn_gate[l], w_ffn_up[l], w_ffn_down[l])
    return rms_norm(x, norm_final_g)
```

```cpp
#define REP_MOBA 2
#include <hip/hip_runtime.h>
#include <hip/hip_bf16.h>
#include <cstdio>
#include <cstdint>

#define GAS __attribute__((address_space(1)))
#define LAS __attribute__((address_space(3)))
typedef unsigned short bf16_t;
typedef short bf16x8 __attribute__((ext_vector_type(8)));
typedef short s16x4 __attribute__((ext_vector_type(4)));
typedef float f32x2 __attribute__((ext_vector_type(2)));
typedef float f32x4 __attribute__((ext_vector_type(4)));
typedef float f32x16 __attribute__((ext_vector_type(16)));
typedef unsigned u32x2 __attribute__((ext_vector_type(2)));
typedef unsigned u32x4 __attribute__((ext_vector_type(4)));
typedef GAS unsigned gu32;

constexpr int BATCH = 2, SEQ = 8192, DM = 1024, M = BATCH * SEQ, NH = 8, HD = 64, BW = 512, DFF = 2816, DEPTH = 2;
constexpr int NIN = 7680, N1 = 4608, NGATE = 3072, NGU = 2 * DFF;
constexpr float RMS_EPS = 1e-6f;
constexpr float LOG2E = 1.4426950408889634f;
constexpr float C2 = 0.125f * LOG2E;
constexpr int NWAVES = 8;

constexpr size_t MiB = 1u << 20;
constexpr size_t WS_CTL = 0, CTL_ZERO_BYTES = 64 * 1024;
constexpr size_t WS_SSA = 1 * MiB, WS_SSB = 2 * MiB, WS_KM = 3 * MiB;
constexpr size_t WS_WIN = 4 * MiB, WS_WG = 13 * MiB, WS_WP = 19 * MiB, WS_WO = 22 * MiB, WS_WGU = 24 * MiB, WS_WD = 35 * MiB;
constexpr size_t WS_XB = 41 * MiB;
constexpr size_t WS_QA = 73 * MiB, WS_KA = 89 * MiB, WS_VA = 105 * MiB, WS_QS = 121 * MiB, WS_KS = 137 * MiB, WS_VS = 153 * MiB;
constexpr size_t WS_BC = 169 * MiB, WS_U = 185 * MiB, WS_MG = 201 * MiB, WS_X = 233 * MiB;
constexpr size_t WS_GA = WS_KA, WS_GB = WS_KS, WS_GC0 = WS_U, WS_GC1 = WS_X;
constexpr size_t WS_ACT = 73 * MiB;
constexpr size_t WS_END = 256 * MiB;
constexpr int CW_BAR = 4096;

constexpr int RING_OFF = 0, RING_BYTES = 131072;
constexpr int LDSCTL_OFF = RING_BYTES, MISC_OFF = LDSCTL_OFF + 320;
constexpr int LDS_BYTES = 147456;

#define LDS_WAIT() asm volatile("s_waitcnt lgkmcnt(0)" ::: "memory")
#define VM_WAIT() asm volatile("s_waitcnt vmcnt(0)" ::: "memory")
#define RLX_AGENT __ATOMIC_RELAXED, __HIP_MEMORY_SCOPE_AGENT

typedef __bf16 bf16x2_t __attribute__((ext_vector_type(2)));
__device__ __forceinline__ unsigned cvt_pk_bf16(float lo, float hi) { const f32x2 v = {lo, hi}; const bf16x2_t b = __builtin_convertvector(v, bf16x2_t); return __builtin_bit_cast(unsigned, b); }
__device__ __forceinline__ float bf_lo(unsigned w) { return __uint_as_float(w << 16); }
__device__ __forceinline__ float bf_hi(unsigned w) { return __uint_as_float(w & 0xffff0000u); }
__device__ __forceinline__ float rstd_row(const float* ssp, int row) {
    const f32x4* p = (const f32x4*)(ssp + (size_t)row * 16);
    const f32x4 a = p[0], b = p[1], c = p[2], d = p[3];
    const float s = (((a.x + a.y) + (a.z + a.w)) + ((b.x + b.y) + (b.z + b.w))) + (((c.x + c.y) + (c.z + c.w)) + ((d.x + d.y) + (d.z + d.w)));
    return rsqrtf(s * (1.0f / DM) + RMS_EPS);
}

namespace pg8 {
constexpr int BM = 256, BK = 64, HALF = 128, HTB = HALF * BK * 2, STAGE_BYTES = 8 * HTB, NXCD = 8, WGM = 8;
__host__ __device__ __forceinline__ int lds_byte(int r, int c) { const int st = (r >> 4) * 2 + (c >> 5), rr = r & 15, cc = c & 31, ob = rr * 64 + cc * 2; return st * 1024 + (ob ^ (((ob >> 9) & 1) << 5)); }
__host__ __device__ __forceinline__ void stage_rc(int b, int& R, int& C) { const int st = b / 1024, sb = b % 1024, swz = sb ^ (((sb >> 9) & 1) << 5); R = (st >> 1) * 16 + swz / 64; C = (st & 1) * 32 + (swz % 64) / 2; }
__host__ __device__ __forceinline__ int perm32(int rho) { const int n = rho >> 4, i = rho & 15; return 8 * (i >> 2) + 4 * n + (i & 3); }

struct Unit { int pm, pn, seg; };
struct Seg { const char* A; const char* B; unsigned hA, hB; int lda, ldb, nt; };

template <int NSEG> struct StaticOrder {
    int nM, nN, nwg, G, c;
    __device__ void init(int M_, int N_, int G_, int c_) { nM = M_ / BM; nN = N_ / BM; nwg = nM * nN; G = G_; c = c_; }
    __device__ bool next(int i, Unit& u) const {
        const int ti = i / NSEG; u.seg = i - ti * NSEG;
        const long L = (long)ti * G + c; if (L >= nwg) return false;
        int wgid = (int)L; { const int q = nwg / NXCD, r = nwg % NXCD, xcd = wgid % NXCD, off = wgid / NXCD; wgid = (xcd < r ? xcd * (q + 1) : r * (q + 1) + (xcd - r) * q) + off; }
        const int nig = WGM * nN, gid = wgid / nig, fm = gid * WGM, gsz = (nM - fm) < WGM ? (nM - fm) : WGM;
        u.pm = fm + ((wgid % nig) % gsz); u.pn = (wgid % nig) / gsz; return true;
    }
};

template <class Prob, class Epi, class Sched>
__device__ __forceinline__ void gemm_phase(LAS unsigned char* lds, const Prob& P, const Sched& S, const Epi& E) {
    int tid = threadIdx.x; asm volatile("" : "+v"(tid));
    const int wid = __builtin_amdgcn_readfirstlane(tid >> 6), lane = tid & 63, wr = wid >> 2, wc = wid & 3, fr = lane & 15, fq = lane >> 4;
    int R0, C0; stage_rc(tid * 16, R0, C0);
    const int Rb0 = (R0 & ~31) + perm32(R0 & 31);
    const size_t kstep = (size_t)(BK * 2);
    const unsigned ldsw = (unsigned)wid * 1024u;
    const int aoff = lds_byte(wr * 64 + fr, fq * 8), boff = lds_byte(wc * 32 + fr, fq * 8);
#define PG8_SA(b, h) (((b) * 2 + (h)) * HTB)
#define PG8_SB(b, h) ((4 + (b) * 2 + (h)) * HTB)
#define PG8_STAGE(bufoff, gbase, v0, q) do { \
        __builtin_amdgcn_global_load_lds((const unsigned*)((const char*)(gbase) + (v0)), (LAS unsigned*)(lds + (bufoff) + ldsw), 16, 0, 0); \
        __builtin_amdgcn_global_load_lds((const unsigned*)((const char*)(gbase) + (q) + (v0)), (LAS unsigned*)(lds + (bufoff) + ldsw + 8192), 16, 0, 0); } while (0)
#define PG8_LDA(dst, b, h) do { _Pragma("unroll") for (int m = 0; m < 4; ++m) _Pragma("unroll") for (int k = 0; k < 2; ++k) dst[m][k] = *(const LAS bf16x8*)(lds + PG8_SA(b, h) + aoff + m * 2048 + k * 1024); } while (0)
#define PG8_LDB(dst, b, h) do { _Pragma("unroll") for (int n = 0; n < 2; ++n) _Pragma("unroll") for (int k = 0; k < 2; ++k) dst[n][k] = *(const LAS bf16x8*)(lds + PG8_SB(b, h) + boff + n * 2048 + k * 1024); } while (0)
#define PG8_MMA(ai, bj, At, Bt) do { __builtin_amdgcn_s_setprio(1); _Pragma("unroll") for (int m = 0; m < 4; ++m) _Pragma("unroll") for (int n = 0; n < 2; ++n) _Pragma("unroll") for (int k = 0; k < 2; ++k) \
        acc[ai][bj][m][n] = __builtin_amdgcn_mfma_f32_16x16x32_bf16(Bt[n][k], At[m][k], acc[ai][bj][m][n], 0, 0, 0); __builtin_amdgcn_s_setprio(0); } while (0)
#define PG8_WAIT_V(n) asm volatile("s_waitcnt vmcnt(" #n ")" ::: "memory")
#define PG8_WAIT_L(n) asm volatile("s_waitcnt lgkmcnt(" #n ")" ::: "memory")
#define PG8_BAR __builtin_amdgcn_s_barrier()
#define PG8_SCHED __builtin_amdgcn_sched_barrier(0)
    Unit cur, nxt; int ui = 0;
    if (!S.next(0, cur)) return;
    Seg sc, sn; P.seg(cur, sc);
    unsigned vAc0 = (unsigned)(R0 * sc.lda + C0) * 2u, vBc0 = (unsigned)(Rb0 * sc.ldb + C0) * 2u;
    f32x4 acc[2][2][4][2];
#pragma unroll
    for (int a = 0; a < 2; ++a)
#pragma unroll
        for (int b = 0; b < 2; ++b)
#pragma unroll
            for (int m = 0; m < 4; ++m)
#pragma unroll
                for (int n = 0; n < 2; ++n) acc[a][b][m][n] = (f32x4){0.f, 0.f, 0.f, 0.f};
    bf16x8 At[4][2], B0[2][2], B1[2][2];
    const char* cA = sc.A; const char* cB = sc.B;
    PG8_STAGE(PG8_SB(0, 0), cB, vBc0, sc.hB >> 1); PG8_STAGE(PG8_SB(0, 1), cB + sc.hB, vBc0, sc.hB >> 1); PG8_STAGE(PG8_SA(0, 0), cA, vAc0, sc.hA >> 1); PG8_STAGE(PG8_SA(0, 1), cA + sc.hA, vAc0, sc.hA >> 1);
    if (wr == 1) PG8_BAR;
    PG8_WAIT_V(2); PG8_BAR;
    PG8_STAGE(PG8_SB(1, 0), cB + kstep, vBc0, sc.hB >> 1); PG8_STAGE(PG8_SA(1, 0), cA + kstep, vAc0, sc.hA >> 1); PG8_STAGE(PG8_SB(1, 1), cB + sc.hB + kstep, vBc0, sc.hB >> 1);
    PG8_WAIT_V(6); PG8_BAR;
    for (;;) {
        const bool has_next = S.next(ui + 1, nxt);
        if (has_next) P.seg(nxt, sn); else sn = sc;
        const unsigned vAn0 = (unsigned)(R0 * sn.lda + C0) * 2u, vBn0 = (unsigned)(Rb0 * sn.ldb + C0) * 2u;
        const char* nA = sn.A; const char* nB = sn.B;
        const int nt = sc.nt;
        for (int t = 0; t < nt; t += 2) {
            const bool last = (t == nt - 2);
            const char* a1 = cA + (size_t)(t + 1) * kstep;
            const char* a2 = last ? nA : cA + (size_t)(t + 2) * kstep; const char* b2 = last ? nB : cB + (size_t)(t + 2) * kstep;
            const char* a3 = a2 + kstep; const char* b3 = b2 + kstep;
            const unsigned hA2 = last ? sn.hA : sc.hA, hB2 = last ? sn.hB : sc.hB;
            const unsigned vA0 = last ? vAn0 : vAc0, vB0 = last ? vBn0 : vBc0, qA = hA2 >> 1, qB = hB2 >> 1;
            PG8_LDB(B0, 0, 0); PG8_LDB(B1, 0, 1); PG8_SCHED; PG8_LDA(At, 0, 0); PG8_STAGE(PG8_SA(1, 1), a1 + sc.hA, vAc0, sc.hA >> 1);
            PG8_WAIT_V(8); PG8_WAIT_L(0); PG8_BAR; PG8_MMA(0, 0, At, B0); PG8_MMA(0, 1, At, B1); PG8_BAR; PG8_SCHED;
            PG8_LDA(At, 0, 1); PG8_STAGE(PG8_SB(0, 0), b2, vB0, qB); PG8_STAGE(PG8_SB(0, 1), b2 + hB2, vB0, qB); PG8_STAGE(PG8_SA(0, 0), a2, vA0, qA);
            PG8_WAIT_V(8); PG8_WAIT_L(0); PG8_BAR; PG8_MMA(1, 0, At, B0); PG8_MMA(1, 1, At, B1); PG8_BAR; PG8_SCHED;
            PG8_LDB(B0, 1, 0); PG8_LDB(B1, 1, 1); PG8_SCHED; PG8_LDA(At, 1, 0); PG8_STAGE(PG8_SA(0, 1), a2 + hA2, vA0, qA);
            PG8_WAIT_V(8); PG8_WAIT_L(0); PG8_BAR; PG8_MMA(0, 0, At, B0); PG8_MMA(0, 1, At, B1); PG8_BAR; PG8_SCHED;
            PG8_LDA(At, 1, 1); PG8_STAGE(PG8_SB(1, 0), b3, vB0, qB); PG8_STAGE(PG8_SB(1, 1), b3 + hB2, vB0, qB); PG8_STAGE(PG8_SA(1, 0), a3, vA0, qA);
            PG8_WAIT_V(8); PG8_WAIT_L(0); PG8_BAR; PG8_MMA(1, 0, At, B0); PG8_MMA(1, 1, At, B1); PG8_BAR; PG8_SCHED;
        }
        if (wr == 0) PG8_BAR;
        E(acc, cur, wr, wc, fr, fq);
        if (!has_next) break;
#pragma unroll
        for (int a = 0; a < 2; ++a)
#pragma unroll
            for (int b = 0; b < 2; ++b)
#pragma unroll
                for (int m = 0; m < 4; ++m)
#pragma unroll
                    for (int n = 0; n < 2; ++n) acc[a][b][m][n] = (f32x4){0.f, 0.f, 0.f, 0.f};
        cur = nxt; sc = sn; cA = nA; cB = nB; vAc0 = vAn0; vBc0 = vBn0; ++ui;
        if (wr == 1) PG8_BAR;
    }
    PG8_WAIT_V(0);
    PG8_BAR;
#undef PG8_SA
#undef PG8_SB
#undef PG8_STAGE
#undef PG8_LDA
#undef PG8_LDB
#undef PG8_MMA
#undef PG8_WAIT_V
#undef PG8_WAIT_L
#undef PG8_BAR
#undef PG8_SCHED
}
}

struct ProbPlain {
    const bf16_t* A; const bf16_t* Bt; int lda, ldb, nt;
    __device__ __forceinline__ void seg(const pg8::Unit& u, pg8::Seg& s) const {
        s.A = (const char*)(A + (size_t)u.pm * 256 * lda); s.B = (const char*)(Bt + (size_t)u.pn * 256 * ldb);
        s.hA = 128u * (unsigned)lda * 2u; s.hB = 128u * (unsigned)ldb * 2u; s.lda = lda; s.ldb = ldb; s.nt = nt;
    }
};
struct ProbC1 {
    const bf16_t* xb; const bf16_t* Wg; const bf16_t* O0; const bf16_t* Wp;
    __device__ __forceinline__ void seg(const pg8::Unit& u, pg8::Seg& s) const {
        if (u.seg < 3) {
            s.A = (const char*)(xb + (size_t)u.pm * 256 * DM); s.B = (const char*)(Wg + ((size_t)u.seg * DM + (size_t)u.pn * 256) * DM);
            s.hA = 128u * DM * 2u; s.hB = 128u * DM * 2u; s.lda = DM; s.ldb = DM; s.nt = DM / 64;
        } else {
            const int br = u.seg - 3; const bf16_t* O = (const bf16_t*)((const char*)O0 + (size_t)br * (48 * MiB));
            s.A = (const char*)(O + (size_t)u.pm * 256 * BW); s.B = (const char*)(Wp + ((size_t)br * DM + (size_t)u.pn * 256) * BW);
            s.hA = 128u * BW * 2u; s.hB = 128u * BW * 2u; s.lda = BW; s.ldb = BW; s.nt = BW / 64;
        }
    }
};

#define EPI_ARGS const f32x4 (&acc)[2][2][4][2], const pg8::Unit& u, int wr, int wc, int fr, int fq
__device__ __forceinline__ void st_bf16x8(bf16_t* p, f32x4 v0, f32x4 v1) {
    u32x4 w; w.x = cvt_pk_bf16(v0[0], v0[1]); w.y = cvt_pk_bf16(v0[2], v0[3]); w.z = cvt_pk_bf16(v1[0], v1[1]); w.w = cvt_pk_bf16(v1[2], v1[3]);
    *(u32x4*)p = w;
}
template <class T> __device__ __forceinline__ T* bo(T* base, unsigned byte_off) { return (T*)((char*)base + byte_off); }
template <class T> __device__ __forceinline__ const T* bo(const T* base, unsigned byte_off) { return (const T*)((const char*)base + byte_off); }
__device__ __forceinline__ void ld_bf16x8(const bf16_t* p, f32x4& v0, f32x4& v1) {
    const u32x4 w = *(const u32x4*)p;
    v0 = (f32x4){bf_lo(w.x), bf_hi(w.x), bf_lo(w.y), bf_hi(w.y)}; v1 = (f32x4){bf_lo(w.z), bf_hi(w.z), bf_lo(w.w), bf_hi(w.w)};
}
__device__ __forceinline__ float rstd_at(const float* ssb, unsigned boff) {
    const f32x4* p = (const f32x4*)bo(ssb, boff);
    const f32x4 a = p[0], b = p[1], c = p[2], d = p[3];
    const float s = (((a.x + a.y) + (a.z + a.w)) + ((b.x + b.y) + (b.z + b.w))) + (((c.x + c.y) + (c.z + c.w)) + ((d.x + d.y) + (d.z + d.w)));
    return rsqrtf(s * (1.0f / DM) + RMS_EPS);
}
struct EpiIn {
    bf16_t* qkv; bf16_t* ub; bf16_t* bc; float* kmp; const float* ss;
    __device__ __forceinline__ void operator()(EPI_ARGS) const {
        const int pn = u.pn; const unsigned lrow = (unsigned)(wr * 64 + fr), lcol = (unsigned)(wc * 32 + 8 * fq);
        const float* ssb = ss + (size_t)u.pm * 256 * 16;
        unsigned lb = (lrow * BW + lcol) * 2u, lsb = lrow * 64u;
        asm volatile("" : "+v"(lb), "+v"(lsb));
        float rs[2][4];
#pragma unroll
        for (int ai = 0; ai < 2; ++ai)
#pragma unroll
            for (int m = 0; m < 4; ++m) { rs[ai][m] = rstd_at(ssb, lsb + (unsigned)(ai * 128 + m * 16) * 64u); asm volatile("" : "+v"(rs[ai][m]) :: "memory"); }
        if (pn < 12) {
            const int t = pn >> 1; const float sc = (t == 0 || t == 3) ? C2 : 1.0f;
            bf16_t* base = qkv + (size_t)t * M * BW + (size_t)u.pm * 256 * BW + (pn & 1) * 256;
            if (t == 1) {
                float* kp = kmp + (size_t)(u.pm * 2 + wr) * BW + (pn & 1) * 256;
#pragma unroll
                for (int bj = 0; bj < 2; ++bj)
#pragma unroll
                    for (int n = 0; n < 2; ++n) { f32x4 s = {0.f, 0.f, 0.f, 0.f};
#pragma unroll
                        for (int ai = 0; ai < 2; ++ai)
#pragma unroll
                            for (int m = 0; m < 4; ++m) s += acc[ai][bj][m][n] * rs[ai][m];
#pragma unroll
                        for (int o = 1; o < 16; o <<= 1) { s[0] += __shfl_xor(s[0], o); s[1] += __shfl_xor(s[1], o); s[2] += __shfl_xor(s[2], o); s[3] += __shfl_xor(s[3], o); }
                        if (fr == 0) *(f32x4*)bo(kp, (lcol + (unsigned)(bj * 128 + 4 * n)) * 4u) = s;
                        asm volatile("" ::: "memory"); }
            }
#pragma unroll
            for (int ai = 0; ai < 2; ++ai)
#pragma unroll
                for (int m = 0; m < 4; ++m) { const float f = rs[ai][m] * sc; const unsigned o = lb + (unsigned)(ai * 128 + m * 16) * BW * 2u;
#pragma unroll
                    for (int bj = 0; bj < 2; ++bj) st_bf16x8(bo(base, o + bj * 256u), acc[ai][bj][m][0] * f, acc[ai][bj][m][1] * f);
                    asm volatile("" ::: "memory"); }
        } else if (pn < 16) {
            bf16_t* base = ub + (size_t)u.pm * 256 * BW + (pn - 12) * 128;
#pragma unroll
            for (int ai = 0; ai < 2; ++ai)
#pragma unroll
                for (int m = 0; m < 4; ++m) { const float f = rs[ai][m] * rs[ai][m];
                    st_bf16x8(bo(base, lb + (unsigned)(ai * 128 + m * 16) * BW * 2u), acc[ai][0][m][0] * acc[ai][1][m][0] * f, acc[ai][0][m][1] * acc[ai][1][m][1] * f);
                    asm volatile("" ::: "memory"); }
        } else {
            bf16_t* base = bc + (size_t)u.pm * 256 * BW + (pn - 16) * 256;
#pragma unroll
            for (int ai = 0; ai < 2; ++ai)
#pragma unroll
                for (int m = 0; m < 4; ++m) { const float f = rs[ai][m]; const unsigned o = lb + (unsigned)(ai * 128 + m * 16) * BW * 2u;
#pragma unroll
                    for (int bj = 0; bj < 2; ++bj) st_bf16x8(bo(base, o + bj * 256u), acc[ai][bj][m][0] * f, acc[ai][bj][m][1] * f);
                    asm volatile("" ::: "memory"); }
        }
    }
};
struct EpiC1 {
    bf16_t* g0; bf16_t* mg; const float* bgate; const float* ss;
    __device__ __forceinline__ bf16_t* gtile(int s, int pm, int pn) const {
        const size_t off = (size_t)s * (48 * MiB) + ((s == 2 && pm >= 32) ? 32 * MiB : 0) + ((size_t)pm * 256 * DM + pn * 256) * 2;
        return (bf16_t*)((char*)g0 + off);
    }
    __device__ __forceinline__ void operator()(EPI_ARGS) const {
        const int sg = u.seg; const unsigned lrow = (unsigned)(wr * 64 + fr), lcol = (unsigned)(wc * 32 + 8 * fq); unsigned lb = (lrow * DM + lcol) * 2u, lsb = lrow * 64u;
        asm volatile("" : "+v"(lb), "+v"(lsb));
        bf16_t* gp = gtile(sg < 3 ? sg : sg - 3, u.pm, u.pn);
        if (sg < 3) {
            const float* bg = bgate + sg * DM + u.pn * 256; const float* ssb = ss + (size_t)u.pm * 256 * 16;
            f32x4 bv[2][2];
#pragma unroll
            for (int bj = 0; bj < 2; ++bj) { bv[bj][0] = *(const f32x4*)bo(bg, (lcol + bj * 128u) * 4u); bv[bj][1] = *(const f32x4*)bo(bg, (lcol + bj * 128u + 4u) * 4u); }
#pragma unroll
            for (int ai = 0; ai < 2; ++ai)
#pragma unroll
                for (int m = 0; m < 4; ++m) { const float rs = rstd_at(ssb, lsb + (unsigned)(ai * 128 + m * 16) * 64u); const unsigned o = lb + (unsigned)(ai * 128 + m * 16) * DM * 2u;
#pragma unroll
                    for (int bj = 0; bj < 2; ++bj) { f32x4 v[2];
#pragma unroll
                        for (int n = 0; n < 2; ++n) { const f32x4 x = acc[ai][bj][m][n] * rs + bv[bj][n];
#pragma unroll
                            for (int e = 0; e < 4; ++e) v[n][e] = __builtin_amdgcn_rcpf(1.0f + __builtin_amdgcn_exp2f(-LOG2E * x[e]));
#if defined(DIAG_RAW_ACC)
                            v[n] = acc[ai][bj][m][n];
#endif
#if defined(DIAG_BIAS)
                            v[n] = bv[bj][n];
#endif
#if defined(DIAG_RS)
                            v[n] = (f32x4){rs, rs, rs, rs};
#endif
                        }
                        st_bf16x8(bo(gp, o + bj * 256u), v[0], v[1]); }
                    asm volatile("" ::: "memory"); }
        } else {
            bf16_t* mp = mg + (size_t)u.pm * 256 * DM + u.pn * 256;
#pragma unroll
            for (int ai = 0; ai < 2; ++ai)
#pragma unroll
                for (int m = 0; m < 4; ++m) { const unsigned o = lb + (unsigned)(ai * 128 + m * 16) * DM * 2u;
#pragma unroll
                    for (int bj = 0; bj < 2; ++bj) { f32x4 a0, a1; ld_bf16x8(bo((const bf16_t*)gp, o + bj * 256u), a0, a1);
                        f32x4 v0 = acc[ai][bj][m][0] * a0, v1 = acc[ai][bj][m][1] * a1;
                        if (sg > 3) { f32x4 p0, p1; ld_bf16x8(bo((const bf16_t*)mp, o + bj * 256u), p0, p1); v0 += p0; v1 += p1; }
                        st_bf16x8(bo(mp, o + bj * 256u), v0, v1); }
                    asm volatile("" ::: "memory"); }
        }
    }
};
struct EpiRes {
    const float* base; float* out; bf16_t* xb; float* sso;
    __device__ __forceinline__ void operator()(EPI_ARGS) const {
        const unsigned lrow = (unsigned)(wr * 64 + fr); unsigned le = lrow * DM + (unsigned)(wc * 32 + 8 * fq), lsb = lrow * 64u;
        asm volatile("" : "+v"(le), "+v"(lsb));
        const size_t torg = (size_t)u.pm * 256 * DM + u.pn * 256;
        const float* bp = base + torg; float* op = out + torg; bf16_t* xp = xb + torg; float* sp = sso + (size_t)u.pm * 256 * 16 + u.pn * 4 + wc;
#pragma unroll
        for (int ai = 0; ai < 2; ++ai)
#pragma unroll
            for (int m = 0; m < 4; ++m) { const unsigned o = le + (unsigned)(ai * 128 + m * 16) * DM; float sq = 0.f;
#pragma unroll
                for (int bj = 0; bj < 2; ++bj) { const unsigned ob = (o + bj * 128u) * 4u;
                    const f32x4 x0 = *(const f32x4*)bo(bp, ob) + acc[ai][bj][m][0], x1 = *(const f32x4*)bo(bp, ob + 16u) + acc[ai][bj][m][1];
                    *(f32x4*)bo(op, ob) = x0; *(f32x4*)bo(op, ob + 16u) = x1; st_bf16x8(bo(xp, ob >> 1), x0, x1);
                    sq += (x0[0] * x0[0] + x0[1] * x0[1]) + (x0[2] * x0[2] + x0[3] * x0[3]) + (x1[0] * x1[0] + x1[1] * x1[1]) + (x1[2] * x1[2] + x1[3] * x1[3]); }
                sq += __shfl_xor(sq, 16); sq += __shfl_xor(sq, 32);
                if (fq == 0) *bo(sp, lsb + (unsigned)(ai * 128 + m * 16) * 64u) = sq;
                asm volatile("" ::: "memory"); }
    }
};
struct EpiFfn {
    bf16_t* act; const float* ss;
    __device__ __forceinline__ void operator()(EPI_ARGS) const {
        const unsigned lrow = (unsigned)(wr * 64 + fr); unsigned lb = (lrow * DFF + (unsigned)(wc * 32 + 8 * fq)) * 2u, lsb = lrow * 64u;
        asm volatile("" : "+v"(lb), "+v"(lsb));
        bf16_t* ap = act + (size_t)u.pm * 256 * DFF + u.pn * 128; const float* ssb = ss + (size_t)u.pm * 256 * 16;
#pragma unroll
        for (int ai = 0; ai < 2; ++ai)
#pragma unroll
            for (int m = 0; m < 4; ++m) { const float rs = rstd_at(ssb, lsb + (unsigned)(ai * 128 + m * 16) * 64u); f32x4 v[2];
#pragma unroll
                for (int n = 0; n < 2; ++n) { const f32x4 g = acc[ai][0][m][n] * rs, up = acc[ai][1][m][n] * rs;
#pragma unroll
                    for (int e = 0; e < 4; ++e) v[n][e] = g[e] * up[e] * __builtin_amdgcn_rcpf(1.0f + __builtin_amdgcn_exp2f(-LOG2E * g[e])); }
                st_bf16x8(bo(ap, lb + (unsigned)(ai * 128 + m * 16) * DFF * 2u), v[0], v[1]);
                asm volatile("" ::: "memory"); }
    }
};

namespace att {
__device__ __forceinline__ constexpr int crow(int r, int hi) { return (r & 3) + 8 * (r >> 2) + 4 * hi; }
__device__ __forceinline__ float swap_lo(float x, float& hiv) { auto rr = __builtin_amdgcn_permlane32_swap(__float_as_uint(x), __float_as_uint(x), false, false); hiv = __uint_as_float(rr[1]); return __uint_as_float(rr[0]); }
__device__ __forceinline__ s16x4 vtr(const LAS unsigned char* p) { return __builtin_bit_cast(s16x4, __builtin_amdgcn_ds_read_tr16_b64_v4i16((LAS s16x4*)p)); }
__device__ __forceinline__ void load_k(bf16x8 (&kf)[8], const bf16_t* Kh, int j0, int r32, int hi) {
    const bf16_t* p = Kh + (size_t)(j0 + r32) * BW + hi * 8;
#pragma unroll
    for (int d0 = 0; d0 < 4; ++d0) { kf[2 * d0] = *(const bf16x8*)(p + d0 * 16); kf[2 * d0 + 1] = *(const bf16x8*)(p + (size_t)32 * BW + d0 * 16); }
}
__device__ __forceinline__ void load_v(u32x4 (&vv)[8], const bf16_t* Vh, int j0, int lane) {
    const bf16_t* p = Vh + (size_t)(j0 + (lane >> 3)) * BW + (lane & 7) * 8;
#pragma unroll
    for (int i = 0; i < 8; ++i) vv[i] = *(const u32x4*)(p + (size_t)(8 * i) * BW);
}
__device__ __forceinline__ void stage_v(LAS unsigned char* vst, const u32x4 (&vv)[8], int lane) {
    const int c = lane & 7;
#pragma unroll
    for (int i = 0; i < 8; ++i) { const int key = 8 * i + (lane >> 3);
        *(LAS u32x4*)(vst + ((c >> 2) * 4 + (key >> 4)) * 1024 + (key & 15) * 64 + (c & 3) * 16) = vv[i]; }
}
__device__ __forceinline__ void qk(f32x16& p0, f32x16& p1, const bf16x8 (&kf)[8], const bf16x8 (&qr)[4]) {
#pragma unroll
    for (int d0 = 0; d0 < 4; ++d0) { p0 = __builtin_amdgcn_mfma_f32_32x32x16_bf16(kf[2 * d0], qr[d0], p0, 0, 0, 0); p1 = __builtin_amdgcn_mfma_f32_32x32x16_bf16(kf[2 * d0 + 1], qr[d0], p1, 0, 0, 0); }
}
__device__ __forceinline__ void pv(f32x16& o0, f32x16& o1, const f32x16& p0, const f32x16& p1, const LAS unsigned char* vst, int lane) {
    const int hi = lane >> 5;
    const LAS unsigned char* vp = vst + ((lane >> 4) & 1) * 32 + (lane & 3) * 8 + (4 * hi + ((lane & 15) >> 2)) * 64;
    u32x4 pw[4];
    pw[0] = (u32x4){cvt_pk_bf16(p0[0], p0[1]), cvt_pk_bf16(p0[2], p0[3]), cvt_pk_bf16(p0[4], p0[5]), cvt_pk_bf16(p0[6], p0[7])};
    pw[1] = (u32x4){cvt_pk_bf16(p0[8], p0[9]), cvt_pk_bf16(p0[10], p0[11]), cvt_pk_bf16(p0[12], p0[13]), cvt_pk_bf16(p0[14], p0[15])};
    pw[2] = (u32x4){cvt_pk_bf16(p1[0], p1[1]), cvt_pk_bf16(p1[2], p1[3]), cvt_pk_bf16(p1[4], p1[5]), cvt_pk_bf16(p1[6], p1[7])};
    pw[3] = (u32x4){cvt_pk_bf16(p1[8], p1[9]), cvt_pk_bf16(p1[10], p1[11]), cvt_pk_bf16(p1[12], p1[13]), cvt_pk_bf16(p1[14], p1[15])};
#pragma unroll
    for (int ks = 0; ks < 4; ++ks) {
        const s16x4 a0 = vtr(vp + ks * 1024), a1 = vtr(vp + ks * 1024 + 512), b0 = vtr(vp + 4096 + ks * 1024), b1 = vtr(vp + 4096 + ks * 1024 + 512);
        const bf16x8 v0 = {a0[0], a0[1], a0[2], a0[3], a1[0], a1[1], a1[2], a1[3]}, v1 = {b0[0], b0[1], b0[2], b0[3], b1[0], b1[1], b1[2], b1[3]};
        const bf16x8 pa = __builtin_bit_cast(bf16x8, pw[ks]);
        o0 = __builtin_amdgcn_mfma_f32_32x32x16_bf16(pa, v0, o0, 0, 0, 0);
        o1 = __builtin_amdgcn_mfma_f32_32x32x16_bf16(pa, v1, o1, 0, 0, 0);
    }
}
__device__ __forceinline__ void store_o(bf16_t* Ow, const f32x16& o0, const f32x16& o1, const float (&rsc)[16], LAS unsigned char* stg, int lane) {
    const int r32 = lane & 31, hi = lane >> 5;
    LAS bf16_t* s = (LAS bf16_t*)stg;
#pragma unroll
    for (int r = 0; r < 16; ++r) { const int orow = crow(r, hi);
        s[orow * 64 + r32] = (bf16_t)(cvt_pk_bf16(o0[r] * rsc[r], 0.f) & 0xffffu); s[orow * 64 + 32 + r32] = (bf16_t)(cvt_pk_bf16(o1[r] * rsc[r], 0.f) & 0xffffu); }
    LDS_WAIT();
#pragma unroll
    for (int i = 0; i < 4; ++i) { const int row = i * 8 + (lane >> 3), ch = lane & 7; const u32x4 v = *(const LAS u32x4*)(stg + row * 128 + ch * 16); *(u32x4*)(Ow + (size_t)row * BW + ch * 8) = v; }
    LDS_WAIT();
}

__device__ __forceinline__ void sb_item(bf16_t* Q, bf16_t* Odst, const bf16_t* K, const bf16_t* V, int b, int h, int q0, LAS unsigned char* vst, int lane) {
    asm volatile("" : "+v"(lane));
    const int r32 = lane & 31, hi = lane >> 5;
    const size_t rowbase = (size_t)b * SEQ;
    bf16_t* Qw = Q + (rowbase + q0) * BW + h * HD;
    bf16x8 qr[4];
#pragma unroll
    for (int d0 = 0; d0 < 4; ++d0) qr[d0] = *(const bf16x8*)(Qw + (size_t)r32 * BW + d0 * 16 + hi * 8);
    const bf16_t* Kh = K + rowbase * BW + h * HD; const bf16_t* Vh = V + rowbase * BW + h * HD;
    f32x16 o0 = {}, o1 = {}; float A2 = 0.f;
    const int tq = q0 + r32;
    bf16x8 kf[8]; load_k(kf, Kh, ((q0 + 30) >> 6) * 64, r32, hi);
    for (int kt = (q0 + 30) >> 6; kt >= 0; --kt) {
        const int j0 = kt * 64;
        f32x16 p0 = {}, p1 = {};
        qk(p0, p1, kf, qr);
        asm volatile("" : "+v"(p0), "+v"(p1) :: "memory");
        u32x4 vv[8]; load_v(vv, Vh, j0, lane);
        if (kt > 0) load_k(kf, Kh, j0 - 64, r32, hi);
        const bool diag = (j0 + 63 >= q0);
        f32x16 l0, l1;
#pragma unroll
        for (int r = 0; r < 16; ++r) {
            { const float z = p0[r]; const float t = __builtin_amdgcn_exp2f(-__builtin_fabsf(z)); float l = -(__builtin_fmaxf(z, 0.f) + __builtin_amdgcn_logf(1.0f + t)); if (diag && (j0 + crow(r, hi) >= tq)) l = 0.f; l0[r] = l; }
            { const float z = p1[r]; const float t = __builtin_amdgcn_exp2f(-__builtin_fabsf(z)); float l = -(__builtin_fmaxf(z, 0.f) + __builtin_amdgcn_logf(1.0f + t)); if (diag && (j0 + 32 + crow(r, hi) >= tq)) l = 0.f; l1[r] = l; }
        }
        float carry = A2;
#pragma unroll
        for (int half = 1; half >= 0; --half) {
            f32x16& l = half ? l1 : l0; f32x16& p = half ? p1 : p0;
            float T[4];
#pragma unroll
            for (int g = 0; g < 4; ++g) { l[4 * g + 2] += l[4 * g + 3]; l[4 * g + 1] += l[4 * g + 2]; l[4 * g] += l[4 * g + 1]; T[g] = l[4 * g]; }
            float Tl[4], Th[4];
#pragma unroll
            for (int g = 0; g < 4; ++g) Tl[g] = swap_lo(T[g], Th[g]);
            float E = carry;
#pragma unroll
            for (int g = 3; g >= 0; --g) { const float eh = E; E += Th[g]; const float el = E; E += Tl[g]; const float off = hi ? eh : el;
                l[4 * g] += off; l[4 * g + 1] += off; l[4 * g + 2] += off; l[4 * g + 3] += off; }
            carry = E;
#pragma unroll
            for (int r = 0; r < 16; ++r) { float w = __builtin_amdgcn_exp2f(p[r] + l[r]); if (diag && (j0 + 32 * half + crow(r, hi) >= tq)) w = 0.f; p[r] = w; }
        }
        A2 = carry;
        stage_v(vst, vv, lane); LDS_WAIT();
        pv(o0, o1, p0, p1, vst, lane);
        LDS_WAIT();
        if (__all(A2 < -150.2f)) break;
    }
    float one[16];
#pragma unroll
    for (int r = 0; r < 16; ++r) one[r] = 1.0f;
    store_o(Odst + (rowbase + q0) * BW + h * HD, o0, o1, one, vst, lane);
}

constexpr float MOBA_THR = 8.0f;
__device__ __forceinline__ unsigned moba_gate(const bf16_t* Qw, int blk, const LAS float* km, int lane) {
    asm volatile("" : "+v"(lane));
    const int r32 = lane & 31, hi = lane >> 5;
    unsigned sel = 0u;
    if (blk > 0) {
        float qf[64];
        { const u32x4* qp = (const u32x4*)(Qw + (size_t)r32 * BW);
#pragma unroll
          for (int c = 0; c < 8; ++c) { const u32x4 x = qp[c]; qf[8 * c] = bf_lo(x.x); qf[8 * c + 1] = bf_hi(x.x); qf[8 * c + 2] = bf_lo(x.y); qf[8 * c + 3] = bf_hi(x.y); qf[8 * c + 4] = bf_lo(x.z); qf[8 * c + 5] = bf_hi(x.z); qf[8 * c + 6] = bf_lo(x.w); qf[8 * c + 7] = bf_hi(x.w); } }
        float v1 = -INFINITY, v2 = -INFINITY, v3 = -INFINITY; int i1 = -1, i2 = -1, i3 = -1;
#define TOP_INS(v, n) do { const bool b1 = (v) > v1 || ((v) == v1 && (n) < i1), b2 = (v) > v2 || ((v) == v2 && (n) < i2), b3 = (v) > v3 || ((v) == v3 && (n) < i3); \
            if (b3) { if (b2) { v3 = v2; i3 = i2; if (b1) { v2 = v1; i2 = i1; v1 = (v); i1 = (n); } else { v2 = (v); i2 = (n); } } else { v3 = (v); i3 = (n); } } } while (0)
#pragma unroll 1
        for (int i = 0; i < 16; ++i) { const int n = 16 * hi + i;
            const LAS f32x4* kr = (const LAS f32x4*)(km + n * 64); float d = 0.f;
#pragma unroll
            for (int c = 0; c < 16; ++c) { const f32x4 kk = kr[c]; d += qf[4 * c] * kk[0]; d += qf[4 * c + 1] * kk[1]; d += qf[4 * c + 2] * kk[2]; d += qf[4 * c + 3] * kk[3]; }
            if (n < blk) TOP_INS(d, n); }
        { float x0, x1; x0 = swap_lo(v1, x1); const float pv1 = hi ? x0 : x1; x0 = swap_lo(v2, x1); const float pv2 = hi ? x0 : x1; x0 = swap_lo(v3, x1); const float pv3 = hi ? x0 : x1;
          x0 = swap_lo(__int_as_float(i1), x1); const int pi1 = __float_as_int(hi ? x0 : x1); x0 = swap_lo(__int_as_float(i2), x1); const int pi2 = __float_as_int(hi ? x0 : x1); x0 = swap_lo(__int_as_float(i3), x1); const int pi3 = __float_as_int(hi ? x0 : x1);
          TOP_INS(pv1, pi1); TOP_INS(pv2, pi2); TOP_INS(pv3, pi3); }
#undef TOP_INS
        if (i1 >= 0) sel |= 1u << i1; if (i2 >= 0) sel |= 1u << i2; if (i3 >= 0) sel |= 1u << i3;
    }
    return sel;
}
__device__ __forceinline__ void moba_tile(f32x16& o0, f32x16& o1, float& mrow, float& lsum, const bf16x8 (&qr)[4], bf16x8 (&kf)[8], const bf16_t* Kh, const bf16_t* Vh, int j0, int jn, float lb, float sl2, bool diag, int tq,
                                          LAS unsigned char* vst, LAS float* wsf, int lane) {
    const int r32 = lane & 31, hi = lane >> 5;
    f32x16 p0, p1;
#pragma unroll
    for (int r = 0; r < 16; ++r) { p0[r] = lb; p1[r] = lb + 32.0f * sl2; }
    qk(p0, p1, kf, qr);
    asm volatile("" : "+v"(p0), "+v"(p1) :: "memory");
    u32x4 vv[8]; load_v(vv, Vh, j0, lane);
    if (jn >= 0) load_k(kf, Kh, jn, r32, hi);
#pragma unroll
    for (int r = 0; r < 16; ++r) { p0[r] = __builtin_fmaf(sl2, (float)crow(r, 0), p0[r]); p1[r] = __builtin_fmaf(sl2, (float)crow(r, 0), p1[r]); }
    if (diag) {
#pragma unroll
        for (int r = 0; r < 16; ++r) { if (j0 + crow(r, hi) > tq) p0[r] = -INFINITY; if (j0 + 32 + crow(r, hi) > tq) p1[r] = -INFINITY; }
    }
    float rm = __builtin_fmaxf(p0[0], p1[0]);
#pragma unroll
    for (int r = 1; r < 16; ++r) rm = __builtin_fmaxf(rm, __builtin_fmaxf(p0[r], p1[r]));
    { float x1; const float x0 = swap_lo(rm, x1); rm = __builtin_fmaxf(x0, x1); }
    if (__any(rm > mrow + MOBA_THR)) {
        const float mn = __builtin_fmaxf(mrow, rm); const float f = __builtin_amdgcn_exp2f(mrow - mn); mrow = mn; lsum *= f;
        if (hi == 0) wsf[r32] = f;
        LDS_WAIT();
#pragma unroll
        for (int r = 0; r < 16; ++r) { const float fr_ = wsf[crow(r, hi)]; o0[r] *= fr_; o1[r] *= fr_; }
        LDS_WAIT();
    }
    float ps = 0.f;
#pragma unroll
    for (int r = 0; r < 16; ++r) { p0[r] = __builtin_amdgcn_exp2f(p0[r] - mrow); p1[r] = __builtin_amdgcn_exp2f(p1[r] - mrow); ps += p0[r] + p1[r]; }
    lsum += ps;
    stage_v(vst, vv, lane); LDS_WAIT();
    pv(o0, o1, p0, p1, vst, lane);
    LDS_WAIT();
}
__device__ __forceinline__ void moba_block_item(const bf16_t* Q, const bf16_t* K, const bf16_t* V, int b, int h, int blk, int n, int tix, const LAS unsigned char* lists, const LAS unsigned* cnt,
                                                const LAS unsigned* selm, unsigned char* recO, float* recML, LAS unsigned char* vst, LAS float* wsf, LAS unsigned* trow, int lane) {
    asm volatile("" : "+v"(lane));
    const int r32 = lane & 31, hi = lane >> 5; const size_t rowbase = (size_t)b * SEQ;
    const int cn = (int)cnt[n]; const int p = 32 * tix + r32; const bool valid = p < cn; const int pp = valid ? p : cn - 1;
    const int q = (int)lists[n * 256 + pp]; const unsigned sm = selm[q];
    const unsigned slot = (unsigned)q * 3u + (unsigned)__builtin_popcount(sm & ((1u << n) - 1u));
    if (hi == 0) trow[r32] = slot | (valid ? 0x80000000u : 0u);
    const int tq = blk * 256 + q;
    const bf16_t* Qrow = Q + (rowbase + tq) * BW + h * HD + hi * 8;
    bf16x8 qr[4];
#pragma unroll
    for (int d0 = 0; d0 < 4; ++d0) qr[d0] = *(const bf16x8*)(Qrow + d0 * 16);
    const bf16_t* Kh = K + rowbase * BW + h * HD; const bf16_t* Vh = V + rowbase * BW + h * HD;
    const float sl2 = __builtin_amdgcn_exp2f(-(float)(h + 1)) * LOG2E;
    f32x16 o0 = {}, o1 = {}; float mrow = -INFINITY, lsum = 0.f;
    bf16x8 kf[8]; load_k(kf, Kh, n * 256, r32, hi);
#pragma unroll 1
    for (int i = 0; i < 4; ++i) { const int j0 = n * 256 + i * 64; moba_tile(o0, o1, mrow, lsum, qr, kf, Kh, Vh, j0, i < 3 ? j0 + 64 : -1, sl2 * (float)(j0 + 4 * hi - tq), sl2, false, tq, vst, wsf, lane); }
    { float x1; const float x0 = swap_lo(lsum, x1); lsum = x0 + x1; }
    if (hi == 0) { wsf[32 + r32] = lsum; if (valid) *(f32x2*)(recML + 2 * slot) = (f32x2){mrow, lsum}; }
    LDS_WAIT();
    float rli[16];
#pragma unroll
    for (int r = 0; r < 16; ++r) rli[r] = 1.0f / wsf[32 + crow(r, hi)];
    LDS_WAIT();
    LAS bf16_t* s = (LAS bf16_t*)vst;
#pragma unroll
    for (int r = 0; r < 16; ++r) { const int orow = crow(r, hi);
        s[orow * 64 + r32] = (bf16_t)(cvt_pk_bf16(o0[r] * rli[r], 0.f) & 0xffffu); s[orow * 64 + 32 + r32] = (bf16_t)(cvt_pk_bf16(o1[r] * rli[r], 0.f) & 0xffffu); }
    LDS_WAIT();
#pragma unroll
    for (int i = 0; i < 4; ++i) { const int row = i * 8 + (lane >> 3), ch = lane & 7; const unsigned tr = trow[row]; const u32x4 v = *(const LAS u32x4*)(vst + row * 128 + ch * 16);
        if (tr & 0x80000000u) *(u32x4*)(recO + (size_t)(tr & 0x7fffffffu) * 128 + ch * 16) = v; }
    LDS_WAIT();
}
__device__ __forceinline__ void moba_own_merge(bf16_t* Q, bf16_t* Odst, const bf16_t* K, const bf16_t* V, int b, int h, int blk, int w, unsigned sel, const unsigned char* recO, const float* recML,
                                               LAS unsigned char* vst, LAS float* wsf, int lane) {
    asm volatile("" : "+v"(lane));
    const int r32 = lane & 31, hi = lane >> 5; const size_t rowbase = (size_t)b * SEQ; const int q0 = blk * 256 + w * 32, tq = q0 + r32;
    bf16_t* Qw = Q + (rowbase + q0) * BW + h * HD;
    bf16x8 qr[4];
#pragma unroll
    for (int d0 = 0; d0 < 4; ++d0) qr[d0] = *(const bf16x8*)(Qw + (size_t)r32 * BW + d0 * 16 + hi * 8);
    const bf16_t* Kh = K + rowbase * BW + h * HD; const bf16_t* Vh = V + rowbase * BW + h * HD;
    const float sl2 = __builtin_amdgcn_exp2f(-(float)(h + 1)) * LOG2E;
    f32x16 o0 = {}, o1 = {}; float mrow = -INFINITY, lsum = 0.f;
    const int nown = (w >> 1) + 1;
    bf16x8 kf[8]; load_k(kf, Kh, blk * 256, r32, hi);
#pragma unroll 1
    for (int i = 0; i < nown; ++i) { const int j0 = blk * 256 + i * 64; moba_tile(o0, o1, mrow, lsum, qr, kf, Kh, Vh, j0, i < nown - 1 ? j0 + 64 : -1, sl2 * (float)(j0 + 4 * hi - tq), sl2, i == nown - 1, tq, vst, wsf, lane); }
    { float x1; const float x0 = swap_lo(lsum, x1); lsum = x0 + x1; }
    const int c = __builtin_popcount(sel); const unsigned qslot = (unsigned)(w * 32 + r32) * 3u;
    float mi[3], li[3]; float mx = mrow;
#pragma unroll
    for (int i = 0; i < 3; ++i) { mi[i] = -INFINITY; li[i] = 0.f; if (i < c) { const f32x2 ml = __builtin_nontemporal_load((const f32x2*)(recML + 2 * (qslot + i))); mi[i] = ml.x; li[i] = ml.y; } mx = __builtin_fmaxf(mx, mi[i]); }
    float wgt[4]; wgt[0] = __builtin_amdgcn_exp2f(mrow - mx); float L = wgt[0] * lsum;
#pragma unroll
    for (int i = 0; i < 3; ++i) { wgt[i + 1] = (i < c) ? __builtin_amdgcn_exp2f(mi[i] - mx) * li[i] : 0.f; L += wgt[i + 1]; }
    const float rL = 1.0f / L;
    if (hi == 0) { wsf[r32] = wgt[0] * rL; wsf[32 + r32] = wgt[1] * rL; wsf[64 + r32] = wgt[2] * rL; wsf[96 + r32] = wgt[3] * rL; }
    LDS_WAIT();
    LAS bf16_t* s = (LAS bf16_t*)vst;
#pragma unroll
    for (int r = 0; r < 16; ++r) { const int orow = crow(r, hi); const float a0 = wsf[orow];
        s[orow * 64 + r32] = (bf16_t)(cvt_pk_bf16(o0[r] * a0, 0.f) & 0xffffu); s[orow * 64 + 32 + r32] = (bf16_t)(cvt_pk_bf16(o1[r] * a0, 0.f) & 0xffffu); }
    LDS_WAIT();
#pragma unroll
    for (int i = 0; i < 4; ++i) { const int row = i * 8 + (lane >> 3), ch = lane & 7; const u32x4 ov = *(const LAS u32x4*)(vst + row * 128 + ch * 16);
        f32x4 v0 = {bf_lo(ov.x), bf_hi(ov.x), bf_lo(ov.y), bf_hi(ov.y)}, v1 = {bf_lo(ov.z), bf_hi(ov.z), bf_lo(ov.w), bf_hi(ov.w)};
        const unsigned rslot = (unsigned)(w * 32 + row) * 3u;
#pragma unroll
        for (int k = 0; k < 3; ++k) { const float ak = wsf[32 * (k + 1) + row];
            if (ak != 0.f) { const u32x4 pw = __builtin_nontemporal_load((const u32x4*)(recO + (size_t)(rslot + k) * 128 + ch * 16));
                v0 += ak * (f32x4){bf_lo(pw.x), bf_hi(pw.x), bf_lo(pw.y), bf_hi(pw.y)}; v1 += ak * (f32x4){bf_lo(pw.z), bf_hi(pw.z), bf_lo(pw.w), bf_hi(pw.w)}; } }
        st_bf16x8(Odst + (rowbase + q0 + row) * BW + h * HD + ch * 8, v0, v1); }
    LDS_WAIT();
}
}

#define XB_TMO      128
#define XB_XCNT(j)  (256  + 64 * (j))
#define XB_XSUB(j)  (1280 + 64 * (j))
#define XB_XGEN(j)  (2304 + 64 * (j))
#define XB_TOP      3328
#define XB_TOPGEN   3392
#define XCD_BAR_WORDS 3456
#define XB_SPIN_CAP (1u << 18)
__device__ __forceinline__ unsigned xb_ld(unsigned* p)              { return __hip_atomic_load(p, __ATOMIC_RELAXED, __HIP_MEMORY_SCOPE_AGENT); }
__device__ __forceinline__ unsigned xb_add(unsigned* p, unsigned v) { return __hip_atomic_fetch_add(p, v, __ATOMIC_RELAXED, __HIP_MEMORY_SCOPE_AGENT); }
__device__ __forceinline__ unsigned xb_xcc_id() { return (unsigned)__builtin_amdgcn_s_getreg((3 << 11) | 20) & 0xFu; }
#define XB_SPIN(cond, bar) do { unsigned _sp = 0; while (cond) { __builtin_amdgcn_s_sleep(1); \
    if ((++_sp & 255u) == 0u) { if (xb_ld(&(bar)[XB_TMO])) break; if (_sp > XB_SPIN_CAP) { atomicAdd(&(bar)[XB_TMO], 1u); break; } } } } while (0)
struct XcdBarrier { unsigned* bar; unsigned x; volatile LAS unsigned* st; };
__device__ __forceinline__ XcdBarrier xcd_barrier_post(unsigned* bar, volatile LAS unsigned* st) {
    XcdBarrier b; b.bar = bar; b.x = xb_xcc_id(); b.st = st;
    if (threadIdx.x == 0) (void)xb_add(&bar[XB_XCNT(b.x)], 1u);
    return b;
}
__device__ __forceinline__ void xcd_barrier_complete(unsigned* bar, unsigned x, unsigned& nloc, unsigned& nx) {
    const unsigned G = gridDim.x * gridDim.y * gridDim.z;
    unsigned sum, cnt, mine, sp = 0u;
    for (;;) {
        sum = 0u; cnt = 0u; mine = 0u;
#pragma unroll
        for (unsigned j = 0; j < 16; ++j) { const unsigned c = xb_ld(&bar[XB_XCNT(j)]); sum += c; cnt += (c > 0u) ? 1u : 0u; mine = (j == x) ? c : mine; }
        if (sum == G) break;
        __builtin_amdgcn_s_sleep(1);
        if ((++sp & 255u) == 0u) { if (xb_ld(&bar[XB_TMO])) break; if (sp > XB_SPIN_CAP) { atomicAdd(&bar[XB_TMO], 1u); break; } }
    }
    nloc = mine > 0u ? mine : 1u; nx = cnt > 0u ? cnt : 1u;
}
__device__ __forceinline__ void xcd_barrier(const XcdBarrier& b) {
    asm volatile("s_waitcnt vmcnt(0)" ::: "memory");
    __syncthreads();
    if (threadIdx.x == 0) {
        unsigned* bar = b.bar;
        __builtin_amdgcn_s_waitcnt(0);
        unsigned nloc = b.st[0], nx = b.st[1];
        if (nloc == 0u) { xcd_barrier_complete(bar, b.x, nloc, nx); b.st[0] = nloc; b.st[1] = nx; }
        const unsigned old = xb_add(&bar[XB_XSUB(b.x)], 1u);
        const unsigned gen = old / nloc;
        if (old + 1u == (gen + 1u) * nloc) {
            __builtin_amdgcn_fence(__ATOMIC_RELEASE, "agent");
            asm volatile("s_waitcnt vmcnt(0)" ::: "memory");
            const unsigned og = xb_add(&bar[XB_TOP], 1u);
            const unsigned tg = og / nx;
            if (og + 1u == (tg + 1u) * nx) xb_add(&bar[XB_TOPGEN], 1u);
            else XB_SPIN(xb_ld(&bar[XB_TOPGEN]) == tg, bar);
            __builtin_amdgcn_fence(__ATOMIC_ACQUIRE, "agent");
            xb_add(&bar[XB_XGEN(b.x)], 1u);
            asm volatile("s_waitcnt vmcnt(0)" ::: "memory");
        } else {
            XB_SPIN(xb_ld(&bar[XB_XGEN(b.x)]) == gen, bar);
            __builtin_amdgcn_fence(__ATOMIC_ACQUIRE, "agent");
            asm volatile("s_waitcnt vmcnt(0)" ::: "memory");
        }
    }
    __syncthreads();
}

__device__ __forceinline__ float wave_sum(float v) {
#pragma unroll
    for (int o = 1; o < 64; o <<= 1) v += __shfl_xor(v, o);
    return v;
}
struct TrD { const float* src; const float* gain; bf16_t* dst; int ldw, ldt; };
__device__ __forceinline__ void tr_load(const TrD& d, f32x4 (&v)[8], float (&g)[8], int lane) {
    const int c4 = lane & 7, r0 = lane >> 3;
#pragma unroll
    for (int i = 0; i < 8; ++i) { const int row = 8 * i + r0; v[i] = *(const f32x4*)(d.src + (size_t)row * d.ldw + 4 * c4); g[i] = d.gain ? d.gain[row] : 1.0f; }
}
__device__ __forceinline__ void tr_store(const TrD& d, const f32x4 (&v)[8], const float (&g)[8], LAS float* scr, int lane) {
    const int c4 = lane & 7, r0 = lane >> 3;
#pragma unroll
    for (int i = 0; i < 8; ++i) { LAS float* s = scr + (8 * i + r0) * 33 + 4 * c4; s[0] = v[i][0] * g[i]; s[1] = v[i][1] * g[i]; s[2] = v[i][2] * g[i]; s[3] = v[i][3] * g[i]; }
    LDS_WAIT(); asm volatile("" ::: "memory");
    const int c = lane & 7;
#pragma unroll
    for (int j = 0; j < 4; ++j) { const int n = (lane >> 3) + 8 * j; const LAS float* s = scr + (8 * c) * 33 + n;
        u32x4 o; o.x = cvt_pk_bf16(s[0 * 33], s[1 * 33]); o.y = cvt_pk_bf16(s[2 * 33], s[3 * 33]); o.z = cvt_pk_bf16(s[4 * 33], s[5 * 33]); o.w = cvt_pk_bf16(s[6 * 33], s[7 * 33]);
        *(u32x4*)(d.dst + (size_t)n * d.ldt + 8 * c) = o; }
    LDS_WAIT(); asm volatile("" ::: "memory");
}
constexpr int I_IN = (DM / 64) * (NIN / 32), I_P = (BW / 64) * (DM / 32), I_O = (DM / 64) * (DM / 32), I_G = (DM / 64) * (DFF / 32), I_D = (DFF / 64) * (DM / 32);
constexpr int NITEMS = I_IN + 3 * I_P + I_O + 2 * I_G + I_D;
struct Args { const float* in[14]; float* out; unsigned char* ws; };
__device__ __forceinline__ void tr_decode(int it, TrD& d, const Args& A, int layer, unsigned char* ws) {
    int r = it;
    if (r < I_IN) { const int nblk = NIN / 32, kb = r / nblk, c0 = 32 * (r % nblk); size_t doff;
        if (c0 < 3072) doff = WS_WIN + (size_t)c0 * DM * 2;
        else if (c0 < 3584) doff = WS_WIN + (size_t)(3072 + 256 * ((c0 - 3072) >> 7) + ((c0 - 3072) & 127)) * DM * 2;
        else if (c0 < 4096) doff = WS_WIN + (size_t)(4096 + (c0 - 3584)) * DM * 2;
        else if (c0 < 4608) doff = WS_WIN + (size_t)(3072 + 256 * ((c0 - 4096) >> 7) + 128 + ((c0 - 4096) & 127)) * DM * 2;
        else doff = WS_WG + (size_t)(c0 - 4608) * DM * 2;
        d.src = A.in[2] + (size_t)layer * DM * NIN + (size_t)(64 * kb) * NIN + c0; d.gain = A.in[1] + (size_t)layer * DM + 64 * kb; d.dst = (bf16_t*)(ws + doff) + 64 * kb; d.ldw = NIN; d.ldt = DM; return; }
    r -= I_IN;
    if (r < I_P) { const int nblk = DM / 32, kb = r / nblk, c0 = 32 * (r % nblk);
        d.src = A.in[5] + (size_t)layer * BW * DM + (size_t)(64 * kb) * DM + c0; d.gain = nullptr; d.dst = (bf16_t*)(ws + WS_WP) + (size_t)c0 * BW + 64 * kb; d.ldw = DM; d.ldt = BW; return; }
    r -= I_P;
    if (r < I_P) { const int nblk = DM / 32, kb = r / nblk, c0 = 32 * (r % nblk);
        d.src = A.in[6] + (size_t)layer * BW * DM + (size_t)(64 * kb) * DM + c0; d.gain = nullptr; d.dst = (bf16_t*)(ws + WS_WP) + (size_t)DM * BW + (size_t)c0 * BW + 64 * kb; d.ldw = DM; d.ldt = BW; return; }
    r -= I_P;
    if (r < I_P) { const int nblk = DM / 32, kb = r / nblk, c0 = 32 * (r % nblk);
        d.src = A.in[7] + (size_t)layer * BW * DM + (size_t)(64 * kb) * DM + c0; d.gain = nullptr; d.dst = (bf16_t*)(ws + WS_WP) + (size_t)2 * DM * BW + (size_t)c0 * BW + 64 * kb; d.ldw = DM; d.ldt = BW; return; }
    r -= I_P;
    if (r < I_O) { const int nblk = DM / 32, kb = r / nblk, c0 = 32 * (r % nblk);
        d.src = A.in[8] + (size_t)layer * DM * DM + (size_t)(64 * kb) * DM + c0; d.gain = nullptr; d.dst = (bf16_t*)(ws + WS_WO) + (size_t)c0 * DM + 64 * kb; d.ldw = DM; d.ldt = DM; return; }
    r -= I_O;
    if (r < I_G) { const int nblk = DFF / 32, kb = r / nblk, c0 = 32 * (r % nblk);
        d.src = A.in[10] + (size_t)layer * DM * DFF + (size_t)(64 * kb) * DFF + c0; d.gain = A.in[9] + (size_t)layer * DM + 64 * kb; d.dst = (bf16_t*)(ws + WS_WGU) + (size_t)(256 * (c0 >> 7) + (c0 & 127)) * DM + 64 * kb; d.ldw = DFF; d.ldt = DM; return; }
    r -= I_G;
    if (r < I_G) { const int nblk = DFF / 32, kb = r / nblk, c0 = 32 * (r % nblk);
        d.src = A.in[11] + (size_t)layer * DM * DFF + (size_t)(64 * kb) * DFF + c0; d.gain = A.in[9] + (size_t)layer * DM + 64 * kb; d.dst = (bf16_t*)(ws + WS_WGU) + (size_t)(256 * (c0 >> 7) + 128 + (c0 & 127)) * DM + 64 * kb; d.ldw = DFF; d.ldt = DM; return; }
    r -= I_G;
    { const int nblk = DM / 32, kb = r / nblk, c0 = 32 * (r % nblk);
      d.src = A.in[12] + (size_t)layer * DFF * DM + (size_t)(64 * kb) * DM + c0; d.gain = nullptr; d.dst = (bf16_t*)(ws + WS_WD) + (size_t)c0 * DFF + 64 * kb; d.ldw = DM; d.ldt = DFF; }
}


__global__ void __launch_bounds__(NWAVES * 64, 2) hybrid_fwd(Args args) {
    extern __shared__ __attribute__((aligned(16))) unsigned char lds_raw[];
    LAS unsigned char* lds = (LAS unsigned char*)lds_raw;
    volatile LAS unsigned* MISC = (volatile LAS unsigned*)(lds + MISC_OFF);
    const int tid = threadIdx.x, lane = tid & 63, wave = __builtin_amdgcn_readfirstlane(tid >> 6);
    const int G = gridDim.x, bx = blockIdx.x, vcu = (G % 8 == 0) ? (bx % 8) * (G / 8) + bx / 8 : bx;
    for (int i = tid; i < (LDS_BYTES - LDSCTL_OFF) / 4; i += NWAVES * 64) ((LAS unsigned*)(lds + LDSCTL_OFF))[i] = 0u;
    __syncthreads();
    XcdBarrier bar = xcd_barrier_post((unsigned*)(args.ws + WS_CTL) + CW_BAR, MISC + 8);

    const int gw = vcu * NWAVES + wave, NGW = G * NWAVES;
    for (int layer = 0; layer < DEPTH; ++layer) {
    int tid = threadIdx.x; asm volatile("" : "+v"(tid)); const int lane = tid & 63;
    size_t opq = 0; asm volatile("" : "+s"(opq));
    unsigned char* ws = args.ws + opq; const float* x_in = args.in[0] + opq; float* out = args.out + opq;
    float* ssA = (float*)(ws + WS_SSA); float* ssB = (float*)(ws + WS_SSB); float* kmp = (float*)(ws + WS_KM);
    bf16_t* Win = (bf16_t*)(ws + WS_WIN); bf16_t* Wg = (bf16_t*)(ws + WS_WG); bf16_t* Wp = (bf16_t*)(ws + WS_WP); bf16_t* Wo = (bf16_t*)(ws + WS_WO);
    bf16_t* Wgu = (bf16_t*)(ws + WS_WGU); bf16_t* Wd = (bf16_t*)(ws + WS_WD);
    bf16_t* xb = (bf16_t*)(ws + WS_XB);
    bf16_t* QA = (bf16_t*)(ws + WS_QA); bf16_t* KA = (bf16_t*)(ws + WS_KA); bf16_t* VA = (bf16_t*)(ws + WS_VA);
    bf16_t* QS = (bf16_t*)(ws + WS_QS); bf16_t* KS = (bf16_t*)(ws + WS_KS); bf16_t* VS = (bf16_t*)(ws + WS_VS);
    bf16_t* Ub = (bf16_t*)(ws + WS_U); bf16_t* BC = (bf16_t*)(ws + WS_BC); bf16_t* MG = (bf16_t*)(ws + WS_MG); bf16_t* ACT = (bf16_t*)(ws + WS_ACT);
    {
#ifndef REP_P0
#define REP_P0 1
#endif
        for (int rep_ = 0; rep_ < REP_P0; ++rep_)
        {
            LAS float* scr = (LAS float*)(lds + RING_OFF + wave * 16384);
#define TR_DEC(it_, d_) tr_decode(it_, d_, args, layer, ws)
            for (int it = gw; it < NITEMS; it += NGW) { TrD dc; f32x4 vc[8]; float gc[8]; TR_DEC(it, dc); tr_load(dc, vc, gc, lane); tr_store(dc, vc, gc, scr, lane); }
#undef TR_DEC
            if (layer == 0) {
                for (int m = gw; m < M; m += NGW) {
                    const f32x4* xr = (const f32x4*)(x_in + (size_t)m * DM) + lane; f32x4 v[4]; float s = 0.f;
#pragma unroll
                    for (int j = 0; j < 4; ++j) { v[j] = xr[64 * j]; s += (v[j].x * v[j].x + v[j].y * v[j].y) + (v[j].z * v[j].z + v[j].w * v[j].w); }
                    s = wave_sum(s);
                    u32x2* o8 = (u32x2*)(xb + (size_t)m * DM) + lane;
#pragma unroll
                    for (int j = 0; j < 4; ++j) o8[64 * j] = (u32x2){cvt_pk_bf16(v[j].x, v[j].y), cvt_pk_bf16(v[j].z, v[j].w)};
                    if (lane < 16) ssA[(size_t)m * 16 + lane] = (lane == 0) ? s : 0.f;
                }
            }
            xcd_barrier(bar);
        }
        const float* xres = (layer == 0) ? x_in : out;

#if defined(DUMP_AFTER_P0)
        {
            const bf16_t* src_ = (const bf16_t*)(ws + WS_WG);
            for (size_t i = (size_t)vcu * (NWAVES * 64) + tid; i < (size_t)M * DM; i += (size_t)G * NWAVES * 64) out[i] = bf_lo((unsigned)src_[i]);
            return;
        }
#endif
#if defined(DIAG_GATES_PLAIN)
        {
            ProbPlain P{xb, Wg, DM, DM, DM / 64}; pg8::StaticOrder<1> S; S.init(M, DM, G, bx);
            EpiC1 E{(bf16_t*)(ws + WS_GA), MG, args.in[3] + (size_t)layer * NGATE, ssA};
            pg8::gemm_phase(lds + RING_OFF, P, S, E);
            xcd_barrier(bar);
            const bf16_t* GAp = (const bf16_t*)(ws + WS_GA);
#if DIAG_GATES_PLAIN == 2
            {
                pg8::Unit u0; S.next(0, u0);
                for (int e = tid; e < 256 * 256; e += NWAVES * 64) { const size_t i = ((size_t)u0.pm * 256 + (e >> 8)) * DM + u0.pn * 256 + (e & 255); out[i] = bf_lo((unsigned)GAp[i]); }
            }
#else
            for (size_t i = (size_t)vcu * (NWAVES * 64) + tid; i < (size_t)M * DM; i += (size_t)G * NWAVES * 64) out[i] = bf_lo((unsigned)GAp[i]);
#endif
            return;
        }
#endif
#ifndef REP_P1
#define REP_P1 1
#endif
        for (int rep_ = 0; rep_ < REP_P1; ++rep_)
        {
            ProbPlain P{xb, Win, DM, DM, DM / 64}; pg8::StaticOrder<1> S; S.init(M, N1, G, bx);
            EpiIn E{QA, Ub, BC, kmp, ssA};
            pg8::gemm_phase(lds + RING_OFF, P, S, E);
            xcd_barrier(bar);
        }

        {
            int tid = threadIdx.x; asm volatile("" : "+v"(tid)); const int lane = tid & 63;
            const int bh = vcu >> 4, s = vcu & 15, b = bh >> 3, h = bh & 7;
            LAS unsigned char* vst = lds + RING_OFF + wave * 8192;
            LAS float* wsf = (LAS float*)(lds + RING_OFF + 65536 + wave * 512);
            LAS float* km = (LAS float*)(lds + RING_OFF + 65536 + 4096);
            if (vcu < 256) {
#ifndef NO_MOBA
                {
                    LAS unsigned* selm = (LAS unsigned*)(lds + RING_OFF + 77824);
                    LAS unsigned* cnt = (LAS unsigned*)(lds + RING_OFF + 78848);
                    LAS unsigned char* lists = lds + RING_OFF + 79872;
                    LAS unsigned* trow = (LAS unsigned*)(lds + RING_OFF + 88064 + wave * 128);
                    unsigned char* recO = ws + WS_MG + (size_t)vcu * 131072; float* recML = (float*)(recO + 98304);
#ifndef REP_MOBA
#define REP_MOBA 1
#endif
                    for (int k = 0; k < 2 * REP_MOBA; ++k) {
                        const int blk = (k & 1) == 0 ? 31 - s : s; bf16_t* Od = (k >= 2 * REP_MOBA - 2) ? QA : (bf16_t*)(ws + WS_X);
                        for (int i = tid; i < 2048; i += NWAVES * 64) { const int n = i >> 6, d = i & 63; const size_t o = (size_t)((b * 32 + n) * 2) * BW + h * HD + d; km[i] = kmp[o] + kmp[o + BW]; }
                        __syncthreads();
                        const unsigned sel = att::moba_gate(QA + ((size_t)b * SEQ + blk * 256 + wave * 32) * BW + h * HD, blk, km, lane);
                        if (lane < 32) selm[wave * 32 + lane] = sel;
                        __syncthreads();
                        for (int n = wave; n < blk; n += NWAVES) {
                            unsigned pos = 0;
#pragma unroll
                            for (int c = 0; c < 4; ++c) { const int q = 64 * c + lane; const bool bit = (selm[q] >> n) & 1u; const unsigned long long mk = __ballot(bit);
                                if (bit) lists[n * 256 + pos + __builtin_amdgcn_mbcnt_hi((unsigned)(mk >> 32), __builtin_amdgcn_mbcnt_lo((unsigned)mk, 0u))] = (unsigned char)q;
                                pos += (unsigned)__builtin_popcountll(mk); }
                            if (lane == 0) cnt[n] = pos;
                        }
                        __syncthreads();
                        { int id = 0;
                          for (int n = 0; n < blk; ++n) { const int nt_ = ((int)cnt[n] + 31) >> 5;
                              for (int t = 0; t < nt_; ++t, ++id) if ((id & (NWAVES - 1)) == wave) att::moba_block_item(QA, KA, VA, b, h, blk, n, t, lists, cnt, selm, recO, recML, vst, wsf, trow, lane); } }
                        VM_WAIT();
                        __syncthreads();
                        att::moba_own_merge(QA, Od, KA, VA, b, h, blk, wave, sel, recO, recML, vst, wsf, lane);
                        __syncthreads();
                    }
                }
#endif
#ifndef NO_SB
#ifndef REP_SB
#define REP_SB 1
#endif
                for (int k = 0; k < 2 * REP_SB; ++k) { const int blk = (k & 1) == 0 ? 31 - s : s; att::sb_item(QS, (k >= 2 * REP_SB - 2) ? QS : (bf16_t*)(ws + WS_X), KS, VS, b, h, blk * 256 + wave * 32, vst, lane); }
#endif
            }
            const float* cw = args.in[4] + (size_t)layer * 3 * BW;
            for (int i = vcu * (NWAVES * 64) + tid; i < M * (BW / 8); i += G * NWAVES * 64) {
                const int t = i >> 6, c = (i & 63) * 8; const int tt = t & (SEQ - 1);
                const u32x4 u2 = *(const u32x4*)(Ub + (size_t)t * BW + c);
                u32x4 u1 = {0u, 0u, 0u, 0u}, u0 = {0u, 0u, 0u, 0u};
                if (tt >= 1) u1 = *(const u32x4*)(Ub + (size_t)(t - 1) * BW + c);
                if (tt >= 2) u0 = *(const u32x4*)(Ub + (size_t)(t - 2) * BW + c);
                const u32x4 bw = *(const u32x4*)(BC + (size_t)t * BW + c);
                float y[8];
#pragma unroll
                for (int e = 0; e < 4; ++e) {
                    const float w0l = cw[c + 2 * e], w0h = cw[c + 2 * e + 1], w1l = cw[BW + c + 2 * e], w1h = cw[BW + c + 2 * e + 1], w2l = cw[2 * BW + c + 2 * e], w2h = cw[2 * BW + c + 2 * e + 1];
                    y[2 * e] = bf_lo(bw[e]) * (w0l * bf_lo(u0[e]) + w1l * bf_lo(u1[e]) + w2l * bf_lo(u2[e]));
                    y[2 * e + 1] = bf_hi(bw[e]) * (w0h * bf_hi(u0[e]) + w1h * bf_hi(u1[e]) + w2h * bf_hi(u2[e]));
                }
                *(u32x4*)(BC + (size_t)t * BW + c) = (u32x4){cvt_pk_bf16(y[0], y[1]), cvt_pk_bf16(y[2], y[3]), cvt_pk_bf16(y[4], y[5]), cvt_pk_bf16(y[6], y[7])};
            }
            xcd_barrier(bar);
        }

#if defined(DUMP_AFTER_P2)
        {
            for (size_t i = (size_t)vcu * (NWAVES * 64) + tid; i < (size_t)M * BW; i += (size_t)G * NWAVES * 64) { out[i] = bf_lo((unsigned)QA[i]); out[(size_t)M * BW + i] = bf_lo((unsigned)QS[i]); }
            return;
        }
#endif
#ifndef REP_P3
#define REP_P3 1
#endif
        for (int rep_ = 0; rep_ < REP_P3; ++rep_)
        {
            static_assert(WS_QS - WS_QA == 48 * MiB && WS_BC - WS_QS == 48 * MiB && WS_GB - WS_GA == 48 * MiB && WS_GC0 - WS_GB == 48 * MiB && WS_GC1 - WS_GC0 == 48 * MiB, "48 MiB spacing");
            ProbC1 P{xb, Wg, QA, Wp}; pg8::StaticOrder<6> S; S.init(M, DM, G, bx);
            EpiC1 E{(bf16_t*)(ws + WS_GA), MG, args.in[3] + (size_t)layer * NGATE, ssA};
            pg8::gemm_phase(lds + RING_OFF, P, S, E);
            xcd_barrier(bar);
        }

#if defined(DUMP_AFTER_P3)
        {
#if DUMP_AFTER_P3 == 2
            const bf16_t* GAp = (const bf16_t*)(ws + WS_GA);
            for (size_t i = (size_t)vcu * (NWAVES * 64) + tid; i < (size_t)M * DM; i += (size_t)G * NWAVES * 64) out[i] = bf_lo((unsigned)GAp[i]);
#else
            for (size_t i = (size_t)vcu * (NWAVES * 64) + tid; i < (size_t)M * DM; i += (size_t)G * NWAVES * 64) out[i] = bf_lo((unsigned)MG[i]);
#endif
            return;
        }
#endif
        {
            ProbPlain P{MG, Wo, DM, DM, DM / 64}; pg8::StaticOrder<1> S; S.init(M, DM, G, bx);
            EpiRes E{xres, out, xb, ssB};
            pg8::gemm_phase(lds + RING_OFF, P, S, E);
            xcd_barrier(bar);
        }

#ifndef REP_P5
#define REP_P5 1
#endif
        for (int rep_ = 0; rep_ < REP_P5; ++rep_)
        {
            ProbPlain P{xb, Wgu, DM, DM, DM / 64}; pg8::StaticOrder<1> S; S.init(M, NGU, G, bx);
            EpiFfn E{ACT, ssB};
            pg8::gemm_phase(lds + RING_OFF, P, S, E);
            xcd_barrier(bar);
        }

        {
            ProbPlain P{ACT, Wd, DFF, DFF, DFF / 64}; pg8::StaticOrder<1> S; S.init(M, DM, G, bx);
            EpiRes E{out, out, xb, ssA};
            pg8::gemm_phase(lds + RING_OFF, P, S, E);
            xcd_barrier(bar);
        }
    }
    }

    {
        const float* gf = args.in[13]; unsigned char* ws = args.ws; float* out = args.out; const float* ssA = (const float*)(ws + WS_SSA);
        for (int m = gw; m < M; m += NGW) {
            const float rs = rstd_row(ssA, m);
            f32x4* xr = (f32x4*)(out + (size_t)m * DM) + lane; const f32x4* gr = (const f32x4*)gf + lane;
#pragma unroll
            for (int j = 0; j < 4; ++j) { const f32x4 v = xr[64 * j], g = gr[64 * j]; xr[64 * j] = v * rs * g; }
        }
        if (xb_ld((unsigned*)(ws + WS_CTL) + CW_BAR + XB_TMO) != 0u && bx == 0) { for (int i = tid; i < 4096; i += NWAVES * 64) out[i] = __builtin_nanf(""); }
    }
}

extern "C" void kernel_launch(void* const* d_in, const int* in_sizes, int n_in, void* d_out, int out_size, void* d_ws, size_t ws_size, hipStream_t stream) {
    static int grid = 0;
    if (grid == 0) {
        if (n_in != 14 || in_sizes[0] != M * DM || out_size != M * DM || ws_size < WS_END) { fprintf(stderr, "kernel_launch: unexpected shapes (n_in %d, in0 %d, out %d, ws %zu)\n", n_in, n_in > 0 ? in_sizes[0] : -1, out_size, ws_size); grid = -1; return; }
        int dev = 0, cus = 0, per_cu = 0;
        if (hipGetDevice(&dev) != hipSuccess || hipDeviceGetAttribute(&cus, hipDeviceAttributeMultiprocessorCount, dev) != hipSuccess) { grid = -1; return; }
        if (hipFuncSetAttribute((const void*)hybrid_fwd, hipFuncAttributeMaxDynamicSharedMemorySize, LDS_BYTES) != hipSuccess) { fprintf(stderr, "kernel_launch: hipFuncSetAttribute failed\n"); grid = -1; return; }
        if (hipOccupancyMaxActiveBlocksPerMultiprocessor(&per_cu, (const void*)hybrid_fwd, NWAVES * 64, LDS_BYTES) != hipSuccess || per_cu < 1) { fprintf(stderr, "kernel_launch: occupancy query says %d blocks/CU\n", per_cu); (void)hipGetLastError(); per_cu = 1; }
        grid = cus;
    }
    if (grid < 0) return;
    if (hipMemsetAsync((char*)d_ws + WS_CTL, 0, CTL_ZERO_BYTES, stream) != hipSuccess) { fprintf(stderr, "kernel_launch: memset failed\n"); return; }
    Args a{};
    for (int i = 0; i < 14; ++i) a.in[i] = (const float*)d_in[i];
    a.out = (float*)d_out; a.ws = (unsigned char*)d_ws;
    void* kargs[] = {&a};
    hipError_t e = hipLaunchCooperativeKernel((const void*)hybrid_fwd, dim3(grid), dim3(NWAVES * 64), kargs, LDS_BYTES, stream);
    if (e != hipSuccess) fprintf(stderr, "kernel_launch: cooperative launch failed: %s (grid %d)\n", hipGetErrorString(e), grid);
}
```

```cpp
#include <hip/hip_runtime.h>
#include <hip/hip_bf16.h>
#include <cstdio>
#include <cstdint>

#define GAS __attribute__((address_space(1)))
#define LAS __attribute__((address_space(3)))
typedef unsigned short bf16_t;
typedef short bf16x8 __attribute__((ext_vector_type(8)));
typedef short s16x4 __attribute__((ext_vector_type(4)));
typedef float f32x2 __attribute__((ext_vector_type(2)));
typedef float f32x4 __attribute__((ext_vector_type(4)));
typedef float f32x16 __attribute__((ext_vector_type(16)));
typedef unsigned u32x2 __attribute__((ext_vector_type(2)));
typedef unsigned u32x4 __attribute__((ext_vector_type(4)));
typedef GAS unsigned gu32;

constexpr int BATCH = 2, SEQ = 8192, DM = 1024, M = BATCH * SEQ, NH = 8, HD = 64, BW = 512, DFF = 2816, DEPTH = 2;
constexpr int NIN = 7680, N1 = 4608, NGATE = 3072, NGU = 2 * DFF;
constexpr float RMS_EPS = 1e-6f;
constexpr float LOG2E = 1.4426950408889634f;
constexpr float C2 = 0.125f * LOG2E;
constexpr int NWAVES = 8;

constexpr size_t MiB = 1u << 20;
constexpr size_t WS_CTL = 0, CTL_ZERO_BYTES = 64 * 1024;
constexpr size_t WS_SSA = 1 * MiB, WS_SSB = 2 * MiB, WS_KM = 3 * MiB;
constexpr size_t WS_WIN = 4 * MiB, WS_WG = 13 * MiB, WS_WP = 19 * MiB, WS_WO = 22 * MiB, WS_WGU = 24 * MiB, WS_WD = 35 * MiB;
constexpr size_t WS_XB = 41 * MiB;
constexpr size_t WS_QA = 73 * MiB, WS_KA = 89 * MiB, WS_VA = 105 * MiB, WS_QS = 121 * MiB, WS_KS = 137 * MiB, WS_VS = 153 * MiB;
constexpr size_t WS_BC = 169 * MiB, WS_U = 185 * MiB, WS_MG = 201 * MiB, WS_X = 233 * MiB;
constexpr size_t WS_GA = WS_KA, WS_GB = WS_KS, WS_GC0 = WS_U, WS_GC1 = WS_X;
constexpr size_t WS_ACT = 73 * MiB;
constexpr size_t WS_END = 256 * MiB;
constexpr int CW_BAR = 4096;

constexpr int RING_OFF = 0, RING_BYTES = 131072;
constexpr int LDSCTL_OFF = RING_BYTES, MISC_OFF = LDSCTL_OFF + 320;
constexpr int LDS_BYTES = 147456;

#define LDS_WAIT() asm volatile("s_waitcnt lgkmcnt(0)" ::: "memory")
#define VM_WAIT() asm volatile("s_waitcnt vmcnt(0)" ::: "memory")
#define RLX_AGENT __ATOMIC_RELAXED, __HIP_MEMORY_SCOPE_AGENT

typedef __bf16 bf16x2_t __attribute__((ext_vector_type(2)));
__device__ __forceinline__ unsigned cvt_pk_bf16(float lo, float hi) { const f32x2 v = {lo, hi}; const bf16x2_t b = __builtin_convertvector(v, bf16x2_t); return __builtin_bit_cast(unsigned, b); }
__device__ __forceinline__ float bf_lo(unsigned w) { return __uint_as_float(w << 16); }
__device__ __forceinline__ float bf_hi(unsigned w) { return __uint_as_float(w & 0xffff0000u); }
__device__ __forceinline__ float rstd_row(const float* ssp, int row) {
    const f32x4* p = (const f32x4*)(ssp + (size_t)row * 16);
    const f32x4 a = p[0], b = p[1], c = p[2], d = p[3];
    const float s = (((a.x + a.y) + (a.z + a.w)) + ((b.x + b.y) + (b.z + b.w))) + (((c.x + c.y) + (c.z + c.w)) + ((d.x + d.y) + (d.z + d.w)));
    return rsqrtf(s * (1.0f / DM) + RMS_EPS);
}

namespace pg8 {
constexpr int BM = 256, BK = 64, HALF = 128, HTB = HALF * BK * 2, STAGE_BYTES = 8 * HTB, NXCD = 8, WGM = 8;
__host__ __device__ __forceinline__ int lds_byte(int r, int c) { const int st = (r >> 4) * 2 + (c >> 5), rr = r & 15, cc = c & 31, ob = rr * 64 + cc * 2; return st * 1024 + (ob ^ (((ob >> 9) & 1) << 5)); }
__host__ __device__ __forceinline__ void stage_rc(int b, int& R, int& C) { const int st = b / 1024, sb = b % 1024, swz = sb ^ (((sb >> 9) & 1) << 5); R = (st >> 1) * 16 + swz / 64; C = (st & 1) * 32 + (swz % 64) / 2; }
__host__ __device__ __forceinline__ int perm32(int rho) { const int n = rho >> 4, i = rho & 15; return 8 * (i >> 2) + 4 * n + (i & 3); }

struct Unit { int pm, pn, seg; };
struct Seg { const char* A; const char* B; unsigned hA, hB; int lda, ldb, nt; };

struct StaticOrder {
    int nM, nN, nwg, G, c, nseg;
    __device__ void init(int M_, int N_, int G_, int c_, int nseg_) { nM = M_ / BM; nN = N_ / BM; nwg = nM * nN; G = G_; c = c_; nseg = nseg_; }
    __device__ bool next(int i, Unit& u) const {
        const int ti = (nseg == 1) ? i : i / nseg; u.seg = i - ti * nseg;
        const long L = (long)ti * G + c; if (L >= nwg) return false;
        int wgid = (int)L; { const int q = nwg / NXCD, r = nwg % NXCD, xcd = wgid % NXCD, off = wgid / NXCD; wgid = (xcd < r ? xcd * (q + 1) : r * (q + 1) + (xcd - r) * q) + off; }
        const int nig = WGM * nN, gid = wgid / nig, fm = gid * WGM, gsz = (nM - fm) < WGM ? (nM - fm) : WGM;
        u.pm = fm + ((wgid % nig) % gsz); u.pn = (wgid % nig) / gsz; return true;
    }
};

template <class Prob, class Epi, class Sched>
__device__ __forceinline__ void gemm_phase(LAS unsigned char* lds, const Prob& P, const Sched& S, const Epi& E) {
    int tid = threadIdx.x; asm volatile("" : "+v"(tid));
    const int wid = __builtin_amdgcn_readfirstlane(tid >> 6), lane = tid & 63, wr = wid >> 2, wc = wid & 3, fr = lane & 15, fq = lane >> 4;
    int R0, C0; stage_rc(tid * 16, R0, C0);
    const int Rb0 = (R0 & ~31) + perm32(R0 & 31);
    const size_t kstep = (size_t)(BK * 2);
    const unsigned ldsw = (unsigned)wid * 1024u;
    const int aoff = lds_byte(wr * 64 + fr, fq * 8), boff = lds_byte(wc * 32 + fr, fq * 8);
#define PG8_SA(b, h) (((b) * 2 + (h)) * HTB)
#define PG8_SB(b, h) ((4 + (b) * 2 + (h)) * HTB)
#define PG8_STAGE(bufoff, gbase, v0, q) do { \
        __builtin_amdgcn_global_load_lds((const unsigned*)((const char*)(gbase) + (v0)), (LAS unsigned*)(lds + (bufoff) + ldsw), 16, 0, 0); \
        __builtin_amdgcn_global_load_lds((const unsigned*)((const char*)(gbase) + (q) + (v0)), (LAS unsigned*)(lds + (bufoff) + ldsw + 8192), 16, 0, 0); } while (0)
#define PG8_LDA(dst, b, h) do { _Pragma("unroll") for (int m = 0; m < 4; ++m) _Pragma("unroll") for (int k = 0; k < 2; ++k) dst[m][k] = *(const LAS bf16x8*)(lds + PG8_SA(b, h) + aoff + m * 2048 + k * 1024); } while (0)
#define PG8_LDB(dst, b, h) do { _Pragma("unroll") for (int n = 0; n < 2; ++n) _Pragma("unroll") for (int k = 0; k < 2; ++k) dst[n][k] = *(const LAS bf16x8*)(lds + PG8_SB(b, h) + boff + n * 2048 + k * 1024); } while (0)
#define PG8_MMA(ai, bj, At, Bt) do { __builtin_amdgcn_s_setprio(1); _Pragma("unroll") for (int m = 0; m < 4; ++m) _Pragma("unroll") for (int n = 0; n < 2; ++n) _Pragma("unroll") for (int k = 0; k < 2; ++k) \
        acc[ai][bj][m][n] = __builtin_amdgcn_mfma_f32_16x16x32_bf16(Bt[n][k], At[m][k], acc[ai][bj][m][n], 0, 0, 0); __builtin_amdgcn_s_setprio(0); } while (0)
#define PG8_WAIT_V(n) asm volatile("s_waitcnt vmcnt(" #n ")" ::: "memory")
#define PG8_WAIT_L(n) asm volatile("s_waitcnt lgkmcnt(" #n ")" ::: "memory")
#define PG8_BAR __builtin_amdgcn_s_barrier()
#define PG8_SCHED __builtin_amdgcn_sched_barrier(0)
    Unit cur, nxt; int ui = 0;
    if (!S.next(0, cur)) return;
    Seg sc, sn; P.seg(cur, sc);
    unsigned vAc0 = (unsigned)(R0 * sc.lda + C0) * 2u, vBc0 = (unsigned)(Rb0 * sc.ldb + C0) * 2u;
    f32x4 acc[2][2][4][2];
#pragma unroll
    for (int a = 0; a < 2; ++a)
#pragma unroll
        for (int b = 0; b < 2; ++b)
#pragma unroll
            for (int m = 0; m < 4; ++m)
#pragma unroll
                for (int n = 0; n < 2; ++n) acc[a][b][m][n] = (f32x4){0.f, 0.f, 0.f, 0.f};
    bf16x8 At[4][2], B0[2][2], B1[2][2];
    const char* cA = sc.A; const char* cB = sc.B;
    PG8_STAGE(PG8_SB(0, 0), cB, vBc0, sc.hB >> 1); PG8_STAGE(PG8_SB(0, 1), cB + sc.hB, vBc0, sc.hB >> 1); PG8_STAGE(PG8_SA(0, 0), cA, vAc0, sc.hA >> 1); PG8_STAGE(PG8_SA(0, 1), cA + sc.hA, vAc0, sc.hA >> 1);
    if (wr == 1) PG8_BAR;
    PG8_WAIT_V(2); PG8_BAR;
    PG8_STAGE(PG8_SB(1, 0), cB + kstep, vBc0, sc.hB >> 1); PG8_STAGE(PG8_SA(1, 0), cA + kstep, vAc0, sc.hA >> 1); PG8_STAGE(PG8_SB(1, 1), cB + sc.hB + kstep, vBc0, sc.hB >> 1);
    PG8_WAIT_V(6); PG8_BAR;
    for (;;) {
        const bool has_next = S.next(ui + 1, nxt);
        if (has_next) P.seg(nxt, sn); else sn = sc;
        const unsigned vAn0 = (unsigned)(R0 * sn.lda + C0) * 2u, vBn0 = (unsigned)(Rb0 * sn.ldb + C0) * 2u;
        const char* nA = sn.A; const char* nB = sn.B;
        const int nt = sc.nt;
        for (int t = 0; t < nt; t += 2) {
            const bool last = (t == nt - 2);
            const char* a1 = cA + (size_t)(t + 1) * kstep;
            const char* a2 = last ? nA : cA + (size_t)(t + 2) * kstep; const char* b2 = last ? nB : cB + (size_t)(t + 2) * kstep;
            const char* a3 = a2 + kstep; const char* b3 = b2 + kstep;
            const unsigned hA2 = last ? sn.hA : sc.hA, hB2 = last ? sn.hB : sc.hB;
            const unsigned vA0 = last ? vAn0 : vAc0, vB0 = last ? vBn0 : vBc0, qA = hA2 >> 1, qB = hB2 >> 1;
            PG8_LDB(B0, 0, 0); PG8_LDB(B1, 0, 1); PG8_SCHED; PG8_LDA(At, 0, 0); PG8_STAGE(PG8_SA(1, 1), a1 + sc.hA, vAc0, sc.hA >> 1);
            PG8_WAIT_V(8); PG8_WAIT_L(0); PG8_BAR; PG8_MMA(0, 0, At, B0); PG8_MMA(0, 1, At, B1); PG8_BAR; PG8_SCHED;
            PG8_LDA(At, 0, 1); PG8_STAGE(PG8_SB(0, 0), b2, vB0, qB); PG8_STAGE(PG8_SB(0, 1), b2 + hB2, vB0, qB); PG8_STAGE(PG8_SA(0, 0), a2, vA0, qA);
            PG8_WAIT_V(8); PG8_WAIT_L(0); PG8_BAR; PG8_MMA(1, 0, At, B0); PG8_MMA(1, 1, At, B1); PG8_BAR; PG8_SCHED;
            PG8_LDB(B0, 1, 0); PG8_LDB(B1, 1, 1); PG8_SCHED; PG8_LDA(At, 1, 0); PG8_STAGE(PG8_SA(0, 1), a2 + hA2, vA0, qA);
            PG8_WAIT_V(8); PG8_WAIT_L(0); PG8_BAR; PG8_MMA(0, 0, At, B0); PG8_MMA(0, 1, At, B1); PG8_BAR; PG8_SCHED;
            PG8_LDA(At, 1, 1); PG8_STAGE(PG8_SB(1, 0), b3, vB0, qB); PG8_STAGE(PG8_SB(1, 1), b3 + hB2, vB0, qB); PG8_STAGE(PG8_SA(1, 0), a3, vA0, qA);
            PG8_WAIT_V(8); PG8_WAIT_L(0); PG8_BAR; PG8_MMA(1, 0, At, B0); PG8_MMA(1, 1, At, B1); PG8_BAR; PG8_SCHED;
        }
        if (wr == 0) PG8_BAR;
        E(acc, cur, wr, wc, fr, fq);
        if (!has_next) break;
#pragma unroll
        for (int a = 0; a < 2; ++a)
#pragma unroll
            for (int b = 0; b < 2; ++b)
#pragma unroll
                for (int m = 0; m < 4; ++m)
#pragma unroll
                    for (int n = 0; n < 2; ++n) acc[a][b][m][n] = (f32x4){0.f, 0.f, 0.f, 0.f};
        cur = nxt; sc = sn; cA = nA; cB = nB; vAc0 = vAn0; vBc0 = vBn0; ++ui;
        if (wr == 1) PG8_BAR;
    }
    PG8_WAIT_V(0);
    PG8_BAR;
#undef PG8_SA
#undef PG8_SB
#undef PG8_STAGE
#undef PG8_LDA
#undef PG8_LDB
#undef PG8_MMA
#undef PG8_WAIT_V
#undef PG8_WAIT_L
#undef PG8_BAR
#undef PG8_SCHED
}
}

#define EPI_ARGS const f32x4 (&acc)[2][2][4][2], const pg8::Unit& u, int wr, int wc, int fr, int fq
__device__ __forceinline__ void st_bf16x8(bf16_t* p, f32x4 v0, f32x4 v1) {
    u32x4 w; w.x = cvt_pk_bf16(v0[0], v0[1]); w.y = cvt_pk_bf16(v0[2], v0[3]); w.z = cvt_pk_bf16(v1[0], v1[1]); w.w = cvt_pk_bf16(v1[2], v1[3]);
    *(u32x4*)p = w;
}
template <class T> __device__ __forceinline__ T* bo(T* base, unsigned byte_off) { return (T*)((char*)base + byte_off); }
template <class T> __device__ __forceinline__ const T* bo(const T* base, unsigned byte_off) { return (const T*)((const char*)base + byte_off); }
__device__ __forceinline__ void ld_bf16x8(const bf16_t* p, f32x4& v0, f32x4& v1) {
    const unsigned long long lo = __hip_atomic_load((const unsigned long long*)p, __ATOMIC_RELAXED, __HIP_MEMORY_SCOPE_AGENT), hi = __hip_atomic_load((const unsigned long long*)p + 1, __ATOMIC_RELAXED, __HIP_MEMORY_SCOPE_AGENT);
    const u32x4 w = {(unsigned)lo, (unsigned)(lo >> 32), (unsigned)hi, (unsigned)(hi >> 32)};
    v0 = (f32x4){bf_lo(w.x), bf_hi(w.x), bf_lo(w.y), bf_hi(w.y)}; v1 = (f32x4){bf_lo(w.z), bf_hi(w.z), bf_lo(w.w), bf_hi(w.w)};
}
__device__ __forceinline__ float rstd_at(const float* ssb, unsigned boff) {
    const f32x4* p = (const f32x4*)bo(ssb, boff);
    const f32x4 a = p[0], b = p[1], c = p[2], d = p[3];
    const float s = (((a.x + a.y) + (a.z + a.w)) + ((b.x + b.y) + (b.z + b.w))) + (((c.x + c.y) + (c.z + c.w)) + ((d.x + d.y) + (d.z + d.w)));
    return rsqrtf(s * (1.0f / DM) + RMS_EPS);
}
struct EpiIn {
    bf16_t* qkv; bf16_t* ub; bf16_t* bc; float* kmp; const float* ss;
    __device__ __forceinline__ void operator()(EPI_ARGS) const {
        const int pn = u.pn; const unsigned lrow = (unsigned)(wr * 64 + fr), lcol = (unsigned)(wc * 32 + 8 * fq);
        const float* ssb = ss + (size_t)u.pm * 256 * 16;
        unsigned lb = (lrow * BW + lcol) * 2u, lsb = lrow * 64u;
        asm volatile("" : "+v"(lb), "+v"(lsb));
        float rs[2][4];
#pragma unroll
        for (int ai = 0; ai < 2; ++ai)
#pragma unroll
            for (int m = 0; m < 4; ++m) { rs[ai][m] = rstd_at(ssb, lsb + (unsigned)(ai * 128 + m * 16) * 64u); asm volatile("" : "+v"(rs[ai][m]) :: "memory"); }
        if (pn < 12) {
            const int t = pn >> 1; const float sc = (t == 0 || t == 3) ? C2 : 1.0f;
            bf16_t* base = qkv + (size_t)t * M * BW + (size_t)u.pm * 256 * BW + (pn & 1) * 256;
            if (t == 1) {
                float* kp = kmp + (size_t)(u.pm * 2 + wr) * BW + (pn & 1) * 256;
#pragma unroll
                for (int bj = 0; bj < 2; ++bj)
#pragma unroll
                    for (int n = 0; n < 2; ++n) { f32x4 s = {0.f, 0.f, 0.f, 0.f};
#pragma unroll
                        for (int ai = 0; ai < 2; ++ai)
#pragma unroll
                            for (int m = 0; m < 4; ++m) s += acc[ai][bj][m][n] * rs[ai][m];
#pragma unroll
                        for (int o = 1; o < 16; o <<= 1) { s[0] += __shfl_xor(s[0], o); s[1] += __shfl_xor(s[1], o); s[2] += __shfl_xor(s[2], o); s[3] += __shfl_xor(s[3], o); }
                        if (fr == 0) *(f32x4*)bo(kp, (lcol + (unsigned)(bj * 128 + 4 * n)) * 4u) = s;
                        asm volatile("" ::: "memory"); }
            }
#pragma unroll
            for (int ai = 0; ai < 2; ++ai)
#pragma unroll
                for (int m = 0; m < 4; ++m) { const float f = rs[ai][m] * sc; const unsigned o = lb + (unsigned)(ai * 128 + m * 16) * BW * 2u;
#pragma unroll
                    for (int bj = 0; bj < 2; ++bj) st_bf16x8(bo(base, o + bj * 256u), acc[ai][bj][m][0] * f, acc[ai][bj][m][1] * f);
                    asm volatile("" ::: "memory"); }
        } else if (pn < 16) {
            bf16_t* base = ub + (size_t)u.pm * 256 * BW + (pn - 12) * 128;
#pragma unroll
            for (int ai = 0; ai < 2; ++ai)
#pragma unroll
                for (int m = 0; m < 4; ++m) { const float f = rs[ai][m] * rs[ai][m];
                    st_bf16x8(bo(base, lb + (unsigned)(ai * 128 + m * 16) * BW * 2u), acc[ai][0][m][0] * acc[ai][1][m][0] * f, acc[ai][0][m][1] * acc[ai][1][m][1] * f);
                    asm volatile("" ::: "memory"); }
        } else {
            bf16_t* base = bc + (size_t)u.pm * 256 * BW + (pn - 16) * 256;
#pragma unroll
            for (int ai = 0; ai < 2; ++ai)
#pragma unroll
                for (int m = 0; m < 4; ++m) { const float f = rs[ai][m]; const unsigned o = lb + (unsigned)(ai * 128 + m * 16) * BW * 2u;
#pragma unroll
                    for (int bj = 0; bj < 2; ++bj) st_bf16x8(bo(base, o + bj * 256u), acc[ai][bj][m][0] * f, acc[ai][bj][m][1] * f);
                    asm volatile("" ::: "memory"); }
        }
    }
};
struct EpiC1 {
    bf16_t* g0; bf16_t* mg; const float* bgate; const float* ss;
    __device__ __forceinline__ bf16_t* gtile(int s, int pm, int pn) const {
        const size_t off = (size_t)s * (48 * MiB) + ((s == 2 && pm >= 32) ? 32 * MiB : 0) + ((size_t)pm * 256 * DM + pn * 256) * 2;
        return (bf16_t*)((char*)g0 + off);
    }
    __device__ __forceinline__ void operator()(EPI_ARGS) const {
        const int sg = u.seg; const unsigned lrow = (unsigned)(wr * 64 + fr), lcol = (unsigned)(wc * 32 + 8 * fq); unsigned lb = (lrow * DM + lcol) * 2u, lsb = lrow * 64u;
        asm volatile("" : "+v"(lb), "+v"(lsb));
        bf16_t* gp = gtile(sg < 3 ? sg : sg - 3, u.pm, u.pn);
        if (sg < 3) {
            const float* bg = bgate + sg * DM + u.pn * 256; const float* ssb = ss + (size_t)u.pm * 256 * 16;
            f32x4 bv[2][2];
#pragma unroll
            for (int bj = 0; bj < 2; ++bj) { bv[bj][0] = *(const f32x4*)bo(bg, (lcol + bj * 128u) * 4u); bv[bj][1] = *(const f32x4*)bo(bg, (lcol + bj * 128u + 4u) * 4u); }
#pragma unroll
            for (int ai = 0; ai < 2; ++ai)
#pragma unroll
                for (int m = 0; m < 4; ++m) { const float rs = rstd_at(ssb, lsb + (unsigned)(ai * 128 + m * 16) * 64u); const unsigned o = lb + (unsigned)(ai * 128 + m * 16) * DM * 2u;
#pragma unroll
                    for (int bj = 0; bj < 2; ++bj) { f32x4 v[2];
#pragma unroll
                        for (int n = 0; n < 2; ++n) { const f32x4 x = acc[ai][bj][m][n] * rs + bv[bj][n];
#pragma unroll
                            for (int e = 0; e < 4; ++e) v[n][e] = __builtin_amdgcn_rcpf(1.0f + __builtin_amdgcn_exp2f(-LOG2E * x[e]));
                        }
                        st_bf16x8(bo(gp, o + bj * 256u), v[0], v[1]); }
                    asm volatile("" ::: "memory"); }
        } else {
            bf16_t* mp = mg + (size_t)u.pm * 256 * DM + u.pn * 256;
#pragma unroll
            for (int ai = 0; ai < 2; ++ai)
#pragma unroll
                for (int m = 0; m < 4; ++m) { const unsigned o = lb + (unsigned)(ai * 128 + m * 16) * DM * 2u;
#pragma unroll
                    for (int bj = 0; bj < 2; ++bj) { f32x4 a0, a1; ld_bf16x8(bo((const bf16_t*)gp, o + bj * 256u), a0, a1);
                        f32x4 v0 = acc[ai][bj][m][0] * a0, v1 = acc[ai][bj][m][1] * a1;
                        if (sg > 3) { f32x4 p0, p1; ld_bf16x8(bo((const bf16_t*)mp, o + bj * 256u), p0, p1); v0 += p0; v1 += p1; }
                        st_bf16x8(bo(mp, o + bj * 256u), v0, v1); }
                    asm volatile("" ::: "memory"); }
        }
    }
};
struct EpiRes {
    const float* base; float* out; bf16_t* xb; float* sso;
    __device__ __forceinline__ void operator()(EPI_ARGS) const {
        const unsigned lrow = (unsigned)(wr * 64 + fr); unsigned le = lrow * DM + (unsigned)(wc * 32 + 8 * fq), lsb = lrow * 64u;
        asm volatile("" : "+v"(le), "+v"(lsb));
        const size_t torg = (size_t)u.pm * 256 * DM + u.pn * 256;
        const float* bp = base + torg; float* op = out + torg; bf16_t* xp = xb + torg; float* sp = sso + (size_t)u.pm * 256 * 16 + u.pn * 4 + wc;
#pragma unroll
        for (int ai = 0; ai < 2; ++ai)
#pragma unroll
            for (int m = 0; m < 4; ++m) { const unsigned o = le + (unsigned)(ai * 128 + m * 16) * DM; float sq = 0.f;
#pragma unroll
                for (int bj = 0; bj < 2; ++bj) { const unsigned ob = (o + bj * 128u) * 4u;
                    const f32x4 x0 = *(const f32x4*)bo(bp, ob) + acc[ai][bj][m][0], x1 = *(const f32x4*)bo(bp, ob + 16u) + acc[ai][bj][m][1];
                    *(f32x4*)bo(op, ob) = x0; *(f32x4*)bo(op, ob + 16u) = x1; st_bf16x8(bo(xp, ob >> 1), x0, x1);
                    sq += (x0[0] * x0[0] + x0[1] * x0[1]) + (x0[2] * x0[2] + x0[3] * x0[3]) + (x1[0] * x1[0] + x1[1] * x1[1]) + (x1[2] * x1[2] + x1[3] * x1[3]); }
                sq += __shfl_xor(sq, 16); sq += __shfl_xor(sq, 32);
                if (fq == 0) *bo(sp, lsb + (unsigned)(ai * 128 + m * 16) * 64u) = sq;
                asm volatile("" ::: "memory"); }
    }
};
struct EpiFfn {
    bf16_t* act; const float* ss;
    __device__ __forceinline__ void operator()(EPI_ARGS) const {
        const unsigned lrow = (unsigned)(wr * 64 + fr); unsigned lb = (lrow * DFF + (unsigned)(wc * 32 + 8 * fq)) * 2u, lsb = lrow * 64u;
        asm volatile("" : "+v"(lb), "+v"(lsb));
        bf16_t* ap = act + (size_t)u.pm * 256 * DFF + u.pn * 128; const float* ssb = ss + (size_t)u.pm * 256 * 16;
#pragma unroll
        for (int ai = 0; ai < 2; ++ai)
#pragma unroll
            for (int m = 0; m < 4; ++m) { const float rs = rstd_at(ssb, lsb + (unsigned)(ai * 128 + m * 16) * 64u); f32x4 v[2];
#pragma unroll
                for (int n = 0; n < 2; ++n) { const f32x4 g = acc[ai][0][m][n] * rs, up = acc[ai][1][m][n] * rs;
#pragma unroll
                    for (int e = 0; e < 4; ++e) v[n][e] = g[e] * up[e] * __builtin_amdgcn_rcpf(1.0f + __builtin_amdgcn_exp2f(-LOG2E * g[e])); }
                st_bf16x8(bo(ap, lb + (unsigned)(ai * 128 + m * 16) * DFF * 2u), v[0], v[1]);
                asm volatile("" ::: "memory"); }
    }
};

struct GCfg {
    int mode;
    int N, nseg;
    const bf16_t* A; const bf16_t* B; int lda, ldb, nt;
    const bf16_t* A2; const bf16_t* B2;
    EpiIn e0; EpiC1 e1; EpiRes e2; EpiFfn e3;
};
struct ProbAny {
    const GCfg* c;
    __device__ __forceinline__ void seg(const pg8::Unit& u, pg8::Seg& s) const {
        if (c->mode == 1 && u.seg >= 3) {
            const int br = u.seg - 3; const bf16_t* O = (const bf16_t*)((const char*)c->A2 + (size_t)br * (48 * MiB));
            s.A = (const char*)(O + (size_t)u.pm * 256 * BW); s.B = (const char*)(c->B2 + ((size_t)br * DM + (size_t)u.pn * 256) * BW);
            s.hA = 128u * BW * 2u; s.hB = 128u * BW * 2u; s.lda = BW; s.ldb = BW; s.nt = BW / 64;
        } else {
            const int so = (c->mode == 1) ? u.seg * DM : 0;
            s.A = (const char*)(c->A + (size_t)u.pm * 256 * c->lda); s.B = (const char*)(c->B + ((size_t)so + (size_t)u.pn * 256) * c->ldb);
            s.hA = 128u * (unsigned)c->lda * 2u; s.hB = 128u * (unsigned)c->ldb * 2u; s.lda = c->lda; s.ldb = c->ldb; s.nt = c->nt;
        }
    }
};
struct EpiAny {
    const GCfg* c;
    __device__ __forceinline__ void operator()(EPI_ARGS) const {
        const int m_ = c->mode;
        if (m_ == 0) c->e0(acc, u, wr, wc, fr, fq);
        else if (m_ == 1) c->e1(acc, u, wr, wc, fr, fq);
        else if (m_ == 2) c->e2(acc, u, wr, wc, fr, fq);
        else c->e3(acc, u, wr, wc, fr, fq);
    }
};

namespace att {
__device__ __forceinline__ constexpr int crow(int r, int hi) { return (r & 3) + 8 * (r >> 2) + 4 * hi; }
__device__ __forceinline__ float swap_lo(float x, float& hiv) { auto rr = __builtin_amdgcn_permlane32_swap(__float_as_uint(x), __float_as_uint(x), false, false); hiv = __uint_as_float(rr[1]); return __uint_as_float(rr[0]); }
__device__ __forceinline__ s16x4 vtr(const LAS unsigned char* p) { return __builtin_bit_cast(s16x4, __builtin_amdgcn_ds_read_tr16_b64_v4i16((LAS s16x4*)p)); }
__device__ __forceinline__ void load_k(bf16x8 (&kf)[8], const bf16_t* Kh, int j0, int r32, int hi) {
    const bf16_t* p = Kh + (size_t)(j0 + r32) * BW + hi * 8;
#pragma unroll
    for (int d0 = 0; d0 < 4; ++d0) { kf[2 * d0] = *(const bf16x8*)(p + d0 * 16); kf[2 * d0 + 1] = *(const bf16x8*)(p + (size_t)32 * BW + d0 * 16); }
}
__device__ __forceinline__ void load_v(u32x4 (&vv)[8], const bf16_t* Vh, int j0, int lane) {
    const bf16_t* p = Vh + (size_t)(j0 + (lane >> 3)) * BW + (lane & 7) * 8;
#pragma unroll
    for (int i = 0; i < 8; ++i) vv[i] = *(const u32x4*)(p + (size_t)(8 * i) * BW);
}
__device__ __forceinline__ void stage_v(LAS unsigned char* vst, const u32x4 (&vv)[8], int lane) {
    const int c = lane & 7;
#pragma unroll
    for (int i = 0; i < 8; ++i) { const int key = 8 * i + (lane >> 3);
        *(LAS u32x4*)(vst + ((c >> 2) * 4 + (key >> 4)) * 1024 + (key & 15) * 64 + (c & 3) * 16) = vv[i]; }
}
__device__ __forceinline__ void qk(f32x16& p0, f32x16& p1, const bf16x8 (&kf)[8], const bf16x8 (&qr)[4]) {
#pragma unroll
    for (int d0 = 0; d0 < 4; ++d0) { p0 = __builtin_amdgcn_mfma_f32_32x32x16_bf16(kf[2 * d0], qr[d0], p0, 0, 0, 0); p1 = __builtin_amdgcn_mfma_f32_32x32x16_bf16(kf[2 * d0 + 1], qr[d0], p1, 0, 0, 0); }
}
__device__ __forceinline__ void pv(f32x16& o0, f32x16& o1, const f32x16& p0, const f32x16& p1, const LAS unsigned char* vst, int lane) {
    const int hi = lane >> 5;
    const LAS unsigned char* vp = vst + ((lane >> 4) & 1) * 32 + (lane & 3) * 8 + (4 * hi + ((lane & 15) >> 2)) * 64;
    u32x4 pw[4];
    pw[0] = (u32x4){cvt_pk_bf16(p0[0], p0[1]), cvt_pk_bf16(p0[2], p0[3]), cvt_pk_bf16(p0[4], p0[5]), cvt_pk_bf16(p0[6], p0[7])};
    pw[1] = (u32x4){cvt_pk_bf16(p0[8], p0[9]), cvt_pk_bf16(p0[10], p0[11]), cvt_pk_bf16(p0[12], p0[13]), cvt_pk_bf16(p0[14], p0[15])};
    pw[2] = (u32x4){cvt_pk_bf16(p1[0], p1[1]), cvt_pk_bf16(p1[2], p1[3]), cvt_pk_bf16(p1[4], p1[5]), cvt_pk_bf16(p1[6], p1[7])};
    pw[3] = (u32x4){cvt_pk_bf16(p1[8], p1[9]), cvt_pk_bf16(p1[10], p1[11]), cvt_pk_bf16(p1[12], p1[13]), cvt_pk_bf16(p1[14], p1[15])};
#pragma unroll
    for (int ks = 0; ks < 4; ++ks) {
        const s16x4 a0 = vtr(vp + ks * 1024), a1 = vtr(vp + ks * 1024 + 512), b0 = vtr(vp + 4096 + ks * 1024), b1 = vtr(vp + 4096 + ks * 1024 + 512);
        const bf16x8 v0 = {a0[0], a0[1], a0[2], a0[3], a1[0], a1[1], a1[2], a1[3]}, v1 = {b0[0], b0[1], b0[2], b0[3], b1[0], b1[1], b1[2], b1[3]};
        const bf16x8 pa = __builtin_bit_cast(bf16x8, pw[ks]);
        o0 = __builtin_amdgcn_mfma_f32_32x32x16_bf16(pa, v0, o0, 0, 0, 0);
        o1 = __builtin_amdgcn_mfma_f32_32x32x16_bf16(pa, v1, o1, 0, 0, 0);
    }
}
__device__ __forceinline__ void store_o(bf16_t* Ow, const f32x16& o0, const f32x16& o1, const float (&rsc)[16], LAS unsigned char* stg, int lane) {
    const int r32 = lane & 31, hi = lane >> 5;
    LAS bf16_t* s = (LAS bf16_t*)stg;
#pragma unroll
    for (int r = 0; r < 16; ++r) { const int orow = crow(r, hi);
        s[orow * 64 + r32] = (bf16_t)(cvt_pk_bf16(o0[r] * rsc[r], 0.f) & 0xffffu); s[orow * 64 + 32 + r32] = (bf16_t)(cvt_pk_bf16(o1[r] * rsc[r], 0.f) & 0xffffu); }
    LDS_WAIT();
#pragma unroll
    for (int i = 0; i < 4; ++i) { const int row = i * 8 + (lane >> 3), ch = lane & 7; const u32x4 v = *(const LAS u32x4*)(stg + row * 128 + ch * 16); *(u32x4*)(Ow + (size_t)row * BW + ch * 8) = v; }
    LDS_WAIT();
}

__device__ __forceinline__ void sb_item(bf16_t* Q, const bf16_t* K, const bf16_t* V, int b, int h, int q0, LAS unsigned char* vst, int lane) {
    asm volatile("" : "+v"(lane));
    const int r32 = lane & 31, hi = lane >> 5;
    const size_t rowbase = (size_t)b * SEQ;
    bf16_t* Qw = Q + (rowbase + q0) * BW + h * HD;
    bf16x8 qr[4];
#pragma unroll
    for (int d0 = 0; d0 < 4; ++d0) qr[d0] = *(const bf16x8*)(Qw + (size_t)r32 * BW + d0 * 16 + hi * 8);
    const bf16_t* Kh = K + rowbase * BW + h * HD; const bf16_t* Vh = V + rowbase * BW + h * HD;
    f32x16 o0 = {}, o1 = {}; float A2 = 0.f;
    const int tq = q0 + r32;
    bf16x8 kf[8]; load_k(kf, Kh, ((q0 + 30) >> 6) * 64, r32, hi);
    for (int kt = (q0 + 30) >> 6; kt >= 0; --kt) {
        const int j0 = kt * 64;
        f32x16 p0 = {}, p1 = {};
        qk(p0, p1, kf, qr);
        asm volatile("" : "+v"(p0), "+v"(p1) :: "memory");
        u32x4 vv[8]; load_v(vv, Vh, j0, lane);
        if (kt > 0) load_k(kf, Kh, j0 - 64, r32, hi);
        const bool diag = (j0 + 63 >= q0);
        f32x16 l0, l1;
#pragma unroll
        for (int r = 0; r < 16; ++r) {
            { const float z = p0[r]; const float t = __builtin_amdgcn_exp2f(-__builtin_fabsf(z)); float l = -(__builtin_fmaxf(z, 0.f) + __builtin_amdgcn_logf(1.0f + t)); if (diag && (j0 + crow(r, hi) >= tq)) l = 0.f; l0[r] = l; }
            { const float z = p1[r]; const float t = __builtin_amdgcn_exp2f(-__builtin_fabsf(z)); float l = -(__builtin_fmaxf(z, 0.f) + __builtin_amdgcn_logf(1.0f + t)); if (diag && (j0 + 32 + crow(r, hi) >= tq)) l = 0.f; l1[r] = l; }
        }
        float carry = A2;
#pragma unroll
        for (int half = 1; half >= 0; --half) {
            f32x16& l = half ? l1 : l0; f32x16& p = half ? p1 : p0;
            float T[4];
#pragma unroll
            for (int g = 0; g < 4; ++g) { l[4 * g + 2] += l[4 * g + 3]; l[4 * g + 1] += l[4 * g + 2]; l[4 * g] += l[4 * g + 1]; T[g] = l[4 * g]; }
            float Tl[4], Th[4];
#pragma unroll
            for (int g = 0; g < 4; ++g) Tl[g] = swap_lo(T[g], Th[g]);
            float E = carry;
#pragma unroll
            for (int g = 3; g >= 0; --g) { const float eh = E; E += Th[g]; const float el = E; E += Tl[g]; const float off = hi ? eh : el;
                l[4 * g] += off; l[4 * g + 1] += off; l[4 * g + 2] += off; l[4 * g + 3] += off; }
            carry = E;
#pragma unroll
            for (int r = 0; r < 16; ++r) { float w = __builtin_amdgcn_exp2f(p[r] + l[r]); if (diag && (j0 + 32 * half + crow(r, hi) >= tq)) w = 0.f; p[r] = w; }
        }
        A2 = carry;
        stage_v(vst, vv, lane); LDS_WAIT();
        pv(o0, o1, p0, p1, vst, lane);
        LDS_WAIT();
        if (__all(A2 < -150.2f)) break;
    }
    float one[16];
#pragma unroll
    for (int r = 0; r < 16; ++r) one[r] = 1.0f;
    store_o(Qw, o0, o1, one, vst, lane);
}

constexpr float MOBA_THR = 8.0f;
__device__ __forceinline__ unsigned moba_gate(const bf16_t* Qw, int blk, const LAS float* km, int lane) {
    asm volatile("" : "+v"(lane));
    const int r32 = lane & 31, hi = lane >> 5;
    unsigned sel = 0u;
    if (blk > 0) {
        float qf[64];
        { const u32x4* qp = (const u32x4*)(Qw + (size_t)r32 * BW);
#pragma unroll
          for (int c = 0; c < 8; ++c) { const u32x4 x = qp[c]; qf[8 * c] = bf_lo(x.x); qf[8 * c + 1] = bf_hi(x.x); qf[8 * c + 2] = bf_lo(x.y); qf[8 * c + 3] = bf_hi(x.y); qf[8 * c + 4] = bf_lo(x.z); qf[8 * c + 5] = bf_hi(x.z); qf[8 * c + 6] = bf_lo(x.w); qf[8 * c + 7] = bf_hi(x.w); } }
        float v1 = -INFINITY, v2 = -INFINITY, v3 = -INFINITY; int i1 = -1, i2 = -1, i3 = -1;
#define TOP_INS(v, n) do { const bool b1 = (v) > v1 || ((v) == v1 && (n) < i1), b2 = (v) > v2 || ((v) == v2 && (n) < i2), b3 = (v) > v3 || ((v) == v3 && (n) < i3); \
            if (b3) { if (b2) { v3 = v2; i3 = i2; if (b1) { v2 = v1; i2 = i1; v1 = (v); i1 = (n); } else { v2 = (v); i2 = (n); } } else { v3 = (v); i3 = (n); } } } while (0)
#pragma unroll 1
        for (int i = 0; i < 16; ++i) { const int n = 16 * hi + i;
            const LAS f32x4* kr = (const LAS f32x4*)(km + n * 64); float d = 0.f;
#pragma unroll
            for (int c = 0; c < 16; ++c) { const f32x4 kk = kr[c]; d += qf[4 * c] * kk[0]; d += qf[4 * c + 1] * kk[1]; d += qf[4 * c + 2] * kk[2]; d += qf[4 * c + 3] * kk[3]; }
            if (n < blk) TOP_INS(d, n); }
        { float x0, x1; x0 = swap_lo(v1, x1); const float pv1 = hi ? x0 : x1; x0 = swap_lo(v2, x1); const float pv2 = hi ? x0 : x1; x0 = swap_lo(v3, x1); const float pv3 = hi ? x0 : x1;
          x0 = swap_lo(__int_as_float(i1), x1); const int pi1 = __float_as_int(hi ? x0 : x1); x0 = swap_lo(__int_as_float(i2), x1); const int pi2 = __float_as_int(hi ? x0 : x1); x0 = swap_lo(__int_as_float(i3), x1); const int pi3 = __float_as_int(hi ? x0 : x1);
          TOP_INS(pv1, pi1); TOP_INS(pv2, pi2); TOP_INS(pv3, pi3); }
#undef TOP_INS
        if (i1 >= 0) sel |= 1u << i1; if (i2 >= 0) sel |= 1u << i2; if (i3 >= 0) sel |= 1u << i3;
    }
    return sel;
}
__device__ __forceinline__ void moba_tile(f32x16& o0, f32x16& o1, float& mrow, float& lsum, const bf16x8 (&qr)[4], bf16x8 (&kf)[8], const bf16_t* Kh, const bf16_t* Vh, int j0, int jn, float lb, float sl2, bool diag, int tq,
                                          LAS unsigned char* vst, LAS float* wsf, int lane) {
    const int r32 = lane & 31, hi = lane >> 5;
    f32x16 p0, p1;
#pragma unroll
    for (int r = 0; r < 16; ++r) { p0[r] = lb; p1[r] = lb + 32.0f * sl2; }
    qk(p0, p1, kf, qr);
    asm volatile("" : "+v"(p0), "+v"(p1) :: "memory");
    u32x4 vv[8]; load_v(vv, Vh, j0, lane);
    if (jn >= 0) load_k(kf, Kh, jn, r32, hi);
#pragma unroll
    for (int r = 0; r < 16; ++r) { p0[r] = __builtin_fmaf(sl2, (float)crow(r, 0), p0[r]); p1[r] = __builtin_fmaf(sl2, (float)crow(r, 0), p1[r]); }
    if (diag) {
#pragma unroll
        for (int r = 0; r < 16; ++r) { if (j0 + crow(r, hi) > tq) p0[r] = -INFINITY; if (j0 + 32 + crow(r, hi) > tq) p1[r] = -INFINITY; }
    }
    float rm = __builtin_fmaxf(p0[0], p1[0]);
#pragma unroll
    for (int r = 1; r < 16; ++r) rm = __builtin_fmaxf(rm, __builtin_fmaxf(p0[r], p1[r]));
    { float x1; const float x0 = swap_lo(rm, x1); rm = __builtin_fmaxf(x0, x1); }
    if (__any(rm > mrow + MOBA_THR)) {
        const float mn = __builtin_fmaxf(mrow, rm); const float f = __builtin_amdgcn_exp2f(mrow - mn); mrow = mn; lsum *= f;
        if (hi == 0) wsf[r32] = f;
        LDS_WAIT();
#pragma unroll
        for (int r = 0; r < 16; ++r) { const float fr_ = wsf[crow(r, hi)]; o0[r] *= fr_; o1[r] *= fr_; }
        LDS_WAIT();
    }
    float ps = 0.f;
#pragma unroll
    for (int r = 0; r < 16; ++r) { p0[r] = __builtin_amdgcn_exp2f(p0[r] - mrow); p1[r] = __builtin_amdgcn_exp2f(p1[r] - mrow); ps += p0[r] + p1[r]; }
    lsum += ps;
    stage_v(vst, vv, lane); LDS_WAIT();
    pv(o0, o1, p0, p1, vst, lane);
    LDS_WAIT();
}
__device__ __forceinline__ void moba_item(const bf16_t* Q, const bf16_t* K, const bf16_t* V, int b, int h, int blk, int n, int tix, const LAS unsigned char* lists, const LAS unsigned* cnt,
                                          const LAS unsigned* selm, unsigned char* recO, float* recML, LAS unsigned char* vst, LAS float* wsf, LAS unsigned* trow, int lane) {
    asm volatile("" : "+v"(lane));
    const int r32 = lane & 31, hi = lane >> 5; const size_t rowbase = (size_t)b * SEQ; const bool own = (n == blk);
    int q; bool valid; unsigned slot;
    if (own) { q = 32 * tix + r32; valid = true; slot = (unsigned)q * 4u + 3u; }
    else { const int cn = (int)cnt[n]; const int p = 32 * tix + r32; valid = p < cn; q = (int)lists[n * 256 + (valid ? p : cn - 1)];
           slot = (unsigned)q * 4u + (unsigned)__builtin_popcount(selm[q] & ((1u << n) - 1u)); }
    if (hi == 0) trow[r32] = slot | (valid ? 0x80000000u : 0u);
    const int tq = blk * 256 + q;
    const bf16_t* Qrow = Q + (rowbase + tq) * BW + h * HD + hi * 8;
    bf16x8 qr[4];
#pragma unroll
    for (int d0 = 0; d0 < 4; ++d0) qr[d0] = *(const bf16x8*)(Qrow + d0 * 16);
    const bf16_t* Kh = K + rowbase * BW + h * HD; const bf16_t* Vh = V + rowbase * BW + h * HD;
    const float sl2 = __builtin_amdgcn_exp2f(-(float)(h + 1)) * LOG2E;
    f32x16 o0 = {}, o1 = {}; float mrow = -INFINITY, lsum = 0.f;
    const int ntile = own ? (tix >> 1) + 1 : 4;
    bf16x8 kf[8]; load_k(kf, Kh, n * 256, r32, hi);
#pragma unroll 1
    for (int i = 0; i < ntile; ++i) { const int j0 = n * 256 + i * 64;
        moba_tile(o0, o1, mrow, lsum, qr, kf, Kh, Vh, j0, i < ntile - 1 ? j0 + 64 : -1, sl2 * (float)(j0 + 4 * hi - tq), sl2, own && i == ntile - 1, tq, vst, wsf, lane); }
    { float x1; const float x0 = swap_lo(lsum, x1); lsum = x0 + x1; }
    if (hi == 0) { wsf[32 + r32] = lsum; if (valid) *(f32x2*)(recML + 2 * slot) = (f32x2){mrow, lsum}; }
    LDS_WAIT();
    LAS bf16_t* s = (LAS bf16_t*)vst;
#pragma unroll
    for (int r = 0; r < 16; ++r) { const int orow = crow(r, hi); const float rl = __builtin_amdgcn_rcpf(wsf[32 + orow]);
        s[orow * 64 + r32] = (bf16_t)(cvt_pk_bf16(o0[r] * rl, 0.f) & 0xffffu); s[orow * 64 + 32 + r32] = (bf16_t)(cvt_pk_bf16(o1[r] * rl, 0.f) & 0xffffu); }
    LDS_WAIT();
#pragma unroll
    for (int i = 0; i < 4; ++i) { const int row = i * 8 + (lane >> 3), ch = lane & 7; const unsigned tr = trow[row]; const u32x4 v = *(const LAS u32x4*)(vst + row * 128 + ch * 16);
        if (tr & 0x80000000u) *(u32x4*)(recO + (size_t)(tr & 0x7fffffffu) * 128 + ch * 16) = v; }
    LDS_WAIT();
}
__device__ __forceinline__ void moba_merge(bf16_t* Q, int b, int h, int blk, int w, const LAS unsigned* selm, const unsigned char* recO, const float* recML, LAS float* wsf, int lane) {
    asm volatile("" : "+v"(lane));
    const int r32 = lane & 31, hi = lane >> 5; const size_t rowbase = (size_t)b * SEQ; const int q0 = blk * 256 + w * 32;
    const int ql = w * 32 + r32; const int c = __builtin_popcount(selm[ql]);
    float mi[4], li[4]; float mx = -INFINITY;
#pragma unroll
    for (int k = 0; k < 4; ++k) { mi[k] = -INFINITY; li[k] = 0.f; if (k == 3 || k < c) { const f32x2 ml = __builtin_nontemporal_load((const f32x2*)(recML + 2 * ((unsigned)ql * 4u + k))); mi[k] = ml.x; li[k] = ml.y; } mx = __builtin_fmaxf(mx, mi[k]); }
    float wg[4], L = 0.f;
#pragma unroll
    for (int k = 0; k < 4; ++k) { wg[k] = (k == 3 || k < c) ? __builtin_amdgcn_exp2f(mi[k] - mx) * li[k] : 0.f; L += wg[k]; }
    const float rL = 1.0f / L;
    if (hi == 0) { wsf[r32] = wg[0] * rL; wsf[32 + r32] = wg[1] * rL; wsf[64 + r32] = wg[2] * rL; wsf[96 + r32] = wg[3] * rL; }
    LDS_WAIT();
    bf16_t* Qw = Q + (rowbase + q0) * BW + h * HD;
#pragma unroll
    for (int i = 0; i < 4; ++i) { const int row = i * 8 + (lane >> 3), ch = lane & 7; f32x4 v0 = {0.f, 0.f, 0.f, 0.f}, v1 = {0.f, 0.f, 0.f, 0.f};
        const unsigned rslot = (unsigned)(w * 32 + row) * 4u;
#pragma unroll
        for (int k = 0; k < 4; ++k) { const float ak = wsf[32 * k + row];
            if (ak != 0.f) { const u32x4 pw = __builtin_nontemporal_load((const u32x4*)(recO + (size_t)(rslot + k) * 128 + ch * 16));
                v0 += ak * (f32x4){bf_lo(pw.x), bf_hi(pw.x), bf_lo(pw.y), bf_hi(pw.y)}; v1 += ak * (f32x4){bf_lo(pw.z), bf_hi(pw.z), bf_lo(pw.w), bf_hi(pw.w)}; } }
        st_bf16x8(Qw + (size_t)row * BW + ch * 8, v0, v1); }
    LDS_WAIT();
}
}

#define XB_TMO      128
#define XB_XCNT(j)  (256  + 64 * (j))
#define XB_XSUB(j)  (1280 + 64 * (j))
#define XB_XGEN(j)  (2304 + 64 * (j))
#define XB_TOP      3328
#define XB_TOPGEN   3392
#define XCD_BAR_WORDS 3456
#define XB_SPIN_CAP (1u << 18)
__device__ __forceinline__ unsigned xb_ld(unsigned* p)              { return __hip_atomic_load(p, __ATOMIC_RELAXED, __HIP_MEMORY_SCOPE_AGENT); }
__device__ __forceinline__ unsigned xb_add(unsigned* p, unsigned v) { return __hip_atomic_fetch_add(p, v, __ATOMIC_RELAXED, __HIP_MEMORY_SCOPE_AGENT); }
__device__ __forceinline__ unsigned xb_xcc_id() { return (unsigned)__builtin_amdgcn_s_getreg((3 << 11) | 20) & 0xFu; }
#define XB_SPIN(cond, bar) do { unsigned _sp = 0; while (cond) { __builtin_amdgcn_s_sleep(1); \
    if ((++_sp & 255u) == 0u) { if (xb_ld(&(bar)[XB_TMO])) break; if (_sp > XB_SPIN_CAP) { atomicAdd(&(bar)[XB_TMO], 1u); break; } } } } while (0)
struct XcdBarrier { unsigned* bar; unsigned x; volatile LAS unsigned* st; };
__device__ __forceinline__ XcdBarrier xcd_barrier_post(unsigned* bar, volatile LAS unsigned* st) {
    XcdBarrier b; b.bar = bar; b.x = xb_xcc_id(); b.st = st;
    if (threadIdx.x == 0) (void)xb_add(&bar[XB_XCNT(b.x)], 1u);
    return b;
}
__device__ __forceinline__ void xcd_barrier_complete(unsigned* bar, unsigned x, unsigned& nloc, unsigned& nx) {
    const unsigned G = gridDim.x * gridDim.y * gridDim.z;
    unsigned sum, cnt, mine, sp = 0u;
    for (;;) {
        sum = 0u; cnt = 0u; mine = 0u;
#pragma unroll
        for (unsigned j = 0; j < 16; ++j) { const unsigned c = xb_ld(&bar[XB_XCNT(j)]); sum += c; cnt += (c > 0u) ? 1u : 0u; mine = (j == x) ? c : mine; }
        if (sum == G) break;
        __builtin_amdgcn_s_sleep(1);
        if ((++sp & 255u) == 0u) { if (xb_ld(&bar[XB_TMO])) break; if (sp > XB_SPIN_CAP) { atomicAdd(&bar[XB_TMO], 1u); break; } }
    }
    nloc = mine > 0u ? mine : 1u; nx = cnt > 0u ? cnt : 1u;
}
__device__ __forceinline__ void xcd_barrier(const XcdBarrier& b) {
    asm volatile("s_waitcnt vmcnt(0)" ::: "memory");
    __syncthreads();
    if (threadIdx.x == 0) {
        unsigned* bar = b.bar;
        __builtin_amdgcn_s_waitcnt(0);
        unsigned nloc = b.st[0], nx = b.st[1];
        if (nloc == 0u) { xcd_barrier_complete(bar, b.x, nloc, nx); b.st[0] = nloc; b.st[1] = nx; }
        const unsigned old = xb_add(&bar[XB_XSUB(b.x)], 1u);
        const unsigned gen = old / nloc;
        if (old + 1u == (gen + 1u) * nloc) {
            __builtin_amdgcn_fence(__ATOMIC_RELEASE, "agent");
            asm volatile("s_waitcnt vmcnt(0)" ::: "memory");
            const unsigned og = xb_add(&bar[XB_TOP], 1u);
            const unsigned tg = og / nx;
            if (og + 1u == (tg + 1u) * nx) xb_add(&bar[XB_TOPGEN], 1u);
            else XB_SPIN(xb_ld(&bar[XB_TOPGEN]) == tg, bar);
            __builtin_amdgcn_fence(__ATOMIC_ACQUIRE, "agent");
            xb_add(&bar[XB_XGEN(b.x)], 1u);
            asm volatile("s_waitcnt vmcnt(0)" ::: "memory");
        } else {
            XB_SPIN(xb_ld(&bar[XB_XGEN(b.x)]) == gen, bar);
            __builtin_amdgcn_fence(__ATOMIC_ACQUIRE, "agent");
            asm volatile("s_waitcnt vmcnt(0)" ::: "memory");
        }
    }
    __syncthreads();
}

__device__ __forceinline__ float wave_sum(float v) {
#pragma unroll
    for (int o = 1; o < 64; o <<= 1) v += __shfl_xor(v, o);
    return v;
}
struct TrD { const float* src; const float* gain; bf16_t* dst; int ldw, ldt; };
__device__ __forceinline__ void tr_load(const TrD& d, f32x4 (&v)[8], float (&g)[8], int lane) {
    const int c4 = lane & 7, r0 = lane >> 3;
#pragma unroll
    for (int i = 0; i < 8; ++i) { const int row = 8 * i + r0; v[i] = *(const GAS f32x4*)((const GAS float*)d.src + (size_t)row * d.ldw + 4 * c4); g[i] = d.gain ? ((const GAS float*)d.gain)[row] : 1.0f; }
}
__device__ __forceinline__ void tr_store(const TrD& d, const f32x4 (&v)[8], const float (&g)[8], LAS float* scr, int lane) {
    const int c4 = lane & 7, r0 = lane >> 3;
#pragma unroll
    for (int i = 0; i < 8; ++i) { LAS float* s = scr + (8 * i + r0) * 33 + 4 * c4; s[0] = v[i][0] * g[i]; s[1] = v[i][1] * g[i]; s[2] = v[i][2] * g[i]; s[3] = v[i][3] * g[i]; }
    LDS_WAIT(); asm volatile("" ::: "memory");
    const int c = lane & 7;
#pragma unroll
    for (int j = 0; j < 4; ++j) { const int n = (lane >> 3) + 8 * j; const LAS float* s = scr + (8 * c) * 33 + n;
        u32x4 o; o.x = cvt_pk_bf16(s[0 * 33], s[1 * 33]); o.y = cvt_pk_bf16(s[2 * 33], s[3 * 33]); o.z = cvt_pk_bf16(s[4 * 33], s[5 * 33]); o.w = cvt_pk_bf16(s[6 * 33], s[7 * 33]);
        *(GAS u32x4*)((GAS bf16_t*)d.dst + (size_t)n * d.ldt + 8 * c) = o; }
    LDS_WAIT(); asm volatile("" ::: "memory");
}
constexpr int I_IN = (DM / 64) * (NIN / 32), I_P = (BW / 64) * (DM / 32), I_O = (DM / 64) * (DM / 32), I_G = (DM / 64) * (DFF / 32), I_D = (DFF / 64) * (DM / 32);
constexpr int NITEMS = I_IN + 3 * I_P + I_O + 2 * I_G + I_D;
struct Args { const float* in[14]; float* out; unsigned char* ws; };
__device__ __forceinline__ void tr_decode(int it, TrD& d, const Args& A, int layer, unsigned char* ws) {
    int r = it;
    if (r < I_IN) { const int nblk = NIN / 32, kb = r / nblk, c0 = 32 * (r % nblk); size_t doff;
        if (c0 < 3072) doff = WS_WIN + (size_t)c0 * DM * 2;
        else if (c0 < 3584) doff = WS_WIN + (size_t)(3072 + 256 * ((c0 - 3072) >> 7) + ((c0 - 3072) & 127)) * DM * 2;
        else if (c0 < 4096) doff = WS_WIN + (size_t)(4096 + (c0 - 3584)) * DM * 2;
        else if (c0 < 4608) doff = WS_WIN + (size_t)(3072 + 256 * ((c0 - 4096) >> 7) + 128 + ((c0 - 4096) & 127)) * DM * 2;
        else doff = WS_WG + (size_t)(c0 - 4608) * DM * 2;
        d.src = A.in[2] + (size_t)layer * DM * NIN + (size_t)(64 * kb) * NIN + c0; d.gain = A.in[1] + (size_t)layer * DM + 64 * kb; d.dst = (bf16_t*)(ws + doff) + 64 * kb; d.ldw = NIN; d.ldt = DM; return; }
    r -= I_IN;
    if (r < I_P) { const int nblk = DM / 32, kb = r / nblk, c0 = 32 * (r % nblk);
        d.src = A.in[5] + (size_t)layer * BW * DM + (size_t)(64 * kb) * DM + c0; d.gain = nullptr; d.dst = (bf16_t*)(ws + WS_WP) + (size_t)c0 * BW + 64 * kb; d.ldw = DM; d.ldt = BW; return; }
    r -= I_P;
    if (r < I_P) { const int nblk = DM / 32, kb = r / nblk, c0 = 32 * (r % nblk);
        d.src = A.in[6] + (size_t)layer * BW * DM + (size_t)(64 * kb) * DM + c0; d.gain = nullptr; d.dst = (bf16_t*)(ws + WS_WP) + (size_t)DM * BW + (size_t)c0 * BW + 64 * kb; d.ldw = DM; d.ldt = BW; return; }
    r -= I_P;
    if (r < I_P) { const int nblk = DM / 32, kb = r / nblk, c0 = 32 * (r % nblk);
        d.src = A.in[7] + (size_t)layer * BW * DM + (size_t)(64 * kb) * DM + c0; d.gain = nullptr; d.dst = (bf16_t*)(ws + WS_WP) + (size_t)2 * DM * BW + (size_t)c0 * BW + 64 * kb; d.ldw = DM; d.ldt = BW; return; }
    r -= I_P;
    if (r < I_O) { const int nblk = DM / 32, kb = r / nblk, c0 = 32 * (r % nblk);
        d.src = A.in[8] + (size_t)layer * DM * DM + (size_t)(64 * kb) * DM + c0; d.gain = nullptr; d.dst = (bf16_t*)(ws + WS_WO) + (size_t)c0 * DM + 64 * kb; d.ldw = DM; d.ldt = DM; return; }
    r -= I_O;
    if (r < I_G) { const int nblk = DFF / 32, kb = r / nblk, c0 = 32 * (r % nblk);
        d.src = A.in[10] + (size_t)layer * DM * DFF + (size_t)(64 * kb) * DFF + c0; d.gain = A.in[9] + (size_t)layer * DM + 64 * kb; d.dst = (bf16_t*)(ws + WS_WGU) + (size_t)(256 * (c0 >> 7) + (c0 & 127)) * DM + 64 * kb; d.ldw = DFF; d.ldt = DM; return; }
    r -= I_G;
    if (r < I_G) { const int nblk = DFF / 32, kb = r / nblk, c0 = 32 * (r % nblk);
        d.src = A.in[11] + (size_t)layer * DM * DFF + (size_t)(64 * kb) * DFF + c0; d.gain = A.in[9] + (size_t)layer * DM + 64 * kb; d.dst = (bf16_t*)(ws + WS_WGU) + (size_t)(256 * (c0 >> 7) + 128 + (c0 & 127)) * DM + 64 * kb; d.ldw = DFF; d.ldt = DM; return; }
    r -= I_G;
    { const int nblk = DM / 32, kb = r / nblk, c0 = 32 * (r % nblk);
      d.src = A.in[12] + (size_t)layer * DFF * DM + (size_t)(64 * kb) * DM + c0; d.gain = nullptr; d.dst = (bf16_t*)(ws + WS_WD) + (size_t)c0 * DFF + 64 * kb; d.ldw = DM; d.ldt = DFF; }
}


__global__ void __launch_bounds__(NWAVES * 64, 2) hybrid_fwd(Args args) {
    extern __shared__ __attribute__((aligned(16))) unsigned char lds_raw[];
    LAS unsigned char* lds = (LAS unsigned char*)lds_raw;
    volatile LAS unsigned* MISC = (volatile LAS unsigned*)(lds + MISC_OFF);
    const int wave = __builtin_amdgcn_readfirstlane((int)threadIdx.x >> 6);
    const int G = gridDim.x, bx = blockIdx.x, vcu = (G % 8 == 0) ? (bx % 8) * (G / 8) + bx / 8 : bx;
    for (int i = threadIdx.x; i < (LDS_BYTES - LDSCTL_OFF) / 4; i += NWAVES * 64) ((LAS unsigned*)(lds + LDSCTL_OFF))[i] = 0u;
    __syncthreads();
    XcdBarrier bar = xcd_barrier_post((unsigned*)(args.ws + WS_CTL) + CW_BAR, MISC + 8);
    const int gw = vcu * NWAVES + wave, NGW = G * NWAVES;

    for (int pp = 0; pp < DEPTH * 7 + 1; ++pp) {
        const int layer = pp / 7, ph = pp - 7 * layer;
        int tid = threadIdx.x; asm volatile("" : "+v"(tid)); const int lane = tid & 63;
        size_t opq = 0; asm volatile("" : "+s"(opq));
        unsigned char* ws = args.ws + opq; const float* x_in = args.in[0] + opq; float* out = args.out + opq;
        float* ssA = (float*)(ws + WS_SSA); float* ssB = (float*)(ws + WS_SSB); float* kmp = (float*)(ws + WS_KM);
        bf16_t* xb = (bf16_t*)(ws + WS_XB);
        bf16_t* QA = (bf16_t*)(ws + WS_QA); bf16_t* KA = (bf16_t*)(ws + WS_KA); bf16_t* VA = (bf16_t*)(ws + WS_VA);
        bf16_t* QS = (bf16_t*)(ws + WS_QS); bf16_t* KS = (bf16_t*)(ws + WS_KS); bf16_t* VS = (bf16_t*)(ws + WS_VS);
        bf16_t* Ub = (bf16_t*)(ws + WS_U); bf16_t* BC = (bf16_t*)(ws + WS_BC); bf16_t* MG = (bf16_t*)(ws + WS_MG); bf16_t* ACT = (bf16_t*)(ws + WS_ACT);

        if (layer == DEPTH) {
            const float* gf = args.in[13];
            for (int m = gw; m < M; m += NGW) {
                const float rs = rstd_row(ssA, m);
                f32x4* xr = (f32x4*)(out + (size_t)m * DM) + lane; const f32x4* gr = (const f32x4*)gf + lane;
#pragma unroll
                for (int j = 0; j < 4; ++j) { const f32x4 v = xr[64 * j], g = gr[64 * j]; xr[64 * j] = v * rs * g; }
            }
            if (xb_ld((unsigned*)(ws + WS_CTL) + CW_BAR + XB_TMO) != 0u && bx == 0) { for (int i = tid; i < 4096; i += NWAVES * 64) out[i] = __builtin_nanf(""); }
            break;
        }
        if (ph == 0) {
            LAS float* scr = (LAS float*)(lds + RING_OFF + wave * 16384);
            for (int it = gw; it < NITEMS; it += NGW) { TrD dc; f32x4 vc[8]; float gc[8]; tr_decode(it, dc, args, layer, ws); tr_load(dc, vc, gc, lane); tr_store(dc, vc, gc, scr, lane); }
            if (layer == 0) {
                for (int m = gw; m < M; m += NGW) {
                    const f32x4* xr = (const f32x4*)(x_in + (size_t)m * DM) + lane; f32x4 v[4]; float s = 0.f;
#pragma unroll
                    for (int j = 0; j < 4; ++j) { v[j] = xr[64 * j]; s += (v[j].x * v[j].x + v[j].y * v[j].y) + (v[j].z * v[j].z + v[j].w * v[j].w); }
                    s = wave_sum(s);
                    u32x2* o8 = (u32x2*)(xb + (size_t)m * DM) + lane;
#pragma unroll
                    for (int j = 0; j < 4; ++j) o8[64 * j] = (u32x2){cvt_pk_bf16(v[j].x, v[j].y), cvt_pk_bf16(v[j].z, v[j].w)};
                    if (lane < 16) ssA[(size_t)m * 16 + lane] = (lane == 0) ? s : 0.f;
                }
            }
        } else if (ph == 2) {
            const int bh = vcu >> 4, s = vcu & 15, b = bh >> 3, h = bh & 7;
            LAS unsigned char* vst = lds + RING_OFF + wave * 8192;
            LAS float* wsf = (LAS float*)(lds + RING_OFF + 65536 + wave * 512);
            LAS float* km = (LAS float*)(lds + RING_OFF + 65536 + 4096);
            LAS unsigned* selm = (LAS unsigned*)(lds + RING_OFF + 77824);
            LAS unsigned* cnt = (LAS unsigned*)(lds + RING_OFF + 78848);
            LAS unsigned char* lists = lds + RING_OFF + 79872;
            LAS unsigned* trow = (LAS unsigned*)(lds + RING_OFF + 88064 + wave * 128);
            unsigned char* recO = ws + WS_MG + (size_t)vcu * 131072; float* recML = (float*)(ws + WS_X + (size_t)vcu * 8192);
            if (vcu < 256) {
                for (int k = 0; k < 2; ++k) {
                    const int blk = k == 0 ? 31 - s : s;
                    for (int i = tid; i < 2048; i += NWAVES * 64) { const int n = i >> 6, d = i & 63; const size_t o = (size_t)((b * 32 + n) * 2) * BW + h * HD + d; km[i] = kmp[o] + kmp[o + BW]; }
                    __syncthreads();
                    const unsigned sel = att::moba_gate(QA + ((size_t)b * SEQ + blk * 256 + wave * 32) * BW + h * HD, blk, km, lane);
                    if (lane < 32) selm[wave * 32 + lane] = sel;
                    __syncthreads();
                    for (int n = wave; n < blk; n += NWAVES) {
                        unsigned pos = 0;
#pragma unroll
                        for (int c = 0; c < 4; ++c) { const int q = 64 * c + lane; const bool bit = (selm[q] >> n) & 1u; const unsigned long long mk = __ballot(bit);
                            if (bit) lists[n * 256 + pos + __builtin_amdgcn_mbcnt_hi((unsigned)(mk >> 32), __builtin_amdgcn_mbcnt_lo((unsigned)mk, 0u))] = (unsigned char)q;
                            pos += (unsigned)__builtin_popcountll(mk); }
                        if (lane == 0) cnt[n] = pos;
                    }
                    __syncthreads();
                    { int id = wave, n = blk, t = wave;
                      int nn = 0, tt = 0, idp = 0;
                      for (;;) {
                          att::moba_item(QA, KA, VA, b, h, blk, n, t, lists, cnt, selm, recO, recML, vst, wsf, trow, lane);
                          bool found = false;
                          while (nn < blk) { const int nt_ = ((int)cnt[nn] + 31) >> 5;
                              if (tt < nt_) { const bool mine = (idp & (NWAVES - 1)) == wave; if (mine) { n = nn; t = tt; found = true; } ++tt; ++idp; if (mine) break; }
                              else { ++nn; tt = 0; } }
                          if (!found) break;
                      } (void)id; }
                    VM_WAIT();
                    __syncthreads();
                    att::moba_merge(QA, b, h, blk, wave, selm, recO, recML, wsf, lane);
                    __syncthreads();
                }
                for (int k = 0; k < 2; ++k) { const int blk = k == 0 ? 31 - s : s; att::sb_item(QS, KS, VS, b, h, blk * 256 + wave * 32, vst, lane); }
            }
            const float* cw = args.in[4] + (size_t)layer * 3 * BW;
            for (int i = vcu * (NWAVES * 64) + tid; i < M * (BW / 8); i += G * NWAVES * 64) {
                const int t = i >> 6, c = (i & 63) * 8; const int tt = t & (SEQ - 1);
                const u32x4 u2 = *(const u32x4*)(Ub + (size_t)t * BW + c);
                u32x4 u1 = {0u, 0u, 0u, 0u}, u0 = {0u, 0u, 0u, 0u};
                if (tt >= 1) u1 = *(const u32x4*)(Ub + (size_t)(t - 1) * BW + c);
                if (tt >= 2) u0 = *(const u32x4*)(Ub + (size_t)(t - 2) * BW + c);
                const u32x4 bw = *(const u32x4*)(BC + (size_t)t * BW + c);
                float y[8];
#pragma unroll
                for (int e = 0; e < 4; ++e) {
                    const float w0l = cw[c + 2 * e], w0h = cw[c + 2 * e + 1], w1l = cw[BW + c + 2 * e], w1h = cw[BW + c + 2 * e + 1], w2l = cw[2 * BW + c + 2 * e], w2h = cw[2 * BW + c + 2 * e + 1];
                    y[2 * e] = bf_lo(bw[e]) * (w0l * bf_lo(u0[e]) + w1l * bf_lo(u1[e]) + w2l * bf_lo(u2[e]));
                    y[2 * e + 1] = bf_hi(bw[e]) * (w0h * bf_hi(u0[e]) + w1h * bf_hi(u1[e]) + w2h * bf_hi(u2[e]));
                }
                *(u32x4*)(BC + (size_t)t * BW + c) = (u32x4){cvt_pk_bf16(y[0], y[1]), cvt_pk_bf16(y[2], y[3]), cvt_pk_bf16(y[4], y[5]), cvt_pk_bf16(y[6], y[7])};
            }
        } else {
            static_assert(WS_QS - WS_QA == 48 * MiB && WS_BC - WS_QS == 48 * MiB && WS_GB - WS_GA == 48 * MiB && WS_GC0 - WS_GB == 48 * MiB && WS_GC1 - WS_GC0 == 48 * MiB, "48 MiB spacing");
            GCfg c{};
            c.e0 = EpiIn{QA, Ub, BC, kmp, ssA};
            c.e1 = EpiC1{(bf16_t*)(ws + WS_GA), MG, args.in[3] + (size_t)layer * NGATE, ssA};
            c.e3 = EpiFfn{ACT, ssB};
            c.A2 = QA; c.B2 = (const bf16_t*)(ws + WS_WP); c.nseg = 1; c.lda = DM; c.ldb = DM; c.nt = DM / 64;
            if (ph == 1) { c.mode = 0; c.N = N1; c.A = xb; c.B = (const bf16_t*)(ws + WS_WIN); }
            else if (ph == 3) { c.mode = 1; c.N = DM; c.nseg = 6; c.A = xb; c.B = (const bf16_t*)(ws + WS_WG); }
            else if (ph == 4) { c.mode = 2; c.N = DM; c.A = MG; c.B = (const bf16_t*)(ws + WS_WO); c.e2 = EpiRes{layer == 0 ? x_in : (const float*)out, out, xb, ssB}; }
            else if (ph == 5) { c.mode = 3; c.N = NGU; c.A = xb; c.B = (const bf16_t*)(ws + WS_WGU); }
            else { c.mode = 2; c.N = DM; c.A = ACT; c.B = (const bf16_t*)(ws + WS_WD); c.lda = DFF; c.ldb = DFF; c.nt = DFF / 64; c.e2 = EpiRes{out, out, xb, ssA}; }
            ProbAny P{&c}; EpiAny E{&c}; pg8::StaticOrder S; S.init(M, c.N, G, bx, c.nseg);
            pg8::gemm_phase(lds + RING_OFF, P, S, E);
        }
        xcd_barrier(bar);
    }
}

extern "C" void kernel_launch(void* const* d_in, const int* in_sizes, int n_in, void* d_out, int out_size, void* d_ws, size_t ws_size, hipStream_t stream) {
    static int grid = 0;
    if (grid == 0) {
        if (n_in != 14 || in_sizes[0] != M * DM || out_size != M * DM || ws_size < WS_END) { fprintf(stderr, "kernel_launch: unexpected shapes (n_in %d, in0 %d, out %d, ws %zu)\n", n_in, n_in > 0 ? in_sizes[0] : -1, out_size, ws_size); grid = -1; return; }
        int dev = 0, cus = 0, per_cu = 0;
        if (hipGetDevice(&dev) != hipSuccess || hipDeviceGetAttribute(&cus, hipDeviceAttributeMultiprocessorCount, dev) != hipSuccess) { grid = -1; return; }
        if (hipFuncSetAttribute((const void*)hybrid_fwd, hipFuncAttributeMaxDynamicSharedMemorySize, LDS_BYTES) != hipSuccess) { fprintf(stderr, "kernel_launch: hipFuncSetAttribute failed\n"); grid = -1; return; }
        if (hipOccupancyMaxActiveBlocksPerMultiprocessor(&per_cu, (const void*)hybrid_fwd, NWAVES * 64, LDS_BYTES) != hipSuccess || per_cu < 1) { fprintf(stderr, "kernel_launch: occupancy query says %d blocks/CU\n", per_cu); (void)hipGetLastError(); per_cu = 1; }
        grid = cus;
    }
    if (grid < 0) return;
    if (hipMemsetAsync((char*)d_ws + WS_CTL, 0, CTL_ZERO_BYTES, stream) != hipSuccess) { fprintf(stderr, "kernel_launch: memset failed\n"); return; }
    Args a{};
    for (int i = 0; i < 14; ++i) a.in[i] = (const float*)d_in[i];
    a.out = (float*)d_out; a.ws = (unsigned char*)d_ws;
    void* kargs[] = {&a};
    hipError_t e = hipLaunchCooperativeKernel((const void*)hybrid_fwd, dim3(grid), dim3(NWAVES * 64), kargs, LDS_BYTES, stream);
    if (e != hipSuccess) fprintf(stderr, "kernel_launch: cooperative launch failed: %s (grid %d)\n", hipGetErrorString(e), grid);
}
```

```cpp
#include <hip/hip_runtime.h>
#include <hip/hip_bf16.h>
#include <cstdio>
#include <cstdint>

#define GAS __attribute__((address_space(1)))
#define LAS __attribute__((address_space(3)))
typedef unsigned short bf16_t;
typedef short bf16x8 __attribute__((ext_vector_type(8)));
typedef short s16x4 __attribute__((ext_vector_type(4)));
typedef float f32x2 __attribute__((ext_vector_type(2)));
typedef float f32x4 __attribute__((ext_vector_type(4)));
typedef float f32x16 __attribute__((ext_vector_type(16)));
typedef unsigned u32x2 __attribute__((ext_vector_type(2)));
typedef unsigned u32x4 __attribute__((ext_vector_type(4)));
typedef GAS unsigned gu32;

constexpr int BATCH = 2, SEQ = 8192, DM = 1024, M = BATCH * SEQ, NH = 8, HD = 64, BW = 512, DFF = 2816, DEPTH = 2;
constexpr int NIN = 7680, N1 = 4608, NGATE = 3072, NGU = 2 * DFF;
constexpr float RMS_EPS = 1e-6f;
constexpr float LOG2E = 1.4426950408889634f;
constexpr float C2 = 0.125f * LOG2E;
constexpr int NWAVES = 8;

constexpr size_t MiB = 1u << 20;
constexpr size_t WS_CTL = 0, CTL_ZERO_BYTES = 64 * 1024;
constexpr size_t WS_SSA = 1 * MiB, WS_SSB = 2 * MiB, WS_KM = 3 * MiB;
constexpr size_t WS_WIN = 4 * MiB, WS_WG = 13 * MiB, WS_WP = 19 * MiB, WS_WO = 22 * MiB, WS_WGU = 24 * MiB, WS_WD = 35 * MiB;
constexpr size_t WS_XB = 41 * MiB;
constexpr size_t WS_QA = 73 * MiB, WS_KA = 89 * MiB, WS_VA = 105 * MiB, WS_QS = 121 * MiB, WS_KS = 137 * MiB, WS_VS = 153 * MiB;
constexpr size_t WS_BC = 169 * MiB, WS_U = 185 * MiB, WS_MG = 201 * MiB, WS_X = 233 * MiB;
constexpr size_t WS_GA = WS_KA, WS_GB = WS_KS, WS_GC0 = WS_U, WS_GC1 = WS_X;
constexpr size_t WS_ACT = 73 * MiB;
constexpr size_t WS_END = 256 * MiB;
constexpr int CW_BAR = 4096;

constexpr int RING_OFF = 0, RING_BYTES = 131072;
constexpr int LDSCTL_OFF = RING_BYTES, MISC_OFF = LDSCTL_OFF + 320;
constexpr int LDS_BYTES = 147456;

#define LDS_WAIT() asm volatile("s_waitcnt lgkmcnt(0)" ::: "memory")
#define VM_WAIT() asm volatile("s_waitcnt vmcnt(0)" ::: "memory")
#define RLX_AGENT __ATOMIC_RELAXED, __HIP_MEMORY_SCOPE_AGENT

typedef __bf16 bf16x2_t __attribute__((ext_vector_type(2)));
__device__ __forceinline__ unsigned cvt_pk_bf16(float lo, float hi) { const f32x2 v = {lo, hi}; const bf16x2_t b = __builtin_convertvector(v, bf16x2_t); return __builtin_bit_cast(unsigned, b); }
__device__ __forceinline__ float bf_lo(unsigned w) { return __uint_as_float(w << 16); }
__device__ __forceinline__ float bf_hi(unsigned w) { return __uint_as_float(w & 0xffff0000u); }
__device__ __forceinline__ float rstd_row(const float* ssp, int row) {
    const f32x4 a = *(const f32x4*)(ssp + (size_t)row * 4);
    return rsqrtf(((a.x + a.y) + (a.z + a.w)) * (1.0f / DM) + RMS_EPS);
}

namespace pg8 {
constexpr int BM = 256, BK = 64, HALF = 128, HTB = HALF * BK * 2, STAGE_BYTES = 8 * HTB, NXCD = 8, WGM = 8;
__host__ __device__ __forceinline__ int lds_byte(int r, int c) { const int st = (r >> 4) * 2 + (c >> 5), rr = r & 15, cc = c & 31, ob = rr * 64 + cc * 2; return st * 1024 + (ob ^ (((ob >> 9) & 1) << 5)); }
__host__ __device__ __forceinline__ void stage_rc(int b, int& R, int& C) { const int st = b / 1024, sb = b % 1024, swz = sb ^ (((sb >> 9) & 1) << 5); R = (st >> 1) * 16 + swz / 64; C = (st & 1) * 32 + (swz % 64) / 2; }
__host__ __device__ __forceinline__ int perm32(int rho) { const int n = rho >> 4, i = rho & 15; return 8 * (i >> 2) + 4 * n + (i & 3); }

struct Unit { int pm, pn, seg; };
struct Seg { const char* A; const char* B; unsigned hA, hB; int lda, ldb, nt; };

struct StaticOrder {
    int nM, nN, nwg, G, c, nseg;
    __device__ void init(int M_, int N_, int G_, int c_, int nseg_) { nM = M_ / BM; nN = N_ / BM; nwg = nM * nN; G = G_; c = c_; nseg = nseg_; }
    __device__ bool next(int i, Unit& u) const {
        const int ti = (nseg == 1) ? i : i / nseg; u.seg = i - ti * nseg;
        const long L = (long)ti * G + c; if (L >= nwg) return false;
        int wgid = (int)L; { const int q = nwg / NXCD, r = nwg % NXCD, xcd = wgid % NXCD, off = wgid / NXCD; wgid = (xcd < r ? xcd * (q + 1) : r * (q + 1) + (xcd - r) * q) + off; }
        const int nig = WGM * nN, gid = wgid / nig, fm = gid * WGM, gsz = (nM - fm) < WGM ? (nM - fm) : WGM;
        u.pm = fm + ((wgid % nig) % gsz); u.pn = (wgid % nig) / gsz; return true;
    }
};

template <class Prob, class Epi, class Sched>
__device__ __forceinline__ void gemm_phase(LAS unsigned char* lds, const Prob& P, const Sched& S, const Epi& E) {
    int tid = threadIdx.x; asm volatile("" : "+v"(tid));
    const int wid = __builtin_amdgcn_readfirstlane(tid >> 6), lane = tid & 63, wr = wid >> 2, wc = wid & 3, fr = lane & 15, fq = lane >> 4;
    int R0, C0; stage_rc(tid * 16, R0, C0);
    const int Rb0 = (R0 & ~31) + perm32(R0 & 31);
    const size_t kstep = (size_t)(BK * 2);
    const unsigned ldsw = (unsigned)wid * 1024u;
    const int aoff = lds_byte(wr * 64 + fr, fq * 8), boff = lds_byte(wc * 32 + fr, fq * 8);
#define PG8_SA(b, h) (((b) * 2 + (h)) * HTB)
#define PG8_SB(b, h) ((4 + (b) * 2 + (h)) * HTB)
#define PG8_STAGE(bufoff, gbase, v0, q) do { \
        __builtin_amdgcn_global_load_lds((const unsigned*)((const char*)(gbase) + (v0)), (LAS unsigned*)(lds + (bufoff) + ldsw), 16, 0, 0); \
        __builtin_amdgcn_global_load_lds((const unsigned*)((const char*)(gbase) + (q) + (v0)), (LAS unsigned*)(lds + (bufoff) + ldsw + 8192), 16, 0, 0); } while (0)
#define PG8_LDA(dst, b, h) do { _Pragma("unroll") for (int m = 0; m < 4; ++m) _Pragma("unroll") for (int k = 0; k < 2; ++k) dst[m][k] = *(const LAS bf16x8*)(lds + PG8_SA(b, h) + aoff + m * 2048 + k * 1024); } while (0)
#define PG8_LDB(dst, b, h) do { _Pragma("unroll") for (int n = 0; n < 2; ++n) _Pragma("unroll") for (int k = 0; k < 2; ++k) dst[n][k] = *(const LAS bf16x8*)(lds + PG8_SB(b, h) + boff + n * 2048 + k * 1024); } while (0)
#define PG8_MMA(ai, bj, At, Bt) do { __builtin_amdgcn_s_setprio(1); _Pragma("unroll") for (int m = 0; m < 4; ++m) _Pragma("unroll") for (int n = 0; n < 2; ++n) _Pragma("unroll") for (int k = 0; k < 2; ++k) \
        acc[ai][bj][m][n] = __builtin_amdgcn_mfma_f32_16x16x32_bf16(Bt[n][k], At[m][k], acc[ai][bj][m][n], 0, 0, 0); __builtin_amdgcn_s_setprio(0); } while (0)
#define PG8_WAIT_V(n) asm volatile("s_waitcnt vmcnt(" #n ")" ::: "memory")
#define PG8_WAIT_L(n) asm volatile("s_waitcnt lgkmcnt(" #n ")" ::: "memory")
#define PG8_BAR __builtin_amdgcn_s_barrier()
#define PG8_SCHED __builtin_amdgcn_sched_barrier(0)
    Unit cur, nxt; int ui = 0;
    if (!S.next(0, cur)) return;
    Seg sc, sn; P.seg(cur, sc);
    unsigned vAc0 = (unsigned)(R0 * sc.lda + C0) * 2u, vBc0 = (unsigned)(Rb0 * sc.ldb + C0) * 2u;
    f32x4 acc[2][2][4][2];
#pragma unroll
    for (int a = 0; a < 2; ++a)
#pragma unroll
        for (int b = 0; b < 2; ++b)
#pragma unroll
            for (int m = 0; m < 4; ++m)
#pragma unroll
                for (int n = 0; n < 2; ++n) acc[a][b][m][n] = (f32x4){0.f, 0.f, 0.f, 0.f};
    bf16x8 At[4][2], B0[2][2], B1[2][2];
    const char* cA = sc.A; const char* cB = sc.B;
    PG8_STAGE(PG8_SB(0, 0), cB, vBc0, sc.hB >> 1); PG8_STAGE(PG8_SB(0, 1), cB + sc.hB, vBc0, sc.hB >> 1); PG8_STAGE(PG8_SA(0, 0), cA, vAc0, sc.hA >> 1); PG8_STAGE(PG8_SA(0, 1), cA + sc.hA, vAc0, sc.hA >> 1);
    if (wr == 1) PG8_BAR;
    PG8_WAIT_V(2); PG8_BAR;
    PG8_STAGE(PG8_SB(1, 0), cB + kstep, vBc0, sc.hB >> 1); PG8_STAGE(PG8_SA(1, 0), cA + kstep, vAc0, sc.hA >> 1); PG8_STAGE(PG8_SB(1, 1), cB + sc.hB + kstep, vBc0, sc.hB >> 1);
    PG8_WAIT_V(6); PG8_BAR;
    for (;;) {
        const bool has_next = S.next(ui + 1, nxt);
        if (has_next) P.seg(nxt, sn); else sn = sc;
        const unsigned vAn0 = (unsigned)(R0 * sn.lda + C0) * 2u, vBn0 = (unsigned)(Rb0 * sn.ldb + C0) * 2u;
        const char* nA = sn.A; const char* nB = sn.B;
        const int nt = sc.nt;
        for (int t = 0; t < nt; t += 2) {
            const bool last = (t == nt - 2);
            const char* a1 = cA + (size_t)(t + 1) * kstep;
            const char* a2 = last ? nA : cA + (size_t)(t + 2) * kstep; const char* b2 = last ? nB : cB + (size_t)(t + 2) * kstep;
            const char* a3 = a2 + kstep; const char* b3 = b2 + kstep;
            const unsigned hA2 = last ? sn.hA : sc.hA, hB2 = last ? sn.hB : sc.hB;
            const unsigned vA0 = last ? vAn0 : vAc0, vB0 = last ? vBn0 : vBc0, qA = hA2 >> 1, qB = hB2 >> 1;
            PG8_LDB(B0, 0, 0); PG8_LDB(B1, 0, 1); PG8_SCHED; PG8_LDA(At, 0, 0); PG8_STAGE(PG8_SA(1, 1), a1 + sc.hA, vAc0, sc.hA >> 1);
            PG8_WAIT_V(8); PG8_WAIT_L(0); PG8_BAR; PG8_MMA(0, 0, At, B0); PG8_MMA(0, 1, At, B1); PG8_BAR; PG8_SCHED;
            PG8_LDA(At, 0, 1); PG8_STAGE(PG8_SB(0, 0), b2, vB0, qB); PG8_STAGE(PG8_SB(0, 1), b2 + hB2, vB0, qB); PG8_STAGE(PG8_SA(0, 0), a2, vA0, qA);
            PG8_WAIT_V(8); PG8_WAIT_L(0); PG8_BAR; PG8_MMA(1, 0, At, B0); PG8_MMA(1, 1, At, B1); PG8_BAR; PG8_SCHED;
            PG8_LDB(B0, 1, 0); PG8_LDB(B1, 1, 1); PG8_SCHED; PG8_LDA(At, 1, 0); PG8_STAGE(PG8_SA(0, 1), a2 + hA2, vA0, qA);
            PG8_WAIT_V(8); PG8_WAIT_L(0); PG8_BAR; PG8_MMA(0, 0, At, B0); PG8_MMA(0, 1, At, B1); PG8_BAR; PG8_SCHED;
            PG8_LDA(At, 1, 1); PG8_STAGE(PG8_SB(1, 0), b3, vB0, qB); PG8_STAGE(PG8_SB(1, 1), b3 + hB2, vB0, qB); PG8_STAGE(PG8_SA(1, 0), a3, vA0, qA);
            PG8_WAIT_V(8); PG8_WAIT_L(0); PG8_BAR; PG8_MMA(1, 0, At, B0); PG8_MMA(1, 1, At, B1); PG8_BAR; PG8_SCHED;
        }
        if (wr == 0) PG8_BAR;
        E(acc, cur, wr, wc, fr, fq);
        if (!has_next) break;
#pragma unroll
        for (int a = 0; a < 2; ++a)
#pragma unroll
            for (int b = 0; b < 2; ++b)
#pragma unroll
                for (int m = 0; m < 4; ++m)
#pragma unroll
                    for (int n = 0; n < 2; ++n) acc[a][b][m][n] = (f32x4){0.f, 0.f, 0.f, 0.f};
        cur = nxt; sc = sn; cA = nA; cB = nB; vAc0 = vAn0; vBc0 = vBn0; ++ui;
        if (wr == 1) PG8_BAR;
    }
    PG8_WAIT_V(0);
    PG8_BAR;
#undef PG8_SA
#undef PG8_SB
#undef PG8_STAGE
#undef PG8_LDA
#undef PG8_LDB
#undef PG8_MMA
#undef PG8_WAIT_V
#undef PG8_WAIT_L
#undef PG8_BAR
#undef PG8_SCHED
}
}

#define EPI_ARGS const f32x4 (&acc)[2][2][4][2], const pg8::Unit& u, int wr, int wc, int fr, int fq
__device__ __forceinline__ void st_bf16x8(bf16_t* p, f32x4 v0, f32x4 v1) {
    u32x4 w; w.x = cvt_pk_bf16(v0[0], v0[1]); w.y = cvt_pk_bf16(v0[2], v0[3]); w.z = cvt_pk_bf16(v1[0], v1[1]); w.w = cvt_pk_bf16(v1[2], v1[3]);
    *(u32x4*)p = w;
}
template <class T> __device__ __forceinline__ T* bo(T* base, unsigned byte_off) { return (T*)((char*)base + byte_off); }
template <class T> __device__ __forceinline__ const T* bo(const T* base, unsigned byte_off) { return (const T*)((const char*)base + byte_off); }
__device__ __forceinline__ void ld_bf16x8(const bf16_t* p, f32x4& v0, f32x4& v1) {
    const unsigned long long lo = __hip_atomic_load((const unsigned long long*)p, __ATOMIC_RELAXED, __HIP_MEMORY_SCOPE_AGENT), hi = __hip_atomic_load((const unsigned long long*)p + 1, __ATOMIC_RELAXED, __HIP_MEMORY_SCOPE_AGENT);
    const u32x4 w = {(unsigned)lo, (unsigned)(lo >> 32), (unsigned)hi, (unsigned)(hi >> 32)};
    v0 = (f32x4){bf_lo(w.x), bf_hi(w.x), bf_lo(w.y), bf_hi(w.y)}; v1 = (f32x4){bf_lo(w.z), bf_hi(w.z), bf_lo(w.w), bf_hi(w.w)};
}
__device__ __forceinline__ float rstd4(f32x4 a) { return rsqrtf(((a.x + a.y) + (a.z + a.w)) * (1.0f / DM) + RMS_EPS); }
__device__ __forceinline__ void rstd8(float (&rs)[2][4], const float* ss, int pm, unsigned lrow) {
    const float* ssb = ss + (size_t)pm * 256 * 4; unsigned lsb = lrow * 16u; asm volatile("" : "+v"(lsb));
    f32x4 t[2][4];
#pragma unroll
    for (int ai = 0; ai < 2; ++ai)
#pragma unroll
        for (int m = 0; m < 4; ++m) t[ai][m] = *(const f32x4*)bo(ssb, lsb + (unsigned)(ai * 128 + m * 16) * 16u);
#pragma unroll
    for (int ai = 0; ai < 2; ++ai)
#pragma unroll
        for (int m = 0; m < 4; ++m) rs[ai][m] = rstd4(t[ai][m]);
}
struct EpiIn {
    bf16_t* qkv; bf16_t* ub; bf16_t* bc; float* kmp; const float* ss;
    __device__ __forceinline__ void operator()(EPI_ARGS) const {
        const int pn = u.pn; const unsigned lrow = (unsigned)(wr * 64 + fr), lcol = (unsigned)(wc * 32 + 8 * fq);
        unsigned lb = (lrow * BW + lcol) * 2u; asm volatile("" : "+v"(lb));
        float rs[2][4]; rstd8(rs, ss, u.pm, lrow);
        if (pn < 12 || pn >= 16) {
            const int t = pn >> 1; const float sc = (t == 0 || t == 3) ? C2 : 1.0f;
            bf16_t* base = (pn < 12 ? qkv + (size_t)t * M * BW + (pn & 1) * 256 : bc + (pn - 16) * 256) + (size_t)u.pm * 256 * BW;
            if (t == 1) {
                float* kp = kmp + (size_t)(u.pm * 2 + wr) * BW + (pn & 1) * 256;
#pragma unroll
                for (int bj = 0; bj < 2; ++bj)
#pragma unroll
                    for (int n = 0; n < 2; ++n) { f32x4 s = {0.f, 0.f, 0.f, 0.f};
#pragma unroll
                        for (int ai = 0; ai < 2; ++ai)
#pragma unroll
                            for (int m = 0; m < 4; ++m) s += acc[ai][bj][m][n] * rs[ai][m];
#pragma unroll
                        for (int o = 1; o < 16; o <<= 1) { s[0] += __shfl_xor(s[0], o); s[1] += __shfl_xor(s[1], o); s[2] += __shfl_xor(s[2], o); s[3] += __shfl_xor(s[3], o); }
                        if (fr == 0) *(f32x4*)bo(kp, (lcol + (unsigned)(bj * 128 + 4 * n)) * 4u) = s; }
            }
#pragma unroll
            for (int ai = 0; ai < 2; ++ai)
#pragma unroll
                for (int m = 0; m < 4; ++m) { const float f = rs[ai][m] * sc; const unsigned o = lb + (unsigned)(ai * 128 + m * 16) * BW * 2u;
#pragma unroll
                    for (int bj = 0; bj < 2; ++bj) st_bf16x8(bo(base, o + bj * 256u), acc[ai][bj][m][0] * f, acc[ai][bj][m][1] * f); }
        } else {
            bf16_t* base = ub + (size_t)u.pm * 256 * BW + (pn - 12) * 128;
#pragma unroll
            for (int ai = 0; ai < 2; ++ai)
#pragma unroll
                for (int m = 0; m < 4; ++m) { const float f = rs[ai][m] * rs[ai][m];
                    st_bf16x8(bo(base, lb + (unsigned)(ai * 128 + m * 16) * BW * 2u), acc[ai][0][m][0] * acc[ai][1][m][0] * f, acc[ai][0][m][1] * acc[ai][1][m][1] * f); }
        }
    }
};
struct EpiC1 {
    bf16_t* g0; bf16_t* mg; const float* bgate; const float* ss;
    __device__ __forceinline__ bf16_t* gtile(int s, int pm, int pn) const {
        const size_t off = (size_t)s * (48 * MiB) + ((s == 2 && pm >= 32) ? 32 * MiB : 0) + ((size_t)pm * 256 * DM + pn * 256) * 2;
        return (bf16_t*)((char*)g0 + off);
    }
    __device__ __forceinline__ void operator()(EPI_ARGS) const {
        const int sg = u.seg; const unsigned lrow = (unsigned)(wr * 64 + fr), lcol = (unsigned)(wc * 32 + 8 * fq); unsigned lb = (lrow * DM + lcol) * 2u;
        asm volatile("" : "+v"(lb));
        bf16_t* gp = gtile(sg < 3 ? sg : sg - 3, u.pm, u.pn);
        if (sg < 3) {
            const float* bg = bgate + sg * DM + u.pn * 256;
            f32x4 bv[2][2];
#pragma unroll
            for (int bj = 0; bj < 2; ++bj) { bv[bj][0] = *(const f32x4*)bo(bg, (lcol + bj * 128u) * 4u) * (-LOG2E); bv[bj][1] = *(const f32x4*)bo(bg, (lcol + bj * 128u + 4u) * 4u) * (-LOG2E); }
            float rs[2][4]; rstd8(rs, ss, u.pm, lrow);
#pragma unroll
            for (int ai = 0; ai < 2; ++ai)
#pragma unroll
                for (int m = 0; m < 4; ++m) { const float rn = rs[ai][m] * (-LOG2E); const unsigned o = lb + (unsigned)(ai * 128 + m * 16) * DM * 2u;
#pragma unroll
                    for (int bj = 0; bj < 2; ++bj) { f32x4 v[2];
#pragma unroll
                        for (int n = 0; n < 2; ++n) { const f32x4 x = acc[ai][bj][m][n] * rn + bv[bj][n];
#pragma unroll
                            for (int e = 0; e < 4; ++e) v[n][e] = __builtin_amdgcn_rcpf(1.0f + __builtin_amdgcn_exp2f(x[e])); }
                        st_bf16x8(bo(gp, o + bj * 256u), v[0], v[1]); } }
        } else {
            bf16_t* mp = mg + (size_t)u.pm * 256 * DM + u.pn * 256;
#pragma unroll
            for (int am = 0; am < 4; ++am) {
                const int ai = am >> 1, m0 = (am & 1) * 2;
                u32x4 gw_[2][2], pw_[2][2];
#pragma unroll
                for (int mm = 0; mm < 2; ++mm)
#pragma unroll
                    for (int bj = 0; bj < 2; ++bj) { const unsigned o = lb + (unsigned)(ai * 128 + (m0 + mm) * 16) * DM * 2u + bj * 256u;
                        gw_[mm][bj] = *(const u32x4*)bo((const bf16_t*)gp, o); if (sg > 3) pw_[mm][bj] = *(const u32x4*)bo((const bf16_t*)mp, o); }
#pragma unroll
                for (int mm = 0; mm < 2; ++mm)
#pragma unroll
                    for (int bj = 0; bj < 2; ++bj) { const int m = m0 + mm; const unsigned o = lb + (unsigned)(ai * 128 + m * 16) * DM * 2u + bj * 256u; const u32x4 g = gw_[mm][bj];
                        f32x4 v0 = acc[ai][bj][m][0] * (f32x4){bf_lo(g.x), bf_hi(g.x), bf_lo(g.y), bf_hi(g.y)}, v1 = acc[ai][bj][m][1] * (f32x4){bf_lo(g.z), bf_hi(g.z), bf_lo(g.w), bf_hi(g.w)};
                        if (sg > 3) { const u32x4 p = pw_[mm][bj]; v0 += (f32x4){bf_lo(p.x), bf_hi(p.x), bf_lo(p.y), bf_hi(p.y)}; v1 += (f32x4){bf_lo(p.z), bf_hi(p.z), bf_lo(p.w), bf_hi(p.w)}; }
                        st_bf16x8(bo(mp, o), v0, v1); }
                asm volatile("" ::: "memory");
            }
        }
    }
};
struct EpiRes {
    const float* base; float* out; bf16_t* xb; float* sso; LAS float* red;
    __device__ __forceinline__ void operator()(EPI_ARGS) const {
        const unsigned lrow = (unsigned)(wr * 64 + fr); unsigned le = lrow * DM + (unsigned)(wc * 32 + 8 * fq);
        asm volatile("" : "+v"(le));
        const size_t torg = (size_t)u.pm * 256 * DM + u.pn * 256;
        const float* bp = base + torg; float* op = out + torg; bf16_t* xp = xb + torg;
#pragma unroll
        for (int am = 0; am < 4; ++am) {
            const int ai = am >> 1, m0 = (am & 1) * 2;
            f32x4 bs[2][2][2];
#pragma unroll
            for (int mm = 0; mm < 2; ++mm)
#pragma unroll
                for (int bj = 0; bj < 2; ++bj) { const unsigned ob = (le + (unsigned)(ai * 128 + (m0 + mm) * 16) * DM + bj * 128u) * 4u; bs[mm][bj][0] = *(const f32x4*)bo(bp, ob); bs[mm][bj][1] = *(const f32x4*)bo(bp, ob + 16u); }
#pragma unroll
            for (int mm = 0; mm < 2; ++mm) { const int m = m0 + mm; float sq = 0.f;
#pragma unroll
                for (int bj = 0; bj < 2; ++bj) { const unsigned ob = (le + (unsigned)(ai * 128 + m * 16) * DM + bj * 128u) * 4u;
                    const f32x4 x0 = bs[mm][bj][0] + acc[ai][bj][m][0], x1 = bs[mm][bj][1] + acc[ai][bj][m][1];
                    *(f32x4*)bo(op, ob) = x0; *(f32x4*)bo(op, ob + 16u) = x1; st_bf16x8(bo(xp, ob >> 1), x0, x1);
                    sq += (x0[0] * x0[0] + x0[1] * x0[1]) + (x0[2] * x0[2] + x0[3] * x0[3]) + (x1[0] * x1[0] + x1[1] * x1[1]) + (x1[2] * x1[2] + x1[3] * x1[3]); }
                sq += __shfl_xor(sq, 16); sq += __shfl_xor(sq, 32);
                if (fq == 0) red[(lrow + (unsigned)(ai * 128 + m * 16)) * 4u + wc] = sq; }
            asm volatile("" ::: "memory");
        }
        asm volatile("s_waitcnt lgkmcnt(0)\n\ts_barrier" ::: "memory");
        { const int t = (int)threadIdx.x; if (t < 256) { const f32x4 r = *(const LAS f32x4*)(red + t * 4); sso[((size_t)u.pm * 256 + t) * 4 + u.pn] = (r.x + r.y) + (r.z + r.w); } }
        asm volatile("s_waitcnt lgkmcnt(0)\n\ts_barrier" ::: "memory");
    }
};
struct EpiFfn {
    bf16_t* act; const float* ss;
    __device__ __forceinline__ void operator()(EPI_ARGS) const {
        const unsigned lrow = (unsigned)(wr * 64 + fr); unsigned lb = (lrow * DFF + (unsigned)(wc * 32 + 8 * fq)) * 2u;
        asm volatile("" : "+v"(lb));
        bf16_t* ap = act + (size_t)u.pm * 256 * DFF + u.pn * 128;
        float rs[2][4]; rstd8(rs, ss, u.pm, lrow);
#pragma unroll
        for (int ai = 0; ai < 2; ++ai)
#pragma unroll
            for (int m = 0; m < 4; ++m) { const float r1 = rs[ai][m], rn = r1 * (-LOG2E); f32x4 v[2];
#pragma unroll
                for (int n = 0; n < 2; ++n) { const f32x4 g = acc[ai][0][m][n], up = acc[ai][1][m][n] * (r1 * r1);
#pragma unroll
                    for (int e = 0; e < 4; ++e) v[n][e] = g[e] * up[e] * __builtin_amdgcn_rcpf(1.0f + __builtin_amdgcn_exp2f(g[e] * rn)); }
                st_bf16x8(bo(ap, lb + (unsigned)(ai * 128 + m * 16) * DFF * 2u), v[0], v[1]); }
    }
};

struct GCfg {
    int mode;
    int N, nseg;
    const bf16_t* A; const bf16_t* B; int lda, ldb, nt;
    const bf16_t* A2; const bf16_t* B2;
    EpiIn e0; EpiC1 e1; EpiRes e2; EpiFfn e3;
};
struct ProbAny {
    const GCfg* c;
    __device__ __forceinline__ void seg(const pg8::Unit& u, pg8::Seg& s) const {
        if (c->mode == 1 && u.seg >= 3) {
            const int br = u.seg - 3; const bf16_t* O = (const bf16_t*)((const char*)c->A2 + (size_t)br * (48 * MiB));
            s.A = (const char*)(O + (size_t)u.pm * 256 * BW); s.B = (const char*)(c->B2 + ((size_t)br * DM + (size_t)u.pn * 256) * BW);
            s.hA = 128u * BW * 2u; s.hB = 128u * BW * 2u; s.lda = BW; s.ldb = BW; s.nt = BW / 64;
        } else {
            const int so = (c->mode == 1) ? u.seg * DM : 0;
            s.A = (const char*)(c->A + (size_t)u.pm * 256 * c->lda); s.B = (const char*)(c->B + ((size_t)so + (size_t)u.pn * 256) * c->ldb);
            s.hA = 128u * (unsigned)c->lda * 2u; s.hB = 128u * (unsigned)c->ldb * 2u; s.lda = c->lda; s.ldb = c->ldb; s.nt = c->nt;
        }
    }
};
struct EpiAny {
    const GCfg* c;
    __device__ __forceinline__ void operator()(EPI_ARGS) const {
        const int m_ = c->mode;
        if (m_ == 0) c->e0(acc, u, wr, wc, fr, fq);
        else if (m_ == 1) c->e1(acc, u, wr, wc, fr, fq);
        else if (m_ == 2) c->e2(acc, u, wr, wc, fr, fq);
        else c->e3(acc, u, wr, wc, fr, fq);
    }
};

namespace att {
__device__ __forceinline__ constexpr int crow(int r, int hi) { return (r & 3) + 8 * (r >> 2) + 4 * hi; }
__device__ __forceinline__ float swap_lo(float x, float& hiv) { auto rr = __builtin_amdgcn_permlane32_swap(__float_as_uint(x), __float_as_uint(x), false, false); hiv = __uint_as_float(rr[1]); return __uint_as_float(rr[0]); }
__device__ __forceinline__ s16x4 vtr(const LAS unsigned char* p) { return __builtin_bit_cast(s16x4, __builtin_amdgcn_ds_read_tr16_b64_v4i16((LAS s16x4*)p)); }
__device__ __forceinline__ void load_k(bf16x8 (&kf)[8], const bf16_t* Kh, int j0, int r32, int hi) {
    const bf16_t* p = Kh + (size_t)(j0 + r32) * BW + hi * 8;
#pragma unroll
    for (int d0 = 0; d0 < 4; ++d0) { kf[2 * d0] = *(const bf16x8*)(p + d0 * 16); kf[2 * d0 + 1] = *(const bf16x8*)(p + (size_t)32 * BW + d0 * 16); }
}
__device__ __forceinline__ void load_v(u32x4 (&vv)[8], const bf16_t* Vh, int j0, int lane) {
    const bf16_t* p = Vh + (size_t)(j0 + (lane >> 3)) * BW + (lane & 7) * 8;
#pragma unroll
    for (int i = 0; i < 8; ++i) vv[i] = *(const u32x4*)(p + (size_t)(8 * i) * BW);
}
__device__ __forceinline__ void stage_v(LAS unsigned char* vst, const u32x4 (&vv)[8], int lane) {
    const int c = lane & 7;
#pragma unroll
    for (int i = 0; i < 8; ++i) { const int key = 8 * i + (lane >> 3);
        *(LAS u32x4*)(vst + ((c >> 2) * 4 + (key >> 4)) * 1024 + (key & 15) * 64 + (c & 3) * 16) = vv[i]; }
}
__device__ __forceinline__ void qk(f32x16& p0, f32x16& p1, const bf16x8 (&kf)[8], const bf16x8 (&qr)[4]) {
#pragma unroll
    for (int d0 = 0; d0 < 4; ++d0) { p0 = __builtin_amdgcn_mfma_f32_32x32x16_bf16(kf[2 * d0], qr[d0], p0, 0, 0, 0); p1 = __builtin_amdgcn_mfma_f32_32x32x16_bf16(kf[2 * d0 + 1], qr[d0], p1, 0, 0, 0); }
}
__device__ __forceinline__ void pv(f32x16& o0, f32x16& o1, const f32x16& p0, const f32x16& p1, const LAS unsigned char* vst, int lane) {
    const int hi = lane >> 5;
    const LAS unsigned char* vp = vst + ((lane >> 4) & 1) * 32 + (lane & 3) * 8 + (4 * hi + ((lane & 15) >> 2)) * 64;
    u32x4 pw[4];
    pw[0] = (u32x4){cvt_pk_bf16(p0[0], p0[1]), cvt_pk_bf16(p0[2], p0[3]), cvt_pk_bf16(p0[4], p0[5]), cvt_pk_bf16(p0[6], p0[7])};
    pw[1] = (u32x4){cvt_pk_bf16(p0[8], p0[9]), cvt_pk_bf16(p0[10], p0[11]), cvt_pk_bf16(p0[12], p0[13]), cvt_pk_bf16(p0[14], p0[15])};
    pw[2] = (u32x4){cvt_pk_bf16(p1[0], p1[1]), cvt_pk_bf16(p1[2], p1[3]), cvt_pk_bf16(p1[4], p1[5]), cvt_pk_bf16(p1[6], p1[7])};
    pw[3] = (u32x4){cvt_pk_bf16(p1[8], p1[9]), cvt_pk_bf16(p1[10], p1[11]), cvt_pk_bf16(p1[12], p1[13]), cvt_pk_bf16(p1[14], p1[15])};
#pragma unroll
    for (int ks = 0; ks < 4; ++ks) {
        const s16x4 a0 = vtr(vp + ks * 1024), a1 = vtr(vp + ks * 1024 + 512), b0 = vtr(vp + 4096 + ks * 1024), b1 = vtr(vp + 4096 + ks * 1024 + 512);
        const bf16x8 v0 = {a0[0], a0[1], a0[2], a0[3], a1[0], a1[1], a1[2], a1[3]}, v1 = {b0[0], b0[1], b0[2], b0[3], b1[0], b1[1], b1[2], b1[3]};
        const bf16x8 pa = __builtin_bit_cast(bf16x8, pw[ks]);
        o0 = __builtin_amdgcn_mfma_f32_32x32x16_bf16(pa, v0, o0, 0, 0, 0);
        o1 = __builtin_amdgcn_mfma_f32_32x32x16_bf16(pa, v1, o1, 0, 0, 0);
    }
}
__device__ __forceinline__ void store_o(bf16_t* Ow, const f32x16& o0, const f32x16& o1, const float (&rsc)[16], LAS unsigned char* stg, int lane) {
    const int r32 = lane & 31, hi = lane >> 5;
    LAS bf16_t* s = (LAS bf16_t*)stg;
#pragma unroll
    for (int r = 0; r < 16; ++r) { const int orow = crow(r, hi);
        s[orow * 64 + r32] = (bf16_t)(cvt_pk_bf16(o0[r] * rsc[r], 0.f) & 0xffffu); s[orow * 64 + 32 + r32] = (bf16_t)(cvt_pk_bf16(o1[r] * rsc[r], 0.f) & 0xffffu); }
    LDS_WAIT();
#pragma unroll
    for (int i = 0; i < 4; ++i) { const int row = i * 8 + (lane >> 3), ch = lane & 7; const u32x4 v = *(const LAS u32x4*)(stg + row * 128 + ch * 16); *(u32x4*)(Ow + (size_t)row * BW + ch * 8) = v; }
    LDS_WAIT();
}

__device__ __forceinline__ void sb_item(bf16_t* Q, const bf16_t* K, const bf16_t* V, int b, int h, int q0, LAS unsigned char* vst, int lane) {
    asm volatile("" : "+v"(lane));
    const int r32 = lane & 31, hi = lane >> 5;
    const size_t rowbase = (size_t)b * SEQ;
    bf16_t* Qw = Q + (rowbase + q0) * BW + h * HD;
    bf16x8 qr[4];
#pragma unroll
    for (int d0 = 0; d0 < 4; ++d0) qr[d0] = *(const bf16x8*)(Qw + (size_t)r32 * BW + d0 * 16 + hi * 8);
    const bf16_t* Kh = K + rowbase * BW + h * HD; const bf16_t* Vh = V + rowbase * BW + h * HD;
    f32x16 o0 = {}, o1 = {}; float A2 = 0.f;
    const int tq = q0 + r32;
    bf16x8 kf[8]; load_k(kf, Kh, ((q0 + 30) >> 6) * 64, r32, hi);
    for (int kt = (q0 + 30) >> 6; kt >= 0; --kt) {
        const int j0 = kt * 64;
        f32x16 p0 = {}, p1 = {};
        qk(p0, p1, kf, qr);
        asm volatile("" : "+v"(p0), "+v"(p1) :: "memory");
        u32x4 vv[8]; load_v(vv, Vh, j0, lane);
        if (kt > 0) load_k(kf, Kh, j0 - 64, r32, hi);
        const bool diag = (j0 + 63 >= q0);
        f32x16 l0, l1;
#pragma unroll
        for (int r = 0; r < 16; ++r) {
            { const float z = p0[r]; const float t = __builtin_amdgcn_exp2f(-__builtin_fabsf(z)); float l = -(__builtin_fmaxf(z, 0.f) + __builtin_amdgcn_logf(1.0f + t)); if (diag && (j0 + crow(r, hi) >= tq)) l = 0.f; l0[r] = l; }
            { const float z = p1[r]; const float t = __builtin_amdgcn_exp2f(-__builtin_fabsf(z)); float l = -(__builtin_fmaxf(z, 0.f) + __builtin_amdgcn_logf(1.0f + t)); if (diag && (j0 + 32 + crow(r, hi) >= tq)) l = 0.f; l1[r] = l; }
        }
        float carry = A2;
#pragma unroll
        for (int half = 1; half >= 0; --half) {
            f32x16& l = half ? l1 : l0; f32x16& p = half ? p1 : p0;
            float T[4];
#pragma unroll
            for (int g = 0; g < 4; ++g) { l[4 * g + 2] += l[4 * g + 3]; l[4 * g + 1] += l[4 * g + 2]; l[4 * g] += l[4 * g + 1]; T[g] = l[4 * g]; }
            float Tl[4], Th[4];
#pragma unroll
            for (int g = 0; g < 4; ++g) Tl[g] = swap_lo(T[g], Th[g]);
            float E = carry;
#pragma unroll
            for (int g = 3; g >= 0; --g) { const float eh = E; E += Th[g]; const float el = E; E += Tl[g]; const float off = hi ? eh : el;
                l[4 * g] += off; l[4 * g + 1] += off; l[4 * g + 2] += off; l[4 * g + 3] += off; }
            carry = E;
#pragma unroll
            for (int r = 0; r < 16; ++r) { float w = __builtin_amdgcn_exp2f(p[r] + l[r]); if (diag && (j0 + 32 * half + crow(r, hi) >= tq)) w = 0.f; p[r] = w; }
        }
        A2 = carry;
        stage_v(vst, vv, lane); LDS_WAIT();
        pv(o0, o1, p0, p1, vst, lane);
        LDS_WAIT();
        if (__all(A2 < -150.2f)) break;
    }
    float one[16];
#pragma unroll
    for (int r = 0; r < 16; ++r) one[r] = 1.0f;
    store_o(Qw, o0, o1, one, vst, lane);
}

constexpr float MOBA_THR = 8.0f;
__device__ __forceinline__ unsigned moba_gate(const bf16_t* Qw, int blk, const LAS float* km, int lane) {
    asm volatile("" : "+v"(lane));
    const int r32 = lane & 31, hi = lane >> 5;
    unsigned sel = 0u;
    if (blk > 0) {
        float qf[64];
        { const u32x4* qp = (const u32x4*)(Qw + (size_t)r32 * BW);
#pragma unroll
          for (int c = 0; c < 8; ++c) { const u32x4 x = qp[c]; qf[8 * c] = bf_lo(x.x); qf[8 * c + 1] = bf_hi(x.x); qf[8 * c + 2] = bf_lo(x.y); qf[8 * c + 3] = bf_hi(x.y); qf[8 * c + 4] = bf_lo(x.z); qf[8 * c + 5] = bf_hi(x.z); qf[8 * c + 6] = bf_lo(x.w); qf[8 * c + 7] = bf_hi(x.w); } }
        float v1 = -INFINITY, v2 = -INFINITY, v3 = -INFINITY; int i1 = -1, i2 = -1, i3 = -1;
#define TOP_INS(v, n) do { const bool b1 = (v) > v1 || ((v) == v1 && (n) < i1), b2 = (v) > v2 || ((v) == v2 && (n) < i2), b3 = (v) > v3 || ((v) == v3 && (n) < i3); \
            if (b3) { if (b2) { v3 = v2; i3 = i2; if (b1) { v2 = v1; i2 = i1; v1 = (v); i1 = (n); } else { v2 = (v); i2 = (n); } } else { v3 = (v); i3 = (n); } } } while (0)
#pragma unroll 1
        for (int i = 0; i < 16; ++i) { const int n = 16 * hi + i;
            const LAS f32x4* kr = (const LAS f32x4*)(km + n * 64); float d = 0.f;
#pragma unroll
            for (int c = 0; c < 16; ++c) { const f32x4 kk = kr[c]; d += qf[4 * c] * kk[0]; d += qf[4 * c + 1] * kk[1]; d += qf[4 * c + 2] * kk[2]; d += qf[4 * c + 3] * kk[3]; }
            if (n < blk) TOP_INS(d, n); }
        { float x0, x1; x0 = swap_lo(v1, x1); const float pv1 = hi ? x0 : x1; x0 = swap_lo(v2, x1); const float pv2 = hi ? x0 : x1; x0 = swap_lo(v3, x1); const float pv3 = hi ? x0 : x1;
          x0 = swap_lo(__int_as_float(i1), x1); const int pi1 = __float_as_int(hi ? x0 : x1); x0 = swap_lo(__int_as_float(i2), x1); const int pi2 = __float_as_int(hi ? x0 : x1); x0 = swap_lo(__int_as_float(i3), x1); const int pi3 = __float_as_int(hi ? x0 : x1);
          TOP_INS(pv1, pi1); TOP_INS(pv2, pi2); TOP_INS(pv3, pi3); }
#undef TOP_INS
        if (i1 >= 0) sel |= 1u << i1; if (i2 >= 0) sel |= 1u << i2; if (i3 >= 0) sel |= 1u << i3;
    }
    return sel;
}
__device__ __forceinline__ void moba_tile(f32x16& o0, f32x16& o1, float& mrow, float& lsum, const bf16x8 (&qr)[4], bf16x8 (&kf)[8], const bf16_t* Kh, const bf16_t* Vh, int j0, int jn, float lb, float sl2, bool diag, int tq,
                                          LAS unsigned char* vst, LAS float* wsf, int lane) {
    const int r32 = lane & 31, hi = lane >> 5;
    f32x16 p0, p1;
#pragma unroll
    for (int r = 0; r < 16; ++r) { p0[r] = lb; p1[r] = lb + 32.0f * sl2; }
    qk(p0, p1, kf, qr);
    asm volatile("" : "+v"(p0), "+v"(p1) :: "memory");
    u32x4 vv[8]; load_v(vv, Vh, j0, lane);
    if (jn >= 0) load_k(kf, Kh, jn, r32, hi);
#pragma unroll
    for (int r = 0; r < 16; ++r) { p0[r] = __builtin_fmaf(sl2, (float)crow(r, 0), p0[r]); p1[r] = __builtin_fmaf(sl2, (float)crow(r, 0), p1[r]); }
    if (diag) {
#pragma unroll
        for (int r = 0; r < 16; ++r) { if (j0 + crow(r, hi) > tq) p0[r] = -INFINITY; if (j0 + 32 + crow(r, hi) > tq) p1[r] = -INFINITY; }
    }
    float rm = __builtin_fmaxf(p0[0], p1[0]);
#pragma unroll
    for (int r = 1; r < 16; ++r) rm = __builtin_fmaxf(rm, __builtin_fmaxf(p0[r], p1[r]));
    { float x1; const float x0 = swap_lo(rm, x1); rm = __builtin_fmaxf(x0, x1); }
    if (__any(rm > mrow + MOBA_THR)) {
        const float mn = __builtin_fmaxf(mrow, rm); const float f = __builtin_amdgcn_exp2f(mrow - mn); mrow = mn; lsum *= f;
        if (hi == 0) wsf[r32] = f;
        LDS_WAIT();
#pragma unroll
        for (int r = 0; r < 16; ++r) { const float fr_ = wsf[crow(r, hi)]; o0[r] *= fr_; o1[r] *= fr_; }
        LDS_WAIT();
    }
    float ps = 0.f;
#pragma unroll
    for (int r = 0; r < 16; ++r) { p0[r] = __builtin_amdgcn_exp2f(p0[r] - mrow); p1[r] = __builtin_amdgcn_exp2f(p1[r] - mrow); ps += p0[r] + p1[r]; }
    lsum += ps;
    stage_v(vst, vv, lane); LDS_WAIT();
    pv(o0, o1, p0, p1, vst, lane);
    LDS_WAIT();
}
__device__ __forceinline__ void moba_item(const bf16_t* Q, const bf16_t* K, const bf16_t* V, int b, int h, int blk, int n, int tix, const LAS unsigned char* lists, const LAS unsigned* cnt,
                                          const LAS unsigned* selm, unsigned char* recO, float* recML, LAS unsigned char* vst, LAS float* wsf, LAS unsigned* trow, int lane) {
    asm volatile("" : "+v"(lane));
    const int r32 = lane & 31, hi = lane >> 5; const size_t rowbase = (size_t)b * SEQ; const bool own = (n == blk);
    int q; bool valid; unsigned slot;
    if (own) { q = 32 * tix + r32; valid = true; slot = (unsigned)q * 4u + 3u; }
    else { const int cn = (int)cnt[n]; const int p = 32 * tix + r32; valid = p < cn; q = (int)lists[n * 256 + (valid ? p : cn - 1)];
           slot = (unsigned)q * 4u + (unsigned)__builtin_popcount(selm[q] & ((1u << n) - 1u)); }
    if (hi == 0) trow[r32] = slot | (valid ? 0x80000000u : 0u);
    const int tq = blk * 256 + q;
    const bf16_t* Qrow = Q + (rowbase + tq) * BW + h * HD + hi * 8;
    bf16x8 qr[4];
#pragma unroll
    for (int d0 = 0; d0 < 4; ++d0) qr[d0] = *(const bf16x8*)(Qrow + d0 * 16);
    const bf16_t* Kh = K + rowbase * BW + h * HD; const bf16_t* Vh = V + rowbase * BW + h * HD;
    const float sl2 = __builtin_amdgcn_exp2f(-(float)(h + 1)) * LOG2E;
    f32x16 o0 = {}, o1 = {}; float mrow = -INFINITY, lsum = 0.f;
    const int ntile = own ? (tix >> 1) + 1 : 4;
    bf16x8 kf[8]; load_k(kf, Kh, n * 256, r32, hi);
#pragma unroll 1
    for (int i = 0; i < ntile; ++i) { const int j0 = n * 256 + i * 64;
        moba_tile(o0, o1, mrow, lsum, qr, kf, Kh, Vh, j0, i < ntile - 1 ? j0 + 64 : -1, sl2 * (float)(j0 + 4 * hi - tq), sl2, own && i == ntile - 1, tq, vst, wsf, lane); }
    { float x1; const float x0 = swap_lo(lsum, x1); lsum = x0 + x1; }
    if (hi == 0) { wsf[32 + r32] = lsum; if (valid) *(f32x2*)(recML + 2 * slot) = (f32x2){mrow, lsum}; }
    LDS_WAIT();
    LAS bf16_t* s = (LAS bf16_t*)vst;
#pragma unroll
    for (int r = 0; r < 16; ++r) { const int orow = crow(r, hi); const float rl = __builtin_amdgcn_rcpf(wsf[32 + orow]);
        s[orow * 64 + r32] = (bf16_t)(cvt_pk_bf16(o0[r] * rl, 0.f) & 0xffffu); s[orow * 64 + 32 + r32] = (bf16_t)(cvt_pk_bf16(o1[r] * rl, 0.f) & 0xffffu); }
    LDS_WAIT();
#pragma unroll
    for (int i = 0; i < 4; ++i) { const int row = i * 8 + (lane >> 3), ch = lane & 7; const unsigned tr = trow[row]; const u32x4 v = *(const LAS u32x4*)(vst + row * 128 + ch * 16);
        if (tr & 0x80000000u) *(u32x4*)(recO + (size_t)(tr & 0x7fffffffu) * 128 + ch * 16) = v; }
    LDS_WAIT();
}
__device__ __forceinline__ void moba_merge(bf16_t* Q, int b, int h, int blk, int w, const LAS unsigned* selm, const unsigned char* recO, const float* recML, LAS float* wsf, int lane) {
    asm volatile("" : "+v"(lane));
    const int r32 = lane & 31, hi = lane >> 5; const size_t rowbase = (size_t)b * SEQ; const int q0 = blk * 256 + w * 32;
    const int ql = w * 32 + r32; const int c = __builtin_popcount(selm[ql]);
    float mi[4], li[4]; float mx = -INFINITY;
#pragma unroll
    for (int k = 0; k < 4; ++k) { mi[k] = -INFINITY; li[k] = 0.f; if (k == 3 || k < c) { const f32x2 ml = __builtin_nontemporal_load((const f32x2*)(recML + 2 * ((unsigned)ql * 4u + k))); mi[k] = ml.x; li[k] = ml.y; } mx = __builtin_fmaxf(mx, mi[k]); }
    float wg[4], L = 0.f;
#pragma unroll
    for (int k = 0; k < 4; ++k) { wg[k] = (k == 3 || k < c) ? __builtin_amdgcn_exp2f(mi[k] - mx) * li[k] : 0.f; L += wg[k]; }
    const float rL = 1.0f / L;
    if (hi == 0) { wsf[r32] = wg[0] * rL; wsf[32 + r32] = wg[1] * rL; wsf[64 + r32] = wg[2] * rL; wsf[96 + r32] = wg[3] * rL; }
    LDS_WAIT();
    bf16_t* Qw = Q + (rowbase + q0) * BW + h * HD;
#pragma unroll
    for (int i = 0; i < 4; ++i) { const int row = i * 8 + (lane >> 3), ch = lane & 7; f32x4 v0 = {0.f, 0.f, 0.f, 0.f}, v1 = {0.f, 0.f, 0.f, 0.f};
        const unsigned rslot = (unsigned)(w * 32 + row) * 4u;
#pragma unroll
        for (int k = 0; k < 4; ++k) { const float ak = wsf[32 * k + row];
            if (ak != 0.f) { const u32x4 pw = __builtin_nontemporal_load((const u32x4*)(recO + (size_t)(rslot + k) * 128 + ch * 16));
                v0 += ak * (f32x4){bf_lo(pw.x), bf_hi(pw.x), bf_lo(pw.y), bf_hi(pw.y)}; v1 += ak * (f32x4){bf_lo(pw.z), bf_hi(pw.z), bf_lo(pw.w), bf_hi(pw.w)}; } }
        st_bf16x8(Qw + (size_t)row * BW + ch * 8, v0, v1); }
    LDS_WAIT();
}
}

#define XB_TMO      128
#define XB_XCNT(j)  (256  + 64 * (j))
#define XB_XSUB(j)  (1280 + 64 * (j))
#define XB_XGEN(j)  (2304 + 64 * (j))
#define XB_TOP      3328
#define XB_TOPGEN   3392
#define XCD_BAR_WORDS 3456
#define XB_SPIN_CAP (1u << 18)
__device__ __forceinline__ unsigned xb_ld(unsigned* p)              { return __hip_atomic_load(p, __ATOMIC_RELAXED, __HIP_MEMORY_SCOPE_AGENT); }
__device__ __forceinline__ unsigned xb_add(unsigned* p, unsigned v) { return __hip_atomic_fetch_add(p, v, __ATOMIC_RELAXED, __HIP_MEMORY_SCOPE_AGENT); }
__device__ __forceinline__ unsigned xb_xcc_id() { return (unsigned)__builtin_amdgcn_s_getreg((3 << 11) | 20) & 0xFu; }
#define XB_SPIN(cond, bar) do { unsigned _sp = 0; while (cond) { __builtin_amdgcn_s_sleep(1); \
    if ((++_sp & 255u) == 0u) { if (xb_ld(&(bar)[XB_TMO])) break; if (_sp > XB_SPIN_CAP) { atomicAdd(&(bar)[XB_TMO], 1u); break; } } } } while (0)
struct XcdBarrier { unsigned* bar; unsigned x; volatile LAS unsigned* st; };
__device__ __forceinline__ XcdBarrier xcd_barrier_post(unsigned* bar, volatile LAS unsigned* st) {
    XcdBarrier b; b.bar = bar; b.x = xb_xcc_id(); b.st = st;
    if (threadIdx.x == 0) (void)xb_add(&bar[XB_XCNT(b.x)], 1u);
    return b;
}
__device__ __forceinline__ void xcd_barrier_complete(unsigned* bar, unsigned x, unsigned& nloc, unsigned& nx) {
    const unsigned G = gridDim.x * gridDim.y * gridDim.z;
    unsigned sum, cnt, mine, sp = 0u;
    for (;;) {
        sum = 0u; cnt = 0u; mine = 0u;
#pragma unroll
        for (unsigned j = 0; j < 16; ++j) { const unsigned c = xb_ld(&bar[XB_XCNT(j)]); sum += c; cnt += (c > 0u) ? 1u : 0u; mine = (j == x) ? c : mine; }
        if (sum == G) break;
        __builtin_amdgcn_s_sleep(1);
        if ((++sp & 255u) == 0u) { if (xb_ld(&bar[XB_TMO])) break; if (sp > XB_SPIN_CAP) { atomicAdd(&bar[XB_TMO], 1u); break; } }
    }
    nloc = mine > 0u ? mine : 1u; nx = cnt > 0u ? cnt : 1u;
}
__device__ __forceinline__ void xcd_barrier(const XcdBarrier& b) {
    asm volatile("s_waitcnt vmcnt(0)" ::: "memory");
    __syncthreads();
    if (threadIdx.x == 0) {
        unsigned* bar = b.bar;
        __builtin_amdgcn_s_waitcnt(0);
        unsigned nloc = b.st[0], nx = b.st[1];
        if (nloc == 0u) { xcd_barrier_complete(bar, b.x, nloc, nx); b.st[0] = nloc; b.st[1] = nx; }
        const unsigned old = xb_add(&bar[XB_XSUB(b.x)], 1u);
        const unsigned gen = old / nloc;
        if (old + 1u == (gen + 1u) * nloc) {
            __builtin_amdgcn_fence(__ATOMIC_RELEASE, "agent");
            asm volatile("s_waitcnt vmcnt(0)" ::: "memory");
            const unsigned og = xb_add(&bar[XB_TOP], 1u);
            const unsigned tg = og / nx;
            if (og + 1u == (tg + 1u) * nx) xb_add(&bar[XB_TOPGEN], 1u);
            else XB_SPIN(xb_ld(&bar[XB_TOPGEN]) == tg, bar);
            __builtin_amdgcn_fence(__ATOMIC_ACQUIRE, "agent");
            xb_add(&bar[XB_XGEN(b.x)], 1u);
            asm volatile("s_waitcnt vmcnt(0)" ::: "memory");
        } else {
            XB_SPIN(xb_ld(&bar[XB_XGEN(b.x)]) == gen, bar);
            __builtin_amdgcn_fence(__ATOMIC_ACQUIRE, "agent");
            asm volatile("s_waitcnt vmcnt(0)" ::: "memory");
        }
    }
    __syncthreads();
}

__device__ __forceinline__ float wave_sum(float v) {
#pragma unroll
    for (int o = 1; o < 64; o <<= 1) v += __shfl_xor(v, o);
    return v;
}
struct TrD { const float* src; const float* gain; bf16_t* dst; int ldw, ldt; };
__device__ __forceinline__ void tr_load(const TrD& d, f32x4 (&v)[8], float (&g)[8], int lane) {
    const int c4 = lane & 7, r0 = lane >> 3;
#pragma unroll
    for (int i = 0; i < 8; ++i) { const int row = 8 * i + r0; v[i] = *(const GAS f32x4*)((const GAS float*)d.src + (size_t)row * d.ldw + 4 * c4); g[i] = d.gain ? ((const GAS float*)d.gain)[row] : 1.0f; }
}
__device__ __forceinline__ void tr_store(const TrD& d, const f32x4 (&v)[8], const float (&g)[8], LAS float* scr, int lane) {
    const int c4 = lane & 7, r0 = lane >> 3;
#pragma unroll
    for (int i = 0; i < 8; ++i) { LAS float* s = scr + (8 * i + r0) * 33 + 4 * c4; s[0] = v[i][0] * g[i]; s[1] = v[i][1] * g[i]; s[2] = v[i][2] * g[i]; s[3] = v[i][3] * g[i]; }
    LDS_WAIT(); asm volatile("" ::: "memory");
    const int c = lane & 7;
#pragma unroll
    for (int j = 0; j < 4; ++j) { const int n = (lane >> 3) + 8 * j; const LAS float* s = scr + (8 * c) * 33 + n;
        u32x4 o; o.x = cvt_pk_bf16(s[0 * 33], s[1 * 33]); o.y = cvt_pk_bf16(s[2 * 33], s[3 * 33]); o.z = cvt_pk_bf16(s[4 * 33], s[5 * 33]); o.w = cvt_pk_bf16(s[6 * 33], s[7 * 33]);
        *(GAS u32x4*)((GAS bf16_t*)d.dst + (size_t)n * d.ldt + 8 * c) = o; }
    LDS_WAIT(); asm volatile("" ::: "memory");
}
constexpr int I_IN = (DM / 64) * (NIN / 32), I_P = (BW / 64) * (DM / 32), I_O = (DM / 64) * (DM / 32), I_G = (DM / 64) * (DFF / 32), I_D = (DFF / 64) * (DM / 32);
constexpr int NITEMS = I_IN + 3 * I_P + I_O + 2 * I_G + I_D;
struct Args { const float* in[14]; float* out; unsigned char* ws; };
__device__ __forceinline__ void tr_decode(int it, TrD& d, const Args& A, int layer, unsigned char* ws) {
    int r = it;
    if (r < I_IN) { const int nblk = NIN / 32, kb = r / nblk, c0 = 32 * (r % nblk); size_t doff;
        if (c0 < 3072) doff = WS_WIN + (size_t)c0 * DM * 2;
        else if (c0 < 3584) doff = WS_WIN + (size_t)(3072 + 256 * ((c0 - 3072) >> 7) + ((c0 - 3072) & 127)) * DM * 2;
        else if (c0 < 4096) doff = WS_WIN + (size_t)(4096 + (c0 - 3584)) * DM * 2;
        else if (c0 < 4608) doff = WS_WIN + (size_t)(3072 + 256 * ((c0 - 4096) >> 7) + 128 + ((c0 - 4096) & 127)) * DM * 2;
        else doff = WS_WG + (size_t)(c0 - 4608) * DM * 2;
        d.src = A.in[2] + (size_t)layer * DM * NIN + (size_t)(64 * kb) * NIN + c0; d.gain = A.in[1] + (size_t)layer * DM + 64 * kb; d.dst = (bf16_t*)(ws + doff) + 64 * kb; d.ldw = NIN; d.ldt = DM; return; }
    r -= I_IN;
    if (r < I_P) { const int nblk = DM / 32, kb = r / nblk, c0 = 32 * (r % nblk);
        d.src = A.in[5] + (size_t)layer * BW * DM + (size_t)(64 * kb) * DM + c0; d.gain = nullptr; d.dst = (bf16_t*)(ws + WS_WP) + (size_t)c0 * BW + 64 * kb; d.ldw = DM; d.ldt = BW; return; }
    r -= I_P;
    if (r < I_P) { const int nblk = DM / 32, kb = r / nblk, c0 = 32 * (r % nblk);
        d.src = A.in[6] + (size_t)layer * BW * DM + (size_t)(64 * kb) * DM + c0; d.gain = nullptr; d.dst = (bf16_t*)(ws + WS_WP) + (size_t)DM * BW + (size_t)c0 * BW + 64 * kb; d.ldw = DM; d.ldt = BW; return; }
    r -= I_P;
    if (r < I_P) { const int nblk = DM / 32, kb = r / nblk, c0 = 32 * (r % nblk);
        d.src = A.in[7] + (size_t)layer * BW * DM + (size_t)(64 * kb) * DM + c0; d.gain = nullptr; d.dst = (bf16_t*)(ws + WS_WP) + (size_t)2 * DM * BW + (size_t)c0 * BW + 64 * kb; d.ldw = DM; d.ldt = BW; return; }
    r -= I_P;
    if (r < I_O) { const int nblk = DM / 32, kb = r / nblk, c0 = 32 * (r % nblk);
        d.src = A.in[8] + (size_t)layer * DM * DM + (size_t)(64 * kb) * DM + c0; d.gain = nullptr; d.dst = (bf16_t*)(ws + WS_WO) + (size_t)c0 * DM + 64 * kb; d.ldw = DM; d.ldt = DM; return; }
    r -= I_O;
    if (r < I_G) { const int nblk = DFF / 32, kb = r / nblk, c0 = 32 * (r % nblk);
        d.src = A.in[10] + (size_t)layer * DM * DFF + (size_t)(64 * kb) * DFF + c0; d.gain = A.in[9] + (size_t)layer * DM + 64 * kb; d.dst = (bf16_t*)(ws + WS_WGU) + (size_t)(256 * (c0 >> 7) + (c0 & 127)) * DM + 64 * kb; d.ldw = DFF; d.ldt = DM; return; }
    r -= I_G;
    if (r < I_G) { const int nblk = DFF / 32, kb = r / nblk, c0 = 32 * (r % nblk);
        d.src = A.in[11] + (size_t)layer * DM * DFF + (size_t)(64 * kb) * DFF + c0; d.gain = A.in[9] + (size_t)layer * DM + 64 * kb; d.dst = (bf16_t*)(ws + WS_WGU) + (size_t)(256 * (c0 >> 7) + 128 + (c0 & 127)) * DM + 64 * kb; d.ldw = DFF; d.ldt = DM; return; }
    r -= I_G;
    { const int nblk = DM / 32, kb = r / nblk, c0 = 32 * (r % nblk);
      d.src = A.in[12] + (size_t)layer * DFF * DM + (size_t)(64 * kb) * DM + c0; d.gain = nullptr; d.dst = (bf16_t*)(ws + WS_WD) + (size_t)c0 * DFF + 64 * kb; d.ldw = DM; d.ldt = DFF; }
}


__global__ void __launch_bounds__(NWAVES * 64, 2) hybrid_fwd(Args args) {
    extern __shared__ __attribute__((aligned(16))) unsigned char lds_raw[];
    LAS unsigned char* lds = (LAS unsigned char*)lds_raw;
    volatile LAS unsigned* MISC = (volatile LAS unsigned*)(lds + MISC_OFF);
    const int wave = __builtin_amdgcn_readfirstlane((int)threadIdx.x >> 6);
    const int G = gridDim.x, bx = blockIdx.x, vcu = (G % 8 == 0) ? (bx % 8) * (G / 8) + bx / 8 : bx;
    for (int i = threadIdx.x; i < (LDS_BYTES - LDSCTL_OFF) / 4; i += NWAVES * 64) ((LAS unsigned*)(lds + LDSCTL_OFF))[i] = 0u;
    __syncthreads();
    XcdBarrier bar = xcd_barrier_post((unsigned*)(args.ws + WS_CTL) + CW_BAR, MISC + 8);
    const int gw = vcu * NWAVES + wave, NGW = G * NWAVES;

#ifndef REP_PH
#define REP_PH -1
#endif
    for (int pq = 0; pq < DEPTH * 7 + 1; ++pq)
    for (int rep_ = 0; rep_ < ((pq % 7 == REP_PH && pq < DEPTH * 7) ? 2 : 1); ++rep_) {
        const int pp = pq;
        const int layer = pp / 7, ph = pp - 7 * layer;
        int tid = threadIdx.x; asm volatile("" : "+v"(tid)); const int lane = tid & 63;
        size_t opq = 0; asm volatile("" : "+s"(opq));
        unsigned char* ws = args.ws + opq; const float* x_in = args.in[0] + opq; float* out = args.out + opq;
        float* ssA = (float*)(ws + WS_SSA); float* ssB = (float*)(ws + WS_SSB); float* kmp = (float*)(ws + WS_KM);
        bf16_t* xb = (bf16_t*)(ws + WS_XB);
        bf16_t* QA = (bf16_t*)(ws + WS_QA); bf16_t* KA = (bf16_t*)(ws + WS_KA); bf16_t* VA = (bf16_t*)(ws + WS_VA);
        bf16_t* QS = (bf16_t*)(ws + WS_QS); bf16_t* KS = (bf16_t*)(ws + WS_KS); bf16_t* VS = (bf16_t*)(ws + WS_VS);
        bf16_t* Ub = (bf16_t*)(ws + WS_U); bf16_t* BC = (bf16_t*)(ws + WS_BC); bf16_t* MG = (bf16_t*)(ws + WS_MG); bf16_t* ACT = (bf16_t*)(ws + WS_ACT);

        if (layer == DEPTH) {
            const float* gf = args.in[13];
            for (int m = gw; m < M; m += NGW) {
                const float rs = rstd_row(ssA, m);
                f32x4* xr = (f32x4*)(out + (size_t)m * DM) + lane; const f32x4* gr = (const f32x4*)gf + lane;
#pragma unroll
                for (int j = 0; j < 4; ++j) { const f32x4 v = xr[64 * j], g = gr[64 * j]; xr[64 * j] = v * rs * g; }
            }
            if (xb_ld((unsigned*)(ws + WS_CTL) + CW_BAR + XB_TMO) != 0u && bx == 0) { for (int i = tid; i < 4096; i += NWAVES * 64) out[i] = __builtin_nanf(""); }
            break;
        }
        if (ph == 0) {
            LAS float* scr = (LAS float*)(lds + RING_OFF + wave * 16384);
            for (int it = gw; it < NITEMS; it += NGW) { TrD dc; f32x4 vc[8]; float gc[8]; tr_decode(it, dc, args, layer, ws); tr_load(dc, vc, gc, lane); tr_store(dc, vc, gc, scr, lane); }
            if (layer == 0) {
                for (int m = gw; m < M; m += NGW) {
                    const f32x4* xr = (const f32x4*)(x_in + (size_t)m * DM) + lane; f32x4 v[4]; float s = 0.f;
#pragma unroll
                    for (int j = 0; j < 4; ++j) { v[j] = xr[64 * j]; s += (v[j].x * v[j].x + v[j].y * v[j].y) + (v[j].z * v[j].z + v[j].w * v[j].w); }
                    s = wave_sum(s);
                    u32x2* o8 = (u32x2*)(xb + (size_t)m * DM) + lane;
#pragma unroll
                    for (int j = 0; j < 4; ++j) o8[64 * j] = (u32x2){cvt_pk_bf16(v[j].x, v[j].y), cvt_pk_bf16(v[j].z, v[j].w)};
                    if (lane < 4) ssA[(size_t)m * 4 + lane] = (lane == 0) ? s : 0.f;
                }
            }
        } else if (ph == 2) {
            const int bh = vcu >> 4, s = vcu & 15, b = bh >> 3, h = bh & 7;
            LAS unsigned char* vst = lds + RING_OFF + wave * 8192;
            LAS float* wsf = (LAS float*)(lds + RING_OFF + 65536 + wave * 512);
            LAS float* km = (LAS float*)(lds + RING_OFF + 65536 + 4096);
            LAS unsigned* selm = (LAS unsigned*)(lds + RING_OFF + 77824);
            LAS unsigned* cnt = (LAS unsigned*)(lds + RING_OFF + 78848);
            LAS unsigned char* lists = lds + RING_OFF + 79872;
            LAS unsigned* trow = (LAS unsigned*)(lds + RING_OFF + 88064 + wave * 128);
            unsigned char* recO = ws + WS_MG + (size_t)vcu * 131072; float* recML = (float*)(ws + WS_X + (size_t)vcu * 8192);
            if (vcu < 256) {
                for (int k = 0; k < 2; ++k) {
                    const int blk = k == 0 ? 31 - s : s;
                    for (int i = tid; i < 2048; i += NWAVES * 64) { const int n = i >> 6, d = i & 63; const size_t o = (size_t)((b * 32 + n) * 2) * BW + h * HD + d; km[i] = kmp[o] + kmp[o + BW]; }
                    __syncthreads();
                    const unsigned sel = att::moba_gate(QA + ((size_t)b * SEQ + blk * 256 + wave * 32) * BW + h * HD, blk, km, lane);
                    if (lane < 32) selm[wave * 32 + lane] = sel;
                    __syncthreads();
                    for (int n = wave; n < blk; n += NWAVES) {
                        unsigned pos = 0;
#pragma unroll
                        for (int c = 0; c < 4; ++c) { const int q = 64 * c + lane; const bool bit = (selm[q] >> n) & 1u; const unsigned long long mk = __ballot(bit);
                            if (bit) lists[n * 256 + pos + __builtin_amdgcn_mbcnt_hi((unsigned)(mk >> 32), __builtin_amdgcn_mbcnt_lo((unsigned)mk, 0u))] = (unsigned char)q;
                            pos += (unsigned)__builtin_popcountll(mk); }
                        if (lane == 0) cnt[n] = pos;
                    }
                    __syncthreads();
                    { int id = wave, n = blk, t = wave;
                      int nn = 0, tt = 0, idp = 0;
                      for (;;) {
                          att::moba_item(QA, KA, VA, b, h, blk, n, t, lists, cnt, selm, recO, recML, vst, wsf, trow, lane);
                          bool found = false;
                          while (nn < blk) { const int nt_ = ((int)cnt[nn] + 31) >> 5;
                              if (tt < nt_) { const bool mine = (idp & (NWAVES - 1)) == wave; if (mine) { n = nn; t = tt; found = true; } ++tt; ++idp; if (mine) break; }
                              else { ++nn; tt = 0; } }
                          if (!found) break;
                      } (void)id; }
                    VM_WAIT();
                    __syncthreads();
                    att::moba_merge(QA, b, h, blk, wave, selm, recO, recML, wsf, lane);
                    __syncthreads();
                }
                for (int k = 0; k < 2; ++k) { const int blk = k == 0 ? 31 - s : s; att::sb_item(QS, KS, VS, b, h, blk * 256 + wave * 32, vst, lane); }
            }
            const float* cw = args.in[4] + (size_t)layer * 3 * BW;
            for (int i = vcu * (NWAVES * 64) + tid; i < M * (BW / 8); i += G * NWAVES * 64) {
                const int t = i >> 6, c = (i & 63) * 8; const int tt = t & (SEQ - 1);
                const u32x4 u2 = *(const u32x4*)(Ub + (size_t)t * BW + c);
                u32x4 u1 = {0u, 0u, 0u, 0u}, u0 = {0u, 0u, 0u, 0u};
                if (tt >= 1) u1 = *(const u32x4*)(Ub + (size_t)(t - 1) * BW + c);
                if (tt >= 2) u0 = *(const u32x4*)(Ub + (size_t)(t - 2) * BW + c);
                const u32x4 bw = *(const u32x4*)(BC + (size_t)t * BW + c);
                float y[8];
#pragma unroll
                for (int e = 0; e < 4; ++e) {
                    const float w0l = cw[c + 2 * e], w0h = cw[c + 2 * e + 1], w1l = cw[BW + c + 2 * e], w1h = cw[BW + c + 2 * e + 1], w2l = cw[2 * BW + c + 2 * e], w2h = cw[2 * BW + c + 2 * e + 1];
                    y[2 * e] = bf_lo(bw[e]) * (w0l * bf_lo(u0[e]) + w1l * bf_lo(u1[e]) + w2l * bf_lo(u2[e]));
                    y[2 * e + 1] = bf_hi(bw[e]) * (w0h * bf_hi(u0[e]) + w1h * bf_hi(u1[e]) + w2h * bf_hi(u2[e]));
                }
                *(u32x4*)(BC + (size_t)t * BW + c) = (u32x4){cvt_pk_bf16(y[0], y[1]), cvt_pk_bf16(y[2], y[3]), cvt_pk_bf16(y[4], y[5]), cvt_pk_bf16(y[6], y[7])};
            }
        } else {
            static_assert(WS_QS - WS_QA == 48 * MiB && WS_BC - WS_QS == 48 * MiB && WS_GB - WS_GA == 48 * MiB && WS_GC0 - WS_GB == 48 * MiB && WS_GC1 - WS_GC0 == 48 * MiB, "48 MiB spacing");
            GCfg c{};
            c.e0 = EpiIn{QA, Ub, BC, kmp, ssA};
            c.e1 = EpiC1{(bf16_t*)(ws + WS_GA), MG, args.in[3] + (size_t)layer * NGATE, ssA};
            c.e3 = EpiFfn{ACT, ssB};
            c.A2 = QA; c.B2 = (const bf16_t*)(ws + WS_WP); c.nseg = 1; c.lda = DM; c.ldb = DM; c.nt = DM / 64;
            if (ph == 1) { c.mode = 0; c.N = N1; c.A = xb; c.B = (const bf16_t*)(ws + WS_WIN); }
            else if (ph == 3) { c.mode = 1; c.N = DM; c.nseg = 6; c.A = xb; c.B = (const bf16_t*)(ws + WS_WG); }
            else if (ph == 4) { c.mode = 2; c.N = DM; c.A = MG; c.B = (const bf16_t*)(ws + WS_WO); c.e2 = EpiRes{layer == 0 ? x_in : (const float*)out, out, xb, ssB, (LAS float*)(lds + LDSCTL_OFF + 1024)}; }
            else if (ph == 5) { c.mode = 3; c.N = NGU; c.A = xb; c.B = (const bf16_t*)(ws + WS_WGU); }
            else { c.mode = 2; c.N = DM; c.A = ACT; c.B = (const bf16_t*)(ws + WS_WD); c.lda = DFF; c.ldb = DFF; c.nt = DFF / 64; c.e2 = EpiRes{out, out, xb, ssA, (LAS float*)(lds + LDSCTL_OFF + 1024)}; }
            ProbAny P{&c}; EpiAny E{&c}; pg8::StaticOrder S; S.init(M, c.N, G, bx, c.nseg);
            pg8::gemm_phase(lds + RING_OFF, P, S, E);
        }
        xcd_barrier(bar);
    }
}

extern "C" void kernel_launch(void* const* d_in, const int* in_sizes, int n_in, void* d_out, int out_size, void* d_ws, size_t ws_size, hipStream_t stream) {
    static int grid = 0;
    if (grid == 0) {
        if (n_in != 14 || in_sizes[0] != M * DM || out_size != M * DM || ws_size < WS_END) { fprintf(stderr, "kernel_launch: unexpected shapes (n_in %d, in0 %d, out %d, ws %zu)\n", n_in, n_in > 0 ? in_sizes[0] : -1, out_size, ws_size); grid = -1; return; }
        int dev = 0, cus = 0, per_cu = 0;
        if (hipGetDevice(&dev) != hipSuccess || hipDeviceGetAttribute(&cus, hipDeviceAttributeMultiprocessorCount, dev) != hipSuccess) { grid = -1; return; }
        if (hipFuncSetAttribute((const void*)hybrid_fwd, hipFuncAttributeMaxDynamicSharedMemorySize, LDS_BYTES) != hipSuccess) { fprintf(stderr, "kernel_launch: hipFuncSetAttribute failed\n"); grid = -1; return; }
        if (hipOccupancyMaxActiveBlocksPerMultiprocessor(&per_cu, (const void*)hybrid_fwd, NWAVES * 64, LDS_BYTES) != hipSuccess || per_cu < 1) { fprintf(stderr, "kernel_launch: occupancy query says %d blocks/CU\n", per_cu); (void)hipGetLastError(); per_cu = 1; }
        grid = cus;
    }
    if (grid < 0) return;
    if (hipMemsetAsync((char*)d_ws + WS_CTL, 0, CTL_ZERO_BYTES, stream) != hipSuccess) { fprintf(stderr, "kernel_launch: memset failed\n"); return; }
    Args a{};
    for (int i = 0; i < 14; ++i) a.in[i] = (const float*)d_in[i];
    a.out = (float*)d_out; a.ws = (unsigned char*)d_ws;
    void* kargs[] = {&a};
    hipError_t e = hipLaunchCooperativeKernel((const void*)hybrid_fwd, dim3(grid), dim3(NWAVES * 64), kargs, LDS_BYTES, stream);
    if (e != hipSuccess) fprintf(stderr, "kernel_launch: cooperative launch failed: %s (grid %d)\n", hipGetErrorString(e), grid);
}
```

```cpp
#include <hip/hip_runtime.h>
#include <hip/hip_bf16.h>
#include <cstdio>
#include <cstdint>

#define GAS __attribute__((address_space(1)))
#define LAS __attribute__((address_space(3)))
typedef unsigned short bf16_t;
typedef short bf16x8 __attribute__((ext_vector_type(8)));
typedef short s16x4 __attribute__((ext_vector_type(4)));
typedef float f32x2 __attribute__((ext_vector_type(2)));
typedef float f32x4 __attribute__((ext_vector_type(4)));
typedef float f32x16 __attribute__((ext_vector_type(16)));
typedef unsigned u32x2 __attribute__((ext_vector_type(2)));
typedef unsigned u32x4 __attribute__((ext_vector_type(4)));
typedef GAS unsigned gu32;

constexpr int BATCH = 2, SEQ = 8192, DM = 1024, M = BATCH * SEQ, NH = 8, HD = 64, BW = 512, DFF = 2816, DEPTH = 2;
constexpr int NIN = 7680, N1 = 4608, NGATE = 3072, NGU = 2 * DFF;
constexpr float RMS_EPS = 1e-6f;
constexpr float LOG2E = 1.4426950408889634f;
constexpr float C2 = 0.125f * LOG2E;
constexpr int NWAVES = 8;

constexpr size_t MiB = 1u << 20;
constexpr size_t WS_CTL = 0, CTL_ZERO_BYTES = 64 * 1024;
constexpr size_t WS_SSA = 1 * MiB, WS_SSB = 2 * MiB, WS_KM = 3 * MiB;
constexpr size_t WS_WIN = 4 * MiB, WS_WG = 13 * MiB, WS_WP = 19 * MiB, WS_WO = 22 * MiB, WS_WGU = 24 * MiB, WS_WD = 35 * MiB;
constexpr size_t WS_XB = 41 * MiB;
constexpr size_t WS_QA = 73 * MiB, WS_KA = 89 * MiB, WS_VA = 105 * MiB, WS_QS = 121 * MiB, WS_KS = 137 * MiB, WS_VS = 153 * MiB;
constexpr size_t WS_BC = 169 * MiB, WS_U = 185 * MiB, WS_MG = 201 * MiB, WS_X = 233 * MiB;
constexpr size_t WS_GA = WS_KA, WS_GB = WS_KS, WS_GC0 = WS_U, WS_GC1 = WS_X;
constexpr size_t WS_ACT = 73 * MiB;
constexpr size_t WS_END = 256 * MiB;
constexpr int CW_BAR = 4096;

constexpr int RING_OFF = 0, RING_BYTES = 131072;
constexpr int LDSCTL_OFF = RING_BYTES, MISC_OFF = LDSCTL_OFF + 320;
constexpr int LDS_BYTES = 147456;

#define LDS_WAIT() asm volatile("s_waitcnt lgkmcnt(0)" ::: "memory")
#define VM_WAIT() asm volatile("s_waitcnt vmcnt(0)" ::: "memory")
#define RLX_AGENT __ATOMIC_RELAXED, __HIP_MEMORY_SCOPE_AGENT

typedef __bf16 bf16x2_t __attribute__((ext_vector_type(2)));
__device__ __forceinline__ unsigned cvt_pk_bf16(float lo, float hi) { const f32x2 v = {lo, hi}; const bf16x2_t b = __builtin_convertvector(v, bf16x2_t); return __builtin_bit_cast(unsigned, b); }
__device__ __forceinline__ float bf_lo(unsigned w) { return __uint_as_float(w << 16); }
__device__ __forceinline__ float bf_hi(unsigned w) { return __uint_as_float(w & 0xffff0000u); }
__device__ __forceinline__ float rstd_row(const float* ssp, int row) {
    const f32x4 a = *(const f32x4*)(ssp + (size_t)row * 4);
    return rsqrtf(((a.x + a.y) + (a.z + a.w)) * (1.0f / DM) + RMS_EPS);
}

namespace pg8 {
constexpr int BM = 256, BK = 64, HALF = 128, HTB = HALF * BK * 2, STAGE_BYTES = 8 * HTB, NXCD = 8, WGM = 8;
__host__ __device__ __forceinline__ int lds_byte(int r, int c) { const int st = (r >> 4) * 2 + (c >> 5), rr = r & 15, cc = c & 31, ob = rr * 64 + cc * 2; return st * 1024 + (ob ^ (((ob >> 9) & 1) << 5)); }
__host__ __device__ __forceinline__ void stage_rc(int b, int& R, int& C) { const int st = b / 1024, sb = b % 1024, swz = sb ^ (((sb >> 9) & 1) << 5); R = (st >> 1) * 16 + swz / 64; C = (st & 1) * 32 + (swz % 64) / 2; }
__host__ __device__ __forceinline__ int perm32(int rho) { const int n = rho >> 4, i = rho & 15; return 8 * (i >> 2) + 4 * n + (i & 3); }

struct Unit { int pm, pn, seg; };
struct Seg { const char* A; const char* B; unsigned hA, hB; int lda, ldb, nt; };

struct StaticOrder {
    int nM, nN, nwg, G, c, nseg;
    __device__ void init(int M_, int N_, int G_, int c_, int nseg_) { nM = M_ / BM; nN = N_ / BM; nwg = nM * nN; G = G_; c = c_; nseg = nseg_; }
    __device__ bool next(int i, Unit& u) const {
        const int ti = (nseg == 1) ? i : i / nseg; u.seg = i - ti * nseg;
        const long L = (long)ti * G + c; if (L >= nwg) return false;
        int wgid = (int)L; { const int q = nwg / NXCD, r = nwg % NXCD, xcd = wgid % NXCD, off = wgid / NXCD; wgid = (xcd < r ? xcd * (q + 1) : r * (q + 1) + (xcd - r) * q) + off; }
        const int nig = WGM * nN, gid = wgid / nig, fm = gid * WGM, gsz = (nM - fm) < WGM ? (nM - fm) : WGM;
        u.pm = fm + ((wgid % nig) % gsz); u.pn = (wgid % nig) / gsz; return true;
    }
};

template <class Prob, class Epi, class Sched>
__device__ __forceinline__ void gemm_phase(LAS unsigned char* lds, const Prob& P, const Sched& S, const Epi& E) {
    int tid = threadIdx.x; asm volatile("" : "+v"(tid));
    const int wid = __builtin_amdgcn_readfirstlane(tid >> 6), lane = tid & 63, wr = wid >> 2, wc = wid & 3, fr = lane & 15, fq = lane >> 4;
    int R0, C0; stage_rc(tid * 16, R0, C0);
    const int Rb0 = (R0 & ~31) + perm32(R0 & 31);
    const size_t kstep = (size_t)(BK * 2);
    const unsigned ldsw = (unsigned)wid * 1024u;
    const int aoff = lds_byte(wr * 64 + fr, fq * 8), boff = lds_byte(wc * 32 + fr, fq * 8);
#define PG8_SA(b, h) (((b) * 2 + (h)) * HTB)
#define PG8_SB(b, h) ((4 + (b) * 2 + (h)) * HTB)
#define PG8_STAGE(bufoff, gbase, v0, q) do { \
        __builtin_amdgcn_global_load_lds((const unsigned*)((const char*)(gbase) + (v0)), (LAS unsigned*)(lds + (bufoff) + ldsw), 16, 0, 0); \
        __builtin_amdgcn_global_load_lds((const unsigned*)((const char*)(gbase) + (q) + (v0)), (LAS unsigned*)(lds + (bufoff) + ldsw + 8192), 16, 0, 0); } while (0)
#define PG8_LDA(dst, b, h) do { _Pragma("unroll") for (int m = 0; m < 4; ++m) _Pragma("unroll") for (int k = 0; k < 2; ++k) dst[m][k] = *(const LAS bf16x8*)(lds + PG8_SA(b, h) + aoff + m * 2048 + k * 1024); } while (0)
#define PG8_LDB(dst, b, h) do { _Pragma("unroll") for (int n = 0; n < 2; ++n) _Pragma("unroll") for (int k = 0; k < 2; ++k) dst[n][k] = *(const LAS bf16x8*)(lds + PG8_SB(b, h) + boff + n * 2048 + k * 1024); } while (0)
#define PG8_MMA(ai, bj, At, Bt) do { __builtin_amdgcn_s_setprio(1); _Pragma("unroll") for (int m = 0; m < 4; ++m) _Pragma("unroll") for (int n = 0; n < 2; ++n) _Pragma("unroll") for (int k = 0; k < 2; ++k) \
        acc[ai][bj][m][n] = __builtin_amdgcn_mfma_f32_16x16x32_bf16(Bt[n][k], At[m][k], acc[ai][bj][m][n], 0, 0, 0); __builtin_amdgcn_s_setprio(0); } while (0)
#define PG8_WAIT_V(n) asm volatile("s_waitcnt vmcnt(" #n ")" ::: "memory")
#define PG8_WAIT_L(n) asm volatile("s_waitcnt lgkmcnt(" #n ")" ::: "memory")
#define PG8_BAR __builtin_amdgcn_s_barrier()
#define PG8_SCHED __builtin_amdgcn_sched_barrier(0)
    Unit cur, nxt; int ui = 0;
    if (!S.next(0, cur)) return;
    Seg sc, sn; P.seg(cur, sc);
    unsigned vAc0 = (unsigned)(R0 * sc.lda + C0) * 2u, vBc0 = (unsigned)(Rb0 * sc.ldb + C0) * 2u;
    f32x4 acc[2][2][4][2];
#pragma unroll
    for (int a = 0; a < 2; ++a)
#pragma unroll
        for (int b = 0; b < 2; ++b)
#pragma unroll
            for (int m = 0; m < 4; ++m)
#pragma unroll
                for (int n = 0; n < 2; ++n) acc[a][b][m][n] = (f32x4){0.f, 0.f, 0.f, 0.f};
    bf16x8 At[4][2], B0[2][2], B1[2][2];
    const char* cA = sc.A; const char* cB = sc.B;
    PG8_STAGE(PG8_SB(0, 0), cB, vBc0, sc.hB >> 1); PG8_STAGE(PG8_SB(0, 1), cB + sc.hB, vBc0, sc.hB >> 1); PG8_STAGE(PG8_SA(0, 0), cA, vAc0, sc.hA >> 1); PG8_STAGE(PG8_SA(0, 1), cA + sc.hA, vAc0, sc.hA >> 1);
    if (wr == 1) PG8_BAR;
    PG8_WAIT_V(2); PG8_BAR;
    PG8_STAGE(PG8_SB(1, 0), cB + kstep, vBc0, sc.hB >> 1); PG8_STAGE(PG8_SA(1, 0), cA + kstep, vAc0, sc.hA >> 1); PG8_STAGE(PG8_SB(1, 1), cB + sc.hB + kstep, vBc0, sc.hB >> 1);
    PG8_WAIT_V(6); PG8_BAR;
    for (;;) {
        const bool has_next = S.next(ui + 1, nxt);
        if (has_next) P.seg(nxt, sn); else sn = sc;
        const unsigned vAn0 = (unsigned)(R0 * sn.lda + C0) * 2u, vBn0 = (unsigned)(Rb0 * sn.ldb + C0) * 2u;
        const char* nA = sn.A; const char* nB = sn.B;
        const int nt = sc.nt;
        for (int t = 0; t < nt; t += 2) {
            const bool last = (t == nt - 2);
            const char* a1 = cA + (size_t)(t + 1) * kstep;
            const char* a2 = last ? nA : cA + (size_t)(t + 2) * kstep; const char* b2 = last ? nB : cB + (size_t)(t + 2) * kstep;
            const char* a3 = a2 + kstep; const char* b3 = b2 + kstep;
            const unsigned hA2 = last ? sn.hA : sc.hA, hB2 = last ? sn.hB : sc.hB;
            const unsigned vA0 = last ? vAn0 : vAc0, vB0 = last ? vBn0 : vBc0, qA = hA2 >> 1, qB = hB2 >> 1;
            PG8_LDB(B0, 0, 0); PG8_LDB(B1, 0, 1); PG8_SCHED; PG8_LDA(At, 0, 0); PG8_STAGE(PG8_SA(1, 1), a1 + sc.hA, vAc0, sc.hA >> 1);
            PG8_WAIT_V(8); PG8_WAIT_L(0); PG8_BAR; PG8_MMA(0, 0, At, B0); PG8_MMA(0, 1, At, B1); PG8_BAR; PG8_SCHED;
            PG8_LDA(At, 0, 1); PG8_STAGE(PG8_SB(0, 0), b2, vB0, qB); PG8_STAGE(PG8_SB(0, 1), b2 + hB2, vB0, qB); PG8_STAGE(PG8_SA(0, 0), a2, vA0, qA);
            PG8_WAIT_V(8); PG8_WAIT_L(0); PG8_BAR; PG8_MMA(1, 0, At, B0); PG8_MMA(1, 1, At, B1); PG8_BAR; PG8_SCHED;
            PG8_LDB(B0, 1, 0); PG8_LDB(B1, 1, 1); PG8_SCHED; PG8_LDA(At, 1, 0); PG8_STAGE(PG8_SA(0, 1), a2 + hA2, vA0, qA);
            PG8_WAIT_V(8); PG8_WAIT_L(0); PG8_BAR; PG8_MMA(0, 0, At, B0); PG8_MMA(0, 1, At, B1); PG8_BAR; PG8_SCHED;
            PG8_LDA(At, 1, 1); PG8_STAGE(PG8_SB(1, 0), b3, vB0, qB); PG8_STAGE(PG8_SB(1, 1), b3 + hB2, vB0, qB); PG8_STAGE(PG8_SA(1, 0), a3, vA0, qA);
            PG8_WAIT_V(8); PG8_WAIT_L(0); PG8_BAR; PG8_MMA(1, 0, At, B0); PG8_MMA(1, 1, At, B1); PG8_BAR; PG8_SCHED;
        }
        if (wr == 0) PG8_BAR;
        E(acc, cur, wr, wc, fr, fq);
        if (!has_next) break;
#pragma unroll
        for (int a = 0; a < 2; ++a)
#pragma unroll
            for (int b = 0; b < 2; ++b)
#pragma unroll
                for (int m = 0; m < 4; ++m)
#pragma unroll
                    for (int n = 0; n < 2; ++n) acc[a][b][m][n] = (f32x4){0.f, 0.f, 0.f, 0.f};
        cur = nxt; sc = sn; cA = nA; cB = nB; vAc0 = vAn0; vBc0 = vBn0; ++ui;
        if (wr == 1) PG8_BAR;
    }
    PG8_WAIT_V(0);
    PG8_BAR;
#undef PG8_SA
#undef PG8_SB
#undef PG8_STAGE
#undef PG8_LDA
#undef PG8_LDB
#undef PG8_MMA
#undef PG8_WAIT_V
#undef PG8_WAIT_L
#undef PG8_BAR
#undef PG8_SCHED
}
}

#define EPI_ARGS const f32x4 (&acc)[2][2][4][2], const pg8::Unit& u, int wr, int wc, int fr, int fq
__device__ __forceinline__ void st_bf16x8(bf16_t* p, f32x4 v0, f32x4 v1) {
    u32x4 w; w.x = cvt_pk_bf16(v0[0], v0[1]); w.y = cvt_pk_bf16(v0[2], v0[3]); w.z = cvt_pk_bf16(v1[0], v1[1]); w.w = cvt_pk_bf16(v1[2], v1[3]);
    *(u32x4*)p = w;
}
template <class T> __device__ __forceinline__ T* bo(T* base, unsigned byte_off) { return (T*)((char*)base + byte_off); }
template <class T> __device__ __forceinline__ const T* bo(const T* base, unsigned byte_off) { return (const T*)((const char*)base + byte_off); }
__device__ __forceinline__ void ld_bf16x8(const bf16_t* p, f32x4& v0, f32x4& v1) {
    const unsigned long long lo = __hip_atomic_load((const unsigned long long*)p, __ATOMIC_RELAXED, __HIP_MEMORY_SCOPE_AGENT), hi = __hip_atomic_load((const unsigned long long*)p + 1, __ATOMIC_RELAXED, __HIP_MEMORY_SCOPE_AGENT);
    const u32x4 w = {(unsigned)lo, (unsigned)(lo >> 32), (unsigned)hi, (unsigned)(hi >> 32)};
    v0 = (f32x4){bf_lo(w.x), bf_hi(w.x), bf_lo(w.y), bf_hi(w.y)}; v1 = (f32x4){bf_lo(w.z), bf_hi(w.z), bf_lo(w.w), bf_hi(w.w)};
}
__device__ __forceinline__ float rstd4(f32x4 a) { return rsqrtf(((a.x + a.y) + (a.z + a.w)) * (1.0f / DM) + RMS_EPS); }
__device__ __forceinline__ void rstd8(float (&rs)[2][4], const float* ss, int pm, unsigned lrow) {
    const float* ssb = ss + (size_t)pm * 256 * 4; unsigned lsb = lrow * 16u; asm volatile("" : "+v"(lsb));
    f32x4 t[2][4];
#pragma unroll
    for (int ai = 0; ai < 2; ++ai)
#pragma unroll
        for (int m = 0; m < 4; ++m) t[ai][m] = *(const f32x4*)bo(ssb, lsb + (unsigned)(ai * 128 + m * 16) * 16u);
#pragma unroll
    for (int ai = 0; ai < 2; ++ai)
#pragma unroll
        for (int m = 0; m < 4; ++m) rs[ai][m] = rstd4(t[ai][m]);
}
struct EpiIn {
    bf16_t* qkv; bf16_t* ub; bf16_t* bc; float* kmp; const float* ss;
    __device__ __forceinline__ void operator()(EPI_ARGS) const {
        const int pn = u.pn; const unsigned lrow = (unsigned)(wr * 64 + fr), lcol = (unsigned)(wc * 32 + 8 * fq);
        unsigned lb = (lrow * BW + lcol) * 2u; asm volatile("" : "+v"(lb));
        float rs[2][4]; rstd8(rs, ss, u.pm, lrow);
        if (pn < 12 || pn >= 16) {
            const int t = pn >> 1; const float sc = (t == 0 || t == 3) ? C2 : 1.0f;
            bf16_t* base = (pn < 12 ? qkv + (size_t)t * M * BW + (pn & 1) * 256 : bc + (pn - 16) * 256) + (size_t)u.pm * 256 * BW;
            if (t == 1) {
                float* kp = kmp + (size_t)(u.pm * 2 + wr) * BW + (pn & 1) * 256;
#pragma unroll
                for (int bj = 0; bj < 2; ++bj)
#pragma unroll
                    for (int n = 0; n < 2; ++n) { f32x4 s = {0.f, 0.f, 0.f, 0.f};
#pragma unroll
                        for (int ai = 0; ai < 2; ++ai)
#pragma unroll
                            for (int m = 0; m < 4; ++m) s += acc[ai][bj][m][n] * rs[ai][m];
#pragma unroll
                        for (int o = 1; o < 16; o <<= 1) { s[0] += __shfl_xor(s[0], o); s[1] += __shfl_xor(s[1], o); s[2] += __shfl_xor(s[2], o); s[3] += __shfl_xor(s[3], o); }
                        if (fr == 0) *(f32x4*)bo(kp, (lcol + (unsigned)(bj * 128 + 4 * n)) * 4u) = s; }
            }
#pragma unroll
            for (int ai = 0; ai < 2; ++ai)
#pragma unroll
                for (int m = 0; m < 4; ++m) { const float f = rs[ai][m] * sc; const unsigned o = lb + (unsigned)(ai * 128 + m * 16) * BW * 2u;
#pragma unroll
                    for (int bj = 0; bj < 2; ++bj) st_bf16x8(bo(base, o + bj * 256u), acc[ai][bj][m][0] * f, acc[ai][bj][m][1] * f); }
        } else {
            bf16_t* base = ub + (size_t)u.pm * 256 * BW + (pn - 12) * 128;
#pragma unroll
            for (int ai = 0; ai < 2; ++ai)
#pragma unroll
                for (int m = 0; m < 4; ++m) { const float f = rs[ai][m] * rs[ai][m];
                    st_bf16x8(bo(base, lb + (unsigned)(ai * 128 + m * 16) * BW * 2u), acc[ai][0][m][0] * acc[ai][1][m][0] * f, acc[ai][0][m][1] * acc[ai][1][m][1] * f); }
        }
    }
};
struct EpiC1 {
    bf16_t* g0; bf16_t* mg; const float* bgate; const float* ss;
    __device__ __forceinline__ bf16_t* gtile(int s, int pm, int pn) const {
        const size_t off = (size_t)s * (48 * MiB) + ((s == 2 && pm >= 32) ? 32 * MiB : 0) + ((size_t)pm * 256 * DM + pn * 256) * 2;
        return (bf16_t*)((char*)g0 + off);
    }
    __device__ __forceinline__ void operator()(EPI_ARGS) const {
        const int sg = u.seg; const unsigned lrow = (unsigned)(wr * 64 + fr), lcol = (unsigned)(wc * 32 + 8 * fq); unsigned lb = (lrow * DM + lcol) * 2u;
        asm volatile("" : "+v"(lb));
        bf16_t* gp = gtile(sg < 3 ? sg : sg - 3, u.pm, u.pn);
        if (sg < 3) {
            const float* bg = bgate + sg * DM + u.pn * 256;
            f32x4 bv[2][2];
#pragma unroll
            for (int bj = 0; bj < 2; ++bj) { bv[bj][0] = *(const f32x4*)bo(bg, (lcol + bj * 128u) * 4u) * (-LOG2E); bv[bj][1] = *(const f32x4*)bo(bg, (lcol + bj * 128u + 4u) * 4u) * (-LOG2E); }
            float rs[2][4]; rstd8(rs, ss, u.pm, lrow);
#pragma unroll
            for (int ai = 0; ai < 2; ++ai)
#pragma unroll
                for (int m = 0; m < 4; ++m) { const float rn = rs[ai][m] * (-LOG2E); const unsigned o = lb + (unsigned)(ai * 128 + m * 16) * DM * 2u;
#pragma unroll
                    for (int bj = 0; bj < 2; ++bj) { f32x4 v[2];
#pragma unroll
                        for (int n = 0; n < 2; ++n) { const f32x4 x = acc[ai][bj][m][n] * rn + bv[bj][n];
#pragma unroll
                            for (int e = 0; e < 4; ++e) v[n][e] = __builtin_amdgcn_rcpf(1.0f + __builtin_amdgcn_exp2f(x[e])); }
                        st_bf16x8(bo(gp, o + bj * 256u), v[0], v[1]); } }
        } else {
            bf16_t* mp = mg + (size_t)u.pm * 256 * DM + u.pn * 256;
#pragma unroll
            for (int am = 0; am < 4; ++am) {
                const int ai = am >> 1, m0 = (am & 1) * 2;
                u32x4 gw_[2][2], pw_[2][2];
#pragma unroll
                for (int mm = 0; mm < 2; ++mm)
#pragma unroll
                    for (int bj = 0; bj < 2; ++bj) { const unsigned o = lb + (unsigned)(ai * 128 + (m0 + mm) * 16) * DM * 2u + bj * 256u;
                        gw_[mm][bj] = *(const u32x4*)bo((const bf16_t*)gp, o); if (sg > 3) pw_[mm][bj] = *(const u32x4*)bo((const bf16_t*)mp, o); }
#pragma unroll
                for (int mm = 0; mm < 2; ++mm)
#pragma unroll
                    for (int bj = 0; bj < 2; ++bj) { const int m = m0 + mm; const unsigned o = lb + (unsigned)(ai * 128 + m * 16) * DM * 2u + bj * 256u; const u32x4 g = gw_[mm][bj];
                        f32x4 v0 = acc[ai][bj][m][0] * (f32x4){bf_lo(g.x), bf_hi(g.x), bf_lo(g.y), bf_hi(g.y)}, v1 = acc[ai][bj][m][1] * (f32x4){bf_lo(g.z), bf_hi(g.z), bf_lo(g.w), bf_hi(g.w)};
                        if (sg > 3) { const u32x4 p = pw_[mm][bj]; v0 += (f32x4){bf_lo(p.x), bf_hi(p.x), bf_lo(p.y), bf_hi(p.y)}; v1 += (f32x4){bf_lo(p.z), bf_hi(p.z), bf_lo(p.w), bf_hi(p.w)}; }
                        st_bf16x8(bo(mp, o), v0, v1); }
                asm volatile("" ::: "memory");
            }
        }
    }
};
struct EpiRes {
    bf16_t* xb; float* sso; LAS float* red;
    __device__ __forceinline__ void operator()(EPI_ARGS) const {
        const unsigned lrow = (unsigned)(wr * 64 + fr); unsigned le = (lrow * DM + (unsigned)(wc * 32 + 8 * fq)) * 2u;
        asm volatile("" : "+v"(le));
        bf16_t* xp = xb + (size_t)u.pm * 256 * DM + u.pn * 256;
#pragma unroll
        for (int ai = 0; ai < 2; ++ai) {
            u32x4 bs[4][2];
#pragma unroll
            for (int m = 0; m < 4; ++m)
#pragma unroll
                for (int bj = 0; bj < 2; ++bj) bs[m][bj] = *(const u32x4*)bo((const bf16_t*)xp, le + (unsigned)(ai * 128 + m * 16) * DM * 2u + bj * 256u);
#pragma unroll
            for (int m = 0; m < 4; ++m) { float sq = 0.f;
#pragma unroll
                for (int bj = 0; bj < 2; ++bj) { const u32x4 w = bs[m][bj];
                    const f32x4 x0 = (f32x4){bf_lo(w.x), bf_hi(w.x), bf_lo(w.y), bf_hi(w.y)} + acc[ai][bj][m][0], x1 = (f32x4){bf_lo(w.z), bf_hi(w.z), bf_lo(w.w), bf_hi(w.w)} + acc[ai][bj][m][1];
                    st_bf16x8(bo(xp, le + (unsigned)(ai * 128 + m * 16) * DM * 2u + bj * 256u), x0, x1);
                    sq += (x0[0] * x0[0] + x0[1] * x0[1]) + (x0[2] * x0[2] + x0[3] * x0[3]) + (x1[0] * x1[0] + x1[1] * x1[1]) + (x1[2] * x1[2] + x1[3] * x1[3]); }
                sq += __shfl_xor(sq, 16); sq += __shfl_xor(sq, 32);
                if (fq == 0) red[(lrow + (unsigned)(ai * 128 + m * 16)) * 4u + wc] = sq; }
            asm volatile("" ::: "memory");
        }
        asm volatile("s_waitcnt lgkmcnt(0)\n\ts_barrier" ::: "memory");
        { const int t = (int)threadIdx.x; if (t < 256) { const f32x4 r = *(const LAS f32x4*)(red + t * 4); sso[((size_t)u.pm * 256 + t) * 4 + u.pn] = (r.x + r.y) + (r.z + r.w); } }
        asm volatile("s_waitcnt lgkmcnt(0)\n\ts_barrier" ::: "memory");
    }
};
struct EpiFfn {
    bf16_t* act; const float* ss;
    __device__ __forceinline__ void operator()(EPI_ARGS) const {
        const unsigned lrow = (unsigned)(wr * 64 + fr); unsigned lb = (lrow * DFF + (unsigned)(wc * 32 + 8 * fq)) * 2u;
        asm volatile("" : "+v"(lb));
        bf16_t* ap = act + (size_t)u.pm * 256 * DFF + u.pn * 128;
        float rs[2][4]; rstd8(rs, ss, u.pm, lrow);
#pragma unroll
        for (int ai = 0; ai < 2; ++ai)
#pragma unroll
            for (int m = 0; m < 4; ++m) { const float r1 = rs[ai][m], rn = r1 * (-LOG2E); f32x4 v[2];
#pragma unroll
                for (int n = 0; n < 2; ++n) { const f32x4 g = acc[ai][0][m][n], up = acc[ai][1][m][n] * (r1 * r1);
#pragma unroll
                    for (int e = 0; e < 4; ++e) v[n][e] = g[e] * up[e] * __builtin_amdgcn_rcpf(1.0f + __builtin_amdgcn_exp2f(g[e] * rn)); }
                st_bf16x8(bo(ap, lb + (unsigned)(ai * 128 + m * 16) * DFF * 2u), v[0], v[1]); }
    }
};

struct GCfg {
    int mode;
    int N, nseg;
    const bf16_t* A; const bf16_t* B; int lda, ldb, nt;
    const bf16_t* A2; const bf16_t* B2;
    EpiIn e0; EpiC1 e1; EpiRes e2; EpiFfn e3;
};
struct ProbAny {
    const GCfg* c;
    __device__ __forceinline__ void seg(const pg8::Unit& u, pg8::Seg& s) const {
        if (c->mode == 1 && u.seg >= 3) {
            const int br = u.seg - 3; const bf16_t* O = (const bf16_t*)((const char*)c->A2 + (size_t)br * (48 * MiB));
            s.A = (const char*)(O + (size_t)u.pm * 256 * BW); s.B = (const char*)(c->B2 + ((size_t)br * DM + (size_t)u.pn * 256) * BW);
            s.hA = 128u * BW * 2u; s.hB = 128u * BW * 2u; s.lda = BW; s.ldb = BW; s.nt = BW / 64;
        } else {
            const int so = (c->mode == 1) ? u.seg * DM : 0;
            s.A = (const char*)(c->A + (size_t)u.pm * 256 * c->lda); s.B = (const char*)(c->B + ((size_t)so + (size_t)u.pn * 256) * c->ldb);
            s.hA = 128u * (unsigned)c->lda * 2u; s.hB = 128u * (unsigned)c->ldb * 2u; s.lda = c->lda; s.ldb = c->ldb; s.nt = c->nt;
        }
    }
};
struct EpiAny {
    const GCfg* c;
    __device__ __forceinline__ void operator()(EPI_ARGS) const {
        const int m_ = c->mode;
        if (m_ == 0) c->e0(acc, u, wr, wc, fr, fq);
        else if (m_ == 1) c->e1(acc, u, wr, wc, fr, fq);
        else if (m_ == 2) c->e2(acc, u, wr, wc, fr, fq);
        else c->e3(acc, u, wr, wc, fr, fq);
    }
};

namespace att {
__device__ __forceinline__ constexpr int crow(int r, int hi) { return (r & 3) + 8 * (r >> 2) + 4 * hi; }
__device__ __forceinline__ float swap_lo(float x, float& hiv) { auto rr = __builtin_amdgcn_permlane32_swap(__float_as_uint(x), __float_as_uint(x), false, false); hiv = __uint_as_float(rr[1]); return __uint_as_float(rr[0]); }
__device__ __forceinline__ s16x4 vtr(const LAS unsigned char* p) { return __builtin_bit_cast(s16x4, __builtin_amdgcn_ds_read_tr16_b64_v4i16((LAS s16x4*)p)); }
__device__ __forceinline__ void load_k(bf16x8 (&kf)[8], const bf16_t* Kh, int j0, int r32, int hi) {
    const bf16_t* p = Kh + (size_t)(j0 + r32) * BW + hi * 8;
#pragma unroll
    for (int d0 = 0; d0 < 4; ++d0) { kf[2 * d0] = *(const bf16x8*)(p + d0 * 16); kf[2 * d0 + 1] = *(const bf16x8*)(p + (size_t)32 * BW + d0 * 16); }
}
__device__ __forceinline__ void load_v(u32x4 (&vv)[8], const bf16_t* Vh, int j0, int lane) {
    const bf16_t* p = Vh + (size_t)(j0 + (lane >> 3)) * BW + (lane & 7) * 8;
#pragma unroll
    for (int i = 0; i < 8; ++i) vv[i] = *(const u32x4*)(p + (size_t)(8 * i) * BW);
}
__device__ __forceinline__ void stage_v(LAS unsigned char* vst, const u32x4 (&vv)[8], int lane) {
    const int c = lane & 7;
#pragma unroll
    for (int i = 0; i < 8; ++i) { const int key = 8 * i + (lane >> 3);
        *(LAS u32x4*)(vst + ((c >> 2) * 4 + (key >> 4)) * 1024 + (key & 15) * 64 + (c & 3) * 16) = vv[i]; }
}
__device__ __forceinline__ void qk(f32x16& p0, f32x16& p1, const bf16x8 (&kf)[8], const bf16x8 (&qr)[4]) {
#pragma unroll
    for (int d0 = 0; d0 < 4; ++d0) { p0 = __builtin_amdgcn_mfma_f32_32x32x16_bf16(kf[2 * d0], qr[d0], p0, 0, 0, 0); p1 = __builtin_amdgcn_mfma_f32_32x32x16_bf16(kf[2 * d0 + 1], qr[d0], p1, 0, 0, 0); }
}
__device__ __forceinline__ void pv(f32x16& o0, f32x16& o1, const f32x16& p0, const f32x16& p1, const LAS unsigned char* vst, int lane) {
    const int hi = lane >> 5;
    const LAS unsigned char* vp = vst + ((lane >> 4) & 1) * 32 + (lane & 3) * 8 + (4 * hi + ((lane & 15) >> 2)) * 64;
    u32x4 pw[4];
    pw[0] = (u32x4){cvt_pk_bf16(p0[0], p0[1]), cvt_pk_bf16(p0[2], p0[3]), cvt_pk_bf16(p0[4], p0[5]), cvt_pk_bf16(p0[6], p0[7])};
    pw[1] = (u32x4){cvt_pk_bf16(p0[8], p0[9]), cvt_pk_bf16(p0[10], p0[11]), cvt_pk_bf16(p0[12], p0[13]), cvt_pk_bf16(p0[14], p0[15])};
    pw[2] = (u32x4){cvt_pk_bf16(p1[0], p1[1]), cvt_pk_bf16(p1[2], p1[3]), cvt_pk_bf16(p1[4], p1[5]), cvt_pk_bf16(p1[6], p1[7])};
    pw[3] = (u32x4){cvt_pk_bf16(p1[8], p1[9]), cvt_pk_bf16(p1[10], p1[11]), cvt_pk_bf16(p1[12], p1[13]), cvt_pk_bf16(p1[14], p1[15])};
#pragma unroll
    for (int ks = 0; ks < 4; ++ks) {
        const s16x4 a0 = vtr(vp + ks * 1024), a1 = vtr(vp + ks * 1024 + 512), b0 = vtr(vp + 4096 + ks * 1024), b1 = vtr(vp + 4096 + ks * 1024 + 512);
        const bf16x8 v0 = {a0[0], a0[1], a0[2], a0[3], a1[0], a1[1], a1[2], a1[3]}, v1 = {b0[0], b0[1], b0[2], b0[3], b1[0], b1[1], b1[2], b1[3]};
        const bf16x8 pa = __builtin_bit_cast(bf16x8, pw[ks]);
        o0 = __builtin_amdgcn_mfma_f32_32x32x16_bf16(pa, v0, o0, 0, 0, 0);
        o1 = __builtin_amdgcn_mfma_f32_32x32x16_bf16(pa, v1, o1, 0, 0, 0);
    }
}
__device__ __forceinline__ void store_o(bf16_t* Ow, const f32x16& o0, const f32x16& o1, const float (&rsc)[16], LAS unsigned char* stg, int lane) {
    const int r32 = lane & 31, hi = lane >> 5;
    LAS bf16_t* s = (LAS bf16_t*)stg;
#pragma unroll
    for (int r = 0; r < 16; ++r) { const int orow = crow(r, hi);
        s[orow * 64 + r32] = (bf16_t)(cvt_pk_bf16(o0[r] * rsc[r], 0.f) & 0xffffu); s[orow * 64 + 32 + r32] = (bf16_t)(cvt_pk_bf16(o1[r] * rsc[r], 0.f) & 0xffffu); }
    LDS_WAIT();
#pragma unroll
    for (int i = 0; i < 4; ++i) { const int row = i * 8 + (lane >> 3), ch = lane & 7; const u32x4 v = *(const LAS u32x4*)(stg + row * 128 + ch * 16); *(u32x4*)(Ow + (size_t)row * BW + ch * 8) = v; }
    LDS_WAIT();
}

__device__ __forceinline__ void sb_item(bf16_t* Q, const bf16_t* K, const bf16_t* V, int b, int h, int q0, LAS unsigned char* vst, int lane) {
    asm volatile("" : "+v"(lane));
    const int r32 = lane & 31, hi = lane >> 5;
    const size_t rowbase = (size_t)b * SEQ;
    bf16_t* Qw = Q + (rowbase + q0) * BW + h * HD;
    bf16x8 qr[4];
#pragma unroll
    for (int d0 = 0; d0 < 4; ++d0) qr[d0] = *(const bf16x8*)(Qw + (size_t)r32 * BW + d0 * 16 + hi * 8);
    const bf16_t* Kh = K + rowbase * BW + h * HD; const bf16_t* Vh = V + rowbase * BW + h * HD;
    f32x16 o0 = {}, o1 = {}; float A2 = 0.f;
    const int tq = q0 + r32;
    bf16x8 kf[8]; load_k(kf, Kh, ((q0 + 30) >> 6) * 64, r32, hi);
    for (int kt = (q0 + 30) >> 6; kt >= 0; --kt) {
        const int j0 = kt * 64;
        f32x16 p0 = {}, p1 = {};
        qk(p0, p1, kf, qr);
        asm volatile("" : "+v"(p0), "+v"(p1) :: "memory");
        u32x4 vv[8]; load_v(vv, Vh, j0, lane);
        if (kt > 0) load_k(kf, Kh, j0 - 64, r32, hi);
        const bool diag = (j0 + 63 >= q0);
        f32x16 l0, l1;
#pragma unroll
        for (int r = 0; r < 16; ++r) {
            { const float z = p0[r]; const float t = __builtin_amdgcn_exp2f(-__builtin_fabsf(z)); float l = -(__builtin_fmaxf(z, 0.f) + __builtin_amdgcn_logf(1.0f + t)); if (diag && (j0 + crow(r, hi) >= tq)) l = 0.f; l0[r] = l; }
            { const float z = p1[r]; const float t = __builtin_amdgcn_exp2f(-__builtin_fabsf(z)); float l = -(__builtin_fmaxf(z, 0.f) + __builtin_amdgcn_logf(1.0f + t)); if (diag && (j0 + 32 + crow(r, hi) >= tq)) l = 0.f; l1[r] = l; }
        }
        float carry = A2;
#pragma unroll
        for (int half = 1; half >= 0; --half) {
            f32x16& l = half ? l1 : l0; f32x16& p = half ? p1 : p0;
            float T[4];
#pragma unroll
            for (int g = 0; g < 4; ++g) { l[4 * g + 2] += l[4 * g + 3]; l[4 * g + 1] += l[4 * g + 2]; l[4 * g] += l[4 * g + 1]; T[g] = l[4 * g]; }
            float Tl[4], Th[4];
#pragma unroll
            for (int g = 0; g < 4; ++g) Tl[g] = swap_lo(T[g], Th[g]);
            float E = carry;
#pragma unroll
            for (int g = 3; g >= 0; --g) { const float eh = E; E += Th[g]; const float el = E; E += Tl[g]; const float off = hi ? eh : el;
                l[4 * g] += off; l[4 * g + 1] += off; l[4 * g + 2] += off; l[4 * g + 3] += off; }
            carry = E;
#pragma unroll
            for (int r = 0; r < 16; ++r) { float w = __builtin_amdgcn_exp2f(p[r] + l[r]); if (diag && (j0 + 32 * half + crow(r, hi) >= tq)) w = 0.f; p[r] = w; }
        }
        A2 = carry;
        stage_v(vst, vv, lane); LDS_WAIT();
        pv(o0, o1, p0, p1, vst, lane);
        LDS_WAIT();
        if (__all(A2 < -150.2f)) break;
    }
    float one[16];
#pragma unroll
    for (int r = 0; r < 16; ++r) one[r] = 1.0f;
    store_o(Qw, o0, o1, one, vst, lane);
}

constexpr float MOBA_THR = 8.0f;
__device__ __forceinline__ unsigned moba_gate(const bf16_t* Qw, int blk, const LAS float* km, int lane) {
    asm volatile("" : "+v"(lane));
    const int r32 = lane & 31, hi = lane >> 5;
    unsigned sel = 0u;
    if (blk > 0) {
        float qf[64];
        { const u32x4* qp = (const u32x4*)(Qw + (size_t)r32 * BW);
#pragma unroll
          for (int c = 0; c < 8; ++c) { const u32x4 x = qp[c]; qf[8 * c] = bf_lo(x.x); qf[8 * c + 1] = bf_hi(x.x); qf[8 * c + 2] = bf_lo(x.y); qf[8 * c + 3] = bf_hi(x.y); qf[8 * c + 4] = bf_lo(x.z); qf[8 * c + 5] = bf_hi(x.z); qf[8 * c + 6] = bf_lo(x.w); qf[8 * c + 7] = bf_hi(x.w); } }
        float v1 = -INFINITY, v2 = -INFINITY, v3 = -INFINITY; int i1 = -1, i2 = -1, i3 = -1;
#define TOP_INS(v, n) do { const bool b1 = (v) > v1 || ((v) == v1 && (n) < i1), b2 = (v) > v2 || ((v) == v2 && (n) < i2), b3 = (v) > v3 || ((v) == v3 && (n) < i3); \
            if (b3) { if (b2) { v3 = v2; i3 = i2; if (b1) { v2 = v1; i2 = i1; v1 = (v); i1 = (n); } else { v2 = (v); i2 = (n); } } else { v3 = (v); i3 = (n); } } } while (0)
#pragma unroll 1
        for (int i = 0; i < 16; ++i) { const int n = 16 * hi + i;
            const LAS f32x4* kr = (const LAS f32x4*)(km + n * 64); float d = 0.f;
#pragma unroll
            for (int c = 0; c < 16; ++c) { const f32x4 kk = kr[c]; d += qf[4 * c] * kk[0]; d += qf[4 * c + 1] * kk[1]; d += qf[4 * c + 2] * kk[2]; d += qf[4 * c + 3] * kk[3]; }
            if (n < blk) TOP_INS(d, n); }
        { float x0, x1; x0 = swap_lo(v1, x1); const float pv1 = hi ? x0 : x1; x0 = swap_lo(v2, x1); const float pv2 = hi ? x0 : x1; x0 = swap_lo(v3, x1); const float pv3 = hi ? x0 : x1;
          x0 = swap_lo(__int_as_float(i1), x1); const int pi1 = __float_as_int(hi ? x0 : x1); x0 = swap_lo(__int_as_float(i2), x1); const int pi2 = __float_as_int(hi ? x0 : x1); x0 = swap_lo(__int_as_float(i3), x1); const int pi3 = __float_as_int(hi ? x0 : x1);
          TOP_INS(pv1, pi1); TOP_INS(pv2, pi2); TOP_INS(pv3, pi3); }
#undef TOP_INS
        if (i1 >= 0) sel |= 1u << i1; if (i2 >= 0) sel |= 1u << i2; if (i3 >= 0) sel |= 1u << i3;
    }
    return sel;
}
__device__ __forceinline__ void moba_tile(f32x16& o0, f32x16& o1, float& mrow, float& lsum, const bf16x8 (&qr)[4], bf16x8 (&kf)[8], const bf16_t* Kh, const bf16_t* Vh, int j0, int jn, float lb, float sl2, bool diag, int tq,
                                          LAS unsigned char* vst, LAS float* wsf, int lane) {
    const int r32 = lane & 31, hi = lane >> 5;
    f32x16 p0, p1;
#pragma unroll
    for (int r = 0; r < 16; ++r) { p0[r] = lb; p1[r] = lb + 32.0f * sl2; }
    qk(p0, p1, kf, qr);
    asm volatile("" : "+v"(p0), "+v"(p1) :: "memory");
    u32x4 vv[8]; load_v(vv, Vh, j0, lane);
    if (jn >= 0) load_k(kf, Kh, jn, r32, hi);
#pragma unroll
    for (int r = 0; r < 16; ++r) { p0[r] = __builtin_fmaf(sl2, (float)crow(r, 0), p0[r]); p1[r] = __builtin_fmaf(sl2, (float)crow(r, 0), p1[r]); }
    if (diag) {
#pragma unroll
        for (int r = 0; r < 16; ++r) { if (j0 + crow(r, hi) > tq) p0[r] = -INFINITY; if (j0 + 32 + crow(r, hi) > tq) p1[r] = -INFINITY; }
    }
    float rm = __builtin_fmaxf(p0[0], p1[0]);
#pragma unroll
    for (int r = 1; r < 16; ++r) rm = __builtin_fmaxf(rm, __builtin_fmaxf(p0[r], p1[r]));
    { float x1; const float x0 = swap_lo(rm, x1); rm = __builtin_fmaxf(x0, x1); }
    if (__any(rm > mrow + MOBA_THR)) {
        const float mn = __builtin_fmaxf(mrow, rm); const float f = __builtin_amdgcn_exp2f(mrow - mn); mrow = mn; lsum *= f;
        if (hi == 0) wsf[r32] = f;
        LDS_WAIT();
#pragma unroll
        for (int r = 0; r < 16; ++r) { const float fr_ = wsf[crow(r, hi)]; o0[r] *= fr_; o1[r] *= fr_; }
        LDS_WAIT();
    }
    float ps = 0.f;
#pragma unroll
    for (int r = 0; r < 16; ++r) { p0[r] = __builtin_amdgcn_exp2f(p0[r] - mrow); p1[r] = __builtin_amdgcn_exp2f(p1[r] - mrow); ps += p0[r] + p1[r]; }
    lsum += ps;
    stage_v(vst, vv, lane); LDS_WAIT();
    pv(o0, o1, p0, p1, vst, lane);
    LDS_WAIT();
}
__device__ __forceinline__ void moba_item(const bf16_t* Q, const bf16_t* K, const bf16_t* V, int b, int h, int blk, int n, int tix, const LAS unsigned char* lists, const LAS unsigned* cnt,
                                          const LAS unsigned* selm, unsigned char* recO, float* recML, LAS unsigned char* vst, LAS float* wsf, LAS unsigned* trow, int lane) {
    asm volatile("" : "+v"(lane));
    const int r32 = lane & 31, hi = lane >> 5; const size_t rowbase = (size_t)b * SEQ; const bool own = (n == blk);
    int q; bool valid; unsigned slot;
    if (own) { q = 32 * tix + r32; valid = true; slot = (unsigned)q * 4u + 3u; }
    else { const int cn = (int)cnt[n]; const int p = 32 * tix + r32; valid = p < cn; q = (int)lists[n * 256 + (valid ? p : cn - 1)];
           slot = (unsigned)q * 4u + (unsigned)__builtin_popcount(selm[q] & ((1u << n) - 1u)); }
    if (hi == 0) trow[r32] = slot | (valid ? 0x80000000u : 0u);
    const int tq = blk * 256 + q;
    const bf16_t* Qrow = Q + (rowbase + tq) * BW + h * HD + hi * 8;
    bf16x8 qr[4];
#pragma unroll
    for (int d0 = 0; d0 < 4; ++d0) qr[d0] = *(const bf16x8*)(Qrow + d0 * 16);
    const bf16_t* Kh = K + rowbase * BW + h * HD; const bf16_t* Vh = V + rowbase * BW + h * HD;
    const float sl2 = __builtin_amdgcn_exp2f(-(float)(h + 1)) * LOG2E;
    f32x16 o0 = {}, o1 = {}; float mrow = -INFINITY, lsum = 0.f;
    const int ntile = own ? (tix >> 1) + 1 : 4;
    bf16x8 kf[8]; load_k(kf, Kh, n * 256, r32, hi);
#pragma unroll 1
    for (int i = 0; i < ntile; ++i) { const int j0 = n * 256 + i * 64;
        moba_tile(o0, o1, mrow, lsum, qr, kf, Kh, Vh, j0, i < ntile - 1 ? j0 + 64 : -1, sl2 * (float)(j0 + 4 * hi - tq), sl2, own && i == ntile - 1, tq, vst, wsf, lane); }
    { float x1; const float x0 = swap_lo(lsum, x1); lsum = x0 + x1; }
    if (hi == 0) { wsf[32 + r32] = lsum; if (valid) *(f32x2*)(recML + 2 * slot) = (f32x2){mrow, lsum}; }
    LDS_WAIT();
    LAS bf16_t* s = (LAS bf16_t*)vst;
#pragma unroll
    for (int r = 0; r < 16; ++r) { const int orow = crow(r, hi); const float rl = __builtin_amdgcn_rcpf(wsf[32 + orow]);
        s[orow * 64 + r32] = (bf16_t)(cvt_pk_bf16(o0[r] * rl, 0.f) & 0xffffu); s[orow * 64 + 32 + r32] = (bf16_t)(cvt_pk_bf16(o1[r] * rl, 0.f) & 0xffffu); }
    LDS_WAIT();
#pragma unroll
    for (int i = 0; i < 4; ++i) { const int row = i * 8 + (lane >> 3), ch = lane & 7; const unsigned tr = trow[row]; const u32x4 v = *(const LAS u32x4*)(vst + row * 128 + ch * 16);
        if (tr & 0x80000000u) *(u32x4*)(recO + (size_t)(tr & 0x7fffffffu) * 128 + ch * 16) = v; }
    LDS_WAIT();
}
__device__ __forceinline__ void moba_merge(bf16_t* Q, int b, int h, int blk, int w, const LAS unsigned* selm, const unsigned char* recO, const float* recML, LAS float* wsf, int lane) {
    asm volatile("" : "+v"(lane));
    const int r32 = lane & 31, hi = lane >> 5; const size_t rowbase = (size_t)b * SEQ; const int q0 = blk * 256 + w * 32;
    const int ql = w * 32 + r32; const int c = __builtin_popcount(selm[ql]);
    float mi[4], li[4]; float mx = -INFINITY;
#pragma unroll
    for (int k = 0; k < 4; ++k) { mi[k] = -INFINITY; li[k] = 0.f; if (k == 3 || k < c) { const f32x2 ml = __builtin_nontemporal_load((const f32x2*)(recML + 2 * ((unsigned)ql * 4u + k))); mi[k] = ml.x; li[k] = ml.y; } mx = __builtin_fmaxf(mx, mi[k]); }
    float wg[4], L = 0.f;
#pragma unroll
    for (int k = 0; k < 4; ++k) { wg[k] = (k == 3 || k < c) ? __builtin_amdgcn_exp2f(mi[k] - mx) * li[k] : 0.f; L += wg[k]; }
    const float rL = 1.0f / L;
    if (hi == 0) { wsf[r32] = wg[0] * rL; wsf[32 + r32] = wg[1] * rL; wsf[64 + r32] = wg[2] * rL; wsf[96 + r32] = wg[3] * rL; }
    LDS_WAIT();
    bf16_t* Qw = Q + (rowbase + q0) * BW + h * HD;
#pragma unroll
    for (int i = 0; i < 4; ++i) { const int row = i * 8 + (lane >> 3), ch = lane & 7; f32x4 v0 = {0.f, 0.f, 0.f, 0.f}, v1 = {0.f, 0.f, 0.f, 0.f};
        const unsigned rslot = (unsigned)(w * 32 + row) * 4u;
#pragma unroll
        for (int k = 0; k < 4; ++k) { const float ak = wsf[32 * k + row];
            if (ak != 0.f) { const u32x4 pw = __builtin_nontemporal_load((const u32x4*)(recO + (size_t)(rslot + k) * 128 + ch * 16));
                v0 += ak * (f32x4){bf_lo(pw.x), bf_hi(pw.x), bf_lo(pw.y), bf_hi(pw.y)}; v1 += ak * (f32x4){bf_lo(pw.z), bf_hi(pw.z), bf_lo(pw.w), bf_hi(pw.w)}; } }
        st_bf16x8(Qw + (size_t)row * BW + ch * 8, v0, v1); }
    LDS_WAIT();
}
}

#define XB_TMO      128
#define XB_XCNT(j)  (256  + 64 * (j))
#define XB_XSUB(j)  (1280 + 64 * (j))
#define XB_XGEN(j)  (2304 + 64 * (j))
#define XB_TOP      3328
#define XB_TOPGEN   3392
#define XCD_BAR_WORDS 3456
#define XB_SPIN_CAP (1u << 18)
__device__ __forceinline__ unsigned xb_ld(unsigned* p)              { return __hip_atomic_load(p, __ATOMIC_RELAXED, __HIP_MEMORY_SCOPE_AGENT); }
__device__ __forceinline__ unsigned xb_add(unsigned* p, unsigned v) { return __hip_atomic_fetch_add(p, v, __ATOMIC_RELAXED, __HIP_MEMORY_SCOPE_AGENT); }
__device__ __forceinline__ unsigned xb_xcc_id() { return (unsigned)__builtin_amdgcn_s_getreg((3 << 11) | 20) & 0xFu; }
#define XB_SPIN(cond, bar) do { unsigned _sp = 0; while (cond) { __builtin_amdgcn_s_sleep(1); \
    if ((++_sp & 255u) == 0u) { if (xb_ld(&(bar)[XB_TMO])) break; if (_sp > XB_SPIN_CAP) { atomicAdd(&(bar)[XB_TMO], 1u); break; } } } } while (0)
struct XcdBarrier { unsigned* bar; unsigned x; volatile LAS unsigned* st; };
__device__ __forceinline__ XcdBarrier xcd_barrier_post(unsigned* bar, volatile LAS unsigned* st) {
    XcdBarrier b; b.bar = bar; b.x = xb_xcc_id(); b.st = st;
    if (threadIdx.x == 0) (void)xb_add(&bar[XB_XCNT(b.x)], 1u);
    return b;
}
__device__ __forceinline__ void xcd_barrier_complete(unsigned* bar, unsigned x, unsigned& nloc, unsigned& nx) {
    const unsigned G = gridDim.x * gridDim.y * gridDim.z;
    unsigned sum, cnt, mine, sp = 0u;
    for (;;) {
        sum = 0u; cnt = 0u; mine = 0u;
#pragma unroll
        for (unsigned j = 0; j < 16; ++j) { const unsigned c = xb_ld(&bar[XB_XCNT(j)]); sum += c; cnt += (c > 0u) ? 1u : 0u; mine = (j == x) ? c : mine; }
        if (sum == G) break;
        __builtin_amdgcn_s_sleep(1);
        if ((++sp & 255u) == 0u) { if (xb_ld(&bar[XB_TMO])) break; if (sp > XB_SPIN_CAP) { atomicAdd(&bar[XB_TMO], 1u); break; } }
    }
    nloc = mine > 0u ? mine : 1u; nx = cnt > 0u ? cnt : 1u;
}
__device__ __forceinline__ void xcd_barrier(const XcdBarrier& b) {
    asm volatile("s_waitcnt vmcnt(0)" ::: "memory");
    __syncthreads();
    if (threadIdx.x == 0) {
        unsigned* bar = b.bar;
        __builtin_amdgcn_s_waitcnt(0);
        unsigned nloc = b.st[0], nx = b.st[1];
        if (nloc == 0u) { xcd_barrier_complete(bar, b.x, nloc, nx); b.st[0] = nloc; b.st[1] = nx; }
        const unsigned old = xb_add(&bar[XB_XSUB(b.x)], 1u);
        const unsigned gen = old / nloc;
        if (old + 1u == (gen + 1u) * nloc) {
            __builtin_amdgcn_fence(__ATOMIC_RELEASE, "agent");
            asm volatile("s_waitcnt vmcnt(0)" ::: "memory");
            const unsigned og = xb_add(&bar[XB_TOP], 1u);
            const unsigned tg = og / nx;
            if (og + 1u == (tg + 1u) * nx) xb_add(&bar[XB_TOPGEN], 1u);
            else XB_SPIN(xb_ld(&bar[XB_TOPGEN]) == tg, bar);
            __builtin_amdgcn_fence(__ATOMIC_ACQUIRE, "agent");
            xb_add(&bar[XB_XGEN(b.x)], 1u);
            asm volatile("s_waitcnt vmcnt(0)" ::: "memory");
        } else {
            XB_SPIN(xb_ld(&bar[XB_XGEN(b.x)]) == gen, bar);
            __builtin_amdgcn_fence(__ATOMIC_ACQUIRE, "agent");
            asm volatile("s_waitcnt vmcnt(0)" ::: "memory");
        }
    }
    __syncthreads();
}

__device__ __forceinline__ float wave_sum(float v) {
#pragma unroll
    for (int o = 1; o < 64; o <<= 1) v += __shfl_xor(v, o);
    return v;
}
struct TrD { const float* src; const float* gain; bf16_t* dst; int ldw, ldt; };
__device__ __forceinline__ void tr_load(const TrD& d, f32x4 (&v)[8], float (&g)[8], int lane) {
    const int c4 = lane & 7, r0 = lane >> 3;
#pragma unroll
    for (int i = 0; i < 8; ++i) { const int row = 8 * i + r0; v[i] = *(const GAS f32x4*)((const GAS float*)d.src + (size_t)row * d.ldw + 4 * c4); g[i] = d.gain ? ((const GAS float*)d.gain)[row] : 1.0f; }
}
__device__ __forceinline__ void tr_store(const TrD& d, const f32x4 (&v)[8], const float (&g)[8], LAS float* scr, int lane) {
    const int c4 = lane & 7, r0 = lane >> 3;
#pragma unroll
    for (int i = 0; i < 8; ++i) { LAS float* s = scr + (8 * i + r0) * 33 + 4 * c4; s[0] = v[i][0] * g[i]; s[1] = v[i][1] * g[i]; s[2] = v[i][2] * g[i]; s[3] = v[i][3] * g[i]; }
    LDS_WAIT(); asm volatile("" ::: "memory");
    const int c = lane & 7;
#pragma unroll
    for (int j = 0; j < 4; ++j) { const int n = (lane >> 3) + 8 * j; const LAS float* s = scr + (8 * c) * 33 + n;
        u32x4 o; o.x = cvt_pk_bf16(s[0 * 33], s[1 * 33]); o.y = cvt_pk_bf16(s[2 * 33], s[3 * 33]); o.z = cvt_pk_bf16(s[4 * 33], s[5 * 33]); o.w = cvt_pk_bf16(s[6 * 33], s[7 * 33]);
        *(GAS u32x4*)((GAS bf16_t*)d.dst + (size_t)n * d.ldt + 8 * c) = o; }
    LDS_WAIT(); asm volatile("" ::: "memory");
}
constexpr int I_IN = (DM / 64) * (NIN / 32), I_P = (BW / 64) * (DM / 32), I_O = (DM / 64) * (DM / 32), I_G = (DM / 64) * (DFF / 32), I_D = (DFF / 64) * (DM / 32);
constexpr int NITEMS = I_IN + 3 * I_P + I_O + 2 * I_G + I_D;
struct Args { const float* in[14]; float* out; unsigned char* ws; };
__device__ __forceinline__ void tr_decode(int it, TrD& d, const Args& A, int layer, unsigned char* ws) {
    int r = it;
    if (r < I_IN) { const int nblk = NIN / 32, kb = r / nblk, c0 = 32 * (r % nblk); size_t doff;
        if (c0 < 3072) doff = WS_WIN + (size_t)c0 * DM * 2;
        else if (c0 < 3584) doff = WS_WIN + (size_t)(3072 + 256 * ((c0 - 3072) >> 7) + ((c0 - 3072) & 127)) * DM * 2;
        else if (c0 < 4096) doff = WS_WIN + (size_t)(4096 + (c0 - 3584)) * DM * 2;
        else if (c0 < 4608) doff = WS_WIN + (size_t)(3072 + 256 * ((c0 - 4096) >> 7) + 128 + ((c0 - 4096) & 127)) * DM * 2;
        else doff = WS_WG + (size_t)(c0 - 4608) * DM * 2;
        d.src = A.in[2] + (size_t)layer * DM * NIN + (size_t)(64 * kb) * NIN + c0; d.gain = A.in[1] + (size_t)layer * DM + 64 * kb; d.dst = (bf16_t*)(ws + doff) + 64 * kb; d.ldw = NIN; d.ldt = DM; return; }
    r -= I_IN;
    if (r < I_P) { const int nblk = DM / 32, kb = r / nblk, c0 = 32 * (r % nblk);
        d.src = A.in[5] + (size_t)layer * BW * DM + (size_t)(64 * kb) * DM + c0; d.gain = nullptr; d.dst = (bf16_t*)(ws + WS_WP) + (size_t)c0 * BW + 64 * kb; d.ldw = DM; d.ldt = BW; return; }
    r -= I_P;
    if (r < I_P) { const int nblk = DM / 32, kb = r / nblk, c0 = 32 * (r % nblk);
        d.src = A.in[6] + (size_t)layer * BW * DM + (size_t)(64 * kb) * DM + c0; d.gain = nullptr; d.dst = (bf16_t*)(ws + WS_WP) + (size_t)DM * BW + (size_t)c0 * BW + 64 * kb; d.ldw = DM; d.ldt = BW; return; }
    r -= I_P;
    if (r < I_P) { const int nblk = DM / 32, kb = r / nblk, c0 = 32 * (r % nblk);
        d.src = A.in[7] + (size_t)layer * BW * DM + (size_t)(64 * kb) * DM + c0; d.gain = nullptr; d.dst = (bf16_t*)(ws + WS_WP) + (size_t)2 * DM * BW + (size_t)c0 * BW + 64 * kb; d.ldw = DM; d.ldt = BW; return; }
    r -= I_P;
    if (r < I_O) { const int nblk = DM / 32, kb = r / nblk, c0 = 32 * (r % nblk);
        d.src = A.in[8] + (size_t)layer * DM * DM + (size_t)(64 * kb) * DM + c0; d.gain = nullptr; d.dst = (bf16_t*)(ws + WS_WO) + (size_t)c0 * DM + 64 * kb; d.ldw = DM; d.ldt = DM; return; }
    r -= I_O;
    if (r < I_G) { const int nblk = DFF / 32, kb = r / nblk, c0 = 32 * (r % nblk);
        d.src = A.in[10] + (size_t)layer * DM * DFF + (size_t)(64 * kb) * DFF + c0; d.gain = A.in[9] + (size_t)layer * DM + 64 * kb; d.dst = (bf16_t*)(ws + WS_WGU) + (size_t)(256 * (c0 >> 7) + (c0 & 127)) * DM + 64 * kb; d.ldw = DFF; d.ldt = DM; return; }
    r -= I_G;
    if (r < I_G) { const int nblk = DFF / 32, kb = r / nblk, c0 = 32 * (r % nblk);
        d.src = A.in[11] + (size_t)layer * DM * DFF + (size_t)(64 * kb) * DFF + c0; d.gain = A.in[9] + (size_t)layer * DM + 64 * kb; d.dst = (bf16_t*)(ws + WS_WGU) + (size_t)(256 * (c0 >> 7) + 128 + (c0 & 127)) * DM + 64 * kb; d.ldw = DFF; d.ldt = DM; return; }
    r -= I_G;
    { const int nblk = DM / 32, kb = r / nblk, c0 = 32 * (r % nblk);
      d.src = A.in[12] + (size_t)layer * DFF * DM + (size_t)(64 * kb) * DM + c0; d.gain = nullptr; d.dst = (bf16_t*)(ws + WS_WD) + (size_t)c0 * DFF + 64 * kb; d.ldw = DM; d.ldt = DFF; }
}


__global__ void __launch_bounds__(NWAVES * 64, 2) hybrid_fwd(Args args) {
    extern __shared__ __attribute__((aligned(16))) unsigned char lds_raw[];
    LAS unsigned char* lds = (LAS unsigned char*)lds_raw;
    volatile LAS unsigned* MISC = (volatile LAS unsigned*)(lds + MISC_OFF);
    const int wave = __builtin_amdgcn_readfirstlane((int)threadIdx.x >> 6);
    const int G = gridDim.x, bx = blockIdx.x, vcu = (G % 8 == 0) ? (bx % 8) * (G / 8) + bx / 8 : bx;
    for (int i = threadIdx.x; i < (LDS_BYTES - LDSCTL_OFF) / 4; i += NWAVES * 64) ((LAS unsigned*)(lds + LDSCTL_OFF))[i] = 0u;
    __syncthreads();
    XcdBarrier bar = xcd_barrier_post((unsigned*)(args.ws + WS_CTL) + CW_BAR, MISC + 8);
    const int gw = vcu * NWAVES + wave, NGW = G * NWAVES;

#ifndef REP_PH
#define REP_PH -1
#endif
    for (int pq = 0; pq < DEPTH * 7 + 1; ++pq)
    for (int rep_ = 0; rep_ < ((pq % 7 == REP_PH && pq < DEPTH * 7) ? 2 : 1); ++rep_) {
        const int pp = pq;
        const int layer = pp / 7, ph = pp - 7 * layer;
        int tid = threadIdx.x; asm volatile("" : "+v"(tid)); const int lane = tid & 63;
        size_t opq = 0; asm volatile("" : "+s"(opq));
        unsigned char* ws = args.ws + opq; const float* x_in = args.in[0] + opq; float* out = args.out + opq;
        float* ssA = (float*)(ws + WS_SSA); float* ssB = (float*)(ws + WS_SSB); float* kmp = (float*)(ws + WS_KM);
        bf16_t* xb = (bf16_t*)(ws + WS_XB);
        bf16_t* QA = (bf16_t*)(ws + WS_QA); bf16_t* KA = (bf16_t*)(ws + WS_KA); bf16_t* VA = (bf16_t*)(ws + WS_VA);
        bf16_t* QS = (bf16_t*)(ws + WS_QS); bf16_t* KS = (bf16_t*)(ws + WS_KS); bf16_t* VS = (bf16_t*)(ws + WS_VS);
        bf16_t* Ub = (bf16_t*)(ws + WS_U); bf16_t* BC = (bf16_t*)(ws + WS_BC); bf16_t* MG = (bf16_t*)(ws + WS_MG); bf16_t* ACT = (bf16_t*)(ws + WS_ACT);

        if (layer == DEPTH) {
            const float* gf = args.in[13];
            for (int m = gw; m < M; m += NGW) {
                const float rs = rstd_row(ssA, m);
                f32x4* xr = (f32x4*)(out + (size_t)m * DM) + lane; const f32x4* gr = (const f32x4*)gf + lane; const u32x2* xs = (const u32x2*)(xb + (size_t)m * DM) + lane;
#pragma unroll
                for (int j = 0; j < 4; ++j) { const u32x2 w = xs[64 * j]; const f32x4 v = {bf_lo(w.x), bf_hi(w.x), bf_lo(w.y), bf_hi(w.y)}, g = gr[64 * j]; xr[64 * j] = v * rs * g; }
            }
            if (xb_ld((unsigned*)(ws + WS_CTL) + CW_BAR + XB_TMO) != 0u && bx == 0) { for (int i = tid; i < 4096; i += NWAVES * 64) out[i] = __builtin_nanf(""); }
            break;
        }
        if (ph == 0) {
            LAS float* scr = (LAS float*)(lds + RING_OFF + wave * 16384);
            for (int it = gw; it < NITEMS; it += NGW) { TrD dc; f32x4 vc[8]; float gc[8]; tr_decode(it, dc, args, layer, ws); tr_load(dc, vc, gc, lane); tr_store(dc, vc, gc, scr, lane); }
            if (layer == 0) {
                for (int m = gw; m < M; m += NGW) {
                    const f32x4* xr = (const f32x4*)(x_in + (size_t)m * DM) + lane; f32x4 v[4]; float s = 0.f;
#pragma unroll
                    for (int j = 0; j < 4; ++j) { v[j] = xr[64 * j]; s += (v[j].x * v[j].x + v[j].y * v[j].y) + (v[j].z * v[j].z + v[j].w * v[j].w); }
                    s = wave_sum(s);
                    u32x2* o8 = (u32x2*)(xb + (size_t)m * DM) + lane;
#pragma unroll
                    for (int j = 0; j < 4; ++j) o8[64 * j] = (u32x2){cvt_pk_bf16(v[j].x, v[j].y), cvt_pk_bf16(v[j].z, v[j].w)};
                    if (lane < 4) ssA[(size_t)m * 4 + lane] = (lane == 0) ? s : 0.f;
                }
            }
        } else if (ph == 2) {
            const int xg = vcu >> 5, jj = vcu & 31;
            LAS unsigned char* vst = lds + RING_OFF + wave * 8192;
            LAS float* wsf = (LAS float*)(lds + RING_OFF + 65536 + wave * 512);
            LAS float* km = (LAS float*)(lds + RING_OFF + 65536 + 4096);
            LAS unsigned* selm = (LAS unsigned*)(lds + RING_OFF + 77824);
            LAS unsigned* cnt = (LAS unsigned*)(lds + RING_OFF + 78848);
            LAS unsigned char* lists = lds + RING_OFF + 79872;
            LAS unsigned* trow = (LAS unsigned*)(lds + RING_OFF + 88064 + wave * 128);
            unsigned char* recO = ws + WS_MG + (size_t)vcu * 131072; float* recML = (float*)(ws + WS_X + (size_t)vcu * 8192);
            if (vcu < 256) {
                for (int k = 0; k < 2; ++k) {
                    const int bh = 2 * xg + k, b = bh >> 3, h = bh & 7, blk = k == 0 ? jj : 31 - jj;
                    for (int i = tid; i < 2048; i += NWAVES * 64) { const int n = i >> 6, d = i & 63; const size_t o = (size_t)((b * 32 + n) * 2) * BW + h * HD + d; km[i] = kmp[o] + kmp[o + BW]; }
                    __syncthreads();
                    const unsigned sel = att::moba_gate(QA + ((size_t)b * SEQ + blk * 256 + wave * 32) * BW + h * HD, blk, km, lane);
                    if (lane < 32) selm[wave * 32 + lane] = sel;
                    __syncthreads();
                    for (int n = wave; n < blk; n += NWAVES) {
                        unsigned pos = 0;
#pragma unroll
                        for (int c = 0; c < 4; ++c) { const int q = 64 * c + lane; const bool bit = (selm[q] >> n) & 1u; const unsigned long long mk = __ballot(bit);
                            if (bit) lists[n * 256 + pos + __builtin_amdgcn_mbcnt_hi((unsigned)(mk >> 32), __builtin_amdgcn_mbcnt_lo((unsigned)mk, 0u))] = (unsigned char)q;
                            pos += (unsigned)__builtin_popcountll(mk); }
                        if (lane == 0) cnt[n] = pos;
                    }
                    __syncthreads();
                    { int id = wave, n = blk, t = wave;
                      int nn = 0, tt = 0, idp = 0;
                      for (;;) {
                          att::moba_item(QA, KA, VA, b, h, blk, n, t, lists, cnt, selm, recO, recML, vst, wsf, trow, lane);
                          bool found = false;
                          while (nn < blk) { const int nt_ = ((int)cnt[nn] + 31) >> 5;
                              if (tt < nt_) { const bool mine = (idp & (NWAVES - 1)) == wave; if (mine) { n = nn; t = tt; found = true; } ++tt; ++idp; if (mine) break; }
                              else { ++nn; tt = 0; } }
                          if (!found) break;
                      } (void)id; }
                    VM_WAIT();
                    __syncthreads();
                    att::moba_merge(QA, b, h, blk, wave, selm, recO, recML, wsf, lane);
                    __syncthreads();
                }
                for (int k = 0; k < 2; ++k) { const int bh = 2 * xg + k, b = bh >> 3, h = bh & 7, blk = k == 0 ? jj : 31 - jj; att::sb_item(QS, KS, VS, b, h, blk * 256 + wave * 32, vst, lane); }
            }
            const float* cw = args.in[4] + (size_t)layer * 3 * BW;
            for (int i = vcu * (NWAVES * 64) + tid; i < M * (BW / 8); i += G * NWAVES * 64) {
                const int t = i >> 6, c = (i & 63) * 8; const int tt = t & (SEQ - 1);
                const u32x4 u2 = *(const u32x4*)(Ub + (size_t)t * BW + c);
                u32x4 u1 = {0u, 0u, 0u, 0u}, u0 = {0u, 0u, 0u, 0u};
                if (tt >= 1) u1 = *(const u32x4*)(Ub + (size_t)(t - 1) * BW + c);
                if (tt >= 2) u0 = *(const u32x4*)(Ub + (size_t)(t - 2) * BW + c);
                const u32x4 bw = *(const u32x4*)(BC + (size_t)t * BW + c);
                float y[8];
#pragma unroll
                for (int e = 0; e < 4; ++e) {
                    const float w0l = cw[c + 2 * e], w0h = cw[c + 2 * e + 1], w1l = cw[BW + c + 2 * e], w1h = cw[BW + c + 2 * e + 1], w2l = cw[2 * BW + c + 2 * e], w2h = cw[2 * BW + c + 2 * e + 1];
                    y[2 * e] = bf_lo(bw[e]) * (w0l * bf_lo(u0[e]) + w1l * bf_lo(u1[e]) + w2l * bf_lo(u2[e]));
                    y[2 * e + 1] = bf_hi(bw[e]) * (w0h * bf_hi(u0[e]) + w1h * bf_hi(u1[e]) + w2h * bf_hi(u2[e]));
                }
                *(u32x4*)(BC + (size_t)t * BW + c) = (u32x4){cvt_pk_bf16(y[0], y[1]), cvt_pk_bf16(y[2], y[3]), cvt_pk_bf16(y[4], y[5]), cvt_pk_bf16(y[6], y[7])};
            }
        } else {
            static_assert(WS_QS - WS_QA == 48 * MiB && WS_BC - WS_QS == 48 * MiB && WS_GB - WS_GA == 48 * MiB && WS_GC0 - WS_GB == 48 * MiB && WS_GC1 - WS_GC0 == 48 * MiB, "48 MiB spacing");
            GCfg c{};
            c.e0 = EpiIn{QA, Ub, BC, kmp, ssA};
            c.e1 = EpiC1{(bf16_t*)(ws + WS_GA), MG, args.in[3] + (size_t)layer * NGATE, ssA};
            c.e3 = EpiFfn{ACT, ssB};
            c.A2 = QA; c.B2 = (const bf16_t*)(ws + WS_WP); c.nseg = 1; c.lda = DM; c.ldb = DM; c.nt = DM / 64;
            if (ph == 1) { c.mode = 0; c.N = N1; c.A = xb; c.B = (const bf16_t*)(ws + WS_WIN); }
            else if (ph == 3) { c.mode = 1; c.N = DM; c.nseg = 6; c.A = xb; c.B = (const bf16_t*)(ws + WS_WG); }
            else if (ph == 4) { c.mode = 2; c.N = DM; c.A = MG; c.B = (const bf16_t*)(ws + WS_WO); c.e2 = EpiRes{xb, ssB, (LAS float*)(lds + LDSCTL_OFF + 1024)}; }
            else if (ph == 5) { c.mode = 3; c.N = NGU; c.A = xb; c.B = (const bf16_t*)(ws + WS_WGU); }
            else { c.mode = 2; c.N = DM; c.A = ACT; c.B = (const bf16_t*)(ws + WS_WD); c.lda = DFF; c.ldb = DFF; c.nt = DFF / 64; c.e2 = EpiRes{xb, ssA, (LAS float*)(lds + LDSCTL_OFF + 1024)}; }
            ProbAny P{&c}; EpiAny E{&c}; pg8::StaticOrder S; S.init(M, c.N, G, bx, c.nseg);
            pg8::gemm_phase(lds + RING_OFF, P, S, E);
        }
        xcd_barrier(bar);
    }
}

extern "C" void kernel_launch(void* const* d_in, const int* in_sizes, int n_in, void* d_out, int out_size, void* d_ws, size_t ws_size, hipStream_t stream) {
    static int grid = 0;
    if (grid == 0) {
        if (n_in != 14 || in_sizes[0] != M * DM || out_size != M * DM || ws_size < WS_END) { fprintf(stderr, "kernel_launch: unexpected shapes (n_in %d, in0 %d, out %d, ws %zu)\n", n_in, n_in > 0 ? in_sizes[0] : -1, out_size, ws_size); grid = -1; return; }
        int dev = 0, cus = 0, per_cu = 0;
        if (hipGetDevice(&dev) != hipSuccess || hipDeviceGetAttribute(&cus, hipDeviceAttributeMultiprocessorCount, dev) != hipSuccess) { grid = -1; return; }
        if (hipFuncSetAttribute((const void*)hybrid_fwd, hipFuncAttributeMaxDynamicSharedMemorySize, LDS_BYTES) != hipSuccess) { fprintf(stderr, "kernel_launch: hipFuncSetAttribute failed\n"); grid = -1; return; }
        if (hipOccupancyMaxActiveBlocksPerMultiprocessor(&per_cu, (const void*)hybrid_fwd, NWAVES * 64, LDS_BYTES) != hipSuccess || per_cu < 1) { fprintf(stderr, "kernel_launch: occupancy query says %d blocks/CU\n", per_cu); (void)hipGetLastError(); per_cu = 1; }
        grid = cus;
    }
    if (grid < 0) return;
    if (hipMemsetAsync((char*)d_ws + WS_CTL, 0, CTL_ZERO_BYTES, stream) != hipSuccess) { fprintf(stderr, "kernel_launch: memset failed\n"); return; }
    Args a{};
    for (int i = 0; i < 14; ++i) a.in[i] = (const float*)d_in[i];
    a.out = (float*)d_out; a.ws = (unsigned char*)d_ws;
    void* kargs[] = {&a};
    hipError_t e = hipLaunchCooperativeKernel((const void*)hybrid_fwd, dim3(grid), dim3(NWAVES * 64), kargs, LDS_BYTES, stream);
    if (e != hipSuccess) fprintf(stderr, "kernel_launch: cooperative launch failed: %s (grid %d)\n", hipGetErrorString(e), grid);
}
```

```cpp
#include <hip/hip_runtime.h>
#include <hip/hip_bf16.h>
#include <cstdio>
#include <cstdint>

#define GAS __attribute__((address_space(1)))
#define LAS __attribute__((address_space(3)))
typedef unsigned short bf16_t;
typedef short bf16x8 __attribute__((ext_vector_type(8)));
typedef short s16x4 __attribute__((ext_vector_type(4)));
typedef float f32x2 __attribute__((ext_vector_type(2)));
typedef float f32x4 __attribute__((ext_vector_type(4)));
typedef float f32x16 __attribute__((ext_vector_type(16)));
typedef unsigned u32x2 __attribute__((ext_vector_type(2)));
typedef unsigned u32x4 __attribute__((ext_vector_type(4)));
typedef GAS unsigned gu32;

constexpr int BATCH = 2, SEQ = 8192, DM = 1024, M = BATCH * SEQ, NH = 8, HD = 64, BW = 512, DFF = 2816, DEPTH = 2;
constexpr int NIN = 7680, N1 = 4608, NGATE = 3072, NGU = 2 * DFF;
constexpr float RMS_EPS = 1e-6f;
constexpr float LOG2E = 1.4426950408889634f;
constexpr float C2 = 0.125f * LOG2E;
constexpr int NWAVES = 8;

constexpr size_t MiB = 1u << 20;
constexpr size_t WS_CTL = 0, CTL_ZERO_BYTES = 64 * 1024;
constexpr size_t WS_SSA = 1 * MiB, WS_SSB = 2 * MiB, WS_KM = 3 * MiB;
constexpr size_t WS_WIN = 4 * MiB, WS_WG = 13 * MiB, WS_WP = 19 * MiB, WS_WO = 22 * MiB, WS_WGU = 24 * MiB, WS_WD = 35 * MiB;
constexpr size_t WS_XB = 41 * MiB;
constexpr size_t WS_QA = 73 * MiB, WS_KA = 89 * MiB, WS_VA = 105 * MiB, WS_QS = 121 * MiB, WS_KS = 137 * MiB, WS_VS = 153 * MiB;
constexpr size_t WS_BC = 169 * MiB, WS_U = 185 * MiB, WS_MG = 201 * MiB, WS_X = 233 * MiB;
constexpr size_t WS_GA = WS_KA, WS_GB = WS_KS, WS_GC0 = WS_U, WS_GC1 = WS_X;
constexpr size_t WS_ACT = 73 * MiB;
constexpr size_t WS_END = 256 * MiB;
constexpr int CW_BAR = 4096;

constexpr int RING_OFF = 0, RING_BYTES = 131072;
constexpr int LDSCTL_OFF = RING_BYTES, MISC_OFF = LDSCTL_OFF + 320;
constexpr int LDS_BYTES = 147456;

#define LDS_WAIT() asm volatile("s_waitcnt lgkmcnt(0)" ::: "memory")
#define VM_WAIT() asm volatile("s_waitcnt vmcnt(0)" ::: "memory")
#define RLX_AGENT __ATOMIC_RELAXED, __HIP_MEMORY_SCOPE_AGENT

typedef __bf16 bf16x2_t __attribute__((ext_vector_type(2)));
__device__ __forceinline__ unsigned cvt_pk_bf16(float lo, float hi) { const f32x2 v = {lo, hi}; const bf16x2_t b = __builtin_convertvector(v, bf16x2_t); return __builtin_bit_cast(unsigned, b); }
template <int O> __device__ __forceinline__ float xshfl(float x) {
    static_assert(O < 32, "use sum32 for the two 32-lane halves");
    return __int_as_float(__builtin_amdgcn_ds_swizzle(__float_as_int(x), (O << 10) | 0x1f));
}
__device__ __forceinline__ int lane_id() { return (int)__builtin_amdgcn_mbcnt_hi(~0u, __builtin_amdgcn_mbcnt_lo(~0u, 0u)); }
__device__ __forceinline__ float sum32(float x) { auto rr = __builtin_amdgcn_permlane32_swap(__float_as_uint(x), __float_as_uint(x), false, false); return __uint_as_float(rr[0]) + __uint_as_float(rr[1]); }
__device__ __forceinline__ float bf_lo(unsigned w) { return __uint_as_float(w << 16); }
__device__ __forceinline__ float bf_hi(unsigned w) { return __uint_as_float(w & 0xffff0000u); }
__device__ __forceinline__ float rstd_row(const float* ssp, int row) {
    const f32x4 a = *(const f32x4*)(ssp + (size_t)row * 4);
    return rsqrtf(((a.x + a.y) + (a.z + a.w)) * (1.0f / DM) + RMS_EPS);
}

namespace pg8 {
constexpr int BM = 256, BK = 64, HALF = 128, HTB = HALF * BK * 2, STAGE_BYTES = 8 * HTB, NXCD = 8, WGM = 8;
__host__ __device__ __forceinline__ int lds_byte(int r, int c) { const int st = (r >> 4) * 2 + (c >> 5), rr = r & 15, cc = c & 31, ob = rr * 64 + cc * 2; return st * 1024 + (ob ^ (((ob >> 9) & 1) << 5)); }
__host__ __device__ __forceinline__ void stage_rc(int b, int& R, int& C) { const int st = b / 1024, sb = b % 1024, swz = sb ^ (((sb >> 9) & 1) << 5); R = (st >> 1) * 16 + swz / 64; C = (st & 1) * 32 + (swz % 64) / 2; }
__host__ __device__ __forceinline__ int perm32(int rho) { const int n = rho >> 4, i = rho & 15; return 8 * (i >> 2) + 4 * n + (i & 3); }

struct Unit { int pm, pn, seg; };
struct Seg { const char* A; const char* B; unsigned hA, hB; int lda, ldb, nt; };

struct StaticOrder {
    int nM, nN, nwg, G, c, nseg;
    __device__ void init(int M_, int N_, int G_, int c_, int nseg_) { nM = M_ / BM; nN = N_ / BM; nwg = nM * nN; G = G_; c = c_; nseg = nseg_; }
    __device__ bool next(int i, Unit& u) const {
        const int ti = (nseg == 1) ? i : i / nseg; u.seg = i - ti * nseg;
        const long L = (long)ti * G + c; if (L >= nwg) return false;
        int wgid = (int)L; { const int q = nwg / NXCD, r = nwg % NXCD, xcd = wgid % NXCD, off = wgid / NXCD; wgid = (xcd < r ? xcd * (q + 1) : r * (q + 1) + (xcd - r) * q) + off; }
        const int nig = WGM * nN, gid = wgid / nig, fm = gid * WGM, gsz = (nM - fm) < WGM ? (nM - fm) : WGM;
        u.pm = fm + ((wgid % nig) % gsz); u.pn = (wgid % nig) / gsz; return true;
    }
};

template <class Prob, class Epi, class Sched>
__device__ __forceinline__ void gemm_phase(LAS unsigned char* lds, const Prob& P, const Sched& S, const Epi& E, int wave_) {
    int tid = wave_ * 64 + lane_id(); asm volatile("" : "+v"(tid));
    const int wid = wave_, lane = tid & 63, wr = wid >> 2, wc = wid & 3, fr = lane & 15, fq = lane >> 4;
#define PG8_RC(R0, C0, Rb0) int R0, C0; { int t_ = tid; asm volatile("" : "+v"(t_)); stage_rc(t_ * 16, R0, C0); } const int Rb0 = (R0 & ~31) + perm32(R0 & 31)
    const size_t kstep = (size_t)(BK * 2);
    const unsigned ldsw = (unsigned)wid * 1024u;
    const int aoff = lds_byte(wr * 64 + fr, fq * 8), boff = lds_byte(wc * 32 + fr, fq * 8);
#define PG8_SA(b, h) (((b) * 2 + (h)) * HTB)
#define PG8_SB(b, h) ((4 + (b) * 2 + (h)) * HTB)
#define PG8_STAGE(bufoff, gbase, v0, q) do { \
        __builtin_amdgcn_global_load_lds((const unsigned*)((const char*)(gbase) + (v0)), (LAS unsigned*)(lds + (bufoff) + ldsw), 16, 0, 0); \
        __builtin_amdgcn_global_load_lds((const unsigned*)((const char*)(gbase) + (q) + (v0)), (LAS unsigned*)(lds + (bufoff) + ldsw + 8192), 16, 0, 0); } while (0)
#define PG8_LDA(dst, b, h) do { _Pragma("unroll") for (int m = 0; m < 4; ++m) _Pragma("unroll") for (int k = 0; k < 2; ++k) dst[m][k] = *(const LAS bf16x8*)(lds + PG8_SA(b, h) + aoff + m * 2048 + k * 1024); } while (0)
#define PG8_LDB(dst, b, h) do { _Pragma("unroll") for (int n = 0; n < 2; ++n) _Pragma("unroll") for (int k = 0; k < 2; ++k) dst[n][k] = *(const LAS bf16x8*)(lds + PG8_SB(b, h) + boff + n * 2048 + k * 1024); } while (0)
#define PG8_MMA(ai, bj, At, Bt) do { __builtin_amdgcn_s_setprio(1); _Pragma("unroll") for (int m = 0; m < 4; ++m) _Pragma("unroll") for (int n = 0; n < 2; ++n) _Pragma("unroll") for (int k = 0; k < 2; ++k) \
        acc[ai][bj][m][n] = __builtin_amdgcn_mfma_f32_16x16x32_bf16(Bt[n][k], At[m][k], acc[ai][bj][m][n], 0, 0, 0); __builtin_amdgcn_s_setprio(0); } while (0)
#define PG8_WAIT_V(n) asm volatile("s_waitcnt vmcnt(" #n ")" ::: "memory")
#define PG8_WAIT_L(n) asm volatile("s_waitcnt lgkmcnt(" #n ")" ::: "memory")
#define PG8_BAR __builtin_amdgcn_s_barrier()
#define PG8_SCHED __builtin_amdgcn_sched_barrier(0)
    Unit cur, nxt; int ui = 0;
    if (!S.next(0, cur)) return;
    Seg sc, sn; P.seg(cur, sc);
    unsigned vAc0, vBc0; { PG8_RC(R0, C0, Rb0); vAc0 = (unsigned)(R0 * sc.lda + C0) * 2u; vBc0 = (unsigned)(Rb0 * sc.ldb + C0) * 2u; }
    f32x4 acc[2][2][4][2];
#pragma unroll
    for (int a = 0; a < 2; ++a)
#pragma unroll
        for (int b = 0; b < 2; ++b)
#pragma unroll
            for (int m = 0; m < 4; ++m)
#pragma unroll
                for (int n = 0; n < 2; ++n) acc[a][b][m][n] = (f32x4){0.f, 0.f, 0.f, 0.f};
    bf16x8 At[4][2], B0[2][2], B1[2][2];
    const char* cA = sc.A; const char* cB = sc.B;
    PG8_STAGE(PG8_SB(0, 0), cB, vBc0, sc.hB >> 1); PG8_STAGE(PG8_SB(0, 1), cB + sc.hB, vBc0, sc.hB >> 1); PG8_STAGE(PG8_SA(0, 0), cA, vAc0, sc.hA >> 1); PG8_STAGE(PG8_SA(0, 1), cA + sc.hA, vAc0, sc.hA >> 1);
    if (wr == 1) PG8_BAR;
    PG8_WAIT_V(2); PG8_BAR;
    PG8_STAGE(PG8_SB(1, 0), cB + kstep, vBc0, sc.hB >> 1); PG8_STAGE(PG8_SA(1, 0), cA + kstep, vAc0, sc.hA >> 1); PG8_STAGE(PG8_SB(1, 1), cB + sc.hB + kstep, vBc0, sc.hB >> 1);
    PG8_WAIT_V(6); PG8_BAR;
    for (;;) {
        const bool has_next = S.next(ui + 1, nxt);
        if (has_next) P.seg(nxt, sn); else sn = sc;
        unsigned vAn0, vBn0; { PG8_RC(R0, C0, Rb0); vAn0 = (unsigned)(R0 * sn.lda + C0) * 2u; vBn0 = (unsigned)(Rb0 * sn.ldb + C0) * 2u; }
        const char* nA = sn.A; const char* nB = sn.B;
        const int nt = sc.nt;
        for (int t = 0; t < nt; t += 2) {
            const bool last = (t == nt - 2);
            const char* a1 = cA + (size_t)(t + 1) * kstep;
            const char* a2 = last ? nA : cA + (size_t)(t + 2) * kstep; const char* b2 = last ? nB : cB + (size_t)(t + 2) * kstep;
            const char* a3 = a2 + kstep; const char* b3 = b2 + kstep;
            const unsigned hA2 = last ? sn.hA : sc.hA, hB2 = last ? sn.hB : sc.hB;
            const unsigned vA0 = last ? vAn0 : vAc0, vB0 = last ? vBn0 : vBc0, qA = hA2 >> 1, qB = hB2 >> 1;
            PG8_LDB(B0, 0, 0); PG8_LDB(B1, 0, 1); PG8_SCHED; PG8_LDA(At, 0, 0); PG8_STAGE(PG8_SA(1, 1), a1 + sc.hA, vAc0, sc.hA >> 1);
            PG8_WAIT_V(8); PG8_WAIT_L(0); PG8_BAR; PG8_MMA(0, 0, At, B0); PG8_MMA(0, 1, At, B1); PG8_BAR; PG8_SCHED;
            PG8_LDA(At, 0, 1); PG8_STAGE(PG8_SB(0, 0), b2, vB0, qB); PG8_STAGE(PG8_SB(0, 1), b2 + hB2, vB0, qB); PG8_STAGE(PG8_SA(0, 0), a2, vA0, qA);
            PG8_WAIT_V(8); PG8_WAIT_L(0); PG8_BAR; PG8_MMA(1, 0, At, B0); PG8_MMA(1, 1, At, B1); PG8_BAR; PG8_SCHED;
            PG8_LDB(B0, 1, 0); PG8_LDB(B1, 1, 1); PG8_SCHED; PG8_LDA(At, 1, 0); PG8_STAGE(PG8_SA(0, 1), a2 + hA2, vA0, qA);
            PG8_WAIT_V(8); PG8_WAIT_L(0); PG8_BAR; PG8_MMA(0, 0, At, B0); PG8_MMA(0, 1, At, B1); PG8_BAR; PG8_SCHED;
            PG8_LDA(At, 1, 1); PG8_STAGE(PG8_SB(1, 0), b3, vB0, qB); PG8_STAGE(PG8_SB(1, 1), b3 + hB2, vB0, qB); PG8_STAGE(PG8_SA(1, 0), a3, vA0, qA);
            PG8_WAIT_V(8); PG8_WAIT_L(0); PG8_BAR; PG8_MMA(1, 0, At, B0); PG8_MMA(1, 1, At, B1); PG8_BAR; PG8_SCHED;
        }
        if (wr == 0) PG8_BAR;
        { int wr_ = wr, wc_ = wc, t_ = tid;
          asm volatile("" : "+s"(wr_), "+s"(wc_), "+v"(t_)); const int fr_ = t_ & 15, fq_ = (t_ >> 4) & 3;
          E(acc, cur, wr_, wc_, fr_, fq_); }
        if (!has_next) break;
#pragma unroll
        for (int a = 0; a < 2; ++a)
#pragma unroll
            for (int b = 0; b < 2; ++b)
#pragma unroll
                for (int m = 0; m < 4; ++m)
#pragma unroll
                    for (int n = 0; n < 2; ++n) acc[a][b][m][n] = (f32x4){0.f, 0.f, 0.f, 0.f};
        cur = nxt; sc = sn; cA = nA; cB = nB; vAc0 = vAn0; vBc0 = vBn0; ++ui;
        if (wr == 1) PG8_BAR;
    }
    PG8_WAIT_V(0);
    PG8_BAR;
#undef PG8_SA
#undef PG8_SB
#undef PG8_STAGE
#undef PG8_LDA
#undef PG8_LDB
#undef PG8_MMA
#undef PG8_WAIT_V
#undef PG8_WAIT_L
#undef PG8_BAR
#undef PG8_SCHED
#undef PG8_RC
}
}

#define EPI_ARGS const f32x4 (&acc)[2][2][4][2], const pg8::Unit& u, int wr, int wc, int fr, int fq
__device__ __forceinline__ void st_bf16x8(bf16_t* p, f32x4 v0, f32x4 v1) {
    u32x4 w; w.x = cvt_pk_bf16(v0[0], v0[1]); w.y = cvt_pk_bf16(v0[2], v0[3]); w.z = cvt_pk_bf16(v1[0], v1[1]); w.w = cvt_pk_bf16(v1[2], v1[3]);
    *(u32x4*)p = w;
}
template <class T> __device__ __forceinline__ T* bo(T* base, unsigned byte_off) { return (T*)((char*)base + byte_off); }
template <class T> __device__ __forceinline__ const T* bo(const T* base, unsigned byte_off) { return (const T*)((const char*)base + byte_off); }
__device__ __forceinline__ void ld_bf16x8(const bf16_t* p, f32x4& v0, f32x4& v1) {
    const unsigned long long lo = __hip_atomic_load((const unsigned long long*)p, __ATOMIC_RELAXED, __HIP_MEMORY_SCOPE_AGENT), hi = __hip_atomic_load((const unsigned long long*)p + 1, __ATOMIC_RELAXED, __HIP_MEMORY_SCOPE_AGENT);
    const u32x4 w = {(unsigned)lo, (unsigned)(lo >> 32), (unsigned)hi, (unsigned)(hi >> 32)};
    v0 = (f32x4){bf_lo(w.x), bf_hi(w.x), bf_lo(w.y), bf_hi(w.y)}; v1 = (f32x4){bf_lo(w.z), bf_hi(w.z), bf_lo(w.w), bf_hi(w.w)};
}
__device__ __forceinline__ float rstd4(f32x4 a) { return rsqrtf(((a.x + a.y) + (a.z + a.w)) * (1.0f / DM) + RMS_EPS); }
__device__ __forceinline__ void rstd8(float (&rs)[2][4], const float* ss, int pm, unsigned lrow) {
    const float* ssb = ss + (size_t)pm * 256 * 4; unsigned lsb = lrow * 16u; asm volatile("" : "+v"(lsb));
    f32x4 t[2][4];
#pragma unroll
    for (int ai = 0; ai < 2; ++ai)
#pragma unroll
        for (int m = 0; m < 4; ++m) t[ai][m] = *(const f32x4*)bo(ssb, lsb + (unsigned)(ai * 128 + m * 16) * 16u);
#pragma unroll
    for (int ai = 0; ai < 2; ++ai)
#pragma unroll
        for (int m = 0; m < 4; ++m) rs[ai][m] = rstd4(t[ai][m]);
}
struct EpiIn {
    unsigned char* ws;
    __device__ __forceinline__ void operator()(EPI_ARGS) const {
        bf16_t* qkv = (bf16_t*)(ws + WS_QA); bf16_t* ub = (bf16_t*)(ws + WS_U); bf16_t* bc = (bf16_t*)(ws + WS_BC); float* kmp = (float*)(ws + WS_KM); const float* ss = (const float*)(ws + WS_SSA);
        const int pn = u.pn; unsigned lrow = (unsigned)(wr * 64 + fr), lcol = (unsigned)(wc * 32 + 8 * fq);
        asm volatile("" : "+v"(lrow), "+v"(lcol));
        const unsigned lb = (lrow * BW + lcol) * 2u;
        float rs[2][4]; rstd8(rs, ss, u.pm, lrow);
        if (pn < 12 || pn >= 16) {
            const int t = pn >> 1; const float sc = (t == 0 || t == 3) ? C2 : 1.0f;
            bf16_t* base = (pn < 12 ? qkv + (size_t)t * M * BW + (pn & 1) * 256 : bc + (pn - 16) * 256) + (size_t)u.pm * 256 * BW;
            if (t == 1) {
                float* kp = kmp + (size_t)(u.pm * 2 + wr) * BW + (pn & 1) * 256;
#pragma unroll
                for (int bj = 0; bj < 2; ++bj)
#pragma unroll
                    for (int n = 0; n < 2; ++n) { f32x4 s = {0.f, 0.f, 0.f, 0.f};
#pragma unroll
                        for (int ai = 0; ai < 2; ++ai)
#pragma unroll
                            for (int m = 0; m < 4; ++m) s += acc[ai][bj][m][n] * rs[ai][m];
#pragma unroll
                        for (int e = 0; e < 4; ++e) { s[e] += xshfl<1>(s[e]); s[e] += xshfl<2>(s[e]); s[e] += xshfl<4>(s[e]); s[e] += xshfl<8>(s[e]); }
                        if (fr == 0) *(f32x4*)bo(kp, (lcol + (unsigned)(bj * 128 + 4 * n)) * 4u) = s; }
            }
#pragma unroll
            for (int ai = 0; ai < 2; ++ai)
#pragma unroll
                for (int m = 0; m < 4; ++m) { const float f = rs[ai][m] * sc; const unsigned o = lb + (unsigned)(ai * 128 + m * 16) * BW * 2u;
#pragma unroll
                    for (int bj = 0; bj < 2; ++bj) st_bf16x8(bo(base, o + bj * 256u), acc[ai][bj][m][0] * f, acc[ai][bj][m][1] * f); }
        } else {
            bf16_t* base = ub + (size_t)u.pm * 256 * BW + (pn - 12) * 128;
#pragma unroll
            for (int ai = 0; ai < 2; ++ai)
#pragma unroll
                for (int m = 0; m < 4; ++m) { const float f = rs[ai][m] * rs[ai][m];
                    st_bf16x8(bo(base, lb + (unsigned)(ai * 128 + m * 16) * BW * 2u), acc[ai][0][m][0] * acc[ai][1][m][0] * f, acc[ai][0][m][1] * acc[ai][1][m][1] * f); }
        }
    }
};
struct EpiC1 {
    unsigned char* ws; const float* bgate;
    __device__ __forceinline__ bf16_t* gtile(int s, int pm, int pn) const {
        const size_t off = WS_GA + (size_t)s * (48 * MiB) + ((s == 2 && pm >= 32) ? 32 * MiB : 0) + ((size_t)pm * 256 * DM + pn * 256) * 2;
        return (bf16_t*)(ws + off);
    }
    __device__ __forceinline__ void operator()(EPI_ARGS) const {
        bf16_t* mg = (bf16_t*)(ws + WS_MG); const float* ss = (const float*)(ws + WS_SSA);
        const int sg = u.seg; unsigned lrow = (unsigned)(wr * 64 + fr), lcol = (unsigned)(wc * 32 + 8 * fq);
        asm volatile("" : "+v"(lrow), "+v"(lcol));
        const unsigned lb = (lrow * DM + lcol) * 2u;
        bf16_t* gp = gtile(sg < 3 ? sg : sg - 3, u.pm, u.pn);
        if (sg < 3) {
            const float* bg = bgate + sg * DM + u.pn * 256;
            f32x4 bv[2][2];
#pragma unroll
            for (int bj = 0; bj < 2; ++bj) { bv[bj][0] = *(const f32x4*)bo(bg, (lcol + bj * 128u) * 4u) * (-LOG2E); bv[bj][1] = *(const f32x4*)bo(bg, (lcol + bj * 128u + 4u) * 4u) * (-LOG2E); }
            float rs[2][4]; rstd8(rs, ss, u.pm, lrow);
#pragma unroll
            for (int ai = 0; ai < 2; ++ai)
#pragma unroll
                for (int m = 0; m < 4; ++m) { const float rn = rs[ai][m] * (-LOG2E); const unsigned o = lb + (unsigned)(ai * 128 + m * 16) * DM * 2u;
#pragma unroll
                    for (int bj = 0; bj < 2; ++bj) { f32x4 v[2];
#pragma unroll
                        for (int n = 0; n < 2; ++n) { const f32x4 x = acc[ai][bj][m][n] * rn + bv[bj][n];
#pragma unroll
                            for (int e = 0; e < 4; ++e) v[n][e] = __builtin_amdgcn_rcpf(1.0f + __builtin_amdgcn_exp2f(x[e])); }
                        st_bf16x8(bo(gp, o + bj * 256u), v[0], v[1]); } }
        } else {
            bf16_t* mp = mg + (size_t)u.pm * 256 * DM + u.pn * 256;
#pragma unroll
            for (int am = 0; am < 4; ++am) {
                const int ai = am >> 1, m0 = (am & 1) * 2;
                u32x4 gw_[2][2], pw_[2][2];
#pragma unroll
                for (int mm = 0; mm < 2; ++mm)
#pragma unroll
                    for (int bj = 0; bj < 2; ++bj) { const unsigned o = lb + (unsigned)(ai * 128 + (m0 + mm) * 16) * DM * 2u + bj * 256u;
                        gw_[mm][bj] = *(const u32x4*)bo((const bf16_t*)gp, o); if (sg > 3) pw_[mm][bj] = *(const u32x4*)bo((const bf16_t*)mp, o); }
#pragma unroll
                for (int mm = 0; mm < 2; ++mm)
#pragma unroll
                    for (int bj = 0; bj < 2; ++bj) { const int m = m0 + mm; const unsigned o = lb + (unsigned)(ai * 128 + m * 16) * DM * 2u + bj * 256u; const u32x4 g = gw_[mm][bj];
                        f32x4 v0 = acc[ai][bj][m][0] * (f32x4){bf_lo(g.x), bf_hi(g.x), bf_lo(g.y), bf_hi(g.y)}, v1 = acc[ai][bj][m][1] * (f32x4){bf_lo(g.z), bf_hi(g.z), bf_lo(g.w), bf_hi(g.w)};
                        if (sg > 3) { const u32x4 p = pw_[mm][bj]; v0 += (f32x4){bf_lo(p.x), bf_hi(p.x), bf_lo(p.y), bf_hi(p.y)}; v1 += (f32x4){bf_lo(p.z), bf_hi(p.z), bf_lo(p.w), bf_hi(p.w)}; }
                        st_bf16x8(bo(mp, o), v0, v1); }
                asm volatile("" ::: "memory");
            }
        }
    }
};
struct EpiRes {
    unsigned char* ws; int toA; LAS float* red;
    __device__ __forceinline__ void operator()(EPI_ARGS) const {
        bf16_t* xb = (bf16_t*)(ws + WS_XB); float* sso = (float*)(ws + (toA ? WS_SSA : WS_SSB));
        unsigned lrow = (unsigned)(wr * 64 + fr), lcol = (unsigned)(wc * 32 + 8 * fq);
        asm volatile("" : "+v"(lrow), "+v"(lcol));
        const unsigned le = (lrow * DM + lcol) * 2u, lr4 = lrow * 4u + (unsigned)wc;
        bf16_t* xp = xb + (size_t)u.pm * 256 * DM + u.pn * 256;
#pragma unroll
        for (int ai = 0; ai < 2; ++ai) {
            u32x4 bs[4][2];
#pragma unroll
            for (int m = 0; m < 4; ++m)
#pragma unroll
                for (int bj = 0; bj < 2; ++bj) bs[m][bj] = *(const u32x4*)bo((const bf16_t*)xp, le + (unsigned)(ai * 128 + m * 16) * DM * 2u + bj * 256u);
#pragma unroll
            for (int m = 0; m < 4; ++m) { float sq = 0.f;
#pragma unroll
                for (int bj = 0; bj < 2; ++bj) { const u32x4 w = bs[m][bj];
                    const f32x4 x0 = (f32x4){bf_lo(w.x), bf_hi(w.x), bf_lo(w.y), bf_hi(w.y)} + acc[ai][bj][m][0], x1 = (f32x4){bf_lo(w.z), bf_hi(w.z), bf_lo(w.w), bf_hi(w.w)} + acc[ai][bj][m][1];
                    st_bf16x8(bo(xp, le + (unsigned)(ai * 128 + m * 16) * DM * 2u + bj * 256u), x0, x1);
                    sq += (x0[0] * x0[0] + x0[1] * x0[1]) + (x0[2] * x0[2] + x0[3] * x0[3]) + (x1[0] * x1[0] + x1[1] * x1[1]) + (x1[2] * x1[2] + x1[3] * x1[3]); }
                sq += xshfl<16>(sq); sq = sum32(sq);
                if (fq == 0) red[lr4 + (unsigned)(ai * 128 + m * 16) * 4u] = sq; }
            asm volatile("" ::: "memory");
        }
        asm volatile("s_waitcnt lgkmcnt(0)\n\ts_barrier" ::: "memory");
        { const int t = ((wr * 4 + wc) * 4 + fq) * 16 + fr; if (t < 256) { const f32x4 r = *(const LAS f32x4*)(red + t * 4); sso[((size_t)u.pm * 256 + t) * 4 + u.pn] = (r.x + r.y) + (r.z + r.w); } }
        asm volatile("s_waitcnt lgkmcnt(0)\n\ts_barrier" ::: "memory");
    }
};
struct EpiFfn {
    unsigned char* ws;
    __device__ __forceinline__ void operator()(EPI_ARGS) const {
        bf16_t* act = (bf16_t*)(ws + WS_ACT); const float* ss = (const float*)(ws + WS_SSB);
        unsigned lrow = (unsigned)(wr * 64 + fr), lcol = (unsigned)(wc * 32 + 8 * fq);
        asm volatile("" : "+v"(lrow), "+v"(lcol));
        const unsigned lb = (lrow * DFF + lcol) * 2u;
        bf16_t* ap = act + (size_t)u.pm * 256 * DFF + u.pn * 128;
        float rs[2][4]; rstd8(rs, ss, u.pm, lrow);
#pragma unroll
        for (int ai = 0; ai < 2; ++ai)
#pragma unroll
            for (int m = 0; m < 4; ++m) { const float r1 = rs[ai][m], rn = r1 * (-LOG2E); f32x4 v[2];
#pragma unroll
                for (int n = 0; n < 2; ++n) { const f32x4 g = acc[ai][0][m][n], up = acc[ai][1][m][n] * (r1 * r1);
#pragma unroll
                    for (int e = 0; e < 4; ++e) v[n][e] = g[e] * up[e] * __builtin_amdgcn_rcpf(1.0f + __builtin_amdgcn_exp2f(g[e] * rn)); }
                st_bf16x8(bo(ap, lb + (unsigned)(ai * 128 + m * 16) * DFF * 2u), v[0], v[1]); }
    }
};

struct GCfg {
    int mode;
    int N, nseg, lda, ldb, nt, toA;
    const bf16_t* A; const bf16_t* B;
    unsigned char* ws; const float* bgate; LAS float* red;
};
struct ProbAny {
    const GCfg* c;
    __device__ __forceinline__ void seg(const pg8::Unit& u, pg8::Seg& s) const {
        if (c->mode == 1 && u.seg >= 3) {
            const int br = u.seg - 3; const bf16_t* O = (const bf16_t*)(c->ws + WS_QA + (size_t)br * (48 * MiB)); const bf16_t* Wp = (const bf16_t*)(c->ws + WS_WP);
            s.A = (const char*)(O + (size_t)u.pm * 256 * BW); s.B = (const char*)(Wp + ((size_t)br * DM + (size_t)u.pn * 256) * BW);
            s.hA = 128u * BW * 2u; s.hB = 128u * BW * 2u; s.lda = BW; s.ldb = BW; s.nt = BW / 64;
        } else {
            const int so = (c->mode == 1) ? u.seg * DM : 0;
            s.A = (const char*)(c->A + (size_t)u.pm * 256 * c->lda); s.B = (const char*)(c->B + ((size_t)so + (size_t)u.pn * 256) * c->ldb);
            s.hA = 128u * (unsigned)c->lda * 2u; s.hB = 128u * (unsigned)c->ldb * 2u; s.lda = c->lda; s.ldb = c->ldb; s.nt = c->nt;
        }
    }
};
struct EpiAny {
    const GCfg* c;
    __device__ __forceinline__ void operator()(EPI_ARGS) const {
        const int m_ = c->mode;
        if (m_ == 0) EpiIn{c->ws}(acc, u, wr, wc, fr, fq);
        else if (m_ == 1) EpiC1{c->ws, c->bgate}(acc, u, wr, wc, fr, fq);
        else if (m_ == 2) EpiRes{c->ws, c->toA, c->red}(acc, u, wr, wc, fr, fq);
        else EpiFfn{c->ws}(acc, u, wr, wc, fr, fq);
    }
};

namespace att {
__device__ __forceinline__ constexpr int crow(int r, int hi) { return (r & 3) + 8 * (r >> 2) + 4 * hi; }
__device__ __forceinline__ float swap_lo(float x, float& hiv) { auto rr = __builtin_amdgcn_permlane32_swap(__float_as_uint(x), __float_as_uint(x), false, false); hiv = __uint_as_float(rr[1]); return __uint_as_float(rr[0]); }
__device__ __forceinline__ s16x4 vtr(const LAS unsigned char* p) { return __builtin_bit_cast(s16x4, __builtin_amdgcn_ds_read_tr16_b64_v4i16((LAS s16x4*)p)); }
__device__ __forceinline__ void load_k(bf16x8 (&kf)[8], const bf16_t* Kh, int j0, int r32, int hi) {
    const bf16_t* p = Kh + (size_t)(j0 + r32) * BW + hi * 8;
#pragma unroll
    for (int d0 = 0; d0 < 4; ++d0) { kf[2 * d0] = *(const bf16x8*)(p + d0 * 16); kf[2 * d0 + 1] = *(const bf16x8*)(p + (size_t)32 * BW + d0 * 16); }
}
__device__ __forceinline__ void load_v(u32x4 (&vv)[8], const bf16_t* Vh, int j0, int lane) {
    const bf16_t* p = Vh + (size_t)(j0 + (lane >> 3)) * BW + (lane & 7) * 8;
#pragma unroll
    for (int i = 0; i < 8; ++i) vv[i] = *(const u32x4*)(p + (size_t)(8 * i) * BW);
}
__device__ __forceinline__ void stage_v(LAS unsigned char* vst, const u32x4 (&vv)[8], int lane) {
    const int c = lane & 7;
#pragma unroll
    for (int i = 0; i < 8; ++i) { const int key = 8 * i + (lane >> 3);
        *(LAS u32x4*)(vst + ((c >> 2) * 4 + (key >> 4)) * 1024 + (key & 15) * 64 + (c & 3) * 16) = vv[i]; }
}
__device__ __forceinline__ void qk(f32x16& p0, f32x16& p1, const bf16x8 (&kf)[8], const bf16x8 (&qr)[4]) {
#pragma unroll
    for (int d0 = 0; d0 < 4; ++d0) { p0 = __builtin_amdgcn_mfma_f32_32x32x16_bf16(kf[2 * d0], qr[d0], p0, 0, 0, 0); p1 = __builtin_amdgcn_mfma_f32_32x32x16_bf16(kf[2 * d0 + 1], qr[d0], p1, 0, 0, 0); }
}
__device__ __forceinline__ void pv(f32x16& o0, f32x16& o1, const f32x16& p0, const f32x16& p1, const LAS unsigned char* vst, int lane) {
    const int hi = lane >> 5;
    const LAS unsigned char* vp = vst + ((lane >> 4) & 1) * 32 + (lane & 3) * 8 + (4 * hi + ((lane & 15) >> 2)) * 64;
    u32x4 pw[4];
    pw[0] = (u32x4){cvt_pk_bf16(p0[0], p0[1]), cvt_pk_bf16(p0[2], p0[3]), cvt_pk_bf16(p0[4], p0[5]), cvt_pk_bf16(p0[6], p0[7])};
    pw[1] = (u32x4){cvt_pk_bf16(p0[8], p0[9]), cvt_pk_bf16(p0[10], p0[11]), cvt_pk_bf16(p0[12], p0[13]), cvt_pk_bf16(p0[14], p0[15])};
    pw[2] = (u32x4){cvt_pk_bf16(p1[0], p1[1]), cvt_pk_bf16(p1[2], p1[3]), cvt_pk_bf16(p1[4], p1[5]), cvt_pk_bf16(p1[6], p1[7])};
    pw[3] = (u32x4){cvt_pk_bf16(p1[8], p1[9]), cvt_pk_bf16(p1[10], p1[11]), cvt_pk_bf16(p1[12], p1[13]), cvt_pk_bf16(p1[14], p1[15])};
#pragma unroll
    for (int ks = 0; ks < 4; ++ks) {
        const s16x4 a0 = vtr(vp + ks * 1024), a1 = vtr(vp + ks * 1024 + 512), b0 = vtr(vp + 4096 + ks * 1024), b1 = vtr(vp + 4096 + ks * 1024 + 512);
        const bf16x8 v0 = {a0[0], a0[1], a0[2], a0[3], a1[0], a1[1], a1[2], a1[3]}, v1 = {b0[0], b0[1], b0[2], b0[3], b1[0], b1[1], b1[2], b1[3]};
        const bf16x8 pa = __builtin_bit_cast(bf16x8, pw[ks]);
        o0 = __builtin_amdgcn_mfma_f32_32x32x16_bf16(pa, v0, o0, 0, 0, 0);
        o1 = __builtin_amdgcn_mfma_f32_32x32x16_bf16(pa, v1, o1, 0, 0, 0);
    }
}
__device__ __forceinline__ void store_o(bf16_t* Ow, const f32x16& o0, const f32x16& o1, const float (&rsc)[16], LAS unsigned char* stg, int lane) {
    const int r32 = lane & 31, hi = lane >> 5;
    LAS bf16_t* s = (LAS bf16_t*)stg;
#pragma unroll
    for (int r = 0; r < 16; ++r) { const int orow = crow(r, hi);
        s[orow * 64 + r32] = (bf16_t)(cvt_pk_bf16(o0[r] * rsc[r], 0.f) & 0xffffu); s[orow * 64 + 32 + r32] = (bf16_t)(cvt_pk_bf16(o1[r] * rsc[r], 0.f) & 0xffffu); }
    LDS_WAIT();
#pragma unroll
    for (int i = 0; i < 4; ++i) { const int row = i * 8 + (lane >> 3), ch = lane & 7; const u32x4 v = *(const LAS u32x4*)(stg + row * 128 + ch * 16); *(u32x4*)(Ow + (size_t)row * BW + ch * 8) = v; }
    LDS_WAIT();
}

__device__ __forceinline__ void sb_item(bf16_t* Q, const bf16_t* K, const bf16_t* V, int b, int h, int q0, LAS unsigned char* vst, int lane) {
    asm volatile("" : "+v"(lane));
    const int r32 = lane & 31, hi = lane >> 5;
    const size_t rowbase = (size_t)b * SEQ;
    bf16_t* Qw = Q + (rowbase + q0) * BW + h * HD;
    bf16x8 qr[4];
#pragma unroll
    for (int d0 = 0; d0 < 4; ++d0) qr[d0] = *(const bf16x8*)(Qw + (size_t)r32 * BW + d0 * 16 + hi * 8);
    const bf16_t* Kh = K + rowbase * BW + h * HD; const bf16_t* Vh = V + rowbase * BW + h * HD;
    f32x16 o0 = {}, o1 = {}; float A2 = 0.f;
    const int tq = q0 + r32;
    bf16x8 kf[8]; load_k(kf, Kh, ((q0 + 30) >> 6) * 64, r32, hi);
    for (int kt = (q0 + 30) >> 6; kt >= 0; --kt) {
        const int j0 = kt * 64;
        f32x16 p0 = {}, p1 = {};
        qk(p0, p1, kf, qr);
        asm volatile("" : "+v"(p0), "+v"(p1) :: "memory");
        u32x4 vv[8]; load_v(vv, Vh, j0, lane);
        if (kt > 0) load_k(kf, Kh, j0 - 64, r32, hi);
        const bool diag = (j0 + 63 >= q0);
        f32x16 l0, l1;
#pragma unroll
        for (int r = 0; r < 16; ++r) {
            { const float z = p0[r]; const float t = __builtin_amdgcn_exp2f(-__builtin_fabsf(z)); float l = -(__builtin_fmaxf(z, 0.f) + __builtin_amdgcn_logf(1.0f + t)); if (diag && (j0 + crow(r, hi) >= tq)) l = 0.f; l0[r] = l; }
            { const float z = p1[r]; const float t = __builtin_amdgcn_exp2f(-__builtin_fabsf(z)); float l = -(__builtin_fmaxf(z, 0.f) + __builtin_amdgcn_logf(1.0f + t)); if (diag && (j0 + 32 + crow(r, hi) >= tq)) l = 0.f; l1[r] = l; }
        }
        float carry = A2;
#pragma unroll
        for (int half = 1; half >= 0; --half) {
            f32x16& l = half ? l1 : l0; f32x16& p = half ? p1 : p0;
            float T[4];
#pragma unroll
            for (int g = 0; g < 4; ++g) { l[4 * g + 2] += l[4 * g + 3]; l[4 * g + 1] += l[4 * g + 2]; l[4 * g] += l[4 * g + 1]; T[g] = l[4 * g]; }
            float Tl[4], Th[4];
#pragma unroll
            for (int g = 0; g < 4; ++g) Tl[g] = swap_lo(T[g], Th[g]);
            float E = carry;
#pragma unroll
            for (int g = 3; g >= 0; --g) { const float eh = E; E += Th[g]; const float el = E; E += Tl[g]; const float off = hi ? eh : el;
                l[4 * g] += off; l[4 * g + 1] += off; l[4 * g + 2] += off; l[4 * g + 3] += off; }
            carry = E;
#pragma unroll
            for (int r = 0; r < 16; ++r) { float w = __builtin_amdgcn_exp2f(p[r] + l[r]); if (diag && (j0 + 32 * half + crow(r, hi) >= tq)) w = 0.f; p[r] = w; }
        }
        A2 = carry;
        stage_v(vst, vv, lane); LDS_WAIT();
        pv(o0, o1, p0, p1, vst, lane);
        LDS_WAIT();
        if (__all(A2 < -150.2f)) break;
    }
    float one[16];
#pragma unroll
    for (int r = 0; r < 16; ++r) one[r] = 1.0f;
    store_o(Qw, o0, o1, one, vst, lane);
}

constexpr float MOBA_THR = 8.0f;
__device__ __forceinline__ unsigned moba_gate(const bf16_t* Qw, const bf16_t* Kown, int blk, int tq0, float sl2, const LAS float* km, const LAS float* kbn, int lane) {
    asm volatile("" : "+v"(lane));
    const int r32 = lane & 31, hi = lane >> 5;
    unsigned sel = 0u;
    if (blk > 0) {
        float qf[64];
        { const u32x4* qp = (const u32x4*)(Qw + (size_t)r32 * BW);
#pragma unroll
          for (int c = 0; c < 8; ++c) { const u32x4 x = qp[c]; qf[8 * c] = bf_lo(x.x); qf[8 * c + 1] = bf_hi(x.x); qf[8 * c + 2] = bf_lo(x.y); qf[8 * c + 3] = bf_hi(x.y); qf[8 * c + 4] = bf_lo(x.z); qf[8 * c + 5] = bf_hi(x.z); qf[8 * c + 6] = bf_lo(x.w); qf[8 * c + 7] = bf_hi(x.w); } }
        float v1 = -INFINITY, v2 = -INFINITY, v3 = -INFINITY; int i1 = -1, i2 = -1, i3 = -1;
#define TOP_INS(v, n) do { const bool b1 = (v) > v1 || ((v) == v1 && (n) < i1), b2 = (v) > v2 || ((v) == v2 && (n) < i2), b3 = (v) > v3 || ((v) == v3 && (n) < i3); \
            if (b3) { if (b2) { v3 = v2; i3 = i2; if (b1) { v2 = v1; i2 = i1; v1 = (v); i1 = (n); } else { v2 = (v); i2 = (n); } } else { v3 = (v); i3 = (n); } } } while (0)
#pragma unroll 1
        for (int i = 0; i < 16; ++i) { const int n = 16 * hi + i;
            const LAS f32x4* kr = (const LAS f32x4*)(km + n * 64); float d0 = 0.f, d1 = 0.f, d2 = 0.f, d3 = 0.f;
#pragma unroll
            for (int c = 0; c < 16; ++c) { const f32x4 kk = kr[c]; d0 += qf[4 * c] * kk[0]; d1 += qf[4 * c + 1] * kk[1]; d2 += qf[4 * c + 2] * kk[2]; d3 += qf[4 * c + 3] * kk[3]; }
            const float d = (d0 + d1) + (d2 + d3);
            if (n < blk) TOP_INS(d, n); }
        { float x0, x1; x0 = swap_lo(v1, x1); const float pv1 = hi ? x0 : x1; x0 = swap_lo(v2, x1); const float pv2 = hi ? x0 : x1; x0 = swap_lo(v3, x1); const float pv3 = hi ? x0 : x1;
          x0 = swap_lo(__int_as_float(i1), x1); const int pi1 = __float_as_int(hi ? x0 : x1); x0 = swap_lo(__int_as_float(i2), x1); const int pi2 = __float_as_int(hi ? x0 : x1); x0 = swap_lo(__int_as_float(i3), x1); const int pi3 = __float_as_int(hi ? x0 : x1);
          TOP_INS(pv1, pi1); TOP_INS(pv2, pi2); TOP_INS(pv3, pi3); }
#undef TOP_INS
        float qn2 = 0.f, zs = 0.f;
        { const u32x4* kp = (const u32x4*)(Kown + (size_t)r32 * BW);
#pragma unroll
          for (int c = 0; c < 8; ++c) { const u32x4 x = kp[c];
              zs += qf[8 * c] * bf_lo(x.x) + qf[8 * c + 1] * bf_hi(x.x) + qf[8 * c + 2] * bf_lo(x.y) + qf[8 * c + 3] * bf_hi(x.y) + qf[8 * c + 4] * bf_lo(x.z) + qf[8 * c + 5] * bf_hi(x.z) + qf[8 * c + 6] * bf_lo(x.w) + qf[8 * c + 7] * bf_hi(x.w);
              qn2 += (qf[8 * c] * qf[8 * c] + qf[8 * c + 1] * qf[8 * c + 1]) + (qf[8 * c + 2] * qf[8 * c + 2] + qf[8 * c + 3] * qf[8 * c + 3]) + (qf[8 * c + 4] * qf[8 * c + 4] + qf[8 * c + 5] * qf[8 * c + 5]) + (qf[8 * c + 6] * qf[8 * c + 6] + qf[8 * c + 7] * qf[8 * c + 7]); } }
        const float qn = sqrtf(qn2) * 1.001f, thr = zs - 151.0f; const int tq = tq0 + r32;
#define KEEP(i_) ((i_) >= 0 && !(qn * kbn[(i_)] - sl2 * (float)(tq - (256 * (i_) + 255)) < thr))
        if (KEEP(i1)) sel |= 1u << i1; if (KEEP(i2)) sel |= 1u << i2; if (KEEP(i3)) sel |= 1u << i3;
#undef KEEP
    }
    return sel;
}
__device__ __forceinline__ void moba_tile(f32x16& o0, f32x16& o1, float& mrow, float& lsum, const bf16x8 (&qr)[4], bf16x8 (&kf)[8], const bf16_t* Kh, const bf16_t* Vh, int j0, int jn, float lb, float sl2, bool diag, int tq,
                                          LAS unsigned char* vst, LAS float* wsf, int lane) {
    const int r32 = lane & 31, hi = lane >> 5;
    f32x16 p0, p1;
#pragma unroll
    for (int r = 0; r < 16; ++r) { p0[r] = lb; p1[r] = lb + 32.0f * sl2; }
    qk(p0, p1, kf, qr);
    asm volatile("" : "+v"(p0), "+v"(p1) :: "memory");
    u32x4 vv[8]; load_v(vv, Vh, j0, lane);
    if (jn >= 0) load_k(kf, Kh, jn, r32, hi);
#pragma unroll
    for (int r = 0; r < 16; ++r) { p0[r] = __builtin_fmaf(sl2, (float)crow(r, 0), p0[r]); p1[r] = __builtin_fmaf(sl2, (float)crow(r, 0), p1[r]); }
    if (diag) {
#pragma unroll
        for (int r = 0; r < 16; ++r) { if (j0 + crow(r, hi) > tq) p0[r] = -INFINITY; if (j0 + 32 + crow(r, hi) > tq) p1[r] = -INFINITY; }
    }
    float rm = __builtin_fmaxf(p0[0], p1[0]);
#pragma unroll
    for (int r = 1; r < 16; ++r) rm = __builtin_fmaxf(rm, __builtin_fmaxf(p0[r], p1[r]));
    { float x1; const float x0 = swap_lo(rm, x1); rm = __builtin_fmaxf(x0, x1); }
    if (__any(rm > mrow + MOBA_THR)) {
        const float mn = __builtin_fmaxf(mrow, rm); const float f = __builtin_amdgcn_exp2f(mrow - mn); mrow = mn; lsum *= f;
        if (hi == 0) wsf[r32] = f;
        LDS_WAIT();
#pragma unroll
        for (int r = 0; r < 16; ++r) { const float fr_ = wsf[crow(r, hi)]; o0[r] *= fr_; o1[r] *= fr_; }
        LDS_WAIT();
    }
    float ps = 0.f;
#pragma unroll
    for (int r = 0; r < 16; ++r) { p0[r] = __builtin_amdgcn_exp2f(p0[r] - mrow); p1[r] = __builtin_amdgcn_exp2f(p1[r] - mrow); ps += p0[r] + p1[r]; }
    lsum += ps;
    stage_v(vst, vv, lane); LDS_WAIT();
    pv(o0, o1, p0, p1, vst, lane);
    LDS_WAIT();
}
__device__ __forceinline__ void moba_item(const bf16_t* Q, const bf16_t* K, const bf16_t* V, int b, int h, int blk, int n, int tix, const LAS unsigned char* lists, const LAS unsigned* cnt,
                                          const LAS unsigned* selm, unsigned char* recO, float* recML, LAS unsigned char* vst, LAS float* wsf, LAS unsigned* trow, int lane) {
    asm volatile("" : "+v"(lane));
    const int r32 = lane & 31, hi = lane >> 5; const size_t rowbase = (size_t)b * SEQ; const bool own = (n == blk);
    int q; bool valid; unsigned slot;
    if (own) { q = 32 * tix + r32; valid = true; slot = (unsigned)q * 4u + 3u; }
    else { const int cn = (int)cnt[n]; const int p = 32 * tix + r32; valid = p < cn; q = (int)lists[n * 256 + (valid ? p : cn - 1)];
           slot = (unsigned)q * 4u + (unsigned)__builtin_popcount(selm[q] & ((1u << n) - 1u)); }
    if (hi == 0) trow[r32] = slot | (valid ? 0x80000000u : 0u);
    const int tq = blk * 256 + q;
    const bf16_t* Qrow = Q + (rowbase + tq) * BW + h * HD + hi * 8;
    bf16x8 qr[4];
#pragma unroll
    for (int d0 = 0; d0 < 4; ++d0) qr[d0] = *(const bf16x8*)(Qrow + d0 * 16);
    const bf16_t* Kh = K + rowbase * BW + h * HD; const bf16_t* Vh = V + rowbase * BW + h * HD;
    const float sl2 = __builtin_amdgcn_exp2f(-(float)(h + 1)) * LOG2E;
    f32x16 o0 = {}, o1 = {}; float mrow = -INFINITY, lsum = 0.f;
    const int ntile = own ? (tix >> 1) + 1 : 4;
    bf16x8 kf[8]; load_k(kf, Kh, n * 256, r32, hi);
#pragma unroll 1
    for (int i = 0; i < ntile; ++i) { const int j0 = n * 256 + i * 64;
        moba_tile(o0, o1, mrow, lsum, qr, kf, Kh, Vh, j0, i < ntile - 1 ? j0 + 64 : -1, sl2 * (float)(j0 + 4 * hi - tq), sl2, own && i == ntile - 1, tq, vst, wsf, lane); }
    { float x1; const float x0 = swap_lo(lsum, x1); lsum = x0 + x1; }
    if (hi == 0) { wsf[32 + r32] = lsum; if (valid) *(f32x2*)(recML + 2 * slot) = (f32x2){mrow, lsum}; }
    LDS_WAIT();
    LAS bf16_t* s = (LAS bf16_t*)vst;
#pragma unroll
    for (int r = 0; r < 16; ++r) { const int orow = crow(r, hi); const float rl = __builtin_amdgcn_rcpf(wsf[32 + orow]);
        s[orow * 64 + r32] = (bf16_t)(cvt_pk_bf16(o0[r] * rl, 0.f) & 0xffffu); s[orow * 64 + 32 + r32] = (bf16_t)(cvt_pk_bf16(o1[r] * rl, 0.f) & 0xffffu); }
    LDS_WAIT();
#pragma unroll
    for (int i = 0; i < 4; ++i) { const int row = i * 8 + (lane >> 3), ch = lane & 7; const unsigned tr = trow[row]; const u32x4 v = *(const LAS u32x4*)(vst + row * 128 + ch * 16);
        if (tr & 0x80000000u) *(u32x4*)(recO + (size_t)(tr & 0x7fffffffu) * 128 + ch * 16) = v; }
    LDS_WAIT();
}
__device__ __forceinline__ void moba_merge(bf16_t* Q, int b, int h, int blk, int w, const LAS unsigned* selm, const unsigned char* recO, const float* recML, LAS float* wsf, int lane) {
    asm volatile("" : "+v"(lane));
    const int r32 = lane & 31, hi = lane >> 5; const size_t rowbase = (size_t)b * SEQ; const int q0 = blk * 256 + w * 32;
    const int ql = w * 32 + r32; const int c = __builtin_popcount(selm[ql]);
    float mi[4], li[4]; float mx = -INFINITY;
#pragma unroll
    for (int k = 0; k < 4; ++k) { mi[k] = -INFINITY; li[k] = 0.f; if (k == 3 || k < c) { const f32x2 ml = __builtin_nontemporal_load((const f32x2*)(recML + 2 * ((unsigned)ql * 4u + k))); mi[k] = ml.x; li[k] = ml.y; } mx = __builtin_fmaxf(mx, mi[k]); }
    float wg[4], L = 0.f;
#pragma unroll
    for (int k = 0; k < 4; ++k) { wg[k] = (k == 3 || k < c) ? __builtin_amdgcn_exp2f(mi[k] - mx) * li[k] : 0.f; L += wg[k]; }
    const float rL = 1.0f / L;
    if (hi == 0) { wsf[r32] = wg[0] * rL; wsf[32 + r32] = wg[1] * rL; wsf[64 + r32] = wg[2] * rL; wsf[96 + r32] = wg[3] * rL; }
    LDS_WAIT();
    bf16_t* Qw = Q + (rowbase + q0) * BW + h * HD;
#pragma unroll
    for (int i = 0; i < 4; ++i) { const int row = i * 8 + (lane >> 3), ch = lane & 7; f32x4 v0 = {0.f, 0.f, 0.f, 0.f}, v1 = {0.f, 0.f, 0.f, 0.f};
        const unsigned rslot = (unsigned)(w * 32 + row) * 4u;
#pragma unroll
        for (int k = 0; k < 4; ++k) { const float ak = wsf[32 * k + row];
            if (ak != 0.f) { const u32x4 pw = __builtin_nontemporal_load((const u32x4*)(recO + (size_t)(rslot + k) * 128 + ch * 16));
                v0 += ak * (f32x4){bf_lo(pw.x), bf_hi(pw.x), bf_lo(pw.y), bf_hi(pw.y)}; v1 += ak * (f32x4){bf_lo(pw.z), bf_hi(pw.z), bf_lo(pw.w), bf_hi(pw.w)}; } }
        st_bf16x8(Qw + (size_t)row * BW + ch * 8, v0, v1); }
    LDS_WAIT();
}
}

#define XB_TMO      128
#define XB_XCNT(j)  (256  + 64 * (j))
#define XB_XSUB(j)  (1280 + 64 * (j))
#define XB_XGEN(j)  (2304 + 64 * (j))
#define XB_TOP      3328
#define XB_TOPGEN   3392
#define XCD_BAR_WORDS 3456
#define XB_SPIN_CAP (1u << 18)
__device__ __forceinline__ unsigned xb_ld(unsigned* p)              { return __hip_atomic_load(p, __ATOMIC_RELAXED, __HIP_MEMORY_SCOPE_AGENT); }
__device__ __forceinline__ unsigned xb_add(unsigned* p, unsigned v) { return __hip_atomic_fetch_add(p, v, __ATOMIC_RELAXED, __HIP_MEMORY_SCOPE_AGENT); }
__device__ __forceinline__ unsigned xb_xcc_id() { return (unsigned)__builtin_amdgcn_s_getreg((3 << 11) | 20) & 0xFu; }
#define XB_SPIN(cond, bar) do { unsigned _sp = 0; while (cond) { __builtin_amdgcn_s_sleep(1); \
    if ((++_sp & 255u) == 0u) { if (xb_ld(&(bar)[XB_TMO])) break; if (_sp > XB_SPIN_CAP) { atomicAdd(&(bar)[XB_TMO], 1u); break; } } } } while (0)
struct XcdBarrier { unsigned* bar; unsigned x; volatile LAS unsigned* st; };
__device__ __forceinline__ XcdBarrier xcd_barrier_post(unsigned* bar, volatile LAS unsigned* st) {
    XcdBarrier b; b.bar = bar; b.x = xb_xcc_id(); b.st = st;
    if (threadIdx.x == 0) (void)xb_add(&bar[XB_XCNT(b.x)], 1u);
    return b;
}
__device__ __forceinline__ void xcd_barrier_complete(unsigned* bar, unsigned x, unsigned& nloc, unsigned& nx) {
    const unsigned G = gridDim.x * gridDim.y * gridDim.z;
    unsigned sum, cnt, mine, sp = 0u;
    for (;;) {
        sum = 0u; cnt = 0u; mine = 0u;
#pragma unroll
        for (unsigned j = 0; j < 16; ++j) { const unsigned c = xb_ld(&bar[XB_XCNT(j)]); sum += c; cnt += (c > 0u) ? 1u : 0u; mine = (j == x) ? c : mine; }
        if (sum == G) break;
        __builtin_amdgcn_s_sleep(1);
        if ((++sp & 255u) == 0u) { if (xb_ld(&bar[XB_TMO])) break; if (sp > XB_SPIN_CAP) { atomicAdd(&bar[XB_TMO], 1u); break; } }
    }
    nloc = mine > 0u ? mine : 1u; nx = cnt > 0u ? cnt : 1u;
}
__device__ __forceinline__ void xcd_barrier(const XcdBarrier& b, int tid_) {
    asm volatile("s_waitcnt vmcnt(0)" ::: "memory");
    __syncthreads();
    if (tid_ == 0) {
        unsigned* bar = b.bar;
        __builtin_amdgcn_s_waitcnt(0);
        unsigned nloc = b.st[0], nx = b.st[1];
        if (nloc == 0u) { xcd_barrier_complete(bar, b.x, nloc, nx); b.st[0] = nloc; b.st[1] = nx; }
        const unsigned old = xb_add(&bar[XB_XSUB(b.x)], 1u);
        const unsigned gen = old / nloc;
        if (old + 1u == (gen + 1u) * nloc) {
            __builtin_amdgcn_fence(__ATOMIC_RELEASE, "agent");
            asm volatile("s_waitcnt vmcnt(0)" ::: "memory");
            const unsigned og = xb_add(&bar[XB_TOP], 1u);
            const unsigned tg = og / nx;
            if (og + 1u == (tg + 1u) * nx) xb_add(&bar[XB_TOPGEN], 1u);
            else XB_SPIN(xb_ld(&bar[XB_TOPGEN]) == tg, bar);
            __builtin_amdgcn_fence(__ATOMIC_ACQUIRE, "agent");
            xb_add(&bar[XB_XGEN(b.x)], 1u);
            asm volatile("s_waitcnt vmcnt(0)" ::: "memory");
        } else {
            XB_SPIN(xb_ld(&bar[XB_XGEN(b.x)]) == gen, bar);
            __builtin_amdgcn_fence(__ATOMIC_ACQUIRE, "agent");
            asm volatile("s_waitcnt vmcnt(0)" ::: "memory");
        }
    }
    __syncthreads();
}

__device__ __forceinline__ float wave_sum(float v) {
#pragma unroll
    for (int o = 1; o < 64; o <<= 1) v += __shfl_xor(v, o);
    return v;
}
struct TrD { const float* src; const float* gain; bf16_t* dst; int ldw, ldt; };
__device__ __forceinline__ void tr_load(const TrD& d, f32x4 (&v)[8], float (&g)[8], int lane) {
    const int c4 = lane & 7, r0 = lane >> 3;
#pragma unroll
    for (int i = 0; i < 8; ++i) { const int row = 8 * i + r0; v[i] = *(const GAS f32x4*)((const GAS float*)d.src + (size_t)row * d.ldw + 4 * c4); g[i] = d.gain ? ((const GAS float*)d.gain)[row] : 1.0f; }
}
__device__ __forceinline__ void tr_store(const TrD& d, const f32x4 (&v)[8], const float (&g)[8], LAS float* scr, int lane) {
    const int c4 = lane & 7, r0 = lane >> 3;
#pragma unroll
    for (int i = 0; i < 8; ++i) { LAS float* s = scr + (8 * i + r0) * 33 + 4 * c4; s[0] = v[i][0] * g[i]; s[1] = v[i][1] * g[i]; s[2] = v[i][2] * g[i]; s[3] = v[i][3] * g[i]; }
    LDS_WAIT(); asm volatile("" ::: "memory");
    const int c = lane & 7;
#pragma unroll
    for (int j = 0; j < 4; ++j) { const int n = (lane >> 3) + 8 * j; const LAS float* s = scr + (8 * c) * 33 + n;
        u32x4 o; o.x = cvt_pk_bf16(s[0 * 33], s[1 * 33]); o.y = cvt_pk_bf16(s[2 * 33], s[3 * 33]); o.z = cvt_pk_bf16(s[4 * 33], s[5 * 33]); o.w = cvt_pk_bf16(s[6 * 33], s[7 * 33]);
        *(GAS u32x4*)((GAS bf16_t*)d.dst + (size_t)n * d.ldt + 8 * c) = o; }
    LDS_WAIT(); asm volatile("" ::: "memory");
}
constexpr int I_IN = (DM / 64) * (NIN / 32), I_P = (BW / 64) * (DM / 32), I_O = (DM / 64) * (DM / 32), I_G = (DM / 64) * (DFF / 32), I_D = (DFF / 64) * (DM / 32);
constexpr int NITEMS = I_IN + 3 * I_P + I_O + 2 * I_G + I_D;
struct Args { const float* in[14]; float* out; unsigned char* ws; };
__device__ __forceinline__ void tr_decode(int it, TrD& d, const Args& A, int layer, unsigned char* ws) {
    int r = it;
    if (r < I_IN) { const int nblk = NIN / 32, kb = r / nblk, c0 = 32 * (r % nblk); size_t doff;
        if (c0 < 3072) doff = WS_WIN + (size_t)c0 * DM * 2;
        else if (c0 < 3584) doff = WS_WIN + (size_t)(3072 + 256 * ((c0 - 3072) >> 7) + ((c0 - 3072) & 127)) * DM * 2;
        else if (c0 < 4096) doff = WS_WIN + (size_t)(4096 + (c0 - 3584)) * DM * 2;
        else if (c0 < 4608) doff = WS_WIN + (size_t)(3072 + 256 * ((c0 - 4096) >> 7) + 128 + ((c0 - 4096) & 127)) * DM * 2;
        else doff = WS_WG + (size_t)(c0 - 4608) * DM * 2;
        d.src = A.in[2] + (size_t)layer * DM * NIN + (size_t)(64 * kb) * NIN + c0; d.gain = A.in[1] + (size_t)layer * DM + 64 * kb; d.dst = (bf16_t*)(ws + doff) + 64 * kb; d.ldw = NIN; d.ldt = DM; return; }
    r -= I_IN;
    if (r < I_P) { const int nblk = DM / 32, kb = r / nblk, c0 = 32 * (r % nblk);
        d.src = A.in[5] + (size_t)layer * BW * DM + (size_t)(64 * kb) * DM + c0; d.gain = nullptr; d.dst = (bf16_t*)(ws + WS_WP) + (size_t)c0 * BW + 64 * kb; d.ldw = DM; d.ldt = BW; return; }
    r -= I_P;
    if (r < I_P) { const int nblk = DM / 32, kb = r / nblk, c0 = 32 * (r % nblk);
        d.src = A.in[6] + (size_t)layer * BW * DM + (size_t)(64 * kb) * DM + c0; d.gain = nullptr; d.dst = (bf16_t*)(ws + WS_WP) + (size_t)DM * BW + (size_t)c0 * BW + 64 * kb; d.ldw = DM; d.ldt = BW; return; }
    r -= I_P;
    if (r < I_P) { const int nblk = DM / 32, kb = r / nblk, c0 = 32 * (r % nblk);
        d.src = A.in[7] + (size_t)layer * BW * DM + (size_t)(64 * kb) * DM + c0; d.gain = nullptr; d.dst = (bf16_t*)(ws + WS_WP) + (size_t)2 * DM * BW + (size_t)c0 * BW + 64 * kb; d.ldw = DM; d.ldt = BW; return; }
    r -= I_P;
    if (r < I_O) { const int nblk = DM / 32, kb = r / nblk, c0 = 32 * (r % nblk);
        d.src = A.in[8] + (size_t)layer * DM * DM + (size_t)(64 * kb) * DM + c0; d.gain = nullptr; d.dst = (bf16_t*)(ws + WS_WO) + (size_t)c0 * DM + 64 * kb; d.ldw = DM; d.ldt = DM; return; }
    r -= I_O;
    if (r < I_G) { const int nblk = DFF / 32, kb = r / nblk, c0 = 32 * (r % nblk);
        d.src = A.in[10] + (size_t)layer * DM * DFF + (size_t)(64 * kb) * DFF + c0; d.gain = A.in[9] + (size_t)layer * DM + 64 * kb; d.dst = (bf16_t*)(ws + WS_WGU) + (size_t)(256 * (c0 >> 7) + (c0 & 127)) * DM + 64 * kb; d.ldw = DFF; d.ldt = DM; return; }
    r -= I_G;
    if (r < I_G) { const int nblk = DFF / 32, kb = r / nblk, c0 = 32 * (r % nblk);
        d.src = A.in[11] + (size_t)layer * DM * DFF + (size_t)(64 * kb) * DFF + c0; d.gain = A.in[9] + (size_t)layer * DM + 64 * kb; d.dst = (bf16_t*)(ws + WS_WGU) + (size_t)(256 * (c0 >> 7) + 128 + (c0 & 127)) * DM + 64 * kb; d.ldw = DFF; d.ldt = DM; return; }
    r -= I_G;
    { const int nblk = DM / 32, kb = r / nblk, c0 = 32 * (r % nblk);
      d.src = A.in[12] + (size_t)layer * DFF * DM + (size_t)(64 * kb) * DM + c0; d.gain = nullptr; d.dst = (bf16_t*)(ws + WS_WD) + (size_t)c0 * DFF + 64 * kb; d.ldw = DM; d.ldt = DFF; }
}


__global__ void __launch_bounds__(NWAVES * 64, 2) hybrid_fwd(Args args) {
    extern __shared__ __attribute__((aligned(16))) unsigned char lds_raw[];
    LAS unsigned char* lds = (LAS unsigned char*)lds_raw;
    volatile LAS unsigned* MISC = (volatile LAS unsigned*)(lds + MISC_OFF);
    const int wave = __builtin_amdgcn_readfirstlane((int)threadIdx.x >> 6);
    const int G = gridDim.x, bx = blockIdx.x, vcu = (G % 8 == 0) ? (bx % 8) * (G / 8) + bx / 8 : bx;
    for (int i = threadIdx.x; i < (LDS_BYTES - LDSCTL_OFF) / 4; i += NWAVES * 64) ((LAS unsigned*)(lds + LDSCTL_OFF))[i] = 0u;
    __syncthreads();
    XcdBarrier bar = xcd_barrier_post((unsigned*)(args.ws + WS_CTL) + CW_BAR, MISC + 8);
    const int gw = vcu * NWAVES + wave, NGW = G * NWAVES;

#ifndef REP_PH
#define REP_PH -1
#endif
    for (int pq = 0; pq < DEPTH * 7 + 1; ++pq)
    for (int rep_ = 0; rep_ < ((pq % 7 == REP_PH && pq < DEPTH * 7) ? 2 : 1); ++rep_) {
        const int pp = pq;
        const int layer = pp / 7, ph = pp - 7 * layer;
        int tid = wave * 64 + lane_id(); asm volatile("" : "+v"(tid)); const int lane = tid & 63;
        size_t opq = 0; asm volatile("" : "+s"(opq));
        unsigned char* ws = args.ws + opq; const float* x_in = args.in[0] + opq; float* out = args.out + opq;
        float* ssA = (float*)(ws + WS_SSA); float* ssB = (float*)(ws + WS_SSB); float* kmp = (float*)(ws + WS_KM);
        bf16_t* xb = (bf16_t*)(ws + WS_XB);
        bf16_t* QA = (bf16_t*)(ws + WS_QA); bf16_t* KA = (bf16_t*)(ws + WS_KA); bf16_t* VA = (bf16_t*)(ws + WS_VA);
        bf16_t* QS = (bf16_t*)(ws + WS_QS); bf16_t* KS = (bf16_t*)(ws + WS_KS); bf16_t* VS = (bf16_t*)(ws + WS_VS);
        bf16_t* Ub = (bf16_t*)(ws + WS_U); bf16_t* BC = (bf16_t*)(ws + WS_BC); bf16_t* MG = (bf16_t*)(ws + WS_MG); bf16_t* ACT = (bf16_t*)(ws + WS_ACT);

        if (layer == DEPTH) {
            const float* gf = args.in[13];
            for (int m = gw; m < M; m += NGW) {
                const float rs = rstd_row(ssA, m);
                f32x4* xr = (f32x4*)(out + (size_t)m * DM) + lane; const f32x4* gr = (const f32x4*)gf + lane; const u32x2* xs = (const u32x2*)(xb + (size_t)m * DM) + lane;
#pragma unroll
                for (int j = 0; j < 4; ++j) { const u32x2 w = xs[64 * j]; const f32x4 v = {bf_lo(w.x), bf_hi(w.x), bf_lo(w.y), bf_hi(w.y)}, g = gr[64 * j]; xr[64 * j] = v * rs * g; }
            }
            if (xb_ld((unsigned*)(ws + WS_CTL) + CW_BAR + XB_TMO) != 0u && bx == 0) { for (int i = tid; i < 4096; i += NWAVES * 64) out[i] = __builtin_nanf(""); }
            break;
        }
        if (ph == 0) {
            LAS float* scr = (LAS float*)(lds + RING_OFF + wave * 16384);
            for (int it = gw; it < NITEMS; it += NGW) { TrD dc; f32x4 vc[8]; float gc[8]; tr_decode(it, dc, args, layer, ws); tr_load(dc, vc, gc, lane); tr_store(dc, vc, gc, scr, lane); }
            if (layer == 0) {
                for (int m = gw; m < M; m += NGW) {
                    const f32x4* xr = (const f32x4*)(x_in + (size_t)m * DM) + lane; f32x4 v[4]; float s = 0.f;
#pragma unroll
                    for (int j = 0; j < 4; ++j) { v[j] = xr[64 * j]; s += (v[j].x * v[j].x + v[j].y * v[j].y) + (v[j].z * v[j].z + v[j].w * v[j].w); }
                    s = wave_sum(s);
                    u32x2* o8 = (u32x2*)(xb + (size_t)m * DM) + lane;
#pragma unroll
                    for (int j = 0; j < 4; ++j) o8[64 * j] = (u32x2){cvt_pk_bf16(v[j].x, v[j].y), cvt_pk_bf16(v[j].z, v[j].w)};
                    if (lane < 4) ssA[(size_t)m * 4 + lane] = (lane == 0) ? s : 0.f;
                }
            }
        } else if (ph == 2) {
            LAS unsigned char* vst = lds + RING_OFF + wave * 8192;
            LAS float* wsf = (LAS float*)(lds + RING_OFF + 65536 + wave * 512);
            LAS float* km = (LAS float*)(lds + RING_OFF + 65536 + 4096);
            LAS unsigned* selm = (LAS unsigned*)(lds + RING_OFF + 77824);
            LAS unsigned* cnt = (LAS unsigned*)(lds + RING_OFF + 78848);
            LAS float* kbn = (LAS float*)(lds + RING_OFF + 78848 + 256);
            LAS unsigned* uslot = (LAS unsigned*)(lds + RING_OFF + 78848 + 512);
            LAS unsigned char* lists = lds + RING_OFF + 79872;
            LAS unsigned* trow = (LAS unsigned*)(lds + RING_OFF + 88064 + wave * 128);
            unsigned char* recO = ws + WS_MG + (size_t)vcu * 131072; float* recML = (float*)(ws + WS_X + (size_t)vcu * 8192);
            unsigned* qctr = (unsigned*)(ws + WS_CTL) + 8192 + layer * 64;
            unsigned* ndone = (unsigned*)(ws + WS_CTL) + 8192 + 128 + layer * 1024;
            float* kbmax = (float*)((unsigned*)(ws + WS_CTL) + 8192 + 4096 + layer * 512);
            for (;;) {
                if (tid == 0) *uslot = __hip_atomic_fetch_add(qctr, 1u, __ATOMIC_RELAXED, __HIP_MEMORY_SCOPE_AGENT);
                __syncthreads();
                const unsigned uq = *uslot;
                __syncthreads();
                if (uq >= 1536u) break;
                if (uq < 512u) {
                    const int bh = (int)(uq >> 5), n = (int)(uq & 31u), b = bh >> 3, h = bh & 7;
                    const u32x4* kp = (const u32x4*)(KA + ((size_t)b * SEQ + n * 256 + (tid >> 1)) * BW + h * HD + (tid & 1) * 32);
                    float sq = 0.f;
#pragma unroll
                    for (int c = 0; c < 4; ++c) { const u32x4 x = kp[c]; const float e0 = bf_lo(x.x), e1 = bf_hi(x.x), e2 = bf_lo(x.y), e3 = bf_hi(x.y), e4 = bf_lo(x.z), e5 = bf_hi(x.z), e6 = bf_lo(x.w), e7 = bf_hi(x.w);
                        sq += (e0 * e0 + e1 * e1) + (e2 * e2 + e3 * e3) + (e4 * e4 + e5 * e5) + (e6 * e6 + e7 * e7); }
                    sq += xshfl<1>(sq);
                    sq = __builtin_fmaxf(sq, xshfl<2>(sq)); sq = __builtin_fmaxf(sq, xshfl<4>(sq)); sq = __builtin_fmaxf(sq, xshfl<8>(sq)); sq = __builtin_fmaxf(sq, xshfl<16>(sq));
                    { float x1; const float x0 = att::swap_lo(sq, x1); sq = __builtin_fmaxf(x0, x1); }
                    if (lane == 0) kbn[wave] = sq;
                    __syncthreads();
                    if (tid == 0) { float m_ = kbn[0];
#pragma unroll
                        for (int w_ = 1; w_ < NWAVES; ++w_) m_ = __builtin_fmaxf(m_, kbn[w_]);
                        __hip_atomic_store(kbmax + bh * 32 + n, m_, __ATOMIC_RELAXED, __HIP_MEMORY_SCOPE_AGENT);
                        asm volatile("s_waitcnt vmcnt(0)" ::: "memory");
                        __hip_atomic_fetch_add(ndone + bh * 64, 1u, __ATOMIC_RELAXED, __HIP_MEMORY_SCOPE_AGENT); }
                    __syncthreads();
                } else if (uq < 1024u) {
                    const unsigned um = uq - 512u; const int h = 7 - (int)(um >> 6), blk = 31 - (int)((um & 63u) >> 1), b = (int)(um & 1u);
                    for (int i = tid; i < 2048; i += NWAVES * 64) { const int n = i >> 6, d = i & 63; const size_t o = (size_t)((b * 32 + n) * 2) * BW + h * HD + d; km[i] = kmp[o] + kmp[o + BW]; }
                    if (tid == 0) {
                        unsigned sp_ = 0; while (__hip_atomic_load(ndone + (b * 8 + h) * 64, __ATOMIC_RELAXED, __HIP_MEMORY_SCOPE_AGENT) < 32u) { __builtin_amdgcn_s_sleep(2);
                            if (++sp_ > (1u << 20)) { atomicAdd((unsigned*)(ws + WS_CTL) + CW_BAR + XB_TMO, 1u); break; } } }
                    __syncthreads();
                    if (tid < 32) kbn[tid] = sqrtf(__hip_atomic_load(kbmax + (b * 8 + h) * 32 + tid, __ATOMIC_RELAXED, __HIP_MEMORY_SCOPE_AGENT)) * 1.01f;
                    __syncthreads();
                    const float sl2 = __builtin_amdgcn_exp2f(-(float)(h + 1)) * LOG2E;
                    const size_t qrow = (size_t)b * SEQ + blk * 256 + wave * 32;
                    const unsigned sel = att::moba_gate(QA + qrow * BW + h * HD, KA + qrow * BW + h * HD, blk, blk * 256 + wave * 32, sl2, km, kbn, lane);
                    if (lane < 32) selm[wave * 32 + lane] = sel;
                    __syncthreads();
                    for (int n = wave; n < blk; n += NWAVES) {
                        unsigned pos = 0;
#pragma unroll
                        for (int c = 0; c < 4; ++c) { const int q = 64 * c + lane; const bool bit = (selm[q] >> n) & 1u; const unsigned long long mk = __ballot(bit);
                            if (bit) lists[n * 256 + pos + __builtin_amdgcn_mbcnt_hi((unsigned)(mk >> 32), __builtin_amdgcn_mbcnt_lo((unsigned)mk, 0u))] = (unsigned char)q;
                            pos += (unsigned)__builtin_popcountll(mk); }
                        if (lane == 0) cnt[n] = pos;
                    }
                    __syncthreads();
                    { int n = blk, t = wave; int nn = 0, tt = 0, idp = 0;
                      for (;;) {
                          att::moba_item(QA, KA, VA, b, h, blk, n, t, lists, cnt, selm, recO, recML, vst, wsf, trow, lane);
                          bool found = false;
                          while (nn < blk) { const int nt_ = ((int)cnt[nn] + 31) >> 5;
                              if (tt < nt_) { const bool mine = (idp & (NWAVES - 1)) == wave; if (mine) { n = nn; t = tt; found = true; } ++tt; ++idp; if (mine) break; }
                              else { ++nn; tt = 0; } }
                          if (!found) break;
                      } }
                    VM_WAIT();
                    __syncthreads();
                    att::moba_merge(QA, b, h, blk, wave, selm, recO, recML, wsf, lane);
                    __syncthreads();
                } else {
                    const unsigned us = uq - 1024u; const int h = (int)(us >> 6), blk = (int)((us & 63u) >> 1), b = (int)(us & 1u);
                    att::sb_item(QS, KS, VS, b, h, blk * 256 + wave * 32, vst, lane);
                }
            }
            const float* cw = args.in[4] + (size_t)layer * 3 * BW;
            for (int i = vcu * (NWAVES * 64) + tid; i < M * (BW / 8); i += G * NWAVES * 64) {
                const int t = i >> 6, c = (i & 63) * 8; const int tt = t & (SEQ - 1);
                const u32x4 u2 = *(const u32x4*)(Ub + (size_t)t * BW + c);
                u32x4 u1 = {0u, 0u, 0u, 0u}, u0 = {0u, 0u, 0u, 0u};
                if (tt >= 1) u1 = *(const u32x4*)(Ub + (size_t)(t - 1) * BW + c);
                if (tt >= 2) u0 = *(const u32x4*)(Ub + (size_t)(t - 2) * BW + c);
                const u32x4 bw = *(const u32x4*)(BC + (size_t)t * BW + c);
                float y[8];
#pragma unroll
                for (int e = 0; e < 4; ++e) {
                    const float w0l = cw[c + 2 * e], w0h = cw[c + 2 * e + 1], w1l = cw[BW + c + 2 * e], w1h = cw[BW + c + 2 * e + 1], w2l = cw[2 * BW + c + 2 * e], w2h = cw[2 * BW + c + 2 * e + 1];
                    y[2 * e] = bf_lo(bw[e]) * (w0l * bf_lo(u0[e]) + w1l * bf_lo(u1[e]) + w2l * bf_lo(u2[e]));
                    y[2 * e + 1] = bf_hi(bw[e]) * (w0h * bf_hi(u0[e]) + w1h * bf_hi(u1[e]) + w2h * bf_hi(u2[e]));
                }
                *(u32x4*)(BC + (size_t)t * BW + c) = (u32x4){cvt_pk_bf16(y[0], y[1]), cvt_pk_bf16(y[2], y[3]), cvt_pk_bf16(y[4], y[5]), cvt_pk_bf16(y[6], y[7])};
            }
        } else {
            static_assert(WS_QS - WS_QA == 48 * MiB && WS_BC - WS_QS == 48 * MiB && WS_GB - WS_GA == 48 * MiB && WS_GC0 - WS_GB == 48 * MiB && WS_GC1 - WS_GC0 == 48 * MiB, "48 MiB spacing");
            GCfg c{};
            c.ws = ws; c.bgate = args.in[3] + (size_t)layer * NGATE; c.red = (LAS float*)(lds + LDSCTL_OFF + 1024);
            c.nseg = 1; c.lda = DM; c.ldb = DM; c.nt = DM / 64; c.toA = 0;
            if (ph == 1) { c.mode = 0; c.N = N1; c.A = xb; c.B = (const bf16_t*)(ws + WS_WIN); }
            else if (ph == 3) { c.mode = 1; c.N = DM; c.nseg = 6; c.A = xb; c.B = (const bf16_t*)(ws + WS_WG); }
            else if (ph == 4) { c.mode = 2; c.N = DM; c.A = MG; c.B = (const bf16_t*)(ws + WS_WO); }
            else if (ph == 5) { c.mode = 3; c.N = NGU; c.A = xb; c.B = (const bf16_t*)(ws + WS_WGU); }
            else { c.mode = 2; c.N = DM; c.A = ACT; c.B = (const bf16_t*)(ws + WS_WD); c.lda = DFF; c.ldb = DFF; c.nt = DFF / 64; c.toA = 1; }
            ProbAny P{&c}; EpiAny E{&c}; pg8::StaticOrder S; S.init(M, c.N, G, bx, c.nseg);
            pg8::gemm_phase(lds + RING_OFF, P, S, E, wave);
        }
        xcd_barrier(bar, tid);
    }
}

extern "C" void kernel_launch(void* const* d_in, const int* in_sizes, int n_in, void* d_out, int out_size, void* d_ws, size_t ws_size, hipStream_t stream) {
    static int grid = 0;
    if (grid == 0) {
        if (n_in != 14 || in_sizes[0] != M * DM || out_size != M * DM || ws_size < WS_END) { fprintf(stderr, "kernel_launch: unexpected shapes (n_in %d, in0 %d, out %d, ws %zu)\n", n_in, n_in > 0 ? in_sizes[0] : -1, out_size, ws_size); grid = -1; return; }
        int dev = 0, cus = 0, per_cu = 0;
        if (hipGetDevice(&dev) != hipSuccess || hipDeviceGetAttribute(&cus, hipDeviceAttributeMultiprocessorCount, dev) != hipSuccess) { grid = -1; return; }
        if (hipFuncSetAttribute((const void*)hybrid_fwd, hipFuncAttributeMaxDynamicSharedMemorySize, LDS_BYTES) != hipSuccess) { fprintf(stderr, "kernel_launch: hipFuncSetAttribute failed\n"); grid = -1; return; }
        if (hipOccupancyMaxActiveBlocksPerMultiprocessor(&per_cu, (const void*)hybrid_fwd, NWAVES * 64, LDS_BYTES) != hipSuccess || per_cu < 1) { fprintf(stderr, "kernel_launch: occupancy query says %d blocks/CU\n", per_cu); (void)hipGetLastError(); per_cu = 1; }
        grid = cus;
    }
    if (grid < 0) return;
    if (hipMemsetAsync((char*)d_ws + WS_CTL, 0, CTL_ZERO_BYTES, stream) != hipSuccess) { fprintf(stderr, "kernel_launch: memset failed\n"); return; }
    Args a{};
    for (int i = 0; i < 14; ++i) a.in[i] = (const float*)d_in[i];
    a.out = (float*)d_out; a.ws = (unsigned char*)d_ws;
    void* kargs[] = {&a};
    hipError_t e = hipLaunchCooperativeKernel((const void*)hybrid_fwd, dim3(grid), dim3(NWAVES * 64), kargs, LDS_BYTES, stream);
    if (e != hipSuccess) fprintf(stderr, "kernel_launch: cooperative launch failed: %s (grid %d)\n", hipGetErrorString(e), grid);
}
```

```cpp
#include <hip/hip_runtime.h>
#include <hip/hip_bf16.h>
#include <cstdio>
#include <cstdint>

#define GAS __attribute__((address_space(1)))
#define LAS __attribute__((address_space(3)))
typedef unsigned short bf16_t;
typedef short bf16x8 __attribute__((ext_vector_type(8)));
typedef short s16x4 __attribute__((ext_vector_type(4)));
typedef float f32x2 __attribute__((ext_vector_type(2)));
typedef float f32x4 __attribute__((ext_vector_type(4)));
typedef float f32x16 __attribute__((ext_vector_type(16)));
typedef unsigned u32x2 __attribute__((ext_vector_type(2)));
typedef unsigned u32x4 __attribute__((ext_vector_type(4)));
typedef GAS unsigned gu32;

constexpr int BATCH = 2, SEQ = 8192, DM = 1024, M = BATCH * SEQ, NH = 8, HD = 64, BW = 512, DFF = 2816, DEPTH = 2;
constexpr int NIN = 7680, N1 = 4608, NGATE = 3072, NGU = 2 * DFF;
constexpr float RMS_EPS = 1e-6f;
constexpr float LOG2E = 1.4426950408889634f;
constexpr float C2 = 0.125f * LOG2E;
constexpr int NWAVES = 8;

constexpr size_t MiB = 1u << 20;
constexpr size_t WS_CTL = 0, CTL_ZERO_BYTES = 64 * 1024;
constexpr size_t WS_SSA = 1 * MiB, WS_SSB = 2 * MiB, WS_KM = 3 * MiB;
constexpr size_t WS_WIN = 4 * MiB, WS_WG = 13 * MiB, WS_WP = 19 * MiB, WS_WO = 22 * MiB, WS_WGU = 24 * MiB, WS_WD = 35 * MiB;
constexpr size_t WS_XB = 41 * MiB;
constexpr size_t WS_QA = 73 * MiB, WS_KA = 89 * MiB, WS_VA = 105 * MiB, WS_QS = 121 * MiB, WS_KS = 137 * MiB, WS_VS = 153 * MiB;
constexpr size_t WS_BC = 169 * MiB, WS_U = 185 * MiB, WS_MG = 201 * MiB, WS_X = 233 * MiB;
constexpr size_t WS_GA = WS_KA, WS_GB = WS_KS, WS_GC0 = WS_U, WS_GC1 = WS_X;
constexpr size_t WS_ACT = 73 * MiB;
constexpr size_t WS_END = 256 * MiB;
constexpr int CW_BAR = 4096;

constexpr int RING_OFF = 0, RING_BYTES = 131072;
constexpr int LDSCTL_OFF = RING_BYTES, MISC_OFF = LDSCTL_OFF + 320;
constexpr int LDS_BYTES = 147456;

#define LDS_WAIT() asm volatile("s_waitcnt lgkmcnt(0)" ::: "memory")
#define VM_WAIT() asm volatile("s_waitcnt vmcnt(0)" ::: "memory")
#define RLX_AGENT __ATOMIC_RELAXED, __HIP_MEMORY_SCOPE_AGENT

typedef __bf16 bf16x2_t __attribute__((ext_vector_type(2)));
__device__ __forceinline__ unsigned cvt_pk_bf16(float lo, float hi) { const f32x2 v = {lo, hi}; const bf16x2_t b = __builtin_convertvector(v, bf16x2_t); return __builtin_bit_cast(unsigned, b); }
template <int O> __device__ __forceinline__ float xshfl(float x) {
    static_assert(O < 32, "use sum32 for the two 32-lane halves");
    return __int_as_float(__builtin_amdgcn_ds_swizzle(__float_as_int(x), (O << 10) | 0x1f));
}
__device__ __forceinline__ int lane_id() { return (int)__builtin_amdgcn_mbcnt_hi(~0u, __builtin_amdgcn_mbcnt_lo(~0u, 0u)); }
__device__ __forceinline__ float sum32(float x) { auto rr = __builtin_amdgcn_permlane32_swap(__float_as_uint(x), __float_as_uint(x), false, false); return __uint_as_float(rr[0]) + __uint_as_float(rr[1]); }
__device__ __forceinline__ float bf_lo(unsigned w) { return __uint_as_float(w << 16); }
__device__ __forceinline__ float bf_hi(unsigned w) { return __uint_as_float(w & 0xffff0000u); }
__device__ __forceinline__ float rstd_row(const float* ssp, int row) {
    const f32x4 a = *(const f32x4*)(ssp + (size_t)row * 4);
    return rsqrtf(((a.x + a.y) + (a.z + a.w)) * (1.0f / DM) + RMS_EPS);
}

namespace pg8 {
constexpr int BM = 256, BK = 64, HALF = 128, HTB = HALF * BK * 2, STAGE_BYTES = 8 * HTB, NXCD = 8, WGM = 8;
__host__ __device__ __forceinline__ int lds_byte(int r, int c) { const int st = (r >> 4) * 2 + (c >> 5), rr = r & 15, cc = c & 31, ob = rr * 64 + cc * 2; return st * 1024 + (ob ^ (((ob >> 9) & 1) << 5)); }
__host__ __device__ __forceinline__ void stage_rc(int b, int& R, int& C) { const int st = b / 1024, sb = b % 1024, swz = sb ^ (((sb >> 9) & 1) << 5); R = (st >> 1) * 16 + swz / 64; C = (st & 1) * 32 + (swz % 64) / 2; }
__host__ __device__ __forceinline__ int perm32(int rho) { const int n = rho >> 4, i = rho & 15; return 8 * (i >> 2) + 4 * n + (i & 3); }

struct Unit { int pm, pn, seg; };
struct Seg { const char* A; const char* B; unsigned hA, hB; int lda, ldb, nt; };

struct StaticOrder {
    int nM, nN, nwg, G, c, nseg;
    __device__ void init(int M_, int N_, int G_, int c_, int nseg_) { nM = M_ / BM; nN = N_ / BM; nwg = nM * nN; G = G_; c = c_; nseg = nseg_; }
    __device__ bool next(int i, Unit& u) const {
        const int ti = (nseg == 1) ? i : i / nseg; u.seg = i - ti * nseg;
        const long L = (long)ti * G + c; if (L >= nwg) return false;
        int wgid = (int)L; { const int q = nwg / NXCD, r = nwg % NXCD, xcd = wgid % NXCD, off = wgid / NXCD; wgid = (xcd < r ? xcd * (q + 1) : r * (q + 1) + (xcd - r) * q) + off; }
        const int nig = WGM * nN, gid = wgid / nig, fm = gid * WGM, gsz = (nM - fm) < WGM ? (nM - fm) : WGM;
        u.pm = fm + ((wgid % nig) % gsz); u.pn = (wgid % nig) / gsz; return true;
    }
};

template <class Prob, class Epi, class Sched>
__device__ __forceinline__ void gemm_phase(LAS unsigned char* lds, const Prob& P, const Sched& S, const Epi& E, int wave_) {
    int tid = wave_ * 64 + lane_id(); asm volatile("" : "+v"(tid));
    const int wid = wave_, lane = tid & 63, wr = wid >> 2, wc = wid & 3, fr = lane & 15, fq = lane >> 4;
#define PG8_RC(R0, C0, Rb0) int R0, C0; { int t_ = tid; asm volatile("" : "+v"(t_)); stage_rc(t_ * 16, R0, C0); } const int Rb0 = (R0 & ~31) + perm32(R0 & 31)
    const size_t kstep = (size_t)(BK * 2);
    const unsigned ldsw = (unsigned)wid * 1024u;
    const int aoff = lds_byte(wr * 64 + fr, fq * 8), boff = lds_byte(wc * 32 + fr, fq * 8);
#define PG8_SA(b, h) (((b) * 2 + (h)) * HTB)
#define PG8_SB(b, h) ((4 + (b) * 2 + (h)) * HTB)
#define PG8_STAGE(bufoff, gbase, v0, q) do { \
        __builtin_amdgcn_global_load_lds((const unsigned*)((const char*)(gbase) + (v0)), (LAS unsigned*)(lds + (bufoff) + ldsw), 16, 0, 0); \
        __builtin_amdgcn_global_load_lds((const unsigned*)((const char*)(gbase) + (q) + (v0)), (LAS unsigned*)(lds + (bufoff) + ldsw + 8192), 16, 0, 0); } while (0)
#define PG8_LDA(dst, b, h) do { _Pragma("unroll") for (int m = 0; m < 4; ++m) _Pragma("unroll") for (int k = 0; k < 2; ++k) dst[m][k] = *(const LAS bf16x8*)(lds + PG8_SA(b, h) + aoff + m * 2048 + k * 1024); } while (0)
#define PG8_LDB(dst, b, h) do { _Pragma("unroll") for (int n = 0; n < 2; ++n) _Pragma("unroll") for (int k = 0; k < 2; ++k) dst[n][k] = *(const LAS bf16x8*)(lds + PG8_SB(b, h) + boff + n * 2048 + k * 1024); } while (0)
#define PG8_MMA(ai, bj, At, Bt) do { __builtin_amdgcn_s_setprio(1); _Pragma("unroll") for (int m = 0; m < 4; ++m) _Pragma("unroll") for (int n = 0; n < 2; ++n) _Pragma("unroll") for (int k = 0; k < 2; ++k) \
        acc[ai][bj][m][n] = __builtin_amdgcn_mfma_f32_16x16x32_bf16(Bt[n][k], At[m][k], acc[ai][bj][m][n], 0, 0, 0); __builtin_amdgcn_s_setprio(0); } while (0)
#define PG8_WAIT_V(n) asm volatile("s_waitcnt vmcnt(" #n ")" ::: "memory")
#define PG8_WAIT_L(n) asm volatile("s_waitcnt lgkmcnt(" #n ")" ::: "memory")
#define PG8_BAR __builtin_amdgcn_s_barrier()
#define PG8_SCHED __builtin_amdgcn_sched_barrier(0)
    Unit cur, nxt; int ui = 0;
    if (!S.next(0, cur)) return;
    Seg sc, sn; P.seg(cur, sc);
    unsigned vAc0, vBc0; { PG8_RC(R0, C0, Rb0); vAc0 = (unsigned)(R0 * sc.lda + C0) * 2u; vBc0 = (unsigned)(Rb0 * sc.ldb + C0) * 2u; }
    f32x4 acc[2][2][4][2];
#pragma unroll
    for (int a = 0; a < 2; ++a)
#pragma unroll
        for (int b = 0; b < 2; ++b)
#pragma unroll
            for (int m = 0; m < 4; ++m)
#pragma unroll
                for (int n = 0; n < 2; ++n) acc[a][b][m][n] = (f32x4){0.f, 0.f, 0.f, 0.f};
    bf16x8 At[4][2], B0[2][2], B1[2][2];
    const char* cA = sc.A; const char* cB = sc.B;
    PG8_STAGE(PG8_SB(0, 0), cB, vBc0, sc.hB >> 1); PG8_STAGE(PG8_SB(0, 1), cB + sc.hB, vBc0, sc.hB >> 1); PG8_STAGE(PG8_SA(0, 0), cA, vAc0, sc.hA >> 1); PG8_STAGE(PG8_SA(0, 1), cA + sc.hA, vAc0, sc.hA >> 1);
    if (wr == 1) PG8_BAR;
    PG8_WAIT_V(2); PG8_BAR;
    PG8_STAGE(PG8_SB(1, 0), cB + kstep, vBc0, sc.hB >> 1); PG8_STAGE(PG8_SA(1, 0), cA + kstep, vAc0, sc.hA >> 1); PG8_STAGE(PG8_SB(1, 1), cB + sc.hB + kstep, vBc0, sc.hB >> 1);
    PG8_WAIT_V(6); PG8_BAR;
    for (;;) {
        const bool has_next = S.next(ui + 1, nxt);
        if (has_next) P.seg(nxt, sn); else sn = sc;
        unsigned vAn0, vBn0; { PG8_RC(R0, C0, Rb0); vAn0 = (unsigned)(R0 * sn.lda + C0) * 2u; vBn0 = (unsigned)(Rb0 * sn.ldb + C0) * 2u; }
        const char* nA = sn.A; const char* nB = sn.B;
        const int nt = sc.nt;
        for (int t = 0; t < nt; t += 2) {
            const bool last = (t == nt - 2);
            const char* a1 = cA + (size_t)(t + 1) * kstep;
            const char* a2 = last ? nA : cA + (size_t)(t + 2) * kstep; const char* b2 = last ? nB : cB + (size_t)(t + 2) * kstep;
            const char* a3 = a2 + kstep; const char* b3 = b2 + kstep;
            const unsigned hA2 = last ? sn.hA : sc.hA, hB2 = last ? sn.hB : sc.hB;
            const unsigned vA0 = last ? vAn0 : vAc0, vB0 = last ? vBn0 : vBc0, qA = hA2 >> 1, qB = hB2 >> 1;
            PG8_LDB(B0, 0, 0); PG8_LDB(B1, 0, 1); PG8_SCHED; PG8_LDA(At, 0, 0); PG8_STAGE(PG8_SA(1, 1), a1 + sc.hA, vAc0, sc.hA >> 1);
            PG8_WAIT_V(8); PG8_WAIT_L(0); PG8_BAR; PG8_MMA(0, 0, At, B0); PG8_MMA(0, 1, At, B1); PG8_BAR; PG8_SCHED;
            PG8_LDA(At, 0, 1); PG8_STAGE(PG8_SB(0, 0), b2, vB0, qB); PG8_STAGE(PG8_SB(0, 1), b2 + hB2, vB0, qB); PG8_STAGE(PG8_SA(0, 0), a2, vA0, qA);
            PG8_WAIT_V(8); PG8_WAIT_L(0); PG8_BAR; PG8_MMA(1, 0, At, B0); PG8_MMA(1, 1, At, B1); PG8_BAR; PG8_SCHED;
            PG8_LDB(B0, 1, 0); PG8_LDB(B1, 1, 1); PG8_SCHED; PG8_LDA(At, 1, 0); PG8_STAGE(PG8_SA(0, 1), a2 + hA2, vA0, qA);
            PG8_WAIT_V(8); PG8_WAIT_L(0); PG8_BAR; PG8_MMA(0, 0, At, B0); PG8_MMA(0, 1, At, B1); PG8_BAR; PG8_SCHED;
            PG8_LDA(At, 1, 1); PG8_STAGE(PG8_SB(1, 0), b3, vB0, qB); PG8_STAGE(PG8_SB(1, 1), b3 + hB2, vB0, qB); PG8_STAGE(PG8_SA(1, 0), a3, vA0, qA);
            PG8_WAIT_V(8); PG8_WAIT_L(0); PG8_BAR; PG8_MMA(1, 0, At, B0); PG8_MMA(1, 1, At, B1); PG8_BAR; PG8_SCHED;
        }
        if (wr == 0) PG8_BAR;
        { int wr_ = wr, wc_ = wc, t_ = tid;
          asm volatile("" : "+s"(wr_), "+s"(wc_), "+v"(t_)); const int fr_ = t_ & 15, fq_ = (t_ >> 4) & 3;
          E(acc, cur, wr_, wc_, fr_, fq_); }
        if (!has_next) break;
#pragma unroll
        for (int a = 0; a < 2; ++a)
#pragma unroll
            for (int b = 0; b < 2; ++b)
#pragma unroll
                for (int m = 0; m < 4; ++m)
#pragma unroll
                    for (int n = 0; n < 2; ++n) acc[a][b][m][n] = (f32x4){0.f, 0.f, 0.f, 0.f};
        cur = nxt; sc = sn; cA = nA; cB = nB; vAc0 = vAn0; vBc0 = vBn0; ++ui;
        if (wr == 1) PG8_BAR;
    }
    PG8_WAIT_V(0);
    PG8_BAR;
#undef PG8_SA
#undef PG8_SB
#undef PG8_STAGE
#undef PG8_LDA
#undef PG8_LDB
#undef PG8_MMA
#undef PG8_WAIT_V
#undef PG8_WAIT_L
#undef PG8_BAR
#undef PG8_SCHED
#undef PG8_RC
}
}

#define EPI_ARGS const f32x4 (&acc)[2][2][4][2], const pg8::Unit& u, int wr, int wc, int fr, int fq
__device__ __forceinline__ void st_bf16x8(bf16_t* p, f32x4 v0, f32x4 v1) {
    u32x4 w; w.x = cvt_pk_bf16(v0[0], v0[1]); w.y = cvt_pk_bf16(v0[2], v0[3]); w.z = cvt_pk_bf16(v1[0], v1[1]); w.w = cvt_pk_bf16(v1[2], v1[3]);
    *(u32x4*)p = w;
}
template <class T> __device__ __forceinline__ T* bo(T* base, unsigned byte_off) { return (T*)((char*)base + byte_off); }
template <class T> __device__ __forceinline__ const T* bo(const T* base, unsigned byte_off) { return (const T*)((const char*)base + byte_off); }
__device__ __forceinline__ void ld_bf16x8(const bf16_t* p, f32x4& v0, f32x4& v1) {
    const unsigned long long lo = __hip_atomic_load((const unsigned long long*)p, __ATOMIC_RELAXED, __HIP_MEMORY_SCOPE_AGENT), hi = __hip_atomic_load((const unsigned long long*)p + 1, __ATOMIC_RELAXED, __HIP_MEMORY_SCOPE_AGENT);
    const u32x4 w = {(unsigned)lo, (unsigned)(lo >> 32), (unsigned)hi, (unsigned)(hi >> 32)};
    v0 = (f32x4){bf_lo(w.x), bf_hi(w.x), bf_lo(w.y), bf_hi(w.y)}; v1 = (f32x4){bf_lo(w.z), bf_hi(w.z), bf_lo(w.w), bf_hi(w.w)};
}
__device__ __forceinline__ float rstd4(f32x4 a) { return rsqrtf(((a.x + a.y) + (a.z + a.w)) * (1.0f / DM) + RMS_EPS); }
__device__ __forceinline__ void rstd8(float (&rs)[2][4], const float* ss, int pm, unsigned lrow) {
    const float* ssb = ss + (size_t)pm * 256 * 4; unsigned lsb = lrow * 16u; asm volatile("" : "+v"(lsb));
    f32x4 t[2][4];
#pragma unroll
    for (int ai = 0; ai < 2; ++ai)
#pragma unroll
        for (int m = 0; m < 4; ++m) t[ai][m] = *(const f32x4*)bo(ssb, lsb + (unsigned)(ai * 128 + m * 16) * 16u);
#pragma unroll
    for (int ai = 0; ai < 2; ++ai)
#pragma unroll
        for (int m = 0; m < 4; ++m) rs[ai][m] = rstd4(t[ai][m]);
}
struct EpiIn {
    unsigned char* ws;
    __device__ __forceinline__ void operator()(EPI_ARGS) const {
        bf16_t* qkv = (bf16_t*)(ws + WS_QA); bf16_t* ub = (bf16_t*)(ws + WS_U); bf16_t* bc = (bf16_t*)(ws + WS_BC); float* kmp = (float*)(ws + WS_KM); const float* ss = (const float*)(ws + WS_SSA);
        const int pn = u.pn; unsigned lrow = (unsigned)(wr * 64 + fr), lcol = (unsigned)(wc * 32 + 8 * fq);
        asm volatile("" : "+v"(lrow), "+v"(lcol));
        const unsigned lb = (lrow * BW + lcol) * 2u;
        float rs[2][4]; rstd8(rs, ss, u.pm, lrow);
        if (pn < 12 || pn >= 16) {
            const int t = pn >> 1; const float sc = (t == 0 || t == 3) ? C2 : 1.0f;
            bf16_t* base = (pn < 12 ? qkv + (size_t)t * M * BW + (pn & 1) * 256 : bc + (pn - 16) * 256) + (size_t)u.pm * 256 * BW;
            if (t == 1) {
                float* kp = kmp + (size_t)(u.pm * 2 + wr) * BW + (pn & 1) * 256;
#pragma unroll
                for (int bj = 0; bj < 2; ++bj)
#pragma unroll
                    for (int n = 0; n < 2; ++n) { f32x4 s = {0.f, 0.f, 0.f, 0.f};
#pragma unroll
                        for (int ai = 0; ai < 2; ++ai)
#pragma unroll
                            for (int m = 0; m < 4; ++m) s += acc[ai][bj][m][n] * rs[ai][m];
#pragma unroll
                        for (int e = 0; e < 4; ++e) { s[e] += xshfl<1>(s[e]); s[e] += xshfl<2>(s[e]); s[e] += xshfl<4>(s[e]); s[e] += xshfl<8>(s[e]); }
                        if (fr == 0) *(f32x4*)bo(kp, (lcol + (unsigned)(bj * 128 + 4 * n)) * 4u) = s; }
            }
#pragma unroll
            for (int ai = 0; ai < 2; ++ai)
#pragma unroll
                for (int m = 0; m < 4; ++m) { const float f = rs[ai][m] * sc; const unsigned o = lb + (unsigned)(ai * 128 + m * 16) * BW * 2u;
#pragma unroll
                    for (int bj = 0; bj < 2; ++bj) st_bf16x8(bo(base, o + bj * 256u), acc[ai][bj][m][0] * f, acc[ai][bj][m][1] * f); }
        } else {
            bf16_t* base = ub + (size_t)u.pm * 256 * BW + (pn - 12) * 128;
#pragma unroll
            for (int ai = 0; ai < 2; ++ai)
#pragma unroll
                for (int m = 0; m < 4; ++m) { const float f = rs[ai][m] * rs[ai][m];
                    st_bf16x8(bo(base, lb + (unsigned)(ai * 128 + m * 16) * BW * 2u), acc[ai][0][m][0] * acc[ai][1][m][0] * f, acc[ai][0][m][1] * acc[ai][1][m][1] * f); }
        }
    }
};
struct EpiC1 {
    unsigned char* ws; const float* bgate;
    __device__ __forceinline__ bf16_t* gtile(int s, int pm, int pn) const {
        const size_t off = WS_GA + (size_t)s * (48 * MiB) + ((s == 2 && pm >= 32) ? 32 * MiB : 0) + ((size_t)pm * 256 * DM + pn * 256) * 2;
        return (bf16_t*)(ws + off);
    }
    __device__ __forceinline__ void operator()(EPI_ARGS) const {
        bf16_t* mg = (bf16_t*)(ws + WS_MG); const float* ss = (const float*)(ws + WS_SSA);
        const int sg = u.seg; unsigned lrow = (unsigned)(wr * 64 + fr), lcol = (unsigned)(wc * 32 + 8 * fq);
        asm volatile("" : "+v"(lrow), "+v"(lcol));
        const unsigned lb = (lrow * DM + lcol) * 2u;
        bf16_t* gp = gtile(sg < 3 ? sg : sg - 3, u.pm, u.pn);
        if (sg < 3) {
            const float* bg = bgate + sg * DM + u.pn * 256;
            f32x4 bv[2][2];
#pragma unroll
            for (int bj = 0; bj < 2; ++bj) { bv[bj][0] = *(const f32x4*)bo(bg, (lcol + bj * 128u) * 4u) * (-LOG2E); bv[bj][1] = *(const f32x4*)bo(bg, (lcol + bj * 128u + 4u) * 4u) * (-LOG2E); }
            float rs[2][4]; rstd8(rs, ss, u.pm, lrow);
#pragma unroll
            for (int ai = 0; ai < 2; ++ai)
#pragma unroll
                for (int m = 0; m < 4; ++m) { const float rn = rs[ai][m] * (-LOG2E); const unsigned o = lb + (unsigned)(ai * 128 + m * 16) * DM * 2u;
#pragma unroll
                    for (int bj = 0; bj < 2; ++bj) { f32x4 v[2];
#pragma unroll
                        for (int n = 0; n < 2; ++n) { const f32x4 x = acc[ai][bj][m][n] * rn + bv[bj][n];
#pragma unroll
                            for (int e = 0; e < 4; ++e) v[n][e] = __builtin_amdgcn_rcpf(1.0f + __builtin_amdgcn_exp2f(x[e])); }
                        st_bf16x8(bo(gp, o + bj * 256u), v[0], v[1]); } }
        } else {
            bf16_t* mp = mg + (size_t)u.pm * 256 * DM + u.pn * 256;
#pragma unroll
            for (int ai = 0; ai < 2; ++ai) {
                constexpr int m0 = 0;
                u32x4 gw_[4][2], pw_[4][2];
#pragma unroll
                for (int mm = 0; mm < 4; ++mm)
#pragma unroll
                    for (int bj = 0; bj < 2; ++bj) { const unsigned o = lb + (unsigned)(ai * 128 + (m0 + mm) * 16) * DM * 2u + bj * 256u;
                        gw_[mm][bj] = *(const u32x4*)bo((const bf16_t*)gp, o); if (sg > 3) pw_[mm][bj] = *(const u32x4*)bo((const bf16_t*)mp, o); }
#pragma unroll
                for (int mm = 0; mm < 4; ++mm)
#pragma unroll
                    for (int bj = 0; bj < 2; ++bj) { const int m = m0 + mm; const unsigned o = lb + (unsigned)(ai * 128 + m * 16) * DM * 2u + bj * 256u; const u32x4 g = gw_[mm][bj];
                        f32x4 v0 = acc[ai][bj][m][0] * (f32x4){bf_lo(g.x), bf_hi(g.x), bf_lo(g.y), bf_hi(g.y)}, v1 = acc[ai][bj][m][1] * (f32x4){bf_lo(g.z), bf_hi(g.z), bf_lo(g.w), bf_hi(g.w)};
                        if (sg > 3) { const u32x4 p = pw_[mm][bj]; v0 += (f32x4){bf_lo(p.x), bf_hi(p.x), bf_lo(p.y), bf_hi(p.y)}; v1 += (f32x4){bf_lo(p.z), bf_hi(p.z), bf_lo(p.w), bf_hi(p.w)}; }
                        st_bf16x8(bo(mp, o), v0, v1); }
                asm volatile("" ::: "memory");
            }
        }
    }
};
struct EpiRes {
    unsigned char* ws; int toA; LAS float* red;
    __device__ __forceinline__ void operator()(EPI_ARGS) const {
        bf16_t* xb = (bf16_t*)(ws + WS_XB); float* sso = (float*)(ws + (toA ? WS_SSA : WS_SSB));
        unsigned lrow = (unsigned)(wr * 64 + fr), lcol = (unsigned)(wc * 32 + 8 * fq);
        asm volatile("" : "+v"(lrow), "+v"(lcol));
        const unsigned le = (lrow * DM + lcol) * 2u, lr4 = lrow * 4u + (unsigned)wc;
        bf16_t* xp = xb + (size_t)u.pm * 256 * DM + u.pn * 256;
#pragma unroll
        for (int ai = 0; ai < 2; ++ai) {
            u32x4 bs[4][2];
#pragma unroll
            for (int m = 0; m < 4; ++m)
#pragma unroll
                for (int bj = 0; bj < 2; ++bj) bs[m][bj] = *(const u32x4*)bo((const bf16_t*)xp, le + (unsigned)(ai * 128 + m * 16) * DM * 2u + bj * 256u);
#pragma unroll
            for (int m = 0; m < 4; ++m) { float sq = 0.f;
#pragma unroll
                for (int bj = 0; bj < 2; ++bj) { const u32x4 w = bs[m][bj];
                    const f32x4 x0 = (f32x4){bf_lo(w.x), bf_hi(w.x), bf_lo(w.y), bf_hi(w.y)} + acc[ai][bj][m][0], x1 = (f32x4){bf_lo(w.z), bf_hi(w.z), bf_lo(w.w), bf_hi(w.w)} + acc[ai][bj][m][1];
                    st_bf16x8(bo(xp, le + (unsigned)(ai * 128 + m * 16) * DM * 2u + bj * 256u), x0, x1);
                    sq += (x0[0] * x0[0] + x0[1] * x0[1]) + (x0[2] * x0[2] + x0[3] * x0[3]) + (x1[0] * x1[0] + x1[1] * x1[1]) + (x1[2] * x1[2] + x1[3] * x1[3]); }
                sq += xshfl<16>(sq); sq = sum32(sq);
                if (fq == 0) red[lr4 + (unsigned)(ai * 128 + m * 16) * 4u] = sq; }
            asm volatile("" ::: "memory");
        }
        asm volatile("s_waitcnt lgkmcnt(0)\n\ts_barrier" ::: "memory");
        { const int t = ((wr * 4 + wc) * 4 + fq) * 16 + fr; if (t < 256) { const f32x4 r = *(const LAS f32x4*)(red + t * 4); sso[((size_t)u.pm * 256 + t) * 4 + u.pn] = (r.x + r.y) + (r.z + r.w); } }
        asm volatile("s_waitcnt lgkmcnt(0)\n\ts_barrier" ::: "memory");
    }
};
struct EpiFfn {
    unsigned char* ws;
    __device__ __forceinline__ void operator()(EPI_ARGS) const {
        bf16_t* act = (bf16_t*)(ws + WS_ACT); const float* ss = (const float*)(ws + WS_SSB);
        unsigned lrow = (unsigned)(wr * 64 + fr), lcol = (unsigned)(wc * 32 + 8 * fq);
        asm volatile("" : "+v"(lrow), "+v"(lcol));
        const unsigned lb = (lrow * DFF + lcol) * 2u;
        bf16_t* ap = act + (size_t)u.pm * 256 * DFF + u.pn * 128;
        float rs[2][4]; rstd8(rs, ss, u.pm, lrow);
#pragma unroll
        for (int ai = 0; ai < 2; ++ai)
#pragma unroll
            for (int m = 0; m < 4; ++m) { const float r1 = rs[ai][m], rn = r1 * (-LOG2E); f32x4 v[2];
#pragma unroll
                for (int n = 0; n < 2; ++n) { const f32x4 g = acc[ai][0][m][n], up = acc[ai][1][m][n] * (r1 * r1);
#pragma unroll
                    for (int e = 0; e < 4; ++e) v[n][e] = g[e] * up[e] * __builtin_amdgcn_rcpf(1.0f + __builtin_amdgcn_exp2f(g[e] * rn)); }
                st_bf16x8(bo(ap, lb + (unsigned)(ai * 128 + m * 16) * DFF * 2u), v[0], v[1]); }
    }
};

struct GCfg {
    int mode;
    int N, nseg, lda, ldb, nt, toA;
    const bf16_t* A; const bf16_t* B;
    unsigned char* ws; const float* bgate; LAS float* red;
};
struct ProbAny {
    const GCfg* c;
    __device__ __forceinline__ void seg(const pg8::Unit& u, pg8::Seg& s) const {
        if (c->mode == 1 && u.seg >= 3) {
            const int br = u.seg - 3; const bf16_t* O = (const bf16_t*)(c->ws + WS_QA + (size_t)br * (48 * MiB)); const bf16_t* Wp = (const bf16_t*)(c->ws + WS_WP);
            s.A = (const char*)(O + (size_t)u.pm * 256 * BW); s.B = (const char*)(Wp + ((size_t)br * DM + (size_t)u.pn * 256) * BW);
            s.hA = 128u * BW * 2u; s.hB = 128u * BW * 2u; s.lda = BW; s.ldb = BW; s.nt = BW / 64;
        } else {
            const int so = (c->mode == 1) ? u.seg * DM : 0;
            s.A = (const char*)(c->A + (size_t)u.pm * 256 * c->lda); s.B = (const char*)(c->B + ((size_t)so + (size_t)u.pn * 256) * c->ldb);
            s.hA = 128u * (unsigned)c->lda * 2u; s.hB = 128u * (unsigned)c->ldb * 2u; s.lda = c->lda; s.ldb = c->ldb; s.nt = c->nt;
        }
    }
};
struct EpiAny {
    const GCfg* c;
    __device__ __forceinline__ void operator()(EPI_ARGS) const {
        const int m_ = c->mode;
        if (m_ == 0) EpiIn{c->ws}(acc, u, wr, wc, fr, fq);
        else if (m_ == 1) EpiC1{c->ws, c->bgate}(acc, u, wr, wc, fr, fq);
        else if (m_ == 2) EpiRes{c->ws, c->toA, c->red}(acc, u, wr, wc, fr, fq);
        else EpiFfn{c->ws}(acc, u, wr, wc, fr, fq);
    }
};

namespace att {
__device__ __forceinline__ constexpr int crow(int r, int hi) { return (r & 3) + 8 * (r >> 2) + 4 * hi; }
__device__ __forceinline__ float swap_lo(float x, float& hiv) { auto rr = __builtin_amdgcn_permlane32_swap(__float_as_uint(x), __float_as_uint(x), false, false); hiv = __uint_as_float(rr[1]); return __uint_as_float(rr[0]); }
__device__ __forceinline__ s16x4 vtr(const LAS unsigned char* p) { return __builtin_bit_cast(s16x4, __builtin_amdgcn_ds_read_tr16_b64_v4i16((LAS s16x4*)p)); }
__device__ __forceinline__ void load_k(bf16x8 (&kf)[8], const bf16_t* Kh, int j0, int r32, int hi) {
    const bf16_t* p = Kh + (size_t)(j0 + r32) * BW + hi * 8;
#pragma unroll
    for (int d0 = 0; d0 < 4; ++d0) { kf[2 * d0] = *(const bf16x8*)(p + d0 * 16); kf[2 * d0 + 1] = *(const bf16x8*)(p + (size_t)32 * BW + d0 * 16); }
}
__device__ __forceinline__ void load_v(u32x4 (&vv)[8], const bf16_t* Vh, int j0, int lane) {
    const bf16_t* p = Vh + (size_t)(j0 + (lane >> 3)) * BW + (lane & 7) * 8;
#pragma unroll
    for (int i = 0; i < 8; ++i) vv[i] = *(const u32x4*)(p + (size_t)(8 * i) * BW);
}
__device__ __forceinline__ void stage_v(LAS unsigned char* vst, const u32x4 (&vv)[8], int lane) {
    const int c = lane & 7;
#pragma unroll
    for (int i = 0; i < 8; ++i) { const int key = 8 * i + (lane >> 3);
        *(LAS u32x4*)(vst + ((c >> 2) * 4 + (key >> 4)) * 1024 + (key & 15) * 64 + (c & 3) * 16) = vv[i]; }
}
__device__ __forceinline__ void qk(f32x16& p0, f32x16& p1, const bf16x8 (&kf)[8], const bf16x8 (&qr)[4]) {
#pragma unroll
    for (int d0 = 0; d0 < 4; ++d0) { p0 = __builtin_amdgcn_mfma_f32_32x32x16_bf16(kf[2 * d0], qr[d0], p0, 0, 0, 0); p1 = __builtin_amdgcn_mfma_f32_32x32x16_bf16(kf[2 * d0 + 1], qr[d0], p1, 0, 0, 0); }
}
__device__ __forceinline__ void pv(f32x16& o0, f32x16& o1, const f32x16& p0, const f32x16& p1, const LAS unsigned char* vst, int lane) {
    const int hi = lane >> 5;
    const LAS unsigned char* vp = vst + ((lane >> 4) & 1) * 32 + (lane & 3) * 8 + (4 * hi + ((lane & 15) >> 2)) * 64;
    u32x4 pw[4];
    pw[0] = (u32x4){cvt_pk_bf16(p0[0], p0[1]), cvt_pk_bf16(p0[2], p0[3]), cvt_pk_bf16(p0[4], p0[5]), cvt_pk_bf16(p0[6], p0[7])};
    pw[1] = (u32x4){cvt_pk_bf16(p0[8], p0[9]), cvt_pk_bf16(p0[10], p0[11]), cvt_pk_bf16(p0[12], p0[13]), cvt_pk_bf16(p0[14], p0[15])};
    pw[2] = (u32x4){cvt_pk_bf16(p1[0], p1[1]), cvt_pk_bf16(p1[2], p1[3]), cvt_pk_bf16(p1[4], p1[5]), cvt_pk_bf16(p1[6], p1[7])};
    pw[3] = (u32x4){cvt_pk_bf16(p1[8], p1[9]), cvt_pk_bf16(p1[10], p1[11]), cvt_pk_bf16(p1[12], p1[13]), cvt_pk_bf16(p1[14], p1[15])};
#pragma unroll
    for (int ks = 0; ks < 4; ++ks) {
        const s16x4 a0 = vtr(vp + ks * 1024), a1 = vtr(vp + ks * 1024 + 512), b0 = vtr(vp + 4096 + ks * 1024), b1 = vtr(vp + 4096 + ks * 1024 + 512);
        const bf16x8 v0 = {a0[0], a0[1], a0[2], a0[3], a1[0], a1[1], a1[2], a1[3]}, v1 = {b0[0], b0[1], b0[2], b0[3], b1[0], b1[1], b1[2], b1[3]};
        const bf16x8 pa = __builtin_bit_cast(bf16x8, pw[ks]);
        o0 = __builtin_amdgcn_mfma_f32_32x32x16_bf16(pa, v0, o0, 0, 0, 0);
        o1 = __builtin_amdgcn_mfma_f32_32x32x16_bf16(pa, v1, o1, 0, 0, 0);
    }
}
__device__ __forceinline__ void store_o(bf16_t* Ow, const f32x16& o0, const f32x16& o1, const float (&rsc)[16], LAS unsigned char* stg, int lane) {
    const int r32 = lane & 31, hi = lane >> 5;
    LAS bf16_t* s = (LAS bf16_t*)stg;
#pragma unroll
    for (int r = 0; r < 16; ++r) { const int orow = crow(r, hi);
        s[orow * 64 + r32] = (bf16_t)(cvt_pk_bf16(o0[r] * rsc[r], 0.f) & 0xffffu); s[orow * 64 + 32 + r32] = (bf16_t)(cvt_pk_bf16(o1[r] * rsc[r], 0.f) & 0xffffu); }
    LDS_WAIT();
#pragma unroll
    for (int i = 0; i < 4; ++i) { const int row = i * 8 + (lane >> 3), ch = lane & 7; const u32x4 v = *(const LAS u32x4*)(stg + row * 128 + ch * 16); *(u32x4*)(Ow + (size_t)row * BW + ch * 8) = v; }
    LDS_WAIT();
}

__device__ __forceinline__ void sb_item(bf16_t* Q, const bf16_t* K, const bf16_t* V, int b, int h, int q0, LAS unsigned char* vst, int lane) {
    asm volatile("" : "+v"(lane));
    const int r32 = lane & 31, hi = lane >> 5;
    const size_t rowbase = (size_t)b * SEQ;
    bf16_t* Qw = Q + (rowbase + q0) * BW + h * HD;
    bf16x8 qr[4];
#pragma unroll
    for (int d0 = 0; d0 < 4; ++d0) qr[d0] = *(const bf16x8*)(Qw + (size_t)r32 * BW + d0 * 16 + hi * 8);
    const bf16_t* Kh = K + rowbase * BW + h * HD; const bf16_t* Vh = V + rowbase * BW + h * HD;
    f32x16 o0 = {}, o1 = {}; float A2 = 0.f;
    const int tq = q0 + r32;
    bf16x8 kf[8]; load_k(kf, Kh, ((q0 + 30) >> 6) * 64, r32, hi);
    for (int kt = (q0 + 30) >> 6; kt >= 0; --kt) {
        const int j0 = kt * 64;
        f32x16 p0 = {}, p1 = {};
        qk(p0, p1, kf, qr);
        asm volatile("" : "+v"(p0), "+v"(p1) :: "memory");
        u32x4 vv[8]; load_v(vv, Vh, j0, lane);
        if (kt > 0) load_k(kf, Kh, j0 - 64, r32, hi);
        const bool diag = (j0 + 63 >= q0);
        f32x16 l0, l1;
#pragma unroll
        for (int r = 0; r < 16; ++r) {
            { const float z = p0[r]; const float t = __builtin_amdgcn_exp2f(-__builtin_fabsf(z)); float l = -(__builtin_fmaxf(z, 0.f) + __builtin_amdgcn_logf(1.0f + t)); if (diag && (j0 + crow(r, hi) >= tq)) l = 0.f; l0[r] = l; }
            { const float z = p1[r]; const float t = __builtin_amdgcn_exp2f(-__builtin_fabsf(z)); float l = -(__builtin_fmaxf(z, 0.f) + __builtin_amdgcn_logf(1.0f + t)); if (diag && (j0 + 32 + crow(r, hi) >= tq)) l = 0.f; l1[r] = l; }
        }
        float carry = A2;
#pragma unroll
        for (int half = 1; half >= 0; --half) {
            f32x16& l = half ? l1 : l0; f32x16& p = half ? p1 : p0;
            float T[4];
#pragma unroll
            for (int g = 0; g < 4; ++g) { l[4 * g + 2] += l[4 * g + 3]; l[4 * g + 1] += l[4 * g + 2]; l[4 * g] += l[4 * g + 1]; T[g] = l[4 * g]; }
            float Tl[4], Th[4];
#pragma unroll
            for (int g = 0; g < 4; ++g) Tl[g] = swap_lo(T[g], Th[g]);
            float E = carry;
#pragma unroll
            for (int g = 3; g >= 0; --g) { const float eh = E; E += Th[g]; const float el = E; E += Tl[g]; const float off = hi ? eh : el;
                l[4 * g] += off; l[4 * g + 1] += off; l[4 * g + 2] += off; l[4 * g + 3] += off; }
            carry = E;
#pragma unroll
            for (int r = 0; r < 16; ++r) { float w = __builtin_amdgcn_exp2f(p[r] + l[r]); if (diag && (j0 + 32 * half + crow(r, hi) >= tq)) w = 0.f; p[r] = w; }
        }
        A2 = carry;
        stage_v(vst, vv, lane); LDS_WAIT();
        pv(o0, o1, p0, p1, vst, lane);
        LDS_WAIT();
        if (__all(A2 < -150.2f)) break;
    }
    float one[16];
#pragma unroll
    for (int r = 0; r < 16; ++r) one[r] = 1.0f;
    store_o(Qw, o0, o1, one, vst, lane);
}

constexpr float MOBA_THR = 8.0f;
__device__ __forceinline__ unsigned moba_gate(const bf16_t* Qw, const bf16_t* Kown, int blk, int tq0, float sl2, const LAS float* km, const LAS float* kbn, int lane) {
    asm volatile("" : "+v"(lane));
    const int r32 = lane & 31, hi = lane >> 5;
    unsigned sel = 0u;
    if (blk > 0) {
        float qf[64];
        { const u32x4* qp = (const u32x4*)(Qw + (size_t)r32 * BW);
#pragma unroll
          for (int c = 0; c < 8; ++c) { const u32x4 x = qp[c]; qf[8 * c] = bf_lo(x.x); qf[8 * c + 1] = bf_hi(x.x); qf[8 * c + 2] = bf_lo(x.y); qf[8 * c + 3] = bf_hi(x.y); qf[8 * c + 4] = bf_lo(x.z); qf[8 * c + 5] = bf_hi(x.z); qf[8 * c + 6] = bf_lo(x.w); qf[8 * c + 7] = bf_hi(x.w); } }
        float v1 = -INFINITY, v2 = -INFINITY, v3 = -INFINITY; int i1 = -1, i2 = -1, i3 = -1;
#define TOP_INS(v, n) do { const bool b1 = (v) > v1 || ((v) == v1 && (n) < i1), b2 = (v) > v2 || ((v) == v2 && (n) < i2), b3 = (v) > v3 || ((v) == v3 && (n) < i3); \
            if (b3) { if (b2) { v3 = v2; i3 = i2; if (b1) { v2 = v1; i2 = i1; v1 = (v); i1 = (n); } else { v2 = (v); i2 = (n); } } else { v3 = (v); i3 = (n); } } } while (0)
#pragma unroll 1
        for (int i = 0; i < 16; ++i) { const int n = 16 * hi + i;
            const LAS f32x4* kr = (const LAS f32x4*)(km + n * 64); float d0 = 0.f, d1 = 0.f, d2 = 0.f, d3 = 0.f;
#pragma unroll
            for (int c = 0; c < 16; ++c) { const f32x4 kk = kr[c]; d0 += qf[4 * c] * kk[0]; d1 += qf[4 * c + 1] * kk[1]; d2 += qf[4 * c + 2] * kk[2]; d3 += qf[4 * c + 3] * kk[3]; }
            const float d = (d0 + d1) + (d2 + d3);
            if (n < blk) TOP_INS(d, n); }
        { float x0, x1; x0 = swap_lo(v1, x1); const float pv1 = hi ? x0 : x1; x0 = swap_lo(v2, x1); const float pv2 = hi ? x0 : x1; x0 = swap_lo(v3, x1); const float pv3 = hi ? x0 : x1;
          x0 = swap_lo(__int_as_float(i1), x1); const int pi1 = __float_as_int(hi ? x0 : x1); x0 = swap_lo(__int_as_float(i2), x1); const int pi2 = __float_as_int(hi ? x0 : x1); x0 = swap_lo(__int_as_float(i3), x1); const int pi3 = __float_as_int(hi ? x0 : x1);
          TOP_INS(pv1, pi1); TOP_INS(pv2, pi2); TOP_INS(pv3, pi3); }
#undef TOP_INS
        float qn2 = 0.f, zs = 0.f;
        { const u32x4* kp = (const u32x4*)(Kown + (size_t)r32 * BW);
#pragma unroll
          for (int c = 0; c < 8; ++c) { const u32x4 x = kp[c];
              zs += qf[8 * c] * bf_lo(x.x) + qf[8 * c + 1] * bf_hi(x.x) + qf[8 * c + 2] * bf_lo(x.y) + qf[8 * c + 3] * bf_hi(x.y) + qf[8 * c + 4] * bf_lo(x.z) + qf[8 * c + 5] * bf_hi(x.z) + qf[8 * c + 6] * bf_lo(x.w) + qf[8 * c + 7] * bf_hi(x.w);
              qn2 += (qf[8 * c] * qf[8 * c] + qf[8 * c + 1] * qf[8 * c + 1]) + (qf[8 * c + 2] * qf[8 * c + 2] + qf[8 * c + 3] * qf[8 * c + 3]) + (qf[8 * c + 4] * qf[8 * c + 4] + qf[8 * c + 5] * qf[8 * c + 5]) + (qf[8 * c + 6] * qf[8 * c + 6] + qf[8 * c + 7] * qf[8 * c + 7]); } }
        const float qn = sqrtf(qn2) * 1.001f, thr = zs - 151.0f; const int tq = tq0 + r32;
#define KEEP(i_) ((i_) >= 0 && !(qn * kbn[(i_)] - sl2 * (float)(tq - (256 * (i_) + 255)) < thr))
        if (KEEP(i1)) sel |= 1u << i1; if (KEEP(i2)) sel |= 1u << i2; if (KEEP(i3)) sel |= 1u << i3;
#undef KEEP
    }
    return sel;
}
__device__ __forceinline__ void moba_tile(f32x16& o0, f32x16& o1, float& mrow, float& lsum, const bf16x8 (&qr)[4], bf16x8 (&kf)[8], const bf16_t* Kh, const bf16_t* Vh, int j0, int jn, float lb, float sl2, bool diag, int tq,
                                          LAS unsigned char* vst, LAS float* wsf, int lane) {
    const int r32 = lane & 31, hi = lane >> 5;
    f32x16 p0, p1;
#pragma unroll
    for (int r = 0; r < 16; ++r) { p0[r] = lb; p1[r] = lb + 32.0f * sl2; }
    qk(p0, p1, kf, qr);
    asm volatile("" : "+v"(p0), "+v"(p1) :: "memory");
    u32x4 vv[8]; load_v(vv, Vh, j0, lane);
    if (jn >= 0) load_k(kf, Kh, jn, r32, hi);
#pragma unroll
    for (int r = 0; r < 16; ++r) { p0[r] = __builtin_fmaf(sl2, (float)crow(r, 0), p0[r]); p1[r] = __builtin_fmaf(sl2, (float)crow(r, 0), p1[r]); }
    if (diag) {
#pragma unroll
        for (int r = 0; r < 16; ++r) { if (j0 + crow(r, hi) > tq) p0[r] = -INFINITY; if (j0 + 32 + crow(r, hi) > tq) p1[r] = -INFINITY; }
    }
    float rm = __builtin_fmaxf(p0[0], p1[0]);
#pragma unroll
    for (int r = 1; r < 16; ++r) rm = __builtin_fmaxf(rm, __builtin_fmaxf(p0[r], p1[r]));
    { float x1; const float x0 = swap_lo(rm, x1); rm = __builtin_fmaxf(x0, x1); }
    if (__any(rm > mrow + MOBA_THR)) {
        const float mn = __builtin_fmaxf(mrow, rm); const float f = __builtin_amdgcn_exp2f(mrow - mn); mrow = mn; lsum *= f;
        if (hi == 0) wsf[r32] = f;
        LDS_WAIT();
#pragma unroll
        for (int r = 0; r < 16; ++r) { const float fr_ = wsf[crow(r, hi)]; o0[r] *= fr_; o1[r] *= fr_; }
        LDS_WAIT();
    }
    float ps = 0.f;
#pragma unroll
    for (int r = 0; r < 16; ++r) { p0[r] = __builtin_amdgcn_exp2f(p0[r] - mrow); p1[r] = __builtin_amdgcn_exp2f(p1[r] - mrow); ps += p0[r] + p1[r]; }
    lsum += ps;
    stage_v(vst, vv, lane); LDS_WAIT();
    pv(o0, o1, p0, p1, vst, lane);
    LDS_WAIT();
}
__device__ __forceinline__ void moba_item(const bf16_t* Q, const bf16_t* K, const bf16_t* V, int b, int h, int blk, int n, int tix, const LAS unsigned char* lists, const LAS unsigned* cnt,
                                          const LAS unsigned* selm, unsigned char* recO, float* recML, LAS unsigned char* vst, LAS float* wsf, LAS unsigned* trow, int lane) {
    asm volatile("" : "+v"(lane));
    const int r32 = lane & 31, hi = lane >> 5; const size_t rowbase = (size_t)b * SEQ; const bool own = (n == blk);
    int q; bool valid; unsigned slot;
    if (own) { q = 32 * tix + r32; valid = true; slot = (unsigned)q * 4u + 3u; }
    else { const int cn = (int)cnt[n]; const int p = 32 * tix + r32; valid = p < cn; q = (int)lists[n * 256 + (valid ? p : cn - 1)];
           slot = (unsigned)q * 4u + (unsigned)__builtin_popcount(selm[q] & ((1u << n) - 1u)); }
    if (hi == 0) trow[r32] = slot | (valid ? 0x80000000u : 0u);
    const int tq = blk * 256 + q;
    const bf16_t* Qrow = Q + (rowbase + tq) * BW + h * HD + hi * 8;
    bf16x8 qr[4];
#pragma unroll
    for (int d0 = 0; d0 < 4; ++d0) qr[d0] = *(const bf16x8*)(Qrow + d0 * 16);
    const bf16_t* Kh = K + rowbase * BW + h * HD; const bf16_t* Vh = V + rowbase * BW + h * HD;
    const float sl2 = __builtin_amdgcn_exp2f(-(float)(h + 1)) * LOG2E;
    f32x16 o0 = {}, o1 = {}; float mrow = -INFINITY, lsum = 0.f;
    const int ntile = own ? (tix >> 1) + 1 : 4;
    bf16x8 kf[8]; load_k(kf, Kh, n * 256, r32, hi);
#pragma unroll 1
    for (int i = 0; i < ntile; ++i) { const int j0 = n * 256 + i * 64;
        moba_tile(o0, o1, mrow, lsum, qr, kf, Kh, Vh, j0, i < ntile - 1 ? j0 + 64 : -1, sl2 * (float)(j0 + 4 * hi - tq), sl2, own && i == ntile - 1, tq, vst, wsf, lane); }
    { float x1; const float x0 = swap_lo(lsum, x1); lsum = x0 + x1; }
    if (hi == 0) { wsf[32 + r32] = lsum; if (valid) *(f32x2*)(recML + 2 * slot) = (f32x2){mrow, lsum}; }
    LDS_WAIT();
    LAS bf16_t* s = (LAS bf16_t*)vst;
#pragma unroll
    for (int r = 0; r < 16; ++r) { const int orow = crow(r, hi); const float rl = __builtin_amdgcn_rcpf(wsf[32 + orow]);
        s[orow * 64 + r32] = (bf16_t)(cvt_pk_bf16(o0[r] * rl, 0.f) & 0xffffu); s[orow * 64 + 32 + r32] = (bf16_t)(cvt_pk_bf16(o1[r] * rl, 0.f) & 0xffffu); }
    LDS_WAIT();
#pragma unroll
    for (int i = 0; i < 4; ++i) { const int row = i * 8 + (lane >> 3), ch = lane & 7; const unsigned tr = trow[row]; const u32x4 v = *(const LAS u32x4*)(vst + row * 128 + ch * 16);
        if (tr & 0x80000000u) *(u32x4*)(recO + (size_t)(tr & 0x7fffffffu) * 128 + ch * 16) = v; }
    LDS_WAIT();
}
__device__ __forceinline__ void moba_merge(bf16_t* Q, int b, int h, int blk, int w, const LAS unsigned* selm, const unsigned char* recO, const float* recML, LAS float* wsf, int lane) {
    asm volatile("" : "+v"(lane));
    const int r32 = lane & 31, hi = lane >> 5; const size_t rowbase = (size_t)b * SEQ; const int q0 = blk * 256 + w * 32;
    const int ql = w * 32 + r32; const int c = __builtin_popcount(selm[ql]);
    float mi[4], li[4]; float mx = -INFINITY;
#pragma unroll
    for (int k = 0; k < 4; ++k) { mi[k] = -INFINITY; li[k] = 0.f; if (k == 3 || k < c) { const f32x2 ml = __builtin_nontemporal_load((const f32x2*)(recML + 2 * ((unsigned)ql * 4u + k))); mi[k] = ml.x; li[k] = ml.y; } mx = __builtin_fmaxf(mx, mi[k]); }
    float wg[4], L = 0.f;
#pragma unroll
    for (int k = 0; k < 4; ++k) { wg[k] = (k == 3 || k < c) ? __builtin_amdgcn_exp2f(mi[k] - mx) * li[k] : 0.f; L += wg[k]; }
    const float rL = 1.0f / L;
    if (hi == 0) { wsf[r32] = wg[0] * rL; wsf[32 + r32] = wg[1] * rL; wsf[64 + r32] = wg[2] * rL; wsf[96 + r32] = wg[3] * rL; }
    LDS_WAIT();
    bf16_t* Qw = Q + (rowbase + q0) * BW + h * HD;
#pragma unroll
    for (int i = 0; i < 4; ++i) { const int row = i * 8 + (lane >> 3), ch = lane & 7; f32x4 v0 = {0.f, 0.f, 0.f, 0.f}, v1 = {0.f, 0.f, 0.f, 0.f};
        const unsigned rslot = (unsigned)(w * 32 + row) * 4u;
#pragma unroll
        for (int k = 0; k < 4; ++k) { const float ak = wsf[32 * k + row];
            if (ak != 0.f) { const u32x4 pw = __builtin_nontemporal_load((const u32x4*)(recO + (size_t)(rslot + k) * 128 + ch * 16));
                v0 += ak * (f32x4){bf_lo(pw.x), bf_hi(pw.x), bf_lo(pw.y), bf_hi(pw.y)}; v1 += ak * (f32x4){bf_lo(pw.z), bf_hi(pw.z), bf_lo(pw.w), bf_hi(pw.w)}; } }
        st_bf16x8(Qw + (size_t)row * BW + ch * 8, v0, v1); }
    LDS_WAIT();
}
}

#define XB_TMO      128
#define XB_XCNT(j)  (256  + 64 * (j))
#define XB_XSUB(j)  (1280 + 64 * (j))
#define XB_XGEN(j)  (2304 + 64 * (j))
#define XB_TOP      3328
#define XB_TOPGEN   3392
#define XCD_BAR_WORDS 3456
#define XB_SPIN_CAP (1u << 18)
__device__ __forceinline__ unsigned xb_ld(unsigned* p)              { return __hip_atomic_load(p, __ATOMIC_RELAXED, __HIP_MEMORY_SCOPE_AGENT); }
__device__ __forceinline__ unsigned xb_add(unsigned* p, unsigned v) { return __hip_atomic_fetch_add(p, v, __ATOMIC_RELAXED, __HIP_MEMORY_SCOPE_AGENT); }
__device__ __forceinline__ unsigned xb_xcc_id() { return (unsigned)__builtin_amdgcn_s_getreg((3 << 11) | 20) & 0xFu; }
#define XB_SPIN(cond, bar) do { unsigned _sp = 0; while (cond) { __builtin_amdgcn_s_sleep(1); \
    if ((++_sp & 255u) == 0u) { if (xb_ld(&(bar)[XB_TMO])) break; if (_sp > XB_SPIN_CAP) { atomicAdd(&(bar)[XB_TMO], 1u); break; } } } } while (0)
struct XcdBarrier { unsigned* bar; unsigned x; volatile LAS unsigned* st; };
__device__ __forceinline__ XcdBarrier xcd_barrier_post(unsigned* bar, volatile LAS unsigned* st) {
    XcdBarrier b; b.bar = bar; b.x = xb_xcc_id(); b.st = st;
    if (threadIdx.x == 0) (void)xb_add(&bar[XB_XCNT(b.x)], 1u);
    return b;
}
__device__ __forceinline__ void xcd_barrier_complete(unsigned* bar, unsigned x, unsigned& nloc, unsigned& nx) {
    const unsigned G = gridDim.x * gridDim.y * gridDim.z;
    unsigned sum, cnt, mine, sp = 0u;
    for (;;) {
        sum = 0u; cnt = 0u; mine = 0u;
#pragma unroll
        for (unsigned j = 0; j < 16; ++j) { const unsigned c = xb_ld(&bar[XB_XCNT(j)]); sum += c; cnt += (c > 0u) ? 1u : 0u; mine = (j == x) ? c : mine; }
        if (sum == G) break;
        __builtin_amdgcn_s_sleep(1);
        if ((++sp & 255u) == 0u) { if (xb_ld(&bar[XB_TMO])) break; if (sp > XB_SPIN_CAP) { atomicAdd(&bar[XB_TMO], 1u); break; } }
    }
    nloc = mine > 0u ? mine : 1u; nx = cnt > 0u ? cnt : 1u;
}
__device__ __forceinline__ void xcd_barrier(const XcdBarrier& b, int tid_) {
    asm volatile("s_waitcnt vmcnt(0)" ::: "memory");
    __syncthreads();
    if (tid_ == 0) {
        unsigned* bar = b.bar;
        __builtin_amdgcn_s_waitcnt(0);
        unsigned nloc = b.st[0], nx = b.st[1];
        if (nloc == 0u) { xcd_barrier_complete(bar, b.x, nloc, nx); b.st[0] = nloc; b.st[1] = nx; }
        const unsigned old = xb_add(&bar[XB_XSUB(b.x)], 1u);
        const unsigned gen = old / nloc;
        if (old + 1u == (gen + 1u) * nloc) {
            __builtin_amdgcn_fence(__ATOMIC_RELEASE, "agent");
            asm volatile("s_waitcnt vmcnt(0)" ::: "memory");
            const unsigned og = xb_add(&bar[XB_TOP], 1u);
            const unsigned tg = og / nx;
            if (og + 1u == (tg + 1u) * nx) xb_add(&bar[XB_TOPGEN], 1u);
            else XB_SPIN(xb_ld(&bar[XB_TOPGEN]) == tg, bar);
            __builtin_amdgcn_fence(__ATOMIC_ACQUIRE, "agent");
            xb_add(&bar[XB_XGEN(b.x)], 1u);
            asm volatile("s_waitcnt vmcnt(0)" ::: "memory");
        } else {
            XB_SPIN(xb_ld(&bar[XB_XGEN(b.x)]) == gen, bar);
            __builtin_amdgcn_fence(__ATOMIC_ACQUIRE, "agent");
            asm volatile("s_waitcnt vmcnt(0)" ::: "memory");
        }
    }
    __syncthreads();
}

__device__ __forceinline__ float wave_sum(float v) {
#pragma unroll
    for (int o = 1; o < 64; o <<= 1) v += __shfl_xor(v, o);
    return v;
}
struct TrD { const float* src; const float* gain; bf16_t* dst; int ldw, ldt; };
__device__ __forceinline__ void tr_load(const TrD& d, f32x4 (&v)[8], float (&g)[8], int lane) {
    const int c4 = lane & 7, r0 = lane >> 3;
#pragma unroll
    for (int i = 0; i < 8; ++i) { const int row = 8 * i + r0; v[i] = *(const GAS f32x4*)((const GAS float*)d.src + (size_t)row * d.ldw + 4 * c4); g[i] = d.gain ? ((const GAS float*)d.gain)[row] : 1.0f; }
}
__device__ __forceinline__ void tr_store(const TrD& d, const f32x4 (&v)[8], const float (&g)[8], LAS float* scr, int lane) {
    const int c4 = lane & 7, r0 = lane >> 3;
#pragma unroll
    for (int i = 0; i < 8; ++i) { LAS float* s = scr + (8 * i + r0) * 33 + 4 * c4; s[0] = v[i][0] * g[i]; s[1] = v[i][1] * g[i]; s[2] = v[i][2] * g[i]; s[3] = v[i][3] * g[i]; }
    LDS_WAIT(); asm volatile("" ::: "memory");
    const int c = lane & 7;
#pragma unroll
    for (int j = 0; j < 4; ++j) { const int n = (lane >> 3) + 8 * j; const LAS float* s = scr + (8 * c) * 33 + n;
        u32x4 o; o.x = cvt_pk_bf16(s[0 * 33], s[1 * 33]); o.y = cvt_pk_bf16(s[2 * 33], s[3 * 33]); o.z = cvt_pk_bf16(s[4 * 33], s[5 * 33]); o.w = cvt_pk_bf16(s[6 * 33], s[7 * 33]);
        *(GAS u32x4*)((GAS bf16_t*)d.dst + (size_t)n * d.ldt + 8 * c) = o; }
    LDS_WAIT(); asm volatile("" ::: "memory");
}
constexpr int I_IN = (DM / 64) * (NIN / 32), I_P = (BW / 64) * (DM / 32), I_O = (DM / 64) * (DM / 32), I_G = (DM / 64) * (DFF / 32), I_D = (DFF / 64) * (DM / 32);
constexpr int NITEMS = I_IN + 3 * I_P + I_O + 2 * I_G + I_D;
struct Args { const float* in[14]; float* out; unsigned char* ws; };
__device__ __forceinline__ void tr_decode(int it, TrD& d, const Args& A, int layer, unsigned char* ws) {
    int r = it;
    if (r < I_IN) { const int nblk = NIN / 32, kb = r / nblk, c0 = 32 * (r % nblk); size_t doff;
        if (c0 < 3072) doff = WS_WIN + (size_t)c0 * DM * 2;
        else if (c0 < 3584) doff = WS_WIN + (size_t)(3072 + 256 * ((c0 - 3072) >> 7) + ((c0 - 3072) & 127)) * DM * 2;
        else if (c0 < 4096) doff = WS_WIN + (size_t)(4096 + (c0 - 3584)) * DM * 2;
        else if (c0 < 4608) doff = WS_WIN + (size_t)(3072 + 256 * ((c0 - 4096) >> 7) + 128 + ((c0 - 4096) & 127)) * DM * 2;
        else doff = WS_WG + (size_t)(c0 - 4608) * DM * 2;
        d.src = A.in[2] + (size_t)layer * DM * NIN + (size_t)(64 * kb) * NIN + c0; d.gain = A.in[1] + (size_t)layer * DM + 64 * kb; d.dst = (bf16_t*)(ws + doff) + 64 * kb; d.ldw = NIN; d.ldt = DM; return; }
    r -= I_IN;
    if (r < I_P) { const int nblk = DM / 32, kb = r / nblk, c0 = 32 * (r % nblk);
        d.src = A.in[5] + (size_t)layer * BW * DM + (size_t)(64 * kb) * DM + c0; d.gain = nullptr; d.dst = (bf16_t*)(ws + WS_WP) + (size_t)c0 * BW + 64 * kb; d.ldw = DM; d.ldt = BW; return; }
    r -= I_P;
    if (r < I_P) { const int nblk = DM / 32, kb = r / nblk, c0 = 32 * (r % nblk);
        d.src = A.in[6] + (size_t)layer * BW * DM + (size_t)(64 * kb) * DM + c0; d.gain = nullptr; d.dst = (bf16_t*)(ws + WS_WP) + (size_t)DM * BW + (size_t)c0 * BW + 64 * kb; d.ldw = DM; d.ldt = BW; return; }
    r -= I_P;
    if (r < I_P) { const int nblk = DM / 32, kb = r / nblk, c0 = 32 * (r % nblk);
        d.src = A.in[7] + (size_t)layer * BW * DM + (size_t)(64 * kb) * DM + c0; d.gain = nullptr; d.dst = (bf16_t*)(ws + WS_WP) + (size_t)2 * DM * BW + (size_t)c0 * BW + 64 * kb; d.ldw = DM; d.ldt = BW; return; }
    r -= I_P;
    if (r < I_O) { const int nblk = DM / 32, kb = r / nblk, c0 = 32 * (r % nblk);
        d.src = A.in[8] + (size_t)layer * DM * DM + (size_t)(64 * kb) * DM + c0; d.gain = nullptr; d.dst = (bf16_t*)(ws + WS_WO) + (size_t)c0 * DM + 64 * kb; d.ldw = DM; d.ldt = DM; return; }
    r -= I_O;
    if (r < I_G) { const int nblk = DFF / 32, kb = r / nblk, c0 = 32 * (r % nblk);
        d.src = A.in[10] + (size_t)layer * DM * DFF + (size_t)(64 * kb) * DFF + c0; d.gain = A.in[9] + (size_t)layer * DM + 64 * kb; d.dst = (bf16_t*)(ws + WS_WGU) + (size_t)(256 * (c0 >> 7) + (c0 & 127)) * DM + 64 * kb; d.ldw = DFF; d.ldt = DM; return; }
    r -= I_G;
    if (r < I_G) { const int nblk = DFF / 32, kb = r / nblk, c0 = 32 * (r % nblk);
        d.src = A.in[11] + (size_t)layer * DM * DFF + (size_t)(64 * kb) * DFF + c0; d.gain = A.in[9] + (size_t)layer * DM + 64 * kb; d.dst = (bf16_t*)(ws + WS_WGU) + (size_t)(256 * (c0 >> 7) + 128 + (c0 & 127)) * DM + 64 * kb; d.ldw = DFF; d.ldt = DM; return; }
    r -= I_G;
    { const int nblk = DM / 32, kb = r / nblk, c0 = 32 * (r % nblk);
      d.src = A.in[12] + (size_t)layer * DFF * DM + (size_t)(64 * kb) * DM + c0; d.gain = nullptr; d.dst = (bf16_t*)(ws + WS_WD) + (size_t)c0 * DFF + 64 * kb; d.ldw = DM; d.ldt = DFF; }
}


__global__ void __launch_bounds__(NWAVES * 64, 2) hybrid_fwd(Args args) {
    extern __shared__ __attribute__((aligned(16))) unsigned char lds_raw[];
    LAS unsigned char* lds = (LAS unsigned char*)lds_raw;
    volatile LAS unsigned* MISC = (volatile LAS unsigned*)(lds + MISC_OFF);
    const int wave = __builtin_amdgcn_readfirstlane((int)threadIdx.x >> 6);
    const int G = gridDim.x, bx = blockIdx.x, vcu = (G % 8 == 0) ? (bx % 8) * (G / 8) + bx / 8 : bx;
    for (int i = threadIdx.x; i < (LDS_BYTES - LDSCTL_OFF) / 4; i += NWAVES * 64) ((LAS unsigned*)(lds + LDSCTL_OFF))[i] = 0u;
    __syncthreads();
    XcdBarrier bar = xcd_barrier_post((unsigned*)(args.ws + WS_CTL) + CW_BAR, MISC + 8);
    const int gw = vcu * NWAVES + wave, NGW = G * NWAVES;

#ifndef REP_PH
#define REP_PH -1
#endif
    for (int pq = 0; pq < DEPTH * 7 + 1; ++pq)
    for (int rep_ = 0; rep_ < ((pq % 7 == REP_PH && pq < DEPTH * 7) ? 2 : 1); ++rep_) {
        const int pp = pq;
        const int layer = pp / 7, ph = pp - 7 * layer;
        int tid = wave * 64 + lane_id(); asm volatile("" : "+v"(tid)); const int lane = tid & 63;
        size_t opq = 0; asm volatile("" : "+s"(opq));
        unsigned char* ws = args.ws + opq; const float* x_in = args.in[0] + opq; float* out = args.out + opq;
        float* ssA = (float*)(ws + WS_SSA); float* ssB = (float*)(ws + WS_SSB); float* kmp = (float*)(ws + WS_KM);
        bf16_t* xb = (bf16_t*)(ws + WS_XB);
        bf16_t* QA = (bf16_t*)(ws + WS_QA); bf16_t* KA = (bf16_t*)(ws + WS_KA); bf16_t* VA = (bf16_t*)(ws + WS_VA);
        bf16_t* QS = (bf16_t*)(ws + WS_QS); bf16_t* KS = (bf16_t*)(ws + WS_KS); bf16_t* VS = (bf16_t*)(ws + WS_VS);
        bf16_t* Ub = (bf16_t*)(ws + WS_U); bf16_t* BC = (bf16_t*)(ws + WS_BC); bf16_t* MG = (bf16_t*)(ws + WS_MG); bf16_t* ACT = (bf16_t*)(ws + WS_ACT);

        if (layer == DEPTH) {
            const float* gf = args.in[13];
            for (int m = gw; m < M; m += NGW) {
                const float rs = rstd_row(ssA, m);
                f32x4* xr = (f32x4*)(out + (size_t)m * DM) + lane; const f32x4* gr = (const f32x4*)gf + lane; const u32x2* xs = (const u32x2*)(xb + (size_t)m * DM) + lane;
#pragma unroll
                for (int j = 0; j < 4; ++j) { const u32x2 w = xs[64 * j]; const f32x4 v = {bf_lo(w.x), bf_hi(w.x), bf_lo(w.y), bf_hi(w.y)}, g = gr[64 * j]; xr[64 * j] = v * rs * g; }
            }
            if (xb_ld((unsigned*)(ws + WS_CTL) + CW_BAR + XB_TMO) != 0u && bx == 0) { for (int i = tid; i < 4096; i += NWAVES * 64) out[i] = __builtin_nanf(""); }
            break;
        }
        if (ph == 0) {
            LAS float* scr = (LAS float*)(lds + RING_OFF + wave * 16384);
            {
                int it = gw;
                for (; it + NGW < NITEMS; it += 2 * NGW) {
                    TrD da, db; f32x4 va[8], vb[8]; float ga[8], gb[8];
                    tr_decode(it, da, args, layer, ws); tr_load(da, va, ga, lane);
                    tr_decode(it + NGW, db, args, layer, ws); tr_load(db, vb, gb, lane);
                    tr_store(da, va, ga, scr, lane); tr_store(db, vb, gb, scr, lane);
                }
                if (it < NITEMS) { TrD da; f32x4 va[8]; float ga[8]; tr_decode(it, da, args, layer, ws); tr_load(da, va, ga, lane); tr_store(da, va, ga, scr, lane); }
            }
            if (layer == 0) {
                for (int m = gw; m < M; m += NGW) {
                    const f32x4* xr = (const f32x4*)(x_in + (size_t)m * DM) + lane; f32x4 v[4]; float s = 0.f;
#pragma unroll
                    for (int j = 0; j < 4; ++j) { v[j] = xr[64 * j]; s += (v[j].x * v[j].x + v[j].y * v[j].y) + (v[j].z * v[j].z + v[j].w * v[j].w); }
                    s = wave_sum(s);
                    u32x2* o8 = (u32x2*)(xb + (size_t)m * DM) + lane;
#pragma unroll
                    for (int j = 0; j < 4; ++j) o8[64 * j] = (u32x2){cvt_pk_bf16(v[j].x, v[j].y), cvt_pk_bf16(v[j].z, v[j].w)};
                    if (lane < 4) ssA[(size_t)m * 4 + lane] = (lane == 0) ? s : 0.f;
                }
            }
        } else if (ph == 2) {
            LAS unsigned char* vst = lds + RING_OFF + wave * 8192;
            LAS float* wsf = (LAS float*)(lds + RING_OFF + 65536 + wave * 512);
            LAS float* km = (LAS float*)(lds + RING_OFF + 65536 + 4096);
            LAS unsigned* selm = (LAS unsigned*)(lds + RING_OFF + 77824);
            LAS unsigned* cnt = (LAS unsigned*)(lds + RING_OFF + 78848);
            LAS float* kbn = (LAS float*)(lds + RING_OFF + 78848 + 256);
            LAS unsigned* uslot = (LAS unsigned*)(lds + RING_OFF + 78848 + 512);
            LAS unsigned char* lists = lds + RING_OFF + 79872;
            LAS unsigned* trow = (LAS unsigned*)(lds + RING_OFF + 88064 + wave * 128);
            unsigned char* recO = ws + WS_MG + (size_t)vcu * 131072; float* recML = (float*)(ws + WS_X + (size_t)vcu * 8192);
            unsigned* qctr = (unsigned*)(ws + WS_CTL) + 8192 + layer * 64;
            unsigned* ndone = (unsigned*)(ws + WS_CTL) + 8192 + 128 + layer * 1024;
            float* kbmax = (float*)((unsigned*)(ws + WS_CTL) + 8192 + 4096 + layer * 512);
            for (;;) {
                if (tid == 0) *uslot = __hip_atomic_fetch_add(qctr, 1u, __ATOMIC_RELAXED, __HIP_MEMORY_SCOPE_AGENT);
                __syncthreads();
                const unsigned uq = *uslot;
                __syncthreads();
                if (uq >= 1536u) break;
                if (uq < 512u) {
                    const int bh = (int)(uq >> 5), n = (int)(uq & 31u), b = bh >> 3, h = bh & 7;
                    const u32x4* kp = (const u32x4*)(KA + ((size_t)b * SEQ + n * 256 + (tid >> 1)) * BW + h * HD + (tid & 1) * 32);
                    float sq = 0.f;
#pragma unroll
                    for (int c = 0; c < 4; ++c) { const u32x4 x = kp[c]; const float e0 = bf_lo(x.x), e1 = bf_hi(x.x), e2 = bf_lo(x.y), e3 = bf_hi(x.y), e4 = bf_lo(x.z), e5 = bf_hi(x.z), e6 = bf_lo(x.w), e7 = bf_hi(x.w);
                        sq += (e0 * e0 + e1 * e1) + (e2 * e2 + e3 * e3) + (e4 * e4 + e5 * e5) + (e6 * e6 + e7 * e7); }
                    sq += xshfl<1>(sq);
                    sq = __builtin_fmaxf(sq, xshfl<2>(sq)); sq = __builtin_fmaxf(sq, xshfl<4>(sq)); sq = __builtin_fmaxf(sq, xshfl<8>(sq)); sq = __builtin_fmaxf(sq, xshfl<16>(sq));
                    { float x1; const float x0 = att::swap_lo(sq, x1); sq = __builtin_fmaxf(x0, x1); }
                    if (lane == 0) kbn[wave] = sq;
                    __syncthreads();
                    if (tid == 0) { float m_ = kbn[0];
#pragma unroll
                        for (int w_ = 1; w_ < NWAVES; ++w_) m_ = __builtin_fmaxf(m_, kbn[w_]);
                        __hip_atomic_store(kbmax + bh * 32 + n, m_, __ATOMIC_RELAXED, __HIP_MEMORY_SCOPE_AGENT);
                        asm volatile("s_waitcnt vmcnt(0)" ::: "memory");
                        __hip_atomic_fetch_add(ndone + bh * 64, 1u, __ATOMIC_RELAXED, __HIP_MEMORY_SCOPE_AGENT); }
                    __syncthreads();
                } else if (uq < 1024u) {
                    const unsigned um = uq - 512u; const int h = 7 - (int)(um >> 6), blk = 31 - (int)((um & 63u) >> 1), b = (int)(um & 1u);
                    for (int i = tid; i < 2048; i += NWAVES * 64) { const int n = i >> 6, d = i & 63; const size_t o = (size_t)((b * 32 + n) * 2) * BW + h * HD + d; km[i] = kmp[o] + kmp[o + BW]; }
                    if (tid == 0) {
                        unsigned sp_ = 0; while (__hip_atomic_load(ndone + (b * 8 + h) * 64, __ATOMIC_RELAXED, __HIP_MEMORY_SCOPE_AGENT) < 32u) { __builtin_amdgcn_s_sleep(2);
                            if (++sp_ > (1u << 20)) { atomicAdd((unsigned*)(ws + WS_CTL) + CW_BAR + XB_TMO, 1u); break; } } }
                    __syncthreads();
                    if (tid < 32) kbn[tid] = sqrtf(__hip_atomic_load(kbmax + (b * 8 + h) * 32 + tid, __ATOMIC_RELAXED, __HIP_MEMORY_SCOPE_AGENT)) * 1.01f;
                    __syncthreads();
                    const float sl2 = __builtin_amdgcn_exp2f(-(float)(h + 1)) * LOG2E;
                    const size_t qrow = (size_t)b * SEQ + blk * 256 + wave * 32;
                    const unsigned sel = att::moba_gate(QA + qrow * BW + h * HD, KA + qrow * BW + h * HD, blk, blk * 256 + wave * 32, sl2, km, kbn, lane);
                    if (lane < 32) selm[wave * 32 + lane] = sel;
                    __syncthreads();
                    for (int n = wave; n < blk; n += NWAVES) {
                        unsigned pos = 0;
#pragma unroll
                        for (int c = 0; c < 4; ++c) { const int q = 64 * c + lane; const bool bit = (selm[q] >> n) & 1u; const unsigned long long mk = __ballot(bit);
                            if (bit) lists[n * 256 + pos + __builtin_amdgcn_mbcnt_hi((unsigned)(mk >> 32), __builtin_amdgcn_mbcnt_lo((unsigned)mk, 0u))] = (unsigned char)q;
                            pos += (unsigned)__builtin_popcountll(mk); }
                        if (lane == 0) cnt[n] = pos;
                    }
                    __syncthreads();
                    { int n = blk, t = wave; int nn = 0, tt = 0, idp = 0;
                      for (;;) {
                          att::moba_item(QA, KA, VA, b, h, blk, n, t, lists, cnt, selm, recO, recML, vst, wsf, trow, lane);
                          bool found = false;
                          while (nn < blk) { const int nt_ = ((int)cnt[nn] + 31) >> 5;
                              if (tt < nt_) { const bool mine = (idp & (NWAVES - 1)) == wave; if (mine) { n = nn; t = tt; found = true; } ++tt; ++idp; if (mine) break; }
                              else { ++nn; tt = 0; } }
                          if (!found) break;
                      } }
                    VM_WAIT();
                    __syncthreads();
                    att::moba_merge(QA, b, h, blk, wave, selm, recO, recML, wsf, lane);
                    __syncthreads();
                } else {
                    const unsigned us = uq - 1024u; const int h = (int)(us >> 6), blk = (int)((us & 63u) >> 1), b = (int)(us & 1u);
                    att::sb_item(QS, KS, VS, b, h, blk * 256 + wave * 32, vst, lane);
                }
            }
            const float* cw = args.in[4] + (size_t)layer * 3 * BW;
            for (int i = vcu * (NWAVES * 64) + tid; i < M * (BW / 8); i += G * NWAVES * 64) {
                const int t = i >> 6, c = (i & 63) * 8; const int tt = t & (SEQ - 1);
                const u32x4 u2 = *(const u32x4*)(Ub + (size_t)t * BW + c);
                u32x4 u1 = {0u, 0u, 0u, 0u}, u0 = {0u, 0u, 0u, 0u};
                if (tt >= 1) u1 = *(const u32x4*)(Ub + (size_t)(t - 1) * BW + c);
                if (tt >= 2) u0 = *(const u32x4*)(Ub + (size_t)(t - 2) * BW + c);
                const u32x4 bw = *(const u32x4*)(BC + (size_t)t * BW + c);
                float y[8];
#pragma unroll
                for (int e = 0; e < 4; ++e) {
                    const float w0l = cw[c + 2 * e], w0h = cw[c + 2 * e + 1], w1l = cw[BW + c + 2 * e], w1h = cw[BW + c + 2 * e + 1], w2l = cw[2 * BW + c + 2 * e], w2h = cw[2 * BW + c + 2 * e + 1];
                    y[2 * e] = bf_lo(bw[e]) * (w0l * bf_lo(u0[e]) + w1l * bf_lo(u1[e]) + w2l * bf_lo(u2[e]));
                    y[2 * e + 1] = bf_hi(bw[e]) * (w0h * bf_hi(u0[e]) + w1h * bf_hi(u1[e]) + w2h * bf_hi(u2[e]));
                }
                *(u32x4*)(BC + (size_t)t * BW + c) = (u32x4){cvt_pk_bf16(y[0], y[1]), cvt_pk_bf16(y[2], y[3]), cvt_pk_bf16(y[4], y[5]), cvt_pk_bf16(y[6], y[7])};
            }
        } else {
            static_assert(WS_QS - WS_QA == 48 * MiB && WS_BC - WS_QS == 48 * MiB && WS_GB - WS_GA == 48 * MiB && WS_GC0 - WS_GB == 48 * MiB && WS_GC1 - WS_GC0 == 48 * MiB, "48 MiB spacing");
            GCfg c{};
            c.ws = ws; c.bgate = args.in[3] + (size_t)layer * NGATE; c.red = (LAS float*)(lds + LDSCTL_OFF + 1024);
            c.nseg = 1; c.lda = DM; c.ldb = DM; c.nt = DM / 64; c.toA = 0;
            if (ph == 1) { c.mode = 0; c.N = N1; c.A = xb; c.B = (const bf16_t*)(ws + WS_WIN); }
            else if (ph == 3) { c.mode = 1; c.N = DM; c.nseg = 6; c.A = xb; c.B = (const bf16_t*)(ws + WS_WG); }
            else if (ph == 4) { c.mode = 2; c.N = DM; c.A = MG; c.B = (const bf16_t*)(ws + WS_WO); }
            else if (ph == 5) { c.mode = 3; c.N = NGU; c.A = xb; c.B = (const bf16_t*)(ws + WS_WGU); }
            else { c.mode = 2; c.N = DM; c.A = ACT; c.B = (const bf16_t*)(ws + WS_WD); c.lda = DFF; c.ldb = DFF; c.nt = DFF / 64; c.toA = 1; }
            ProbAny P{&c}; EpiAny E{&c}; pg8::StaticOrder S; S.init(M, c.N, G, bx, c.nseg);
            pg8::gemm_phase(lds + RING_OFF, P, S, E, wave);
        }
        xcd_barrier(bar, tid);
    }
}

extern "C" void kernel_launch(void* const* d_in, const int* in_sizes, int n_in, void* d_out, int out_size, void* d_ws, size_t ws_size, hipStream_t stream) {
    static int grid = 0;
    if (grid == 0) {
        if (n_in != 14 || in_sizes[0] != M * DM || out_size != M * DM || ws_size < WS_END) { fprintf(stderr, "kernel_launch: unexpected shapes (n_in %d, in0 %d, out %d, ws %zu)\n", n_in, n_in > 0 ? in_sizes[0] : -1, out_size, ws_size); grid = -1; return; }
        int dev = 0, cus = 0, per_cu = 0;
        if (hipGetDevice(&dev) != hipSuccess || hipDeviceGetAttribute(&cus, hipDeviceAttributeMultiprocessorCount, dev) != hipSuccess) { grid = -1; return; }
        if (hipFuncSetAttribute((const void*)hybrid_fwd, hipFuncAttributeMaxDynamicSharedMemorySize, LDS_BYTES) != hipSuccess) { fprintf(stderr, "kernel_launch: hipFuncSetAttribute failed\n"); grid = -1; return; }
        if (hipOccupancyMaxActiveBlocksPerMultiprocessor(&per_cu, (const void*)hybrid_fwd, NWAVES * 64, LDS_BYTES) != hipSuccess || per_cu < 1) { fprintf(stderr, "kernel_launch: occupancy query says %d blocks/CU\n", per_cu); (void)hipGetLastError(); per_cu = 1; }
        grid = cus;
    }
    if (grid < 0) return;
    if (hipMemsetAsync((char*)d_ws + WS_CTL, 0, CTL_ZERO_BYTES, stream) != hipSuccess) { fprintf(stderr, "kernel_launch: memset failed\n"); return; }
    Args a{};
    for (int i = 0; i < 14; ++i) a.in[i] = (const float*)d_in[i];
    a.out = (float*)d_out; a.ws = (unsigned char*)d_ws;
    void* kargs[] = {&a};
    hipError_t e = hipLaunchCooperativeKernel((const void*)hybrid_fwd, dim3(grid), dim3(NWAVES * 64), kargs, LDS_BYTES, stream);
    if (e != hipSuccess) fprintf(stderr, "kernel_launch: cooperative launch failed: %s (grid %d)\n", hipGetErrorString(e), grid);
}
```

```cpp
#include <hip/hip_runtime.h>
#include <hip/hip_bf16.h>
#include <cstdio>
#include <cstdint>

#define GAS __attribute__((address_space(1)))
#define LAS __attribute__((address_space(3)))
typedef unsigned short bf16_t;
typedef short bf16x8 __attribute__((ext_vector_type(8)));
typedef short s16x4 __attribute__((ext_vector_type(4)));
typedef float f32x2 __attribute__((ext_vector_type(2)));
typedef float f32x4 __attribute__((ext_vector_type(4)));
typedef float f32x16 __attribute__((ext_vector_type(16)));
typedef unsigned u32x2 __attribute__((ext_vector_type(2)));
typedef unsigned u32x4 __attribute__((ext_vector_type(4)));
typedef GAS unsigned gu32;

constexpr int BATCH = 2, SEQ = 8192, DM = 1024, M = BATCH * SEQ, NH = 8, HD = 64, BW = 512, DFF = 2816, DEPTH = 2;
constexpr int NIN = 7680, N1 = 4608, NGATE = 3072, NGU = 2 * DFF;
constexpr float RMS_EPS = 1e-6f;
constexpr float LOG2E = 1.4426950408889634f;
constexpr float C2 = 0.125f * LOG2E;
constexpr int NWAVES = 8;

constexpr size_t MiB = 1u << 20;
constexpr size_t WS_CTL = 0, CTL_ZERO_BYTES = 64 * 1024;
constexpr size_t WS_SSA = 1 * MiB, WS_SSB = 2 * MiB, WS_KM = 3 * MiB;
constexpr size_t WS_WIN = 4 * MiB, WS_WG = 13 * MiB, WS_WP = 19 * MiB, WS_WO = 22 * MiB, WS_WGU = 24 * MiB, WS_WD = 35 * MiB;
constexpr size_t WS_XB = 41 * MiB;
constexpr size_t WS_QA = 73 * MiB, WS_KA = 89 * MiB, WS_VA = 105 * MiB, WS_QS = 121 * MiB, WS_KS = 137 * MiB, WS_VS = 153 * MiB;
constexpr size_t WS_BC = 169 * MiB, WS_U = 185 * MiB, WS_MG = 201 * MiB, WS_X = 233 * MiB;
constexpr size_t WS_GA = WS_KA, WS_GB = WS_KS, WS_GC0 = WS_U, WS_GC1 = WS_X;
constexpr size_t WS_ACT = 73 * MiB;
constexpr size_t WS_END = 256 * MiB;
constexpr int CW_BAR = 4096;

constexpr int RING_OFF = 0, RING_BYTES = 131072;
constexpr int LDSCTL_OFF = RING_BYTES, MISC_OFF = LDSCTL_OFF + 320;
constexpr int LDS_BYTES = 147456;

#define LDS_WAIT() asm volatile("s_waitcnt lgkmcnt(0)" ::: "memory")
#define VM_WAIT() asm volatile("s_waitcnt vmcnt(0)" ::: "memory")
#define RLX_AGENT __ATOMIC_RELAXED, __HIP_MEMORY_SCOPE_AGENT

typedef __bf16 bf16x2_t __attribute__((ext_vector_type(2)));
__device__ __forceinline__ unsigned cvt_pk_bf16(float lo, float hi) { const f32x2 v = {lo, hi}; const bf16x2_t b = __builtin_convertvector(v, bf16x2_t); return __builtin_bit_cast(unsigned, b); }
template <int O> __device__ __forceinline__ float xshfl(float x) {
    static_assert(O < 32, "use sum32 for the two 32-lane halves");
    return __int_as_float(__builtin_amdgcn_ds_swizzle(__float_as_int(x), (O << 10) | 0x1f));
}
__device__ __forceinline__ int lane_id() { return (int)__builtin_amdgcn_mbcnt_hi(~0u, __builtin_amdgcn_mbcnt_lo(~0u, 0u)); }
__device__ __forceinline__ float sum32(float x) { auto rr = __builtin_amdgcn_permlane32_swap(__float_as_uint(x), __float_as_uint(x), false, false); return __uint_as_float(rr[0]) + __uint_as_float(rr[1]); }
__device__ __forceinline__ float bf_lo(unsigned w) { return __uint_as_float(w << 16); }
__device__ __forceinline__ float bf_hi(unsigned w) { return __uint_as_float(w & 0xffff0000u); }
__device__ __forceinline__ float rstd_row(const float* ssp, int row) {
    const f32x4 a = *(const f32x4*)(ssp + (size_t)row * 4);
    return rsqrtf(((a.x + a.y) + (a.z + a.w)) * (1.0f / DM) + RMS_EPS);
}

namespace pg8 {
constexpr int BM = 256, BK = 64, HALF = 128, HTB = HALF * BK * 2, STAGE_BYTES = 8 * HTB, NXCD = 8, WGM = 8;
__host__ __device__ __forceinline__ int lds_byte(int r, int c) { const int st = (r >> 4) * 2 + (c >> 5), rr = r & 15, cc = c & 31, ob = rr * 64 + cc * 2; return st * 1024 + (ob ^ (((ob >> 9) & 1) << 5)); }
__host__ __device__ __forceinline__ void stage_rc(int b, int& R, int& C) { const int st = b / 1024, sb = b % 1024, swz = sb ^ (((sb >> 9) & 1) << 5); R = (st >> 1) * 16 + swz / 64; C = (st & 1) * 32 + (swz % 64) / 2; }
__host__ __device__ __forceinline__ int perm32(int rho) { const int n = rho >> 4, i = rho & 15; return 8 * (i >> 2) + 4 * n + (i & 3); }

struct Unit { int pm, pn, seg; };
struct Seg { const char* A; const char* B; unsigned hA, hB; int lda, ldb, nt; };

struct StaticOrder {
    int nM, nN, nwg, G, c, nseg;
    __device__ void init(int M_, int N_, int G_, int c_, int nseg_) { nM = M_ / BM; nN = N_ / BM; nwg = nM * nN; G = G_; c = c_; nseg = nseg_; }
    __device__ bool next(int i, Unit& u) const {
        const int ti = (nseg == 1) ? i : i / nseg; u.seg = i - ti * nseg;
        const long L = (long)ti * G + c; if (L >= nwg) return false;
        int wgid = (int)L; { const int q = nwg / NXCD, r = nwg % NXCD, xcd = wgid % NXCD, off = wgid / NXCD; wgid = (xcd < r ? xcd * (q + 1) : r * (q + 1) + (xcd - r) * q) + off; }
        const int nig = WGM * nN, gid = wgid / nig, fm = gid * WGM, gsz = (nM - fm) < WGM ? (nM - fm) : WGM;
        u.pm = fm + ((wgid % nig) % gsz); u.pn = (wgid % nig) / gsz; return true;
    }
};

template <class Prob, class Epi, class Sched>
__device__ __forceinline__ void gemm_phase(LAS unsigned char* lds, const Prob& P, const Sched& S, const Epi& E, int wave_) {
    int tid = wave_ * 64 + lane_id(); asm volatile("" : "+v"(tid));
    const int wid = wave_, lane = tid & 63, wr = wid >> 2, wc = wid & 3, fr = lane & 15, fq = lane >> 4;
#define PG8_RC(R0, C0, Rb0) int R0, C0; { int t_ = tid; asm volatile("" : "+v"(t_)); stage_rc(t_ * 16, R0, C0); } const int Rb0 = (R0 & ~31) + perm32(R0 & 31)
    const size_t kstep = (size_t)(BK * 2);
    const unsigned ldsw = (unsigned)wid * 1024u;
    const int aoff = lds_byte(wr * 64 + fr, fq * 8), boff = lds_byte(wc * 32 + fr, fq * 8);
#define PG8_SA(b, h) (((b) * 2 + (h)) * HTB)
#define PG8_SB(b, h) ((4 + (b) * 2 + (h)) * HTB)
#define PG8_STAGE(bufoff, gbase, v0, q) do { \
        __builtin_amdgcn_global_load_lds((const unsigned*)((const char*)(gbase) + (v0)), (LAS unsigned*)(lds + (bufoff) + ldsw), 16, 0, 0); \
        __builtin_amdgcn_global_load_lds((const unsigned*)((const char*)(gbase) + (q) + (v0)), (LAS unsigned*)(lds + (bufoff) + ldsw + 8192), 16, 0, 0); } while (0)
#define PG8_LDA(dst, b, h) do { _Pragma("unroll") for (int m = 0; m < 4; ++m) _Pragma("unroll") for (int k = 0; k < 2; ++k) dst[m][k] = *(const LAS bf16x8*)(lds + PG8_SA(b, h) + aoff + m * 2048 + k * 1024); } while (0)
#define PG8_LDB(dst, b, h) do { _Pragma("unroll") for (int n = 0; n < 2; ++n) _Pragma("unroll") for (int k = 0; k < 2; ++k) dst[n][k] = *(const LAS bf16x8*)(lds + PG8_SB(b, h) + boff + n * 2048 + k * 1024); } while (0)
#define PG8_MMA(ai, bj, At, Bt) do { __builtin_amdgcn_s_setprio(1); _Pragma("unroll") for (int m = 0; m < 4; ++m) _Pragma("unroll") for (int n = 0; n < 2; ++n) _Pragma("unroll") for (int k = 0; k < 2; ++k) \
        acc[ai][bj][m][n] = __builtin_amdgcn_mfma_f32_16x16x32_bf16(Bt[n][k], At[m][k], acc[ai][bj][m][n], 0, 0, 0); __builtin_amdgcn_s_setprio(0); } while (0)
#define PG8_WAIT_V(n) asm volatile("s_waitcnt vmcnt(" #n ")" ::: "memory")
#define PG8_WAIT_L(n) asm volatile("s_waitcnt lgkmcnt(" #n ")" ::: "memory")
#define PG8_BAR __builtin_amdgcn_s_barrier()
#define PG8_SCHED __builtin_amdgcn_sched_barrier(0)
    Unit cur, nxt; int ui = 0;
    if (!S.next(0, cur)) return;
    Seg sc, sn; P.seg(cur, sc);
    unsigned vAc0, vBc0; { PG8_RC(R0, C0, Rb0); vAc0 = (unsigned)(R0 * sc.lda + C0) * 2u; vBc0 = (unsigned)(Rb0 * sc.ldb + C0) * 2u; }
    f32x4 acc[2][2][4][2];
#pragma unroll
    for (int a = 0; a < 2; ++a)
#pragma unroll
        for (int b = 0; b < 2; ++b)
#pragma unroll
            for (int m = 0; m < 4; ++m)
#pragma unroll
                for (int n = 0; n < 2; ++n) acc[a][b][m][n] = (f32x4){0.f, 0.f, 0.f, 0.f};
    bf16x8 At[4][2], B0[2][2], B1[2][2];
    const char* cA = sc.A; const char* cB = sc.B;
    PG8_STAGE(PG8_SB(0, 0), cB, vBc0, sc.hB >> 1); PG8_STAGE(PG8_SB(0, 1), cB + sc.hB, vBc0, sc.hB >> 1); PG8_STAGE(PG8_SA(0, 0), cA, vAc0, sc.hA >> 1); PG8_STAGE(PG8_SA(0, 1), cA + sc.hA, vAc0, sc.hA >> 1);
    if (wr == 1) PG8_BAR;
    PG8_WAIT_V(2); PG8_BAR;
    PG8_STAGE(PG8_SB(1, 0), cB + kstep, vBc0, sc.hB >> 1); PG8_STAGE(PG8_SA(1, 0), cA + kstep, vAc0, sc.hA >> 1); PG8_STAGE(PG8_SB(1, 1), cB + sc.hB + kstep, vBc0, sc.hB >> 1);
    PG8_WAIT_V(6); PG8_BAR;
    for (;;) {
        const bool has_next = S.next(ui + 1, nxt);
        if (has_next) P.seg(nxt, sn); else sn = sc;
        unsigned vAn0, vBn0; { PG8_RC(R0, C0, Rb0); vAn0 = (unsigned)(R0 * sn.lda + C0) * 2u; vBn0 = (unsigned)(Rb0 * sn.ldb + C0) * 2u; }
        const char* nA = sn.A; const char* nB = sn.B;
        const int nt = sc.nt;
        for (int t = 0; t < nt; t += 2) {
            const bool last = (t == nt - 2);
            const char* a1 = cA + (size_t)(t + 1) * kstep;
            const char* a2 = last ? nA : cA + (size_t)(t + 2) * kstep; const char* b2 = last ? nB : cB + (size_t)(t + 2) * kstep;
            const char* a3 = a2 + kstep; const char* b3 = b2 + kstep;
            const unsigned hA2 = last ? sn.hA : sc.hA, hB2 = last ? sn.hB : sc.hB;
            const unsigned vA0 = last ? vAn0 : vAc0, vB0 = last ? vBn0 : vBc0, qA = hA2 >> 1, qB = hB2 >> 1;
            PG8_LDB(B0, 0, 0); PG8_LDB(B1, 0, 1); PG8_SCHED; PG8_LDA(At, 0, 0); PG8_STAGE(PG8_SA(1, 1), a1 + sc.hA, vAc0, sc.hA >> 1);
            PG8_WAIT_V(8); PG8_WAIT_L(0); PG8_BAR; PG8_MMA(0, 0, At, B0); PG8_MMA(0, 1, At, B1); PG8_BAR; PG8_SCHED;
            PG8_LDA(At, 0, 1); PG8_STAGE(PG8_SB(0, 0), b2, vB0, qB); PG8_STAGE(PG8_SB(0, 1), b2 + hB2, vB0, qB); PG8_STAGE(PG8_SA(0, 0), a2, vA0, qA);
            PG8_WAIT_V(8); PG8_WAIT_L(0); PG8_BAR; PG8_MMA(1, 0, At, B0); PG8_MMA(1, 1, At, B1); PG8_BAR; PG8_SCHED;
            PG8_LDB(B0, 1, 0); PG8_LDB(B1, 1, 1); PG8_SCHED; PG8_LDA(At, 1, 0); PG8_STAGE(PG8_SA(0, 1), a2 + hA2, vA0, qA);
            PG8_WAIT_V(8); PG8_WAIT_L(0); PG8_BAR; PG8_MMA(0, 0, At, B0); PG8_MMA(0, 1, At, B1); PG8_BAR; PG8_SCHED;
            PG8_LDA(At, 1, 1); PG8_STAGE(PG8_SB(1, 0), b3, vB0, qB); PG8_STAGE(PG8_SB(1, 1), b3 + hB2, vB0, qB); PG8_STAGE(PG8_SA(1, 0), a3, vA0, qA);
            PG8_WAIT_V(8); PG8_WAIT_L(0); PG8_BAR; PG8_MMA(1, 0, At, B0); PG8_MMA(1, 1, At, B1); PG8_BAR; PG8_SCHED;
        }
        if (wr == 0) PG8_BAR;
        { int wr_ = wr, wc_ = wc, t_ = tid;
          asm volatile("" : "+s"(wr_), "+s"(wc_), "+v"(t_)); const int fr_ = t_ & 15, fq_ = (t_ >> 4) & 3;
          E(acc, cur, wr_, wc_, fr_, fq_); }
        if (!has_next) break;
#pragma unroll
        for (int a = 0; a < 2; ++a)
#pragma unroll
            for (int b = 0; b < 2; ++b)
#pragma unroll
                for (int m = 0; m < 4; ++m)
#pragma unroll
                    for (int n = 0; n < 2; ++n) acc[a][b][m][n] = (f32x4){0.f, 0.f, 0.f, 0.f};
        cur = nxt; sc = sn; cA = nA; cB = nB; vAc0 = vAn0; vBc0 = vBn0; ++ui;
        if (wr == 1) PG8_BAR;
    }
    PG8_WAIT_V(0);
    PG8_BAR;
#undef PG8_SA
#undef PG8_SB
#undef PG8_STAGE
#undef PG8_LDA
#undef PG8_LDB
#undef PG8_MMA
#undef PG8_WAIT_V
#undef PG8_WAIT_L
#undef PG8_BAR
#undef PG8_SCHED
#undef PG8_RC
}
}

#define EPI_ARGS const f32x4 (&acc)[2][2][4][2], const pg8::Unit& u, int wr, int wc, int fr, int fq
__device__ __forceinline__ void st_bf16x8(bf16_t* p, f32x4 v0, f32x4 v1) {
    u32x4 w; w.x = cvt_pk_bf16(v0[0], v0[1]); w.y = cvt_pk_bf16(v0[2], v0[3]); w.z = cvt_pk_bf16(v1[0], v1[1]); w.w = cvt_pk_bf16(v1[2], v1[3]);
    *(u32x4*)p = w;
}
template <class T> __device__ __forceinline__ T* bo(T* base, unsigned byte_off) { return (T*)((char*)base + byte_off); }
template <class T> __device__ __forceinline__ const T* bo(const T* base, unsigned byte_off) { return (const T*)((const char*)base + byte_off); }
__device__ __forceinline__ void ld_bf16x8(const bf16_t* p, f32x4& v0, f32x4& v1) {
    const unsigned long long lo = __hip_atomic_load((const unsigned long long*)p, __ATOMIC_RELAXED, __HIP_MEMORY_SCOPE_AGENT), hi = __hip_atomic_load((const unsigned long long*)p + 1, __ATOMIC_RELAXED, __HIP_MEMORY_SCOPE_AGENT);
    const u32x4 w = {(unsigned)lo, (unsigned)(lo >> 32), (unsigned)hi, (unsigned)(hi >> 32)};
    v0 = (f32x4){bf_lo(w.x), bf_hi(w.x), bf_lo(w.y), bf_hi(w.y)}; v1 = (f32x4){bf_lo(w.z), bf_hi(w.z), bf_lo(w.w), bf_hi(w.w)};
}
__device__ __forceinline__ float rstd4(f32x4 a) { return rsqrtf(((a.x + a.y) + (a.z + a.w)) * (1.0f / DM) + RMS_EPS); }
__device__ __forceinline__ void rstd8(float (&rs)[2][4], const float* ss, int pm, unsigned lrow) {
    const float* ssb = ss + (size_t)pm * 256 * 4; unsigned lsb = lrow * 16u; asm volatile("" : "+v"(lsb));
    f32x4 t[2][4];
#pragma unroll
    for (int ai = 0; ai < 2; ++ai)
#pragma unroll
        for (int m = 0; m < 4; ++m) t[ai][m] = *(const f32x4*)bo(ssb, lsb + (unsigned)(ai * 128 + m * 16) * 16u);
#pragma unroll
    for (int ai = 0; ai < 2; ++ai)
#pragma unroll
        for (int m = 0; m < 4; ++m) rs[ai][m] = rstd4(t[ai][m]);
}
struct EpiIn {
    unsigned char* ws;
    __device__ __forceinline__ void operator()(EPI_ARGS) const {
        bf16_t* qkv = (bf16_t*)(ws + WS_QA); bf16_t* ub = (bf16_t*)(ws + WS_U); bf16_t* bc = (bf16_t*)(ws + WS_BC); float* kmp = (float*)(ws + WS_KM); const float* ss = (const float*)(ws + WS_SSA);
        const int pn = u.pn; unsigned lrow = (unsigned)(wr * 64 + fr), lcol = (unsigned)(wc * 32 + 8 * fq);
        asm volatile("" : "+v"(lrow), "+v"(lcol));
        const unsigned lb = (lrow * BW + lcol) * 2u;
        float rs[2][4]; rstd8(rs, ss, u.pm, lrow);
        if (pn < 12 || pn >= 16) {
            const int t = pn >> 1; const float sc = (t == 0 || t == 3) ? C2 : 1.0f;
            bf16_t* base = (pn < 12 ? qkv + (size_t)t * M * BW + (pn & 1) * 256 : bc + (pn - 16) * 256) + (size_t)u.pm * 256 * BW;
            if (t == 1) {
                float* kp = kmp + (size_t)(u.pm * 2 + wr) * BW + (pn & 1) * 256;
#pragma unroll
                for (int bj = 0; bj < 2; ++bj)
#pragma unroll
                    for (int n = 0; n < 2; ++n) { f32x4 s = {0.f, 0.f, 0.f, 0.f};
#pragma unroll
                        for (int ai = 0; ai < 2; ++ai)
#pragma unroll
                            for (int m = 0; m < 4; ++m) s += acc[ai][bj][m][n] * rs[ai][m];
#pragma unroll
                        for (int e = 0; e < 4; ++e) { s[e] += xshfl<1>(s[e]); s[e] += xshfl<2>(s[e]); s[e] += xshfl<4>(s[e]); s[e] += xshfl<8>(s[e]); }
                        if (fr == 0) *(f32x4*)bo(kp, (lcol + (unsigned)(bj * 128 + 4 * n)) * 4u) = s; }
            }
            if (t == 1 || t == 4) {
                bf16_t* kb = qkv + (size_t)t * M * BW + ((size_t)((u.pm >> 5) * 8 + (pn & 1) * 4) * SEQ + (size_t)(u.pm & 31) * 256) * HD;
                const unsigned fr_ = lrow & 15u, wr_ = lrow >> 6, hl = lcol >> 6, dch = (lcol & 63u) >> 3;
#pragma unroll
                for (int ai = 0; ai < 2; ++ai)
#pragma unroll
                    for (int m = 0; m < 4; ++m) { float f = rs[ai][m]; asm volatile("" : "+v"(f));
#pragma unroll
                        for (int bj = 0; bj < 2; ++bj) { const unsigned eo = (unsigned)(bj * 2 + hl) * (SEQ * HD) + (((wr_ * 2 + ai * 4 + (m >> 1)) * 8 + dch) * 256 + (fr_ + 16u * (m & 1)) * 8);
                            st_bf16x8(bo(kb, eo * 2u), acc[ai][bj][m][0] * f, acc[ai][bj][m][1] * f); } }
            } else {
#pragma unroll
            for (int ai = 0; ai < 2; ++ai)
#pragma unroll
                for (int m = 0; m < 4; ++m) { const float f = rs[ai][m] * sc; const unsigned o = lb + (unsigned)(ai * 128 + m * 16) * BW * 2u;
#pragma unroll
                    for (int bj = 0; bj < 2; ++bj) st_bf16x8(bo(base, o + bj * 256u), acc[ai][bj][m][0] * f, acc[ai][bj][m][1] * f); }
            }
        } else {
            bf16_t* base = ub + (size_t)u.pm * 256 * BW + (pn - 12) * 128;
#pragma unroll
            for (int ai = 0; ai < 2; ++ai)
#pragma unroll
                for (int m = 0; m < 4; ++m) { const float f = rs[ai][m] * rs[ai][m];
                    st_bf16x8(bo(base, lb + (unsigned)(ai * 128 + m * 16) * BW * 2u), acc[ai][0][m][0] * acc[ai][1][m][0] * f, acc[ai][0][m][1] * acc[ai][1][m][1] * f); }
        }
    }
};
struct EpiC1 {
    unsigned char* ws; const float* bgate;
    __device__ __forceinline__ bf16_t* gtile(int s, int pm, int pn) const {
        const size_t off = WS_GA + (size_t)s * (48 * MiB) + ((s == 2 && pm >= 32) ? 32 * MiB : 0) + ((size_t)pm * 256 * DM + pn * 256) * 2;
        return (bf16_t*)(ws + off);
    }
    __device__ __forceinline__ void operator()(EPI_ARGS) const {
        bf16_t* mg = (bf16_t*)(ws + WS_MG); const float* ss = (const float*)(ws + WS_SSA);
        const int sg = u.seg; unsigned lrow = (unsigned)(wr * 64 + fr), lcol = (unsigned)(wc * 32 + 8 * fq);
        asm volatile("" : "+v"(lrow), "+v"(lcol));
        const unsigned lb = (lrow * DM + lcol) * 2u;
        bf16_t* gp = gtile(sg < 3 ? sg : sg - 3, u.pm, u.pn);
        if (sg < 3) {
            const float* bg = bgate + sg * DM + u.pn * 256;
            f32x4 bv[2][2];
#pragma unroll
            for (int bj = 0; bj < 2; ++bj) { bv[bj][0] = *(const f32x4*)bo(bg, (lcol + bj * 128u) * 4u) * (-LOG2E); bv[bj][1] = *(const f32x4*)bo(bg, (lcol + bj * 128u + 4u) * 4u) * (-LOG2E); }
            float rs[2][4]; rstd8(rs, ss, u.pm, lrow);
#pragma unroll
            for (int ai = 0; ai < 2; ++ai)
#pragma unroll
                for (int m = 0; m < 4; ++m) { const float rn = rs[ai][m] * (-LOG2E); const unsigned o = lb + (unsigned)(ai * 128 + m * 16) * DM * 2u;
#pragma unroll
                    for (int bj = 0; bj < 2; ++bj) { f32x4 v[2];
#pragma unroll
                        for (int n = 0; n < 2; ++n) { const f32x4 x = acc[ai][bj][m][n] * rn + bv[bj][n];
#pragma unroll
                            for (int e = 0; e < 4; ++e) v[n][e] = __builtin_amdgcn_rcpf(1.0f + __builtin_amdgcn_exp2f(x[e])); }
                        st_bf16x8(bo(gp, o + bj * 256u), v[0], v[1]); } }
        } else {
            bf16_t* mp = mg + (size_t)u.pm * 256 * DM + u.pn * 256;
#pragma unroll
            for (int ai = 0; ai < 2; ++ai) {
                constexpr int m0 = 0;
                u32x4 gw_[4][2], pw_[4][2];
#pragma unroll
                for (int mm = 0; mm < 4; ++mm)
#pragma unroll
                    for (int bj = 0; bj < 2; ++bj) { const unsigned o = lb + (unsigned)(ai * 128 + (m0 + mm) * 16) * DM * 2u + bj * 256u;
                        gw_[mm][bj] = *(const u32x4*)bo((const bf16_t*)gp, o); if (sg > 3) pw_[mm][bj] = *(const u32x4*)bo((const bf16_t*)mp, o); }
#pragma unroll
                for (int mm = 0; mm < 4; ++mm)
#pragma unroll
                    for (int bj = 0; bj < 2; ++bj) { const int m = m0 + mm; const unsigned o = lb + (unsigned)(ai * 128 + m * 16) * DM * 2u + bj * 256u; const u32x4 g = gw_[mm][bj];
                        f32x4 v0 = acc[ai][bj][m][0] * (f32x4){bf_lo(g.x), bf_hi(g.x), bf_lo(g.y), bf_hi(g.y)}, v1 = acc[ai][bj][m][1] * (f32x4){bf_lo(g.z), bf_hi(g.z), bf_lo(g.w), bf_hi(g.w)};
                        if (sg > 3) { const u32x4 p = pw_[mm][bj]; v0 += (f32x4){bf_lo(p.x), bf_hi(p.x), bf_lo(p.y), bf_hi(p.y)}; v1 += (f32x4){bf_lo(p.z), bf_hi(p.z), bf_lo(p.w), bf_hi(p.w)}; }
                        st_bf16x8(bo(mp, o), v0, v1); }
                asm volatile("" ::: "memory");
            }
        }
    }
};
struct EpiRes {
    unsigned char* ws; int toA; LAS float* red;
    __device__ __forceinline__ void operator()(EPI_ARGS) const {
        bf16_t* xb = (bf16_t*)(ws + WS_XB); float* sso = (float*)(ws + (toA ? WS_SSA : WS_SSB));
        unsigned lrow = (unsigned)(wr * 64 + fr), lcol = (unsigned)(wc * 32 + 8 * fq);
        asm volatile("" : "+v"(lrow), "+v"(lcol));
        const unsigned le = (lrow * DM + lcol) * 2u, lr4 = lrow * 4u + (unsigned)wc;
        bf16_t* xp = xb + (size_t)u.pm * 256 * DM + u.pn * 256;
#pragma unroll
        for (int ai = 0; ai < 2; ++ai) {
            u32x4 bs[4][2];
#pragma unroll
            for (int m = 0; m < 4; ++m)
#pragma unroll
                for (int bj = 0; bj < 2; ++bj) bs[m][bj] = *(const u32x4*)bo((const bf16_t*)xp, le + (unsigned)(ai * 128 + m * 16) * DM * 2u + bj * 256u);
#pragma unroll
            for (int m = 0; m < 4; ++m) { float sq = 0.f;
#pragma unroll
                for (int bj = 0; bj < 2; ++bj) { const u32x4 w = bs[m][bj];
                    const f32x4 x0 = (f32x4){bf_lo(w.x), bf_hi(w.x), bf_lo(w.y), bf_hi(w.y)} + acc[ai][bj][m][0], x1 = (f32x4){bf_lo(w.z), bf_hi(w.z), bf_lo(w.w), bf_hi(w.w)} + acc[ai][bj][m][1];
                    st_bf16x8(bo(xp, le + (unsigned)(ai * 128 + m * 16) * DM * 2u + bj * 256u), x0, x1);
                    sq += (x0[0] * x0[0] + x0[1] * x0[1]) + (x0[2] * x0[2] + x0[3] * x0[3]) + (x1[0] * x1[0] + x1[1] * x1[1]) + (x1[2] * x1[2] + x1[3] * x1[3]); }
                sq += xshfl<16>(sq); sq = sum32(sq);
                if (fq == 0) red[lr4 + (unsigned)(ai * 128 + m * 16) * 4u] = sq; }
            asm volatile("" ::: "memory");
        }
        asm volatile("s_waitcnt lgkmcnt(0)\n\ts_barrier" ::: "memory");
        { const int t = ((wr * 4 + wc) * 4 + fq) * 16 + fr; if (t < 256) { const f32x4 r = *(const LAS f32x4*)(red + t * 4); sso[((size_t)u.pm * 256 + t) * 4 + u.pn] = (r.x + r.y) + (r.z + r.w); } }
        asm volatile("s_waitcnt lgkmcnt(0)\n\ts_barrier" ::: "memory");
    }
};
struct EpiFfn {
    unsigned char* ws;
    __device__ __forceinline__ void operator()(EPI_ARGS) const {
        bf16_t* act = (bf16_t*)(ws + WS_ACT); const float* ss = (const float*)(ws + WS_SSB);
        unsigned lrow = (unsigned)(wr * 64 + fr), lcol = (unsigned)(wc * 32 + 8 * fq);
        asm volatile("" : "+v"(lrow), "+v"(lcol));
        const unsigned lb = (lrow * DFF + lcol) * 2u;
        bf16_t* ap = act + (size_t)u.pm * 256 * DFF + u.pn * 128;
        float rs[2][4]; rstd8(rs, ss, u.pm, lrow);
#pragma unroll
        for (int ai = 0; ai < 2; ++ai)
#pragma unroll
            for (int m = 0; m < 4; ++m) { const float r1 = rs[ai][m], rn = r1 * (-LOG2E); f32x4 v[2];
#pragma unroll
                for (int n = 0; n < 2; ++n) { const f32x4 g = acc[ai][0][m][n], up = acc[ai][1][m][n] * (r1 * r1);
#pragma unroll
                    for (int e = 0; e < 4; ++e) v[n][e] = g[e] * up[e] * __builtin_amdgcn_rcpf(1.0f + __builtin_amdgcn_exp2f(g[e] * rn)); }
                st_bf16x8(bo(ap, lb + (unsigned)(ai * 128 + m * 16) * DFF * 2u), v[0], v[1]); }
    }
};

struct GCfg {
    int mode;
    int N, nseg, lda, ldb, nt, toA;
    const bf16_t* A; const bf16_t* B;
    unsigned char* ws; const float* bgate; LAS float* red;
};
struct ProbAny {
    const GCfg* c;
    __device__ __forceinline__ void seg(const pg8::Unit& u, pg8::Seg& s) const {
        if (c->mode == 1 && u.seg >= 3) {
            const int br = u.seg - 3; const bf16_t* O = (const bf16_t*)(c->ws + WS_QA + (size_t)br * (48 * MiB)); const bf16_t* Wp = (const bf16_t*)(c->ws + WS_WP);
            s.A = (const char*)(O + (size_t)u.pm * 256 * BW); s.B = (const char*)(Wp + ((size_t)br * DM + (size_t)u.pn * 256) * BW);
            s.hA = 128u * BW * 2u; s.hB = 128u * BW * 2u; s.lda = BW; s.ldb = BW; s.nt = BW / 64;
        } else {
            const int so = (c->mode == 1) ? u.seg * DM : 0;
            s.A = (const char*)(c->A + (size_t)u.pm * 256 * c->lda); s.B = (const char*)(c->B + ((size_t)so + (size_t)u.pn * 256) * c->ldb);
            s.hA = 128u * (unsigned)c->lda * 2u; s.hB = 128u * (unsigned)c->ldb * 2u; s.lda = c->lda; s.ldb = c->ldb; s.nt = c->nt;
        }
    }
};
struct EpiAny {
    const GCfg* c;
    __device__ __forceinline__ void operator()(EPI_ARGS) const {
        const int m_ = c->mode;
        if (m_ == 0) EpiIn{c->ws}(acc, u, wr, wc, fr, fq);
        else if (m_ == 1) EpiC1{c->ws, c->bgate}(acc, u, wr, wc, fr, fq);
        else if (m_ == 2) EpiRes{c->ws, c->toA, c->red}(acc, u, wr, wc, fr, fq);
        else EpiFfn{c->ws}(acc, u, wr, wc, fr, fq);
    }
};

namespace att {
__device__ __forceinline__ constexpr int crow(int r, int hi) { return (r & 3) + 8 * (r >> 2) + 4 * hi; }
__device__ __forceinline__ float swap_lo(float x, float& hiv) { auto rr = __builtin_amdgcn_permlane32_swap(__float_as_uint(x), __float_as_uint(x), false, false); hiv = __uint_as_float(rr[1]); return __uint_as_float(rr[0]); }
__device__ __forceinline__ s16x4 vtr(const LAS unsigned char* p) { return __builtin_bit_cast(s16x4, __builtin_amdgcn_ds_read_tr16_b64_v4i16((LAS s16x4*)p)); }
__device__ __forceinline__ void load_k(bf16x8 (&kf)[8], const bf16_t* Kh, int j0, int r32, int hi) {
    const bf16_t* p = Kh + (size_t)(j0 >> 5) * 2048 + hi * 256 + r32 * 8;
#pragma unroll
    for (int d0 = 0; d0 < 4; ++d0) { kf[2 * d0] = *(const bf16x8*)(p + d0 * 512); kf[2 * d0 + 1] = *(const bf16x8*)(p + 2048 + d0 * 512); }
}
__device__ __forceinline__ void load_v(u32x4 (&vv)[8], const bf16_t* Vh, int j0, int lane) {
    const bf16_t* p = Vh + (size_t)(j0 + (lane >> 3)) * BW + (lane & 7) * 8;
#pragma unroll
    for (int i = 0; i < 8; ++i) vv[i] = *(const u32x4*)(p + (size_t)(8 * i) * BW);
}
__device__ __forceinline__ void stage_v(LAS unsigned char* vst, const u32x4 (&vv)[8], int lane) {
    const int c = lane & 7;
#pragma unroll
    for (int i = 0; i < 8; ++i) { const int key = 8 * i + (lane >> 3);
        *(LAS u32x4*)(vst + ((c >> 2) * 4 + (key >> 4)) * 1024 + (key & 15) * 64 + (c & 3) * 16) = vv[i]; }
}
__device__ __forceinline__ void qk(f32x16& p0, f32x16& p1, const bf16x8 (&kf)[8], const bf16x8 (&qr)[4]) {
#pragma unroll
    for (int d0 = 0; d0 < 4; ++d0) { p0 = __builtin_amdgcn_mfma_f32_32x32x16_bf16(kf[2 * d0], qr[d0], p0, 0, 0, 0); p1 = __builtin_amdgcn_mfma_f32_32x32x16_bf16(kf[2 * d0 + 1], qr[d0], p1, 0, 0, 0); }
}
__device__ __forceinline__ void pv(f32x16& o0, f32x16& o1, const f32x16& p0, const f32x16& p1, const LAS unsigned char* vst, int lane) {
    const int hi = lane >> 5;
    const LAS unsigned char* vp = vst + ((lane >> 4) & 1) * 32 + (lane & 3) * 8 + (4 * hi + ((lane & 15) >> 2)) * 64;
    u32x4 pw[4];
    pw[0] = (u32x4){cvt_pk_bf16(p0[0], p0[1]), cvt_pk_bf16(p0[2], p0[3]), cvt_pk_bf16(p0[4], p0[5]), cvt_pk_bf16(p0[6], p0[7])};
    pw[1] = (u32x4){cvt_pk_bf16(p0[8], p0[9]), cvt_pk_bf16(p0[10], p0[11]), cvt_pk_bf16(p0[12], p0[13]), cvt_pk_bf16(p0[14], p0[15])};
    pw[2] = (u32x4){cvt_pk_bf16(p1[0], p1[1]), cvt_pk_bf16(p1[2], p1[3]), cvt_pk_bf16(p1[4], p1[5]), cvt_pk_bf16(p1[6], p1[7])};
    pw[3] = (u32x4){cvt_pk_bf16(p1[8], p1[9]), cvt_pk_bf16(p1[10], p1[11]), cvt_pk_bf16(p1[12], p1[13]), cvt_pk_bf16(p1[14], p1[15])};
#pragma unroll
    for (int ks = 0; ks < 4; ++ks) {
        const s16x4 a0 = vtr(vp + ks * 1024), a1 = vtr(vp + ks * 1024 + 512), b0 = vtr(vp + 4096 + ks * 1024), b1 = vtr(vp + 4096 + ks * 1024 + 512);
        const bf16x8 v0 = {a0[0], a0[1], a0[2], a0[3], a1[0], a1[1], a1[2], a1[3]}, v1 = {b0[0], b0[1], b0[2], b0[3], b1[0], b1[1], b1[2], b1[3]};
        const bf16x8 pa = __builtin_bit_cast(bf16x8, pw[ks]);
        o0 = __builtin_amdgcn_mfma_f32_32x32x16_bf16(pa, v0, o0, 0, 0, 0);
        o1 = __builtin_amdgcn_mfma_f32_32x32x16_bf16(pa, v1, o1, 0, 0, 0);
    }
}
__device__ __forceinline__ void store_o(bf16_t* Ow, const f32x16& o0, const f32x16& o1, const float (&rsc)[16], LAS unsigned char* stg, int lane) {
    const int r32 = lane & 31, hi = lane >> 5;
    LAS bf16_t* s = (LAS bf16_t*)stg;
#pragma unroll
    for (int r = 0; r < 16; ++r) { const int orow = crow(r, hi);
        s[orow * 64 + r32] = (bf16_t)(cvt_pk_bf16(o0[r] * rsc[r], 0.f) & 0xffffu); s[orow * 64 + 32 + r32] = (bf16_t)(cvt_pk_bf16(o1[r] * rsc[r], 0.f) & 0xffffu); }
    LDS_WAIT();
#pragma unroll
    for (int i = 0; i < 4; ++i) { const int row = i * 8 + (lane >> 3), ch = lane & 7; const u32x4 v = *(const LAS u32x4*)(stg + row * 128 + ch * 16); *(u32x4*)(Ow + (size_t)row * BW + ch * 8) = v; }
    LDS_WAIT();
}

__device__ __forceinline__ void sb_item(bf16_t* Q, const bf16_t* K, const bf16_t* V, int b, int h, int q0, LAS unsigned char* vst, int lane) {
    asm volatile("" : "+v"(lane));
    const int r32 = lane & 31, hi = lane >> 5;
    const size_t rowbase = (size_t)b * SEQ;
    bf16_t* Qw = Q + (rowbase + q0) * BW + h * HD;
    bf16x8 qr[4];
#pragma unroll
    for (int d0 = 0; d0 < 4; ++d0) qr[d0] = *(const bf16x8*)(Qw + (size_t)r32 * BW + d0 * 16 + hi * 8);
    const bf16_t* Kh = K + (size_t)(b * NH + h) * SEQ * HD; const bf16_t* Vh = V + rowbase * BW + h * HD;
    f32x16 o0 = {}, o1 = {}; float A2 = 0.f;
    const int tq = q0 + r32;
    bf16x8 kf[8]; load_k(kf, Kh, ((q0 + 30) >> 6) * 64, r32, hi);
    for (int kt = (q0 + 30) >> 6; kt >= 0; --kt) {
        const int j0 = kt * 64;
        f32x16 p0 = {}, p1 = {};
        qk(p0, p1, kf, qr);
        asm volatile("" : "+v"(p0), "+v"(p1) :: "memory");
        u32x4 vv[8]; load_v(vv, Vh, j0, lane);
        if (kt > 0) load_k(kf, Kh, j0 - 64, r32, hi);
        const bool diag = (j0 + 63 >= q0);
        f32x16 l0, l1;
#pragma unroll
        for (int r = 0; r < 16; ++r) {
            { const float z = p0[r]; const float t = __builtin_amdgcn_exp2f(-__builtin_fabsf(z)); float l = -(__builtin_fmaxf(z, 0.f) + __builtin_amdgcn_logf(1.0f + t)); if (diag && (j0 + crow(r, hi) >= tq)) l = 0.f; l0[r] = l; }
            { const float z = p1[r]; const float t = __builtin_amdgcn_exp2f(-__builtin_fabsf(z)); float l = -(__builtin_fmaxf(z, 0.f) + __builtin_amdgcn_logf(1.0f + t)); if (diag && (j0 + 32 + crow(r, hi) >= tq)) l = 0.f; l1[r] = l; }
        }
        float carry = A2;
#pragma unroll
        for (int half = 1; half >= 0; --half) {
            f32x16& l = half ? l1 : l0; f32x16& p = half ? p1 : p0;
            float T[4];
#pragma unroll
            for (int g = 0; g < 4; ++g) { l[4 * g + 2] += l[4 * g + 3]; l[4 * g + 1] += l[4 * g + 2]; l[4 * g] += l[4 * g + 1]; T[g] = l[4 * g]; }
            float Tl[4], Th[4];
#pragma unroll
            for (int g = 0; g < 4; ++g) Tl[g] = swap_lo(T[g], Th[g]);
            float E = carry;
#pragma unroll
            for (int g = 3; g >= 0; --g) { const float eh = E; E += Th[g]; const float el = E; E += Tl[g]; const float off = hi ? eh : el;
                l[4 * g] += off; l[4 * g + 1] += off; l[4 * g + 2] += off; l[4 * g + 3] += off; }
            carry = E;
#pragma unroll
            for (int r = 0; r < 16; ++r) { float w = __builtin_amdgcn_exp2f(p[r] + l[r]); if (diag && (j0 + 32 * half + crow(r, hi) >= tq)) w = 0.f; p[r] = w; }
        }
        A2 = carry;
        stage_v(vst, vv, lane); LDS_WAIT();
        pv(o0, o1, p0, p1, vst, lane);
        LDS_WAIT();
        if (__all(A2 < -150.2f)) break;
    }
    float one[16];
#pragma unroll
    for (int r = 0; r < 16; ++r) one[r] = 1.0f;
    store_o(Qw, o0, o1, one, vst, lane);
}

constexpr float MOBA_THR = 8.0f;
__device__ __forceinline__ unsigned moba_gate(const bf16_t* Qw, const bf16_t* Kown, int blk, int tq0, float sl2, const LAS float* km, const LAS float* kbn, int lane) {
    asm volatile("" : "+v"(lane));
    const int r32 = lane & 31, hi = lane >> 5;
    unsigned sel = 0u;
    if (blk > 0) {
        float qf[64];
        { const u32x4* qp = (const u32x4*)(Qw + (size_t)r32 * BW);
#pragma unroll
          for (int c = 0; c < 8; ++c) { const u32x4 x = qp[c]; qf[8 * c] = bf_lo(x.x); qf[8 * c + 1] = bf_hi(x.x); qf[8 * c + 2] = bf_lo(x.y); qf[8 * c + 3] = bf_hi(x.y); qf[8 * c + 4] = bf_lo(x.z); qf[8 * c + 5] = bf_hi(x.z); qf[8 * c + 6] = bf_lo(x.w); qf[8 * c + 7] = bf_hi(x.w); } }
        float v1 = -INFINITY, v2 = -INFINITY, v3 = -INFINITY; int i1 = -1, i2 = -1, i3 = -1;
#define TOP_INS(v, n) do { const bool b1 = (v) > v1 || ((v) == v1 && (n) < i1), b2 = (v) > v2 || ((v) == v2 && (n) < i2), b3 = (v) > v3 || ((v) == v3 && (n) < i3); \
            if (b3) { if (b2) { v3 = v2; i3 = i2; if (b1) { v2 = v1; i2 = i1; v1 = (v); i1 = (n); } else { v2 = (v); i2 = (n); } } else { v3 = (v); i3 = (n); } } } while (0)
#pragma unroll 1
        for (int i = 0; i < 16; ++i) { const int n = 16 * hi + i;
            const LAS f32x4* kr = (const LAS f32x4*)(km + n * 64); float d0 = 0.f, d1 = 0.f, d2 = 0.f, d3 = 0.f;
#pragma unroll
            for (int c = 0; c < 16; ++c) { const f32x4 kk = kr[c]; d0 += qf[4 * c] * kk[0]; d1 += qf[4 * c + 1] * kk[1]; d2 += qf[4 * c + 2] * kk[2]; d3 += qf[4 * c + 3] * kk[3]; }
            const float d = (d0 + d1) + (d2 + d3);
            if (n < blk) TOP_INS(d, n); }
        { float x0, x1; x0 = swap_lo(v1, x1); const float pv1 = hi ? x0 : x1; x0 = swap_lo(v2, x1); const float pv2 = hi ? x0 : x1; x0 = swap_lo(v3, x1); const float pv3 = hi ? x0 : x1;
          x0 = swap_lo(__int_as_float(i1), x1); const int pi1 = __float_as_int(hi ? x0 : x1); x0 = swap_lo(__int_as_float(i2), x1); const int pi2 = __float_as_int(hi ? x0 : x1); x0 = swap_lo(__int_as_float(i3), x1); const int pi3 = __float_as_int(hi ? x0 : x1);
          TOP_INS(pv1, pi1); TOP_INS(pv2, pi2); TOP_INS(pv3, pi3); }
#undef TOP_INS
        float qn2 = 0.f, zs = 0.f;
        { const int tk = tq0 + r32; const bf16_t* kp = Kown + (size_t)(tk >> 5) * 2048 + (tk & 31) * 8;
#pragma unroll
          for (int c = 0; c < 8; ++c) { const u32x4 x = *(const u32x4*)(kp + c * 256);
              zs += qf[8 * c] * bf_lo(x.x) + qf[8 * c + 1] * bf_hi(x.x) + qf[8 * c + 2] * bf_lo(x.y) + qf[8 * c + 3] * bf_hi(x.y) + qf[8 * c + 4] * bf_lo(x.z) + qf[8 * c + 5] * bf_hi(x.z) + qf[8 * c + 6] * bf_lo(x.w) + qf[8 * c + 7] * bf_hi(x.w);
              qn2 += (qf[8 * c] * qf[8 * c] + qf[8 * c + 1] * qf[8 * c + 1]) + (qf[8 * c + 2] * qf[8 * c + 2] + qf[8 * c + 3] * qf[8 * c + 3]) + (qf[8 * c + 4] * qf[8 * c + 4] + qf[8 * c + 5] * qf[8 * c + 5]) + (qf[8 * c + 6] * qf[8 * c + 6] + qf[8 * c + 7] * qf[8 * c + 7]); } }
        const float qn = sqrtf(qn2) * 1.001f, thr = zs - 151.0f; const int tq = tq0 + r32;
#define KEEP(i_) ((i_) >= 0 && !(qn * kbn[(i_)] - sl2 * (float)(tq - (256 * (i_) + 255)) < thr))
        if (KEEP(i1)) sel |= 1u << i1; if (KEEP(i2)) sel |= 1u << i2; if (KEEP(i3)) sel |= 1u << i3;
#undef KEEP
    }
    return sel;
}
__device__ __forceinline__ void moba_tile(f32x16& o0, f32x16& o1, float& mrow, float& lsum, const bf16x8 (&qr)[4], bf16x8 (&kf)[8], const bf16_t* Kh, const bf16_t* Vh, int j0, int jn, float lb, float sl2, bool diag, int tq,
                                          LAS unsigned char* vst, LAS float* wsf, int lane) {
    const int r32 = lane & 31, hi = lane >> 5;
    f32x16 p0, p1;
#pragma unroll
    for (int r = 0; r < 16; ++r) { p0[r] = lb; p1[r] = lb + 32.0f * sl2; }
    qk(p0, p1, kf, qr);
    asm volatile("" : "+v"(p0), "+v"(p1) :: "memory");
    u32x4 vv[8]; load_v(vv, Vh, j0, lane);
    if (jn >= 0) load_k(kf, Kh, jn, r32, hi);
#pragma unroll
    for (int r = 0; r < 16; ++r) { p0[r] = __builtin_fmaf(sl2, (float)crow(r, 0), p0[r]); p1[r] = __builtin_fmaf(sl2, (float)crow(r, 0), p1[r]); }
    if (diag) {
#pragma unroll
        for (int r = 0; r < 16; ++r) { if (j0 + crow(r, hi) > tq) p0[r] = -INFINITY; if (j0 + 32 + crow(r, hi) > tq) p1[r] = -INFINITY; }
    }
    float rm = __builtin_fmaxf(p0[0], p1[0]);
#pragma unroll
    for (int r = 1; r < 16; ++r) rm = __builtin_fmaxf(rm, __builtin_fmaxf(p0[r], p1[r]));
    { float x1; const float x0 = swap_lo(rm, x1); rm = __builtin_fmaxf(x0, x1); }
    if (__any(rm > mrow + MOBA_THR)) {
        const float mn = __builtin_fmaxf(mrow, rm); const float f = __builtin_amdgcn_exp2f(mrow - mn); mrow = mn; lsum *= f;
        if (hi == 0) wsf[r32] = f;
        LDS_WAIT();
#pragma unroll
        for (int r = 0; r < 16; ++r) { const float fr_ = wsf[crow(r, hi)]; o0[r] *= fr_; o1[r] *= fr_; }
        LDS_WAIT();
    }
    float ps = 0.f;
#pragma unroll
    for (int r = 0; r < 16; ++r) { p0[r] = __builtin_amdgcn_exp2f(p0[r] - mrow); p1[r] = __builtin_amdgcn_exp2f(p1[r] - mrow); ps += p0[r] + p1[r]; }
    lsum += ps;
    stage_v(vst, vv, lane); LDS_WAIT();
    pv(o0, o1, p0, p1, vst, lane);
    LDS_WAIT();
}
__device__ __forceinline__ void moba_item(const bf16_t* Q, const bf16_t* K, const bf16_t* V, int b, int h, int blk, int n, int tix, const LAS unsigned char* lists, const LAS unsigned* cnt,
                                          const LAS unsigned* selm, unsigned char* recO, float* recML, LAS unsigned char* vst, LAS float* wsf, LAS unsigned* trow, int lane) {
    asm volatile("" : "+v"(lane));
    const int r32 = lane & 31, hi = lane >> 5; const size_t rowbase = (size_t)b * SEQ; const bool own = (n == blk);
    int q; bool valid; unsigned slot;
    if (own) { q = 32 * tix + r32; valid = true; slot = (unsigned)q * 4u + 3u; }
    else { const int cn = (int)cnt[n]; const int p = 32 * tix + r32; valid = p < cn; q = (int)lists[n * 256 + (valid ? p : cn - 1)];
           slot = (unsigned)q * 4u + (unsigned)__builtin_popcount(selm[q] & ((1u << n) - 1u)); }
    if (hi == 0) trow[r32] = slot | (valid ? 0x80000000u : 0u);
    const int tq = blk * 256 + q;
    const bf16_t* Qrow = Q + (rowbase + tq) * BW + h * HD + hi * 8;
    bf16x8 qr[4];
#pragma unroll
    for (int d0 = 0; d0 < 4; ++d0) qr[d0] = *(const bf16x8*)(Qrow + d0 * 16);
    const bf16_t* Kh = K + (size_t)(b * NH + h) * SEQ * HD; const bf16_t* Vh = V + rowbase * BW + h * HD;
    const float sl2 = __builtin_amdgcn_exp2f(-(float)(h + 1)) * LOG2E;
    f32x16 o0 = {}, o1 = {}; float mrow = -INFINITY, lsum = 0.f;
    const int ntile = own ? (tix >> 1) + 1 : 4;
    bf16x8 kf[8]; load_k(kf, Kh, n * 256, r32, hi);
#pragma unroll 1
    for (int i = 0; i < ntile; ++i) { const int j0 = n * 256 + i * 64;
        moba_tile(o0, o1, mrow, lsum, qr, kf, Kh, Vh, j0, i < ntile - 1 ? j0 + 64 : -1, sl2 * (float)(j0 + 4 * hi - tq), sl2, own && i == ntile - 1, tq, vst, wsf, lane); }
    { float x1; const float x0 = swap_lo(lsum, x1); lsum = x0 + x1; }
    if (hi == 0) { wsf[32 + r32] = lsum; if (valid) *(f32x2*)(recML + 2 * slot) = (f32x2){mrow, lsum}; }
    LDS_WAIT();
    LAS bf16_t* s = (LAS bf16_t*)vst;
#pragma unroll
    for (int r = 0; r < 16; ++r) { const int orow = crow(r, hi); const float rl = __builtin_amdgcn_rcpf(wsf[32 + orow]);
        s[orow * 64 + r32] = (bf16_t)(cvt_pk_bf16(o0[r] * rl, 0.f) & 0xffffu); s[orow * 64 + 32 + r32] = (bf16_t)(cvt_pk_bf16(o1[r] * rl, 0.f) & 0xffffu); }
    LDS_WAIT();
#pragma unroll
    for (int i = 0; i < 4; ++i) { const int row = i * 8 + (lane >> 3), ch = lane & 7; const unsigned tr = trow[row]; const u32x4 v = *(const LAS u32x4*)(vst + row * 128 + ch * 16);
        if (tr & 0x80000000u) *(u32x4*)(recO + (size_t)(tr & 0x7fffffffu) * 128 + ch * 16) = v; }
    LDS_WAIT();
}
__device__ __forceinline__ void moba_merge(bf16_t* Q, int b, int h, int blk, int w, const LAS unsigned* selm, const unsigned char* recO, const float* recML, LAS float* wsf, int lane) {
    asm volatile("" : "+v"(lane));
    const int r32 = lane & 31, hi = lane >> 5; const size_t rowbase = (size_t)b * SEQ; const int q0 = blk * 256 + w * 32;
    const int ql = w * 32 + r32; const int c = __builtin_popcount(selm[ql]);
    float mi[4], li[4]; float mx = -INFINITY;
#pragma unroll
    for (int k = 0; k < 4; ++k) { mi[k] = -INFINITY; li[k] = 0.f; if (k == 3 || k < c) { const f32x2 ml = __builtin_nontemporal_load((const f32x2*)(recML + 2 * ((unsigned)ql * 4u + k))); mi[k] = ml.x; li[k] = ml.y; } mx = __builtin_fmaxf(mx, mi[k]); }
    float wg[4], L = 0.f;
#pragma unroll
    for (int k = 0; k < 4; ++k) { wg[k] = (k == 3 || k < c) ? __builtin_amdgcn_exp2f(mi[k] - mx) * li[k] : 0.f; L += wg[k]; }
    const float rL = 1.0f / L;
    if (hi == 0) { wsf[r32] = wg[0] * rL; wsf[32 + r32] = wg[1] * rL; wsf[64 + r32] = wg[2] * rL; wsf[96 + r32] = wg[3] * rL; }
    LDS_WAIT();
    bf16_t* Qw = Q + (rowbase + q0) * BW + h * HD;
#pragma unroll
    for (int i = 0; i < 4; ++i) { const int row = i * 8 + (lane >> 3), ch = lane & 7; f32x4 v0 = {0.f, 0.f, 0.f, 0.f}, v1 = {0.f, 0.f, 0.f, 0.f};
        const unsigned rslot = (unsigned)(w * 32 + row) * 4u;
#pragma unroll
        for (int k = 0; k < 4; ++k) { const float ak = wsf[32 * k + row];
            if (ak != 0.f) { const u32x4 pw = __builtin_nontemporal_load((const u32x4*)(recO + (size_t)(rslot + k) * 128 + ch * 16));
                v0 += ak * (f32x4){bf_lo(pw.x), bf_hi(pw.x), bf_lo(pw.y), bf_hi(pw.y)}; v1 += ak * (f32x4){bf_lo(pw.z), bf_hi(pw.z), bf_lo(pw.w), bf_hi(pw.w)}; } }
        st_bf16x8(Qw + (size_t)row * BW + ch * 8, v0, v1); }
    LDS_WAIT();
}
}

#define XB_TMO      128
#define XB_XCNT(j)  (256  + 64 * (j))
#define XB_XSUB(j)  (1280 + 64 * (j))
#define XB_XGEN(j)  (2304 + 64 * (j))
#define XB_TOP      3328
#define XB_TOPGEN   3392
#define XCD_BAR_WORDS 3456
#define XB_SPIN_CAP (1u << 18)
__device__ __forceinline__ unsigned xb_ld(unsigned* p)              { return __hip_atomic_load(p, __ATOMIC_RELAXED, __HIP_MEMORY_SCOPE_AGENT); }
__device__ __forceinline__ unsigned xb_add(unsigned* p, unsigned v) { return __hip_atomic_fetch_add(p, v, __ATOMIC_RELAXED, __HIP_MEMORY_SCOPE_AGENT); }
__device__ __forceinline__ unsigned xb_xcc_id() { return (unsigned)__builtin_amdgcn_s_getreg((3 << 11) | 20) & 0xFu; }
#define XB_SPIN(cond, bar) do { unsigned _sp = 0; while (cond) { __builtin_amdgcn_s_sleep(1); \
    if ((++_sp & 255u) == 0u) { if (xb_ld(&(bar)[XB_TMO])) break; if (_sp > XB_SPIN_CAP) { atomicAdd(&(bar)[XB_TMO], 1u); break; } } } } while (0)
struct XcdBarrier { unsigned* bar; unsigned x; volatile LAS unsigned* st; };
__device__ __forceinline__ XcdBarrier xcd_barrier_post(unsigned* bar, volatile LAS unsigned* st) {
    XcdBarrier b; b.bar = bar; b.x = xb_xcc_id(); b.st = st;
    if (threadIdx.x == 0) (void)xb_add(&bar[XB_XCNT(b.x)], 1u);
    return b;
}
__device__ __forceinline__ void xcd_barrier_complete(unsigned* bar, unsigned x, unsigned& nloc, unsigned& nx) {
    const unsigned G = gridDim.x * gridDim.y * gridDim.z;
    unsigned sum, cnt, mine, sp = 0u;
    for (;;) {
        sum = 0u; cnt = 0u; mine = 0u;
#pragma unroll
        for (unsigned j = 0; j < 16; ++j) { const unsigned c = xb_ld(&bar[XB_XCNT(j)]); sum += c; cnt += (c > 0u) ? 1u : 0u; mine = (j == x) ? c : mine; }
        if (sum == G) break;
        __builtin_amdgcn_s_sleep(1);
        if ((++sp & 255u) == 0u) { if (xb_ld(&bar[XB_TMO])) break; if (sp > XB_SPIN_CAP) { atomicAdd(&bar[XB_TMO], 1u); break; } }
    }
    nloc = mine > 0u ? mine : 1u; nx = cnt > 0u ? cnt : 1u;
}
__device__ __forceinline__ void xcd_barrier(const XcdBarrier& b, int tid_) {
    asm volatile("s_waitcnt vmcnt(0)" ::: "memory");
    __syncthreads();
    if (tid_ == 0) {
        unsigned* bar = b.bar;
        __builtin_amdgcn_s_waitcnt(0);
        unsigned nloc = b.st[0], nx = b.st[1];
        if (nloc == 0u) { xcd_barrier_complete(bar, b.x, nloc, nx); b.st[0] = nloc; b.st[1] = nx; }
        const unsigned old = xb_add(&bar[XB_XSUB(b.x)], 1u);
        const unsigned gen = old / nloc;
        if (old + 1u == (gen + 1u) * nloc) {
            __builtin_amdgcn_fence(__ATOMIC_RELEASE, "agent");
            asm volatile("s_waitcnt vmcnt(0)" ::: "memory");
            const unsigned og = xb_add(&bar[XB_TOP], 1u);
            const unsigned tg = og / nx;
            if (og + 1u == (tg + 1u) * nx) xb_add(&bar[XB_TOPGEN], 1u);
            else XB_SPIN(xb_ld(&bar[XB_TOPGEN]) == tg, bar);
            __builtin_amdgcn_fence(__ATOMIC_ACQUIRE, "agent");
            xb_add(&bar[XB_XGEN(b.x)], 1u);
            asm volatile("s_waitcnt vmcnt(0)" ::: "memory");
        } else {
            XB_SPIN(xb_ld(&bar[XB_XGEN(b.x)]) == gen, bar);
            __builtin_amdgcn_fence(__ATOMIC_ACQUIRE, "agent");
            asm volatile("s_waitcnt vmcnt(0)" ::: "memory");
        }
    }
    __syncthreads();
}

__device__ __forceinline__ float wave_sum(float v) {
#pragma unroll
    for (int o = 1; o < 64; o <<= 1) v += __shfl_xor(v, o);
    return v;
}
struct TrD { const float* src; const float* gain; bf16_t* dst; int ldw, ldt; };
__device__ __forceinline__ void tr_load(const TrD& d, f32x4 (&v)[8], float (&g)[8], int lane) {
    const int c4 = lane & 7, r0 = lane >> 3;
#pragma unroll
    for (int i = 0; i < 8; ++i) { const int row = 8 * i + r0; v[i] = *(const GAS f32x4*)((const GAS float*)d.src + (size_t)row * d.ldw + 4 * c4); g[i] = d.gain ? ((const GAS float*)d.gain)[row] : 1.0f; }
}
__device__ __forceinline__ void tr_store(const TrD& d, const f32x4 (&v)[8], const float (&g)[8], LAS float* scr, int lane) {
    const int c4 = lane & 7, r0 = lane >> 3;
#pragma unroll
    for (int i = 0; i < 8; ++i) { LAS float* s = scr + (8 * i + r0) * 33 + 4 * c4; s[0] = v[i][0] * g[i]; s[1] = v[i][1] * g[i]; s[2] = v[i][2] * g[i]; s[3] = v[i][3] * g[i]; }
    LDS_WAIT(); asm volatile("" ::: "memory");
    const int c = lane & 7;
#pragma unroll
    for (int j = 0; j < 4; ++j) { const int n = (lane >> 3) + 8 * j; const LAS float* s = scr + (8 * c) * 33 + n;
        u32x4 o; o.x = cvt_pk_bf16(s[0 * 33], s[1 * 33]); o.y = cvt_pk_bf16(s[2 * 33], s[3 * 33]); o.z = cvt_pk_bf16(s[4 * 33], s[5 * 33]); o.w = cvt_pk_bf16(s[6 * 33], s[7 * 33]);
        *(GAS u32x4*)((GAS bf16_t*)d.dst + (size_t)n * d.ldt + 8 * c) = o; }
    LDS_WAIT(); asm volatile("" ::: "memory");
}
constexpr int I_IN = (DM / 64) * (NIN / 32), I_P = (BW / 64) * (DM / 32), I_O = (DM / 64) * (DM / 32), I_G = (DM / 64) * (DFF / 32), I_D = (DFF / 64) * (DM / 32);
constexpr int NITEMS = I_IN + 3 * I_P + I_O + 2 * I_G + I_D;
struct Args { const float* in[14]; float* out; unsigned char* ws; };
__device__ __forceinline__ void tr_decode(int it, TrD& d, const Args& A, int layer, unsigned char* ws) {
    int r = it;
    if (r < I_IN) { const int nblk = NIN / 32, kb = r / nblk, c0 = 32 * (r % nblk); size_t doff;
        if (c0 < 3072) doff = WS_WIN + (size_t)c0 * DM * 2;
        else if (c0 < 3584) doff = WS_WIN + (size_t)(3072 + 256 * ((c0 - 3072) >> 7) + ((c0 - 3072) & 127)) * DM * 2;
        else if (c0 < 4096) doff = WS_WIN + (size_t)(4096 + (c0 - 3584)) * DM * 2;
        else if (c0 < 4608) doff = WS_WIN + (size_t)(3072 + 256 * ((c0 - 4096) >> 7) + 128 + ((c0 - 4096) & 127)) * DM * 2;
        else doff = WS_WG + (size_t)(c0 - 4608) * DM * 2;
        d.src = A.in[2] + (size_t)layer * DM * NIN + (size_t)(64 * kb) * NIN + c0; d.gain = A.in[1] + (size_t)layer * DM + 64 * kb; d.dst = (bf16_t*)(ws + doff) + 64 * kb; d.ldw = NIN; d.ldt = DM; return; }
    r -= I_IN;
    if (r < I_P) { const int nblk = DM / 32, kb = r / nblk, c0 = 32 * (r % nblk);
        d.src = A.in[5] + (size_t)layer * BW * DM + (size_t)(64 * kb) * DM + c0; d.gain = nullptr; d.dst = (bf16_t*)(ws + WS_WP) + (size_t)c0 * BW + 64 * kb; d.ldw = DM; d.ldt = BW; return; }
    r -= I_P;
    if (r < I_P) { const int nblk = DM / 32, kb = r / nblk, c0 = 32 * (r % nblk);
        d.src = A.in[6] + (size_t)layer * BW * DM + (size_t)(64 * kb) * DM + c0; d.gain = nullptr; d.dst = (bf16_t*)(ws + WS_WP) + (size_t)DM * BW + (size_t)c0 * BW + 64 * kb; d.ldw = DM; d.ldt = BW; return; }
    r -= I_P;
    if (r < I_P) { const int nblk = DM / 32, kb = r / nblk, c0 = 32 * (r % nblk);
        d.src = A.in[7] + (size_t)layer * BW * DM + (size_t)(64 * kb) * DM + c0; d.gain = nullptr; d.dst = (bf16_t*)(ws + WS_WP) + (size_t)2 * DM * BW + (size_t)c0 * BW + 64 * kb; d.ldw = DM; d.ldt = BW; return; }
    r -= I_P;
    if (r < I_O) { const int nblk = DM / 32, kb = r / nblk, c0 = 32 * (r % nblk);
        d.src = A.in[8] + (size_t)layer * DM * DM + (size_t)(64 * kb) * DM + c0; d.gain = nullptr; d.dst = (bf16_t*)(ws + WS_WO) + (size_t)c0 * DM + 64 * kb; d.ldw = DM; d.ldt = DM; return; }
    r -= I_O;
    if (r < I_G) { const int nblk = DFF / 32, kb = r / nblk, c0 = 32 * (r % nblk);
        d.src = A.in[10] + (size_t)layer * DM * DFF + (size_t)(64 * kb) * DFF + c0; d.gain = A.in[9] + (size_t)layer * DM + 64 * kb; d.dst = (bf16_t*)(ws + WS_WGU) + (size_t)(256 * (c0 >> 7) + (c0 & 127)) * DM + 64 * kb; d.ldw = DFF; d.ldt = DM; return; }
    r -= I_G;
    if (r < I_G) { const int nblk = DFF / 32, kb = r / nblk, c0 = 32 * (r % nblk);
        d.src = A.in[11] + (size_t)layer * DM * DFF + (size_t)(64 * kb) * DFF + c0; d.gain = A.in[9] + (size_t)layer * DM + 64 * kb; d.dst = (bf16_t*)(ws + WS_WGU) + (size_t)(256 * (c0 >> 7) + 128 + (c0 & 127)) * DM + 64 * kb; d.ldw = DFF; d.ldt = DM; return; }
    r -= I_G;
    { const int nblk = DM / 32, kb = r / nblk, c0 = 32 * (r % nblk);
      d.src = A.in[12] + (size_t)layer * DFF * DM + (size_t)(64 * kb) * DM + c0; d.gain = nullptr; d.dst = (bf16_t*)(ws + WS_WD) + (size_t)c0 * DFF + 64 * kb; d.ldw = DM; d.ldt = DFF; }
}


__global__ void __launch_bounds__(NWAVES * 64, 2) hybrid_fwd(Args args) {
    extern __shared__ __attribute__((aligned(16))) unsigned char lds_raw[];
    LAS unsigned char* lds = (LAS unsigned char*)lds_raw;
    volatile LAS unsigned* MISC = (volatile LAS unsigned*)(lds + MISC_OFF);
    const int wave = __builtin_amdgcn_readfirstlane((int)threadIdx.x >> 6);
    const int G = gridDim.x, bx = blockIdx.x, vcu = (G % 8 == 0) ? (bx % 8) * (G / 8) + bx / 8 : bx;
    for (int i = threadIdx.x; i < (LDS_BYTES - LDSCTL_OFF) / 4; i += NWAVES * 64) ((LAS unsigned*)(lds + LDSCTL_OFF))[i] = 0u;
    __syncthreads();
    XcdBarrier bar = xcd_barrier_post((unsigned*)(args.ws + WS_CTL) + CW_BAR, MISC + 8);
    const int gw = vcu * NWAVES + wave, NGW = G * NWAVES;

#ifndef REP_PH
#define REP_PH -1
#endif
    for (int pq = 0; pq < DEPTH * 7 + 1; ++pq)
    for (int rep_ = 0; rep_ < ((pq % 7 == REP_PH && pq < DEPTH * 7) ? 2 : 1); ++rep_) {
        const int pp = pq;
        const int layer = pp / 7, ph = pp - 7 * layer;
        int tid = wave * 64 + lane_id(); asm volatile("" : "+v"(tid)); const int lane = tid & 63;
        size_t opq = 0; asm volatile("" : "+s"(opq));
        unsigned char* ws = args.ws + opq; const float* x_in = args.in[0] + opq; float* out = args.out + opq;
        float* ssA = (float*)(ws + WS_SSA); float* ssB = (float*)(ws + WS_SSB); float* kmp = (float*)(ws + WS_KM);
        bf16_t* xb = (bf16_t*)(ws + WS_XB);
        bf16_t* QA = (bf16_t*)(ws + WS_QA); bf16_t* KA = (bf16_t*)(ws + WS_KA); bf16_t* VA = (bf16_t*)(ws + WS_VA);
        bf16_t* QS = (bf16_t*)(ws + WS_QS); bf16_t* KS = (bf16_t*)(ws + WS_KS); bf16_t* VS = (bf16_t*)(ws + WS_VS);
        bf16_t* Ub = (bf16_t*)(ws + WS_U); bf16_t* BC = (bf16_t*)(ws + WS_BC); bf16_t* MG = (bf16_t*)(ws + WS_MG); bf16_t* ACT = (bf16_t*)(ws + WS_ACT);

        if (layer == DEPTH) {
            const float* gf = args.in[13];
            for (int m = gw; m < M; m += NGW) {
                const float rs = rstd_row(ssA, m);
                f32x4* xr = (f32x4*)(out + (size_t)m * DM) + lane; const f32x4* gr = (const f32x4*)gf + lane; const u32x2* xs = (const u32x2*)(xb + (size_t)m * DM) + lane;
#pragma unroll
                for (int j = 0; j < 4; ++j) { const u32x2 w = xs[64 * j]; const f32x4 v = {bf_lo(w.x), bf_hi(w.x), bf_lo(w.y), bf_hi(w.y)}, g = gr[64 * j]; xr[64 * j] = v * rs * g; }
            }
            if (xb_ld((unsigned*)(ws + WS_CTL) + CW_BAR + XB_TMO) != 0u && bx == 0) { for (int i = tid; i < 4096; i += NWAVES * 64) out[i] = __builtin_nanf(""); }
            break;
        }
        if (ph == 0) {
            LAS float* scr = (LAS float*)(lds + RING_OFF + wave * 16384);
            {
                int it = gw;
                for (; it + NGW < NITEMS; it += 2 * NGW) {
                    TrD da, db; f32x4 va[8], vb[8]; float ga[8], gb[8];
                    tr_decode(it, da, args, layer, ws); tr_load(da, va, ga, lane);
                    tr_decode(it + NGW, db, args, layer, ws); tr_load(db, vb, gb, lane);
                    tr_store(da, va, ga, scr, lane); tr_store(db, vb, gb, scr, lane);
                }
                if (it < NITEMS) { TrD da; f32x4 va[8]; float ga[8]; tr_decode(it, da, args, layer, ws); tr_load(da, va, ga, lane); tr_store(da, va, ga, scr, lane); }
            }
            if (layer == 0) {
                for (int m = gw; m < M; m += NGW) {
                    const f32x4* xr = (const f32x4*)(x_in + (size_t)m * DM) + lane; f32x4 v[4]; float s = 0.f;
#pragma unroll
                    for (int j = 0; j < 4; ++j) { v[j] = xr[64 * j]; s += (v[j].x * v[j].x + v[j].y * v[j].y) + (v[j].z * v[j].z + v[j].w * v[j].w); }
                    s = wave_sum(s);
                    u32x2* o8 = (u32x2*)(xb + (size_t)m * DM) + lane;
#pragma unroll
                    for (int j = 0; j < 4; ++j) o8[64 * j] = (u32x2){cvt_pk_bf16(v[j].x, v[j].y), cvt_pk_bf16(v[j].z, v[j].w)};
                    if (lane < 4) ssA[(size_t)m * 4 + lane] = (lane == 0) ? s : 0.f;
                }
            }
        } else if (ph == 2) {
            LAS unsigned char* vst = lds + RING_OFF + wave * 8192;
            LAS float* wsf = (LAS float*)(lds + RING_OFF + 65536 + wave * 512);
            LAS float* km = (LAS float*)(lds + RING_OFF + 65536 + 4096);
            LAS unsigned* selm = (LAS unsigned*)(lds + RING_OFF + 77824);
            LAS unsigned* cnt = (LAS unsigned*)(lds + RING_OFF + 78848);
            LAS float* kbn = (LAS float*)(lds + RING_OFF + 78848 + 256);
            LAS unsigned* uslot = (LAS unsigned*)(lds + RING_OFF + 78848 + 512);
            LAS unsigned char* lists = lds + RING_OFF + 79872;
            LAS unsigned* trow = (LAS unsigned*)(lds + RING_OFF + 88064 + wave * 128);
            unsigned char* recO = ws + WS_MG + (size_t)vcu * 131072; float* recML = (float*)(ws + WS_X + (size_t)vcu * 8192);
            unsigned* qctr = (unsigned*)(ws + WS_CTL) + 8192 + layer * 64;
            unsigned* ndone = (unsigned*)(ws + WS_CTL) + 8192 + 128 + layer * 1024;
            float* kbmax = (float*)((unsigned*)(ws + WS_CTL) + 8192 + 4096 + layer * 512);
            for (;;) {
                if (tid == 0) *uslot = __hip_atomic_fetch_add(qctr, 1u, __ATOMIC_RELAXED, __HIP_MEMORY_SCOPE_AGENT);
                __syncthreads();
                const unsigned uq = *uslot;
                __syncthreads();
                if (uq >= 1536u) break;
                if (uq < 512u) {
                    const int bh = (int)(uq >> 5), n = (int)(uq & 31u), b = bh >> 3, h = bh & 7;
                    const int key_ = n * 256 + (tid >> 1); const bf16_t* kp = KA + (size_t)(b * NH + h) * SEQ * HD + (size_t)(key_ >> 5) * 2048 + (tid & 1) * 1024 + (key_ & 31) * 8;
                    float sq = 0.f;
#pragma unroll
                    for (int c = 0; c < 4; ++c) { const u32x4 x = *(const u32x4*)(kp + c * 256); const float e0 = bf_lo(x.x), e1 = bf_hi(x.x), e2 = bf_lo(x.y), e3 = bf_hi(x.y), e4 = bf_lo(x.z), e5 = bf_hi(x.z), e6 = bf_lo(x.w), e7 = bf_hi(x.w);
                        sq += (e0 * e0 + e1 * e1) + (e2 * e2 + e3 * e3) + (e4 * e4 + e5 * e5) + (e6 * e6 + e7 * e7); }
                    sq += xshfl<1>(sq);
                    sq = __builtin_fmaxf(sq, xshfl<2>(sq)); sq = __builtin_fmaxf(sq, xshfl<4>(sq)); sq = __builtin_fmaxf(sq, xshfl<8>(sq)); sq = __builtin_fmaxf(sq, xshfl<16>(sq));
                    { float x1; const float x0 = att::swap_lo(sq, x1); sq = __builtin_fmaxf(x0, x1); }
                    if (lane == 0) kbn[wave] = sq;
                    __syncthreads();
                    if (tid == 0) { float m_ = kbn[0];
#pragma unroll
                        for (int w_ = 1; w_ < NWAVES; ++w_) m_ = __builtin_fmaxf(m_, kbn[w_]);
                        __hip_atomic_store(kbmax + bh * 32 + n, m_, __ATOMIC_RELAXED, __HIP_MEMORY_SCOPE_AGENT);
                        asm volatile("s_waitcnt vmcnt(0)" ::: "memory");
                        __hip_atomic_fetch_add(ndone + bh * 64, 1u, __ATOMIC_RELAXED, __HIP_MEMORY_SCOPE_AGENT); }
                    __syncthreads();
                } else if (uq < 1024u) {
                    const unsigned um = uq - 512u; const int h = 7 - (int)(um >> 6), blk = 31 - (int)((um & 63u) >> 1), b = (int)(um & 1u);
                    for (int i = tid; i < 2048; i += NWAVES * 64) { const int n = i >> 6, d = i & 63; const size_t o = (size_t)((b * 32 + n) * 2) * BW + h * HD + d; km[i] = kmp[o] + kmp[o + BW]; }
                    if (tid == 0) {
                        unsigned sp_ = 0; while (__hip_atomic_load(ndone + (b * 8 + h) * 64, __ATOMIC_RELAXED, __HIP_MEMORY_SCOPE_AGENT) < 32u) { __builtin_amdgcn_s_sleep(2);
                            if (++sp_ > (1u << 20)) { atomicAdd((unsigned*)(ws + WS_CTL) + CW_BAR + XB_TMO, 1u); break; } } }
                    __syncthreads();
                    if (tid < 32) kbn[tid] = sqrtf(__hip_atomic_load(kbmax + (b * 8 + h) * 32 + tid, __ATOMIC_RELAXED, __HIP_MEMORY_SCOPE_AGENT)) * 1.01f;
                    __syncthreads();
                    const float sl2 = __builtin_amdgcn_exp2f(-(float)(h + 1)) * LOG2E;
                    const size_t qrow = (size_t)b * SEQ + blk * 256 + wave * 32;
                    const unsigned sel = att::moba_gate(QA + qrow * BW + h * HD, KA + (size_t)(b * NH + h) * SEQ * HD, blk, blk * 256 + wave * 32, sl2, km, kbn, lane);
                    if (lane < 32) selm[wave * 32 + lane] = sel;
                    __syncthreads();
                    for (int n = wave; n < blk; n += NWAVES) {
                        unsigned pos = 0;
#pragma unroll
                        for (int c = 0; c < 4; ++c) { const int q = 64 * c + lane; const bool bit = (selm[q] >> n) & 1u; const unsigned long long mk = __ballot(bit);
                            if (bit) lists[n * 256 + pos + __builtin_amdgcn_mbcnt_hi((unsigned)(mk >> 32), __builtin_amdgcn_mbcnt_lo((unsigned)mk, 0u))] = (unsigned char)q;
                            pos += (unsigned)__builtin_popcountll(mk); }
                        if (lane == 0) cnt[n] = pos;
                    }
                    __syncthreads();
                    { int n = blk, t = wave; int nn = 0, tt = 0, idp = 0;
                      for (;;) {
                          att::moba_item(QA, KA, VA, b, h, blk, n, t, lists, cnt, selm, recO, recML, vst, wsf, trow, lane);
                          bool found = false;
                          while (nn < blk) { const int nt_ = ((int)cnt[nn] + 31) >> 5;
                              if (tt < nt_) { const bool mine = (idp & (NWAVES - 1)) == wave; if (mine) { n = nn; t = tt; found = true; } ++tt; ++idp; if (mine) break; }
                              else { ++nn; tt = 0; } }
                          if (!found) break;
                      } }
                    VM_WAIT();
                    __syncthreads();
                    att::moba_merge(QA, b, h, blk, wave, selm, recO, recML, wsf, lane);
                    __syncthreads();
                } else {
                    const unsigned us = uq - 1024u; const int h = (int)(us >> 6), blk = (int)((us & 63u) >> 1), b = (int)(us & 1u);
                    att::sb_item(QS, KS, VS, b, h, blk * 256 + wave * 32, vst, lane);
                }
            }
            const float* cw = args.in[4] + (size_t)layer * 3 * BW;
            for (int i = vcu * (NWAVES * 64) + tid; i < M * (BW / 8); i += G * NWAVES * 64) {
                const int t = i >> 6, c = (i & 63) * 8; const int tt = t & (SEQ - 1);
                const u32x4 u2 = *(const u32x4*)(Ub + (size_t)t * BW + c);
                u32x4 u1 = {0u, 0u, 0u, 0u}, u0 = {0u, 0u, 0u, 0u};
                if (tt >= 1) u1 = *(const u32x4*)(Ub + (size_t)(t - 1) * BW + c);
                if (tt >= 2) u0 = *(const u32x4*)(Ub + (size_t)(t - 2) * BW + c);
                const u32x4 bw = *(const u32x4*)(BC + (size_t)t * BW + c);
                float y[8];
#pragma unroll
                for (int e = 0; e < 4; ++e) {
                    const float w0l = cw[c + 2 * e], w0h = cw[c + 2 * e + 1], w1l = cw[BW + c + 2 * e], w1h = cw[BW + c + 2 * e + 1], w2l = cw[2 * BW + c + 2 * e], w2h = cw[2 * BW + c + 2 * e + 1];
                    y[2 * e] = bf_lo(bw[e]) * (w0l * bf_lo(u0[e]) + w1l * bf_lo(u1[e]) + w2l * bf_lo(u2[e]));
                    y[2 * e + 1] = bf_hi(bw[e]) * (w0h * bf_hi(u0[e]) + w1h * bf_hi(u1[e]) + w2h * bf_hi(u2[e]));
                }
                *(u32x4*)(BC + (size_t)t * BW + c) = (u32x4){cvt_pk_bf16(y[0], y[1]), cvt_pk_bf16(y[2], y[3]), cvt_pk_bf16(y[4], y[5]), cvt_pk_bf16(y[6], y[7])};
            }
        } else {
            static_assert(WS_QS - WS_QA == 48 * MiB && WS_BC - WS_QS == 48 * MiB && WS_GB - WS_GA == 48 * MiB && WS_GC0 - WS_GB == 48 * MiB && WS_GC1 - WS_GC0 == 48 * MiB, "48 MiB spacing");
            GCfg c{};
            c.ws = ws; c.bgate = args.in[3] + (size_t)layer * NGATE; c.red = (LAS float*)(lds + LDSCTL_OFF + 1024);
            c.nseg = 1; c.lda = DM; c.ldb = DM; c.nt = DM / 64; c.toA = 0;
            if (ph == 1) { c.mode = 0; c.N = N1; c.A = xb; c.B = (const bf16_t*)(ws + WS_WIN); }
            else if (ph == 3) { c.mode = 1; c.N = DM; c.nseg = 6; c.A = xb; c.B = (const bf16_t*)(ws + WS_WG); }
            else if (ph == 4) { c.mode = 2; c.N = DM; c.A = MG; c.B = (const bf16_t*)(ws + WS_WO); }
            else if (ph == 5) { c.mode = 3; c.N = NGU; c.A = xb; c.B = (const bf16_t*)(ws + WS_WGU); }
            else { c.mode = 2; c.N = DM; c.A = ACT; c.B = (const bf16_t*)(ws + WS_WD); c.lda = DFF; c.ldb = DFF; c.nt = DFF / 64; c.toA = 1; }
            ProbAny P{&c}; EpiAny E{&c}; pg8::StaticOrder S; S.init(M, c.N, G, bx, c.nseg);
            pg8::gemm_phase(lds + RING_OFF, P, S, E, wave);
        }
        xcd_barrier(bar, tid);
    }
}

extern "C" void kernel_launch(void* const* d_in, const int* in_sizes, int n_in, void* d_out, int out_size, void* d_ws, size_t ws_size, hipStream_t stream) {
    static int grid = 0;
    if (grid == 0) {
        if (n_in != 14 || in_sizes[0] != M * DM || out_size != M * DM || ws_size < WS_END) { fprintf(stderr, "kernel_launch: unexpected shapes (n_in %d, in0 %d, out %d, ws %zu)\n", n_in, n_in > 0 ? in_sizes[0] : -1, out_size, ws_size); grid = -1; return; }
        int dev = 0, cus = 0, per_cu = 0;
        if (hipGetDevice(&dev) != hipSuccess || hipDeviceGetAttribute(&cus, hipDeviceAttributeMultiprocessorCount, dev) != hipSuccess) { grid = -1; return; }
        if (hipFuncSetAttribute((const void*)hybrid_fwd, hipFuncAttributeMaxDynamicSharedMemorySize, LDS_BYTES) != hipSuccess) { fprintf(stderr, "kernel_launch: hipFuncSetAttribute failed\n"); grid = -1; return; }
        if (hipOccupancyMaxActiveBlocksPerMultiprocessor(&per_cu, (const void*)hybrid_fwd, NWAVES * 64, LDS_BYTES) != hipSuccess || per_cu < 1) { fprintf(stderr, "kernel_launch: occupancy query says %d blocks/CU\n", per_cu); (void)hipGetLastError(); per_cu = 1; }
        grid = cus;
    }
    if (grid < 0) return;
    if (hipMemsetAsync((char*)d_ws + WS_CTL, 0, CTL_ZERO_BYTES, stream) != hipSuccess) { fprintf(stderr, "kernel_launch: memset failed\n"); return; }
    Args a{};
    for (int i = 0; i < 14; ++i) a.in[i] = (const float*)d_in[i];
    a.out = (float*)d_out; a.ws = (unsigned char*)d_ws;
    void* kargs[] = {&a};
    hipError_t e = hipLaunchCooperativeKernel((const void*)hybrid_fwd, dim3(grid), dim3(NWAVES * 64), kargs, LDS_BYTES, stream);
    if (e != hipSuccess) fprintf(stderr, "kernel_launch: cooperative launch failed: %s (grid %d)\n", hipGetErrorString(e), grid);
}
```

```cpp
#include <hip/hip_runtime.h>
#include <hip/hip_bf16.h>
#include <cstdio>
#include <cstdint>

#define GAS __attribute__((address_space(1)))
#define LAS __attribute__((address_space(3)))
typedef unsigned short bf16_t;
typedef short bf16x8 __attribute__((ext_vector_type(8)));
typedef short s16x4 __attribute__((ext_vector_type(4)));
typedef float f32x2 __attribute__((ext_vector_type(2)));
typedef float f32x4 __attribute__((ext_vector_type(4)));
typedef float f32x16 __attribute__((ext_vector_type(16)));
typedef unsigned u32x2 __attribute__((ext_vector_type(2)));
typedef unsigned u32x4 __attribute__((ext_vector_type(4)));
typedef GAS unsigned gu32;

constexpr int BATCH = 2, SEQ = 8192, DM = 1024, M = BATCH * SEQ, NH = 8, HD = 64, BW = 512, DFF = 2816, DEPTH = 2;
constexpr int NIN = 7680, N1 = 4608, NGATE = 3072, NGU = 2 * DFF;
constexpr float RMS_EPS = 1e-6f;
constexpr float LOG2E = 1.4426950408889634f;
constexpr float C2 = 0.125f * LOG2E;
constexpr int NWAVES = 8;

constexpr size_t MiB = 1u << 20;
constexpr size_t WS_CTL = 0, CTL_ZERO_BYTES = 64 * 1024;
constexpr size_t WS_SSA = 1 * MiB, WS_SSB = 2 * MiB, WS_KM = 3 * MiB;
constexpr size_t WS_WIN = 4 * MiB, WS_WG = 13 * MiB, WS_WP = 19 * MiB, WS_WO = 22 * MiB, WS_WGU = 24 * MiB, WS_WD = 35 * MiB;
constexpr size_t WS_XB = 41 * MiB;
constexpr size_t WS_QA = 73 * MiB, WS_KA = 89 * MiB, WS_VA = 105 * MiB, WS_QS = 121 * MiB, WS_KS = 137 * MiB, WS_VS = 153 * MiB;
constexpr size_t WS_BC = 169 * MiB, WS_U = 185 * MiB, WS_MG = 201 * MiB, WS_X = 233 * MiB;
constexpr size_t WS_GA = WS_KA, WS_GB = WS_KS, WS_GC0 = WS_U, WS_GC1 = WS_X;
constexpr size_t WS_ACT = 73 * MiB;
constexpr size_t WS_END = 256 * MiB;
constexpr int CW_BAR = 4096;

constexpr int RING_OFF = 0, RING_BYTES = 131072;
constexpr int ATT_OFF = RING_BYTES, ATT_BYTES = 23552;
constexpr int LDSCTL_OFF = ATT_OFF + ATT_BYTES, MISC_OFF = LDSCTL_OFF + 320;
constexpr int LDS_BYTES = 163840;
static_assert(LDSCTL_OFF + 1024 + 4096 <= LDS_BYTES, "LDS map");

#define LDS_WAIT() asm volatile("s_waitcnt lgkmcnt(0)" ::: "memory")
#define VM_WAIT() asm volatile("s_waitcnt vmcnt(0)" ::: "memory")
#define RLX_AGENT __ATOMIC_RELAXED, __HIP_MEMORY_SCOPE_AGENT

typedef __bf16 bf16x2_t __attribute__((ext_vector_type(2)));
__device__ __forceinline__ unsigned cvt_pk_bf16(float lo, float hi) { const f32x2 v = {lo, hi}; const bf16x2_t b = __builtin_convertvector(v, bf16x2_t); return __builtin_bit_cast(unsigned, b); }
template <int O> __device__ __forceinline__ float xshfl(float x) {
    static_assert(O < 32, "use sum32 for the two 32-lane halves");
    return __int_as_float(__builtin_amdgcn_ds_swizzle(__float_as_int(x), (O << 10) | 0x1f));
}
__device__ __forceinline__ int lane_id() { return (int)__builtin_amdgcn_mbcnt_hi(~0u, __builtin_amdgcn_mbcnt_lo(~0u, 0u)); }
__device__ __forceinline__ float sum32(float x) { auto rr = __builtin_amdgcn_permlane32_swap(__float_as_uint(x), __float_as_uint(x), false, false); return __uint_as_float(rr[0]) + __uint_as_float(rr[1]); }
__device__ __forceinline__ float bf_lo(unsigned w) { return __uint_as_float(w << 16); }
__device__ __forceinline__ float bf_hi(unsigned w) { return __uint_as_float(w & 0xffff0000u); }
__device__ __forceinline__ float rstd_row(const float* ssp, int row) {
    const f32x4 a = *(const f32x4*)(ssp + (size_t)row * 4);
    return rsqrtf(((a.x + a.y) + (a.z + a.w)) * (1.0f / DM) + RMS_EPS);
}

namespace pg8 {
constexpr int BM = 256, BK = 64, HALF = 128, HTB = HALF * BK * 2, STAGE_BYTES = 8 * HTB, NXCD = 8, WGM = 8;
__host__ __device__ __forceinline__ int lds_byte(int r, int c) { const int st = (r >> 4) * 2 + (c >> 5), rr = r & 15, cc = c & 31, ob = rr * 64 + cc * 2; return st * 1024 + (ob ^ (((ob >> 9) & 1) << 5)); }
__host__ __device__ __forceinline__ void stage_rc(int b, int& R, int& C) { const int st = b / 1024, sb = b % 1024, swz = sb ^ (((sb >> 9) & 1) << 5); R = (st >> 1) * 16 + swz / 64; C = (st & 1) * 32 + (swz % 64) / 2; }
__host__ __device__ __forceinline__ int perm32(int rho) { const int n = rho >> 4, i = rho & 15; return 8 * (i >> 2) + 4 * n + (i & 3); }

struct Unit { int pm, pn, seg; };
struct Seg { const char* A; const char* B; unsigned hA, hB; int lda, ldb, nt; };

struct StaticOrder {
    int nM, nN, nwg, G, c, nseg;
    __device__ void init(int M_, int N_, int G_, int c_, int nseg_) { nM = M_ / BM; nN = N_ / BM; nwg = nM * nN; G = G_; c = c_; nseg = nseg_; }
    __device__ bool next(int i, Unit& u) const {
        const int ti = (nseg == 1) ? i : i / nseg; u.seg = i - ti * nseg;
        const long L = (long)ti * G + c; if (L >= nwg) return false;
        int wgid = (int)L; { const int q = nwg / NXCD, r = nwg % NXCD, xcd = wgid % NXCD, off = wgid / NXCD; wgid = (xcd < r ? xcd * (q + 1) : r * (q + 1) + (xcd - r) * q) + off; }
        const int nig = WGM * nN, gid = wgid / nig, fm = gid * WGM, gsz = (nM - fm) < WGM ? (nM - fm) : WGM;
        u.pm = fm + ((wgid % nig) % gsz); u.pn = (wgid % nig) / gsz; return true;
    }
};

template <class Prob, class Epi, class Sched>
__device__ __forceinline__ void gemm_phase(LAS unsigned char* lds, const Prob& P, const Sched& S, const Epi& E, int wave_) {
    int tid = wave_ * 64 + lane_id(); asm volatile("" : "+v"(tid));
    const int wid = wave_, lane = tid & 63, wr = wid >> 2, wc = wid & 3, fr = lane & 15, fq = lane >> 4;
#define PG8_RC(R0, C0, Rb0) int R0, C0; { int t_ = tid; asm volatile("" : "+v"(t_)); stage_rc(t_ * 16, R0, C0); } const int Rb0 = (R0 & ~31) + perm32(R0 & 31)
    const size_t kstep = (size_t)(BK * 2);
    const unsigned ldsw = (unsigned)wid * 1024u;
    const int aoff = lds_byte(wr * 64 + fr, fq * 8), boff = lds_byte(wc * 32 + fr, fq * 8);
#define PG8_SA(b, h) (((b) * 2 + (h)) * HTB)
#define PG8_SB(b, h) ((4 + (b) * 2 + (h)) * HTB)
#define PG8_STAGE(bufoff, gbase, v0, q) do { \
        __builtin_amdgcn_global_load_lds((const unsigned*)((const char*)(gbase) + (v0)), (LAS unsigned*)(lds + (bufoff) + ldsw), 16, 0, 0); \
        __builtin_amdgcn_global_load_lds((const unsigned*)((const char*)(gbase) + (q) + (v0)), (LAS unsigned*)(lds + (bufoff) + ldsw + 8192), 16, 0, 0); } while (0)
#define PG8_LDA(dst, b, h) do { _Pragma("unroll") for (int m = 0; m < 4; ++m) _Pragma("unroll") for (int k = 0; k < 2; ++k) dst[m][k] = *(const LAS bf16x8*)(lds + PG8_SA(b, h) + aoff + m * 2048 + k * 1024); } while (0)
#define PG8_LDB(dst, b, h) do { _Pragma("unroll") for (int n = 0; n < 2; ++n) _Pragma("unroll") for (int k = 0; k < 2; ++k) dst[n][k] = *(const LAS bf16x8*)(lds + PG8_SB(b, h) + boff + n * 2048 + k * 1024); } while (0)
#define PG8_MMA(ai, bj, At, Bt) do { __builtin_amdgcn_s_setprio(1); _Pragma("unroll") for (int m = 0; m < 4; ++m) _Pragma("unroll") for (int n = 0; n < 2; ++n) _Pragma("unroll") for (int k = 0; k < 2; ++k) \
        acc[ai][bj][m][n] = __builtin_amdgcn_mfma_f32_16x16x32_bf16(Bt[n][k], At[m][k], acc[ai][bj][m][n], 0, 0, 0); __builtin_amdgcn_s_setprio(0); } while (0)
#define PG8_WAIT_V(n) asm volatile("s_waitcnt vmcnt(" #n ")" ::: "memory")
#define PG8_WAIT_L(n) asm volatile("s_waitcnt lgkmcnt(" #n ")" ::: "memory")
#define PG8_BAR __builtin_amdgcn_s_barrier()
#define PG8_SCHED __builtin_amdgcn_sched_barrier(0)
    Unit cur, nxt; int ui = 0;
    if (!S.next(0, cur)) return;
    Seg sc, sn; P.seg(cur, sc);
    unsigned vAc0, vBc0; { PG8_RC(R0, C0, Rb0); vAc0 = (unsigned)(R0 * sc.lda + C0) * 2u; vBc0 = (unsigned)(Rb0 * sc.ldb + C0) * 2u; }
    f32x4 acc[2][2][4][2];
#pragma unroll
    for (int a = 0; a < 2; ++a)
#pragma unroll
        for (int b = 0; b < 2; ++b)
#pragma unroll
            for (int m = 0; m < 4; ++m)
#pragma unroll
                for (int n = 0; n < 2; ++n) acc[a][b][m][n] = (f32x4){0.f, 0.f, 0.f, 0.f};
    bf16x8 At[4][2], B0[2][2], B1[2][2];
    const char* cA = sc.A; const char* cB = sc.B;
    PG8_STAGE(PG8_SB(0, 0), cB, vBc0, sc.hB >> 1); PG8_STAGE(PG8_SB(0, 1), cB + sc.hB, vBc0, sc.hB >> 1); PG8_STAGE(PG8_SA(0, 0), cA, vAc0, sc.hA >> 1); PG8_STAGE(PG8_SA(0, 1), cA + sc.hA, vAc0, sc.hA >> 1);
    if (wr == 1) PG8_BAR;
    PG8_WAIT_V(2); PG8_BAR;
    PG8_STAGE(PG8_SB(1, 0), cB + kstep, vBc0, sc.hB >> 1); PG8_STAGE(PG8_SA(1, 0), cA + kstep, vAc0, sc.hA >> 1); PG8_STAGE(PG8_SB(1, 1), cB + sc.hB + kstep, vBc0, sc.hB >> 1);
    PG8_WAIT_V(6); PG8_BAR;
    for (;;) {
        const bool has_next = S.next(ui + 1, nxt);
        if (has_next) P.seg(nxt, sn); else sn = sc;
        unsigned vAn0, vBn0; { PG8_RC(R0, C0, Rb0); vAn0 = (unsigned)(R0 * sn.lda + C0) * 2u; vBn0 = (unsigned)(Rb0 * sn.ldb + C0) * 2u; }
        const char* nA = sn.A; const char* nB = sn.B;
        const int nt = sc.nt;
        for (int t = 0; t < nt; t += 2) {
            const bool last = (t == nt - 2);
            const char* a1 = cA + (size_t)(t + 1) * kstep;
            const char* a2 = last ? nA : cA + (size_t)(t + 2) * kstep; const char* b2 = last ? nB : cB + (size_t)(t + 2) * kstep;
            const char* a3 = a2 + kstep; const char* b3 = b2 + kstep;
            const unsigned hA2 = last ? sn.hA : sc.hA, hB2 = last ? sn.hB : sc.hB;
            const unsigned vA0 = last ? vAn0 : vAc0, vB0 = last ? vBn0 : vBc0, qA = hA2 >> 1, qB = hB2 >> 1;
            PG8_LDB(B0, 0, 0); PG8_LDB(B1, 0, 1); PG8_SCHED; PG8_LDA(At, 0, 0); PG8_STAGE(PG8_SA(1, 1), a1 + sc.hA, vAc0, sc.hA >> 1);
            PG8_WAIT_V(8); PG8_WAIT_L(0); PG8_BAR; PG8_MMA(0, 0, At, B0); PG8_MMA(0, 1, At, B1); PG8_BAR; PG8_SCHED;
            PG8_LDA(At, 0, 1); PG8_STAGE(PG8_SB(0, 0), b2, vB0, qB); PG8_STAGE(PG8_SB(0, 1), b2 + hB2, vB0, qB); PG8_STAGE(PG8_SA(0, 0), a2, vA0, qA);
            PG8_WAIT_V(8); PG8_WAIT_L(0); PG8_BAR; PG8_MMA(1, 0, At, B0); PG8_MMA(1, 1, At, B1); PG8_BAR; PG8_SCHED;
            PG8_LDB(B0, 1, 0); PG8_LDB(B1, 1, 1); PG8_SCHED; PG8_LDA(At, 1, 0); PG8_STAGE(PG8_SA(0, 1), a2 + hA2, vA0, qA);
            PG8_WAIT_V(8); PG8_WAIT_L(0); PG8_BAR; PG8_MMA(0, 0, At, B0); PG8_MMA(0, 1, At, B1); PG8_BAR; PG8_SCHED;
            PG8_LDA(At, 1, 1); PG8_STAGE(PG8_SB(1, 0), b3, vB0, qB); PG8_STAGE(PG8_SB(1, 1), b3 + hB2, vB0, qB); PG8_STAGE(PG8_SA(1, 0), a3, vA0, qA);
            PG8_WAIT_V(8); PG8_WAIT_L(0); PG8_BAR; PG8_MMA(1, 0, At, B0); PG8_MMA(1, 1, At, B1); PG8_BAR; PG8_SCHED;
        }
        if (wr == 0) PG8_BAR;
        { int wr_ = wr, wc_ = wc, t_ = tid;
          asm volatile("" : "+s"(wr_), "+s"(wc_), "+v"(t_)); const int fr_ = t_ & 15, fq_ = (t_ >> 4) & 3;
          E(acc, cur, wr_, wc_, fr_, fq_); }
        if (!has_next) break;
#pragma unroll
        for (int a = 0; a < 2; ++a)
#pragma unroll
            for (int b = 0; b < 2; ++b)
#pragma unroll
                for (int m = 0; m < 4; ++m)
#pragma unroll
                    for (int n = 0; n < 2; ++n) acc[a][b][m][n] = (f32x4){0.f, 0.f, 0.f, 0.f};
        cur = nxt; sc = sn; cA = nA; cB = nB; vAc0 = vAn0; vBc0 = vBn0; ++ui;
        if (wr == 1) PG8_BAR;
    }
    PG8_WAIT_V(0);
    PG8_BAR;
#undef PG8_SA
#undef PG8_SB
#undef PG8_STAGE
#undef PG8_LDA
#undef PG8_LDB
#undef PG8_MMA
#undef PG8_WAIT_V
#undef PG8_WAIT_L
#undef PG8_BAR
#undef PG8_SCHED
#undef PG8_RC
}
}

#define EPI_ARGS const f32x4 (&acc)[2][2][4][2], const pg8::Unit& u, int wr, int wc, int fr, int fq
__device__ __forceinline__ void st_bf16x8(bf16_t* p, f32x4 v0, f32x4 v1) {
    u32x4 w; w.x = cvt_pk_bf16(v0[0], v0[1]); w.y = cvt_pk_bf16(v0[2], v0[3]); w.z = cvt_pk_bf16(v1[0], v1[1]); w.w = cvt_pk_bf16(v1[2], v1[3]);
    *(u32x4*)p = w;
}
template <class T> __device__ __forceinline__ T* bo(T* base, unsigned byte_off) { return (T*)((char*)base + byte_off); }
template <class T> __device__ __forceinline__ const T* bo(const T* base, unsigned byte_off) { return (const T*)((const char*)base + byte_off); }
__device__ __forceinline__ void ld_bf16x8(const bf16_t* p, f32x4& v0, f32x4& v1) {
    const unsigned long long lo = __hip_atomic_load((const unsigned long long*)p, __ATOMIC_RELAXED, __HIP_MEMORY_SCOPE_AGENT), hi = __hip_atomic_load((const unsigned long long*)p + 1, __ATOMIC_RELAXED, __HIP_MEMORY_SCOPE_AGENT);
    const u32x4 w = {(unsigned)lo, (unsigned)(lo >> 32), (unsigned)hi, (unsigned)(hi >> 32)};
    v0 = (f32x4){bf_lo(w.x), bf_hi(w.x), bf_lo(w.y), bf_hi(w.y)}; v1 = (f32x4){bf_lo(w.z), bf_hi(w.z), bf_lo(w.w), bf_hi(w.w)};
}
__device__ __forceinline__ float rstd4(f32x4 a) { return rsqrtf(((a.x + a.y) + (a.z + a.w)) * (1.0f / DM) + RMS_EPS); }
__device__ __forceinline__ void rstd8(float (&rs)[2][4], const float* ss, int pm, unsigned lrow) {
    const float* ssb = ss + (size_t)pm * 256 * 4; unsigned lsb = lrow * 16u; asm volatile("" : "+v"(lsb));
    f32x4 t[2][4];
#pragma unroll
    for (int ai = 0; ai < 2; ++ai)
#pragma unroll
        for (int m = 0; m < 4; ++m) t[ai][m] = *(const f32x4*)bo(ssb, lsb + (unsigned)(ai * 128 + m * 16) * 16u);
#pragma unroll
    for (int ai = 0; ai < 2; ++ai)
#pragma unroll
        for (int m = 0; m < 4; ++m) rs[ai][m] = rstd4(t[ai][m]);
}
struct EpiIn {
    unsigned char* ws;
    __device__ __forceinline__ void operator()(EPI_ARGS) const {
        bf16_t* qkv = (bf16_t*)(ws + WS_QA); bf16_t* ub = (bf16_t*)(ws + WS_U); bf16_t* bc = (bf16_t*)(ws + WS_BC); float* kmp = (float*)(ws + WS_KM); const float* ss = (const float*)(ws + WS_SSA);
        const int pn = u.pn; unsigned lrow = (unsigned)(wr * 64 + fr), lcol = (unsigned)(wc * 32 + 8 * fq);
        asm volatile("" : "+v"(lrow), "+v"(lcol));
        const unsigned lb = (lrow * BW + lcol) * 2u;
        float rs[2][4]; rstd8(rs, ss, u.pm, lrow);
        if (pn < 12 || pn >= 16) {
            const int t = pn >> 1; const float sc = (t == 0 || t == 3) ? C2 : 1.0f;
            bf16_t* base = (pn < 12 ? qkv + (size_t)t * M * BW + (pn & 1) * 256 : bc + (pn - 16) * 256) + (size_t)u.pm * 256 * BW;
            if (t == 1) {
                float* kp = kmp + (size_t)(u.pm * 2 + wr) * BW + (pn & 1) * 256;
#pragma unroll
                for (int bj = 0; bj < 2; ++bj)
#pragma unroll
                    for (int n = 0; n < 2; ++n) { f32x4 s = {0.f, 0.f, 0.f, 0.f};
#pragma unroll
                        for (int ai = 0; ai < 2; ++ai)
#pragma unroll
                            for (int m = 0; m < 4; ++m) s += acc[ai][bj][m][n] * rs[ai][m];
#pragma unroll
                        for (int e = 0; e < 4; ++e) { s[e] += xshfl<1>(s[e]); s[e] += xshfl<2>(s[e]); s[e] += xshfl<4>(s[e]); s[e] += xshfl<8>(s[e]); }
                        if (fr == 0) *(f32x4*)bo(kp, (lcol + (unsigned)(bj * 128 + 4 * n)) * 4u) = s; }
            }
            if (t == 2 || t == 5) {
                bf16_t* vb = qkv + (size_t)t * M * BW + ((size_t)((u.pm >> 5) * 8 + (pn & 1) * 4) * SEQ + (size_t)(u.pm & 31) * 256) * HD;
                const unsigned fr_ = lrow & 15u, wr_ = lrow >> 6, hl = lcol >> 6, dd = lcol & 63u;
#pragma unroll
                for (int ai = 0; ai < 2; ++ai)
#pragma unroll
                    for (int m = 0; m < 4; ++m) { float f = rs[ai][m]; asm volatile("" : "+v"(f));
#pragma unroll
                        for (int bj = 0; bj < 2; ++bj) { const unsigned eo = (unsigned)(bj * 2 + hl) * (SEQ * HD) + ((wr_ + 2 * ai) * 4096 + ((dd >> 5) * 4 + m) * 512 + fr_ * 32 + (dd & 31u));
                            st_bf16x8(bo(vb, eo * 2u), acc[ai][bj][m][0] * f, acc[ai][bj][m][1] * f); } }
            } else if (t == 1 || t == 4) {
                bf16_t* kb = qkv + (size_t)t * M * BW + ((size_t)((u.pm >> 5) * 8 + (pn & 1) * 4) * SEQ + (size_t)(u.pm & 31) * 256) * HD;
                const unsigned fr_ = lrow & 15u, wr_ = lrow >> 6, hl = lcol >> 6, dch = (lcol & 63u) >> 3;
#pragma unroll
                for (int ai = 0; ai < 2; ++ai)
#pragma unroll
                    for (int m = 0; m < 4; ++m) { float f = rs[ai][m]; asm volatile("" : "+v"(f));
#pragma unroll
                        for (int bj = 0; bj < 2; ++bj) { const unsigned eo = (unsigned)(bj * 2 + hl) * (SEQ * HD) + (((wr_ * 2 + ai * 4 + (m >> 1)) * 8 + dch) * 256 + (fr_ + 16u * (m & 1)) * 8);
                            st_bf16x8(bo(kb, eo * 2u), acc[ai][bj][m][0] * f, acc[ai][bj][m][1] * f); } }
            } else {
#pragma unroll
            for (int ai = 0; ai < 2; ++ai)
#pragma unroll
                for (int m = 0; m < 4; ++m) { const float f = rs[ai][m] * sc; const unsigned o = lb + (unsigned)(ai * 128 + m * 16) * BW * 2u;
#pragma unroll
                    for (int bj = 0; bj < 2; ++bj) st_bf16x8(bo(base, o + bj * 256u), acc[ai][bj][m][0] * f, acc[ai][bj][m][1] * f); }
            }
        } else {
            bf16_t* base = ub + (size_t)u.pm * 256 * BW + (pn - 12) * 128;
#pragma unroll
            for (int ai = 0; ai < 2; ++ai)
#pragma unroll
                for (int m = 0; m < 4; ++m) { const float f = rs[ai][m] * rs[ai][m];
                    st_bf16x8(bo(base, lb + (unsigned)(ai * 128 + m * 16) * BW * 2u), acc[ai][0][m][0] * acc[ai][1][m][0] * f, acc[ai][0][m][1] * acc[ai][1][m][1] * f); }
        }
    }
};
struct EpiC1 {
    unsigned char* ws; const float* bgate;
    __device__ __forceinline__ bf16_t* gtile(int s, int pm, int pn) const {
        const size_t off = WS_GA + (size_t)s * (48 * MiB) + ((s == 2 && pm >= 32) ? 32 * MiB : 0) + ((size_t)pm * 256 * DM + pn * 256) * 2;
        return (bf16_t*)(ws + off);
    }
    __device__ __forceinline__ void operator()(EPI_ARGS) const {
        bf16_t* mg = (bf16_t*)(ws + WS_MG); const float* ss = (const float*)(ws + WS_SSA);
        const int sg = u.seg; unsigned lrow = (unsigned)(wr * 64 + fr), lcol = (unsigned)(wc * 32 + 8 * fq);
        asm volatile("" : "+v"(lrow), "+v"(lcol));
        const unsigned lb = (lrow * DM + lcol) * 2u;
        bf16_t* gp = gtile(sg < 3 ? sg : sg - 3, u.pm, u.pn);
        if (sg < 3) {
            const float* bg = bgate + sg * DM + u.pn * 256;
            f32x4 bv[2][2];
#pragma unroll
            for (int bj = 0; bj < 2; ++bj) { bv[bj][0] = *(const f32x4*)bo(bg, (lcol + bj * 128u) * 4u) * (-LOG2E); bv[bj][1] = *(const f32x4*)bo(bg, (lcol + bj * 128u + 4u) * 4u) * (-LOG2E); }
            float rs[2][4]; rstd8(rs, ss, u.pm, lrow);
#pragma unroll
            for (int ai = 0; ai < 2; ++ai)
#pragma unroll
                for (int m = 0; m < 4; ++m) { const float rn = rs[ai][m] * (-LOG2E); const unsigned o = lb + (unsigned)(ai * 128 + m * 16) * DM * 2u;
#pragma unroll
                    for (int bj = 0; bj < 2; ++bj) { f32x4 v[2];
#pragma unroll
                        for (int n = 0; n < 2; ++n) { const f32x4 x = acc[ai][bj][m][n] * rn + bv[bj][n];
#pragma unroll
                            for (int e = 0; e < 4; ++e) v[n][e] = __builtin_amdgcn_rcpf(1.0f + __builtin_amdgcn_exp2f(x[e])); }
                        st_bf16x8(bo(gp, o + bj * 256u), v[0], v[1]); } }
        } else {
            bf16_t* mp = mg + (size_t)u.pm * 256 * DM + u.pn * 256;
#pragma unroll
            for (int ai = 0; ai < 2; ++ai) {
                constexpr int m0 = 0;
                u32x4 gw_[4][2], pw_[4][2];
#pragma unroll
                for (int mm = 0; mm < 4; ++mm)
#pragma unroll
                    for (int bj = 0; bj < 2; ++bj) { const unsigned o = lb + (unsigned)(ai * 128 + (m0 + mm) * 16) * DM * 2u + bj * 256u;
                        gw_[mm][bj] = *(const u32x4*)bo((const bf16_t*)gp, o); if (sg > 3) pw_[mm][bj] = *(const u32x4*)bo((const bf16_t*)mp, o); }
#pragma unroll
                for (int mm = 0; mm < 4; ++mm)
#pragma unroll
                    for (int bj = 0; bj < 2; ++bj) { const int m = m0 + mm; const unsigned o = lb + (unsigned)(ai * 128 + m * 16) * DM * 2u + bj * 256u; const u32x4 g = gw_[mm][bj];
                        f32x4 v0 = acc[ai][bj][m][0] * (f32x4){bf_lo(g.x), bf_hi(g.x), bf_lo(g.y), bf_hi(g.y)}, v1 = acc[ai][bj][m][1] * (f32x4){bf_lo(g.z), bf_hi(g.z), bf_lo(g.w), bf_hi(g.w)};
                        if (sg > 3) { const u32x4 p = pw_[mm][bj]; v0 += (f32x4){bf_lo(p.x), bf_hi(p.x), bf_lo(p.y), bf_hi(p.y)}; v1 += (f32x4){bf_lo(p.z), bf_hi(p.z), bf_lo(p.w), bf_hi(p.w)}; }
                        st_bf16x8(bo(mp, o), v0, v1); }
                asm volatile("" ::: "memory");
            }
        }
    }
};
struct EpiRes {
    unsigned char* ws; int toA; LAS float* red;
    __device__ __forceinline__ void operator()(EPI_ARGS) const {
        bf16_t* xb = (bf16_t*)(ws + WS_XB); float* sso = (float*)(ws + (toA ? WS_SSA : WS_SSB));
        unsigned lrow = (unsigned)(wr * 64 + fr), lcol = (unsigned)(wc * 32 + 8 * fq);
        asm volatile("" : "+v"(lrow), "+v"(lcol));
        const unsigned le = (lrow * DM + lcol) * 2u, lr4 = lrow * 4u + (unsigned)wc;
        bf16_t* xp = xb + (size_t)u.pm * 256 * DM + u.pn * 256;
#pragma unroll
        for (int ai = 0; ai < 2; ++ai) {
            u32x4 bs[4][2];
#pragma unroll
            for (int m = 0; m < 4; ++m)
#pragma unroll
                for (int bj = 0; bj < 2; ++bj) bs[m][bj] = *(const u32x4*)bo((const bf16_t*)xp, le + (unsigned)(ai * 128 + m * 16) * DM * 2u + bj * 256u);
#pragma unroll
            for (int m = 0; m < 4; ++m) { float sq = 0.f;
#pragma unroll
                for (int bj = 0; bj < 2; ++bj) { const u32x4 w = bs[m][bj];
                    const f32x4 x0 = (f32x4){bf_lo(w.x), bf_hi(w.x), bf_lo(w.y), bf_hi(w.y)} + acc[ai][bj][m][0], x1 = (f32x4){bf_lo(w.z), bf_hi(w.z), bf_lo(w.w), bf_hi(w.w)} + acc[ai][bj][m][1];
                    st_bf16x8(bo(xp, le + (unsigned)(ai * 128 + m * 16) * DM * 2u + bj * 256u), x0, x1);
                    sq += (x0[0] * x0[0] + x0[1] * x0[1]) + (x0[2] * x0[2] + x0[3] * x0[3]) + (x1[0] * x1[0] + x1[1] * x1[1]) + (x1[2] * x1[2] + x1[3] * x1[3]); }
                sq += xshfl<16>(sq); sq = sum32(sq);
                if (fq == 0) red[lr4 + (unsigned)(ai * 128 + m * 16) * 4u] = sq; }
            asm volatile("" ::: "memory");
        }
        asm volatile("s_waitcnt lgkmcnt(0)\n\ts_barrier" ::: "memory");
        { const int t = ((wr * 4 + wc) * 4 + fq) * 16 + fr; if (t < 256) { const f32x4 r = *(const LAS f32x4*)(red + t * 4); sso[((size_t)u.pm * 256 + t) * 4 + u.pn] = (r.x + r.y) + (r.z + r.w); } }
        asm volatile("s_waitcnt lgkmcnt(0)\n\ts_barrier" ::: "memory");
    }
};
struct EpiFfn {
    unsigned char* ws;
    __device__ __forceinline__ void operator()(EPI_ARGS) const {
        bf16_t* act = (bf16_t*)(ws + WS_ACT); const float* ss = (const float*)(ws + WS_SSB);
        unsigned lrow = (unsigned)(wr * 64 + fr), lcol = (unsigned)(wc * 32 + 8 * fq);
        asm volatile("" : "+v"(lrow), "+v"(lcol));
        const unsigned lb = (lrow * DFF + lcol) * 2u;
        bf16_t* ap = act + (size_t)u.pm * 256 * DFF + u.pn * 128;
        float rs[2][4]; rstd8(rs, ss, u.pm, lrow);
#pragma unroll
        for (int ai = 0; ai < 2; ++ai)
#pragma unroll
            for (int m = 0; m < 4; ++m) { const float r1 = rs[ai][m], rn = r1 * (-LOG2E); f32x4 v[2];
#pragma unroll
                for (int n = 0; n < 2; ++n) { const f32x4 g = acc[ai][0][m][n], up = acc[ai][1][m][n] * (r1 * r1);
#pragma unroll
                    for (int e = 0; e < 4; ++e) v[n][e] = g[e] * up[e] * __builtin_amdgcn_rcpf(1.0f + __builtin_amdgcn_exp2f(g[e] * rn)); }
                st_bf16x8(bo(ap, lb + (unsigned)(ai * 128 + m * 16) * DFF * 2u), v[0], v[1]); }
    }
};

struct GCfg {
    int mode;
    int N, nseg, lda, ldb, nt, toA;
    const bf16_t* A; const bf16_t* B;
    unsigned char* ws; const float* bgate; LAS float* red;
};
struct ProbAny {
    const GCfg* c;
    __device__ __forceinline__ void seg(const pg8::Unit& u, pg8::Seg& s) const {
        if (c->mode == 1 && u.seg >= 3) {
            const int br = u.seg - 3; const bf16_t* O = (const bf16_t*)(c->ws + WS_QA + (size_t)br * (48 * MiB)); const bf16_t* Wp = (const bf16_t*)(c->ws + WS_WP);
            s.A = (const char*)(O + (size_t)u.pm * 256 * BW); s.B = (const char*)(Wp + ((size_t)br * DM + (size_t)u.pn * 256) * BW);
            s.hA = 128u * BW * 2u; s.hB = 128u * BW * 2u; s.lda = BW; s.ldb = BW; s.nt = BW / 64;
        } else {
            const int so = (c->mode == 1) ? u.seg * DM : 0;
            s.A = (const char*)(c->A + (size_t)u.pm * 256 * c->lda); s.B = (const char*)(c->B + ((size_t)so + (size_t)u.pn * 256) * c->ldb);
            s.hA = 128u * (unsigned)c->lda * 2u; s.hB = 128u * (unsigned)c->ldb * 2u; s.lda = c->lda; s.ldb = c->ldb; s.nt = c->nt;
        }
    }
};
struct EpiAny {
    const GCfg* c;
    __device__ __forceinline__ void operator()(EPI_ARGS) const {
        const int m_ = c->mode;
        if (m_ == 0) EpiIn{c->ws}(acc, u, wr, wc, fr, fq);
        else if (m_ == 1) EpiC1{c->ws, c->bgate}(acc, u, wr, wc, fr, fq);
        else if (m_ == 2) EpiRes{c->ws, c->toA, c->red}(acc, u, wr, wc, fr, fq);
        else EpiFfn{c->ws}(acc, u, wr, wc, fr, fq);
    }
};

namespace att {
__device__ __forceinline__ constexpr int crow(int r, int hi) { return (r & 3) + 8 * (r >> 2) + 4 * hi; }
__device__ __forceinline__ float swap_lo(float x, float& hiv) { auto rr = __builtin_amdgcn_permlane32_swap(__float_as_uint(x), __float_as_uint(x), false, false); hiv = __uint_as_float(rr[1]); return __uint_as_float(rr[0]); }
__device__ __forceinline__ s16x4 vtr(const LAS unsigned char* p) { return __builtin_bit_cast(s16x4, __builtin_amdgcn_ds_read_tr16_b64_v4i16((LAS s16x4*)p)); }
__device__ __forceinline__ void load_k(bf16x8 (&kf)[8], const bf16_t* Kh, int j0, int r32, int hi) {
    const bf16_t* p = Kh + (size_t)(j0 >> 5) * 2048 + hi * 256 + r32 * 8;
#pragma unroll
    for (int d0 = 0; d0 < 4; ++d0) { kf[2 * d0] = *(const bf16x8*)(p + d0 * 512); kf[2 * d0 + 1] = *(const bf16x8*)(p + 2048 + d0 * 512); }
}
__device__ __forceinline__ void dma_v(LAS unsigned char* vbuf, const bf16_t* Vh, int j0, int lane) {
    const bf16_t* p = Vh + (size_t)(j0 >> 6) * 4096 + lane * 8;
#pragma unroll
    for (int i = 0; i < 8; ++i) __builtin_amdgcn_global_load_lds((const unsigned*)(p + i * 512), (LAS unsigned*)(vbuf + i * 1024), 16, 0, 0);
}
__device__ __forceinline__ void load_v(u32x4 (&vv)[8], const bf16_t* Vh, int j0, int lane) {
    const bf16_t* p = Vh + (size_t)(j0 + (lane >> 3)) * BW + (lane & 7) * 8;
#pragma unroll
    for (int i = 0; i < 8; ++i) vv[i] = *(const u32x4*)(p + (size_t)(8 * i) * BW);
}
__device__ __forceinline__ void stage_v(LAS unsigned char* vst, const u32x4 (&vv)[8], int lane) {
    const int c = lane & 7;
#pragma unroll
    for (int i = 0; i < 8; ++i) { const int key = 8 * i + (lane >> 3);
        *(LAS u32x4*)(vst + ((c >> 2) * 4 + (key >> 4)) * 1024 + (key & 15) * 64 + (c & 3) * 16) = vv[i]; }
}
__device__ __forceinline__ void qk(f32x16& p0, f32x16& p1, const bf16x8 (&kf)[8], const bf16x8 (&qr)[4]) {
#pragma unroll
    for (int d0 = 0; d0 < 4; ++d0) { p0 = __builtin_amdgcn_mfma_f32_32x32x16_bf16(kf[2 * d0], qr[d0], p0, 0, 0, 0); p1 = __builtin_amdgcn_mfma_f32_32x32x16_bf16(kf[2 * d0 + 1], qr[d0], p1, 0, 0, 0); }
}
__device__ __forceinline__ void pv(f32x16& o0, f32x16& o1, const f32x16& p0, const f32x16& p1, const LAS unsigned char* vst, int lane) {
    const int hi = lane >> 5;
    const LAS unsigned char* vp = vst + ((lane >> 4) & 1) * 32 + (lane & 3) * 8 + (4 * hi + ((lane & 15) >> 2)) * 64;
    u32x4 pw[4];
    pw[0] = (u32x4){cvt_pk_bf16(p0[0], p0[1]), cvt_pk_bf16(p0[2], p0[3]), cvt_pk_bf16(p0[4], p0[5]), cvt_pk_bf16(p0[6], p0[7])};
    pw[1] = (u32x4){cvt_pk_bf16(p0[8], p0[9]), cvt_pk_bf16(p0[10], p0[11]), cvt_pk_bf16(p0[12], p0[13]), cvt_pk_bf16(p0[14], p0[15])};
    pw[2] = (u32x4){cvt_pk_bf16(p1[0], p1[1]), cvt_pk_bf16(p1[2], p1[3]), cvt_pk_bf16(p1[4], p1[5]), cvt_pk_bf16(p1[6], p1[7])};
    pw[3] = (u32x4){cvt_pk_bf16(p1[8], p1[9]), cvt_pk_bf16(p1[10], p1[11]), cvt_pk_bf16(p1[12], p1[13]), cvt_pk_bf16(p1[14], p1[15])};
#pragma unroll
    for (int ks = 0; ks < 4; ++ks) {
        const s16x4 a0 = vtr(vp + ks * 1024), a1 = vtr(vp + ks * 1024 + 512), b0 = vtr(vp + 4096 + ks * 1024), b1 = vtr(vp + 4096 + ks * 1024 + 512);
        const bf16x8 v0 = {a0[0], a0[1], a0[2], a0[3], a1[0], a1[1], a1[2], a1[3]}, v1 = {b0[0], b0[1], b0[2], b0[3], b1[0], b1[1], b1[2], b1[3]};
        const bf16x8 pa = __builtin_bit_cast(bf16x8, pw[ks]);
        o0 = __builtin_amdgcn_mfma_f32_32x32x16_bf16(pa, v0, o0, 0, 0, 0);
        o1 = __builtin_amdgcn_mfma_f32_32x32x16_bf16(pa, v1, o1, 0, 0, 0);
    }
}
__device__ __forceinline__ void store_o(bf16_t* Ow, const f32x16& o0, const f32x16& o1, const float (&rsc)[16], LAS unsigned char* stg, int lane) {
    const int r32 = lane & 31, hi = lane >> 5;
    LAS bf16_t* s = (LAS bf16_t*)stg;
#pragma unroll
    for (int r = 0; r < 16; ++r) { const int orow = crow(r, hi);
        s[orow * 64 + r32] = (bf16_t)(cvt_pk_bf16(o0[r] * rsc[r], 0.f) & 0xffffu); s[orow * 64 + 32 + r32] = (bf16_t)(cvt_pk_bf16(o1[r] * rsc[r], 0.f) & 0xffffu); }
    LDS_WAIT();
#pragma unroll
    for (int i = 0; i < 4; ++i) { const int row = i * 8 + (lane >> 3), ch = lane & 7; const u32x4 v = *(const LAS u32x4*)(stg + row * 128 + ch * 16); *(u32x4*)(Ow + (size_t)row * BW + ch * 8) = v; }
    LDS_WAIT();
}

__device__ __forceinline__ void sb_item(bf16_t* Q, const bf16_t* K, const bf16_t* V, int b, int h, int q0, LAS unsigned char* vst, int lane) {
    asm volatile("" : "+v"(lane));
    const int r32 = lane & 31, hi = lane >> 5;
    const size_t rowbase = (size_t)b * SEQ;
    bf16_t* Qw = Q + (rowbase + q0) * BW + h * HD;
    bf16x8 qr[4];
#pragma unroll
    for (int d0 = 0; d0 < 4; ++d0) qr[d0] = *(const bf16x8*)(Qw + (size_t)r32 * BW + d0 * 16 + hi * 8);
    const bf16_t* Kh = K + (size_t)(b * NH + h) * SEQ * HD; const bf16_t* Vh = V + (size_t)(b * NH + h) * SEQ * HD;
    f32x16 o0 = {}, o1 = {}; float A2 = 0.f;
    const int tq = q0 + r32;
    bf16x8 kf[8]; load_k(kf, Kh, ((q0 + 30) >> 6) * 64, r32, hi); dma_v(vst + (((q0 + 30) >> 6) & 1) * 8192, Vh, ((q0 + 30) >> 6) * 64, lane);
    for (int kt = (q0 + 30) >> 6; kt >= 0; --kt) {
        const int j0 = kt * 64;
        f32x16 p0 = {}, p1 = {};
        qk(p0, p1, kf, qr);
        asm volatile("" : "+v"(p0), "+v"(p1) :: "memory");
        LAS unsigned char* vcur = vst + (kt & 1) * 8192;
        if (kt > 0) { dma_v(vst + ((kt - 1) & 1) * 8192, Vh, j0 - 64, lane); load_k(kf, Kh, j0 - 64, r32, hi); }
        const bool diag = (j0 + 63 >= q0);
        f32x16 l0, l1;
#pragma unroll
        for (int r = 0; r < 16; ++r) {
            { const float z = p0[r]; const float t = __builtin_amdgcn_exp2f(-__builtin_fabsf(z)); float l = -(__builtin_fmaxf(z, 0.f) + __builtin_amdgcn_logf(1.0f + t)); if (diag && (j0 + crow(r, hi) >= tq)) l = 0.f; l0[r] = l; }
            { const float z = p1[r]; const float t = __builtin_amdgcn_exp2f(-__builtin_fabsf(z)); float l = -(__builtin_fmaxf(z, 0.f) + __builtin_amdgcn_logf(1.0f + t)); if (diag && (j0 + 32 + crow(r, hi) >= tq)) l = 0.f; l1[r] = l; }
        }
        float carry = A2;
#pragma unroll
        for (int half = 1; half >= 0; --half) {
            f32x16& l = half ? l1 : l0; f32x16& p = half ? p1 : p0;
            float T[4];
#pragma unroll
            for (int g = 0; g < 4; ++g) { l[4 * g + 2] += l[4 * g + 3]; l[4 * g + 1] += l[4 * g + 2]; l[4 * g] += l[4 * g + 1]; T[g] = l[4 * g]; }
            float Tl[4], Th[4];
#pragma unroll
            for (int g = 0; g < 4; ++g) Tl[g] = swap_lo(T[g], Th[g]);
            float E = carry;
#pragma unroll
            for (int g = 3; g >= 0; --g) { const float eh = E; E += Th[g]; const float el = E; E += Tl[g]; const float off = hi ? eh : el;
                l[4 * g] += off; l[4 * g + 1] += off; l[4 * g + 2] += off; l[4 * g + 3] += off; }
            carry = E;
#pragma unroll
            for (int r = 0; r < 16; ++r) { float w = __builtin_amdgcn_exp2f(p[r] + l[r]); if (diag && (j0 + 32 * half + crow(r, hi) >= tq)) w = 0.f; p[r] = w; }
        }
        A2 = carry;
        if (kt > 0) asm volatile("s_waitcnt vmcnt(16)" ::: "memory"); else asm volatile("s_waitcnt vmcnt(0)" ::: "memory");
        pv(o0, o1, p0, p1, vcur, lane);
        LDS_WAIT();
        if (__all(A2 < -150.2f)) break;
    }
    float one[16];
#pragma unroll
    for (int r = 0; r < 16; ++r) one[r] = 1.0f;
    store_o(Qw, o0, o1, one, vst, lane);
}

constexpr float MOBA_THR = 8.0f;
__device__ __forceinline__ unsigned moba_gate(const bf16_t* Qw, const bf16_t* Kown, int blk, int tq0, float sl2, const LAS float* km, const LAS float* kbn, int lane) {
    asm volatile("" : "+v"(lane));
    const int r32 = lane & 31, hi = lane >> 5;
    unsigned sel = 0u;
    if (blk > 0) {
        float qf[64];
        { const u32x4* qp = (const u32x4*)(Qw + (size_t)r32 * BW);
#pragma unroll
          for (int c = 0; c < 8; ++c) { const u32x4 x = qp[c]; qf[8 * c] = bf_lo(x.x); qf[8 * c + 1] = bf_hi(x.x); qf[8 * c + 2] = bf_lo(x.y); qf[8 * c + 3] = bf_hi(x.y); qf[8 * c + 4] = bf_lo(x.z); qf[8 * c + 5] = bf_hi(x.z); qf[8 * c + 6] = bf_lo(x.w); qf[8 * c + 7] = bf_hi(x.w); } }
        float v1 = -INFINITY, v2 = -INFINITY, v3 = -INFINITY; int i1 = -1, i2 = -1, i3 = -1;
#define TOP_INS(v, n) do { const bool b1 = (v) > v1 || ((v) == v1 && (n) < i1), b2 = (v) > v2 || ((v) == v2 && (n) < i2), b3 = (v) > v3 || ((v) == v3 && (n) < i3); \
            if (b3) { if (b2) { v3 = v2; i3 = i2; if (b1) { v2 = v1; i2 = i1; v1 = (v); i1 = (n); } else { v2 = (v); i2 = (n); } } else { v3 = (v); i3 = (n); } } } while (0)
#pragma unroll 1
        for (int i = 0; i < 16; ++i) { const int n = 16 * hi + i;
            const LAS f32x4* kr = (const LAS f32x4*)(km + n * 64); float d0 = 0.f, d1 = 0.f, d2 = 0.f, d3 = 0.f;
#pragma unroll
            for (int c = 0; c < 16; ++c) { const f32x4 kk = kr[c]; d0 += qf[4 * c] * kk[0]; d1 += qf[4 * c + 1] * kk[1]; d2 += qf[4 * c + 2] * kk[2]; d3 += qf[4 * c + 3] * kk[3]; }
            const float d = (d0 + d1) + (d2 + d3);
            if (n < blk) TOP_INS(d, n); }
        { float x0, x1; x0 = swap_lo(v1, x1); const float pv1 = hi ? x0 : x1; x0 = swap_lo(v2, x1); const float pv2 = hi ? x0 : x1; x0 = swap_lo(v3, x1); const float pv3 = hi ? x0 : x1;
          x0 = swap_lo(__int_as_float(i1), x1); const int pi1 = __float_as_int(hi ? x0 : x1); x0 = swap_lo(__int_as_float(i2), x1); const int pi2 = __float_as_int(hi ? x0 : x1); x0 = swap_lo(__int_as_float(i3), x1); const int pi3 = __float_as_int(hi ? x0 : x1);
          TOP_INS(pv1, pi1); TOP_INS(pv2, pi2); TOP_INS(pv3, pi3); }
#undef TOP_INS
        float qn2 = 0.f, zs = 0.f;
        { const int tk = tq0 + r32; const bf16_t* kp = Kown + (size_t)(tk >> 5) * 2048 + (tk & 31) * 8;
#pragma unroll
          for (int c = 0; c < 8; ++c) { const u32x4 x = *(const u32x4*)(kp + c * 256);
              zs += qf[8 * c] * bf_lo(x.x) + qf[8 * c + 1] * bf_hi(x.x) + qf[8 * c + 2] * bf_lo(x.y) + qf[8 * c + 3] * bf_hi(x.y) + qf[8 * c + 4] * bf_lo(x.z) + qf[8 * c + 5] * bf_hi(x.z) + qf[8 * c + 6] * bf_lo(x.w) + qf[8 * c + 7] * bf_hi(x.w);
              qn2 += (qf[8 * c] * qf[8 * c] + qf[8 * c + 1] * qf[8 * c + 1]) + (qf[8 * c + 2] * qf[8 * c + 2] + qf[8 * c + 3] * qf[8 * c + 3]) + (qf[8 * c + 4] * qf[8 * c + 4] + qf[8 * c + 5] * qf[8 * c + 5]) + (qf[8 * c + 6] * qf[8 * c + 6] + qf[8 * c + 7] * qf[8 * c + 7]); } }
        const float qn = sqrtf(qn2) * 1.001f, thr = zs - 151.0f; const int tq = tq0 + r32;
#define KEEP(i_) ((i_) >= 0 && !(qn * kbn[(i_)] - sl2 * (float)(tq - (256 * (i_) + 255)) < thr))
        if (KEEP(i1)) sel |= 1u << i1; if (KEEP(i2)) sel |= 1u << i2; if (KEEP(i3)) sel |= 1u << i3;
#undef KEEP
    }
    return sel;
}
__device__ __forceinline__ void moba_tile(f32x16& o0, f32x16& o1, float& mrow, float& lsum, const bf16x8 (&qr)[4], bf16x8 (&kf)[8], const bf16_t* Kh, const bf16_t* Vh, int j0, int jn, float lb, float sl2, bool diag, int tq,
                                          LAS unsigned char* vst, LAS float* wsf, int lane) {
    const int r32 = lane & 31, hi = lane >> 5;
    f32x16 p0, p1;
#pragma unroll
    for (int r = 0; r < 16; ++r) { p0[r] = lb; p1[r] = lb + 32.0f * sl2; }
    qk(p0, p1, kf, qr);
    asm volatile("" : "+v"(p0), "+v"(p1) :: "memory");
    LAS unsigned char* vcur = vst + ((j0 >> 6) & 1) * 8192;
    if (jn >= 0) { dma_v(vst + ((jn >> 6) & 1) * 8192, Vh, jn, lane); load_k(kf, Kh, jn, r32, hi); }
#pragma unroll
    for (int r = 0; r < 16; ++r) { p0[r] = __builtin_fmaf(sl2, (float)crow(r, 0), p0[r]); p1[r] = __builtin_fmaf(sl2, (float)crow(r, 0), p1[r]); }
    if (diag) {
#pragma unroll
        for (int r = 0; r < 16; ++r) { if (j0 + crow(r, hi) > tq) p0[r] = -INFINITY; if (j0 + 32 + crow(r, hi) > tq) p1[r] = -INFINITY; }
    }
    float rm = __builtin_fmaxf(p0[0], p1[0]);
#pragma unroll
    for (int r = 1; r < 16; ++r) rm = __builtin_fmaxf(rm, __builtin_fmaxf(p0[r], p1[r]));
    { float x1; const float x0 = swap_lo(rm, x1); rm = __builtin_fmaxf(x0, x1); }
    if (__any(rm > mrow + MOBA_THR)) {
        const float mn = __builtin_fmaxf(mrow, rm); const float f = __builtin_amdgcn_exp2f(mrow - mn); mrow = mn; lsum *= f;
        if (hi == 0) wsf[r32] = f;
        LDS_WAIT();
#pragma unroll
        for (int r = 0; r < 16; ++r) { const float fr_ = wsf[crow(r, hi)]; o0[r] *= fr_; o1[r] *= fr_; }
        LDS_WAIT();
    }
    float ps = 0.f;
#pragma unroll
    for (int r = 0; r < 16; ++r) { p0[r] = __builtin_amdgcn_exp2f(p0[r] - mrow); p1[r] = __builtin_amdgcn_exp2f(p1[r] - mrow); ps += p0[r] + p1[r]; }
    lsum += ps;
    if (jn >= 0) asm volatile("s_waitcnt vmcnt(16)" ::: "memory"); else asm volatile("s_waitcnt vmcnt(0)" ::: "memory");
    pv(o0, o1, p0, p1, vcur, lane);
    LDS_WAIT();
}
__device__ __forceinline__ void moba_item(const bf16_t* Q, const bf16_t* K, const bf16_t* V, int b, int h, int blk, int n, int tix, const LAS unsigned char* lists, const LAS unsigned* cnt,
                                          const LAS unsigned* selm, unsigned char* recO, float* recML, LAS unsigned char* vst, LAS float* wsf, LAS unsigned* trow, int lane) {
    asm volatile("" : "+v"(lane));
    const int r32 = lane & 31, hi = lane >> 5; const size_t rowbase = (size_t)b * SEQ; const bool own = (n == blk);
    int q; bool valid; unsigned slot;
    if (own) { q = 32 * tix + r32; valid = true; slot = (unsigned)q * 4u + 3u; }
    else { const int cn = (int)cnt[n]; const int p = 32 * tix + r32; valid = p < cn; q = (int)lists[n * 256 + (valid ? p : cn - 1)];
           slot = (unsigned)q * 4u + (unsigned)__builtin_popcount(selm[q] & ((1u << n) - 1u)); }
    if (hi == 0) trow[r32] = slot | (valid ? 0x80000000u : 0u);
    const int tq = blk * 256 + q;
    const bf16_t* Qrow = Q + (rowbase + tq) * BW + h * HD + hi * 8;
    bf16x8 qr[4];
#pragma unroll
    for (int d0 = 0; d0 < 4; ++d0) qr[d0] = *(const bf16x8*)(Qrow + d0 * 16);
    const bf16_t* Kh = K + (size_t)(b * NH + h) * SEQ * HD; const bf16_t* Vh = V + (size_t)(b * NH + h) * SEQ * HD;
    const float sl2 = __builtin_amdgcn_exp2f(-(float)(h + 1)) * LOG2E;
    f32x16 o0 = {}, o1 = {}; float mrow = -INFINITY, lsum = 0.f;
    const int ntile = own ? (tix >> 1) + 1 : 4;
    bf16x8 kf[8]; load_k(kf, Kh, n * 256, r32, hi); dma_v(vst + ((n * 4) & 1) * 8192, Vh, n * 256, lane);
#pragma unroll 1
    for (int i = 0; i < ntile; ++i) { const int j0 = n * 256 + i * 64;
        moba_tile(o0, o1, mrow, lsum, qr, kf, Kh, Vh, j0, i < ntile - 1 ? j0 + 64 : -1, sl2 * (float)(j0 + 4 * hi - tq), sl2, own && i == ntile - 1, tq, vst, wsf, lane); }
    { float x1; const float x0 = swap_lo(lsum, x1); lsum = x0 + x1; }
    if (hi == 0) { wsf[32 + r32] = lsum; if (valid) *(f32x2*)(recML + 2 * slot) = (f32x2){mrow, lsum}; }
    LDS_WAIT();
    LAS bf16_t* s = (LAS bf16_t*)vst;
#pragma unroll
    for (int r = 0; r < 16; ++r) { const int orow = crow(r, hi); const float rl = __builtin_amdgcn_rcpf(wsf[32 + orow]);
        s[orow * 64 + r32] = (bf16_t)(cvt_pk_bf16(o0[r] * rl, 0.f) & 0xffffu); s[orow * 64 + 32 + r32] = (bf16_t)(cvt_pk_bf16(o1[r] * rl, 0.f) & 0xffffu); }
    LDS_WAIT();
#pragma unroll
    for (int i = 0; i < 4; ++i) { const int row = i * 8 + (lane >> 3), ch = lane & 7; const unsigned tr = trow[row]; const u32x4 v = *(const LAS u32x4*)(vst + row * 128 + ch * 16);
        if (tr & 0x80000000u) *(u32x4*)(recO + (size_t)(tr & 0x7fffffffu) * 128 + ch * 16) = v; }
    LDS_WAIT();
}
__device__ __forceinline__ void moba_merge(bf16_t* Q, int b, int h, int blk, int w, const LAS unsigned* selm, const unsigned char* recO, const float* recML, LAS float* wsf, int lane) {
    asm volatile("" : "+v"(lane));
    const int r32 = lane & 31, hi = lane >> 5; const size_t rowbase = (size_t)b * SEQ; const int q0 = blk * 256 + w * 32;
    const int ql = w * 32 + r32; const int c = __builtin_popcount(selm[ql]);
    float mi[4], li[4]; float mx = -INFINITY;
#pragma unroll
    for (int k = 0; k < 4; ++k) { mi[k] = -INFINITY; li[k] = 0.f; if (k == 3 || k < c) { const f32x2 ml = __builtin_nontemporal_load((const f32x2*)(recML + 2 * ((unsigned)ql * 4u + k))); mi[k] = ml.x; li[k] = ml.y; } mx = __builtin_fmaxf(mx, mi[k]); }
    float wg[4], L = 0.f;
#pragma unroll
    for (int k = 0; k < 4; ++k) { wg[k] = (k == 3 || k < c) ? __builtin_amdgcn_exp2f(mi[k] - mx) * li[k] : 0.f; L += wg[k]; }
    const float rL = 1.0f / L;
    if (hi == 0) { wsf[r32] = wg[0] * rL; wsf[32 + r32] = wg[1] * rL; wsf[64 + r32] = wg[2] * rL; wsf[96 + r32] = wg[3] * rL; }
    LDS_WAIT();
    bf16_t* Qw = Q + (rowbase + q0) * BW + h * HD;
#pragma unroll
    for (int i = 0; i < 4; ++i) { const int row = i * 8 + (lane >> 3), ch = lane & 7; f32x4 v0 = {0.f, 0.f, 0.f, 0.f}, v1 = {0.f, 0.f, 0.f, 0.f};
        const unsigned rslot = (unsigned)(w * 32 + row) * 4u;
#pragma unroll
        for (int k = 0; k < 4; ++k) { const float ak = wsf[32 * k + row];
            if (ak != 0.f) { const u32x4 pw = __builtin_nontemporal_load((const u32x4*)(recO + (size_t)(rslot + k) * 128 + ch * 16));
                v0 += ak * (f32x4){bf_lo(pw.x), bf_hi(pw.x), bf_lo(pw.y), bf_hi(pw.y)}; v1 += ak * (f32x4){bf_lo(pw.z), bf_hi(pw.z), bf_lo(pw.w), bf_hi(pw.w)}; } }
        st_bf16x8(Qw + (size_t)row * BW + ch * 8, v0, v1); }
    LDS_WAIT();
}
}

#define XB_TMO      128
#define XB_XCNT(j)  (256  + 64 * (j))
#define XB_XSUB(j)  (1280 + 64 * (j))
#define XB_XGEN(j)  (2304 + 64 * (j))
#define XB_TOP      3328
#define XB_TOPGEN   3392
#define XCD_BAR_WORDS 3456
#define XB_SPIN_CAP (1u << 18)
__device__ __forceinline__ unsigned xb_ld(unsigned* p)              { return __hip_atomic_load(p, __ATOMIC_RELAXED, __HIP_MEMORY_SCOPE_AGENT); }
__device__ __forceinline__ unsigned xb_add(unsigned* p, unsigned v) { return __hip_atomic_fetch_add(p, v, __ATOMIC_RELAXED, __HIP_MEMORY_SCOPE_AGENT); }
__device__ __forceinline__ unsigned xb_xcc_id() { return (unsigned)__builtin_amdgcn_s_getreg((3 << 11) | 20) & 0xFu; }
#define XB_SPIN(cond, bar) do { unsigned _sp = 0; while (cond) { __builtin_amdgcn_s_sleep(1); \
    if ((++_sp & 255u) == 0u) { if (xb_ld(&(bar)[XB_TMO])) break; if (_sp > XB_SPIN_CAP) { atomicAdd(&(bar)[XB_TMO], 1u); break; } } } } while (0)
struct XcdBarrier { unsigned* bar; unsigned x; volatile LAS unsigned* st; };
__device__ __forceinline__ XcdBarrier xcd_barrier_post(unsigned* bar, volatile LAS unsigned* st) {
    XcdBarrier b; b.bar = bar; b.x = xb_xcc_id(); b.st = st;
    if (threadIdx.x == 0) (void)xb_add(&bar[XB_XCNT(b.x)], 1u);
    return b;
}
__device__ __forceinline__ void xcd_barrier_complete(unsigned* bar, unsigned x, unsigned& nloc, unsigned& nx) {
    const unsigned G = gridDim.x * gridDim.y * gridDim.z;
    unsigned sum, cnt, mine, sp = 0u;
    for (;;) {
        sum = 0u; cnt = 0u; mine = 0u;
#pragma unroll
        for (unsigned j = 0; j < 16; ++j) { const unsigned c = xb_ld(&bar[XB_XCNT(j)]); sum += c; cnt += (c > 0u) ? 1u : 0u; mine = (j == x) ? c : mine; }
        if (sum == G) break;
        __builtin_amdgcn_s_sleep(1);
        if ((++sp & 255u) == 0u) { if (xb_ld(&bar[XB_TMO])) break; if (sp > XB_SPIN_CAP) { atomicAdd(&bar[XB_TMO], 1u); break; } }
    }
    nloc = mine > 0u ? mine : 1u; nx = cnt > 0u ? cnt : 1u;
}
__device__ __forceinline__ void xcd_barrier(const XcdBarrier& b, int tid_) {
    asm volatile("s_waitcnt vmcnt(0)" ::: "memory");
    __syncthreads();
    if (tid_ == 0) {
        unsigned* bar = b.bar;
        __builtin_amdgcn_s_waitcnt(0);
        unsigned nloc = b.st[0], nx = b.st[1];
        if (nloc == 0u) { xcd_barrier_complete(bar, b.x, nloc, nx); b.st[0] = nloc; b.st[1] = nx; }
        const unsigned old = xb_add(&bar[XB_XSUB(b.x)], 1u);
        const unsigned gen = old / nloc;
        if (old + 1u == (gen + 1u) * nloc) {
            __builtin_amdgcn_fence(__ATOMIC_RELEASE, "agent");
            asm volatile("s_waitcnt vmcnt(0)" ::: "memory");
            const unsigned og = xb_add(&bar[XB_TOP], 1u);
            const unsigned tg = og / nx;
            if (og + 1u == (tg + 1u) * nx) xb_add(&bar[XB_TOPGEN], 1u);
            else XB_SPIN(xb_ld(&bar[XB_TOPGEN]) == tg, bar);
            __builtin_amdgcn_fence(__ATOMIC_ACQUIRE, "agent");
            xb_add(&bar[XB_XGEN(b.x)], 1u);
            asm volatile("s_waitcnt vmcnt(0)" ::: "memory");
        } else {
            XB_SPIN(xb_ld(&bar[XB_XGEN(b.x)]) == gen, bar);
            __builtin_amdgcn_fence(__ATOMIC_ACQUIRE, "agent");
            asm volatile("s_waitcnt vmcnt(0)" ::: "memory");
        }
    }
    __syncthreads();
}

__device__ __forceinline__ float wave_sum(float v) {
#pragma unroll
    for (int o = 1; o < 64; o <<= 1) v += __shfl_xor(v, o);
    return v;
}
struct TrD { const float* src; const float* gain; bf16_t* dst; int ldw, ldt; };
__device__ __forceinline__ void tr_load(const TrD& d, f32x4 (&v)[8], float (&g)[8], int lane) {
    const int c4 = lane & 7, r0 = lane >> 3;
#pragma unroll
    for (int i = 0; i < 8; ++i) { const int row = 8 * i + r0; v[i] = *(const GAS f32x4*)((const GAS float*)d.src + (size_t)row * d.ldw + 4 * c4); g[i] = d.gain ? ((const GAS float*)d.gain)[row] : 1.0f; }
}
__device__ __forceinline__ void tr_store(const TrD& d, const f32x4 (&v)[8], const float (&g)[8], LAS float* scr, int lane) {
    const int c4 = lane & 7, r0 = lane >> 3;
#pragma unroll
    for (int i = 0; i < 8; ++i) { LAS float* s = scr + (8 * i + r0) * 33 + 4 * c4; s[0] = v[i][0] * g[i]; s[1] = v[i][1] * g[i]; s[2] = v[i][2] * g[i]; s[3] = v[i][3] * g[i]; }
    LDS_WAIT(); asm volatile("" ::: "memory");
    const int c = lane & 7;
#pragma unroll
    for (int j = 0; j < 4; ++j) { const int n = (lane >> 3) + 8 * j; const LAS float* s = scr + (8 * c) * 33 + n;
        u32x4 o; o.x = cvt_pk_bf16(s[0 * 33], s[1 * 33]); o.y = cvt_pk_bf16(s[2 * 33], s[3 * 33]); o.z = cvt_pk_bf16(s[4 * 33], s[5 * 33]); o.w = cvt_pk_bf16(s[6 * 33], s[7 * 33]);
        *(GAS u32x4*)((GAS bf16_t*)d.dst + (size_t)n * d.ldt + 8 * c) = o; }
    LDS_WAIT(); asm volatile("" ::: "memory");
}
constexpr int I_IN = (DM / 64) * (NIN / 32), I_P = (BW / 64) * (DM / 32), I_O = (DM / 64) * (DM / 32), I_G = (DM / 64) * (DFF / 32), I_D = (DFF / 64) * (DM / 32);
constexpr int NITEMS = I_IN + 3 * I_P + I_O + 2 * I_G + I_D;
struct Args { const float* in[14]; float* out; unsigned char* ws; };
__device__ __forceinline__ void tr_decode(int it, TrD& d, const Args& A, int layer, unsigned char* ws) {
    int r = it;
    if (r < I_IN) { const int nblk = NIN / 32, kb = r / nblk, c0 = 32 * (r % nblk); size_t doff;
        if (c0 < 3072) doff = WS_WIN + (size_t)c0 * DM * 2;
        else if (c0 < 3584) doff = WS_WIN + (size_t)(3072 + 256 * ((c0 - 3072) >> 7) + ((c0 - 3072) & 127)) * DM * 2;
        else if (c0 < 4096) doff = WS_WIN + (size_t)(4096 + (c0 - 3584)) * DM * 2;
        else if (c0 < 4608) doff = WS_WIN + (size_t)(3072 + 256 * ((c0 - 4096) >> 7) + 128 + ((c0 - 4096) & 127)) * DM * 2;
        else doff = WS_WG + (size_t)(c0 - 4608) * DM * 2;
        d.src = A.in[2] + (size_t)layer * DM * NIN + (size_t)(64 * kb) * NIN + c0; d.gain = A.in[1] + (size_t)layer * DM + 64 * kb; d.dst = (bf16_t*)(ws + doff) + 64 * kb; d.ldw = NIN; d.ldt = DM; return; }
    r -= I_IN;
    if (r < I_P) { const int nblk = DM / 32, kb = r / nblk, c0 = 32 * (r % nblk);
        d.src = A.in[5] + (size_t)layer * BW * DM + (size_t)(64 * kb) * DM + c0; d.gain = nullptr; d.dst = (bf16_t*)(ws + WS_WP) + (size_t)c0 * BW + 64 * kb; d.ldw = DM; d.ldt = BW; return; }
    r -= I_P;
    if (r < I_P) { const int nblk = DM / 32, kb = r / nblk, c0 = 32 * (r % nblk);
        d.src = A.in[6] + (size_t)layer * BW * DM + (size_t)(64 * kb) * DM + c0; d.gain = nullptr; d.dst = (bf16_t*)(ws + WS_WP) + (size_t)DM * BW + (size_t)c0 * BW + 64 * kb; d.ldw = DM; d.ldt = BW; return; }
    r -= I_P;
    if (r < I_P) { const int nblk = DM / 32, kb = r / nblk, c0 = 32 * (r % nblk);
        d.src = A.in[7] + (size_t)layer * BW * DM + (size_t)(64 * kb) * DM + c0; d.gain = nullptr; d.dst = (bf16_t*)(ws + WS_WP) + (size_t)2 * DM * BW + (size_t)c0 * BW + 64 * kb; d.ldw = DM; d.ldt = BW; return; }
    r -= I_P;
    if (r < I_O) { const int nblk = DM / 32, kb = r / nblk, c0 = 32 * (r % nblk);
        d.src = A.in[8] + (size_t)layer * DM * DM + (size_t)(64 * kb) * DM + c0; d.gain = nullptr; d.dst = (bf16_t*)(ws + WS_WO) + (size_t)c0 * DM + 64 * kb; d.ldw = DM; d.ldt = DM; return; }
    r -= I_O;
    if (r < I_G) { const int nblk = DFF / 32, kb = r / nblk, c0 = 32 * (r % nblk);
        d.src = A.in[10] + (size_t)layer * DM * DFF + (size_t)(64 * kb) * DFF + c0; d.gain = A.in[9] + (size_t)layer * DM + 64 * kb; d.dst = (bf16_t*)(ws + WS_WGU) + (size_t)(256 * (c0 >> 7) + (c0 & 127)) * DM + 64 * kb; d.ldw = DFF; d.ldt = DM; return; }
    r -= I_G;
    if (r < I_G) { const int nblk = DFF / 32, kb = r / nblk, c0 = 32 * (r % nblk);
        d.src = A.in[11] + (size_t)layer * DM * DFF + (size_t)(64 * kb) * DFF + c0; d.gain = A.in[9] + (size_t)layer * DM + 64 * kb; d.dst = (bf16_t*)(ws + WS_WGU) + (size_t)(256 * (c0 >> 7) + 128 + (c0 & 127)) * DM + 64 * kb; d.ldw = DFF; d.ldt = DM; return; }
    r -= I_G;
    { const int nblk = DM / 32, kb = r / nblk, c0 = 32 * (r % nblk);
      d.src = A.in[12] + (size_t)layer * DFF * DM + (size_t)(64 * kb) * DM + c0; d.gain = nullptr; d.dst = (bf16_t*)(ws + WS_WD) + (size_t)c0 * DFF + 64 * kb; d.ldw = DM; d.ldt = DFF; }
}


__global__ void __launch_bounds__(NWAVES * 64, 2) hybrid_fwd(Args args) {
    extern __shared__ __attribute__((aligned(16))) unsigned char lds_raw[];
    LAS unsigned char* lds = (LAS unsigned char*)lds_raw;
    volatile LAS unsigned* MISC = (volatile LAS unsigned*)(lds + MISC_OFF);
    const int wave = __builtin_amdgcn_readfirstlane((int)threadIdx.x >> 6);
    const int G = gridDim.x, bx = blockIdx.x, vcu = (G % 8 == 0) ? (bx % 8) * (G / 8) + bx / 8 : bx;
    for (int i = threadIdx.x; i < (LDS_BYTES - LDSCTL_OFF) / 4; i += NWAVES * 64) ((LAS unsigned*)(lds + LDSCTL_OFF))[i] = 0u;
    __syncthreads();
    XcdBarrier bar = xcd_barrier_post((unsigned*)(args.ws + WS_CTL) + CW_BAR, MISC + 8);
    const int gw = vcu * NWAVES + wave, NGW = G * NWAVES;

#ifndef REP_PH
#define REP_PH -1
#endif
    for (int pq = 0; pq < DEPTH * 7 + 1; ++pq)
    for (int rep_ = 0; rep_ < ((pq % 7 == REP_PH && pq < DEPTH * 7) ? 2 : 1); ++rep_) {
        const int pp = pq;
        const int layer = pp / 7, ph = pp - 7 * layer;
        int tid = wave * 64 + lane_id(); asm volatile("" : "+v"(tid)); const int lane = tid & 63;
        size_t opq = 0; asm volatile("" : "+s"(opq));
        unsigned char* ws = args.ws + opq; const float* x_in = args.in[0] + opq; float* out = args.out + opq;
        float* ssA = (float*)(ws + WS_SSA); float* ssB = (float*)(ws + WS_SSB); float* kmp = (float*)(ws + WS_KM);
        bf16_t* xb = (bf16_t*)(ws + WS_XB);
        bf16_t* QA = (bf16_t*)(ws + WS_QA); bf16_t* KA = (bf16_t*)(ws + WS_KA); bf16_t* VA = (bf16_t*)(ws + WS_VA);
        bf16_t* QS = (bf16_t*)(ws + WS_QS); bf16_t* KS = (bf16_t*)(ws + WS_KS); bf16_t* VS = (bf16_t*)(ws + WS_VS);
        bf16_t* Ub = (bf16_t*)(ws + WS_U); bf16_t* BC = (bf16_t*)(ws + WS_BC); bf16_t* MG = (bf16_t*)(ws + WS_MG); bf16_t* ACT = (bf16_t*)(ws + WS_ACT);

        if (layer == DEPTH) {
            const float* gf = args.in[13];
            for (int m = gw; m < M; m += NGW) {
                const float rs = rstd_row(ssA, m);
                f32x4* xr = (f32x4*)(out + (size_t)m * DM) + lane; const f32x4* gr = (const f32x4*)gf + lane; const u32x2* xs = (const u32x2*)(xb + (size_t)m * DM) + lane;
#pragma unroll
                for (int j = 0; j < 4; ++j) { const u32x2 w = xs[64 * j]; const f32x4 v = {bf_lo(w.x), bf_hi(w.x), bf_lo(w.y), bf_hi(w.y)}, g = gr[64 * j]; xr[64 * j] = v * rs * g; }
            }
            if (xb_ld((unsigned*)(ws + WS_CTL) + CW_BAR + XB_TMO) != 0u && bx == 0) { for (int i = tid; i < 4096; i += NWAVES * 64) out[i] = __builtin_nanf(""); }
            break;
        }
        if (ph == 0) {
            LAS float* scr = (LAS float*)(lds + RING_OFF + wave * 16384);
            {
                int it = gw;
                for (; it + NGW < NITEMS; it += 2 * NGW) {
                    TrD da, db; f32x4 va[8], vb[8]; float ga[8], gb[8];
                    tr_decode(it, da, args, layer, ws); tr_load(da, va, ga, lane);
                    tr_decode(it + NGW, db, args, layer, ws); tr_load(db, vb, gb, lane);
                    tr_store(da, va, ga, scr, lane); tr_store(db, vb, gb, scr, lane);
                }
                if (it < NITEMS) { TrD da; f32x4 va[8]; float ga[8]; tr_decode(it, da, args, layer, ws); tr_load(da, va, ga, lane); tr_store(da, va, ga, scr, lane); }
            }
            if (layer == 0) {
                for (int m = gw; m < M; m += NGW) {
                    const f32x4* xr = (const f32x4*)(x_in + (size_t)m * DM) + lane; f32x4 v[4]; float s = 0.f;
#pragma unroll
                    for (int j = 0; j < 4; ++j) { v[j] = xr[64 * j]; s += (v[j].x * v[j].x + v[j].y * v[j].y) + (v[j].z * v[j].z + v[j].w * v[j].w); }
                    s = wave_sum(s);
                    u32x2* o8 = (u32x2*)(xb + (size_t)m * DM) + lane;
#pragma unroll
                    for (int j = 0; j < 4; ++j) o8[64 * j] = (u32x2){cvt_pk_bf16(v[j].x, v[j].y), cvt_pk_bf16(v[j].z, v[j].w)};
                    if (lane < 4) ssA[(size_t)m * 4 + lane] = (lane == 0) ? s : 0.f;
                }
            }
        } else if (ph == 2) {
            LAS unsigned char* vst = lds + RING_OFF + wave * 16384;
            LAS float* wsf = (LAS float*)(lds + ATT_OFF + wave * 512);
            LAS float* km = (LAS float*)(lds + ATT_OFF + 4096);
            LAS unsigned* selm = (LAS unsigned*)(lds + ATT_OFF + 12288);
            LAS unsigned* cnt = (LAS unsigned*)(lds + ATT_OFF + 13312);
            LAS float* kbn = (LAS float*)(lds + ATT_OFF + 13312 + 256);
            LAS unsigned* uslot = (LAS unsigned*)(lds + ATT_OFF + 13312 + 512);
            LAS unsigned char* lists = lds + ATT_OFF + 14336;
            LAS unsigned* trow = (LAS unsigned*)(lds + ATT_OFF + 22528 + wave * 128);
            unsigned char* recO = ws + WS_MG + (size_t)vcu * 131072; float* recML = (float*)(ws + WS_X + (size_t)vcu * 8192);
            unsigned* qctr = (unsigned*)(ws + WS_CTL) + 8192 + layer * 64;
            unsigned* ndone = (unsigned*)(ws + WS_CTL) + 8192 + 128 + layer * 1024;
            float* kbmax = (float*)((unsigned*)(ws + WS_CTL) + 8192 + 4096 + layer * 512);
            for (;;) {
                if (tid == 0) *uslot = __hip_atomic_fetch_add(qctr, 1u, __ATOMIC_RELAXED, __HIP_MEMORY_SCOPE_AGENT);
                __syncthreads();
                const unsigned uq = *uslot;
                __syncthreads();
                if (uq >= 1536u) break;
                if (uq < 512u) {
                    const int bh = (int)(uq >> 5), n = (int)(uq & 31u), b = bh >> 3, h = bh & 7;
                    const int key_ = n * 256 + (tid >> 1); const bf16_t* kp = KA + (size_t)(b * NH + h) * SEQ * HD + (size_t)(key_ >> 5) * 2048 + (tid & 1) * 1024 + (key_ & 31) * 8;
                    float sq = 0.f;
#pragma unroll
                    for (int c = 0; c < 4; ++c) { const u32x4 x = *(const u32x4*)(kp + c * 256); const float e0 = bf_lo(x.x), e1 = bf_hi(x.x), e2 = bf_lo(x.y), e3 = bf_hi(x.y), e4 = bf_lo(x.z), e5 = bf_hi(x.z), e6 = bf_lo(x.w), e7 = bf_hi(x.w);
                        sq += (e0 * e0 + e1 * e1) + (e2 * e2 + e3 * e3) + (e4 * e4 + e5 * e5) + (e6 * e6 + e7 * e7); }
                    sq += xshfl<1>(sq);
                    sq = __builtin_fmaxf(sq, xshfl<2>(sq)); sq = __builtin_fmaxf(sq, xshfl<4>(sq)); sq = __builtin_fmaxf(sq, xshfl<8>(sq)); sq = __builtin_fmaxf(sq, xshfl<16>(sq));
                    { float x1; const float x0 = att::swap_lo(sq, x1); sq = __builtin_fmaxf(x0, x1); }
                    if (lane == 0) kbn[wave] = sq;
                    __syncthreads();
                    if (tid == 0) { float m_ = kbn[0];
#pragma unroll
                        for (int w_ = 1; w_ < NWAVES; ++w_) m_ = __builtin_fmaxf(m_, kbn[w_]);
                        __hip_atomic_store(kbmax + bh * 32 + n, m_, __ATOMIC_RELAXED, __HIP_MEMORY_SCOPE_AGENT);
                        asm volatile("s_waitcnt vmcnt(0)" ::: "memory");
                        __hip_atomic_fetch_add(ndone + bh * 64, 1u, __ATOMIC_RELAXED, __HIP_MEMORY_SCOPE_AGENT); }
                    __syncthreads();
                } else if (uq < 1024u) {
                    const unsigned um = uq - 512u; const int h = 7 - (int)(um >> 6), blk = 31 - (int)((um & 63u) >> 1), b = (int)(um & 1u);
                    for (int i = tid; i < 2048; i += NWAVES * 64) { const int n = i >> 6, d = i & 63; const size_t o = (size_t)((b * 32 + n) * 2) * BW + h * HD + d; km[i] = kmp[o] + kmp[o + BW]; }
                    if (tid == 0) {
                        unsigned sp_ = 0; while (__hip_atomic_load(ndone + (b * 8 + h) * 64, __ATOMIC_RELAXED, __HIP_MEMORY_SCOPE_AGENT) < 32u) { __builtin_amdgcn_s_sleep(2);
                            if (++sp_ > (1u << 20)) { atomicAdd((unsigned*)(ws + WS_CTL) + CW_BAR + XB_TMO, 1u); break; } } }
                    __syncthreads();
                    if (tid < 32) kbn[tid] = sqrtf(__hip_atomic_load(kbmax + (b * 8 + h) * 32 + tid, __ATOMIC_RELAXED, __HIP_MEMORY_SCOPE_AGENT)) * 1.01f;
                    __syncthreads();
                    const float sl2 = __builtin_amdgcn_exp2f(-(float)(h + 1)) * LOG2E;
                    const size_t qrow = (size_t)b * SEQ + blk * 256 + wave * 32;
                    const unsigned sel = att::moba_gate(QA + qrow * BW + h * HD, KA + (size_t)(b * NH + h) * SEQ * HD, blk, blk * 256 + wave * 32, sl2, km, kbn, lane);
                    if (lane < 32) selm[wave * 32 + lane] = sel;
                    __syncthreads();
                    for (int n = wave; n < blk; n += NWAVES) {
                        unsigned pos = 0;
#pragma unroll
                        for (int c = 0; c < 4; ++c) { const int q = 64 * c + lane; const bool bit = (selm[q] >> n) & 1u; const unsigned long long mk = __ballot(bit);
                            if (bit) lists[n * 256 + pos + __builtin_amdgcn_mbcnt_hi((unsigned)(mk >> 32), __builtin_amdgcn_mbcnt_lo((unsigned)mk, 0u))] = (unsigned char)q;
                            pos += (unsigned)__builtin_popcountll(mk); }
                        if (lane == 0) cnt[n] = pos;
                    }
                    __syncthreads();
                    { int n = blk, t = wave; int nn = 0, tt = 0, idp = 0;
                      for (;;) {
                          att::moba_item(QA, KA, VA, b, h, blk, n, t, lists, cnt, selm, recO, recML, vst, wsf, trow, lane);
                          bool found = false;
                          while (nn < blk) { const int nt_ = ((int)cnt[nn] + 31) >> 5;
                              if (tt < nt_) { const bool mine = (idp & (NWAVES - 1)) == wave; if (mine) { n = nn; t = tt; found = true; } ++tt; ++idp; if (mine) break; }
                              else { ++nn; tt = 0; } }
                          if (!found) break;
                      } }
                    VM_WAIT();
                    __syncthreads();
                    att::moba_merge(QA, b, h, blk, wave, selm, recO, recML, wsf, lane);
                    __syncthreads();
                } else {
                    const unsigned us = uq - 1024u; const int h = (int)(us >> 6), blk = (int)((us & 63u) >> 1), b = (int)(us & 1u);
                    att::sb_item(QS, KS, VS, b, h, blk * 256 + wave * 32, vst, lane);
                }
            }
            const float* cw = args.in[4] + (size_t)layer * 3 * BW;
            for (int i = vcu * (NWAVES * 64) + tid; i < M * (BW / 8); i += G * NWAVES * 64) {
                const int t = i >> 6, c = (i & 63) * 8; const int tt = t & (SEQ - 1);
                const u32x4 u2 = *(const u32x4*)(Ub + (size_t)t * BW + c);
                u32x4 u1 = {0u, 0u, 0u, 0u}, u0 = {0u, 0u, 0u, 0u};
                if (tt >= 1) u1 = *(const u32x4*)(Ub + (size_t)(t - 1) * BW + c);
                if (tt >= 2) u0 = *(const u32x4*)(Ub + (size_t)(t - 2) * BW + c);
                const u32x4 bw = *(const u32x4*)(BC + (size_t)t * BW + c);
                float y[8];
#pragma unroll
                for (int e = 0; e < 4; ++e) {
                    const float w0l = cw[c + 2 * e], w0h = cw[c + 2 * e + 1], w1l = cw[BW + c + 2 * e], w1h = cw[BW + c + 2 * e + 1], w2l = cw[2 * BW + c + 2 * e], w2h = cw[2 * BW + c + 2 * e + 1];
                    y[2 * e] = bf_lo(bw[e]) * (w0l * bf_lo(u0[e]) + w1l * bf_lo(u1[e]) + w2l * bf_lo(u2[e]));
                    y[2 * e + 1] = bf_hi(bw[e]) * (w0h * bf_hi(u0[e]) + w1h * bf_hi(u1[e]) + w2h * bf_hi(u2[e]));
                }
                *(u32x4*)(BC + (size_t)t * BW + c) = (u32x4){cvt_pk_bf16(y[0], y[1]), cvt_pk_bf16(y[2], y[3]), cvt_pk_bf16(y[4], y[5]), cvt_pk_bf16(y[6], y[7])};
            }
        } else {
            static_assert(WS_QS - WS_QA == 48 * MiB && WS_BC - WS_QS == 48 * MiB && WS_GB - WS_GA == 48 * MiB && WS_GC0 - WS_GB == 48 * MiB && WS_GC1 - WS_GC0 == 48 * MiB, "48 MiB spacing");
            GCfg c{};
            c.ws = ws; c.bgate = args.in[3] + (size_t)layer * NGATE; c.red = (LAS float*)(lds + LDSCTL_OFF + 1024);
            c.nseg = 1; c.lda = DM; c.ldb = DM; c.nt = DM / 64; c.toA = 0;
            if (ph == 1) { c.mode = 0; c.N = N1; c.A = xb; c.B = (const bf16_t*)(ws + WS_WIN); }
            else if (ph == 3) { c.mode = 1; c.N = DM; c.nseg = 6; c.A = xb; c.B = (const bf16_t*)(ws + WS_WG); }
            else if (ph == 4) { c.mode = 2; c.N = DM; c.A = MG; c.B = (const bf16_t*)(ws + WS_WO); }
            else if (ph == 5) { c.mode = 3; c.N = NGU; c.A = xb; c.B = (const bf16_t*)(ws + WS_WGU); }
            else { c.mode = 2; c.N = DM; c.A = ACT; c.B = (const bf16_t*)(ws + WS_WD); c.lda = DFF; c.ldb = DFF; c.nt = DFF / 64; c.toA = 1; }
            ProbAny P{&c}; EpiAny E{&c}; pg8::StaticOrder S; S.init(M, c.N, G, bx, c.nseg);
            pg8::gemm_phase(lds + RING_OFF, P, S, E, wave);
        }
        xcd_barrier(bar, tid);
    }
}

extern "C" void kernel_launch(void* const* d_in, const int* in_sizes, int n_in, void* d_out, int out_size, void* d_ws, size_t ws_size, hipStream_t stream) {
    static int grid = 0;
    if (grid == 0) {
        if (n_in != 14 || in_sizes[0] != M * DM || out_size != M * DM || ws_size < WS_END) { fprintf(stderr, "kernel_launch: unexpected shapes (n_in %d, in0 %d, out %d, ws %zu)\n", n_in, n_in > 0 ? in_sizes[0] : -1, out_size, ws_size); grid = -1; return; }
        int dev = 0, cus = 0, per_cu = 0;
        if (hipGetDevice(&dev) != hipSuccess || hipDeviceGetAttribute(&cus, hipDeviceAttributeMultiprocessorCount, dev) != hipSuccess) { grid = -1; return; }
        if (hipFuncSetAttribute((const void*)hybrid_fwd, hipFuncAttributeMaxDynamicSharedMemorySize, LDS_BYTES) != hipSuccess) { fprintf(stderr, "kernel_launch: hipFuncSetAttribute failed\n"); grid = -1; return; }
        if (hipOccupancyMaxActiveBlocksPerMultiprocessor(&per_cu, (const void*)hybrid_fwd, NWAVES * 64, LDS_BYTES) != hipSuccess || per_cu < 1) { fprintf(stderr, "kernel_launch: occupancy query says %d blocks/CU\n", per_cu); (void)hipGetLastError(); per_cu = 1; }
        grid = cus;
    }
    if (grid < 0) return;
    if (hipMemsetAsync((char*)d_ws + WS_CTL, 0, CTL_ZERO_BYTES, stream) != hipSuccess) { fprintf(stderr, "kernel_launch: memset failed\n"); return; }
    Args a{};
    for (int i = 0; i < 14; ++i) a.in[i] = (const float*)d_in[i];
    a.out = (float*)d_out; a.ws = (unsigned char*)d_ws;
    void* kargs[] = {&a};
    hipError_t e = hipLaunchCooperativeKernel((const void*)hybrid_fwd, dim3(grid), dim3(NWAVES * 64), kargs, LDS_BYTES, stream);
    if (e != hipSuccess) fprintf(stderr, "kernel_launch: cooperative launch failed: %s (grid %d)\n", hipGetErrorString(e), grid);
}
```

```cpp
#include <hip/hip_runtime.h>
#include <hip/hip_bf16.h>
#include <cstdio>
#include <cstdint>

#define GAS __attribute__((address_space(1)))
#define LAS __attribute__((address_space(3)))
typedef unsigned short bf16_t;
typedef short bf16x8 __attribute__((ext_vector_type(8)));
typedef short s16x4 __attribute__((ext_vector_type(4)));
typedef float f32x2 __attribute__((ext_vector_type(2)));
typedef float f32x4 __attribute__((ext_vector_type(4)));
typedef float f32x16 __attribute__((ext_vector_type(16)));
typedef unsigned u32x2 __attribute__((ext_vector_type(2)));
typedef unsigned u32x4 __attribute__((ext_vector_type(4)));
typedef GAS unsigned gu32;

constexpr int BATCH = 2, SEQ = 8192, DM = 1024, M = BATCH * SEQ, NH = 8, HD = 64, BW = 512, DFF = 2816, DEPTH = 2;
constexpr int NIN = 7680, N1 = 4608, NGATE = 3072, NGU = 2 * DFF;
constexpr float RMS_EPS = 1e-6f;
constexpr float LOG2E = 1.4426950408889634f;
constexpr float C2 = 0.125f * LOG2E;
constexpr int NWAVES = 8;

constexpr size_t MiB = 1u << 20;
constexpr size_t WS_CTL = 0, CTL_ZERO_BYTES = 64 * 1024;
constexpr size_t WS_SSA = 1 * MiB, WS_SSB = 2 * MiB, WS_KM = 3 * MiB;
constexpr size_t WS_WIN = 4 * MiB, WS_WG = 13 * MiB, WS_WP = 19 * MiB, WS_WO = 22 * MiB, WS_WGU = 24 * MiB, WS_WD = 35 * MiB;
constexpr size_t WS_XB = 41 * MiB;
constexpr size_t WS_QA = 73 * MiB, WS_KA = 89 * MiB, WS_VA = 105 * MiB, WS_QS = 121 * MiB, WS_KS = 137 * MiB, WS_VS = 153 * MiB;
constexpr size_t WS_BC = 169 * MiB, WS_U = 185 * MiB, WS_MG = 201 * MiB, WS_X = 233 * MiB;
constexpr size_t WS_GA = WS_KA, WS_GB = WS_KS, WS_GC0 = WS_U, WS_GC1 = WS_X;
constexpr size_t WS_ACT = 73 * MiB;
constexpr size_t WS_END = 256 * MiB;
constexpr int CW_BAR = 4096;

constexpr int RING_OFF = 0, RING_BYTES = 131072;
constexpr int ATT_OFF = RING_BYTES, ATT_BYTES = 23552;
constexpr int LDSCTL_OFF = ATT_OFF + ATT_BYTES, MISC_OFF = LDSCTL_OFF + 320;
constexpr int LDS_BYTES = 163840;
static_assert(LDSCTL_OFF + 1024 + 4096 <= LDS_BYTES, "LDS map");

#define LDS_WAIT() asm volatile("s_waitcnt lgkmcnt(0)" ::: "memory")
#define VM_WAIT() asm volatile("s_waitcnt vmcnt(0)" ::: "memory")
#define RLX_AGENT __ATOMIC_RELAXED, __HIP_MEMORY_SCOPE_AGENT

typedef __bf16 bf16x2_t __attribute__((ext_vector_type(2)));
__device__ __forceinline__ unsigned cvt_pk_bf16(float lo, float hi) { const f32x2 v = {lo, hi}; const bf16x2_t b = __builtin_convertvector(v, bf16x2_t); return __builtin_bit_cast(unsigned, b); }
template <int O> __device__ __forceinline__ float xshfl(float x) {
    static_assert(O < 32, "use sum32 for the two 32-lane halves");
    return __int_as_float(__builtin_amdgcn_ds_swizzle(__float_as_int(x), (O << 10) | 0x1f));
}
__device__ __forceinline__ int lane_id() { return (int)__builtin_amdgcn_mbcnt_hi(~0u, __builtin_amdgcn_mbcnt_lo(~0u, 0u)); }
__device__ __forceinline__ float sum32(float x) { auto rr = __builtin_amdgcn_permlane32_swap(__float_as_uint(x), __float_as_uint(x), false, false); return __uint_as_float(rr[0]) + __uint_as_float(rr[1]); }
__device__ __forceinline__ float bf_lo(unsigned w) { return __uint_as_float(w << 16); }
__device__ __forceinline__ float bf_hi(unsigned w) { return __uint_as_float(w & 0xffff0000u); }
__device__ __forceinline__ float rstd_row(const float* ssp, int row) {
    const f32x4 a = *(const f32x4*)(ssp + (size_t)row * 4);
    return rsqrtf(((a.x + a.y) + (a.z + a.w)) * (1.0f / DM) + RMS_EPS);
}

namespace pg8 {
constexpr int BM = 256, BK = 64, HALF = 128, HTB = HALF * BK * 2, STAGE_BYTES = 8 * HTB, NXCD = 8, WGM = 8;
__host__ __device__ __forceinline__ int lds_byte(int r, int c) { const int st = (r >> 4) * 2 + (c >> 5), rr = r & 15, cc = c & 31, ob = rr * 64 + cc * 2; return st * 1024 + (ob ^ (((ob >> 9) & 1) << 5)); }
__host__ __device__ __forceinline__ void stage_rc(int b, int& R, int& C) { const int st = b / 1024, sb = b % 1024, swz = sb ^ (((sb >> 9) & 1) << 5); R = (st >> 1) * 16 + swz / 64; C = (st & 1) * 32 + (swz % 64) / 2; }
__host__ __device__ __forceinline__ int perm32(int rho) { const int n = rho >> 4, i = rho & 15; return 8 * (i >> 2) + 4 * n + (i & 3); }

struct Unit { int pm, pn, seg; };
struct Seg { const char* A; const char* B; unsigned hA, hB; int lda, ldb, nt; };

struct StaticOrder {
    int nM, nN, nwg, G, c, nseg;
    __device__ void init(int M_, int N_, int G_, int c_, int nseg_) { nM = M_ / BM; nN = N_ / BM; nwg = nM * nN; G = G_; c = c_; nseg = nseg_; }
    __device__ bool next(int i, Unit& u) const {
        const int ti = (nseg == 1) ? i : i / nseg; u.seg = i - ti * nseg;
        const long L = (long)ti * G + c; if (L >= nwg) return false;
        int wgid = (int)L; { const int q = nwg / NXCD, r = nwg % NXCD, xcd = wgid % NXCD, off = wgid / NXCD; wgid = (xcd < r ? xcd * (q + 1) : r * (q + 1) + (xcd - r) * q) + off; }
        const int nig = WGM * nN, gid = wgid / nig, fm = gid * WGM, gsz = (nM - fm) < WGM ? (nM - fm) : WGM;
        u.pm = fm + ((wgid % nig) % gsz); u.pn = (wgid % nig) / gsz; return true;
    }
};

template <class Prob, class Epi, class Sched>
__device__ __forceinline__ void gemm_phase(LAS unsigned char* lds, const Prob& P, const Sched& S, const Epi& E, int wave_) {
    int tid = wave_ * 64 + lane_id(); asm volatile("" : "+v"(tid));
    const int wid = wave_, lane = tid & 63, wr = wid >> 2, wc = wid & 3, fr = lane & 15, fq = lane >> 4;
#define PG8_RC(R0, C0, Rb0) int R0, C0; { int t_ = tid; asm volatile("" : "+v"(t_)); stage_rc(t_ * 16, R0, C0); } const int Rb0 = (R0 & ~31) + perm32(R0 & 31)
    const size_t kstep = (size_t)(BK * 2);
    const unsigned ldsw = (unsigned)wid * 1024u;
    const int aoff = lds_byte(wr * 64 + fr, fq * 8), boff = lds_byte(wc * 32 + fr, fq * 8);
#define PG8_SA(b, h) (((b) * 2 + (h)) * HTB)
#define PG8_SB(b, h) ((4 + (b) * 2 + (h)) * HTB)
#define PG8_STAGE(bufoff, gbase, v0, q) do { \
        __builtin_amdgcn_global_load_lds((const unsigned*)((const char*)(gbase) + (v0)), (LAS unsigned*)(lds + (bufoff) + ldsw), 16, 0, 0); \
        __builtin_amdgcn_global_load_lds((const unsigned*)((const char*)(gbase) + (q) + (v0)), (LAS unsigned*)(lds + (bufoff) + ldsw + 8192), 16, 0, 0); } while (0)
#define PG8_LDA(dst, b, h) do { _Pragma("unroll") for (int m = 0; m < 4; ++m) _Pragma("unroll") for (int k = 0; k < 2; ++k) dst[m][k] = *(const LAS bf16x8*)(lds + PG8_SA(b, h) + aoff + m * 2048 + k * 1024); } while (0)
#define PG8_LDB(dst, b, h) do { _Pragma("unroll") for (int n = 0; n < 2; ++n) _Pragma("unroll") for (int k = 0; k < 2; ++k) dst[n][k] = *(const LAS bf16x8*)(lds + PG8_SB(b, h) + boff + n * 2048 + k * 1024); } while (0)
#define PG8_MMA(ai, bj, At, Bt) do { __builtin_amdgcn_s_setprio(1); _Pragma("unroll") for (int m = 0; m < 4; ++m) _Pragma("unroll") for (int n = 0; n < 2; ++n) _Pragma("unroll") for (int k = 0; k < 2; ++k) \
        acc[ai][bj][m][n] = __builtin_amdgcn_mfma_f32_16x16x32_bf16(Bt[n][k], At[m][k], acc[ai][bj][m][n], 0, 0, 0); __builtin_amdgcn_s_setprio(0); } while (0)
#define PG8_WAIT_V(n) asm volatile("s_waitcnt vmcnt(" #n ")" ::: "memory")
#define PG8_WAIT_L(n) asm volatile("s_waitcnt lgkmcnt(" #n ")" ::: "memory")
#define PG8_BAR __builtin_amdgcn_s_barrier()
#define PG8_SCHED __builtin_amdgcn_sched_barrier(0)
    Unit cur, nxt; int ui = 0;
    if (!S.next(0, cur)) return;
    Seg sc, sn; P.seg(cur, sc);
    unsigned vAc0, vBc0; { PG8_RC(R0, C0, Rb0); vAc0 = (unsigned)(R0 * sc.lda + C0) * 2u; vBc0 = (unsigned)(Rb0 * sc.ldb + C0) * 2u; }
    f32x4 acc[2][2][4][2];
#pragma unroll
    for (int a = 0; a < 2; ++a)
#pragma unroll
        for (int b = 0; b < 2; ++b)
#pragma unroll
            for (int m = 0; m < 4; ++m)
#pragma unroll
                for (int n = 0; n < 2; ++n) acc[a][b][m][n] = (f32x4){0.f, 0.f, 0.f, 0.f};
    bf16x8 At[4][2], B0[2][2], B1[2][2];
    const char* cA = sc.A; const char* cB = sc.B;
    PG8_STAGE(PG8_SB(0, 0), cB, vBc0, sc.hB >> 1); PG8_STAGE(PG8_SB(0, 1), cB + sc.hB, vBc0, sc.hB >> 1); PG8_STAGE(PG8_SA(0, 0), cA, vAc0, sc.hA >> 1); PG8_STAGE(PG8_SA(0, 1), cA + sc.hA, vAc0, sc.hA >> 1);
    if (wr == 1) PG8_BAR;
    PG8_WAIT_V(2); PG8_BAR;
    PG8_STAGE(PG8_SB(1, 0), cB + kstep, vBc0, sc.hB >> 1); PG8_STAGE(PG8_SA(1, 0), cA + kstep, vAc0, sc.hA >> 1); PG8_STAGE(PG8_SB(1, 1), cB + sc.hB + kstep, vBc0, sc.hB >> 1);
    PG8_WAIT_V(6); PG8_BAR;
    for (;;) {
        const bool has_next = S.next(ui + 1, nxt);
        if (has_next) P.seg(nxt, sn); else sn = sc;
        unsigned vAn0, vBn0; { PG8_RC(R0, C0, Rb0); vAn0 = (unsigned)(R0 * sn.lda + C0) * 2u; vBn0 = (unsigned)(Rb0 * sn.ldb + C0) * 2u; }
        const char* nA = sn.A; const char* nB = sn.B;
        const int nt = sc.nt;
        for (int t = 0; t < nt; t += 2) {
            const bool last = (t == nt - 2);
            const char* a1 = cA + (size_t)(t + 1) * kstep;
            const char* a2 = last ? nA : cA + (size_t)(t + 2) * kstep; const char* b2 = last ? nB : cB + (size_t)(t + 2) * kstep;
            const char* a3 = a2 + kstep; const char* b3 = b2 + kstep;
            const unsigned hA2 = last ? sn.hA : sc.hA, hB2 = last ? sn.hB : sc.hB;
            const unsigned vA0 = last ? vAn0 : vAc0, vB0 = last ? vBn0 : vBc0, qA = hA2 >> 1, qB = hB2 >> 1;
            PG8_LDB(B0, 0, 0); PG8_LDB(B1, 0, 1); PG8_SCHED; PG8_LDA(At, 0, 0); PG8_STAGE(PG8_SA(1, 1), a1 + sc.hA, vAc0, sc.hA >> 1);
            PG8_WAIT_V(8); PG8_WAIT_L(0); PG8_BAR; PG8_MMA(0, 0, At, B0); PG8_MMA(0, 1, At, B1); PG8_BAR; PG8_SCHED;
            PG8_LDA(At, 0, 1); PG8_STAGE(PG8_SB(0, 0), b2, vB0, qB); PG8_STAGE(PG8_SB(0, 1), b2 + hB2, vB0, qB); PG8_STAGE(PG8_SA(0, 0), a2, vA0, qA);
            PG8_WAIT_V(8); PG8_WAIT_L(0); PG8_BAR; PG8_MMA(1, 0, At, B0); PG8_MMA(1, 1, At, B1); PG8_BAR; PG8_SCHED;
            PG8_LDB(B0, 1, 0); PG8_LDB(B1, 1, 1); PG8_SCHED; PG8_LDA(At, 1, 0); PG8_STAGE(PG8_SA(0, 1), a2 + hA2, vA0, qA);
            PG8_WAIT_V(8); PG8_WAIT_L(0); PG8_BAR; PG8_MMA(0, 0, At, B0); PG8_MMA(0, 1, At, B1); PG8_BAR; PG8_SCHED;
            PG8_LDA(At, 1, 1); PG8_STAGE(PG8_SB(1, 0), b3, vB0, qB); PG8_STAGE(PG8_SB(1, 1), b3 + hB2, vB0, qB); PG8_STAGE(PG8_SA(1, 0), a3, vA0, qA);
            PG8_WAIT_V(8); PG8_WAIT_L(0); PG8_BAR; PG8_MMA(1, 0, At, B0); PG8_MMA(1, 1, At, B1); PG8_BAR; PG8_SCHED;
        }
        if (wr == 0) PG8_BAR;
        { int wr_ = wr, wc_ = wc, t_ = tid;
          asm volatile("" : "+s"(wr_), "+s"(wc_), "+v"(t_)); const int fr_ = t_ & 15, fq_ = (t_ >> 4) & 3;
          E(acc, cur, wr_, wc_, fr_, fq_); }
        if (!has_next) break;
#pragma unroll
        for (int a = 0; a < 2; ++a)
#pragma unroll
            for (int b = 0; b < 2; ++b)
#pragma unroll
                for (int m = 0; m < 4; ++m)
#pragma unroll
                    for (int n = 0; n < 2; ++n) acc[a][b][m][n] = (f32x4){0.f, 0.f, 0.f, 0.f};
        cur = nxt; sc = sn; cA = nA; cB = nB; vAc0 = vAn0; vBc0 = vBn0; ++ui;
        if (wr == 1) PG8_BAR;
    }
    PG8_WAIT_V(0);
    PG8_BAR;
#undef PG8_SA
#undef PG8_SB
#undef PG8_STAGE
#undef PG8_LDA
#undef PG8_LDB
#undef PG8_MMA
#undef PG8_WAIT_V
#undef PG8_WAIT_L
#undef PG8_BAR
#undef PG8_SCHED
#undef PG8_RC
}
}

#define EPI_ARGS const f32x4 (&acc)[2][2][4][2], const pg8::Unit& u, int wr, int wc, int fr, int fq
__device__ __forceinline__ void st_bf16x8(bf16_t* p, f32x4 v0, f32x4 v1) {
    u32x4 w; w.x = cvt_pk_bf16(v0[0], v0[1]); w.y = cvt_pk_bf16(v0[2], v0[3]); w.z = cvt_pk_bf16(v1[0], v1[1]); w.w = cvt_pk_bf16(v1[2], v1[3]);
#ifdef SC1_STORES
    asm volatile("global_store_dwordx4 %0, %1, off sc1\n\ts_nop 1" :: "v"(p), "v"(w) : "memory");
#else
    *(u32x4*)p = w;
#endif
}
template <class T> __device__ __forceinline__ T* bo(T* base, unsigned byte_off) { return (T*)((char*)base + byte_off); }
template <class T> __device__ __forceinline__ const T* bo(const T* base, unsigned byte_off) { return (const T*)((const char*)base + byte_off); }
__device__ __forceinline__ void ld_bf16x8(const bf16_t* p, f32x4& v0, f32x4& v1) {
    const unsigned long long lo = __hip_atomic_load((const unsigned long long*)p, __ATOMIC_RELAXED, __HIP_MEMORY_SCOPE_AGENT), hi = __hip_atomic_load((const unsigned long long*)p + 1, __ATOMIC_RELAXED, __HIP_MEMORY_SCOPE_AGENT);
    const u32x4 w = {(unsigned)lo, (unsigned)(lo >> 32), (unsigned)hi, (unsigned)(hi >> 32)};
    v0 = (f32x4){bf_lo(w.x), bf_hi(w.x), bf_lo(w.y), bf_hi(w.y)}; v1 = (f32x4){bf_lo(w.z), bf_hi(w.z), bf_lo(w.w), bf_hi(w.w)};
}
__device__ __forceinline__ float rstd4(f32x4 a) { return rsqrtf(((a.x + a.y) + (a.z + a.w)) * (1.0f / DM) + RMS_EPS); }
__device__ __forceinline__ void rstd8(float (&rs)[2][4], const float* ss, int pm, unsigned lrow) {
    const float* ssb = ss + (size_t)pm * 256 * 4; unsigned lsb = lrow * 16u; asm volatile("" : "+v"(lsb));
    f32x4 t[2][4];
#pragma unroll
    for (int ai = 0; ai < 2; ++ai)
#pragma unroll
        for (int m = 0; m < 4; ++m) t[ai][m] = *(const f32x4*)bo(ssb, lsb + (unsigned)(ai * 128 + m * 16) * 16u);
#pragma unroll
    for (int ai = 0; ai < 2; ++ai)
#pragma unroll
        for (int m = 0; m < 4; ++m) rs[ai][m] = rstd4(t[ai][m]);
}
struct EpiIn {
    unsigned char* ws;
    __device__ __forceinline__ void operator()(EPI_ARGS) const {
        bf16_t* qkv = (bf16_t*)(ws + WS_QA); bf16_t* ub = (bf16_t*)(ws + WS_U); bf16_t* bc = (bf16_t*)(ws + WS_BC); float* kmp = (float*)(ws + WS_KM); const float* ss = (const float*)(ws + WS_SSA);
        const int pn = u.pn; unsigned lrow = (unsigned)(wr * 64 + fr), lcol = (unsigned)(wc * 32 + 8 * fq);
        asm volatile("" : "+v"(lrow), "+v"(lcol));
        const unsigned lb = (lrow * BW + lcol) * 2u;
        float rs[2][4]; rstd8(rs, ss, u.pm, lrow);
        if (pn < 12 || pn >= 16) {
            const int t = pn >> 1; const float sc = (t == 0 || t == 3) ? C2 : 1.0f;
            bf16_t* base = (pn < 12 ? qkv + (size_t)t * M * BW + (pn & 1) * 256 : bc + (pn - 16) * 256) + (size_t)u.pm * 256 * BW;
            if (t == 1) {
                float* kp = kmp + (size_t)(u.pm * 2 + wr) * BW + (pn & 1) * 256;
#pragma unroll
                for (int bj = 0; bj < 2; ++bj)
#pragma unroll
                    for (int n = 0; n < 2; ++n) { f32x4 s = {0.f, 0.f, 0.f, 0.f};
#pragma unroll
                        for (int ai = 0; ai < 2; ++ai)
#pragma unroll
                            for (int m = 0; m < 4; ++m) s += acc[ai][bj][m][n] * rs[ai][m];
#pragma unroll
                        for (int e = 0; e < 4; ++e) { s[e] += xshfl<1>(s[e]); s[e] += xshfl<2>(s[e]); s[e] += xshfl<4>(s[e]); s[e] += xshfl<8>(s[e]); }
                        if (fr == 0) *(f32x4*)bo(kp, (lcol + (unsigned)(bj * 128 + 4 * n)) * 4u) = s; }
            }
            if (t == 2 || t == 5) {
                bf16_t* vb = qkv + (size_t)t * M * BW + ((size_t)((u.pm >> 5) * 8 + (pn & 1) * 4) * SEQ + (size_t)(u.pm & 31) * 256) * HD;
                const unsigned fr_ = lrow & 15u, wr_ = lrow >> 6, hl = lcol >> 6, dd = lcol & 63u;
#pragma unroll
                for (int ai = 0; ai < 2; ++ai)
#pragma unroll
                    for (int m = 0; m < 4; ++m) { float f = rs[ai][m]; asm volatile("" : "+v"(f));
#pragma unroll
                        for (int bj = 0; bj < 2; ++bj) { const unsigned eo = (unsigned)(bj * 2 + hl) * (SEQ * HD) + ((wr_ + 2 * ai) * 4096 + ((dd >> 5) * 4 + m) * 512 + fr_ * 32 + (dd & 31u));
                            st_bf16x8(bo(vb, eo * 2u), acc[ai][bj][m][0] * f, acc[ai][bj][m][1] * f); } }
            } else if (t == 1 || t == 4) {
                bf16_t* kb = qkv + (size_t)t * M * BW + ((size_t)((u.pm >> 5) * 8 + (pn & 1) * 4) * SEQ + (size_t)(u.pm & 31) * 256) * HD;
                const unsigned fr_ = lrow & 15u, wr_ = lrow >> 6, hl = lcol >> 6, dch = (lcol & 63u) >> 3;
#pragma unroll
                for (int ai = 0; ai < 2; ++ai)
#pragma unroll
                    for (int m = 0; m < 4; ++m) { float f = rs[ai][m]; asm volatile("" : "+v"(f));
#pragma unroll
                        for (int bj = 0; bj < 2; ++bj) { const unsigned eo = (unsigned)(bj * 2 + hl) * (SEQ * HD) + (((wr_ * 2 + ai * 4 + (m >> 1)) * 8 + dch) * 256 + (fr_ + 16u * (m & 1)) * 8);
                            st_bf16x8(bo(kb, eo * 2u), acc[ai][bj][m][0] * f, acc[ai][bj][m][1] * f); } }
            } else {
#pragma unroll
            for (int ai = 0; ai < 2; ++ai)
#pragma unroll
                for (int m = 0; m < 4; ++m) { const float f = rs[ai][m] * sc; const unsigned o = lb + (unsigned)(ai * 128 + m * 16) * BW * 2u;
#pragma unroll
                    for (int bj = 0; bj < 2; ++bj) st_bf16x8(bo(base, o + bj * 256u), acc[ai][bj][m][0] * f, acc[ai][bj][m][1] * f); }
            }
        } else {
            bf16_t* base = ub + (size_t)u.pm * 256 * BW + (pn - 12) * 128;
#pragma unroll
            for (int ai = 0; ai < 2; ++ai)
#pragma unroll
                for (int m = 0; m < 4; ++m) { const float f = rs[ai][m] * rs[ai][m];
                    st_bf16x8(bo(base, lb + (unsigned)(ai * 128 + m * 16) * BW * 2u), acc[ai][0][m][0] * acc[ai][1][m][0] * f, acc[ai][0][m][1] * acc[ai][1][m][1] * f); }
        }
    }
};
struct EpiC1 {
    unsigned char* ws; const float* bgate;
    __device__ __forceinline__ bf16_t* gtile(int s, int pm, int pn) const {
        const size_t off = WS_GA + (size_t)s * (48 * MiB) + ((s == 2 && pm >= 32) ? 32 * MiB : 0) + ((size_t)pm * 256 * DM + pn * 256) * 2;
        return (bf16_t*)(ws + off);
    }
    __device__ __forceinline__ void operator()(EPI_ARGS) const {
        bf16_t* mg = (bf16_t*)(ws + WS_MG); const float* ss = (const float*)(ws + WS_SSA);
        const int sg = u.seg; unsigned lrow = (unsigned)(wr * 64 + fr), lcol = (unsigned)(wc * 32 + 8 * fq);
        asm volatile("" : "+v"(lrow), "+v"(lcol));
        const unsigned lb = (lrow * DM + lcol) * 2u;
        bf16_t* gp = gtile(sg < 3 ? sg : sg - 3, u.pm, u.pn);
        if (sg < 3) {
            const float* bg = bgate + sg * DM + u.pn * 256;
            f32x4 bv[2][2];
#pragma unroll
            for (int bj = 0; bj < 2; ++bj) { bv[bj][0] = *(const f32x4*)bo(bg, (lcol + bj * 128u) * 4u) * (-LOG2E); bv[bj][1] = *(const f32x4*)bo(bg, (lcol + bj * 128u + 4u) * 4u) * (-LOG2E); }
            float rs[2][4]; rstd8(rs, ss, u.pm, lrow);
#pragma unroll
            for (int ai = 0; ai < 2; ++ai)
#pragma unroll
                for (int m = 0; m < 4; ++m) { const float rn = rs[ai][m] * (-LOG2E); const unsigned o = lb + (unsigned)(ai * 128 + m * 16) * DM * 2u;
#pragma unroll
                    for (int bj = 0; bj < 2; ++bj) { f32x4 v[2];
#pragma unroll
                        for (int n = 0; n < 2; ++n) { const f32x4 x = acc[ai][bj][m][n] * rn + bv[bj][n];
#pragma unroll
                            for (int e = 0; e < 4; ++e) v[n][e] = __builtin_amdgcn_rcpf(1.0f + __builtin_amdgcn_exp2f(x[e])); }
                        st_bf16x8(bo(gp, o + bj * 256u), v[0], v[1]); } }
        } else {
            bf16_t* mp = mg + (size_t)u.pm * 256 * DM + u.pn * 256;
#pragma unroll
            for (int ai = 0; ai < 2; ++ai) {
                constexpr int m0 = 0;
                u32x4 gw_[4][2], pw_[4][2];
#pragma unroll
                for (int mm = 0; mm < 4; ++mm)
#pragma unroll
                    for (int bj = 0; bj < 2; ++bj) { const unsigned o = lb + (unsigned)(ai * 128 + (m0 + mm) * 16) * DM * 2u + bj * 256u;
                        gw_[mm][bj] = *(const u32x4*)bo((const bf16_t*)gp, o); if (sg > 3) pw_[mm][bj] = *(const u32x4*)bo((const bf16_t*)mp, o); }
#pragma unroll
                for (int mm = 0; mm < 4; ++mm)
#pragma unroll
                    for (int bj = 0; bj < 2; ++bj) { const int m = m0 + mm; const unsigned o = lb + (unsigned)(ai * 128 + m * 16) * DM * 2u + bj * 256u; const u32x4 g = gw_[mm][bj];
                        f32x4 v0 = acc[ai][bj][m][0] * (f32x4){bf_lo(g.x), bf_hi(g.x), bf_lo(g.y), bf_hi(g.y)}, v1 = acc[ai][bj][m][1] * (f32x4){bf_lo(g.z), bf_hi(g.z), bf_lo(g.w), bf_hi(g.w)};
                        if (sg > 3) { const u32x4 p = pw_[mm][bj]; v0 += (f32x4){bf_lo(p.x), bf_hi(p.x), bf_lo(p.y), bf_hi(p.y)}; v1 += (f32x4){bf_lo(p.z), bf_hi(p.z), bf_lo(p.w), bf_hi(p.w)}; }
                        st_bf16x8(bo(mp, o), v0, v1); }
                asm volatile("" ::: "memory");
            }
        }
    }
};
struct EpiRes {
    unsigned char* ws; int toA; LAS float* red;
    __device__ __forceinline__ void operator()(EPI_ARGS) const {
        bf16_t* xb = (bf16_t*)(ws + WS_XB); float* sso = (float*)(ws + (toA ? WS_SSA : WS_SSB));
        unsigned lrow = (unsigned)(wr * 64 + fr), lcol = (unsigned)(wc * 32 + 8 * fq);
        asm volatile("" : "+v"(lrow), "+v"(lcol));
        const unsigned le = (lrow * DM + lcol) * 2u, lr4 = lrow * 4u + (unsigned)wc;
        bf16_t* xp = xb + (size_t)u.pm * 256 * DM + u.pn * 256;
#pragma unroll
        for (int ai = 0; ai < 2; ++ai) {
            u32x4 bs[4][2];
#pragma unroll
            for (int m = 0; m < 4; ++m)
#pragma unroll
                for (int bj = 0; bj < 2; ++bj) bs[m][bj] = *(const u32x4*)bo((const bf16_t*)xp, le + (unsigned)(ai * 128 + m * 16) * DM * 2u + bj * 256u);
#pragma unroll
            for (int m = 0; m < 4; ++m) { float sq = 0.f;
#pragma unroll
                for (int bj = 0; bj < 2; ++bj) { const u32x4 w = bs[m][bj];
                    const f32x4 x0 = (f32x4){bf_lo(w.x), bf_hi(w.x), bf_lo(w.y), bf_hi(w.y)} + acc[ai][bj][m][0], x1 = (f32x4){bf_lo(w.z), bf_hi(w.z), bf_lo(w.w), bf_hi(w.w)} + acc[ai][bj][m][1];
                    st_bf16x8(bo(xp, le + (unsigned)(ai * 128 + m * 16) * DM * 2u + bj * 256u), x0, x1);
                    sq += (x0[0] * x0[0] + x0[1] * x0[1]) + (x0[2] * x0[2] + x0[3] * x0[3]) + (x1[0] * x1[0] + x1[1] * x1[1]) + (x1[2] * x1[2] + x1[3] * x1[3]); }
                sq += xshfl<16>(sq); sq = sum32(sq);
                if (fq == 0) red[lr4 + (unsigned)(ai * 128 + m * 16) * 4u] = sq; }
            asm volatile("" ::: "memory");
        }
        asm volatile("s_waitcnt lgkmcnt(0)\n\ts_barrier" ::: "memory");
        { const int t = ((wr * 4 + wc) * 4 + fq) * 16 + fr; if (t < 256) { const f32x4 r = *(const LAS f32x4*)(red + t * 4); sso[((size_t)u.pm * 256 + t) * 4 + u.pn] = (r.x + r.y) + (r.z + r.w); } }
        asm volatile("s_waitcnt lgkmcnt(0)\n\ts_barrier" ::: "memory");
    }
};
struct EpiFfn {
    unsigned char* ws;
    __device__ __forceinline__ void operator()(EPI_ARGS) const {
        bf16_t* act = (bf16_t*)(ws + WS_ACT); const float* ss = (const float*)(ws + WS_SSB);
        unsigned lrow = (unsigned)(wr * 64 + fr), lcol = (unsigned)(wc * 32 + 8 * fq);
        asm volatile("" : "+v"(lrow), "+v"(lcol));
        const unsigned lb = (lrow * DFF + lcol) * 2u;
        bf16_t* ap = act + (size_t)u.pm * 256 * DFF + u.pn * 128;
        float rs[2][4]; rstd8(rs, ss, u.pm, lrow);
#pragma unroll
        for (int ai = 0; ai < 2; ++ai)
#pragma unroll
            for (int m = 0; m < 4; ++m) { const float r1 = rs[ai][m], rn = r1 * (-LOG2E); f32x4 v[2];
#pragma unroll
                for (int n = 0; n < 2; ++n) { const f32x4 g = acc[ai][0][m][n], up = acc[ai][1][m][n] * (r1 * r1);
#pragma unroll
                    for (int e = 0; e < 4; ++e) v[n][e] = g[e] * up[e] * __builtin_amdgcn_rcpf(1.0f + __builtin_amdgcn_exp2f(g[e] * rn)); }
                st_bf16x8(bo(ap, lb + (unsigned)(ai * 128 + m * 16) * DFF * 2u), v[0], v[1]); }
    }
};

struct GCfg {
    int mode;
    int N, nseg, lda, ldb, nt, toA;
    const bf16_t* A; const bf16_t* B;
    unsigned char* ws; unsigned char* wb; const float* bgate; LAS float* red;
};
struct ProbAny {
    const GCfg* c;
    __device__ __forceinline__ void seg(const pg8::Unit& u, pg8::Seg& s) const {
        if (c->mode == 1 && u.seg >= 3) {
            const int br = u.seg - 3; const bf16_t* O = (const bf16_t*)(c->ws + WS_QA + (size_t)br * (48 * MiB)); const bf16_t* Wp = (const bf16_t*)(c->wb + (WS_WP - WS_WIN));
            s.A = (const char*)(O + (size_t)u.pm * 256 * BW); s.B = (const char*)(Wp + ((size_t)br * DM + (size_t)u.pn * 256) * BW);
            s.hA = 128u * BW * 2u; s.hB = 128u * BW * 2u; s.lda = BW; s.ldb = BW; s.nt = BW / 64;
        } else {
            const int so = (c->mode == 1) ? u.seg * DM : 0;
            s.A = (const char*)(c->A + (size_t)u.pm * 256 * c->lda); s.B = (const char*)(c->B + ((size_t)so + (size_t)u.pn * 256) * c->ldb);
            s.hA = 128u * (unsigned)c->lda * 2u; s.hB = 128u * (unsigned)c->ldb * 2u; s.lda = c->lda; s.ldb = c->ldb; s.nt = c->nt;
        }
    }
};
struct EpiAny {
    const GCfg* c;
    __device__ __forceinline__ void operator()(EPI_ARGS) const {
        const int m_ = c->mode;
        if (m_ == 0) EpiIn{c->ws}(acc, u, wr, wc, fr, fq);
        else if (m_ == 1) EpiC1{c->ws, c->bgate}(acc, u, wr, wc, fr, fq);
        else if (m_ == 2) EpiRes{c->ws, c->toA, c->red}(acc, u, wr, wc, fr, fq);
        else EpiFfn{c->ws}(acc, u, wr, wc, fr, fq);
    }
};

namespace att {
__device__ __forceinline__ constexpr int crow(int r, int hi) { return (r & 3) + 8 * (r >> 2) + 4 * hi; }
__device__ __forceinline__ float swap_lo(float x, float& hiv) { auto rr = __builtin_amdgcn_permlane32_swap(__float_as_uint(x), __float_as_uint(x), false, false); hiv = __uint_as_float(rr[1]); return __uint_as_float(rr[0]); }
__device__ __forceinline__ s16x4 vtr(const LAS unsigned char* p) { return __builtin_bit_cast(s16x4, __builtin_amdgcn_ds_read_tr16_b64_v4i16((LAS s16x4*)p)); }
__device__ __forceinline__ void load_k(bf16x8 (&kf)[8], const bf16_t* Kh, int j0, int r32, int hi) {
    const bf16_t* p = Kh + (size_t)(j0 >> 5) * 2048 + hi * 256 + r32 * 8;
#pragma unroll
    for (int d0 = 0; d0 < 4; ++d0) { kf[2 * d0] = *(const bf16x8*)(p + d0 * 512); kf[2 * d0 + 1] = *(const bf16x8*)(p + 2048 + d0 * 512); }
}
__device__ __forceinline__ void dma_v(LAS unsigned char* vbuf, const bf16_t* Vh, int j0, int lane) {
    const bf16_t* p = Vh + (size_t)(j0 >> 6) * 4096 + lane * 8;
#pragma unroll
    for (int i = 0; i < 8; ++i) __builtin_amdgcn_global_load_lds((const unsigned*)(p + i * 512), (LAS unsigned*)(vbuf + i * 1024), 16, 0, 0);
}
__device__ __forceinline__ void load_v(u32x4 (&vv)[8], const bf16_t* Vh, int j0, int lane) {
    const bf16_t* p = Vh + (size_t)(j0 + (lane >> 3)) * BW + (lane & 7) * 8;
#pragma unroll
    for (int i = 0; i < 8; ++i) vv[i] = *(const u32x4*)(p + (size_t)(8 * i) * BW);
}
__device__ __forceinline__ void stage_v(LAS unsigned char* vst, const u32x4 (&vv)[8], int lane) {
    const int c = lane & 7;
#pragma unroll
    for (int i = 0; i < 8; ++i) { const int key = 8 * i + (lane >> 3);
        *(LAS u32x4*)(vst + ((c >> 2) * 4 + (key >> 4)) * 1024 + (key & 15) * 64 + (c & 3) * 16) = vv[i]; }
}
__device__ __forceinline__ void qk(f32x16& p0, f32x16& p1, const bf16x8 (&kf)[8], const bf16x8 (&qr)[4]) {
#pragma unroll
    for (int d0 = 0; d0 < 4; ++d0) { p0 = __builtin_amdgcn_mfma_f32_32x32x16_bf16(kf[2 * d0], qr[d0], p0, 0, 0, 0); p1 = __builtin_amdgcn_mfma_f32_32x32x16_bf16(kf[2 * d0 + 1], qr[d0], p1, 0, 0, 0); }
}
__device__ __forceinline__ void pv(f32x16& o0, f32x16& o1, const f32x16& p0, const f32x16& p1, const LAS unsigned char* vst, int lane) {
    const int hi = lane >> 5;
    const LAS unsigned char* vp = vst + ((lane >> 4) & 1) * 32 + (lane & 3) * 8 + (4 * hi + ((lane & 15) >> 2)) * 64;
    u32x4 pw[4];
    pw[0] = (u32x4){cvt_pk_bf16(p0[0], p0[1]), cvt_pk_bf16(p0[2], p0[3]), cvt_pk_bf16(p0[4], p0[5]), cvt_pk_bf16(p0[6], p0[7])};
    pw[1] = (u32x4){cvt_pk_bf16(p0[8], p0[9]), cvt_pk_bf16(p0[10], p0[11]), cvt_pk_bf16(p0[12], p0[13]), cvt_pk_bf16(p0[14], p0[15])};
    pw[2] = (u32x4){cvt_pk_bf16(p1[0], p1[1]), cvt_pk_bf16(p1[2], p1[3]), cvt_pk_bf16(p1[4], p1[5]), cvt_pk_bf16(p1[6], p1[7])};
    pw[3] = (u32x4){cvt_pk_bf16(p1[8], p1[9]), cvt_pk_bf16(p1[10], p1[11]), cvt_pk_bf16(p1[12], p1[13]), cvt_pk_bf16(p1[14], p1[15])};
#pragma unroll
    for (int ks = 0; ks < 4; ++ks) {
        const s16x4 a0 = vtr(vp + ks * 1024), a1 = vtr(vp + ks * 1024 + 512), b0 = vtr(vp + 4096 + ks * 1024), b1 = vtr(vp + 4096 + ks * 1024 + 512);
        const bf16x8 v0 = {a0[0], a0[1], a0[2], a0[3], a1[0], a1[1], a1[2], a1[3]}, v1 = {b0[0], b0[1], b0[2], b0[3], b1[0], b1[1], b1[2], b1[3]};
        const bf16x8 pa = __builtin_bit_cast(bf16x8, pw[ks]);
        o0 = __builtin_amdgcn_mfma_f32_32x32x16_bf16(pa, v0, o0, 0, 0, 0);
        o1 = __builtin_amdgcn_mfma_f32_32x32x16_bf16(pa, v1, o1, 0, 0, 0);
    }
}
__device__ __forceinline__ void store_o(bf16_t* Ow, const f32x16& o0, const f32x16& o1, const float (&rsc)[16], LAS unsigned char* stg, int lane) {
    const int r32 = lane & 31, hi = lane >> 5;
    LAS bf16_t* s = (LAS bf16_t*)stg;
#pragma unroll
    for (int r = 0; r < 16; ++r) { const int orow = crow(r, hi);
        s[orow * 64 + r32] = (bf16_t)(cvt_pk_bf16(o0[r] * rsc[r], 0.f) & 0xffffu); s[orow * 64 + 32 + r32] = (bf16_t)(cvt_pk_bf16(o1[r] * rsc[r], 0.f) & 0xffffu); }
    LDS_WAIT();
#pragma unroll
    for (int i = 0; i < 4; ++i) { const int row = i * 8 + (lane >> 3), ch = lane & 7; const u32x4 v = *(const LAS u32x4*)(stg + row * 128 + ch * 16); *(u32x4*)(Ow + (size_t)row * BW + ch * 8) = v; }
    LDS_WAIT();
}

__device__ __forceinline__ void sb_item(bf16_t* Q, const bf16_t* K, const bf16_t* V, int b, int h, int q0, LAS unsigned char* vst, int lane) {
    asm volatile("" : "+v"(lane));
    const int r32 = lane & 31, hi = lane >> 5;
    const size_t rowbase = (size_t)b * SEQ;
    bf16_t* Qw = Q + (rowbase + q0) * BW + h * HD;
    bf16x8 qr[4];
#pragma unroll
    for (int d0 = 0; d0 < 4; ++d0) qr[d0] = *(const bf16x8*)(Qw + (size_t)r32 * BW + d0 * 16 + hi * 8);
    const bf16_t* Kh = K + (size_t)(b * NH + h) * SEQ * HD; const bf16_t* Vh = V + (size_t)(b * NH + h) * SEQ * HD;
    f32x16 o0 = {}, o1 = {}; float A2 = 0.f;
    const int tq = q0 + r32;
    bf16x8 kf[8]; load_k(kf, Kh, ((q0 + 30) >> 6) * 64, r32, hi); dma_v(vst + (((q0 + 30) >> 6) & 1) * 8192, Vh, ((q0 + 30) >> 6) * 64, lane);
    for (int kt = (q0 + 30) >> 6; kt >= 0; --kt) {
        const int j0 = kt * 64;
        f32x16 p0 = {}, p1 = {};
        qk(p0, p1, kf, qr);
        asm volatile("" : "+v"(p0), "+v"(p1) :: "memory");
        LAS unsigned char* vcur = vst + (kt & 1) * 8192;
        if (kt > 0) { dma_v(vst + ((kt - 1) & 1) * 8192, Vh, j0 - 64, lane); load_k(kf, Kh, j0 - 64, r32, hi); }
        const bool diag = (j0 + 63 >= q0);
        f32x16 l0, l1;
#pragma unroll
        for (int r = 0; r < 16; ++r) {
            { const float z = p0[r]; const float t = __builtin_amdgcn_exp2f(-__builtin_fabsf(z)); float l = -(__builtin_fmaxf(z, 0.f) + __builtin_amdgcn_logf(1.0f + t)); if (diag && (j0 + crow(r, hi) >= tq)) l = 0.f; l0[r] = l; }
            { const float z = p1[r]; const float t = __builtin_amdgcn_exp2f(-__builtin_fabsf(z)); float l = -(__builtin_fmaxf(z, 0.f) + __builtin_amdgcn_logf(1.0f + t)); if (diag && (j0 + 32 + crow(r, hi) >= tq)) l = 0.f; l1[r] = l; }
        }
        float carry = A2;
#pragma unroll
        for (int half = 1; half >= 0; --half) {
            f32x16& l = half ? l1 : l0; f32x16& p = half ? p1 : p0;
            float T[4];
#pragma unroll
            for (int g = 0; g < 4; ++g) { l[4 * g + 2] += l[4 * g + 3]; l[4 * g + 1] += l[4 * g + 2]; l[4 * g] += l[4 * g + 1]; T[g] = l[4 * g]; }
            float Tl[4], Th[4];
#pragma unroll
            for (int g = 0; g < 4; ++g) Tl[g] = swap_lo(T[g], Th[g]);
            float E = carry;
#pragma unroll
            for (int g = 3; g >= 0; --g) { const float eh = E; E += Th[g]; const float el = E; E += Tl[g]; const float off = hi ? eh : el;
                l[4 * g] += off; l[4 * g + 1] += off; l[4 * g + 2] += off; l[4 * g + 3] += off; }
            carry = E;
#pragma unroll
            for (int r = 0; r < 16; ++r) { float w = __builtin_amdgcn_exp2f(p[r] + l[r]); if (diag && (j0 + 32 * half + crow(r, hi) >= tq)) w = 0.f; p[r] = w; }
        }
        A2 = carry;
        if (kt > 0) asm volatile("s_waitcnt vmcnt(16)" ::: "memory"); else asm volatile("s_waitcnt vmcnt(0)" ::: "memory");
        pv(o0, o1, p0, p1, vcur, lane);
        LDS_WAIT();
        if (__all(A2 < -150.2f)) break;
    }
    float one[16];
#pragma unroll
    for (int r = 0; r < 16; ++r) one[r] = 1.0f;
    store_o(Qw, o0, o1, one, vst, lane);
}

constexpr float MOBA_THR = 8.0f;
__device__ __forceinline__ unsigned moba_gate(const bf16_t* Qw, const bf16_t* Kown, int blk, int tq0, float sl2, const LAS float* km, const LAS float* kbn, int lane) {
    asm volatile("" : "+v"(lane));
    const int r32 = lane & 31, hi = lane >> 5;
    unsigned sel = 0u;
    if (blk > 0) {
        float qf[64];
        { const u32x4* qp = (const u32x4*)(Qw + (size_t)r32 * BW);
#pragma unroll
          for (int c = 0; c < 8; ++c) { const u32x4 x = qp[c]; qf[8 * c] = bf_lo(x.x); qf[8 * c + 1] = bf_hi(x.x); qf[8 * c + 2] = bf_lo(x.y); qf[8 * c + 3] = bf_hi(x.y); qf[8 * c + 4] = bf_lo(x.z); qf[8 * c + 5] = bf_hi(x.z); qf[8 * c + 6] = bf_lo(x.w); qf[8 * c + 7] = bf_hi(x.w); } }
        float v1 = -INFINITY, v2 = -INFINITY, v3 = -INFINITY; int i1 = -1, i2 = -1, i3 = -1;
#define TOP_INS(v, n) do { const bool b1 = (v) > v1 || ((v) == v1 && (n) < i1), b2 = (v) > v2 || ((v) == v2 && (n) < i2), b3 = (v) > v3 || ((v) == v3 && (n) < i3); \
            if (b3) { if (b2) { v3 = v2; i3 = i2; if (b1) { v2 = v1; i2 = i1; v1 = (v); i1 = (n); } else { v2 = (v); i2 = (n); } } else { v3 = (v); i3 = (n); } } } while (0)
#pragma unroll 1
        for (int i = 0; i < 16; ++i) { const int n = 16 * hi + i;
            const LAS f32x4* kr = (const LAS f32x4*)(km + n * 64); float d0 = 0.f, d1 = 0.f, d2 = 0.f, d3 = 0.f;
#pragma unroll
            for (int c = 0; c < 16; ++c) { const f32x4 kk = kr[c]; d0 += qf[4 * c] * kk[0]; d1 += qf[4 * c + 1] * kk[1]; d2 += qf[4 * c + 2] * kk[2]; d3 += qf[4 * c + 3] * kk[3]; }
            const float d = (d0 + d1) + (d2 + d3);
            if (n < blk) TOP_INS(d, n); }
        { float x0, x1; x0 = swap_lo(v1, x1); const float pv1 = hi ? x0 : x1; x0 = swap_lo(v2, x1); const float pv2 = hi ? x0 : x1; x0 = swap_lo(v3, x1); const float pv3 = hi ? x0 : x1;
          x0 = swap_lo(__int_as_float(i1), x1); const int pi1 = __float_as_int(hi ? x0 : x1); x0 = swap_lo(__int_as_float(i2), x1); const int pi2 = __float_as_int(hi ? x0 : x1); x0 = swap_lo(__int_as_float(i3), x1); const int pi3 = __float_as_int(hi ? x0 : x1);
          TOP_INS(pv1, pi1); TOP_INS(pv2, pi2); TOP_INS(pv3, pi3); }
#undef TOP_INS
        float qn2 = 0.f, zs = 0.f;
        { const int tk = tq0 + r32; const bf16_t* kp = Kown + (size_t)(tk >> 5) * 2048 + (tk & 31) * 8;
#pragma unroll
          for (int c = 0; c < 8; ++c) { const u32x4 x = *(const u32x4*)(kp + c * 256);
              zs += qf[8 * c] * bf_lo(x.x) + qf[8 * c + 1] * bf_hi(x.x) + qf[8 * c + 2] * bf_lo(x.y) + qf[8 * c + 3] * bf_hi(x.y) + qf[8 * c + 4] * bf_lo(x.z) + qf[8 * c + 5] * bf_hi(x.z) + qf[8 * c + 6] * bf_lo(x.w) + qf[8 * c + 7] * bf_hi(x.w);
              qn2 += (qf[8 * c] * qf[8 * c] + qf[8 * c + 1] * qf[8 * c + 1]) + (qf[8 * c + 2] * qf[8 * c + 2] + qf[8 * c + 3] * qf[8 * c + 3]) + (qf[8 * c + 4] * qf[8 * c + 4] + qf[8 * c + 5] * qf[8 * c + 5]) + (qf[8 * c + 6] * qf[8 * c + 6] + qf[8 * c + 7] * qf[8 * c + 7]); } }
        const float qn = sqrtf(qn2) * 1.001f, thr = zs - 151.0f; const int tq = tq0 + r32;
#define KEEP(i_) ((i_) >= 0 && !(qn * kbn[(i_)] - sl2 * (float)(tq - (256 * (i_) + 255)) < thr))
        if (KEEP(i1)) sel |= 1u << i1; if (KEEP(i2)) sel |= 1u << i2; if (KEEP(i3)) sel |= 1u << i3;
#undef KEEP
    }
    return sel;
}
__device__ __forceinline__ void moba_tile(f32x16& o0, f32x16& o1, float& mrow, float& lsum, const bf16x8 (&qr)[4], bf16x8 (&kf)[8], const bf16_t* Kh, const bf16_t* Vh, int j0, int jn, float lb, float sl2, bool diag, int tq,
                                          LAS unsigned char* vst, LAS float* wsf, int lane) {
    const int r32 = lane & 31, hi = lane >> 5;
    f32x16 p0, p1;
#pragma unroll
    for (int r = 0; r < 16; ++r) { p0[r] = lb; p1[r] = lb + 32.0f * sl2; }
    qk(p0, p1, kf, qr);
    asm volatile("" : "+v"(p0), "+v"(p1) :: "memory");
    LAS unsigned char* vcur = vst + ((j0 >> 6) & 1) * 8192;
    if (jn >= 0) { dma_v(vst + ((jn >> 6) & 1) * 8192, Vh, jn, lane); load_k(kf, Kh, jn, r32, hi); }
#pragma unroll
    for (int r = 0; r < 16; ++r) { p0[r] = __builtin_fmaf(sl2, (float)crow(r, 0), p0[r]); p1[r] = __builtin_fmaf(sl2, (float)crow(r, 0), p1[r]); }
    if (diag) {
#pragma unroll
        for (int r = 0; r < 16; ++r) { if (j0 + crow(r, hi) > tq) p0[r] = -INFINITY; if (j0 + 32 + crow(r, hi) > tq) p1[r] = -INFINITY; }
    }
    float rm = __builtin_fmaxf(p0[0], p1[0]);
#pragma unroll
    for (int r = 1; r < 16; ++r) rm = __builtin_fmaxf(rm, __builtin_fmaxf(p0[r], p1[r]));
    { float x1; const float x0 = swap_lo(rm, x1); rm = __builtin_fmaxf(x0, x1); }
    if (__any(rm > mrow + MOBA_THR)) {
        const float mn = __builtin_fmaxf(mrow, rm); const float f = __builtin_amdgcn_exp2f(mrow - mn); mrow = mn; lsum *= f;
        if (hi == 0) wsf[r32] = f;
        LDS_WAIT();
#pragma unroll
        for (int r = 0; r < 16; ++r) { const float fr_ = wsf[crow(r, hi)]; o0[r] *= fr_; o1[r] *= fr_; }
        LDS_WAIT();
    }
    float ps = 0.f;
#pragma unroll
    for (int r = 0; r < 16; ++r) { p0[r] = __builtin_amdgcn_exp2f(p0[r] - mrow); p1[r] = __builtin_amdgcn_exp2f(p1[r] - mrow); ps += p0[r] + p1[r]; }
    lsum += ps;
    if (jn >= 0) asm volatile("s_waitcnt vmcnt(16)" ::: "memory"); else asm volatile("s_waitcnt vmcnt(0)" ::: "memory");
    pv(o0, o1, p0, p1, vcur, lane);
    LDS_WAIT();
}
__device__ __forceinline__ void moba_item(const bf16_t* Q, const bf16_t* K, const bf16_t* V, int b, int h, int blk, int n, int tix, const LAS unsigned char* lists, const LAS unsigned* cnt,
                                          const LAS unsigned* selm, unsigned char* recO, float* recML, LAS unsigned char* vst, LAS float* wsf, LAS unsigned* trow, int lane) {
    asm volatile("" : "+v"(lane));
    const int r32 = lane & 31, hi = lane >> 5; const size_t rowbase = (size_t)b * SEQ; const bool own = (n == blk);
    int q; bool valid; unsigned slot;
    if (own) { q = 32 * tix + r32; valid = true; slot = (unsigned)q * 4u + 3u; }
    else { const int cn = (int)cnt[n]; const int p = 32 * tix + r32; valid = p < cn; q = (int)lists[n * 256 + (valid ? p : cn - 1)];
           slot = (unsigned)q * 4u + (unsigned)__builtin_popcount(selm[q] & ((1u << n) - 1u)); }
    if (hi == 0) trow[r32] = slot | (valid ? 0x80000000u : 0u);
    const int tq = blk * 256 + q;
    const bf16_t* Qrow = Q + (rowbase + tq) * BW + h * HD + hi * 8;
    bf16x8 qr[4];
#pragma unroll
    for (int d0 = 0; d0 < 4; ++d0) qr[d0] = *(const bf16x8*)(Qrow + d0 * 16);
    const bf16_t* Kh = K + (size_t)(b * NH + h) * SEQ * HD; const bf16_t* Vh = V + (size_t)(b * NH + h) * SEQ * HD;
    const float sl2 = __builtin_amdgcn_exp2f(-(float)(h + 1)) * LOG2E;
    f32x16 o0 = {}, o1 = {}; float mrow = -INFINITY, lsum = 0.f;
    const int ntile = own ? (tix >> 1) + 1 : 4;
    bf16x8 kf[8]; load_k(kf, Kh, n * 256, r32, hi); dma_v(vst + ((n * 4) & 1) * 8192, Vh, n * 256, lane);
#pragma unroll 1
    for (int i = 0; i < ntile; ++i) { const int j0 = n * 256 + i * 64;
        moba_tile(o0, o1, mrow, lsum, qr, kf, Kh, Vh, j0, i < ntile - 1 ? j0 + 64 : -1, sl2 * (float)(j0 + 4 * hi - tq), sl2, own && i == ntile - 1, tq, vst, wsf, lane); }
    { float x1; const float x0 = swap_lo(lsum, x1); lsum = x0 + x1; }
    if (hi == 0) { wsf[32 + r32] = lsum; if (valid) *(f32x2*)(recML + 2 * slot) = (f32x2){mrow, lsum}; }
    LDS_WAIT();
    LAS bf16_t* s = (LAS bf16_t*)vst;
#pragma unroll
    for (int r = 0; r < 16; ++r) { const int orow = crow(r, hi); const float rl = __builtin_amdgcn_rcpf(wsf[32 + orow]);
        s[orow * 64 + r32] = (bf16_t)(cvt_pk_bf16(o0[r] * rl, 0.f) & 0xffffu); s[orow * 64 + 32 + r32] = (bf16_t)(cvt_pk_bf16(o1[r] * rl, 0.f) & 0xffffu); }
    LDS_WAIT();
#pragma unroll
    for (int i = 0; i < 4; ++i) { const int row = i * 8 + (lane >> 3), ch = lane & 7; const unsigned tr = trow[row]; const u32x4 v = *(const LAS u32x4*)(vst + row * 128 + ch * 16);
        if (tr & 0x80000000u) *(u32x4*)(recO + (size_t)(tr & 0x7fffffffu) * 128 + ch * 16) = v; }
    LDS_WAIT();
}
__device__ __forceinline__ void moba_merge(bf16_t* Q, int b, int h, int blk, int w, const LAS unsigned* selm, const unsigned char* recO, const float* recML, LAS float* wsf, int lane) {
    asm volatile("" : "+v"(lane));
    const int r32 = lane & 31, hi = lane >> 5; const size_t rowbase = (size_t)b * SEQ; const int q0 = blk * 256 + w * 32;
    const int ql = w * 32 + r32; const int c = __builtin_popcount(selm[ql]);
    float mi[4], li[4]; float mx = -INFINITY;
#pragma unroll
    for (int k = 0; k < 4; ++k) { mi[k] = -INFINITY; li[k] = 0.f; if (k == 3 || k < c) { const f32x2 ml = __builtin_nontemporal_load((const f32x2*)(recML + 2 * ((unsigned)ql * 4u + k))); mi[k] = ml.x; li[k] = ml.y; } mx = __builtin_fmaxf(mx, mi[k]); }
    float wg[4], L = 0.f;
#pragma unroll
    for (int k = 0; k < 4; ++k) { wg[k] = (k == 3 || k < c) ? __builtin_amdgcn_exp2f(mi[k] - mx) * li[k] : 0.f; L += wg[k]; }
    const float rL = 1.0f / L;
    if (hi == 0) { wsf[r32] = wg[0] * rL; wsf[32 + r32] = wg[1] * rL; wsf[64 + r32] = wg[2] * rL; wsf[96 + r32] = wg[3] * rL; }
    LDS_WAIT();
    bf16_t* Qw = Q + (rowbase + q0) * BW + h * HD;
#pragma unroll
    for (int i = 0; i < 4; ++i) { const int row = i * 8 + (lane >> 3), ch = lane & 7; f32x4 v0 = {0.f, 0.f, 0.f, 0.f}, v1 = {0.f, 0.f, 0.f, 0.f};
        const unsigned rslot = (unsigned)(w * 32 + row) * 4u;
#pragma unroll
        for (int k = 0; k < 4; ++k) { const float ak = wsf[32 * k + row];
            if (ak != 0.f) { const u32x4 pw = __builtin_nontemporal_load((const u32x4*)(recO + (size_t)(rslot + k) * 128 + ch * 16));
                v0 += ak * (f32x4){bf_lo(pw.x), bf_hi(pw.x), bf_lo(pw.y), bf_hi(pw.y)}; v1 += ak * (f32x4){bf_lo(pw.z), bf_hi(pw.z), bf_lo(pw.w), bf_hi(pw.w)}; } }
        st_bf16x8(Qw + (size_t)row * BW + ch * 8, v0, v1); }
    LDS_WAIT();
}
}

#define XB_TMO      128
#define XB_XCNT(j)  (256  + 64 * (j))
#define XB_XSUB(j)  (1280 + 64 * (j))
#define XB_XGEN(j)  (2304 + 64 * (j))
#define XB_TOP      3328
#define XB_TOPGEN   3392
#define XCD_BAR_WORDS 3456
#define XB_SPIN_CAP (1u << 18)
__device__ __forceinline__ unsigned xb_ld(unsigned* p)              { return __hip_atomic_load(p, __ATOMIC_RELAXED, __HIP_MEMORY_SCOPE_AGENT); }
__device__ __forceinline__ unsigned xb_add(unsigned* p, unsigned v) { return __hip_atomic_fetch_add(p, v, __ATOMIC_RELAXED, __HIP_MEMORY_SCOPE_AGENT); }
__device__ __forceinline__ unsigned xb_xcc_id() { return (unsigned)__builtin_amdgcn_s_getreg((3 << 11) | 20) & 0xFu; }
#define XB_SPIN(cond, bar) do { unsigned _sp = 0; while (cond) { __builtin_amdgcn_s_sleep(1); \
    if ((++_sp & 255u) == 0u) { if (xb_ld(&(bar)[XB_TMO])) break; if (_sp > XB_SPIN_CAP) { atomicAdd(&(bar)[XB_TMO], 1u); break; } } } } while (0)
struct XcdBarrier { unsigned* bar; unsigned x; volatile LAS unsigned* st; };
__device__ __forceinline__ XcdBarrier xcd_barrier_post(unsigned* bar, volatile LAS unsigned* st) {
    XcdBarrier b; b.bar = bar; b.x = xb_xcc_id(); b.st = st;
    if (threadIdx.x == 0) (void)xb_add(&bar[XB_XCNT(b.x)], 1u);
    return b;
}
__device__ __forceinline__ void xcd_barrier_complete(unsigned* bar, unsigned x, unsigned& nloc, unsigned& nx) {
    const unsigned G = gridDim.x * gridDim.y * gridDim.z;
    unsigned sum, cnt, mine, sp = 0u;
    for (;;) {
        sum = 0u; cnt = 0u; mine = 0u;
#pragma unroll
        for (unsigned j = 0; j < 16; ++j) { const unsigned c = xb_ld(&bar[XB_XCNT(j)]); sum += c; cnt += (c > 0u) ? 1u : 0u; mine = (j == x) ? c : mine; }
        if (sum == G) break;
        __builtin_amdgcn_s_sleep(1);
        if ((++sp & 255u) == 0u) { if (xb_ld(&bar[XB_TMO])) break; if (sp > XB_SPIN_CAP) { atomicAdd(&bar[XB_TMO], 1u); break; } }
    }
    nloc = mine > 0u ? mine : 1u; nx = cnt > 0u ? cnt : 1u;
}
__device__ __forceinline__ void xcd_barrier(const XcdBarrier& b, int tid_) {
    asm volatile("s_waitcnt vmcnt(0)" ::: "memory");
    __syncthreads();
    if (tid_ == 0) {
        unsigned* bar = b.bar;
        __builtin_amdgcn_s_waitcnt(0);
        unsigned nloc = b.st[0], nx = b.st[1];
        if (nloc == 0u) { xcd_barrier_complete(bar, b.x, nloc, nx); b.st[0] = nloc; b.st[1] = nx; }
        const unsigned old = xb_add(&bar[XB_XSUB(b.x)], 1u);
        const unsigned gen = old / nloc;
        if (old + 1u == (gen + 1u) * nloc) {
            __builtin_amdgcn_fence(__ATOMIC_RELEASE, "agent");
            asm volatile("s_waitcnt vmcnt(0)" ::: "memory");
            const unsigned og = xb_add(&bar[XB_TOP], 1u);
            const unsigned tg = og / nx;
            if (og + 1u == (tg + 1u) * nx) xb_add(&bar[XB_TOPGEN], 1u);
            else XB_SPIN(xb_ld(&bar[XB_TOPGEN]) == tg, bar);
            __builtin_amdgcn_fence(__ATOMIC_ACQUIRE, "agent");
            xb_add(&bar[XB_XGEN(b.x)], 1u);
            asm volatile("s_waitcnt vmcnt(0)" ::: "memory");
        } else {
            XB_SPIN(xb_ld(&bar[XB_XGEN(b.x)]) == gen, bar);
            __builtin_amdgcn_fence(__ATOMIC_ACQUIRE, "agent");
            asm volatile("s_waitcnt vmcnt(0)" ::: "memory");
        }
    }
    __syncthreads();
}

__device__ __forceinline__ float wave_sum(float v) {
#pragma unroll
    for (int o = 1; o < 64; o <<= 1) v += __shfl_xor(v, o);
    return v;
}
struct TrD { const float* src; const float* gain; bf16_t* dst; int ldw, ldt; };
__device__ __forceinline__ void tr_load(const TrD& d, f32x4 (&v)[8], float (&g)[8], int lane) {
    const int c4 = lane & 7, r0 = lane >> 3;
#pragma unroll
    for (int i = 0; i < 8; ++i) { const int row = 8 * i + r0; v[i] = *(const GAS f32x4*)((const GAS float*)d.src + (size_t)row * d.ldw + 4 * c4); g[i] = d.gain ? ((const GAS float*)d.gain)[row] : 1.0f; }
}
__device__ __forceinline__ void tr_store(const TrD& d, const f32x4 (&v)[8], const float (&g)[8], LAS float* scr, int lane) {
    const int c4 = lane & 7, r0 = lane >> 3;
#pragma unroll
    for (int i = 0; i < 8; ++i) { LAS float* s = scr + (8 * i + r0) * 33 + 4 * c4; s[0] = v[i][0] * g[i]; s[1] = v[i][1] * g[i]; s[2] = v[i][2] * g[i]; s[3] = v[i][3] * g[i]; }
    LDS_WAIT(); asm volatile("" ::: "memory");
    const int c = lane & 7;
#pragma unroll
    for (int j = 0; j < 4; ++j) { const int n = (lane >> 3) + 8 * j; const LAS float* s = scr + (8 * c) * 33 + n;
        u32x4 o; o.x = cvt_pk_bf16(s[0 * 33], s[1 * 33]); o.y = cvt_pk_bf16(s[2 * 33], s[3 * 33]); o.z = cvt_pk_bf16(s[4 * 33], s[5 * 33]); o.w = cvt_pk_bf16(s[6 * 33], s[7 * 33]);
        *(GAS u32x4*)((GAS bf16_t*)d.dst + (size_t)n * d.ldt + 8 * c) = o; }
    LDS_WAIT(); asm volatile("" ::: "memory");
}
constexpr int I_IN = (DM / 64) * (NIN / 32), I_P = (BW / 64) * (DM / 32), I_O = (DM / 64) * (DM / 32), I_G = (DM / 64) * (DFF / 32), I_D = (DFF / 64) * (DM / 32);
constexpr int NITEMS = I_IN + 3 * I_P + I_O + 2 * I_G + I_D;
struct Args { const float* in[14]; float* out; unsigned char* ws; };
__device__ __forceinline__ void tr_decode(int it, TrD& d, const Args& A, int layer, unsigned char* wb) {
    int r = it;
    if (r < I_IN) { const int nblk = NIN / 32, kb = r / nblk, c0 = 32 * (r % nblk); size_t doff;
        if (c0 < 3072) doff = (size_t)c0 * DM * 2;
        else if (c0 < 3584) doff = (size_t)(3072 + 256 * ((c0 - 3072) >> 7) + ((c0 - 3072) & 127)) * DM * 2;
        else if (c0 < 4096) doff = (size_t)(4096 + (c0 - 3584)) * DM * 2;
        else if (c0 < 4608) doff = (size_t)(3072 + 256 * ((c0 - 4096) >> 7) + 128 + ((c0 - 4096) & 127)) * DM * 2;
        else doff = (WS_WG - WS_WIN) + (size_t)(c0 - 4608) * DM * 2;
        d.src = A.in[2] + (size_t)layer * DM * NIN + (size_t)(64 * kb) * NIN + c0; d.gain = A.in[1] + (size_t)layer * DM + 64 * kb; d.dst = (bf16_t*)(wb + doff) + 64 * kb; d.ldw = NIN; d.ldt = DM; return; }
    r -= I_IN;
    if (r < I_P) { const int nblk = DM / 32, kb = r / nblk, c0 = 32 * (r % nblk);
        d.src = A.in[5] + (size_t)layer * BW * DM + (size_t)(64 * kb) * DM + c0; d.gain = nullptr; d.dst = (bf16_t*)(wb + (WS_WP - WS_WIN)) + (size_t)c0 * BW + 64 * kb; d.ldw = DM; d.ldt = BW; return; }
    r -= I_P;
    if (r < I_P) { const int nblk = DM / 32, kb = r / nblk, c0 = 32 * (r % nblk);
        d.src = A.in[6] + (size_t)layer * BW * DM + (size_t)(64 * kb) * DM + c0; d.gain = nullptr; d.dst = (bf16_t*)(wb + (WS_WP - WS_WIN)) + (size_t)DM * BW + (size_t)c0 * BW + 64 * kb; d.ldw = DM; d.ldt = BW; return; }
    r -= I_P;
    if (r < I_P) { const int nblk = DM / 32, kb = r / nblk, c0 = 32 * (r % nblk);
        d.src = A.in[7] + (size_t)layer * BW * DM + (size_t)(64 * kb) * DM + c0; d.gain = nullptr; d.dst = (bf16_t*)(wb + (WS_WP - WS_WIN)) + (size_t)2 * DM * BW + (size_t)c0 * BW + 64 * kb; d.ldw = DM; d.ldt = BW; return; }
    r -= I_P;
    if (r < I_O) { const int nblk = DM / 32, kb = r / nblk, c0 = 32 * (r % nblk);
        d.src = A.in[8] + (size_t)layer * DM * DM + (size_t)(64 * kb) * DM + c0; d.gain = nullptr; d.dst = (bf16_t*)(wb + (WS_WO - WS_WIN)) + (size_t)c0 * DM + 64 * kb; d.ldw = DM; d.ldt = DM; return; }
    r -= I_O;
    if (r < I_G) { const int nblk = DFF / 32, kb = r / nblk, c0 = 32 * (r % nblk);
        d.src = A.in[10] + (size_t)layer * DM * DFF + (size_t)(64 * kb) * DFF + c0; d.gain = A.in[9] + (size_t)layer * DM + 64 * kb; d.dst = (bf16_t*)(wb + (WS_WGU - WS_WIN)) + (size_t)(256 * (c0 >> 7) + (c0 & 127)) * DM + 64 * kb; d.ldw = DFF; d.ldt = DM; return; }
    r -= I_G;
    if (r < I_G) { const int nblk = DFF / 32, kb = r / nblk, c0 = 32 * (r % nblk);
        d.src = A.in[11] + (size_t)layer * DM * DFF + (size_t)(64 * kb) * DFF + c0; d.gain = A.in[9] + (size_t)layer * DM + 64 * kb; d.dst = (bf16_t*)(wb + (WS_WGU - WS_WIN)) + (size_t)(256 * (c0 >> 7) + 128 + (c0 & 127)) * DM + 64 * kb; d.ldw = DFF; d.ldt = DM; return; }
    r -= I_G;
    { const int nblk = DM / 32, kb = r / nblk, c0 = 32 * (r % nblk);
      d.src = A.in[12] + (size_t)layer * DFF * DM + (size_t)(64 * kb) * DM + c0; d.gain = nullptr; d.dst = (bf16_t*)(wb + (WS_WD - WS_WIN)) + (size_t)c0 * DFF + 64 * kb; d.ldw = DM; d.ldt = DFF; }
}


__global__ void __launch_bounds__(NWAVES * 64, 2) hybrid_fwd(Args args) {
    extern __shared__ __attribute__((aligned(16))) unsigned char lds_raw[];
    LAS unsigned char* lds = (LAS unsigned char*)lds_raw;
    volatile LAS unsigned* MISC = (volatile LAS unsigned*)(lds + MISC_OFF);
    const int wave = __builtin_amdgcn_readfirstlane((int)threadIdx.x >> 6);
    const int G = gridDim.x, bx = blockIdx.x, vcu = (G % 8 == 0) ? (bx % 8) * (G / 8) + bx / 8 : bx;
    for (int i = threadIdx.x; i < (LDS_BYTES - LDSCTL_OFF) / 4; i += NWAVES * 64) ((LAS unsigned*)(lds + LDSCTL_OFF))[i] = 0u;
    __syncthreads();
    XcdBarrier bar = xcd_barrier_post((unsigned*)(args.ws + WS_CTL) + CW_BAR, MISC + 8);
    const int gw = vcu * NWAVES + wave, NGW = G * NWAVES;

    for (int pq = 0; pq < DEPTH * 7 + 1; ++pq) {
        const int layer = pq / 7, ph = pq - 7 * layer;
        int tid = wave * 64 + lane_id(); asm volatile("" : "+v"(tid)); const int lane = tid & 63;
        size_t opq = 0; asm volatile("" : "+s"(opq));
        unsigned char* ws = args.ws + opq; const float* x_in = args.in[0] + opq; float* out = args.out + opq;
        float* ssA = (float*)(ws + WS_SSA); float* ssB = (float*)(ws + WS_SSB); float* kmp = (float*)(ws + WS_KM);
        bf16_t* xb = (bf16_t*)(ws + WS_XB);
        bf16_t* QA = (bf16_t*)(ws + WS_QA); bf16_t* KA = (bf16_t*)(ws + WS_KA); bf16_t* VA = (bf16_t*)(ws + WS_VA);
        bf16_t* QS = (bf16_t*)(ws + WS_QS); bf16_t* KS = (bf16_t*)(ws + WS_KS); bf16_t* VS = (bf16_t*)(ws + WS_VS);
        bf16_t* Ub = (bf16_t*)(ws + WS_U); bf16_t* BC = (bf16_t*)(ws + WS_BC); bf16_t* MG = (bf16_t*)(ws + WS_MG); bf16_t* ACT = (bf16_t*)(ws + WS_ACT);

        if (layer == DEPTH) {
            const float* gf = args.in[13];
            for (int m = gw; m < M; m += NGW) {
                const float rs = rstd_row(ssA, m);
                f32x4* xr = (f32x4*)(out + (size_t)m * DM) + lane; const f32x4* gr = (const f32x4*)gf + lane; const u32x2* xs = (const u32x2*)(xb + (size_t)m * DM) + lane;
#pragma unroll
                for (int j = 0; j < 4; ++j) { const u32x2 w = xs[64 * j]; const f32x4 v = {bf_lo(w.x), bf_hi(w.x), bf_lo(w.y), bf_hi(w.y)}, g = gr[64 * j]; xr[64 * j] = v * rs * g; }
            }
            if (xb_ld((unsigned*)(ws + WS_CTL) + CW_BAR + XB_TMO) != 0u && bx == 0) { for (int i = tid; i < 4096; i += NWAVES * 64) out[i] = __builtin_nanf(""); }
            break;
        }
        if (ph == 0) {
            LAS float* scr = (LAS float*)(lds + RING_OFF + wave * 16384);
            {
                constexpr int NIT2 = NITEMS; unsigned char* wb_ = layer == 0 ? ws + WS_WIN : (unsigned char*)out;
#define TR_DEC(i_, d_) tr_decode(i_, d_, args, layer, wb_)
                int it = gw;
                for (; it + NGW < NIT2; it += 2 * NGW) {
                    TrD da, db; f32x4 va[8], vb[8]; float ga[8], gb[8];
                    TR_DEC(it, da); tr_load(da, va, ga, lane);
                    TR_DEC(it + NGW, db); tr_load(db, vb, gb, lane);
                    tr_store(da, va, ga, scr, lane); tr_store(db, vb, gb, scr, lane);
                }
                if (it < NIT2) { TrD da; f32x4 va[8]; float ga[8]; TR_DEC(it, da); tr_load(da, va, ga, lane); tr_store(da, va, ga, scr, lane); }
#undef TR_DEC
            }
            if (layer == 0) {
                for (int m = gw; m < M; m += NGW) {
                    const f32x4* xr = (const f32x4*)(x_in + (size_t)m * DM) + lane; f32x4 v[4]; float s = 0.f;
#pragma unroll
                    for (int j = 0; j < 4; ++j) { v[j] = xr[64 * j]; s += (v[j].x * v[j].x + v[j].y * v[j].y) + (v[j].z * v[j].z + v[j].w * v[j].w); }
                    s = wave_sum(s);
                    u32x2* o8 = (u32x2*)(xb + (size_t)m * DM) + lane;
#pragma unroll
                    for (int j = 0; j < 4; ++j) o8[64 * j] = (u32x2){cvt_pk_bf16(v[j].x, v[j].y), cvt_pk_bf16(v[j].z, v[j].w)};
                    if (lane < 4) ssA[(size_t)m * 4 + lane] = (lane == 0) ? s : 0.f;
                }
            }
        } else if (ph == 2) {
            LAS unsigned char* vst = lds + RING_OFF + wave * 16384;
            LAS float* wsf = (LAS float*)(lds + ATT_OFF + wave * 512);
            LAS float* km = (LAS float*)(lds + ATT_OFF + 4096);
            LAS unsigned* selm = (LAS unsigned*)(lds + ATT_OFF + 12288);
            LAS unsigned* cnt = (LAS unsigned*)(lds + ATT_OFF + 13312);
            LAS float* kbn = (LAS float*)(lds + ATT_OFF + 13312 + 256);
            LAS unsigned* uslot = (LAS unsigned*)(lds + ATT_OFF + 13312 + 512);
            LAS unsigned char* lists = lds + ATT_OFF + 14336;
            LAS unsigned* trow = (LAS unsigned*)(lds + ATT_OFF + 22528 + wave * 128);
            unsigned char* recO = ws + WS_MG + (size_t)vcu * 131072; float* recML = (float*)(ws + WS_X + (size_t)vcu * 8192);
            unsigned* qctr = (unsigned*)(ws + WS_CTL) + 8192 + layer * 64;
            unsigned* ndone = (unsigned*)(ws + WS_CTL) + 8192 + 128 + layer * 1024;
            float* kbmax = (float*)((unsigned*)(ws + WS_CTL) + 8192 + 4096 + layer * 512);
            for (;;) {
                if (tid == 0) *uslot = __hip_atomic_fetch_add(qctr, 1u, __ATOMIC_RELAXED, __HIP_MEMORY_SCOPE_AGENT);
                __syncthreads();
                const unsigned uq = *uslot;
                __syncthreads();
                if (uq >= 1792u) break;
                if (uq >= 1536u) {
                    const float* cw = args.in[4] + (size_t)layer * 3 * BW;
#pragma unroll 1
                    for (int k8 = 0; k8 < 8; ++k8) { const int i = (int)(uq - 1536u) * 4096 + k8 * (NWAVES * 64) + tid;
                        const int t = i >> 6, c = (i & 63) * 8; const int tt = t & (SEQ - 1);
                        const u32x4 u2 = *(const u32x4*)(Ub + (size_t)t * BW + c);
                        u32x4 u1 = {0u, 0u, 0u, 0u}, u0 = {0u, 0u, 0u, 0u};
                        if (tt >= 1) u1 = *(const u32x4*)(Ub + (size_t)(t - 1) * BW + c);
                        if (tt >= 2) u0 = *(const u32x4*)(Ub + (size_t)(t - 2) * BW + c);
                        const u32x4 bw = *(const u32x4*)(BC + (size_t)t * BW + c);
                        float y[8];
#pragma unroll
                        for (int e = 0; e < 4; ++e) {
                            const float w0l = cw[c + 2 * e], w0h = cw[c + 2 * e + 1], w1l = cw[BW + c + 2 * e], w1h = cw[BW + c + 2 * e + 1], w2l = cw[2 * BW + c + 2 * e], w2h = cw[2 * BW + c + 2 * e + 1];
                            y[2 * e] = bf_lo(bw[e]) * (w0l * bf_lo(u0[e]) + w1l * bf_lo(u1[e]) + w2l * bf_lo(u2[e]));
                            y[2 * e + 1] = bf_hi(bw[e]) * (w0h * bf_hi(u0[e]) + w1h * bf_hi(u1[e]) + w2h * bf_hi(u2[e]));
                        }
                        *(u32x4*)(BC + (size_t)t * BW + c) = (u32x4){cvt_pk_bf16(y[0], y[1]), cvt_pk_bf16(y[2], y[3]), cvt_pk_bf16(y[4], y[5]), cvt_pk_bf16(y[6], y[7])}; }
                    continue;
                }
                if (uq < 512u) {
                    const int bh = (int)(uq >> 5), n = (int)(uq & 31u), b = bh >> 3, h = bh & 7;
                    const int key_ = n * 256 + (tid >> 1); const bf16_t* kp = KA + (size_t)(b * NH + h) * SEQ * HD + (size_t)(key_ >> 5) * 2048 + (tid & 1) * 1024 + (key_ & 31) * 8;
                    float sq = 0.f;
#pragma unroll
                    for (int c = 0; c < 4; ++c) { const u32x4 x = *(const u32x4*)(kp + c * 256); const float e0 = bf_lo(x.x), e1 = bf_hi(x.x), e2 = bf_lo(x.y), e3 = bf_hi(x.y), e4 = bf_lo(x.z), e5 = bf_hi(x.z), e6 = bf_lo(x.w), e7 = bf_hi(x.w);
                        sq += (e0 * e0 + e1 * e1) + (e2 * e2 + e3 * e3) + (e4 * e4 + e5 * e5) + (e6 * e6 + e7 * e7); }
                    sq += xshfl<1>(sq);
                    sq = __builtin_fmaxf(sq, xshfl<2>(sq)); sq = __builtin_fmaxf(sq, xshfl<4>(sq)); sq = __builtin_fmaxf(sq, xshfl<8>(sq)); sq = __builtin_fmaxf(sq, xshfl<16>(sq));
                    { float x1; const float x0 = att::swap_lo(sq, x1); sq = __builtin_fmaxf(x0, x1); }
                    if (lane == 0) kbn[wave] = sq;
                    __syncthreads();
                    if (tid == 0) { float m_ = kbn[0];
#pragma unroll
                        for (int w_ = 1; w_ < NWAVES; ++w_) m_ = __builtin_fmaxf(m_, kbn[w_]);
                        __hip_atomic_store(kbmax + bh * 32 + n, m_, __ATOMIC_RELAXED, __HIP_MEMORY_SCOPE_AGENT);
                        asm volatile("s_waitcnt vmcnt(0)" ::: "memory");
                        __hip_atomic_fetch_add(ndone + bh * 64, 1u, __ATOMIC_RELAXED, __HIP_MEMORY_SCOPE_AGENT); }
                    __syncthreads();
                } else if (uq < 1024u) {
                    const unsigned um = uq - 512u; const int h = 7 - (int)(um >> 6), blk = 31 - (int)((um & 63u) >> 1), b = (int)(um & 1u);
                    for (int i = tid; i < 2048; i += NWAVES * 64) { const int n = i >> 6, d = i & 63; const size_t o = (size_t)((b * 32 + n) * 2) * BW + h * HD + d; km[i] = kmp[o] + kmp[o + BW]; }
                    if (tid == 0) {
                        unsigned sp_ = 0; while (__hip_atomic_load(ndone + (b * 8 + h) * 64, __ATOMIC_RELAXED, __HIP_MEMORY_SCOPE_AGENT) < 32u) { __builtin_amdgcn_s_sleep(2);
                            if (++sp_ > (1u << 20)) { atomicAdd((unsigned*)(ws + WS_CTL) + CW_BAR + XB_TMO, 1u); break; } } }
                    __syncthreads();
                    if (tid < 32) kbn[tid] = sqrtf(__hip_atomic_load(kbmax + (b * 8 + h) * 32 + tid, __ATOMIC_RELAXED, __HIP_MEMORY_SCOPE_AGENT)) * 1.01f;
                    __syncthreads();
                    const float sl2 = __builtin_amdgcn_exp2f(-(float)(h + 1)) * LOG2E;
                    const size_t qrow = (size_t)b * SEQ + blk * 256 + wave * 32;
                    const unsigned sel = att::moba_gate(QA + qrow * BW + h * HD, KA + (size_t)(b * NH + h) * SEQ * HD, blk, blk * 256 + wave * 32, sl2, km, kbn, lane);
                    if (lane < 32) selm[wave * 32 + lane] = sel;
                    __syncthreads();
                    for (int n = wave; n < blk; n += NWAVES) {
                        unsigned pos = 0;
#pragma unroll
                        for (int c = 0; c < 4; ++c) { const int q = 64 * c + lane; const bool bit = (selm[q] >> n) & 1u; const unsigned long long mk = __ballot(bit);
                            if (bit) lists[n * 256 + pos + __builtin_amdgcn_mbcnt_hi((unsigned)(mk >> 32), __builtin_amdgcn_mbcnt_lo((unsigned)mk, 0u))] = (unsigned char)q;
                            pos += (unsigned)__builtin_popcountll(mk); }
                        if (lane == 0) cnt[n] = pos;
                    }
                    __syncthreads();
                    { int n = blk, t = wave; int nn = 0, tt = 0, idp = 0;
                      for (;;) {
                          att::moba_item(QA, KA, VA, b, h, blk, n, t, lists, cnt, selm, recO, recML, vst, wsf, trow, lane);
                          bool found = false;
                          while (nn < blk) { const int nt_ = ((int)cnt[nn] + 31) >> 5;
                              if (tt < nt_) { const bool mine = (idp & (NWAVES - 1)) == wave; if (mine) { n = nn; t = tt; found = true; } ++tt; ++idp; if (mine) break; }
                              else { ++nn; tt = 0; } }
                          if (!found) break;
                      } }
                    VM_WAIT();
                    __syncthreads();
                    att::moba_merge(QA, b, h, blk, wave, selm, recO, recML, wsf, lane);
                    __syncthreads();
                } else {
                    const unsigned us = uq - 1024u; const int h = (int)(us >> 6), blk = (int)((us & 63u) >> 1), b = (int)(us & 1u);
                    att::sb_item(QS, KS, VS, b, h, blk * 256 + wave * 32, vst, lane);
                }
            }
        } else {
            static_assert(WS_QS - WS_QA == 48 * MiB && WS_BC - WS_QS == 48 * MiB && WS_GB - WS_GA == 48 * MiB && WS_GC0 - WS_GB == 48 * MiB && WS_GC1 - WS_GC0 == 48 * MiB, "48 MiB spacing");
            GCfg c{};
            c.ws = ws; c.wb = layer == 0 ? ws + WS_WIN : (unsigned char*)out; c.bgate = args.in[3] + (size_t)layer * NGATE; c.red = (LAS float*)(lds + LDSCTL_OFF + 1024);
            c.nseg = 1; c.lda = DM; c.ldb = DM; c.nt = DM / 64; c.toA = 0;
            if (ph == 1) { c.mode = 0; c.N = N1; c.A = xb; c.B = (const bf16_t*)c.wb; }
            else if (ph == 3) { c.mode = 1; c.N = DM; c.nseg = 6; c.A = xb; c.B = (const bf16_t*)(c.wb + (WS_WG - WS_WIN)); }
            else if (ph == 4) { c.mode = 2; c.N = DM; c.A = MG; c.B = (const bf16_t*)(c.wb + (WS_WO - WS_WIN)); }
            else if (ph == 5) { c.mode = 3; c.N = NGU; c.A = xb; c.B = (const bf16_t*)(c.wb + (WS_WGU - WS_WIN)); }
            else { c.mode = 2; c.N = DM; c.A = ACT; c.B = (const bf16_t*)(c.wb + (WS_WD - WS_WIN)); c.lda = DFF; c.ldb = DFF; c.nt = DFF / 64; c.toA = 1; }
            ProbAny P{&c}; EpiAny E{&c}; pg8::StaticOrder S; S.init(M, c.N, G, bx, c.nseg);
            pg8::gemm_phase(lds + RING_OFF, P, S, E, wave);
        }
        if (!(ph == 6 && layer + 1 < DEPTH)) xcd_barrier(bar, tid);
    }
}

extern "C" void kernel_launch(void* const* d_in, const int* in_sizes, int n_in, void* d_out, int out_size, void* d_ws, size_t ws_size, hipStream_t stream) {
    static int grid = 0;
    if (grid == 0) {
        if (n_in != 14 || in_sizes[0] != M * DM || out_size != M * DM || ws_size < WS_END) { fprintf(stderr, "kernel_launch: unexpected shapes (n_in %d, in0 %d, out %d, ws %zu)\n", n_in, n_in > 0 ? in_sizes[0] : -1, out_size, ws_size); grid = -1; return; }
        int dev = 0, cus = 0, per_cu = 0;
        if (hipGetDevice(&dev) != hipSuccess || hipDeviceGetAttribute(&cus, hipDeviceAttributeMultiprocessorCount, dev) != hipSuccess) { grid = -1; return; }
        if (hipFuncSetAttribute((const void*)hybrid_fwd, hipFuncAttributeMaxDynamicSharedMemorySize, LDS_BYTES) != hipSuccess) { fprintf(stderr, "kernel_launch: hipFuncSetAttribute failed\n"); grid = -1; return; }
        if (hipOccupancyMaxActiveBlocksPerMultiprocessor(&per_cu, (const void*)hybrid_fwd, NWAVES * 64, LDS_BYTES) != hipSuccess || per_cu < 1) { fprintf(stderr, "kernel_launch: occupancy query says %d blocks/CU\n", per_cu); (void)hipGetLastError(); per_cu = 1; }
        grid = cus;
    }
    if (grid < 0) return;
    if (hipMemsetAsync((char*)d_ws + WS_CTL, 0, CTL_ZERO_BYTES, stream) != hipSuccess) { fprintf(stderr, "kernel_launch: memset failed\n"); return; }
    Args a{};
    for (int i = 0; i < 14; ++i) a.in[i] = (const float*)d_in[i];
    a.out = (float*)d_out; a.ws = (unsigned char*)d_ws;
    void* kargs[] = {&a};
    hipError_t e = hipLaunchCooperativeKernel((const void*)hybrid_fwd, dim3(grid), dim3(NWAVES * 64), kargs, LDS_BYTES, stream);
    if (e != hipSuccess) fprintf(stderr, "kernel_launch: cooperative launch failed: %s (grid %d)\n", hipGetErrorString(e), grid);
}
```

```cpp
#include <hip/hip_runtime.h>
#include <hip/hip_bf16.h>
#include <cstdio>
#include <cstdint>

#define GAS __attribute__((address_space(1)))
#define LAS __attribute__((address_space(3)))
typedef unsigned short bf16_t;
typedef short bf16x8 __attribute__((ext_vector_type(8)));
typedef short s16x4 __attribute__((ext_vector_type(4)));
typedef float f32x2 __attribute__((ext_vector_type(2)));
typedef float f32x4 __attribute__((ext_vector_type(4)));
typedef float f32x16 __attribute__((ext_vector_type(16)));
typedef unsigned u32x2 __attribute__((ext_vector_type(2)));
typedef unsigned u32x4 __attribute__((ext_vector_type(4)));
typedef GAS unsigned gu32;

constexpr int BATCH = 2, SEQ = 8192, DM = 1024, M = BATCH * SEQ, NH = 8, HD = 64, BW = 512, DFF = 2816, DEPTH = 2;
constexpr int NIN = 7680, N1 = 4608, NGATE = 3072, NGU = 2 * DFF;
constexpr float RMS_EPS = 1e-6f;
constexpr float LOG2E = 1.4426950408889634f;
constexpr float C2 = 0.125f * LOG2E;
constexpr int NWAVES = 8;

constexpr size_t MiB = 1u << 20;
constexpr size_t WS_CTL = 0, CTL_ZERO_BYTES = 64 * 1024;
constexpr size_t WS_SSA = 1 * MiB, WS_SSB = 2 * MiB, WS_KM = 3 * MiB;
constexpr size_t WS_WIN = 4 * MiB, WS_WG = 13 * MiB, WS_WP = 19 * MiB, WS_WO = 22 * MiB, WS_WGU = 24 * MiB, WS_WD = 35 * MiB;
constexpr size_t WS_XB = 41 * MiB;
constexpr size_t WS_QA = 73 * MiB, WS_KA = 89 * MiB, WS_VA = 105 * MiB, WS_QS = 121 * MiB, WS_KS = 137 * MiB, WS_VS = 153 * MiB;
constexpr size_t WS_BC = 169 * MiB, WS_U = 185 * MiB, WS_MG = 201 * MiB, WS_X = 233 * MiB;
constexpr size_t WS_ACT = 73 * MiB;
constexpr size_t WS_END = 256 * MiB;
constexpr int CW_BAR = 4096;

constexpr int RING_OFF = 0, RING_BYTES = 131072;
constexpr int ATT_OFF = RING_BYTES, ATT_BYTES = 23552;
constexpr int LDSCTL_OFF = ATT_OFF + ATT_BYTES, MISC_OFF = LDSCTL_OFF + 320;
constexpr int LDS_BYTES = 163840;
static_assert(LDSCTL_OFF + 1024 + 4096 <= LDS_BYTES, "LDS map");

#define LDS_WAIT() asm volatile("s_waitcnt lgkmcnt(0)" ::: "memory")
#define VM_WAIT() asm volatile("s_waitcnt vmcnt(0)" ::: "memory")
#define RLX_AGENT __ATOMIC_RELAXED, __HIP_MEMORY_SCOPE_AGENT

typedef __bf16 bf16x2_t __attribute__((ext_vector_type(2)));
__device__ __forceinline__ unsigned cvt_pk_bf16(float lo, float hi) { const f32x2 v = {lo, hi}; const bf16x2_t b = __builtin_convertvector(v, bf16x2_t); return __builtin_bit_cast(unsigned, b); }
template <int O> __device__ __forceinline__ float xshfl(float x) {
    static_assert(O < 32, "use sum32 for the two 32-lane halves");
    return __int_as_float(__builtin_amdgcn_ds_swizzle(__float_as_int(x), (O << 10) | 0x1f));
}
__device__ __forceinline__ int lane_id() { return (int)__builtin_amdgcn_mbcnt_hi(~0u, __builtin_amdgcn_mbcnt_lo(~0u, 0u)); }
__device__ __forceinline__ float sum32(float x) { auto rr = __builtin_amdgcn_permlane32_swap(__float_as_uint(x), __float_as_uint(x), false, false); return __uint_as_float(rr[0]) + __uint_as_float(rr[1]); }
__device__ __forceinline__ float bf_lo(unsigned w) { return __uint_as_float(w << 16); }
__device__ __forceinline__ float bf_hi(unsigned w) { return __uint_as_float(w & 0xffff0000u); }
__device__ __forceinline__ float rstd_row(const float* ssp, int row) {
    const f32x4 a = *(const f32x4*)(ssp + (size_t)row * 4);
    return rsqrtf(((a.x + a.y) + (a.z + a.w)) * (1.0f / DM) + RMS_EPS);
}

namespace pg8 {
constexpr int BM = 256, BK = 64, HALF = 128, HTB = HALF * BK * 2, STAGE_BYTES = 8 * HTB, NXCD = 8, WGM = 8;
__host__ __device__ __forceinline__ int lds_byte(int r, int c) { const int st = (r >> 4) * 2 + (c >> 5), rr = r & 15, cc = c & 31, ob = rr * 64 + cc * 2; return st * 1024 + (ob ^ (((ob >> 9) & 1) << 5)); }
__host__ __device__ __forceinline__ void stage_rc(int b, int& R, int& C) { const int st = b / 1024, sb = b % 1024, swz = sb ^ (((sb >> 9) & 1) << 5); R = (st >> 1) * 16 + swz / 64; C = (st & 1) * 32 + (swz % 64) / 2; }
__host__ __device__ __forceinline__ int perm32(int rho) { const int n = rho >> 4, i = rho & 15; return 8 * (i >> 2) + 4 * n + (i & 3); }

struct Unit { int pm, pn, seg; };
struct Seg { const char* A; const char* B; unsigned hA, hB; int lda, ldb, nt; };

struct StaticOrder {
    int nM, nN, nwg, G, c, nseg;
    __device__ void init(int M_, int N_, int G_, int c_, int nseg_) { nM = M_ / BM; nN = N_ / BM; nwg = nM * nN; G = G_; c = c_; nseg = nseg_; }
    __device__ bool next(int i, Unit& u) const {
        const int ti = (nseg == 1) ? i : i / nseg; u.seg = i - ti * nseg;
        const long L = (long)ti * G + c; if (L >= nwg) return false;
        int wgid = (int)L; { const int q = nwg / NXCD, r = nwg % NXCD, xcd = wgid % NXCD, off = wgid / NXCD; wgid = (xcd < r ? xcd * (q + 1) : r * (q + 1) + (xcd - r) * q) + off; }
        const int nig = WGM * nN, gid = wgid / nig, fm = gid * WGM, gsz = (nM - fm) < WGM ? (nM - fm) : WGM;
        u.pm = fm + ((wgid % nig) % gsz); u.pn = (wgid % nig) / gsz; return true;
    }
};

template <class Prob, class Epi, class Sched>
__device__ __forceinline__ void gemm_phase(LAS unsigned char* lds, const Prob& P, const Sched& S, const Epi& E, int wave_) {
    int tid = wave_ * 64 + lane_id(); asm volatile("" : "+v"(tid));
    const int wid = wave_, lane = tid & 63, wr = wid >> 2, wc = wid & 3, fr = lane & 15, fq = lane >> 4;
#define PG8_RC(R0, C0, Rb0) int R0, C0; { int t_ = tid; asm volatile("" : "+v"(t_)); stage_rc(t_ * 16, R0, C0); } const int Rb0 = (R0 & ~31) + perm32(R0 & 31)
    const size_t kstep = (size_t)(BK * 2);
    const unsigned ldsw = (unsigned)wid * 1024u;
    const int aoff = lds_byte(wr * 64 + fr, fq * 8), boff = lds_byte(wc * 32 + fr, fq * 8);
#define PG8_SA(b, h) (((b) * 2 + (h)) * HTB)
#define PG8_SB(b, h) ((4 + (b) * 2 + (h)) * HTB)
#define PG8_STAGE(bufoff, gbase, v0, q) do { \
        __builtin_amdgcn_global_load_lds((const unsigned*)((const char*)(gbase) + (v0)), (LAS unsigned*)(lds + (bufoff) + ldsw), 16, 0, 0); \
        __builtin_amdgcn_global_load_lds((const unsigned*)((const char*)(gbase) + (q) + (v0)), (LAS unsigned*)(lds + (bufoff) + ldsw + 8192), 16, 0, 0); } while (0)
#define PG8_LDA(dst, b, h) do { _Pragma("unroll") for (int m = 0; m < 4; ++m) _Pragma("unroll") for (int k = 0; k < 2; ++k) dst[m][k] = *(const LAS bf16x8*)(lds + PG8_SA(b, h) + aoff + m * 2048 + k * 1024); } while (0)
#define PG8_LDB(dst, b, h) do { _Pragma("unroll") for (int n = 0; n < 2; ++n) _Pragma("unroll") for (int k = 0; k < 2; ++k) dst[n][k] = *(const LAS bf16x8*)(lds + PG8_SB(b, h) + boff + n * 2048 + k * 1024); } while (0)
#define PG8_MMA(ai, bj, At, Bt) do { __builtin_amdgcn_s_setprio(1); _Pragma("unroll") for (int m = 0; m < 4; ++m) _Pragma("unroll") for (int n = 0; n < 2; ++n) _Pragma("unroll") for (int k = 0; k < 2; ++k) \
        acc[ai][bj][m][n] = __builtin_amdgcn_mfma_f32_16x16x32_bf16(Bt[n][k], At[m][k], acc[ai][bj][m][n], 0, 0, 0); __builtin_amdgcn_s_setprio(0); } while (0)
#define PG8_WAIT_V(n) asm volatile("s_waitcnt vmcnt(" #n ")" ::: "memory")
#define PG8_WAIT_L(n) asm volatile("s_waitcnt lgkmcnt(" #n ")" ::: "memory")
#define PG8_BAR __builtin_amdgcn_s_barrier()
#define PG8_SCHED __builtin_amdgcn_sched_barrier(0)
    Unit cur, nxt; int ui = 0;
    if (!S.next(0, cur)) return;
    Seg sc, sn; P.seg(cur, sc);
    unsigned vAc0, vBc0; { PG8_RC(R0, C0, Rb0); vAc0 = (unsigned)(R0 * sc.lda + C0) * 2u; vBc0 = (unsigned)(Rb0 * sc.ldb + C0) * 2u; }
    f32x4 acc[2][2][4][2];
#pragma unroll
    for (int a = 0; a < 2; ++a)
#pragma unroll
        for (int b = 0; b < 2; ++b)
#pragma unroll
            for (int m = 0; m < 4; ++m)
#pragma unroll
                for (int n = 0; n < 2; ++n) acc[a][b][m][n] = (f32x4){0.f, 0.f, 0.f, 0.f};
    bf16x8 At[4][2], B0[2][2], B1[2][2];
    const char* cA = sc.A; const char* cB = sc.B;
    PG8_STAGE(PG8_SB(0, 0), cB, vBc0, sc.hB >> 1); PG8_STAGE(PG8_SB(0, 1), cB + sc.hB, vBc0, sc.hB >> 1); PG8_STAGE(PG8_SA(0, 0), cA, vAc0, sc.hA >> 1); PG8_STAGE(PG8_SA(0, 1), cA + sc.hA, vAc0, sc.hA >> 1);
    if (wr == 1) PG8_BAR;
    PG8_WAIT_V(2); PG8_BAR;
    PG8_STAGE(PG8_SB(1, 0), cB + kstep, vBc0, sc.hB >> 1); PG8_STAGE(PG8_SA(1, 0), cA + kstep, vAc0, sc.hA >> 1); PG8_STAGE(PG8_SB(1, 1), cB + sc.hB + kstep, vBc0, sc.hB >> 1);
    PG8_WAIT_V(6); PG8_BAR;
    for (;;) {
        const bool has_next = S.next(ui + 1, nxt);
        if (has_next) P.seg(nxt, sn); else sn = sc;
        unsigned vAn0, vBn0; { PG8_RC(R0, C0, Rb0); vAn0 = (unsigned)(R0 * sn.lda + C0) * 2u; vBn0 = (unsigned)(Rb0 * sn.ldb + C0) * 2u; }
        const char* nA = sn.A; const char* nB = sn.B;
        const int nt = sc.nt;
        for (int t = 0; t < nt; t += 2) {
            const bool last = (t == nt - 2);
            const char* a1 = cA + (size_t)(t + 1) * kstep;
            const char* a2 = last ? nA : cA + (size_t)(t + 2) * kstep; const char* b2 = last ? nB : cB + (size_t)(t + 2) * kstep;
            const char* a3 = a2 + kstep; const char* b3 = b2 + kstep;
            const unsigned hA2 = last ? sn.hA : sc.hA, hB2 = last ? sn.hB : sc.hB;
            const unsigned vA0 = last ? vAn0 : vAc0, vB0 = last ? vBn0 : vBc0, qA = hA2 >> 1, qB = hB2 >> 1;
            PG8_LDB(B0, 0, 0); PG8_LDB(B1, 0, 1); PG8_SCHED; PG8_LDA(At, 0, 0); PG8_STAGE(PG8_SA(1, 1), a1 + sc.hA, vAc0, sc.hA >> 1);
            PG8_WAIT_V(8); PG8_WAIT_L(0); PG8_BAR; PG8_MMA(0, 0, At, B0); PG8_MMA(0, 1, At, B1); PG8_BAR; PG8_SCHED;
            PG8_LDA(At, 0, 1); PG8_STAGE(PG8_SB(0, 0), b2, vB0, qB); PG8_STAGE(PG8_SB(0, 1), b2 + hB2, vB0, qB); PG8_STAGE(PG8_SA(0, 0), a2, vA0, qA);
            PG8_WAIT_V(8); PG8_WAIT_L(0); PG8_BAR; PG8_MMA(1, 0, At, B0); PG8_MMA(1, 1, At, B1); PG8_BAR; PG8_SCHED;
            PG8_LDB(B0, 1, 0); PG8_LDB(B1, 1, 1); PG8_SCHED; PG8_LDA(At, 1, 0); PG8_STAGE(PG8_SA(0, 1), a2 + hA2, vA0, qA);
            PG8_WAIT_V(8); PG8_WAIT_L(0); PG8_BAR; PG8_MMA(0, 0, At, B0); PG8_MMA(0, 1, At, B1); PG8_BAR; PG8_SCHED;
            PG8_LDA(At, 1, 1); PG8_STAGE(PG8_SB(1, 0), b3, vB0, qB); PG8_STAGE(PG8_SB(1, 1), b3 + hB2, vB0, qB); PG8_STAGE(PG8_SA(1, 0), a3, vA0, qA);
            PG8_WAIT_V(8); PG8_WAIT_L(0); PG8_BAR; PG8_MMA(1, 0, At, B0); PG8_MMA(1, 1, At, B1); PG8_BAR; PG8_SCHED;
        }
        if (wr == 0) PG8_BAR;
        { int wr_ = wr, wc_ = wc, t_ = tid;
          asm volatile("" : "+s"(wr_), "+s"(wc_), "+v"(t_)); const int fr_ = t_ & 15, fq_ = (t_ >> 4) & 3;
          E(acc, cur, wr_, wc_, fr_, fq_); }
        if (!has_next) break;
#pragma unroll
        for (int a = 0; a < 2; ++a)
#pragma unroll
            for (int b = 0; b < 2; ++b)
#pragma unroll
                for (int m = 0; m < 4; ++m)
#pragma unroll
                    for (int n = 0; n < 2; ++n) acc[a][b][m][n] = (f32x4){0.f, 0.f, 0.f, 0.f};
        cur = nxt; sc = sn; cA = nA; cB = nB; vAc0 = vAn0; vBc0 = vBn0; ++ui;
        if (wr == 1) PG8_BAR;
    }
    PG8_WAIT_V(0);
    PG8_BAR;
#undef PG8_SA
#undef PG8_SB
#undef PG8_STAGE
#undef PG8_LDA
#undef PG8_LDB
#undef PG8_MMA
#undef PG8_WAIT_V
#undef PG8_WAIT_L
#undef PG8_BAR
#undef PG8_SCHED
#undef PG8_RC
}
}

#define EPI_ARGS const f32x4 (&acc)[2][2][4][2], const pg8::Unit& u, int wr, int wc, int fr, int fq
__device__ __forceinline__ void st_bf16x8(bf16_t* p, f32x4 v0, f32x4 v1) {
    u32x4 w; w.x = cvt_pk_bf16(v0[0], v0[1]); w.y = cvt_pk_bf16(v0[2], v0[3]); w.z = cvt_pk_bf16(v1[0], v1[1]); w.w = cvt_pk_bf16(v1[2], v1[3]);
#ifdef SC1_STORES
    asm volatile("global_store_dwordx4 %0, %1, off sc1\n\ts_nop 1" :: "v"(p), "v"(w) : "memory");
#else
    *(u32x4*)p = w;
#endif
}
template <class T> __device__ __forceinline__ T* bo(T* base, unsigned byte_off) { return (T*)((char*)base + byte_off); }
template <class T> __device__ __forceinline__ const T* bo(const T* base, unsigned byte_off) { return (const T*)((const char*)base + byte_off); }
__device__ __forceinline__ void ld_bf16x8(const bf16_t* p, f32x4& v0, f32x4& v1) {
    const unsigned long long lo = __hip_atomic_load((const unsigned long long*)p, __ATOMIC_RELAXED, __HIP_MEMORY_SCOPE_AGENT), hi = __hip_atomic_load((const unsigned long long*)p + 1, __ATOMIC_RELAXED, __HIP_MEMORY_SCOPE_AGENT);
    const u32x4 w = {(unsigned)lo, (unsigned)(lo >> 32), (unsigned)hi, (unsigned)(hi >> 32)};
    v0 = (f32x4){bf_lo(w.x), bf_hi(w.x), bf_lo(w.y), bf_hi(w.y)}; v1 = (f32x4){bf_lo(w.z), bf_hi(w.z), bf_lo(w.w), bf_hi(w.w)};
}
__device__ __forceinline__ float rstd4(f32x4 a) { return rsqrtf(((a.x + a.y) + (a.z + a.w)) * (1.0f / DM) + RMS_EPS); }
__device__ __forceinline__ void rstd8(float (&rs)[2][4], const float* ss, int pm, unsigned lrow) {
    const float* ssb = ss + (size_t)pm * 256 * 4; unsigned lsb = lrow * 16u; asm volatile("" : "+v"(lsb));
    f32x4 t[2][4];
#pragma unroll
    for (int ai = 0; ai < 2; ++ai)
#pragma unroll
        for (int m = 0; m < 4; ++m) t[ai][m] = *(const f32x4*)bo(ssb, lsb + (unsigned)(ai * 128 + m * 16) * 16u);
#pragma unroll
    for (int ai = 0; ai < 2; ++ai)
#pragma unroll
        for (int m = 0; m < 4; ++m) rs[ai][m] = rstd4(t[ai][m]);
}
struct EpiIn {
    unsigned char* ws;
    __device__ __forceinline__ void operator()(EPI_ARGS) const {
        bf16_t* qkv = (bf16_t*)(ws + WS_QA); bf16_t* ub = (bf16_t*)(ws + WS_U); bf16_t* bc = (bf16_t*)(ws + WS_BC); float* kmp = (float*)(ws + WS_KM); const float* ss = (const float*)(ws + WS_SSA);
        const int pn = u.pn; unsigned lrow = (unsigned)(wr * 64 + fr), lcol = (unsigned)(wc * 32 + 8 * fq);
        asm volatile("" : "+v"(lrow), "+v"(lcol));
        const unsigned lb = (lrow * BW + lcol) * 2u;
        float rs[2][4]; rstd8(rs, ss, u.pm, lrow);
        if (pn < 12 || pn >= 16) {
            const int t = pn >> 1; const float sc = (t == 0 || t == 3) ? C2 : 1.0f;
            bf16_t* base = (pn < 12 ? qkv + (size_t)t * M * BW + (pn & 1) * 256 : bc + (pn - 16) * 256) + (size_t)u.pm * 256 * BW;
            if (t == 1) {
                float* kp = kmp + (size_t)(u.pm * 2 + wr) * BW + (pn & 1) * 256;
#pragma unroll
                for (int bj = 0; bj < 2; ++bj)
#pragma unroll
                    for (int n = 0; n < 2; ++n) { f32x4 s = {0.f, 0.f, 0.f, 0.f};
#pragma unroll
                        for (int ai = 0; ai < 2; ++ai)
#pragma unroll
                            for (int m = 0; m < 4; ++m) s += acc[ai][bj][m][n] * rs[ai][m];
#pragma unroll
                        for (int e = 0; e < 4; ++e) { s[e] += xshfl<1>(s[e]); s[e] += xshfl<2>(s[e]); s[e] += xshfl<4>(s[e]); s[e] += xshfl<8>(s[e]); }
                        if (fr == 0) *(f32x4*)bo(kp, (lcol + (unsigned)(bj * 128 + 4 * n)) * 4u) = s; }
            }
            if (t == 2 || t == 5) {
                bf16_t* vb = qkv + (size_t)t * M * BW + ((size_t)((u.pm >> 5) * 8 + (pn & 1) * 4) * SEQ + (size_t)(u.pm & 31) * 256) * HD;
                const unsigned fr_ = lrow & 15u, wr_ = lrow >> 6, hl = lcol >> 6, dd = lcol & 63u;
#pragma unroll
                for (int ai = 0; ai < 2; ++ai)
#pragma unroll
                    for (int m = 0; m < 4; ++m) { float f = rs[ai][m]; asm volatile("" : "+v"(f));
#pragma unroll
                        for (int bj = 0; bj < 2; ++bj) { const unsigned eo = (unsigned)(bj * 2 + hl) * (SEQ * HD) + ((wr_ + 2 * ai) * 4096 + ((dd >> 5) * 4 + m) * 512 + fr_ * 32 + (dd & 31u));
                            st_bf16x8(bo(vb, eo * 2u), acc[ai][bj][m][0] * f, acc[ai][bj][m][1] * f); } }
            } else if (t == 1 || t == 4) {
                bf16_t* kb = qkv + (size_t)t * M * BW + ((size_t)((u.pm >> 5) * 8 + (pn & 1) * 4) * SEQ + (size_t)(u.pm & 31) * 256) * HD;
                const unsigned fr_ = lrow & 15u, wr_ = lrow >> 6, hl = lcol >> 6, dch = (lcol & 63u) >> 3;
#pragma unroll
                for (int ai = 0; ai < 2; ++ai)
#pragma unroll
                    for (int m = 0; m < 4; ++m) { float f = rs[ai][m]; asm volatile("" : "+v"(f));
#pragma unroll
                        for (int bj = 0; bj < 2; ++bj) { const unsigned eo = (unsigned)(bj * 2 + hl) * (SEQ * HD) + (((wr_ * 2 + ai * 4 + (m >> 1)) * 8 + dch) * 256 + (fr_ + 16u * (m & 1)) * 8);
                            st_bf16x8(bo(kb, eo * 2u), acc[ai][bj][m][0] * f, acc[ai][bj][m][1] * f); } }
            } else {
#pragma unroll
            for (int ai = 0; ai < 2; ++ai)
#pragma unroll
                for (int m = 0; m < 4; ++m) { const float f = rs[ai][m] * sc; const unsigned o = lb + (unsigned)(ai * 128 + m * 16) * BW * 2u;
#pragma unroll
                    for (int bj = 0; bj < 2; ++bj) st_bf16x8(bo(base, o + bj * 256u), acc[ai][bj][m][0] * f, acc[ai][bj][m][1] * f); }
            }
        } else {
            bf16_t* base = ub + (size_t)u.pm * 256 * BW + (pn - 12) * 128;
#pragma unroll
            for (int ai = 0; ai < 2; ++ai)
#pragma unroll
                for (int m = 0; m < 4; ++m) { const float f = rs[ai][m] * rs[ai][m];
                    st_bf16x8(bo(base, lb + (unsigned)(ai * 128 + m * 16) * BW * 2u), acc[ai][0][m][0] * acc[ai][1][m][0] * f, acc[ai][0][m][1] * acc[ai][1][m][1] * f); }
        }
    }
};
struct EpiC1 {
    unsigned char* ws; const float* bgate;
    __device__ __forceinline__ unsigned char* gtile(int s, int pm, int pn) const { return ws + WS_KA + (size_t)(s + (s >> 1)) * (16 * MiB) + (size_t)(pm * 4 + pn) * 65536; }
    __device__ __forceinline__ void operator()(EPI_ARGS) const {
        bf16_t* mg = (bf16_t*)(ws + WS_MG); const float* ss = (const float*)(ws + WS_SSA);
        const int sg = u.seg; unsigned lrow = (unsigned)(wr * 64 + fr), lcol = (unsigned)(wc * 32 + 8 * fq);
        asm volatile("" : "+v"(lrow), "+v"(lcol));
        const unsigned lb = (lrow * DM + lcol) * 2u, lg = (unsigned)((wr * 4 + wc) * 8 * 1024 + (fq * 16 + fr) * 16);
        unsigned char* gp = gtile(sg < 3 ? sg : sg - 3, u.pm, u.pn);
        if (sg < 3) {
            const float* bg = bgate + sg * DM + u.pn * 256;
            f32x4 bv[2][2];
#pragma unroll
            for (int bj = 0; bj < 2; ++bj) { bv[bj][0] = *(const f32x4*)bo(bg, (lcol + bj * 128u) * 4u) * (-LOG2E); bv[bj][1] = *(const f32x4*)bo(bg, (lcol + bj * 128u + 4u) * 4u) * (-LOG2E); }
            float rs[2][4]; rstd8(rs, ss, u.pm, lrow);
#pragma unroll
            for (int ai = 0; ai < 2; ++ai)
#pragma unroll
                for (int m = 0; m < 4; ++m) { const float rn = rs[ai][m] * (-LOG2E); u32x4 w;
#pragma unroll
                    for (int bj = 0; bj < 2; ++bj)
#pragma unroll
                        for (int n = 0; n < 2; ++n) { const f32x4 x = acc[ai][bj][m][n] * rn + bv[bj][n];
                            unsigned q[4];
#pragma unroll
                            for (int e = 0; e < 4; ++e) q[e] = (unsigned)(__builtin_amdgcn_rcpf(1.0f + __builtin_amdgcn_exp2f(x[e])) * 255.0f + 0.5f);
                            w[bj * 2 + n] = q[0] | (q[1] << 8) | (q[2] << 16) | (q[3] << 24); }
                    *(u32x4*)bo(gp, lg + (unsigned)((ai * 4 + m) * 1024)) = w; }
        } else {
            bf16_t* mp = mg + (size_t)u.pm * 256 * DM + u.pn * 256;
#pragma unroll
            for (int ai = 0; ai < 2; ++ai) {
                u32x4 gw_[4], pw_[4][2];
#pragma unroll
                for (int mm = 0; mm < 4; ++mm) { gw_[mm] = *(const u32x4*)bo((const unsigned char*)gp, lg + (unsigned)((ai * 4 + mm) * 1024));
#pragma unroll
                    for (int bj = 0; bj < 2; ++bj) if (sg > 3) pw_[mm][bj] = *(const u32x4*)bo((const bf16_t*)mp, lb + (unsigned)(ai * 128 + mm * 16) * DM * 2u + bj * 256u); }
#pragma unroll
                for (int mm = 0; mm < 4; ++mm)
#pragma unroll
                    for (int bj = 0; bj < 2; ++bj) { const unsigned o = lb + (unsigned)(ai * 128 + mm * 16) * DM * 2u + bj * 256u; const unsigned g0 = gw_[mm][bj * 2], g1 = gw_[mm][bj * 2 + 1]; constexpr float s = 1.0f / 255.0f;
                        f32x4 v0 = acc[ai][bj][mm][0] * ((f32x4){(float)(g0 & 255u), (float)((g0 >> 8) & 255u), (float)((g0 >> 16) & 255u), (float)(g0 >> 24)} * s);
                        f32x4 v1 = acc[ai][bj][mm][1] * ((f32x4){(float)(g1 & 255u), (float)((g1 >> 8) & 255u), (float)((g1 >> 16) & 255u), (float)(g1 >> 24)} * s);
                        if (sg > 3) { const u32x4 p = pw_[mm][bj]; v0 += (f32x4){bf_lo(p.x), bf_hi(p.x), bf_lo(p.y), bf_hi(p.y)}; v1 += (f32x4){bf_lo(p.z), bf_hi(p.z), bf_lo(p.w), bf_hi(p.w)}; }
                        st_bf16x8(bo(mp, o), v0, v1); }
                asm volatile("" ::: "memory");
            }
        }
    }
};
struct EpiRes {
    unsigned char* ws; int toA; LAS float* red;
    __device__ __forceinline__ void operator()(EPI_ARGS) const {
        bf16_t* xb = (bf16_t*)(ws + WS_XB); float* sso = (float*)(ws + (toA ? WS_SSA : WS_SSB));
        unsigned lrow = (unsigned)(wr * 64 + fr), lcol = (unsigned)(wc * 32 + 8 * fq);
        asm volatile("" : "+v"(lrow), "+v"(lcol));
        const unsigned le = (lrow * DM + lcol) * 2u, lr4 = lrow * 4u + (unsigned)wc;
        bf16_t* xp = xb + (size_t)u.pm * 256 * DM + u.pn * 256;
#pragma unroll
        for (int ai = 0; ai < 2; ++ai) {
            u32x4 bs[4][2];
#pragma unroll
            for (int m = 0; m < 4; ++m)
#pragma unroll
                for (int bj = 0; bj < 2; ++bj) bs[m][bj] = *(const u32x4*)bo((const bf16_t*)xp, le + (unsigned)(ai * 128 + m * 16) * DM * 2u + bj * 256u);
#pragma unroll
            for (int m = 0; m < 4; ++m) { float sq = 0.f;
#pragma unroll
                for (int bj = 0; bj < 2; ++bj) { const u32x4 w = bs[m][bj];
                    const f32x4 x0 = (f32x4){bf_lo(w.x), bf_hi(w.x), bf_lo(w.y), bf_hi(w.y)} + acc[ai][bj][m][0], x1 = (f32x4){bf_lo(w.z), bf_hi(w.z), bf_lo(w.w), bf_hi(w.w)} + acc[ai][bj][m][1];
                    st_bf16x8(bo(xp, le + (unsigned)(ai * 128 + m * 16) * DM * 2u + bj * 256u), x0, x1);
                    sq += (x0[0] * x0[0] + x0[1] * x0[1]) + (x0[2] * x0[2] + x0[3] * x0[3]) + (x1[0] * x1[0] + x1[1] * x1[1]) + (x1[2] * x1[2] + x1[3] * x1[3]); }
                sq += xshfl<16>(sq); sq = sum32(sq);
                if (fq == 0) red[lr4 + (unsigned)(ai * 128 + m * 16) * 4u] = sq; }
            asm volatile("" ::: "memory");
        }
        asm volatile("s_waitcnt lgkmcnt(0)\n\ts_barrier" ::: "memory");
        { const int t = ((wr * 4 + wc) * 4 + fq) * 16 + fr; if (t < 256) { const f32x4 r = *(const LAS f32x4*)(red + t * 4); sso[((size_t)u.pm * 256 + t) * 4 + u.pn] = (r.x + r.y) + (r.z + r.w); } }
        asm volatile("s_waitcnt lgkmcnt(0)\n\ts_barrier" ::: "memory");
    }
};
struct EpiFfn {
    unsigned char* ws;
    __device__ __forceinline__ void operator()(EPI_ARGS) const {
        bf16_t* act = (bf16_t*)(ws + WS_ACT); const float* ss = (const float*)(ws + WS_SSB);
        unsigned lrow = (unsigned)(wr * 64 + fr), lcol = (unsigned)(wc * 32 + 8 * fq);
        asm volatile("" : "+v"(lrow), "+v"(lcol));
        const unsigned lb = (lrow * DFF + lcol) * 2u;
        bf16_t* ap = act + (size_t)u.pm * 256 * DFF + u.pn * 128;
        float rs[2][4]; rstd8(rs, ss, u.pm, lrow);
#pragma unroll
        for (int ai = 0; ai < 2; ++ai)
#pragma unroll
            for (int m = 0; m < 4; ++m) { const float r1 = rs[ai][m], rn = r1 * (-LOG2E); f32x4 v[2];
#pragma unroll
                for (int n = 0; n < 2; ++n) { const f32x4 g = acc[ai][0][m][n], up = acc[ai][1][m][n] * (r1 * r1);
#pragma unroll
                    for (int e = 0; e < 4; ++e) v[n][e] = g[e] * up[e] * __builtin_amdgcn_rcpf(1.0f + __builtin_amdgcn_exp2f(g[e] * rn)); }
                st_bf16x8(bo(ap, lb + (unsigned)(ai * 128 + m * 16) * DFF * 2u), v[0], v[1]); }
    }
};

struct GCfg {
    int mode;
    int N, nseg, lda, ldb, nt, toA;
    const bf16_t* A; const bf16_t* B;
    unsigned char* ws; unsigned char* wb; const float* bgate; LAS float* red;
};
struct ProbAny {
    const GCfg* c;
    __device__ __forceinline__ void seg(const pg8::Unit& u, pg8::Seg& s) const {
        if (c->mode == 1 && u.seg >= 3) {
            const int br = u.seg - 3; const bf16_t* O = (const bf16_t*)(c->ws + WS_QA + (size_t)br * (48 * MiB)); const bf16_t* Wp = (const bf16_t*)(c->wb + (WS_WP - WS_WIN));
            s.A = (const char*)(O + (size_t)u.pm * 256 * BW); s.B = (const char*)(Wp + ((size_t)br * DM + (size_t)u.pn * 256) * BW);
            s.hA = 128u * BW * 2u; s.hB = 128u * BW * 2u; s.lda = BW; s.ldb = BW; s.nt = BW / 64;
        } else {
            const int so = (c->mode == 1) ? u.seg * DM : 0;
            s.A = (const char*)(c->A + (size_t)u.pm * 256 * c->lda); s.B = (const char*)(c->B + ((size_t)so + (size_t)u.pn * 256) * c->ldb);
            s.hA = 128u * (unsigned)c->lda * 2u; s.hB = 128u * (unsigned)c->ldb * 2u; s.lda = c->lda; s.ldb = c->ldb; s.nt = c->nt;
        }
    }
};
struct EpiAny {
    const GCfg* c;
    __device__ __forceinline__ void operator()(EPI_ARGS) const {
        const int m_ = c->mode;
        if (m_ == 0) EpiIn{c->ws}(acc, u, wr, wc, fr, fq);
        else if (m_ == 1) EpiC1{c->ws, c->bgate}(acc, u, wr, wc, fr, fq);
        else if (m_ == 2) EpiRes{c->ws, c->toA, c->red}(acc, u, wr, wc, fr, fq);
        else EpiFfn{c->ws}(acc, u, wr, wc, fr, fq);
    }
};

namespace att {
__device__ __forceinline__ constexpr int crow(int r, int hi) { return (r & 3) + 8 * (r >> 2) + 4 * hi; }
__device__ __forceinline__ float swap_lo(float x, float& hiv) { auto rr = __builtin_amdgcn_permlane32_swap(__float_as_uint(x), __float_as_uint(x), false, false); hiv = __uint_as_float(rr[1]); return __uint_as_float(rr[0]); }
__device__ __forceinline__ s16x4 vtr(const LAS unsigned char* p) { return __builtin_bit_cast(s16x4, __builtin_amdgcn_ds_read_tr16_b64_v4i16((LAS s16x4*)p)); }
__device__ __forceinline__ void load_k(bf16x8 (&kf)[8], const bf16_t* Kh, int j0, int r32, int hi) {
    const bf16_t* p = Kh + (size_t)(j0 >> 5) * 2048 + hi * 256 + r32 * 8;
#pragma unroll
    for (int d0 = 0; d0 < 4; ++d0) { kf[2 * d0] = *(const bf16x8*)(p + d0 * 512); kf[2 * d0 + 1] = *(const bf16x8*)(p + 2048 + d0 * 512); }
}
__device__ __forceinline__ void dma_v(LAS unsigned char* vbuf, const bf16_t* Vh, int j0, int lane) {
    const bf16_t* p = Vh + (size_t)(j0 >> 6) * 4096 + lane * 8;
#pragma unroll
    for (int i = 0; i < 8; ++i) __builtin_amdgcn_global_load_lds((const unsigned*)(p + i * 512), (LAS unsigned*)(vbuf + i * 1024), 16, 0, 0);
}
__device__ __forceinline__ void load_v(u32x4 (&vv)[8], const bf16_t* Vh, int j0, int lane) {
    const bf16_t* p = Vh + (size_t)(j0 + (lane >> 3)) * BW + (lane & 7) * 8;
#pragma unroll
    for (int i = 0; i < 8; ++i) vv[i] = *(const u32x4*)(p + (size_t)(8 * i) * BW);
}
__device__ __forceinline__ void stage_v(LAS unsigned char* vst, const u32x4 (&vv)[8], int lane) {
    const int c = lane & 7;
#pragma unroll
    for (int i = 0; i < 8; ++i) { const int key = 8 * i + (lane >> 3);
        *(LAS u32x4*)(vst + ((c >> 2) * 4 + (key >> 4)) * 1024 + (key & 15) * 64 + (c & 3) * 16) = vv[i]; }
}
__device__ __forceinline__ void qk(f32x16& p0, f32x16& p1, const bf16x8 (&kf)[8], const bf16x8 (&qr)[4]) {
#pragma unroll
    for (int d0 = 0; d0 < 4; ++d0) { p0 = __builtin_amdgcn_mfma_f32_32x32x16_bf16(kf[2 * d0], qr[d0], p0, 0, 0, 0); p1 = __builtin_amdgcn_mfma_f32_32x32x16_bf16(kf[2 * d0 + 1], qr[d0], p1, 0, 0, 0); }
}
__device__ __forceinline__ void pv(f32x16& o0, f32x16& o1, const f32x16& p0, const f32x16& p1, const LAS unsigned char* vst, int lane) {
    const int hi = lane >> 5;
    const LAS unsigned char* vp = vst + ((lane >> 4) & 1) * 32 + (lane & 3) * 8 + (4 * hi + ((lane & 15) >> 2)) * 64;
    u32x4 pw[4];
    pw[0] = (u32x4){cvt_pk_bf16(p0[0], p0[1]), cvt_pk_bf16(p0[2], p0[3]), cvt_pk_bf16(p0[4], p0[5]), cvt_pk_bf16(p0[6], p0[7])};
    pw[1] = (u32x4){cvt_pk_bf16(p0[8], p0[9]), cvt_pk_bf16(p0[10], p0[11]), cvt_pk_bf16(p0[12], p0[13]), cvt_pk_bf16(p0[14], p0[15])};
    pw[2] = (u32x4){cvt_pk_bf16(p1[0], p1[1]), cvt_pk_bf16(p1[2], p1[3]), cvt_pk_bf16(p1[4], p1[5]), cvt_pk_bf16(p1[6], p1[7])};
    pw[3] = (u32x4){cvt_pk_bf16(p1[8], p1[9]), cvt_pk_bf16(p1[10], p1[11]), cvt_pk_bf16(p1[12], p1[13]), cvt_pk_bf16(p1[14], p1[15])};
#pragma unroll
    for (int ks = 0; ks < 4; ++ks) {
        const s16x4 a0 = vtr(vp + ks * 1024), a1 = vtr(vp + ks * 1024 + 512), b0 = vtr(vp + 4096 + ks * 1024), b1 = vtr(vp + 4096 + ks * 1024 + 512);
        const bf16x8 v0 = {a0[0], a0[1], a0[2], a0[3], a1[0], a1[1], a1[2], a1[3]}, v1 = {b0[0], b0[1], b0[2], b0[3], b1[0], b1[1], b1[2], b1[3]};
        const bf16x8 pa = __builtin_bit_cast(bf16x8, pw[ks]);
        o0 = __builtin_amdgcn_mfma_f32_32x32x16_bf16(pa, v0, o0, 0, 0, 0);
        o1 = __builtin_amdgcn_mfma_f32_32x32x16_bf16(pa, v1, o1, 0, 0, 0);
    }
}
__device__ __forceinline__ void store_o(bf16_t* Ow, const f32x16& o0, const f32x16& o1, const float (&rsc)[16], LAS unsigned char* stg, int lane) {
    const int r32 = lane & 31, hi = lane >> 5;
    LAS bf16_t* s = (LAS bf16_t*)stg;
#pragma unroll
    for (int r = 0; r < 16; ++r) { const int orow = crow(r, hi);
        s[orow * 64 + r32] = (bf16_t)(cvt_pk_bf16(o0[r] * rsc[r], 0.f) & 0xffffu); s[orow * 64 + 32 + r32] = (bf16_t)(cvt_pk_bf16(o1[r] * rsc[r], 0.f) & 0xffffu); }
    LDS_WAIT();
#pragma unroll
    for (int i = 0; i < 4; ++i) { const int row = i * 8 + (lane >> 3), ch = lane & 7; const u32x4 v = *(const LAS u32x4*)(stg + row * 128 + ch * 16); *(u32x4*)(Ow + (size_t)row * BW + ch * 8) = v; }
    LDS_WAIT();
}

__device__ __forceinline__ void sb_item(bf16_t* Q, const bf16_t* K, const bf16_t* V, int b, int h, int q0, LAS unsigned char* vst, int lane) {
    asm volatile("" : "+v"(lane));
    const int r32 = lane & 31, hi = lane >> 5;
    const size_t rowbase = (size_t)b * SEQ;
    bf16_t* Qw = Q + (rowbase + q0) * BW + h * HD;
    bf16x8 qr[4];
#pragma unroll
    for (int d0 = 0; d0 < 4; ++d0) qr[d0] = *(const bf16x8*)(Qw + (size_t)r32 * BW + d0 * 16 + hi * 8);
    const bf16_t* Kh = K + (size_t)(b * NH + h) * SEQ * HD; const bf16_t* Vh = V + (size_t)(b * NH + h) * SEQ * HD;
    f32x16 o0 = {}, o1 = {}; float A2 = 0.f;
    const int tq = q0 + r32;
    bf16x8 kf[8]; load_k(kf, Kh, ((q0 + 30) >> 6) * 64, r32, hi); dma_v(vst + (((q0 + 30) >> 6) & 1) * 8192, Vh, ((q0 + 30) >> 6) * 64, lane);
    for (int kt = (q0 + 30) >> 6; kt >= 0; --kt) {
        const int j0 = kt * 64;
        f32x16 p0 = {}, p1 = {};
        qk(p0, p1, kf, qr);
        asm volatile("" : "+v"(p0), "+v"(p1) :: "memory");
        LAS unsigned char* vcur = vst + (kt & 1) * 8192;
        if (kt > 0) { dma_v(vst + ((kt - 1) & 1) * 8192, Vh, j0 - 64, lane); load_k(kf, Kh, j0 - 64, r32, hi); }
        const bool diag = (j0 + 63 >= q0);
        f32x16 l0, l1;
#pragma unroll
        for (int r = 0; r < 16; ++r) {
            { const float z = p0[r]; const float t = __builtin_amdgcn_exp2f(-__builtin_fabsf(z)); float l = -(__builtin_fmaxf(z, 0.f) + __builtin_amdgcn_logf(1.0f + t)); if (diag && (j0 + crow(r, hi) >= tq)) l = 0.f; l0[r] = l; }
            { const float z = p1[r]; const float t = __builtin_amdgcn_exp2f(-__builtin_fabsf(z)); float l = -(__builtin_fmaxf(z, 0.f) + __builtin_amdgcn_logf(1.0f + t)); if (diag && (j0 + 32 + crow(r, hi) >= tq)) l = 0.f; l1[r] = l; }
        }
        float carry = A2;
#pragma unroll
        for (int half = 1; half >= 0; --half) {
            f32x16& l = half ? l1 : l0; f32x16& p = half ? p1 : p0;
            float T[4];
#pragma unroll
            for (int g = 0; g < 4; ++g) { l[4 * g + 2] += l[4 * g + 3]; l[4 * g + 1] += l[4 * g + 2]; l[4 * g] += l[4 * g + 1]; T[g] = l[4 * g]; }
            float Tl[4], Th[4];
#pragma unroll
            for (int g = 0; g < 4; ++g) Tl[g] = swap_lo(T[g], Th[g]);
            float E = carry;
#pragma unroll
            for (int g = 3; g >= 0; --g) { const float eh = E; E += Th[g]; const float el = E; E += Tl[g]; const float off = hi ? eh : el;
                l[4 * g] += off; l[4 * g + 1] += off; l[4 * g + 2] += off; l[4 * g + 3] += off; }
            carry = E;
#pragma unroll
            for (int r = 0; r < 16; ++r) { float w = __builtin_amdgcn_exp2f(p[r] + l[r]); if (diag && (j0 + 32 * half + crow(r, hi) >= tq)) w = 0.f; p[r] = w; }
        }
        A2 = carry;
        if (kt > 0) asm volatile("s_waitcnt vmcnt(16)" ::: "memory"); else asm volatile("s_waitcnt vmcnt(0)" ::: "memory");
        pv(o0, o1, p0, p1, vcur, lane);
        LDS_WAIT();
        if (__all(A2 < -150.2f)) break;
    }
    float one[16];
#pragma unroll
    for (int r = 0; r < 16; ++r) one[r] = 1.0f;
    store_o(Qw, o0, o1, one, vst, lane);
}

constexpr float MOBA_THR = 8.0f;
__device__ __forceinline__ unsigned moba_gate(const bf16_t* Qw, const bf16_t* Kown, int blk, int tq0, float sl2, const LAS float* km, const LAS float* kbn, int lane) {
    asm volatile("" : "+v"(lane));
    const int r32 = lane & 31, hi = lane >> 5;
    unsigned sel = 0u;
    if (blk > 0) {
        float qf[64];
        { const u32x4* qp = (const u32x4*)(Qw + (size_t)r32 * BW);
#pragma unroll
          for (int c = 0; c < 8; ++c) { const u32x4 x = qp[c]; qf[8 * c] = bf_lo(x.x); qf[8 * c + 1] = bf_hi(x.x); qf[8 * c + 2] = bf_lo(x.y); qf[8 * c + 3] = bf_hi(x.y); qf[8 * c + 4] = bf_lo(x.z); qf[8 * c + 5] = bf_hi(x.z); qf[8 * c + 6] = bf_lo(x.w); qf[8 * c + 7] = bf_hi(x.w); } }
        float v1 = -INFINITY, v2 = -INFINITY, v3 = -INFINITY; int i1 = -1, i2 = -1, i3 = -1;
#define TOP_INS(v, n) do { const bool b1 = (v) > v1 || ((v) == v1 && (n) < i1), b2 = (v) > v2 || ((v) == v2 && (n) < i2), b3 = (v) > v3 || ((v) == v3 && (n) < i3); \
            if (b3) { if (b2) { v3 = v2; i3 = i2; if (b1) { v2 = v1; i2 = i1; v1 = (v); i1 = (n); } else { v2 = (v); i2 = (n); } } else { v3 = (v); i3 = (n); } } } while (0)
#pragma unroll 1
        for (int i = 0; i < 16; ++i) { const int n = 16 * hi + i;
            const LAS f32x4* kr = (const LAS f32x4*)(km + n * 64); float d0 = 0.f, d1 = 0.f, d2 = 0.f, d3 = 0.f;
#pragma unroll
            for (int c = 0; c < 16; ++c) { const f32x4 kk = kr[c]; d0 += qf[4 * c] * kk[0]; d1 += qf[4 * c + 1] * kk[1]; d2 += qf[4 * c + 2] * kk[2]; d3 += qf[4 * c + 3] * kk[3]; }
            const float d = (d0 + d1) + (d2 + d3);
            if (n < blk) TOP_INS(d, n); }
        { float x0, x1; x0 = swap_lo(v1, x1); const float pv1 = hi ? x0 : x1; x0 = swap_lo(v2, x1); const float pv2 = hi ? x0 : x1; x0 = swap_lo(v3, x1); const float pv3 = hi ? x0 : x1;
          x0 = swap_lo(__int_as_float(i1), x1); const int pi1 = __float_as_int(hi ? x0 : x1); x0 = swap_lo(__int_as_float(i2), x1); const int pi2 = __float_as_int(hi ? x0 : x1); x0 = swap_lo(__int_as_float(i3), x1); const int pi3 = __float_as_int(hi ? x0 : x1);
          TOP_INS(pv1, pi1); TOP_INS(pv2, pi2); TOP_INS(pv3, pi3); }
#undef TOP_INS
        float qn2 = 0.f, zs = 0.f;
        { const int tk = tq0 + r32; const bf16_t* kp = Kown + (size_t)(tk >> 5) * 2048 + (tk & 31) * 8;
#pragma unroll
          for (int c = 0; c < 8; ++c) { const u32x4 x = *(const u32x4*)(kp + c * 256);
              zs += qf[8 * c] * bf_lo(x.x) + qf[8 * c + 1] * bf_hi(x.x) + qf[8 * c + 2] * bf_lo(x.y) + qf[8 * c + 3] * bf_hi(x.y) + qf[8 * c + 4] * bf_lo(x.z) + qf[8 * c + 5] * bf_hi(x.z) + qf[8 * c + 6] * bf_lo(x.w) + qf[8 * c + 7] * bf_hi(x.w);
              qn2 += (qf[8 * c] * qf[8 * c] + qf[8 * c + 1] * qf[8 * c + 1]) + (qf[8 * c + 2] * qf[8 * c + 2] + qf[8 * c + 3] * qf[8 * c + 3]) + (qf[8 * c + 4] * qf[8 * c + 4] + qf[8 * c + 5] * qf[8 * c + 5]) + (qf[8 * c + 6] * qf[8 * c + 6] + qf[8 * c + 7] * qf[8 * c + 7]); } }
        const float qn = sqrtf(qn2) * 1.001f, thr = zs - 151.0f; const int tq = tq0 + r32;
#define KEEP(i_) ((i_) >= 0 && !(qn * kbn[(i_)] - sl2 * (float)(tq - (256 * (i_) + 255)) < thr))
        if (KEEP(i1)) sel |= 1u << i1; if (KEEP(i2)) sel |= 1u << i2; if (KEEP(i3)) sel |= 1u << i3;
#undef KEEP
    }
    return sel;
}
__device__ __forceinline__ void moba_tile(f32x16& o0, f32x16& o1, float& mrow, float& lsum, const bf16x8 (&qr)[4], bf16x8 (&kf)[8], const bf16_t* Kh, const bf16_t* Vh, int j0, int jn, float lb, float sl2, bool diag, int tq,
                                          LAS unsigned char* vst, LAS float* wsf, int lane) {
    const int r32 = lane & 31, hi = lane >> 5;
    f32x16 p0, p1;
#pragma unroll
    for (int r = 0; r < 16; ++r) { p0[r] = lb; p1[r] = lb + 32.0f * sl2; }
    qk(p0, p1, kf, qr);
    asm volatile("" : "+v"(p0), "+v"(p1) :: "memory");
    LAS unsigned char* vcur = vst + ((j0 >> 6) & 1) * 8192;
    if (jn >= 0) { dma_v(vst + ((jn >> 6) & 1) * 8192, Vh, jn, lane); load_k(kf, Kh, jn, r32, hi); }
#pragma unroll
    for (int r = 0; r < 16; ++r) { p0[r] = __builtin_fmaf(sl2, (float)crow(r, 0), p0[r]); p1[r] = __builtin_fmaf(sl2, (float)crow(r, 0), p1[r]); }
    if (diag) {
#pragma unroll
        for (int r = 0; r < 16; ++r) { if (j0 + crow(r, hi) > tq) p0[r] = -INFINITY; if (j0 + 32 + crow(r, hi) > tq) p1[r] = -INFINITY; }
    }
    float rm = __builtin_fmaxf(p0[0], p1[0]);
#pragma unroll
    for (int r = 1; r < 16; ++r) rm = __builtin_fmaxf(rm, __builtin_fmaxf(p0[r], p1[r]));
    { float x1; const float x0 = swap_lo(rm, x1); rm = __builtin_fmaxf(x0, x1); }
    if (__any(rm > mrow + MOBA_THR)) {
        const float mn = __builtin_fmaxf(mrow, rm); const float f = __builtin_amdgcn_exp2f(mrow - mn); mrow = mn; lsum *= f;
        if (hi == 0) wsf[r32] = f;
        LDS_WAIT();
#pragma unroll
        for (int r = 0; r < 16; ++r) { const float fr_ = wsf[crow(r, hi)]; o0[r] *= fr_; o1[r] *= fr_; }
        LDS_WAIT();
    }
    float ps = 0.f;
#pragma unroll
    for (int r = 0; r < 16; ++r) { p0[r] = __builtin_amdgcn_exp2f(p0[r] - mrow); p1[r] = __builtin_amdgcn_exp2f(p1[r] - mrow); ps += p0[r] + p1[r]; }
    lsum += ps;
    if (jn >= 0) asm volatile("s_waitcnt vmcnt(16)" ::: "memory"); else asm volatile("s_waitcnt vmcnt(0)" ::: "memory");
    pv(o0, o1, p0, p1, vcur, lane);
    LDS_WAIT();
}
__device__ __forceinline__ void moba_item(const bf16_t* Q, const bf16_t* K, const bf16_t* V, int b, int h, int blk, int n, int tix, const LAS unsigned char* lists, const LAS unsigned* cnt,
                                          const LAS unsigned* selm, unsigned char* recO, float* recML, LAS unsigned char* vst, LAS float* wsf, LAS unsigned* trow, int lane) {
    asm volatile("" : "+v"(lane));
    const int r32 = lane & 31, hi = lane >> 5; const size_t rowbase = (size_t)b * SEQ; const bool own = (n == blk);
    int q; bool valid; unsigned slot;
    if (own) { q = 32 * tix + r32; valid = true; slot = (unsigned)q * 4u + 3u; }
    else { const int cn = (int)cnt[n]; const int p = 32 * tix + r32; valid = p < cn; q = (int)lists[n * 256 + (valid ? p : cn - 1)];
           slot = (unsigned)q * 4u + (unsigned)__builtin_popcount(selm[q] & ((1u << n) - 1u)); }
    if (hi == 0) trow[r32] = slot | (valid ? 0x80000000u : 0u);
    const int tq = blk * 256 + q;
    const bf16_t* Qrow = Q + (rowbase + tq) * BW + h * HD + hi * 8;
    bf16x8 qr[4];
#pragma unroll
    for (int d0 = 0; d0 < 4; ++d0) qr[d0] = *(const bf16x8*)(Qrow + d0 * 16);
    const bf16_t* Kh = K + (size_t)(b * NH + h) * SEQ * HD; const bf16_t* Vh = V + (size_t)(b * NH + h) * SEQ * HD;
    const float sl2 = __builtin_amdgcn_exp2f(-(float)(h + 1)) * LOG2E;
    f32x16 o0 = {}, o1 = {}; float mrow = -INFINITY, lsum = 0.f;
    const int ntile = own ? (tix >> 1) + 1 : 4;
    bf16x8 kf[8]; load_k(kf, Kh, n * 256, r32, hi); dma_v(vst + ((n * 4) & 1) * 8192, Vh, n * 256, lane);
#pragma unroll 1
    for (int i = 0; i < ntile; ++i) { const int j0 = n * 256 + i * 64;
        moba_tile(o0, o1, mrow, lsum, qr, kf, Kh, Vh, j0, i < ntile - 1 ? j0 + 64 : -1, sl2 * (float)(j0 + 4 * hi - tq), sl2, own && i == ntile - 1, tq, vst, wsf, lane); }
    { float x1; const float x0 = swap_lo(lsum, x1); lsum = x0 + x1; }
    if (hi == 0) { wsf[32 + r32] = lsum; if (valid) *(f32x2*)(recML + 2 * slot) = (f32x2){mrow, lsum}; }
    LDS_WAIT();
    LAS bf16_t* s = (LAS bf16_t*)vst;
#pragma unroll
    for (int r = 0; r < 16; ++r) { const int orow = crow(r, hi); const float rl = __builtin_amdgcn_rcpf(wsf[32 + orow]);
        s[orow * 64 + r32] = (bf16_t)(cvt_pk_bf16(o0[r] * rl, 0.f) & 0xffffu); s[orow * 64 + 32 + r32] = (bf16_t)(cvt_pk_bf16(o1[r] * rl, 0.f) & 0xffffu); }
    LDS_WAIT();
#pragma unroll
    for (int i = 0; i < 4; ++i) { const int row = i * 8 + (lane >> 3), ch = lane & 7; const unsigned tr = trow[row]; const u32x4 v = *(const LAS u32x4*)(vst + row * 128 + ch * 16);
        if (tr & 0x80000000u) *(u32x4*)(recO + (size_t)(tr & 0x7fffffffu) * 128 + ch * 16) = v; }
    LDS_WAIT();
}
__device__ __forceinline__ void moba_merge(bf16_t* Q, int b, int h, int blk, int w, const LAS unsigned* selm, const unsigned char* recO, const float* recML, LAS float* wsf, int lane) {
    asm volatile("" : "+v"(lane));
    const int r32 = lane & 31, hi = lane >> 5; const size_t rowbase = (size_t)b * SEQ; const int q0 = blk * 256 + w * 32;
    const int ql = w * 32 + r32; const int c = __builtin_popcount(selm[ql]);
    float mi[4], li[4]; float mx = -INFINITY;
#pragma unroll
    for (int k = 0; k < 4; ++k) { mi[k] = -INFINITY; li[k] = 0.f; if (k == 3 || k < c) { const f32x2 ml = __builtin_nontemporal_load((const f32x2*)(recML + 2 * ((unsigned)ql * 4u + k))); mi[k] = ml.x; li[k] = ml.y; } mx = __builtin_fmaxf(mx, mi[k]); }
    float wg[4], L = 0.f;
#pragma unroll
    for (int k = 0; k < 4; ++k) { wg[k] = (k == 3 || k < c) ? __builtin_amdgcn_exp2f(mi[k] - mx) * li[k] : 0.f; L += wg[k]; }
    const float rL = 1.0f / L;
    if (hi == 0) { wsf[r32] = wg[0] * rL; wsf[32 + r32] = wg[1] * rL; wsf[64 + r32] = wg[2] * rL; wsf[96 + r32] = wg[3] * rL; }
    LDS_WAIT();
    bf16_t* Qw = Q + (rowbase + q0) * BW + h * HD;
#pragma unroll
    for (int i = 0; i < 4; ++i) { const int row = i * 8 + (lane >> 3), ch = lane & 7; f32x4 v0 = {0.f, 0.f, 0.f, 0.f}, v1 = {0.f, 0.f, 0.f, 0.f};
        const unsigned rslot = (unsigned)(w * 32 + row) * 4u;
#pragma unroll
        for (int k = 0; k < 4; ++k) { const float ak = wsf[32 * k + row];
            if (ak != 0.f) { const u32x4 pw = __builtin_nontemporal_load((const u32x4*)(recO + (size_t)(rslot + k) * 128 + ch * 16));
                v0 += ak * (f32x4){bf_lo(pw.x), bf_hi(pw.x), bf_lo(pw.y), bf_hi(pw.y)}; v1 += ak * (f32x4){bf_lo(pw.z), bf_hi(pw.z), bf_lo(pw.w), bf_hi(pw.w)}; } }
        st_bf16x8(Qw + (size_t)row * BW + ch * 8, v0, v1); }
    LDS_WAIT();
}
}

#define XB_TMO      128
#define XB_XCNT(j)  (256  + 64 * (j))
#define XB_XSUB(j)  (1280 + 64 * (j))
#define XB_XGEN(j)  (2304 + 64 * (j))
#define XB_TOP      3328
#define XB_TOPGEN   3392
#define XCD_BAR_WORDS 3456
#define XB_SPIN_CAP (1u << 18)
__device__ __forceinline__ unsigned xb_ld(unsigned* p)              { return __hip_atomic_load(p, __ATOMIC_RELAXED, __HIP_MEMORY_SCOPE_AGENT); }
__device__ __forceinline__ unsigned xb_add(unsigned* p, unsigned v) { return __hip_atomic_fetch_add(p, v, __ATOMIC_RELAXED, __HIP_MEMORY_SCOPE_AGENT); }
__device__ __forceinline__ unsigned xb_xcc_id() { return (unsigned)__builtin_amdgcn_s_getreg((3 << 11) | 20) & 0xFu; }
#define XB_SPIN(cond, bar) do { unsigned _sp = 0; while (cond) { __builtin_amdgcn_s_sleep(1); \
    if ((++_sp & 255u) == 0u) { if (xb_ld(&(bar)[XB_TMO])) break; if (_sp > XB_SPIN_CAP) { atomicAdd(&(bar)[XB_TMO], 1u); break; } } } } while (0)
struct XcdBarrier { unsigned* bar; unsigned x; volatile LAS unsigned* st; };
__device__ __forceinline__ XcdBarrier xcd_barrier_post(unsigned* bar, volatile LAS unsigned* st) {
    XcdBarrier b; b.bar = bar; b.x = xb_xcc_id(); b.st = st;
    if (threadIdx.x == 0) (void)xb_add(&bar[XB_XCNT(b.x)], 1u);
    return b;
}
__device__ __forceinline__ void xcd_barrier_complete(unsigned* bar, unsigned x, unsigned& nloc, unsigned& nx) {
    const unsigned G = gridDim.x * gridDim.y * gridDim.z;
    unsigned sum, cnt, mine, sp = 0u;
    for (;;) {
        sum = 0u; cnt = 0u; mine = 0u;
#pragma unroll
        for (unsigned j = 0; j < 16; ++j) { const unsigned c = xb_ld(&bar[XB_XCNT(j)]); sum += c; cnt += (c > 0u) ? 1u : 0u; mine = (j == x) ? c : mine; }
        if (sum == G) break;
        __builtin_amdgcn_s_sleep(1);
        if ((++sp & 255u) == 0u) { if (xb_ld(&bar[XB_TMO])) break; if (sp > XB_SPIN_CAP) { atomicAdd(&bar[XB_TMO], 1u); break; } }
    }
    nloc = mine > 0u ? mine : 1u; nx = cnt > 0u ? cnt : 1u;
}
__device__ __forceinline__ void xcd_barrier(const XcdBarrier& b, int tid_) {
    asm volatile("s_waitcnt vmcnt(0)" ::: "memory");
    __syncthreads();
    if (tid_ == 0) {
        unsigned* bar = b.bar;
        __builtin_amdgcn_s_waitcnt(0);
        unsigned nloc = b.st[0], nx = b.st[1];
        if (nloc == 0u) { xcd_barrier_complete(bar, b.x, nloc, nx); b.st[0] = nloc; b.st[1] = nx; }
        const unsigned old = xb_add(&bar[XB_XSUB(b.x)], 1u);
        const unsigned gen = old / nloc;
        if (old + 1u == (gen + 1u) * nloc) {
            __builtin_amdgcn_fence(__ATOMIC_RELEASE, "agent");
            asm volatile("s_waitcnt vmcnt(0)" ::: "memory");
            const unsigned og = xb_add(&bar[XB_TOP], 1u);
            const unsigned tg = og / nx;
            if (og + 1u == (tg + 1u) * nx) xb_add(&bar[XB_TOPGEN], 1u);
            else XB_SPIN(xb_ld(&bar[XB_TOPGEN]) == tg, bar);
            __builtin_amdgcn_fence(__ATOMIC_ACQUIRE, "agent");
            xb_add(&bar[XB_XGEN(b.x)], 1u);
            asm volatile("s_waitcnt vmcnt(0)" ::: "memory");
        } else {
            XB_SPIN(xb_ld(&bar[XB_XGEN(b.x)]) == gen, bar);
            __builtin_amdgcn_fence(__ATOMIC_ACQUIRE, "agent");
            asm volatile("s_waitcnt vmcnt(0)" ::: "memory");
        }
    }
    __syncthreads();
}

__device__ __forceinline__ float wave_sum(float v) {
#pragma unroll
    for (int o = 1; o < 64; o <<= 1) v += __shfl_xor(v, o);
    return v;
}
struct TrD { const float* src; const float* gain; bf16_t* dst; int ldw, ldt; };
__device__ __forceinline__ void tr_load(const TrD& d, f32x4 (&v)[8], float (&g)[8], int lane) {
    const int c4 = lane & 7, r0 = lane >> 3;
#pragma unroll
    for (int i = 0; i < 8; ++i) { const int row = 8 * i + r0; v[i] = *(const GAS f32x4*)((const GAS float*)d.src + (size_t)row * d.ldw + 4 * c4); g[i] = d.gain ? ((const GAS float*)d.gain)[row] : 1.0f; }
}
__device__ __forceinline__ void tr_store(const TrD& d, const f32x4 (&v)[8], const float (&g)[8], LAS float* scr, int lane) {
    const int c4 = lane & 7, r0 = lane >> 3;
#pragma unroll
    for (int i = 0; i < 8; ++i) { LAS float* s = scr + (8 * i + r0) * 33 + 4 * c4; s[0] = v[i][0] * g[i]; s[1] = v[i][1] * g[i]; s[2] = v[i][2] * g[i]; s[3] = v[i][3] * g[i]; }
    LDS_WAIT(); asm volatile("" ::: "memory");
    const int c = lane & 7;
#pragma unroll
    for (int j = 0; j < 4; ++j) { const int n = (lane >> 3) + 8 * j; const LAS float* s = scr + (8 * c) * 33 + n;
        u32x4 o; o.x = cvt_pk_bf16(s[0 * 33], s[1 * 33]); o.y = cvt_pk_bf16(s[2 * 33], s[3 * 33]); o.z = cvt_pk_bf16(s[4 * 33], s[5 * 33]); o.w = cvt_pk_bf16(s[6 * 33], s[7 * 33]);
        *(GAS u32x4*)((GAS bf16_t*)d.dst + (size_t)n * d.ldt + 8 * c) = o; }
    LDS_WAIT(); asm volatile("" ::: "memory");
}
constexpr int I_IN = (DM / 64) * (NIN / 32), I_P = (BW / 64) * (DM / 32), I_O = (DM / 64) * (DM / 32), I_G = (DM / 64) * (DFF / 32), I_D = (DFF / 64) * (DM / 32);
constexpr int NITEMS = I_IN + 3 * I_P + I_O + 2 * I_G + I_D;
struct Args { const float* in[14]; float* out; unsigned char* ws; };
__device__ __forceinline__ void tr_decode(int it, TrD& d, const Args& A, int layer, unsigned char* wb) {
    int r = it;
    if (r < I_IN) { const int nblk = NIN / 32, kb = r / nblk, c0 = 32 * (r % nblk); size_t doff;
        if (c0 < 3072) doff = (size_t)c0 * DM * 2;
        else if (c0 < 3584) doff = (size_t)(3072 + 256 * ((c0 - 3072) >> 7) + ((c0 - 3072) & 127)) * DM * 2;
        else if (c0 < 4096) doff = (size_t)(4096 + (c0 - 3584)) * DM * 2;
        else if (c0 < 4608) doff = (size_t)(3072 + 256 * ((c0 - 4096) >> 7) + 128 + ((c0 - 4096) & 127)) * DM * 2;
        else doff = (WS_WG - WS_WIN) + (size_t)(c0 - 4608) * DM * 2;
        d.src = A.in[2] + (size_t)layer * DM * NIN + (size_t)(64 * kb) * NIN + c0; d.gain = A.in[1] + (size_t)layer * DM + 64 * kb; d.dst = (bf16_t*)(wb + doff) + 64 * kb; d.ldw = NIN; d.ldt = DM; return; }
    r -= I_IN;
    if (r < I_P) { const int nblk = DM / 32, kb = r / nblk, c0 = 32 * (r % nblk);
        d.src = A.in[5] + (size_t)layer * BW * DM + (size_t)(64 * kb) * DM + c0; d.gain = nullptr; d.dst = (bf16_t*)(wb + (WS_WP - WS_WIN)) + (size_t)c0 * BW + 64 * kb; d.ldw = DM; d.ldt = BW; return; }
    r -= I_P;
    if (r < I_P) { const int nblk = DM / 32, kb = r / nblk, c0 = 32 * (r % nblk);
        d.src = A.in[6] + (size_t)layer * BW * DM + (size_t)(64 * kb) * DM + c0; d.gain = nullptr; d.dst = (bf16_t*)(wb + (WS_WP - WS_WIN)) + (size_t)DM * BW + (size_t)c0 * BW + 64 * kb; d.ldw = DM; d.ldt = BW; return; }
    r -= I_P;
    if (r < I_P) { const int nblk = DM / 32, kb = r / nblk, c0 = 32 * (r % nblk);
        d.src = A.in[7] + (size_t)layer * BW * DM + (size_t)(64 * kb) * DM + c0; d.gain = nullptr; d.dst = (bf16_t*)(wb + (WS_WP - WS_WIN)) + (size_t)2 * DM * BW + (size_t)c0 * BW + 64 * kb; d.ldw = DM; d.ldt = BW; return; }
    r -= I_P;
    if (r < I_O) { const int nblk = DM / 32, kb = r / nblk, c0 = 32 * (r % nblk);
        d.src = A.in[8] + (size_t)layer * DM * DM + (size_t)(64 * kb) * DM + c0; d.gain = nullptr; d.dst = (bf16_t*)(wb + (WS_WO - WS_WIN)) + (size_t)c0 * DM + 64 * kb; d.ldw = DM; d.ldt = DM; return; }
    r -= I_O;
    if (r < I_G) { const int nblk = DFF / 32, kb = r / nblk, c0 = 32 * (r % nblk);
        d.src = A.in[10] + (size_t)layer * DM * DFF + (size_t)(64 * kb) * DFF + c0; d.gain = A.in[9] + (size_t)layer * DM + 64 * kb; d.dst = (bf16_t*)(wb + (WS_WGU - WS_WIN)) + (size_t)(256 * (c0 >> 7) + (c0 & 127)) * DM + 64 * kb; d.ldw = DFF; d.ldt = DM; return; }
    r -= I_G;
    if (r < I_G) { const int nblk = DFF / 32, kb = r / nblk, c0 = 32 * (r % nblk);
        d.src = A.in[11] + (size_t)layer * DM * DFF + (size_t)(64 * kb) * DFF + c0; d.gain = A.in[9] + (size_t)layer * DM + 64 * kb; d.dst = (bf16_t*)(wb + (WS_WGU - WS_WIN)) + (size_t)(256 * (c0 >> 7) + 128 + (c0 & 127)) * DM + 64 * kb; d.ldw = DFF; d.ldt = DM; return; }
    r -= I_G;
    { const int nblk = DM / 32, kb = r / nblk, c0 = 32 * (r % nblk);
      d.src = A.in[12] + (size_t)layer * DFF * DM + (size_t)(64 * kb) * DM + c0; d.gain = nullptr; d.dst = (bf16_t*)(wb + (WS_WD - WS_WIN)) + (size_t)c0 * DFF + 64 * kb; d.ldw = DM; d.ldt = DFF; }
}


__global__ void __launch_bounds__(NWAVES * 64, 2) hybrid_fwd(Args args) {
    extern __shared__ __attribute__((aligned(16))) unsigned char lds_raw[];
    LAS unsigned char* lds = (LAS unsigned char*)lds_raw;
    volatile LAS unsigned* MISC = (volatile LAS unsigned*)(lds + MISC_OFF);
    const int wave = __builtin_amdgcn_readfirstlane((int)threadIdx.x >> 6);
    const int G = gridDim.x, bx = blockIdx.x, vcu = (G % 8 == 0) ? (bx % 8) * (G / 8) + bx / 8 : bx;
    for (int i = threadIdx.x; i < (LDS_BYTES - LDSCTL_OFF) / 4; i += NWAVES * 64) ((LAS unsigned*)(lds + LDSCTL_OFF))[i] = 0u;
    __syncthreads();
    XcdBarrier bar = xcd_barrier_post((unsigned*)(args.ws + WS_CTL) + CW_BAR, MISC + 8);
    const int gw = vcu * NWAVES + wave, NGW = G * NWAVES;

    for (int pq = 0; pq < DEPTH * 7 + 1; ++pq) {
        const int layer = pq / 7, ph = pq - 7 * layer;
        int tid = wave * 64 + lane_id(); asm volatile("" : "+v"(tid)); const int lane = tid & 63;
        size_t opq = 0; asm volatile("" : "+s"(opq));
        unsigned char* ws = args.ws + opq; const float* x_in = args.in[0] + opq; float* out = args.out + opq;
        float* ssA = (float*)(ws + WS_SSA); float* ssB = (float*)(ws + WS_SSB); float* kmp = (float*)(ws + WS_KM);
        bf16_t* xb = (bf16_t*)(ws + WS_XB);
        bf16_t* QA = (bf16_t*)(ws + WS_QA); bf16_t* KA = (bf16_t*)(ws + WS_KA); bf16_t* VA = (bf16_t*)(ws + WS_VA);
        bf16_t* QS = (bf16_t*)(ws + WS_QS); bf16_t* KS = (bf16_t*)(ws + WS_KS); bf16_t* VS = (bf16_t*)(ws + WS_VS);
        bf16_t* Ub = (bf16_t*)(ws + WS_U); bf16_t* BC = (bf16_t*)(ws + WS_BC); bf16_t* MG = (bf16_t*)(ws + WS_MG); bf16_t* ACT = (bf16_t*)(ws + WS_ACT);

        if (layer == DEPTH) {
            const float* gf = args.in[13];
            for (int m = gw; m < M; m += NGW) {
                const float rs = rstd_row(ssA, m);
                f32x4* xr = (f32x4*)(out + (size_t)m * DM) + lane; const f32x4* gr = (const f32x4*)gf + lane; const u32x2* xs = (const u32x2*)(xb + (size_t)m * DM) + lane;
#pragma unroll
                for (int j = 0; j < 4; ++j) { const u32x2 w = xs[64 * j]; const f32x4 v = {bf_lo(w.x), bf_hi(w.x), bf_lo(w.y), bf_hi(w.y)}, g = gr[64 * j]; xr[64 * j] = v * rs * g; }
            }
            if (xb_ld((unsigned*)(ws + WS_CTL) + CW_BAR + XB_TMO) != 0u && bx == 0) { for (int i = tid; i < 4096; i += NWAVES * 64) out[i] = __builtin_nanf(""); }
            break;
        }
        if (ph == 0) {
            LAS float* scr = (LAS float*)(lds + RING_OFF + wave * 16384);
            {
                constexpr int NIT2 = NITEMS; unsigned char* wb_ = layer == 0 ? ws + WS_WIN : (unsigned char*)out;
#define TR_DEC(i_, d_) tr_decode(i_, d_, args, layer, wb_)
                int it = gw;
                for (; it + NGW < NIT2; it += 2 * NGW) {
                    TrD da, db; f32x4 va[8], vb[8]; float ga[8], gb[8];
                    TR_DEC(it, da); tr_load(da, va, ga, lane);
                    TR_DEC(it + NGW, db); tr_load(db, vb, gb, lane);
                    tr_store(da, va, ga, scr, lane); tr_store(db, vb, gb, scr, lane);
                }
                if (it < NIT2) { TrD da; f32x4 va[8]; float ga[8]; TR_DEC(it, da); tr_load(da, va, ga, lane); tr_store(da, va, ga, scr, lane); }
#undef TR_DEC
            }
            if (layer == 0) {
                for (int m = gw; m < M; m += NGW) {
                    const f32x4* xr = (const f32x4*)(x_in + (size_t)m * DM) + lane; f32x4 v[4]; float s = 0.f;
#pragma unroll
                    for (int j = 0; j < 4; ++j) { v[j] = xr[64 * j]; s += (v[j].x * v[j].x + v[j].y * v[j].y) + (v[j].z * v[j].z + v[j].w * v[j].w); }
                    s = wave_sum(s);
                    u32x2* o8 = (u32x2*)(xb + (size_t)m * DM) + lane;
#pragma unroll
                    for (int j = 0; j < 4; ++j) o8[64 * j] = (u32x2){cvt_pk_bf16(v[j].x, v[j].y), cvt_pk_bf16(v[j].z, v[j].w)};
                    if (lane < 4) ssA[(size_t)m * 4 + lane] = (lane == 0) ? s : 0.f;
                }
            }
        } else if (ph == 2) {
            LAS unsigned char* vst = lds + RING_OFF + wave * 16384;
            LAS float* wsf = (LAS float*)(lds + ATT_OFF + wave * 512);
            LAS float* km = (LAS float*)(lds + ATT_OFF + 4096);
            LAS unsigned* selm = (LAS unsigned*)(lds + ATT_OFF + 12288);
            LAS unsigned* cnt = (LAS unsigned*)(lds + ATT_OFF + 13312);
            LAS float* kbn = (LAS float*)(lds + ATT_OFF + 13312 + 256);
            LAS unsigned* uslot = (LAS unsigned*)(lds + ATT_OFF + 13312 + 512);
            LAS unsigned char* lists = lds + ATT_OFF + 14336;
            LAS unsigned* trow = (LAS unsigned*)(lds + ATT_OFF + 22528 + wave * 128);
            unsigned char* recO = ws + WS_MG + (size_t)vcu * 131072; float* recML = (float*)(ws + WS_X + (size_t)vcu * 8192);
            unsigned* qctr = (unsigned*)(ws + WS_CTL) + 8192 + layer * 64;
            unsigned* ndone = (unsigned*)(ws + WS_CTL) + 8192 + 128 + layer * 1024;
            float* kbmax = (float*)((unsigned*)(ws + WS_CTL) + 8192 + 4096 + layer * 512);
            for (;;) {
                if (tid == 0) *uslot = __hip_atomic_fetch_add(qctr, 1u, __ATOMIC_RELAXED, __HIP_MEMORY_SCOPE_AGENT);
                __syncthreads();
                const unsigned uq = *uslot;
                __syncthreads();
                if (uq >= 1792u) break;
                if (uq >= 1536u) {
                    const float* cw = args.in[4] + (size_t)layer * 3 * BW;
#pragma unroll 1
                    for (int k8 = 0; k8 < 8; ++k8) { const int i = (int)(uq - 1536u) * 4096 + k8 * (NWAVES * 64) + tid;
                        const int t = i >> 6, c = (i & 63) * 8; const int tt = t & (SEQ - 1);
                        const u32x4 u2 = *(const u32x4*)(Ub + (size_t)t * BW + c);
                        u32x4 u1 = {0u, 0u, 0u, 0u}, u0 = {0u, 0u, 0u, 0u};
                        if (tt >= 1) u1 = *(const u32x4*)(Ub + (size_t)(t - 1) * BW + c);
                        if (tt >= 2) u0 = *(const u32x4*)(Ub + (size_t)(t - 2) * BW + c);
                        const u32x4 bw = *(const u32x4*)(BC + (size_t)t * BW + c);
                        float y[8];
#pragma unroll
                        for (int e = 0; e < 4; ++e) {
                            const float w0l = cw[c + 2 * e], w0h = cw[c + 2 * e + 1], w1l = cw[BW + c + 2 * e], w1h = cw[BW + c + 2 * e + 1], w2l = cw[2 * BW + c + 2 * e], w2h = cw[2 * BW + c + 2 * e + 1];
                            y[2 * e] = bf_lo(bw[e]) * (w0l * bf_lo(u0[e]) + w1l * bf_lo(u1[e]) + w2l * bf_lo(u2[e]));
                            y[2 * e + 1] = bf_hi(bw[e]) * (w0h * bf_hi(u0[e]) + w1h * bf_hi(u1[e]) + w2h * bf_hi(u2[e]));
                        }
                        *(u32x4*)(BC + (size_t)t * BW + c) = (u32x4){cvt_pk_bf16(y[0], y[1]), cvt_pk_bf16(y[2], y[3]), cvt_pk_bf16(y[4], y[5]), cvt_pk_bf16(y[6], y[7])}; }
                    continue;
                }
                if (uq < 512u) {
                    const int bh = (int)(uq >> 5), n = (int)(uq & 31u), b = bh >> 3, h = bh & 7;
                    const int key_ = n * 256 + (tid >> 1); const bf16_t* kp = KA + (size_t)(b * NH + h) * SEQ * HD + (size_t)(key_ >> 5) * 2048 + (tid & 1) * 1024 + (key_ & 31) * 8;
                    float sq = 0.f;
#pragma unroll
                    for (int c = 0; c < 4; ++c) { const u32x4 x = *(const u32x4*)(kp + c * 256); const float e0 = bf_lo(x.x), e1 = bf_hi(x.x), e2 = bf_lo(x.y), e3 = bf_hi(x.y), e4 = bf_lo(x.z), e5 = bf_hi(x.z), e6 = bf_lo(x.w), e7 = bf_hi(x.w);
                        sq += (e0 * e0 + e1 * e1) + (e2 * e2 + e3 * e3) + (e4 * e4 + e5 * e5) + (e6 * e6 + e7 * e7); }
                    sq += xshfl<1>(sq);
                    sq = __builtin_fmaxf(sq, xshfl<2>(sq)); sq = __builtin_fmaxf(sq, xshfl<4>(sq)); sq = __builtin_fmaxf(sq, xshfl<8>(sq)); sq = __builtin_fmaxf(sq, xshfl<16>(sq));
                    { float x1; const float x0 = att::swap_lo(sq, x1); sq = __builtin_fmaxf(x0, x1); }
                    if (lane == 0) kbn[wave] = sq;
                    __syncthreads();
                    if (tid == 0) { float m_ = kbn[0];
#pragma unroll
                        for (int w_ = 1; w_ < NWAVES; ++w_) m_ = __builtin_fmaxf(m_, kbn[w_]);
                        __hip_atomic_store(kbmax + bh * 32 + n, m_, __ATOMIC_RELAXED, __HIP_MEMORY_SCOPE_AGENT);
                        asm volatile("s_waitcnt vmcnt(0)" ::: "memory");
                        __hip_atomic_fetch_add(ndone + bh * 64, 1u, __ATOMIC_RELAXED, __HIP_MEMORY_SCOPE_AGENT); }
                    __syncthreads();
                } else if (uq < 1024u) {
                    const unsigned um = uq - 512u; const int h = 7 - (int)(um >> 6), blk = 31 - (int)((um & 63u) >> 1), b = (int)(um & 1u);
                    for (int i = tid; i < 2048; i += NWAVES * 64) { const int n = i >> 6, d = i & 63; const size_t o = (size_t)((b * 32 + n) * 2) * BW + h * HD + d; km[i] = kmp[o] + kmp[o + BW]; }
                    if (tid == 0) {
                        unsigned sp_ = 0; while (__hip_atomic_load(ndone + (b * 8 + h) * 64, __ATOMIC_RELAXED, __HIP_MEMORY_SCOPE_AGENT) < 32u) { __builtin_amdgcn_s_sleep(2);
                            if (++sp_ > (1u << 20)) { atomicAdd((unsigned*)(ws + WS_CTL) + CW_BAR + XB_TMO, 1u); break; } } }
                    __syncthreads();
                    if (tid < 32) kbn[tid] = sqrtf(__hip_atomic_load(kbmax + (b * 8 + h) * 32 + tid, __ATOMIC_RELAXED, __HIP_MEMORY_SCOPE_AGENT)) * 1.01f;
                    __syncthreads();
                    const float sl2 = __builtin_amdgcn_exp2f(-(float)(h + 1)) * LOG2E;
                    const size_t qrow = (size_t)b * SEQ + blk * 256 + wave * 32;
                    const unsigned sel = att::moba_gate(QA + qrow * BW + h * HD, KA + (size_t)(b * NH + h) * SEQ * HD, blk, blk * 256 + wave * 32, sl2, km, kbn, lane);
                    if (lane < 32) selm[wave * 32 + lane] = sel;
                    __syncthreads();
                    for (int n = wave; n < blk; n += NWAVES) {
                        unsigned pos = 0;
#pragma unroll
                        for (int c = 0; c < 4; ++c) { const int q = 64 * c + lane; const bool bit = (selm[q] >> n) & 1u; const unsigned long long mk = __ballot(bit);
                            if (bit) lists[n * 256 + pos + __builtin_amdgcn_mbcnt_hi((unsigned)(mk >> 32), __builtin_amdgcn_mbcnt_lo((unsigned)mk, 0u))] = (unsigned char)q;
                            pos += (unsigned)__builtin_popcountll(mk); }
                        if (lane == 0) cnt[n] = pos;
                    }
                    __syncthreads();
                    { int n = blk, t = wave; int nn = 0, tt = 0, idp = 0;
                      for (;;) {
                          att::moba_item(QA, KA, VA, b, h, blk, n, t, lists, cnt, selm, recO, recML, vst, wsf, trow, lane);
                          bool found = false;
                          while (nn < blk) { const int nt_ = ((int)cnt[nn] + 31) >> 5;
                              if (tt < nt_) { const bool mine = (idp & (NWAVES - 1)) == wave; if (mine) { n = nn; t = tt; found = true; } ++tt; ++idp; if (mine) break; }
                              else { ++nn; tt = 0; } }
                          if (!found) break;
                      } }
                    VM_WAIT();
                    __syncthreads();
                    att::moba_merge(QA, b, h, blk, wave, selm, recO, recML, wsf, lane);
                    __syncthreads();
                } else {
                    const unsigned us = uq - 1024u; const int h = (int)(us >> 6), blk = (int)((us & 63u) >> 1), b = (int)(us & 1u);
                    att::sb_item(QS, KS, VS, b, h, blk * 256 + wave * 32, vst, lane);
                }
            }
        } else {
            static_assert(WS_QS - WS_QA == 48 * MiB && WS_BC - WS_QS == 48 * MiB && WS_VA - WS_KA == 16 * MiB && WS_KS - WS_KA == 48 * MiB, "O_a / O_s / O_c 48 MiB apart; gate scratch = K_a | V_a | K_s");
            GCfg c{};
            c.ws = ws; c.wb = layer == 0 ? ws + WS_WIN : (unsigned char*)out; c.bgate = args.in[3] + (size_t)layer * NGATE; c.red = (LAS float*)(lds + LDSCTL_OFF + 1024);
            c.nseg = 1; c.lda = DM; c.ldb = DM; c.nt = DM / 64; c.toA = 0;
            if (ph == 1) { c.mode = 0; c.N = N1; c.A = xb; c.B = (const bf16_t*)c.wb; }
            else if (ph == 3) { c.mode = 1; c.N = DM; c.nseg = 6; c.A = xb; c.B = (const bf16_t*)(c.wb + (WS_WG - WS_WIN)); }
            else if (ph == 4) { c.mode = 2; c.N = DM; c.A = MG; c.B = (const bf16_t*)(c.wb + (WS_WO - WS_WIN)); }
            else if (ph == 5) { c.mode = 3; c.N = NGU; c.A = xb; c.B = (const bf16_t*)(c.wb + (WS_WGU - WS_WIN)); }
            else { c.mode = 2; c.N = DM; c.A = ACT; c.B = (const bf16_t*)(c.wb + (WS_WD - WS_WIN)); c.lda = DFF; c.ldb = DFF; c.nt = DFF / 64; c.toA = 1; }
            ProbAny P{&c}; EpiAny E{&c}; pg8::StaticOrder S; S.init(M, c.N, G, bx, c.nseg);
            pg8::gemm_phase(lds + RING_OFF, P, S, E, wave);
        }
        if (!(ph == 6 && layer + 1 < DEPTH)) xcd_barrier(bar, tid);
    }
}

extern "C" void kernel_launch(void* const* d_in, const int* in_sizes, int n_in, void* d_out, int out_size, void* d_ws, size_t ws_size, hipStream_t stream) {
    static int grid = 0;
    if (grid == 0) {
        if (n_in != 14 || in_sizes[0] != M * DM || out_size != M * DM || ws_size < WS_END) { fprintf(stderr, "kernel_launch: unexpected shapes (n_in %d, in0 %d, out %d, ws %zu)\n", n_in, n_in > 0 ? in_sizes[0] : -1, out_size, ws_size); grid = -1; return; }
        int dev = 0, cus = 0, per_cu = 0;
        if (hipGetDevice(&dev) != hipSuccess || hipDeviceGetAttribute(&cus, hipDeviceAttributeMultiprocessorCount, dev) != hipSuccess) { grid = -1; return; }
        if (hipFuncSetAttribute((const void*)hybrid_fwd, hipFuncAttributeMaxDynamicSharedMemorySize, LDS_BYTES) != hipSuccess) { fprintf(stderr, "kernel_launch: hipFuncSetAttribute failed\n"); grid = -1; return; }
        if (hipOccupancyMaxActiveBlocksPerMultiprocessor(&per_cu, (const void*)hybrid_fwd, NWAVES * 64, LDS_BYTES) != hipSuccess || per_cu < 1) { fprintf(stderr, "kernel_launch: occupancy query says %d blocks/CU\n", per_cu); (void)hipGetLastError(); per_cu = 1; }
        grid = cus;
    }
    if (grid < 0) return;
    if (hipMemsetAsync((char*)d_ws + WS_CTL, 0, CTL_ZERO_BYTES, stream) != hipSuccess) { fprintf(stderr, "kernel_launch: memset failed\n"); return; }
    Args a{};
    for (int i = 0; i < 14; ++i) a.in[i] = (const float*)d_in[i];
    a.out = (float*)d_out; a.ws = (unsigned char*)d_ws;
    void* kargs[] = {&a};
    hipError_t e = hipLaunchCooperativeKernel((const void*)hybrid_fwd, dim3(grid), dim3(NWAVES * 64), kargs, LDS_BYTES, stream);
    if (e != hipSuccess) fprintf(stderr, "kernel_launch: cooperative launch failed: %s (grid %d)\n", hipGetErrorString(e), grid);
}
```

```cpp
#include <hip/hip_runtime.h>
#include <hip/hip_bf16.h>
#include <cstdio>
#include <cstdint>

#define GAS __attribute__((address_space(1)))
#define LAS __attribute__((address_space(3)))
typedef unsigned short bf16_t;
typedef short bf16x8 __attribute__((ext_vector_type(8)));
typedef short s16x4 __attribute__((ext_vector_type(4)));
typedef float f32x2 __attribute__((ext_vector_type(2)));
typedef float f32x4 __attribute__((ext_vector_type(4)));
typedef float f32x16 __attribute__((ext_vector_type(16)));
typedef unsigned u32x2 __attribute__((ext_vector_type(2)));
typedef unsigned u32x4 __attribute__((ext_vector_type(4)));
typedef GAS unsigned gu32;

constexpr int BATCH = 2, SEQ = 8192, DM = 1024, M = BATCH * SEQ, NH = 8, HD = 64, BW = 512, DFF = 2816, DEPTH = 2;
constexpr int NIN = 7680, N1 = 4608, NGATE = 3072, NGU = 2 * DFF;
constexpr float RMS_EPS = 1e-6f;
constexpr float LOG2E = 1.4426950408889634f;
constexpr float C2 = 0.125f * LOG2E;
constexpr int NWAVES = 8;

constexpr size_t MiB = 1u << 20;
constexpr size_t WS_CTL = 0, CTL_ZERO_BYTES = 64 * 1024;
constexpr size_t WS_SSA = 1 * MiB, WS_SSB = 2 * MiB, WS_KM = 3 * MiB;
constexpr size_t WS_WIN = 4 * MiB, WS_WG = 13 * MiB, WS_WP = 19 * MiB, WS_WO = 22 * MiB, WS_WGU = 24 * MiB, WS_WD = 35 * MiB;
constexpr size_t WS_XB = 41 * MiB;
constexpr size_t WS_QA = 73 * MiB, WS_KA = 89 * MiB, WS_VA = 105 * MiB, WS_QS = 121 * MiB, WS_KS = 137 * MiB, WS_VS = 153 * MiB;
constexpr size_t WS_BC = 169 * MiB, WS_U = 185 * MiB, WS_MG = 201 * MiB, WS_X = 233 * MiB;
constexpr size_t WS_ACT = 73 * MiB;
constexpr size_t WS_END = 256 * MiB;
constexpr int CW_BAR = 4096;

constexpr int RING_OFF = 0, RING_BYTES = 131072;
constexpr int ATT_OFF = RING_BYTES, ATT_BYTES = 23552;
constexpr int LDSCTL_OFF = ATT_OFF + ATT_BYTES, MISC_OFF = LDSCTL_OFF + 320;
constexpr int LDS_BYTES = 163840;
static_assert(LDSCTL_OFF + 1024 + 4096 <= LDS_BYTES, "LDS map");

#define LDS_WAIT() asm volatile("s_waitcnt lgkmcnt(0)" ::: "memory")
#define VM_WAIT() asm volatile("s_waitcnt vmcnt(0)" ::: "memory")
#define RLX_AGENT __ATOMIC_RELAXED, __HIP_MEMORY_SCOPE_AGENT

typedef __bf16 bf16x2_t __attribute__((ext_vector_type(2)));
__device__ __forceinline__ unsigned cvt_pk_bf16(float lo, float hi) { const f32x2 v = {lo, hi}; const bf16x2_t b = __builtin_convertvector(v, bf16x2_t); return __builtin_bit_cast(unsigned, b); }
template <int O> __device__ __forceinline__ float xshfl(float x) {
    static_assert(O < 32, "use sum32 for the two 32-lane halves");
    return __int_as_float(__builtin_amdgcn_ds_swizzle(__float_as_int(x), (O << 10) | 0x1f));
}
__device__ __forceinline__ int lane_id() { return (int)__builtin_amdgcn_mbcnt_hi(~0u, __builtin_amdgcn_mbcnt_lo(~0u, 0u)); }
__device__ __forceinline__ float sum32(float x) { auto rr = __builtin_amdgcn_permlane32_swap(__float_as_uint(x), __float_as_uint(x), false, false); return __uint_as_float(rr[0]) + __uint_as_float(rr[1]); }
__device__ __forceinline__ float bf_lo(unsigned w) { return __uint_as_float(w << 16); }
__device__ __forceinline__ float bf_hi(unsigned w) { return __uint_as_float(w & 0xffff0000u); }
__device__ __forceinline__ float rstd_row(const float* ssp, int row) {
    const f32x4 a = *(const f32x4*)(ssp + (size_t)row * 4);
    return rsqrtf(((a.x + a.y) + (a.z + a.w)) * (1.0f / DM) + RMS_EPS);
}

namespace pg8 {
constexpr int BM = 256, BK = 64, HALF = 128, HTB = HALF * BK * 2, STAGE_BYTES = 8 * HTB, NXCD = 8, WGM = 8;
__host__ __device__ __forceinline__ int lds_byte(int r, int c) { const int st = (r >> 4) * 2 + (c >> 5), rr = r & 15, cc = c & 31, ob = rr * 64 + cc * 2; return st * 1024 + (ob ^ (((ob >> 9) & 1) << 5)); }
__host__ __device__ __forceinline__ void stage_rc(int b, int& R, int& C) { const int st = b / 1024, sb = b % 1024, swz = sb ^ (((sb >> 9) & 1) << 5); R = (st >> 1) * 16 + swz / 64; C = (st & 1) * 32 + (swz % 64) / 2; }
__host__ __device__ __forceinline__ int perm32(int rho) { const int n = rho >> 4, i = rho & 15; return 8 * (i >> 2) + 4 * n + (i & 3); }

struct Unit { int pm, pn, seg; };
struct Seg { const char* A; const char* B; unsigned hA, hB; int lda, ldb, nt; };

struct StaticOrder {
    int nM, nN, nwg, G, c, nseg;
    __device__ void init(int M_, int N_, int G_, int c_, int nseg_) { nM = M_ / BM; nN = N_ / BM; nwg = nM * nN; G = G_; c = c_; nseg = nseg_; }
    __device__ bool next(int i, Unit& u) const {
        const int ti = (nseg == 1) ? i : i / nseg; u.seg = i - ti * nseg;
        const long L = (long)ti * G + c; if (L >= nwg) return false;
        int wgid = (int)L; { const int q = nwg / NXCD, r = nwg % NXCD, xcd = wgid % NXCD, off = wgid / NXCD; wgid = (xcd < r ? xcd * (q + 1) : r * (q + 1) + (xcd - r) * q) + off; }
        const int nig = WGM * nN, gid = wgid / nig, fm = gid * WGM, gsz = (nM - fm) < WGM ? (nM - fm) : WGM;
        u.pm = fm + ((wgid % nig) % gsz); u.pn = (wgid % nig) / gsz; return true;
    }
};

template <class Prob, class Epi, class Sched>
__device__ __forceinline__ void gemm_phase(LAS unsigned char* lds, const Prob& P, const Sched& S, const Epi& E, int wave_) {
    int tid = wave_ * 64 + lane_id(); asm volatile("" : "+v"(tid));
    const int wid = wave_, lane = tid & 63, wr = wid >> 2, wc = wid & 3, fr = lane & 15, fq = lane >> 4;
#define PG8_RC(R0, C0, Rb0) int R0, C0; { int t_ = tid; asm volatile("" : "+v"(t_)); stage_rc(t_ * 16, R0, C0); } const int Rb0 = (R0 & ~31) + perm32(R0 & 31)
    const size_t kstep = (size_t)(BK * 2);
    const unsigned ldsw = (unsigned)wid * 1024u;
    const int aoff = lds_byte(wr * 64 + fr, fq * 8), boff = lds_byte(wc * 32 + fr, fq * 8);
#define PG8_SA(b, h) (((b) * 2 + (h)) * HTB)
#define PG8_SB(b, h) ((4 + (b) * 2 + (h)) * HTB)
#define PG8_STAGE(bufoff, gbase, v0, q) do { \
        __builtin_amdgcn_global_load_lds((const unsigned*)((const char*)(gbase) + (v0)), (LAS unsigned*)(lds + (bufoff) + ldsw), 16, 0, 0); \
        __builtin_amdgcn_global_load_lds((const unsigned*)((const char*)(gbase) + (q) + (v0)), (LAS unsigned*)(lds + (bufoff) + ldsw + 8192), 16, 0, 0); } while (0)
#define PG8_LDA(dst, b, h) do { _Pragma("unroll") for (int m = 0; m < 4; ++m) _Pragma("unroll") for (int k = 0; k < 2; ++k) dst[m][k] = *(const LAS bf16x8*)(lds + PG8_SA(b, h) + aoff + m * 2048 + k * 1024); } while (0)
#define PG8_LDB(dst, b, h) do { _Pragma("unroll") for (int n = 0; n < 2; ++n) _Pragma("unroll") for (int k = 0; k < 2; ++k) dst[n][k] = *(const LAS bf16x8*)(lds + PG8_SB(b, h) + boff + n * 2048 + k * 1024); } while (0)
#define PG8_MMA(ai, bj, At, Bt) do { __builtin_amdgcn_s_setprio(1); _Pragma("unroll") for (int m = 0; m < 4; ++m) _Pragma("unroll") for (int n = 0; n < 2; ++n) _Pragma("unroll") for (int k = 0; k < 2; ++k) \
        acc[ai][bj][m][n] = __builtin_amdgcn_mfma_f32_16x16x32_bf16(Bt[n][k], At[m][k], acc[ai][bj][m][n], 0, 0, 0); __builtin_amdgcn_s_setprio(0); } while (0)
#define PG8_WAIT_V(n) asm volatile("s_waitcnt vmcnt(" #n ")" ::: "memory")
#define PG8_WAIT_L(n) asm volatile("s_waitcnt lgkmcnt(" #n ")" ::: "memory")
#define PG8_BAR __builtin_amdgcn_s_barrier()
#define PG8_SCHED __builtin_amdgcn_sched_barrier(0)
    Unit cur, nxt; int ui = 0;
    if (!S.next(0, cur)) return;
    Seg sc, sn; P.seg(cur, sc);
    unsigned vAc0, vBc0; { PG8_RC(R0, C0, Rb0); vAc0 = (unsigned)(R0 * sc.lda + C0) * 2u; vBc0 = (unsigned)(Rb0 * sc.ldb + C0) * 2u; }
    f32x4 acc[2][2][4][2];
#pragma unroll
    for (int a = 0; a < 2; ++a)
#pragma unroll
        for (int b = 0; b < 2; ++b)
#pragma unroll
            for (int m = 0; m < 4; ++m)
#pragma unroll
                for (int n = 0; n < 2; ++n) acc[a][b][m][n] = (f32x4){0.f, 0.f, 0.f, 0.f};
    bf16x8 At[4][2], B0[2][2], B1[2][2];
    const char* cA = sc.A; const char* cB = sc.B;
    PG8_STAGE(PG8_SB(0, 0), cB, vBc0, sc.hB >> 1); PG8_STAGE(PG8_SB(0, 1), cB + sc.hB, vBc0, sc.hB >> 1); PG8_STAGE(PG8_SA(0, 0), cA, vAc0, sc.hA >> 1); PG8_STAGE(PG8_SA(0, 1), cA + sc.hA, vAc0, sc.hA >> 1);
    if (wr == 1) PG8_BAR;
    PG8_WAIT_V(2); PG8_BAR;
    PG8_STAGE(PG8_SB(1, 0), cB + kstep, vBc0, sc.hB >> 1); PG8_STAGE(PG8_SA(1, 0), cA + kstep, vAc0, sc.hA >> 1); PG8_STAGE(PG8_SB(1, 1), cB + sc.hB + kstep, vBc0, sc.hB >> 1);
    PG8_WAIT_V(6); PG8_BAR;
    for (;;) {
        const bool has_next = S.next(ui + 1, nxt);
        if (has_next) P.seg(nxt, sn); else sn = sc;
        unsigned vAn0, vBn0; { PG8_RC(R0, C0, Rb0); vAn0 = (unsigned)(R0 * sn.lda + C0) * 2u; vBn0 = (unsigned)(Rb0 * sn.ldb + C0) * 2u; }
        const char* nA = sn.A; const char* nB = sn.B;
        const int nt = sc.nt;
        for (int t = 0; t < nt; t += 2) {
            const bool last = (t == nt - 2);
            const char* a1 = cA + (size_t)(t + 1) * kstep;
            const char* a2 = last ? nA : cA + (size_t)(t + 2) * kstep; const char* b2 = last ? nB : cB + (size_t)(t + 2) * kstep;
            const char* a3 = a2 + kstep; const char* b3 = b2 + kstep;
            const unsigned hA2 = last ? sn.hA : sc.hA, hB2 = last ? sn.hB : sc.hB;
            const unsigned vA0 = last ? vAn0 : vAc0, vB0 = last ? vBn0 : vBc0, qA = hA2 >> 1, qB = hB2 >> 1;
            PG8_LDB(B0, 0, 0); PG8_LDB(B1, 0, 1); PG8_SCHED; PG8_LDA(At, 0, 0); PG8_STAGE(PG8_SA(1, 1), a1 + sc.hA, vAc0, sc.hA >> 1);
            PG8_WAIT_V(8); PG8_WAIT_L(0); PG8_BAR; PG8_MMA(0, 0, At, B0); PG8_MMA(0, 1, At, B1); PG8_BAR; PG8_SCHED;
            PG8_LDA(At, 0, 1); PG8_STAGE(PG8_SB(0, 0), b2, vB0, qB); PG8_STAGE(PG8_SB(0, 1), b2 + hB2, vB0, qB); PG8_STAGE(PG8_SA(0, 0), a2, vA0, qA);
            PG8_WAIT_V(8); PG8_WAIT_L(0); PG8_BAR; PG8_MMA(1, 0, At, B0); PG8_MMA(1, 1, At, B1); PG8_BAR; PG8_SCHED;
            PG8_LDB(B0, 1, 0); PG8_LDB(B1, 1, 1); PG8_SCHED; PG8_LDA(At, 1, 0); PG8_STAGE(PG8_SA(0, 1), a2 + hA2, vA0, qA);
            PG8_WAIT_V(8); PG8_WAIT_L(0); PG8_BAR; PG8_MMA(0, 0, At, B0); PG8_MMA(0, 1, At, B1); PG8_BAR; PG8_SCHED;
            PG8_LDA(At, 1, 1); PG8_STAGE(PG8_SB(1, 0), b3, vB0, qB); PG8_STAGE(PG8_SB(1, 1), b3 + hB2, vB0, qB); PG8_STAGE(PG8_SA(1, 0), a3, vA0, qA);
            PG8_WAIT_V(8); PG8_WAIT_L(0); PG8_BAR; PG8_MMA(1, 0, At, B0); PG8_MMA(1, 1, At, B1); PG8_BAR; PG8_SCHED;
        }
        if (wr == 0) PG8_BAR;
        { int wr_ = wr, wc_ = wc, t_ = tid;
          asm volatile("" : "+s"(wr_), "+s"(wc_), "+v"(t_)); const int fr_ = t_ & 15, fq_ = (t_ >> 4) & 3;
          E(acc, cur, wr_, wc_, fr_, fq_); }
        if (!has_next) break;
#pragma unroll
        for (int a = 0; a < 2; ++a)
#pragma unroll
            for (int b = 0; b < 2; ++b)
#pragma unroll
                for (int m = 0; m < 4; ++m)
#pragma unroll
                    for (int n = 0; n < 2; ++n) acc[a][b][m][n] = (f32x4){0.f, 0.f, 0.f, 0.f};
        cur = nxt; sc = sn; cA = nA; cB = nB; vAc0 = vAn0; vBc0 = vBn0; ++ui;
        if (wr == 1) PG8_BAR;
    }
    PG8_WAIT_V(0);
    PG8_BAR;
#undef PG8_SA
#undef PG8_SB
#undef PG8_STAGE
#undef PG8_LDA
#undef PG8_LDB
#undef PG8_MMA
#undef PG8_WAIT_V
#undef PG8_WAIT_L
#undef PG8_BAR
#undef PG8_SCHED
#undef PG8_RC
}
}

#define EPI_ARGS const f32x4 (&acc)[2][2][4][2], const pg8::Unit& u, int wr, int wc, int fr, int fq
__device__ __forceinline__ void st_bf16x8(bf16_t* p, f32x4 v0, f32x4 v1) {
    u32x4 w; w.x = cvt_pk_bf16(v0[0], v0[1]); w.y = cvt_pk_bf16(v0[2], v0[3]); w.z = cvt_pk_bf16(v1[0], v1[1]); w.w = cvt_pk_bf16(v1[2], v1[3]);
#ifdef SC1_STORES
    asm volatile("global_store_dwordx4 %0, %1, off sc1\n\ts_nop 1" :: "v"(p), "v"(w) : "memory");
#else
    *(u32x4*)p = w;
#endif
}
template <class T> __device__ __forceinline__ T* bo(T* base, unsigned byte_off) { return (T*)((char*)base + byte_off); }
template <class T> __device__ __forceinline__ const T* bo(const T* base, unsigned byte_off) { return (const T*)((const char*)base + byte_off); }
__device__ __forceinline__ void ld_bf16x8(const bf16_t* p, f32x4& v0, f32x4& v1) {
    const unsigned long long lo = __hip_atomic_load((const unsigned long long*)p, __ATOMIC_RELAXED, __HIP_MEMORY_SCOPE_AGENT), hi = __hip_atomic_load((const unsigned long long*)p + 1, __ATOMIC_RELAXED, __HIP_MEMORY_SCOPE_AGENT);
    const u32x4 w = {(unsigned)lo, (unsigned)(lo >> 32), (unsigned)hi, (unsigned)(hi >> 32)};
    v0 = (f32x4){bf_lo(w.x), bf_hi(w.x), bf_lo(w.y), bf_hi(w.y)}; v1 = (f32x4){bf_lo(w.z), bf_hi(w.z), bf_lo(w.w), bf_hi(w.w)};
}
__device__ __forceinline__ float rstd4(f32x4 a) { return rsqrtf(((a.x + a.y) + (a.z + a.w)) * (1.0f / DM) + RMS_EPS); }
__device__ __forceinline__ void rstd8(float (&rs)[2][4], const float* ss, int pm, unsigned lrow) {
    const float* ssb = ss + (size_t)pm * 256 * 4; unsigned lsb = lrow * 16u; asm volatile("" : "+v"(lsb));
    f32x4 t[2][4];
#pragma unroll
    for (int ai = 0; ai < 2; ++ai)
#pragma unroll
        for (int m = 0; m < 4; ++m) t[ai][m] = *(const f32x4*)bo(ssb, lsb + (unsigned)(ai * 128 + m * 16) * 16u);
#pragma unroll
    for (int ai = 0; ai < 2; ++ai)
#pragma unroll
        for (int m = 0; m < 4; ++m) rs[ai][m] = rstd4(t[ai][m]);
}
struct EpiIn {
    unsigned char* ws;
    __device__ __forceinline__ void operator()(EPI_ARGS) const {
        bf16_t* qkv = (bf16_t*)(ws + WS_QA); bf16_t* ub = (bf16_t*)(ws + WS_U); bf16_t* bc = (bf16_t*)(ws + WS_BC); float* kmp = (float*)(ws + WS_KM); const float* ss = (const float*)(ws + WS_SSA);
        const int pn = u.pn; unsigned lrow = (unsigned)(wr * 64 + fr), lcol = (unsigned)(wc * 32 + 8 * fq);
        asm volatile("" : "+v"(lrow), "+v"(lcol));
        const unsigned lb = (lrow * BW + lcol) * 2u;
        float rs[2][4]; rstd8(rs, ss, u.pm, lrow);
        if (pn < 12 || pn >= 16) {
            const int t = pn >> 1; const float sc = (t == 0 || t == 3) ? C2 : 1.0f;
            bf16_t* base = (pn < 12 ? qkv + (size_t)t * M * BW + (pn & 1) * 256 : bc + (pn - 16) * 256) + (size_t)u.pm * 256 * BW;
            if (t == 1) {
                float* kp = kmp + (size_t)(u.pm * 2 + wr) * BW + (pn & 1) * 256;
#pragma unroll
                for (int bj = 0; bj < 2; ++bj)
#pragma unroll
                    for (int n = 0; n < 2; ++n) { f32x4 s = {0.f, 0.f, 0.f, 0.f};
#pragma unroll
                        for (int ai = 0; ai < 2; ++ai)
#pragma unroll
                            for (int m = 0; m < 4; ++m) s += acc[ai][bj][m][n] * rs[ai][m];
#pragma unroll
                        for (int e = 0; e < 4; ++e) { s[e] += xshfl<1>(s[e]); s[e] += xshfl<2>(s[e]); s[e] += xshfl<4>(s[e]); s[e] += xshfl<8>(s[e]); }
                        if (fr == 0) *(f32x4*)bo(kp, (lcol + (unsigned)(bj * 128 + 4 * n)) * 4u) = s; }
            }
            if (t == 2 || t == 5) {
                bf16_t* vb = qkv + (size_t)t * M * BW + ((size_t)((u.pm >> 5) * 8 + (pn & 1) * 4) * SEQ + (size_t)(u.pm & 31) * 256) * HD;
                const unsigned fr_ = lrow & 15u, wr_ = lrow >> 6, hl = lcol >> 6, dd = lcol & 63u;
#pragma unroll
                for (int ai = 0; ai < 2; ++ai)
#pragma unroll
                    for (int m = 0; m < 4; ++m) { float f = rs[ai][m]; asm volatile("" : "+v"(f));
#pragma unroll
                        for (int bj = 0; bj < 2; ++bj) { const unsigned eo = (unsigned)(bj * 2 + hl) * (SEQ * HD) + ((wr_ + 2 * ai) * 4096 + ((dd >> 5) * 4 + m) * 512 + fr_ * 32 + (dd & 31u));
                            st_bf16x8(bo(vb, eo * 2u), acc[ai][bj][m][0] * f, acc[ai][bj][m][1] * f); } }
            } else if (t == 1 || t == 4) {
                bf16_t* kb = qkv + (size_t)t * M * BW + ((size_t)((u.pm >> 5) * 8 + (pn & 1) * 4) * SEQ + (size_t)(u.pm & 31) * 256) * HD;
                const unsigned fr_ = lrow & 15u, wr_ = lrow >> 6, hl = lcol >> 6, dch = (lcol & 63u) >> 3;
#pragma unroll
                for (int ai = 0; ai < 2; ++ai)
#pragma unroll
                    for (int m = 0; m < 4; ++m) { float f = rs[ai][m]; asm volatile("" : "+v"(f));
#pragma unroll
                        for (int bj = 0; bj < 2; ++bj) { const unsigned eo = (unsigned)(bj * 2 + hl) * (SEQ * HD) + (((wr_ * 2 + ai * 4 + (m >> 1)) * 8 + dch) * 256 + (fr_ + 16u * (m & 1)) * 8);
                            st_bf16x8(bo(kb, eo * 2u), acc[ai][bj][m][0] * f, acc[ai][bj][m][1] * f); } }
            } else {
#pragma unroll
            for (int ai = 0; ai < 2; ++ai)
#pragma unroll
                for (int m = 0; m < 4; ++m) { const float f = rs[ai][m] * sc; const unsigned o = lb + (unsigned)(ai * 128 + m * 16) * BW * 2u;
#pragma unroll
                    for (int bj = 0; bj < 2; ++bj) st_bf16x8(bo(base, o + bj * 256u), acc[ai][bj][m][0] * f, acc[ai][bj][m][1] * f); }
            }
        } else {
            bf16_t* base = ub + (size_t)u.pm * 256 * BW + (pn - 12) * 128;
#pragma unroll
            for (int ai = 0; ai < 2; ++ai)
#pragma unroll
                for (int m = 0; m < 4; ++m) { const float f = rs[ai][m] * rs[ai][m];
                    st_bf16x8(bo(base, lb + (unsigned)(ai * 128 + m * 16) * BW * 2u), acc[ai][0][m][0] * acc[ai][1][m][0] * f, acc[ai][0][m][1] * acc[ai][1][m][1] * f); }
        }
    }
};
struct EpiC1 {
    unsigned char* ws; const float* bgate;
    __device__ __forceinline__ unsigned char* gtile(int s, int pm, int pn) const { return ws + WS_KA + (size_t)(s + (s >> 1)) * (16 * MiB) + (size_t)(pm * 4 + pn) * 65536; }
    __device__ __forceinline__ void operator()(EPI_ARGS) const {
        bf16_t* mg = (bf16_t*)(ws + WS_MG); const float* ss = (const float*)(ws + WS_SSA);
        const int sg = u.seg; unsigned lrow = (unsigned)(wr * 64 + fr), lcol = (unsigned)(wc * 32 + 8 * fq);
        asm volatile("" : "+v"(lrow), "+v"(lcol));
        const unsigned lb = (lrow * DM + lcol) * 2u, lg = (unsigned)((wr * 4 + wc) * 8 * 1024 + (fq * 16 + fr) * 16);
        unsigned char* gp = gtile(sg < 3 ? sg : sg - 3, u.pm, u.pn);
        if (sg < 3) {
            const float* bg = bgate + sg * DM + u.pn * 256;
            f32x4 bv[2][2];
#pragma unroll
            for (int bj = 0; bj < 2; ++bj) { bv[bj][0] = *(const f32x4*)bo(bg, (lcol + bj * 128u) * 4u) * (-LOG2E); bv[bj][1] = *(const f32x4*)bo(bg, (lcol + bj * 128u + 4u) * 4u) * (-LOG2E); }
            float rs[2][4]; rstd8(rs, ss, u.pm, lrow);
#pragma unroll
            for (int ai = 0; ai < 2; ++ai)
#pragma unroll
                for (int m = 0; m < 4; ++m) { const float rn = rs[ai][m] * (-LOG2E); u32x4 w;
#pragma unroll
                    for (int bj = 0; bj < 2; ++bj)
#pragma unroll
                        for (int n = 0; n < 2; ++n) { const f32x4 x = acc[ai][bj][m][n] * rn + bv[bj][n];
                            unsigned q[4];
#pragma unroll
                            for (int e = 0; e < 4; ++e) q[e] = (unsigned)(__builtin_amdgcn_rcpf(1.0f + __builtin_amdgcn_exp2f(x[e])) * 255.0f + 0.5f);
                            w[bj * 2 + n] = q[0] | (q[1] << 8) | (q[2] << 16) | (q[3] << 24); }
                    *(u32x4*)bo(gp, lg + (unsigned)((ai * 4 + m) * 1024)) = w; }
        } else {
            bf16_t* mp = mg + (size_t)u.pm * 256 * DM + u.pn * 256;
#pragma unroll
            for (int ai = 0; ai < 2; ++ai) {
                u32x4 gw_[4], pw_[4][2];
#pragma unroll
                for (int mm = 0; mm < 4; ++mm) { gw_[mm] = *(const u32x4*)bo((const unsigned char*)gp, lg + (unsigned)((ai * 4 + mm) * 1024));
#pragma unroll
                    for (int bj = 0; bj < 2; ++bj) if (sg > 3) pw_[mm][bj] = *(const u32x4*)bo((const bf16_t*)mp, lb + (unsigned)(ai * 128 + mm * 16) * DM * 2u + bj * 256u); }
#pragma unroll
                for (int mm = 0; mm < 4; ++mm)
#pragma unroll
                    for (int bj = 0; bj < 2; ++bj) { const unsigned o = lb + (unsigned)(ai * 128 + mm * 16) * DM * 2u + bj * 256u; const unsigned g0 = gw_[mm][bj * 2], g1 = gw_[mm][bj * 2 + 1]; constexpr float s = 1.0f / 255.0f;
                        f32x4 v0 = acc[ai][bj][mm][0] * ((f32x4){(float)(g0 & 255u), (float)((g0 >> 8) & 255u), (float)((g0 >> 16) & 255u), (float)(g0 >> 24)} * s);
                        f32x4 v1 = acc[ai][bj][mm][1] * ((f32x4){(float)(g1 & 255u), (float)((g1 >> 8) & 255u), (float)((g1 >> 16) & 255u), (float)(g1 >> 24)} * s);
                        if (sg > 3) { const u32x4 p = pw_[mm][bj]; v0 += (f32x4){bf_lo(p.x), bf_hi(p.x), bf_lo(p.y), bf_hi(p.y)}; v1 += (f32x4){bf_lo(p.z), bf_hi(p.z), bf_lo(p.w), bf_hi(p.w)}; }
                        st_bf16x8(bo(mp, o), v0, v1); }
                asm volatile("" ::: "memory");
            }
        }
    }
};
struct EpiRes {
    unsigned char* ws; int toA; LAS float* red;
    __device__ __forceinline__ void operator()(EPI_ARGS) const {
        bf16_t* xb = (bf16_t*)(ws + WS_XB); float* sso = (float*)(ws + (toA ? WS_SSA : WS_SSB));
        unsigned lrow = (unsigned)(wr * 64 + fr), lcol = (unsigned)(wc * 32 + 8 * fq);
        asm volatile("" : "+v"(lrow), "+v"(lcol));
        const unsigned le = (lrow * DM + lcol) * 2u, lr4 = lrow * 4u + (unsigned)wc;
        bf16_t* xp = xb + (size_t)u.pm * 256 * DM + u.pn * 256;
#pragma unroll
        for (int ai = 0; ai < 2; ++ai) {
            u32x4 bs[4][2];
#pragma unroll
            for (int m = 0; m < 4; ++m)
#pragma unroll
                for (int bj = 0; bj < 2; ++bj) bs[m][bj] = *(const u32x4*)bo((const bf16_t*)xp, le + (unsigned)(ai * 128 + m * 16) * DM * 2u + bj * 256u);
#pragma unroll
            for (int m = 0; m < 4; ++m) { float sq = 0.f;
#pragma unroll
                for (int bj = 0; bj < 2; ++bj) { const u32x4 w = bs[m][bj];
                    const f32x4 x0 = (f32x4){bf_lo(w.x), bf_hi(w.x), bf_lo(w.y), bf_hi(w.y)} + acc[ai][bj][m][0], x1 = (f32x4){bf_lo(w.z), bf_hi(w.z), bf_lo(w.w), bf_hi(w.w)} + acc[ai][bj][m][1];
                    st_bf16x8(bo(xp, le + (unsigned)(ai * 128 + m * 16) * DM * 2u + bj * 256u), x0, x1);
                    sq += (x0[0] * x0[0] + x0[1] * x0[1]) + (x0[2] * x0[2] + x0[3] * x0[3]) + (x1[0] * x1[0] + x1[1] * x1[1]) + (x1[2] * x1[2] + x1[3] * x1[3]); }
                sq += xshfl<16>(sq); sq = sum32(sq);
                if (fq == 0) red[lr4 + (unsigned)(ai * 128 + m * 16) * 4u] = sq; }
            asm volatile("" ::: "memory");
        }
        asm volatile("s_waitcnt lgkmcnt(0)\n\ts_barrier" ::: "memory");
        { const int t = ((wr * 4 + wc) * 4 + fq) * 16 + fr; if (t < 256) { const f32x4 r = *(const LAS f32x4*)(red + t * 4); sso[((size_t)u.pm * 256 + t) * 4 + u.pn] = (r.x + r.y) + (r.z + r.w); } }
        asm volatile("s_waitcnt lgkmcnt(0)\n\ts_barrier" ::: "memory");
    }
};
struct EpiFfn {
    unsigned char* ws;
    __device__ __forceinline__ void operator()(EPI_ARGS) const {
        bf16_t* act = (bf16_t*)(ws + WS_ACT); const float* ss = (const float*)(ws + WS_SSB);
        unsigned lrow = (unsigned)(wr * 64 + fr), lcol = (unsigned)(wc * 32 + 8 * fq);
        asm volatile("" : "+v"(lrow), "+v"(lcol));
        const unsigned lb = (lrow * DFF + lcol) * 2u;
        bf16_t* ap = act + (size_t)u.pm * 256 * DFF + u.pn * 128;
        float rs[2][4]; rstd8(rs, ss, u.pm, lrow);
#pragma unroll
        for (int ai = 0; ai < 2; ++ai)
#pragma unroll
            for (int m = 0; m < 4; ++m) { const float r1 = rs[ai][m], rn = r1 * (-LOG2E); f32x4 v[2];
#pragma unroll
                for (int n = 0; n < 2; ++n) { const f32x4 g = acc[ai][0][m][n], up = acc[ai][1][m][n] * (r1 * r1);
#pragma unroll
                    for (int e = 0; e < 4; ++e) v[n][e] = g[e] * up[e] * __builtin_amdgcn_rcpf(1.0f + __builtin_amdgcn_exp2f(g[e] * rn)); }
                st_bf16x8(bo(ap, lb + (unsigned)(ai * 128 + m * 16) * DFF * 2u), v[0], v[1]); }
    }
};

struct GCfg {
    int mode;
    int N, nseg, lda, ldb, nt, toA;
    const bf16_t* A; const bf16_t* B;
    unsigned char* ws; unsigned char* wb; const float* bgate; LAS float* red;
};
struct ProbAny {
    const GCfg* c;
    __device__ __forceinline__ void seg(const pg8::Unit& u, pg8::Seg& s) const {
        if (c->mode == 1 && u.seg >= 3) {
            const int br = u.seg - 3; const bf16_t* O = (const bf16_t*)(c->ws + WS_QA + (size_t)br * (48 * MiB)); const bf16_t* Wp = (const bf16_t*)(c->wb + (WS_WP - WS_WIN));
            s.A = (const char*)(O + (size_t)u.pm * 256 * BW); s.B = (const char*)(Wp + ((size_t)br * DM + (size_t)u.pn * 256) * BW);
            s.hA = 128u * BW * 2u; s.hB = 128u * BW * 2u; s.lda = BW; s.ldb = BW; s.nt = BW / 64;
        } else {
            const int so = (c->mode == 1) ? u.seg * DM : 0;
            s.A = (const char*)(c->A + (size_t)u.pm * 256 * c->lda); s.B = (const char*)(c->B + ((size_t)so + (size_t)u.pn * 256) * c->ldb);
            s.hA = 128u * (unsigned)c->lda * 2u; s.hB = 128u * (unsigned)c->ldb * 2u; s.lda = c->lda; s.ldb = c->ldb; s.nt = c->nt;
        }
    }
};
struct EpiAny {
    const GCfg* c;
    __device__ __forceinline__ void operator()(EPI_ARGS) const {
        const int m_ = c->mode;
        if (m_ == 0) EpiIn{c->ws}(acc, u, wr, wc, fr, fq);
        else if (m_ == 1) EpiC1{c->ws, c->bgate}(acc, u, wr, wc, fr, fq);
        else if (m_ == 2) EpiRes{c->ws, c->toA, c->red}(acc, u, wr, wc, fr, fq);
        else EpiFfn{c->ws}(acc, u, wr, wc, fr, fq);
    }
};

namespace att {
__device__ __forceinline__ constexpr int crow(int r, int hi) { return (r & 3) + 8 * (r >> 2) + 4 * hi; }
__device__ __forceinline__ float swap_lo(float x, float& hiv) { auto rr = __builtin_amdgcn_permlane32_swap(__float_as_uint(x), __float_as_uint(x), false, false); hiv = __uint_as_float(rr[1]); return __uint_as_float(rr[0]); }
__device__ __forceinline__ s16x4 vtr(const LAS unsigned char* p) { return __builtin_bit_cast(s16x4, __builtin_amdgcn_ds_read_tr16_b64_v4i16((LAS s16x4*)p)); }
__device__ __forceinline__ void load_k(bf16x8 (&kf)[8], const bf16_t* Kh, int j0, int r32, int hi) {
    const bf16_t* p = Kh + (size_t)(j0 >> 5) * 2048 + hi * 256 + r32 * 8;
#pragma unroll
    for (int d0 = 0; d0 < 4; ++d0) { kf[2 * d0] = *(const bf16x8*)(p + d0 * 512); kf[2 * d0 + 1] = *(const bf16x8*)(p + 2048 + d0 * 512); }
}
__device__ __forceinline__ void dma_v(LAS unsigned char* vbuf, const bf16_t* Vh, int j0, int lane) {
    const bf16_t* p = Vh + (size_t)(j0 >> 6) * 4096 + lane * 8;
#pragma unroll
    for (int i = 0; i < 8; ++i) __builtin_amdgcn_global_load_lds((const unsigned*)(p + i * 512), (LAS unsigned*)(vbuf + i * 1024), 16, 0, 0);
}
__device__ __forceinline__ void load_v(u32x4 (&vv)[8], const bf16_t* Vh, int j0, int lane) {
    const bf16_t* p = Vh + (size_t)(j0 + (lane >> 3)) * BW + (lane & 7) * 8;
#pragma unroll
    for (int i = 0; i < 8; ++i) vv[i] = *(const u32x4*)(p + (size_t)(8 * i) * BW);
}
__device__ __forceinline__ void stage_v(LAS unsigned char* vst, const u32x4 (&vv)[8], int lane) {
    const int c = lane & 7;
#pragma unroll
    for (int i = 0; i < 8; ++i) { const int key = 8 * i + (lane >> 3);
        *(LAS u32x4*)(vst + ((c >> 2) * 4 + (key >> 4)) * 1024 + (key & 15) * 64 + (c & 3) * 16) = vv[i]; }
}
__device__ __forceinline__ void qk(f32x16& p0, f32x16& p1, const bf16x8 (&kf)[8], const bf16x8 (&qr)[4]) {
#pragma unroll
    for (int d0 = 0; d0 < 4; ++d0) { p0 = __builtin_amdgcn_mfma_f32_32x32x16_bf16(kf[2 * d0], qr[d0], p0, 0, 0, 0); p1 = __builtin_amdgcn_mfma_f32_32x32x16_bf16(kf[2 * d0 + 1], qr[d0], p1, 0, 0, 0); }
}
__device__ __forceinline__ void pv(f32x16& o0, f32x16& o1, const f32x16& p0, const f32x16& p1, const LAS unsigned char* vst, int lane) {
    const int hi = lane >> 5;
    const LAS unsigned char* vp = vst + ((lane >> 4) & 1) * 32 + (lane & 3) * 8 + (4 * hi + ((lane & 15) >> 2)) * 64;
    u32x4 pw[4];
    pw[0] = (u32x4){cvt_pk_bf16(p0[0], p0[1]), cvt_pk_bf16(p0[2], p0[3]), cvt_pk_bf16(p0[4], p0[5]), cvt_pk_bf16(p0[6], p0[7])};
    pw[1] = (u32x4){cvt_pk_bf16(p0[8], p0[9]), cvt_pk_bf16(p0[10], p0[11]), cvt_pk_bf16(p0[12], p0[13]), cvt_pk_bf16(p0[14], p0[15])};
    pw[2] = (u32x4){cvt_pk_bf16(p1[0], p1[1]), cvt_pk_bf16(p1[2], p1[3]), cvt_pk_bf16(p1[4], p1[5]), cvt_pk_bf16(p1[6], p1[7])};
    pw[3] = (u32x4){cvt_pk_bf16(p1[8], p1[9]), cvt_pk_bf16(p1[10], p1[11]), cvt_pk_bf16(p1[12], p1[13]), cvt_pk_bf16(p1[14], p1[15])};
#pragma unroll
    for (int ks = 0; ks < 4; ++ks) {
        const s16x4 a0 = vtr(vp + ks * 1024), a1 = vtr(vp + ks * 1024 + 512), b0 = vtr(vp + 4096 + ks * 1024), b1 = vtr(vp + 4096 + ks * 1024 + 512);
        const bf16x8 v0 = {a0[0], a0[1], a0[2], a0[3], a1[0], a1[1], a1[2], a1[3]}, v1 = {b0[0], b0[1], b0[2], b0[3], b1[0], b1[1], b1[2], b1[3]};
        const bf16x8 pa = __builtin_bit_cast(bf16x8, pw[ks]);
        o0 = __builtin_amdgcn_mfma_f32_32x32x16_bf16(pa, v0, o0, 0, 0, 0);
        o1 = __builtin_amdgcn_mfma_f32_32x32x16_bf16(pa, v1, o1, 0, 0, 0);
    }
}
__device__ __forceinline__ void store_o(bf16_t* Ow, const f32x16& o0, const f32x16& o1, const float (&rsc)[16], LAS unsigned char* stg, int lane) {
    const int r32 = lane & 31, hi = lane >> 5;
    LAS bf16_t* s = (LAS bf16_t*)stg;
#pragma unroll
    for (int r = 0; r < 16; ++r) { const int orow = crow(r, hi);
        s[orow * 64 + r32] = (bf16_t)(cvt_pk_bf16(o0[r] * rsc[r], 0.f) & 0xffffu); s[orow * 64 + 32 + r32] = (bf16_t)(cvt_pk_bf16(o1[r] * rsc[r], 0.f) & 0xffffu); }
    LDS_WAIT();
#pragma unroll
    for (int i = 0; i < 4; ++i) { const int row = i * 8 + (lane >> 3), ch = lane & 7; const u32x4 v = *(const LAS u32x4*)(stg + row * 128 + ch * 16); *(u32x4*)(Ow + (size_t)row * BW + ch * 8) = v; }
    LDS_WAIT();
}

__device__ __forceinline__ void sb_item(bf16_t* Q, const bf16_t* K, const bf16_t* V, int b, int h, int q0, LAS unsigned char* vst, int lane) {
    asm volatile("" : "+v"(lane));
    const int r32 = lane & 31, hi = lane >> 5;
    const size_t rowbase = (size_t)b * SEQ;
    bf16_t* Qw = Q + (rowbase + q0) * BW + h * HD;
    bf16x8 qr[4];
#pragma unroll
    for (int d0 = 0; d0 < 4; ++d0) qr[d0] = *(const bf16x8*)(Qw + (size_t)r32 * BW + d0 * 16 + hi * 8);
    const bf16_t* Kh = K + (size_t)(b * NH + h) * SEQ * HD; const bf16_t* Vh = V + (size_t)(b * NH + h) * SEQ * HD;
    f32x16 o0 = {}, o1 = {}; float A2 = 0.f;
    const int tq = q0 + r32;
    bf16x8 kf[8]; load_k(kf, Kh, ((q0 + 30) >> 6) * 64, r32, hi); dma_v(vst + (((q0 + 30) >> 6) & 1) * 8192, Vh, ((q0 + 30) >> 6) * 64, lane);
    for (int kt = (q0 + 30) >> 6; kt >= 0; --kt) {
        const int j0 = kt * 64;
        f32x16 p0 = {}, p1 = {};
        qk(p0, p1, kf, qr);
        asm volatile("" : "+v"(p0), "+v"(p1) :: "memory");
        LAS unsigned char* vcur = vst + (kt & 1) * 8192;
        if (kt > 0) { dma_v(vst + ((kt - 1) & 1) * 8192, Vh, j0 - 64, lane); load_k(kf, Kh, j0 - 64, r32, hi); }
        const bool diag = (j0 + 63 >= q0);
        f32x16 l0, l1;
#pragma unroll
        for (int r = 0; r < 16; ++r) {
            { const float z = p0[r]; const float t = __builtin_amdgcn_exp2f(-__builtin_fabsf(z)); float l = -(__builtin_fmaxf(z, 0.f) + __builtin_amdgcn_logf(1.0f + t)); if (diag && (j0 + crow(r, hi) >= tq)) l = 0.f; l0[r] = l; }
            { const float z = p1[r]; const float t = __builtin_amdgcn_exp2f(-__builtin_fabsf(z)); float l = -(__builtin_fmaxf(z, 0.f) + __builtin_amdgcn_logf(1.0f + t)); if (diag && (j0 + 32 + crow(r, hi) >= tq)) l = 0.f; l1[r] = l; }
        }
        float carry = A2;
#pragma unroll
        for (int half = 1; half >= 0; --half) {
            f32x16& l = half ? l1 : l0; f32x16& p = half ? p1 : p0;
            float T[4];
#pragma unroll
            for (int g = 0; g < 4; ++g) { l[4 * g + 2] += l[4 * g + 3]; l[4 * g + 1] += l[4 * g + 2]; l[4 * g] += l[4 * g + 1]; T[g] = l[4 * g]; }
            float Tl[4], Th[4];
#pragma unroll
            for (int g = 0; g < 4; ++g) Tl[g] = swap_lo(T[g], Th[g]);
            float E = carry;
#pragma unroll
            for (int g = 3; g >= 0; --g) { const float eh = E; E += Th[g]; const float el = E; E += Tl[g]; const float off = hi ? eh : el;
                l[4 * g] += off; l[4 * g + 1] += off; l[4 * g + 2] += off; l[4 * g + 3] += off; }
            carry = E;
#pragma unroll
            for (int r = 0; r < 16; ++r) { float w = __builtin_amdgcn_exp2f(p[r] + l[r]); if (diag && (j0 + 32 * half + crow(r, hi) >= tq)) w = 0.f; p[r] = w; }
        }
        A2 = carry;
        if (kt > 0) asm volatile("s_waitcnt vmcnt(16)" ::: "memory"); else asm volatile("s_waitcnt vmcnt(0)" ::: "memory");
        pv(o0, o1, p0, p1, vcur, lane);
        LDS_WAIT();
        if (__all(A2 < -150.2f)) break;
    }
    float one[16];
#pragma unroll
    for (int r = 0; r < 16; ++r) one[r] = 1.0f;
    store_o(Qw, o0, o1, one, vst, lane);
}

constexpr float MOBA_THR = 8.0f;
__device__ __forceinline__ unsigned moba_gate(const bf16_t* Qw, const bf16_t* Kown, int blk, int tq0, float sl2, const LAS float* km, const LAS float* kbn, int lane) {
    asm volatile("" : "+v"(lane));
    const int r32 = lane & 31, hi = lane >> 5;
    unsigned sel = 0u;
    if (blk > 0) {
        bf16x8 qr[4], kr[4];
        { const bf16_t* Qrow = Qw + (size_t)r32 * BW + hi * 8;
          const int tk = tq0 + r32; const bf16_t* kp = Kown + (size_t)(tk >> 5) * 2048 + hi * 256 + (tk & 31) * 8;
#pragma unroll
          for (int d0 = 0; d0 < 4; ++d0) { qr[d0] = *(const bf16x8*)(Qrow + d0 * 16); kr[d0] = *(const bf16x8*)(kp + d0 * 512); } }
        f32x16 p = {};
#pragma unroll
        for (int d0 = 0; d0 < 4; ++d0) { const LAS f32x4* kmr = (const LAS f32x4*)(km + r32 * 64); const int c0 = d0 * 4 + hi * 2; const f32x4 a = kmr[c0 ^ (r32 & 15)], c = kmr[(c0 + 1) ^ (r32 & 15)];
            const u32x4 h = {cvt_pk_bf16(a[0], a[1]), cvt_pk_bf16(a[2], a[3]), cvt_pk_bf16(c[0], c[1]), cvt_pk_bf16(c[2], c[3])};
            const u32x4 l = {cvt_pk_bf16(a[0] - bf_lo(h.x), a[1] - bf_hi(h.x)), cvt_pk_bf16(a[2] - bf_lo(h.y), a[3] - bf_hi(h.y)), cvt_pk_bf16(c[0] - bf_lo(h.z), c[1] - bf_hi(h.z)), cvt_pk_bf16(c[2] - bf_lo(h.w), c[3] - bf_hi(h.w))};
            p = __builtin_amdgcn_mfma_f32_32x32x16_bf16(__builtin_bit_cast(bf16x8, l), qr[d0], p, 0, 0, 0);
            p = __builtin_amdgcn_mfma_f32_32x32x16_bf16(__builtin_bit_cast(bf16x8, h), qr[d0], p, 0, 0, 0); }
        float v1 = -INFINITY, v2 = -INFINITY, v3 = -INFINITY; int i1 = -1, i2 = -1, i3 = -1;
#define TOP_INS(v, n) do { const bool b1 = (v) > v1 || ((v) == v1 && (n) < i1), b2 = (v) > v2 || ((v) == v2 && (n) < i2), b3 = (v) > v3 || ((v) == v3 && (n) < i3); \
            if (b3) { if (b2) { v3 = v2; i3 = i2; if (b1) { v2 = v1; i2 = i1; v1 = (v); i1 = (n); } else { v2 = (v); i2 = (n); } } else { v3 = (v); i3 = (n); } } } while (0)
#pragma unroll
        for (int r = 0; r < 16; ++r) { const int n = crow(r, 0) + 4 * hi; const float d = p[r]; if (n < blk) TOP_INS(d, n); }
        { float x0, x1; x0 = swap_lo(v1, x1); const float pv1 = hi ? x0 : x1; x0 = swap_lo(v2, x1); const float pv2 = hi ? x0 : x1; x0 = swap_lo(v3, x1); const float pv3 = hi ? x0 : x1;
          x0 = swap_lo(__int_as_float(i1), x1); const int pi1 = __float_as_int(hi ? x0 : x1); x0 = swap_lo(__int_as_float(i2), x1); const int pi2 = __float_as_int(hi ? x0 : x1); x0 = swap_lo(__int_as_float(i3), x1); const int pi3 = __float_as_int(hi ? x0 : x1);
          TOP_INS(pv1, pi1); TOP_INS(pv2, pi2); TOP_INS(pv3, pi3); }
#undef TOP_INS
        float qn2 = 0.f, zs = 0.f;
#pragma unroll
        for (int d0 = 0; d0 < 4; ++d0) { const u32x4 q = __builtin_bit_cast(u32x4, qr[d0]), x = __builtin_bit_cast(u32x4, kr[d0]);
            const float q0 = bf_lo(q.x), q1 = bf_hi(q.x), q2 = bf_lo(q.y), q3 = bf_hi(q.y), q4 = bf_lo(q.z), q5 = bf_hi(q.z), q6 = bf_lo(q.w), q7 = bf_hi(q.w);
            zs += q0 * bf_lo(x.x) + q1 * bf_hi(x.x) + q2 * bf_lo(x.y) + q3 * bf_hi(x.y) + q4 * bf_lo(x.z) + q5 * bf_hi(x.z) + q6 * bf_lo(x.w) + q7 * bf_hi(x.w);
            qn2 += (q0 * q0 + q1 * q1) + (q2 * q2 + q3 * q3) + (q4 * q4 + q5 * q5) + (q6 * q6 + q7 * q7); }
        { float x1; float x0 = swap_lo(zs, x1); zs = x0 + x1; x0 = swap_lo(qn2, x1); qn2 = x0 + x1; }
        const float qn = sqrtf(qn2) * 1.001f, thr = zs - 151.0f; const int tq = tq0 + r32;
#define KEEP(i_) ((i_) >= 0 && !(qn * kbn[(i_)] - sl2 * (float)(tq - (256 * (i_) + 255)) < thr))
        if (KEEP(i1)) sel |= 1u << i1; if (KEEP(i2)) sel |= 1u << i2; if (KEEP(i3)) sel |= 1u << i3;
#undef KEEP
    }
    return sel;
}
__device__ __forceinline__ void moba_tile(f32x16& o0, f32x16& o1, float& mrow, float& lsum, const bf16x8 (&qr)[4], bf16x8 (&kf)[8], const bf16_t* Kh, const bf16_t* Vh, int j0, int jn, float lb, float sl2, bool diag, int tq,
                                          LAS unsigned char* vst, LAS float* wsf, int lane) {
    const int r32 = lane & 31, hi = lane >> 5;
    f32x16 p0, p1;
#pragma unroll
    for (int r = 0; r < 16; ++r) { p0[r] = lb; p1[r] = lb + 32.0f * sl2; }
    qk(p0, p1, kf, qr);
    asm volatile("" : "+v"(p0), "+v"(p1) :: "memory");
    LAS unsigned char* vcur = vst + ((j0 >> 6) & 1) * 8192;
    if (jn >= 0) { dma_v(vst + ((jn >> 6) & 1) * 8192, Vh, jn, lane); load_k(kf, Kh, jn, r32, hi); }
#pragma unroll
    for (int r = 0; r < 16; ++r) { p0[r] = __builtin_fmaf(sl2, (float)crow(r, 0), p0[r]); p1[r] = __builtin_fmaf(sl2, (float)crow(r, 0), p1[r]); }
    if (diag) {
#pragma unroll
        for (int r = 0; r < 16; ++r) { if (j0 + crow(r, hi) > tq) p0[r] = -INFINITY; if (j0 + 32 + crow(r, hi) > tq) p1[r] = -INFINITY; }
    }
    float rm = __builtin_fmaxf(p0[0], p1[0]);
#pragma unroll
    for (int r = 1; r < 16; ++r) rm = __builtin_fmaxf(rm, __builtin_fmaxf(p0[r], p1[r]));
    { float x1; const float x0 = swap_lo(rm, x1); rm = __builtin_fmaxf(x0, x1); }
    if (__any(rm > mrow + MOBA_THR)) {
        const float mn = __builtin_fmaxf(mrow, rm); const float f = __builtin_amdgcn_exp2f(mrow - mn); mrow = mn; lsum *= f;
        if (hi == 0) wsf[r32] = f;
        LDS_WAIT();
#pragma unroll
        for (int r = 0; r < 16; ++r) { const float fr_ = wsf[crow(r, hi)]; o0[r] *= fr_; o1[r] *= fr_; }
        LDS_WAIT();
    }
    float ps = 0.f;
#pragma unroll
    for (int r = 0; r < 16; ++r) { p0[r] = __builtin_amdgcn_exp2f(p0[r] - mrow); p1[r] = __builtin_amdgcn_exp2f(p1[r] - mrow); ps += p0[r] + p1[r]; }
    lsum += ps;
    if (jn >= 0) asm volatile("s_waitcnt vmcnt(16)" ::: "memory"); else asm volatile("s_waitcnt vmcnt(0)" ::: "memory");
    pv(o0, o1, p0, p1, vcur, lane);
    LDS_WAIT();
}
__device__ __forceinline__ void moba_item(const bf16_t* Q, const bf16_t* K, const bf16_t* V, int b, int h, int blk, int n, int tix, const LAS unsigned char* lists, const LAS unsigned* cnt,
                                          const LAS unsigned* selm, unsigned char* recO, float* recML, LAS unsigned char* vst, LAS float* wsf, LAS unsigned* trow, int lane) {
    asm volatile("" : "+v"(lane));
    const int r32 = lane & 31, hi = lane >> 5; const size_t rowbase = (size_t)b * SEQ; const bool own = (n == blk);
    int q; bool valid; unsigned slot;
    if (own) { q = 32 * tix + r32; valid = true; slot = (unsigned)q * 4u + 3u; }
    else { const int cn = (int)cnt[n]; const int p = 32 * tix + r32; valid = p < cn; q = (int)lists[n * 256 + (valid ? p : cn - 1)];
           slot = (unsigned)q * 4u + (unsigned)__builtin_popcount(selm[q] & ((1u << n) - 1u)); }
    if (hi == 0) trow[r32] = slot | (valid ? 0x80000000u : 0u);
    const int tq = blk * 256 + q;
    const bf16_t* Qrow = Q + (rowbase + tq) * BW + h * HD + hi * 8;
    bf16x8 qr[4];
#pragma unroll
    for (int d0 = 0; d0 < 4; ++d0) qr[d0] = *(const bf16x8*)(Qrow + d0 * 16);
    const bf16_t* Kh = K + (size_t)(b * NH + h) * SEQ * HD; const bf16_t* Vh = V + (size_t)(b * NH + h) * SEQ * HD;
    const float sl2 = __builtin_amdgcn_exp2f(-(float)(h + 1)) * LOG2E;
    f32x16 o0 = {}, o1 = {}; float mrow = -INFINITY, lsum = 0.f;
    const int ntile = own ? (tix >> 1) + 1 : 4;
    bf16x8 kf[8]; load_k(kf, Kh, n * 256, r32, hi); dma_v(vst + ((n * 4) & 1) * 8192, Vh, n * 256, lane);
#pragma unroll 1
    for (int i = 0; i < ntile; ++i) { const int j0 = n * 256 + i * 64;
        moba_tile(o0, o1, mrow, lsum, qr, kf, Kh, Vh, j0, i < ntile - 1 ? j0 + 64 : -1, sl2 * (float)(j0 + 4 * hi - tq), sl2, own && i == ntile - 1, tq, vst, wsf, lane); }
    { float x1; const float x0 = swap_lo(lsum, x1); lsum = x0 + x1; }
    if (hi == 0) { wsf[32 + r32] = lsum; if (valid) *(f32x2*)(recML + 2 * slot) = (f32x2){mrow, lsum}; }
    LDS_WAIT();
    LAS bf16_t* s = (LAS bf16_t*)vst;
#pragma unroll
    for (int r = 0; r < 16; ++r) { const int orow = crow(r, hi); const float rl = __builtin_amdgcn_rcpf(wsf[32 + orow]);
        s[orow * 64 + r32] = (bf16_t)(cvt_pk_bf16(o0[r] * rl, 0.f) & 0xffffu); s[orow * 64 + 32 + r32] = (bf16_t)(cvt_pk_bf16(o1[r] * rl, 0.f) & 0xffffu); }
    LDS_WAIT();
#pragma unroll
    for (int i = 0; i < 4; ++i) { const int row = i * 8 + (lane >> 3), ch = lane & 7; const unsigned tr = trow[row]; const u32x4 v = *(const LAS u32x4*)(vst + row * 128 + ch * 16);
        if (tr & 0x80000000u) *(u32x4*)(recO + (size_t)(tr & 0x7fffffffu) * 128 + ch * 16) = v; }
    LDS_WAIT();
}
__device__ __forceinline__ void moba_merge(bf16_t* Q, int b, int h, int blk, int w, const LAS unsigned* selm, const unsigned char* recO, const float* recML, LAS float* wsf, int lane) {
    asm volatile("" : "+v"(lane));
    const int r32 = lane & 31, hi = lane >> 5; const size_t rowbase = (size_t)b * SEQ; const int q0 = blk * 256 + w * 32;
    const int ql = w * 32 + r32; const int c = __builtin_popcount(selm[ql]);
    float mi[4], li[4]; float mx = -INFINITY;
#pragma unroll
    for (int k = 0; k < 4; ++k) { mi[k] = -INFINITY; li[k] = 0.f; if (k == 3 || k < c) { const f32x2 ml = __builtin_nontemporal_load((const f32x2*)(recML + 2 * ((unsigned)ql * 4u + k))); mi[k] = ml.x; li[k] = ml.y; } mx = __builtin_fmaxf(mx, mi[k]); }
    float wg[4], L = 0.f;
#pragma unroll
    for (int k = 0; k < 4; ++k) { wg[k] = (k == 3 || k < c) ? __builtin_amdgcn_exp2f(mi[k] - mx) * li[k] : 0.f; L += wg[k]; }
    const float rL = 1.0f / L;
    if (hi == 0) { wsf[r32] = wg[0] * rL; wsf[32 + r32] = wg[1] * rL; wsf[64 + r32] = wg[2] * rL; wsf[96 + r32] = wg[3] * rL; }
    LDS_WAIT();
    bf16_t* Qw = Q + (rowbase + q0) * BW + h * HD;
#pragma unroll
    for (int i = 0; i < 4; ++i) { const int row = i * 8 + (lane >> 3), ch = lane & 7; f32x4 v0 = {0.f, 0.f, 0.f, 0.f}, v1 = {0.f, 0.f, 0.f, 0.f};
        const unsigned rslot = (unsigned)(w * 32 + row) * 4u;
#pragma unroll
        for (int k = 0; k < 4; ++k) { const float ak = wsf[32 * k + row];
            if (ak != 0.f) { const u32x4 pw = __builtin_nontemporal_load((const u32x4*)(recO + (size_t)(rslot + k) * 128 + ch * 16));
                v0 += ak * (f32x4){bf_lo(pw.x), bf_hi(pw.x), bf_lo(pw.y), bf_hi(pw.y)}; v1 += ak * (f32x4){bf_lo(pw.z), bf_hi(pw.z), bf_lo(pw.w), bf_hi(pw.w)}; } }
        st_bf16x8(Qw + (size_t)row * BW + ch * 8, v0, v1); }
    LDS_WAIT();
}
}

#define XB_TMO      128
#define XB_XCNT(j)  (256  + 64 * (j))
#define XB_XSUB(j)  (1280 + 64 * (j))
#define XB_XGEN(j)  (2304 + 64 * (j))
#define XB_TOP      3328
#define XB_TOPGEN   3392
#define XCD_BAR_WORDS 3456
#define XB_SPIN_CAP (1u << 18)
__device__ __forceinline__ unsigned xb_ld(unsigned* p)              { return __hip_atomic_load(p, __ATOMIC_RELAXED, __HIP_MEMORY_SCOPE_AGENT); }
__device__ __forceinline__ unsigned xb_add(unsigned* p, unsigned v) { return __hip_atomic_fetch_add(p, v, __ATOMIC_RELAXED, __HIP_MEMORY_SCOPE_AGENT); }
__device__ __forceinline__ unsigned xb_xcc_id() { return (unsigned)__builtin_amdgcn_s_getreg((3 << 11) | 20) & 0xFu; }
#define XB_SPIN(cond, bar) do { unsigned _sp = 0; while (cond) { __builtin_amdgcn_s_sleep(1); \
    if ((++_sp & 255u) == 0u) { if (xb_ld(&(bar)[XB_TMO])) break; if (_sp > XB_SPIN_CAP) { atomicAdd(&(bar)[XB_TMO], 1u); break; } } } } while (0)
struct XcdBarrier { unsigned* bar; unsigned x; volatile LAS unsigned* st; };
__device__ __forceinline__ XcdBarrier xcd_barrier_post(unsigned* bar, volatile LAS unsigned* st) {
    XcdBarrier b; b.bar = bar; b.x = xb_xcc_id(); b.st = st;
    if (threadIdx.x == 0) (void)xb_add(&bar[XB_XCNT(b.x)], 1u);
    return b;
}
__device__ __forceinline__ void xcd_barrier_complete(unsigned* bar, unsigned x, unsigned& nloc, unsigned& nx) {
    const unsigned G = gridDim.x * gridDim.y * gridDim.z;
    unsigned sum, cnt, mine, sp = 0u;
    for (;;) {
        sum = 0u; cnt = 0u; mine = 0u;
#pragma unroll
        for (unsigned j = 0; j < 16; ++j) { const unsigned c = xb_ld(&bar[XB_XCNT(j)]); sum += c; cnt += (c > 0u) ? 1u : 0u; mine = (j == x) ? c : mine; }
        if (sum == G) break;
        __builtin_amdgcn_s_sleep(1);
        if ((++sp & 255u) == 0u) { if (xb_ld(&bar[XB_TMO])) break; if (sp > XB_SPIN_CAP) { atomicAdd(&bar[XB_TMO], 1u); break; } }
    }
    nloc = mine > 0u ? mine : 1u; nx = cnt > 0u ? cnt : 1u;
}
__device__ __forceinline__ void xcd_barrier(const XcdBarrier& b, int tid_) {
    asm volatile("s_waitcnt vmcnt(0)" ::: "memory");
    __syncthreads();
    if (tid_ == 0) {
        unsigned* bar = b.bar;
        __builtin_amdgcn_s_waitcnt(0);
        unsigned nloc = b.st[0], nx = b.st[1];
        if (nloc == 0u) { xcd_barrier_complete(bar, b.x, nloc, nx); b.st[0] = nloc; b.st[1] = nx; }
        const unsigned old = xb_add(&bar[XB_XSUB(b.x)], 1u);
        const unsigned gen = old / nloc;
        if (old + 1u == (gen + 1u) * nloc) {
            __builtin_amdgcn_fence(__ATOMIC_RELEASE, "agent");
            asm volatile("s_waitcnt vmcnt(0)" ::: "memory");
            const unsigned og = xb_add(&bar[XB_TOP], 1u);
            const unsigned tg = og / nx;
            if (og + 1u == (tg + 1u) * nx) xb_add(&bar[XB_TOPGEN], 1u);
            else XB_SPIN(xb_ld(&bar[XB_TOPGEN]) == tg, bar);
            __builtin_amdgcn_fence(__ATOMIC_ACQUIRE, "agent");
            xb_add(&bar[XB_XGEN(b.x)], 1u);
            asm volatile("s_waitcnt vmcnt(0)" ::: "memory");
        } else {
            XB_SPIN(xb_ld(&bar[XB_XGEN(b.x)]) == gen, bar);
            __builtin_amdgcn_fence(__ATOMIC_ACQUIRE, "agent");
            asm volatile("s_waitcnt vmcnt(0)" ::: "memory");
        }
    }
    __syncthreads();
}

__device__ __forceinline__ float wave_sum(float v) {
#pragma unroll
    for (int o = 1; o < 64; o <<= 1) v += __shfl_xor(v, o);
    return v;
}
struct TrD { const float* src; const float* gain; bf16_t* dst; int ldw, ldt; };
__device__ __forceinline__ void tr_load(const TrD& d, f32x4 (&v)[8], float (&g)[8], int lane) {
    const int c4 = lane & 7, r0 = lane >> 3;
#pragma unroll
    for (int i = 0; i < 8; ++i) { const int row = 8 * i + r0; v[i] = *(const GAS f32x4*)((const GAS float*)d.src + (size_t)row * d.ldw + 4 * c4); g[i] = d.gain ? ((const GAS float*)d.gain)[row] : 1.0f; }
}
__device__ __forceinline__ void tr_store(const TrD& d, const f32x4 (&v)[8], const float (&g)[8], LAS float* scr, int lane) {
    const int c4 = lane & 7, r0 = lane >> 3;
#pragma unroll
    for (int i = 0; i < 8; ++i) { LAS float* s = scr + (8 * i + r0) * 33 + 4 * c4; s[0] = v[i][0] * g[i]; s[1] = v[i][1] * g[i]; s[2] = v[i][2] * g[i]; s[3] = v[i][3] * g[i]; }
    LDS_WAIT(); asm volatile("" ::: "memory");
    const int c = lane & 7;
#pragma unroll
    for (int j = 0; j < 4; ++j) { const int n = (lane >> 3) + 8 * j; const LAS float* s = scr + (8 * c) * 33 + n;
        u32x4 o; o.x = cvt_pk_bf16(s[0 * 33], s[1 * 33]); o.y = cvt_pk_bf16(s[2 * 33], s[3 * 33]); o.z = cvt_pk_bf16(s[4 * 33], s[5 * 33]); o.w = cvt_pk_bf16(s[6 * 33], s[7 * 33]);
        *(GAS u32x4*)((GAS bf16_t*)d.dst + (size_t)n * d.ldt + 8 * c) = o; }
    LDS_WAIT(); asm volatile("" ::: "memory");
}
constexpr int I_IN = (DM / 64) * (NIN / 32), I_P = (BW / 64) * (DM / 32), I_O = (DM / 64) * (DM / 32), I_G = (DM / 64) * (DFF / 32), I_D = (DFF / 64) * (DM / 32);
constexpr int NITEMS = I_IN + 3 * I_P + I_O + 2 * I_G + I_D;
struct Args { const float* in[14]; float* out; unsigned char* ws; };
__device__ __forceinline__ void tr_decode(int it, TrD& d, const Args& A, int layer, unsigned char* wb) {
    int r = it;
    if (r < I_IN) { const int nblk = NIN / 32, kb = r / nblk, c0 = 32 * (r % nblk); size_t doff;
        if (c0 < 3072) doff = (size_t)c0 * DM * 2;
        else if (c0 < 3584) doff = (size_t)(3072 + 256 * ((c0 - 3072) >> 7) + ((c0 - 3072) & 127)) * DM * 2;
        else if (c0 < 4096) doff = (size_t)(4096 + (c0 - 3584)) * DM * 2;
        else if (c0 < 4608) doff = (size_t)(3072 + 256 * ((c0 - 4096) >> 7) + 128 + ((c0 - 4096) & 127)) * DM * 2;
        else doff = (WS_WG - WS_WIN) + (size_t)(c0 - 4608) * DM * 2;
        d.src = A.in[2] + (size_t)layer * DM * NIN + (size_t)(64 * kb) * NIN + c0; d.gain = A.in[1] + (size_t)layer * DM + 64 * kb; d.dst = (bf16_t*)(wb + doff) + 64 * kb; d.ldw = NIN; d.ldt = DM; return; }
    r -= I_IN;
    if (r < I_P) { const int nblk = DM / 32, kb = r / nblk, c0 = 32 * (r % nblk);
        d.src = A.in[5] + (size_t)layer * BW * DM + (size_t)(64 * kb) * DM + c0; d.gain = nullptr; d.dst = (bf16_t*)(wb + (WS_WP - WS_WIN)) + (size_t)c0 * BW + 64 * kb; d.ldw = DM; d.ldt = BW; return; }
    r -= I_P;
    if (r < I_P) { const int nblk = DM / 32, kb = r / nblk, c0 = 32 * (r % nblk);
        d.src = A.in[6] + (size_t)layer * BW * DM + (size_t)(64 * kb) * DM + c0; d.gain = nullptr; d.dst = (bf16_t*)(wb + (WS_WP - WS_WIN)) + (size_t)DM * BW + (size_t)c0 * BW + 64 * kb; d.ldw = DM; d.ldt = BW; return; }
    r -= I_P;
    if (r < I_P) { const int nblk = DM / 32, kb = r / nblk, c0 = 32 * (r % nblk);
        d.src = A.in[7] + (size_t)layer * BW * DM + (size_t)(64 * kb) * DM + c0; d.gain = nullptr; d.dst = (bf16_t*)(wb + (WS_WP - WS_WIN)) + (size_t)2 * DM * BW + (size_t)c0 * BW + 64 * kb; d.ldw = DM; d.ldt = BW; return; }
    r -= I_P;
    if (r < I_O) { const int nblk = DM / 32, kb = r / nblk, c0 = 32 * (r % nblk);
        d.src = A.in[8] + (size_t)layer * DM * DM + (size_t)(64 * kb) * DM + c0; d.gain = nullptr; d.dst = (bf16_t*)(wb + (WS_WO - WS_WIN)) + (size_t)c0 * DM + 64 * kb; d.ldw = DM; d.ldt = DM; return; }
    r -= I_O;
    if (r < I_G) { const int nblk = DFF / 32, kb = r / nblk, c0 = 32 * (r % nblk);
        d.src = A.in[10] + (size_t)layer * DM * DFF + (size_t)(64 * kb) * DFF + c0; d.gain = A.in[9] + (size_t)layer * DM + 64 * kb; d.dst = (bf16_t*)(wb + (WS_WGU - WS_WIN)) + (size_t)(256 * (c0 >> 7) + (c0 & 127)) * DM + 64 * kb; d.ldw = DFF; d.ldt = DM; return; }
    r -= I_G;
    if (r < I_G) { const int nblk = DFF / 32, kb = r / nblk, c0 = 32 * (r % nblk);
        d.src = A.in[11] + (size_t)layer * DM * DFF + (size_t)(64 * kb) * DFF + c0; d.gain = A.in[9] + (size_t)layer * DM + 64 * kb; d.dst = (bf16_t*)(wb + (WS_WGU - WS_WIN)) + (size_t)(256 * (c0 >> 7) + 128 + (c0 & 127)) * DM + 64 * kb; d.ldw = DFF; d.ldt = DM; return; }
    r -= I_G;
    { const int nblk = DM / 32, kb = r / nblk, c0 = 32 * (r % nblk);
      d.src = A.in[12] + (size_t)layer * DFF * DM + (size_t)(64 * kb) * DM + c0; d.gain = nullptr; d.dst = (bf16_t*)(wb + (WS_WD - WS_WIN)) + (size_t)c0 * DFF + 64 * kb; d.ldw = DM; d.ldt = DFF; }
}


__global__ void __launch_bounds__(NWAVES * 64, 2) hybrid_fwd(Args args) {
    extern __shared__ __attribute__((aligned(16))) unsigned char lds_raw[];
    LAS unsigned char* lds = (LAS unsigned char*)lds_raw;
    volatile LAS unsigned* MISC = (volatile LAS unsigned*)(lds + MISC_OFF);
    const int wave = __builtin_amdgcn_readfirstlane((int)threadIdx.x >> 6);
    const int G = gridDim.x, bx = blockIdx.x, vcu = (G % 8 == 0) ? (bx % 8) * (G / 8) + bx / 8 : bx;
    for (int i = threadIdx.x; i < (LDS_BYTES - LDSCTL_OFF) / 4; i += NWAVES * 64) ((LAS unsigned*)(lds + LDSCTL_OFF))[i] = 0u;
    __syncthreads();
    XcdBarrier bar = xcd_barrier_post((unsigned*)(args.ws + WS_CTL) + CW_BAR, MISC + 8);
    const int gw = vcu * NWAVES + wave, NGW = G * NWAVES;

    for (int pq = 0; pq < DEPTH * 7 + 1; ++pq) {
        const int layer = pq / 7, ph = pq - 7 * layer;
        int tid = wave * 64 + lane_id(); asm volatile("" : "+v"(tid)); const int lane = tid & 63;
        size_t opq = 0; asm volatile("" : "+s"(opq));
        unsigned char* ws = args.ws + opq; const float* x_in = args.in[0] + opq; float* out = args.out + opq;
        float* ssA = (float*)(ws + WS_SSA); float* ssB = (float*)(ws + WS_SSB); float* kmp = (float*)(ws + WS_KM);
        bf16_t* xb = (bf16_t*)(ws + WS_XB);
        bf16_t* QA = (bf16_t*)(ws + WS_QA); bf16_t* KA = (bf16_t*)(ws + WS_KA); bf16_t* VA = (bf16_t*)(ws + WS_VA);
        bf16_t* QS = (bf16_t*)(ws + WS_QS); bf16_t* KS = (bf16_t*)(ws + WS_KS); bf16_t* VS = (bf16_t*)(ws + WS_VS);
        bf16_t* Ub = (bf16_t*)(ws + WS_U); bf16_t* BC = (bf16_t*)(ws + WS_BC); bf16_t* MG = (bf16_t*)(ws + WS_MG); bf16_t* ACT = (bf16_t*)(ws + WS_ACT);

        if (layer == DEPTH) {
            const float* gf = args.in[13];
            for (int m = gw; m < M; m += NGW) {
                const float rs = rstd_row(ssA, m);
                f32x4* xr = (f32x4*)(out + (size_t)m * DM) + lane; const f32x4* gr = (const f32x4*)gf + lane; const u32x2* xs = (const u32x2*)(xb + (size_t)m * DM) + lane;
#pragma unroll
                for (int j = 0; j < 4; ++j) { const u32x2 w = xs[64 * j]; const f32x4 v = {bf_lo(w.x), bf_hi(w.x), bf_lo(w.y), bf_hi(w.y)}, g = gr[64 * j]; xr[64 * j] = v * rs * g; }
            }
            if (xb_ld((unsigned*)(ws + WS_CTL) + CW_BAR + XB_TMO) != 0u && bx == 0) { for (int i = tid; i < 4096; i += NWAVES * 64) out[i] = __builtin_nanf(""); }
            break;
        }
        if (ph == 0) {
            LAS float* scr = (LAS float*)(lds + RING_OFF + wave * 16384);
            {
                constexpr int NIT2 = NITEMS; unsigned char* wb_ = layer == 0 ? ws + WS_WIN : (unsigned char*)out;
#define TR_DEC(i_, d_) tr_decode(i_, d_, args, layer, wb_)
                int it = gw;
                for (; it + NGW < NIT2; it += 2 * NGW) {
                    TrD da, db; f32x4 va[8], vb[8]; float ga[8], gb[8];
                    TR_DEC(it, da); tr_load(da, va, ga, lane);
                    TR_DEC(it + NGW, db); tr_load(db, vb, gb, lane);
                    tr_store(da, va, ga, scr, lane); tr_store(db, vb, gb, scr, lane);
                }
                if (it < NIT2) { TrD da; f32x4 va[8]; float ga[8]; TR_DEC(it, da); tr_load(da, va, ga, lane); tr_store(da, va, ga, scr, lane); }
#undef TR_DEC
            }
            if (layer == 0) {
                for (int m = gw; m < M; m += NGW) {
                    const f32x4* xr = (const f32x4*)(x_in + (size_t)m * DM) + lane; f32x4 v[4]; float s = 0.f;
#pragma unroll
                    for (int j = 0; j < 4; ++j) { v[j] = xr[64 * j]; s += (v[j].x * v[j].x + v[j].y * v[j].y) + (v[j].z * v[j].z + v[j].w * v[j].w); }
                    s = wave_sum(s);
                    u32x2* o8 = (u32x2*)(xb + (size_t)m * DM) + lane;
#pragma unroll
                    for (int j = 0; j < 4; ++j) o8[64 * j] = (u32x2){cvt_pk_bf16(v[j].x, v[j].y), cvt_pk_bf16(v[j].z, v[j].w)};
                    if (lane < 4) ssA[(size_t)m * 4 + lane] = (lane == 0) ? s : 0.f;
                }
            }
        } else if (ph == 2) {
            LAS unsigned char* vst = lds + RING_OFF + wave * 16384;
            LAS float* wsf = (LAS float*)(lds + ATT_OFF + wave * 512);
            LAS float* km = (LAS float*)(lds + ATT_OFF + 4096);
            LAS unsigned* selm = (LAS unsigned*)(lds + ATT_OFF + 12288);
            LAS unsigned* cnt = (LAS unsigned*)(lds + ATT_OFF + 13312);
            LAS float* kbn = (LAS float*)(lds + ATT_OFF + 13312 + 256);
            LAS unsigned* uslot = (LAS unsigned*)(lds + ATT_OFF + 13312 + 512);
            LAS unsigned char* lists = lds + ATT_OFF + 14336;
            LAS unsigned* trow = (LAS unsigned*)(lds + ATT_OFF + 22528 + wave * 128);
            unsigned char* recO = ws + WS_MG + (size_t)vcu * 131072; float* recML = (float*)(ws + WS_X + (size_t)vcu * 8192);
            unsigned* qbase = (unsigned*)(ws + WS_CTL) + 14336 + layer * 512;
            int xq = (int)(bar.x & 7u);
            unsigned* ndone = (unsigned*)(ws + WS_CTL) + 8192 + 128 + layer * 1024;
            float* kbmax = (float*)((unsigned*)(ws + WS_CTL) + 8192 + 4096 + layer * 512);
            for (;;) {
                if (wave == 0) {
                    unsigned got = 0xffffffffu;
                    if (lane == 0) { const unsigned u_ = __hip_atomic_fetch_add(qbase + xq * 64, 1u, __ATOMIC_RELAXED, __HIP_MEMORY_SCOPE_AGENT); if (u_ < 224u) got = (unsigned)xq * 256u + u_; }
                    got = (unsigned)__builtin_amdgcn_readfirstlane((int)got);
                    while (got == 0xffffffffu) {
                        const unsigned c_ = lane < 8 ? __hip_atomic_load(qbase + lane * 64, __ATOMIC_RELAXED, __HIP_MEMORY_SCOPE_AGENT) : 224u;
                        const unsigned mk = (unsigned)__ballot(c_ < 224u) & 0xffu;
                        if (mk == 0u) break;
                        const unsigned rot = ((mk >> xq) | (mk << (8 - xq))) & 0xffu;
                        const int j_ = (xq + __builtin_ctz(rot)) & 7;
                        if (lane == 0) { const unsigned u_ = __hip_atomic_fetch_add(qbase + j_ * 64, 1u, __ATOMIC_RELAXED, __HIP_MEMORY_SCOPE_AGENT); if (u_ < 224u) got = (unsigned)j_ * 256u + u_; }
                        got = (unsigned)__builtin_amdgcn_readfirstlane((int)got);
                        xq = j_;
                    }
                    if (lane == 0) *uslot = got;
                }
                __syncthreads();
                const unsigned uq_ = *uslot;
                __syncthreads();
                if (uq_ == 0xffffffffu) break;
                const int xu = (int)(uq_ >> 8), ul = (int)(uq_ & 255u);
                if (ul >= 192) { const unsigned ucv = (unsigned)(xu * 32 + (ul - 192));
                    const float* cw = args.in[4] + (size_t)layer * 3 * BW;
#pragma unroll 1
                    for (int k8 = 0; k8 < 8; ++k8) { const int i = (int)ucv * 4096 + k8 * (NWAVES * 64) + tid;
                        const int t = i >> 6, c = (i & 63) * 8; const int tt = t & (SEQ - 1);
                        const u32x4 u2 = *(const u32x4*)(Ub + (size_t)t * BW + c);
                        u32x4 u1 = {0u, 0u, 0u, 0u}, u0 = {0u, 0u, 0u, 0u};
                        if (tt >= 1) u1 = *(const u32x4*)(Ub + (size_t)(t - 1) * BW + c);
                        if (tt >= 2) u0 = *(const u32x4*)(Ub + (size_t)(t - 2) * BW + c);
                        const u32x4 bw = *(const u32x4*)(BC + (size_t)t * BW + c);
                        float y[8];
#pragma unroll
                        for (int e = 0; e < 4; ++e) {
                            const float w0l = cw[c + 2 * e], w0h = cw[c + 2 * e + 1], w1l = cw[BW + c + 2 * e], w1h = cw[BW + c + 2 * e + 1], w2l = cw[2 * BW + c + 2 * e], w2h = cw[2 * BW + c + 2 * e + 1];
                            y[2 * e] = bf_lo(bw[e]) * (w0l * bf_lo(u0[e]) + w1l * bf_lo(u1[e]) + w2l * bf_lo(u2[e]));
                            y[2 * e + 1] = bf_hi(bw[e]) * (w0h * bf_hi(u0[e]) + w1h * bf_hi(u1[e]) + w2h * bf_hi(u2[e]));
                        }
                        *(u32x4*)(BC + (size_t)t * BW + c) = (u32x4){cvt_pk_bf16(y[0], y[1]), cvt_pk_bf16(y[2], y[3]), cvt_pk_bf16(y[4], y[5]), cvt_pk_bf16(y[6], y[7])}; }
                    continue;
                }
                if (ul < 64) {
                    const int b = xu & 1, h = (ul >> 5) ? (xu >> 1) : 7 - (xu >> 1), bh = b * 8 + h, n = ul & 31;
                    const int key_ = n * 256 + (tid >> 1); const bf16_t* kp = KA + (size_t)(b * NH + h) * SEQ * HD + (size_t)(key_ >> 5) * 2048 + (tid & 1) * 1024 + (key_ & 31) * 8;
                    float sq = 0.f;
#pragma unroll
                    for (int c = 0; c < 4; ++c) { const u32x4 x = *(const u32x4*)(kp + c * 256); const float e0 = bf_lo(x.x), e1 = bf_hi(x.x), e2 = bf_lo(x.y), e3 = bf_hi(x.y), e4 = bf_lo(x.z), e5 = bf_hi(x.z), e6 = bf_lo(x.w), e7 = bf_hi(x.w);
                        sq += (e0 * e0 + e1 * e1) + (e2 * e2 + e3 * e3) + (e4 * e4 + e5 * e5) + (e6 * e6 + e7 * e7); }
                    sq += xshfl<1>(sq);
                    sq = __builtin_fmaxf(sq, xshfl<2>(sq)); sq = __builtin_fmaxf(sq, xshfl<4>(sq)); sq = __builtin_fmaxf(sq, xshfl<8>(sq)); sq = __builtin_fmaxf(sq, xshfl<16>(sq));
                    { float x1; const float x0 = att::swap_lo(sq, x1); sq = __builtin_fmaxf(x0, x1); }
                    if (lane == 0) kbn[wave] = sq;
                    __syncthreads();
                    if (tid == 0) { float m_ = kbn[0];
#pragma unroll
                        for (int w_ = 1; w_ < NWAVES; ++w_) m_ = __builtin_fmaxf(m_, kbn[w_]);
                        __hip_atomic_store(kbmax + bh * 32 + n, m_, __ATOMIC_RELAXED, __HIP_MEMORY_SCOPE_AGENT);
                        asm volatile("s_waitcnt vmcnt(0)" ::: "memory");
                        __hip_atomic_fetch_add(ndone + bh * 64, 1u, __ATOMIC_RELAXED, __HIP_MEMORY_SCOPE_AGENT); }
                    __syncthreads();
                } else if (ul < 128) {
                    const int b = xu & 1, h = ((ul - 64) >> 5) ? (xu >> 1) : 7 - (xu >> 1), blk = 31 - (ul & 31);
                    for (int i = tid; i < 2048; i += NWAVES * 64) { const int n = i >> 6, d = i & 63; const size_t o = (size_t)((b * 32 + n) * 2) * BW + h * HD + d; km[n * 64 + ((((d >> 2) ^ (n & 15)) << 2) | (d & 3))] = kmp[o] + kmp[o + BW]; }
                    if (tid == 0) {
                        unsigned sp_ = 0; while (__hip_atomic_load(ndone + (b * 8 + h) * 64, __ATOMIC_RELAXED, __HIP_MEMORY_SCOPE_AGENT) < 32u) { __builtin_amdgcn_s_sleep(2);
                            if (++sp_ > (1u << 20)) { atomicAdd((unsigned*)(ws + WS_CTL) + CW_BAR + XB_TMO, 1u); break; } } }
                    __syncthreads();
                    if (tid < 32) kbn[tid] = sqrtf(__hip_atomic_load(kbmax + (b * 8 + h) * 32 + tid, __ATOMIC_RELAXED, __HIP_MEMORY_SCOPE_AGENT)) * 1.01f;
                    __syncthreads();
                    const float sl2 = __builtin_amdgcn_exp2f(-(float)(h + 1)) * LOG2E;
                    const size_t qrow = (size_t)b * SEQ + blk * 256 + wave * 32;
                    const unsigned sel = att::moba_gate(QA + qrow * BW + h * HD, KA + (size_t)(b * NH + h) * SEQ * HD, blk, blk * 256 + wave * 32, sl2, km, kbn, lane);
                    if (lane < 32) selm[wave * 32 + lane] = sel;
                    __syncthreads();
                    for (int n = wave; n < blk; n += NWAVES) {
                        unsigned pos = 0;
#pragma unroll
                        for (int c = 0; c < 4; ++c) { const int q = 64 * c + lane; const bool bit = (selm[q] >> n) & 1u; const unsigned long long mk = __ballot(bit);
                            if (bit) lists[n * 256 + pos + __builtin_amdgcn_mbcnt_hi((unsigned)(mk >> 32), __builtin_amdgcn_mbcnt_lo((unsigned)mk, 0u))] = (unsigned char)q;
                            pos += (unsigned)__builtin_popcountll(mk); }
                        if (lane == 0) cnt[n] = pos;
                    }
                    __syncthreads();
                    { int n = blk, t = wave; int nn = 0, tt = 0, idp = 0;
                      for (;;) {
                          att::moba_item(QA, KA, VA, b, h, blk, n, t, lists, cnt, selm, recO, recML, vst, wsf, trow, lane);
                          bool found = false;
                          while (nn < blk) { const int nt_ = ((int)cnt[nn] + 31) >> 5;
                              if (tt < nt_) { const bool mine = (idp & (NWAVES - 1)) == wave; if (mine) { n = nn; t = tt; found = true; } ++tt; ++idp; if (mine) break; }
                              else { ++nn; tt = 0; } }
                          if (!found) break;
                      } }
                    VM_WAIT();
                    __syncthreads();
                    att::moba_merge(QA, b, h, blk, wave, selm, recO, recML, wsf, lane);
                    __syncthreads();
                } else {
                    const int b = xu & 1, h = (xu >> 1) * 2 + ((ul - 128) >> 5), blk = ul & 31;
                    att::sb_item(QS, KS, VS, b, h, blk * 256 + wave * 32, vst, lane);
                }
            }
        } else {
            static_assert(WS_QS - WS_QA == 48 * MiB && WS_BC - WS_QS == 48 * MiB && WS_VA - WS_KA == 16 * MiB && WS_KS - WS_KA == 48 * MiB, "O_a / O_s / O_c 48 MiB apart; gate scratch = K_a | V_a | K_s");
            GCfg c{};
            c.ws = ws; c.wb = layer == 0 ? ws + WS_WIN : (unsigned char*)out; c.bgate = args.in[3] + (size_t)layer * NGATE; c.red = (LAS float*)(lds + LDSCTL_OFF + 1024);
            c.nseg = 1; c.lda = DM; c.ldb = DM; c.nt = DM / 64; c.toA = 0;
            if (ph == 1) { c.mode = 0; c.N = N1; c.A = xb; c.B = (const bf16_t*)c.wb; }
            else if (ph == 3) { c.mode = 1; c.N = DM; c.nseg = 6; c.A = xb; c.B = (const bf16_t*)(c.wb + (WS_WG - WS_WIN)); }
            else if (ph == 4) { c.mode = 2; c.N = DM; c.A = MG; c.B = (const bf16_t*)(c.wb + (WS_WO - WS_WIN)); }
            else if (ph == 5) { c.mode = 3; c.N = NGU; c.A = xb; c.B = (const bf16_t*)(c.wb + (WS_WGU - WS_WIN)); }
            else { c.mode = 2; c.N = DM; c.A = ACT; c.B = (const bf16_t*)(c.wb + (WS_WD - WS_WIN)); c.lda = DFF; c.ldb = DFF; c.nt = DFF / 64; c.toA = 1; }
            ProbAny P{&c}; EpiAny E{&c}; pg8::StaticOrder S; S.init(M, c.N, G, bx, c.nseg);
            pg8::gemm_phase(lds + RING_OFF, P, S, E, wave);
        }
        if (!(ph == 6 && layer + 1 < DEPTH)) xcd_barrier(bar, tid);
    }
}

extern "C" void kernel_launch(void* const* d_in, const int* in_sizes, int n_in, void* d_out, int out_size, void* d_ws, size_t ws_size, hipStream_t stream) {
    static int grid = 0;
    if (grid == 0) {
        if (n_in != 14 || in_sizes[0] != M * DM || out_size != M * DM || ws_size < WS_END) { fprintf(stderr, "kernel_launch: unexpected shapes (n_in %d, in0 %d, out %d, ws %zu)\n", n_in, n_in > 0 ? in_sizes[0] : -1, out_size, ws_size); grid = -1; return; }
        int dev = 0, cus = 0, per_cu = 0;
        if (hipGetDevice(&dev) != hipSuccess || hipDeviceGetAttribute(&cus, hipDeviceAttributeMultiprocessorCount, dev) != hipSuccess) { grid = -1; return; }
        if (hipFuncSetAttribute((const void*)hybrid_fwd, hipFuncAttributeMaxDynamicSharedMemorySize, LDS_BYTES) != hipSuccess) { fprintf(stderr, "kernel_launch: hipFuncSetAttribute failed\n"); grid = -1; return; }
        if (hipOccupancyMaxActiveBlocksPerMultiprocessor(&per_cu, (const void*)hybrid_fwd, NWAVES * 64, LDS_BYTES) != hipSuccess || per_cu < 1) { fprintf(stderr, "kernel_launch: occupancy query says %d blocks/CU\n", per_cu); (void)hipGetLastError(); per_cu = 1; }
        grid = cus;
    }
    if (grid < 0) return;
    if (hipMemsetAsync((char*)d_ws + WS_CTL, 0, CTL_ZERO_BYTES, stream) != hipSuccess) { fprintf(stderr, "kernel_launch: memset failed\n"); return; }
    Args a{};
    for (int i = 0; i < 14; ++i) a.in[i] = (const float*)d_in[i];
    a.out = (float*)d_out; a.ws = (unsigned char*)d_ws;
    void* kargs[] = {&a};
    hipError_t e = hipLaunchCooperativeKernel((const void*)hybrid_fwd, dim3(grid), dim3(NWAVES * 64), kargs, LDS_BYTES, stream);
    if (e != hipSuccess) fprintf(stderr, "kernel_launch: cooperative launch failed: %s (grid %d)\n", hipGetErrorString(e), grid);
}
```

```cpp
#include <hip/hip_runtime.h>
#include <hip/hip_bf16.h>
#include <cstdio>
#include <cstdint>

#define GAS __attribute__((address_space(1)))
#define LAS __attribute__((address_space(3)))
typedef unsigned short bf16_t;
typedef short bf16x8 __attribute__((ext_vector_type(8)));
typedef short s16x4 __attribute__((ext_vector_type(4)));
typedef float f32x2 __attribute__((ext_vector_type(2)));
typedef float f32x4 __attribute__((ext_vector_type(4)));
typedef float f32x16 __attribute__((ext_vector_type(16)));
typedef unsigned u32x2 __attribute__((ext_vector_type(2)));
typedef unsigned u32x4 __attribute__((ext_vector_type(4)));
typedef GAS unsigned gu32;

constexpr int BATCH = 2, SEQ = 8192, DM = 1024, M = BATCH * SEQ, NH = 8, HD = 64, BW = 512, DFF = 2816, DEPTH = 2;
constexpr int NIN = 7680, N1 = 4608, NGATE = 3072, NGU = 2 * DFF;
constexpr float RMS_EPS = 1e-6f;
constexpr float LOG2E = 1.4426950408889634f;
constexpr float C2 = 0.125f * LOG2E;
constexpr int NWAVES = 8;

constexpr size_t MiB = 1u << 20;
constexpr size_t WS_CTL = 0, CTL_ZERO_BYTES = 64 * 1024;
constexpr size_t WS_SSA = 1 * MiB, WS_SSB = 2 * MiB, WS_KM = 3 * MiB;
constexpr size_t WS_WIN = 4 * MiB, WS_WG = 13 * MiB, WS_WP = 19 * MiB, WS_WO = 22 * MiB, WS_WGU = 24 * MiB, WS_WD = 35 * MiB;
constexpr size_t WS_XB = 41 * MiB;
constexpr size_t WS_QA = 73 * MiB, WS_KA = 89 * MiB, WS_VA = 105 * MiB, WS_QS = 121 * MiB, WS_KS = 137 * MiB, WS_VS = 153 * MiB;
constexpr size_t WS_BC = 169 * MiB, WS_U = 185 * MiB, WS_MG = 201 * MiB, WS_X = 233 * MiB;
constexpr size_t WS_ACT = 73 * MiB;
constexpr size_t WS_END = 256 * MiB;
constexpr int CW_BAR = 4096;

constexpr int RING_OFF = 0, RING_BYTES = 131072;
constexpr int ATT_OFF = RING_BYTES, ATT_BYTES = 23552;
constexpr int LDSCTL_OFF = ATT_OFF + ATT_BYTES, MISC_OFF = LDSCTL_OFF + 320;
constexpr int LDS_BYTES = 163840;
static_assert(LDSCTL_OFF + 1024 + 4096 <= LDS_BYTES, "LDS map");

#define LDS_WAIT() asm volatile("s_waitcnt lgkmcnt(0)" ::: "memory")
#define VM_WAIT() asm volatile("s_waitcnt vmcnt(0)" ::: "memory")
#define RLX_AGENT __ATOMIC_RELAXED, __HIP_MEMORY_SCOPE_AGENT

typedef __bf16 bf16x2_t __attribute__((ext_vector_type(2)));
__device__ __forceinline__ unsigned cvt_pk_bf16(float lo, float hi) { const f32x2 v = {lo, hi}; const bf16x2_t b = __builtin_convertvector(v, bf16x2_t); return __builtin_bit_cast(unsigned, b); }
template <int O> __device__ __forceinline__ float xshfl(float x) {
    static_assert(O < 32, "use sum32 for the two 32-lane halves");
    return __int_as_float(__builtin_amdgcn_ds_swizzle(__float_as_int(x), (O << 10) | 0x1f));
}
__device__ __forceinline__ int lane_id() { return (int)__builtin_amdgcn_mbcnt_hi(~0u, __builtin_amdgcn_mbcnt_lo(~0u, 0u)); }
__device__ __forceinline__ float sum32(float x) { auto rr = __builtin_amdgcn_permlane32_swap(__float_as_uint(x), __float_as_uint(x), false, false); return __uint_as_float(rr[0]) + __uint_as_float(rr[1]); }
__device__ __forceinline__ float bf_lo(unsigned w) { return __uint_as_float(w << 16); }
__device__ __forceinline__ float bf_hi(unsigned w) { return __uint_as_float(w & 0xffff0000u); }
__device__ __forceinline__ float rstd_row(const float* ssp, int row) {
    const f32x4 a = *(const f32x4*)(ssp + (size_t)row * 4);
    return rsqrtf(((a.x + a.y) + (a.z + a.w)) * (1.0f / DM) + RMS_EPS);
}

namespace pg8 {
constexpr int BM = 256, BK = 64, HALF = 128, HTB = HALF * BK * 2, STAGE_BYTES = 8 * HTB, NXCD = 8, WGM = 8;
__host__ __device__ __forceinline__ int lds_byte(int r, int c) { const int st = (r >> 4) * 2 + (c >> 5), rr = r & 15, cc = c & 31, ob = rr * 64 + cc * 2; return st * 1024 + (ob ^ (((ob >> 9) & 1) << 5)); }
__host__ __device__ __forceinline__ void stage_rc(int b, int& R, int& C) { const int st = b / 1024, sb = b % 1024, swz = sb ^ (((sb >> 9) & 1) << 5); R = (st >> 1) * 16 + swz / 64; C = (st & 1) * 32 + (swz % 64) / 2; }
__host__ __device__ __forceinline__ int perm32(int rho) { const int n = rho >> 4, i = rho & 15; return 8 * (i >> 2) + 4 * n + (i & 3); }

struct Unit { int pm, pn, seg; };
struct Seg { const char* A; const char* B; unsigned hA, hB; int lda, ldb, nt; };

struct StaticOrder {
    int nM, nN, nwg, G, c, nseg;
    __device__ void init(int M_, int N_, int G_, int c_, int nseg_) { nM = M_ / BM; nN = N_ / BM; nwg = nM * nN; G = G_; c = c_; nseg = nseg_; }
    __device__ bool next(int i, Unit& u) const {
        const int ti = (nseg == 1) ? i : i / nseg; u.seg = i - ti * nseg;
        const long L = (long)ti * G + c; if (L >= nwg) return false;
        int wgid = (int)L; { const int q = nwg / NXCD, r = nwg % NXCD, xcd = wgid % NXCD, off = wgid / NXCD; wgid = (xcd < r ? xcd * (q + 1) : r * (q + 1) + (xcd - r) * q) + off; }
        const int nig = WGM * nN, gid = wgid / nig, fm = gid * WGM, gsz = (nM - fm) < WGM ? (nM - fm) : WGM;
        u.pm = fm + ((wgid % nig) % gsz); u.pn = (wgid % nig) / gsz; return true;
    }
};

template <class Prob, class Epi, class Sched>
__device__ __forceinline__ void gemm_phase(LAS unsigned char* lds, const Prob& P, const Sched& S, const Epi& E, int wave_) {
    int tid = wave_ * 64 + lane_id(); asm volatile("" : "+v"(tid));
    const int wid = wave_, lane = tid & 63, wr = wid >> 2, wc = wid & 3, fr = lane & 15, fq = lane >> 4;
#define PG8_RC(R0, C0, Rb0) int R0, C0; { int t_ = tid; asm volatile("" : "+v"(t_)); stage_rc(t_ * 16, R0, C0); } const int Rb0 = (R0 & ~31) + perm32(R0 & 31)
    const size_t kstep = (size_t)(BK * 2);
    const unsigned ldsw = (unsigned)wid * 1024u;
    const int aoff = lds_byte(wr * 64 + fr, fq * 8), boff = lds_byte(wc * 32 + fr, fq * 8);
#define PG8_SA(b, h) (((b) * 2 + (h)) * HTB)
#define PG8_SB(b, h) ((4 + (b) * 2 + (h)) * HTB)
#define PG8_STAGE(bufoff, gbase, v0, q) do { \
        __builtin_amdgcn_global_load_lds((const unsigned*)((const char*)(gbase) + (v0)), (LAS unsigned*)(lds + (bufoff) + ldsw), 16, 0, 0); \
        __builtin_amdgcn_global_load_lds((const unsigned*)((const char*)(gbase) + (q) + (v0)), (LAS unsigned*)(lds + (bufoff) + ldsw + 8192), 16, 0, 0); } while (0)
#define PG8_LDA(dst, b, h) do { _Pragma("unroll") for (int m = 0; m < 4; ++m) _Pragma("unroll") for (int k = 0; k < 2; ++k) dst[m][k] = *(const LAS bf16x8*)(lds + PG8_SA(b, h) + aoff + m * 2048 + k * 1024); } while (0)
#define PG8_LDB(dst, b, h) do { _Pragma("unroll") for (int n = 0; n < 2; ++n) _Pragma("unroll") for (int k = 0; k < 2; ++k) dst[n][k] = *(const LAS bf16x8*)(lds + PG8_SB(b, h) + boff + n * 2048 + k * 1024); } while (0)
#define PG8_MMA(ai, bj, At, Bt) do { __builtin_amdgcn_s_setprio(1); _Pragma("unroll") for (int m = 0; m < 4; ++m) _Pragma("unroll") for (int n = 0; n < 2; ++n) _Pragma("unroll") for (int k = 0; k < 2; ++k) \
        acc[ai][bj][m][n] = __builtin_amdgcn_mfma_f32_16x16x32_bf16(Bt[n][k], At[m][k], acc[ai][bj][m][n], 0, 0, 0); __builtin_amdgcn_s_setprio(0); } while (0)
#define PG8_WAIT_V(n) asm volatile("s_waitcnt vmcnt(" #n ")" ::: "memory")
#define PG8_WAIT_L(n) asm volatile("s_waitcnt lgkmcnt(" #n ")" ::: "memory")
#define PG8_BAR __builtin_amdgcn_s_barrier()
#define PG8_SCHED __builtin_amdgcn_sched_barrier(0)
    Unit cur, nxt; int ui = 0;
    if (!S.next(0, cur)) return;
    Seg sc, sn; P.seg(cur, sc);
    unsigned vAc0, vBc0; { PG8_RC(R0, C0, Rb0); vAc0 = (unsigned)(R0 * sc.lda + C0) * 2u; vBc0 = (unsigned)(Rb0 * sc.ldb + C0) * 2u; }
    f32x4 acc[2][2][4][2];
#pragma unroll
    for (int a = 0; a < 2; ++a)
#pragma unroll
        for (int b = 0; b < 2; ++b)
#pragma unroll
            for (int m = 0; m < 4; ++m)
#pragma unroll
                for (int n = 0; n < 2; ++n) acc[a][b][m][n] = (f32x4){0.f, 0.f, 0.f, 0.f};
    bf16x8 At[4][2], B0[2][2], B1[2][2];
    const char* cA = sc.A; const char* cB = sc.B;
    PG8_STAGE(PG8_SB(0, 0), cB, vBc0, sc.hB >> 1); PG8_STAGE(PG8_SB(0, 1), cB + sc.hB, vBc0, sc.hB >> 1); PG8_STAGE(PG8_SA(0, 0), cA, vAc0, sc.hA >> 1); PG8_STAGE(PG8_SA(0, 1), cA + sc.hA, vAc0, sc.hA >> 1);
    if (wr == 1) PG8_BAR;
    PG8_WAIT_V(2); PG8_BAR;
    PG8_STAGE(PG8_SB(1, 0), cB + kstep, vBc0, sc.hB >> 1); PG8_STAGE(PG8_SA(1, 0), cA + kstep, vAc0, sc.hA >> 1); PG8_STAGE(PG8_SB(1, 1), cB + sc.hB + kstep, vBc0, sc.hB >> 1);
    PG8_WAIT_V(6); PG8_BAR;
    for (;;) {
        const bool has_next = S.next(ui + 1, nxt);
        if (has_next) P.seg(nxt, sn); else sn = sc;
        unsigned vAn0, vBn0; { PG8_RC(R0, C0, Rb0); vAn0 = (unsigned)(R0 * sn.lda + C0) * 2u; vBn0 = (unsigned)(Rb0 * sn.ldb + C0) * 2u; }
        const char* nA = sn.A; const char* nB = sn.B;
        const int nt = sc.nt;
        for (int t = 0; t < nt; t += 2) {
            const bool last = (t == nt - 2);
            const char* a1 = cA + (size_t)(t + 1) * kstep;
            const char* a2 = last ? nA : cA + (size_t)(t + 2) * kstep; const char* b2 = last ? nB : cB + (size_t)(t + 2) * kstep;
            const char* a3 = a2 + kstep; const char* b3 = b2 + kstep;
            const unsigned hA2 = last ? sn.hA : sc.hA, hB2 = last ? sn.hB : sc.hB;
            const unsigned vA0 = last ? vAn0 : vAc0, vB0 = last ? vBn0 : vBc0, qA = hA2 >> 1, qB = hB2 >> 1;
            PG8_LDB(B0, 0, 0); PG8_LDB(B1, 0, 1); PG8_SCHED; PG8_LDA(At, 0, 0); PG8_STAGE(PG8_SA(1, 1), a1 + sc.hA, vAc0, sc.hA >> 1);
            PG8_WAIT_V(8); PG8_WAIT_L(0); PG8_BAR; PG8_MMA(0, 0, At, B0); PG8_MMA(0, 1, At, B1); PG8_BAR; PG8_SCHED;
            PG8_LDA(At, 0, 1); PG8_STAGE(PG8_SB(0, 0), b2, vB0, qB); PG8_STAGE(PG8_SB(0, 1), b2 + hB2, vB0, qB); PG8_STAGE(PG8_SA(0, 0), a2, vA0, qA);
            PG8_WAIT_V(8); PG8_WAIT_L(0); PG8_BAR; PG8_MMA(1, 0, At, B0); PG8_MMA(1, 1, At, B1); PG8_BAR; PG8_SCHED;
            PG8_LDB(B0, 1, 0); PG8_LDB(B1, 1, 1); PG8_SCHED; PG8_LDA(At, 1, 0); PG8_STAGE(PG8_SA(0, 1), a2 + hA2, vA0, qA);
            PG8_WAIT_V(8); PG8_WAIT_L(0); PG8_BAR; PG8_MMA(0, 0, At, B0); PG8_MMA(0, 1, At, B1); PG8_BAR; PG8_SCHED;
            PG8_LDA(At, 1, 1); PG8_STAGE(PG8_SB(1, 0), b3, vB0, qB); PG8_STAGE(PG8_SB(1, 1), b3 + hB2, vB0, qB); PG8_STAGE(PG8_SA(1, 0), a3, vA0, qA);
            PG8_WAIT_V(8); PG8_WAIT_L(0); PG8_BAR; PG8_MMA(1, 0, At, B0); PG8_MMA(1, 1, At, B1); PG8_BAR; PG8_SCHED;
        }
        if (wr == 0) PG8_BAR;
        { int wr_ = wr, wc_ = wc, t_ = tid;
          asm volatile("" : "+s"(wr_), "+s"(wc_), "+v"(t_)); const int fr_ = t_ & 15, fq_ = (t_ >> 4) & 3;
          E(acc, cur, wr_, wc_, fr_, fq_); }
        if (!has_next) break;
#pragma unroll
        for (int a = 0; a < 2; ++a)
#pragma unroll
            for (int b = 0; b < 2; ++b)
#pragma unroll
                for (int m = 0; m < 4; ++m)
#pragma unroll
                    for (int n = 0; n < 2; ++n) acc[a][b][m][n] = (f32x4){0.f, 0.f, 0.f, 0.f};
        cur = nxt; sc = sn; cA = nA; cB = nB; vAc0 = vAn0; vBc0 = vBn0; ++ui;
        if (wr == 1) PG8_BAR;
    }
    PG8_WAIT_V(0);
    PG8_BAR;
#undef PG8_SA
#undef PG8_SB
#undef PG8_STAGE
#undef PG8_LDA
#undef PG8_LDB
#undef PG8_MMA
#undef PG8_WAIT_V
#undef PG8_WAIT_L
#undef PG8_BAR
#undef PG8_SCHED
#undef PG8_RC
}
}

#define EPI_ARGS const f32x4 (&acc)[2][2][4][2], const pg8::Unit& u, int wr, int wc, int fr, int fq
__device__ __forceinline__ void st_bf16x8(bf16_t* p, f32x4 v0, f32x4 v1) {
    u32x4 w; w.x = cvt_pk_bf16(v0[0], v0[1]); w.y = cvt_pk_bf16(v0[2], v0[3]); w.z = cvt_pk_bf16(v1[0], v1[1]); w.w = cvt_pk_bf16(v1[2], v1[3]);
#ifdef SC1_STORES
    asm volatile("global_store_dwordx4 %0, %1, off sc1\n\ts_nop 1" :: "v"(p), "v"(w) : "memory");
#else
    *(u32x4*)p = w;
#endif
}
template <class T> __device__ __forceinline__ T* bo(T* base, unsigned byte_off) { return (T*)((char*)base + byte_off); }
template <class T> __device__ __forceinline__ const T* bo(const T* base, unsigned byte_off) { return (const T*)((const char*)base + byte_off); }
__device__ __forceinline__ void ld_bf16x8(const bf16_t* p, f32x4& v0, f32x4& v1) {
    const unsigned long long lo = __hip_atomic_load((const unsigned long long*)p, __ATOMIC_RELAXED, __HIP_MEMORY_SCOPE_AGENT), hi = __hip_atomic_load((const unsigned long long*)p + 1, __ATOMIC_RELAXED, __HIP_MEMORY_SCOPE_AGENT);
    const u32x4 w = {(unsigned)lo, (unsigned)(lo >> 32), (unsigned)hi, (unsigned)(hi >> 32)};
    v0 = (f32x4){bf_lo(w.x), bf_hi(w.x), bf_lo(w.y), bf_hi(w.y)}; v1 = (f32x4){bf_lo(w.z), bf_hi(w.z), bf_lo(w.w), bf_hi(w.w)};
}
__device__ __forceinline__ float rstd4(f32x4 a) { return rsqrtf(((a.x + a.y) + (a.z + a.w)) * (1.0f / DM) + RMS_EPS); }
__device__ __forceinline__ void rstd8(float (&rs)[2][4], const float* ss, int pm, unsigned lrow) {
    const float* ssb = ss + (size_t)pm * 256 * 4; unsigned lsb = lrow * 16u; asm volatile("" : "+v"(lsb));
    f32x4 t[2][4];
#pragma unroll
    for (int ai = 0; ai < 2; ++ai)
#pragma unroll
        for (int m = 0; m < 4; ++m) t[ai][m] = *(const f32x4*)bo(ssb, lsb + (unsigned)(ai * 128 + m * 16) * 16u);
#pragma unroll
    for (int ai = 0; ai < 2; ++ai)
#pragma unroll
        for (int m = 0; m < 4; ++m) rs[ai][m] = rstd4(t[ai][m]);
}
struct EpiIn {
    unsigned char* ws;
    __device__ __forceinline__ void operator()(EPI_ARGS) const {
        bf16_t* qkv = (bf16_t*)(ws + WS_QA); bf16_t* ub = (bf16_t*)(ws + WS_U); bf16_t* bc = (bf16_t*)(ws + WS_BC); float* kmp = (float*)(ws + WS_KM); const float* ss = (const float*)(ws + WS_SSA);
        const int pn = u.pn; unsigned lrow = (unsigned)(wr * 64 + fr), lcol = (unsigned)(wc * 32 + 8 * fq);
        asm volatile("" : "+v"(lrow), "+v"(lcol));
        const unsigned lb = (lrow * BW + lcol) * 2u;
        float rs[2][4]; rstd8(rs, ss, u.pm, lrow);
        if (pn < 12 || pn >= 16) {
            const int t = pn >> 1; const float sc = (t == 0 || t == 3) ? C2 : 1.0f;
            bf16_t* base = (pn < 12 ? qkv + (size_t)t * M * BW + (pn & 1) * 256 : bc + (pn - 16) * 256) + (size_t)u.pm * 256 * BW;
            if (t == 1) {
                float* kp = kmp + (size_t)(u.pm * 2 + wr) * BW + (pn & 1) * 256;
#pragma unroll
                for (int bj = 0; bj < 2; ++bj)
#pragma unroll
                    for (int n = 0; n < 2; ++n) { f32x4 s = {0.f, 0.f, 0.f, 0.f};
#pragma unroll
                        for (int ai = 0; ai < 2; ++ai)
#pragma unroll
                            for (int m = 0; m < 4; ++m) s += acc[ai][bj][m][n] * rs[ai][m];
#pragma unroll
                        for (int e = 0; e < 4; ++e) { s[e] += xshfl<1>(s[e]); s[e] += xshfl<2>(s[e]); s[e] += xshfl<4>(s[e]); s[e] += xshfl<8>(s[e]); }
                        if (fr == 0) *(f32x4*)bo(kp, (lcol + (unsigned)(bj * 128 + 4 * n)) * 4u) = s; }
            }
            if (t == 2 || t == 5) {
                bf16_t* vb = qkv + (size_t)t * M * BW + ((size_t)((u.pm >> 5) * 8 + (pn & 1) * 4) * SEQ + (size_t)(u.pm & 31) * 256) * HD;
                const unsigned fr_ = lrow & 15u, wr_ = lrow >> 6, hl = lcol >> 6, dd = lcol & 63u;
#pragma unroll
                for (int ai = 0; ai < 2; ++ai)
#pragma unroll
                    for (int m = 0; m < 4; ++m) { float f = rs[ai][m]; asm volatile("" : "+v"(f));
#pragma unroll
                        for (int bj = 0; bj < 2; ++bj) { const unsigned eo = (unsigned)(bj * 2 + hl) * (SEQ * HD) + ((wr_ + 2 * ai) * 4096 + ((dd >> 5) * 4 + m) * 512 + fr_ * 32 + (dd & 31u));
                            st_bf16x8(bo(vb, eo * 2u), acc[ai][bj][m][0] * f, acc[ai][bj][m][1] * f); } }
            } else if (t == 1 || t == 4) {
                bf16_t* kb = qkv + (size_t)t * M * BW + ((size_t)((u.pm >> 5) * 8 + (pn & 1) * 4) * SEQ + (size_t)(u.pm & 31) * 256) * HD;
                const unsigned fr_ = lrow & 15u, wr_ = lrow >> 6, hl = lcol >> 6, dch = (lcol & 63u) >> 3;
#pragma unroll
                for (int ai = 0; ai < 2; ++ai)
#pragma unroll
                    for (int m = 0; m < 4; ++m) { float f = rs[ai][m]; asm volatile("" : "+v"(f));
#pragma unroll
                        for (int bj = 0; bj < 2; ++bj) { const unsigned eo = (unsigned)(bj * 2 + hl) * (SEQ * HD) + (((wr_ * 2 + ai * 4 + (m >> 1)) * 8 + dch) * 256 + (fr_ + 16u * (m & 1)) * 8);
                            st_bf16x8(bo(kb, eo * 2u), acc[ai][bj][m][0] * f, acc[ai][bj][m][1] * f); } }
            } else {
#pragma unroll
            for (int ai = 0; ai < 2; ++ai)
#pragma unroll
                for (int m = 0; m < 4; ++m) { const float f = rs[ai][m] * sc; const unsigned o = lb + (unsigned)(ai * 128 + m * 16) * BW * 2u;
#pragma unroll
                    for (int bj = 0; bj < 2; ++bj) st_bf16x8(bo(base, o + bj * 256u), acc[ai][bj][m][0] * f, acc[ai][bj][m][1] * f); }
            }
        } else {
            bf16_t* base = ub + (size_t)u.pm * 256 * BW + (pn - 12) * 128;
#pragma unroll
            for (int ai = 0; ai < 2; ++ai)
#pragma unroll
                for (int m = 0; m < 4; ++m) { const float f = rs[ai][m] * rs[ai][m];
                    st_bf16x8(bo(base, lb + (unsigned)(ai * 128 + m * 16) * BW * 2u), acc[ai][0][m][0] * acc[ai][1][m][0] * f, acc[ai][0][m][1] * acc[ai][1][m][1] * f); }
        }
    }
};
struct EpiC1 {
    unsigned char* ws; const float* bgate;
    __device__ __forceinline__ unsigned char* gtile(int s, int pm, int pn) const { return ws + WS_KA + (size_t)(s + (s >> 1)) * (16 * MiB) + (size_t)(pm * 4 + pn) * 65536; }
    __device__ __forceinline__ void operator()(EPI_ARGS) const {
        bf16_t* mg = (bf16_t*)(ws + WS_MG); const float* ss = (const float*)(ws + WS_SSA);
        const int sg = u.seg; unsigned lrow = (unsigned)(wr * 64 + fr), lcol = (unsigned)(wc * 32 + 8 * fq);
        asm volatile("" : "+v"(lrow), "+v"(lcol));
        const unsigned lb = (lrow * DM + lcol) * 2u, lg = (unsigned)((wr * 4 + wc) * 8 * 1024 + (fq * 16 + fr) * 16);
        unsigned char* gp = gtile(sg < 3 ? sg : sg - 3, u.pm, u.pn);
        if (sg < 3) {
            const float* bg = bgate + sg * DM + u.pn * 256;
            f32x4 bv[2][2];
#pragma unroll
            for (int bj = 0; bj < 2; ++bj) { bv[bj][0] = *(const f32x4*)bo(bg, (lcol + bj * 128u) * 4u) * (-LOG2E); bv[bj][1] = *(const f32x4*)bo(bg, (lcol + bj * 128u + 4u) * 4u) * (-LOG2E); }
            float rs[2][4]; rstd8(rs, ss, u.pm, lrow);
#pragma unroll
            for (int ai = 0; ai < 2; ++ai)
#pragma unroll
                for (int m = 0; m < 4; ++m) { const float rn = rs[ai][m] * (-LOG2E); u32x4 w;
#pragma unroll
                    for (int bj = 0; bj < 2; ++bj)
#pragma unroll
                        for (int n = 0; n < 2; ++n) { const f32x4 x = acc[ai][bj][m][n] * rn + bv[bj][n];
                            unsigned q[4];
#pragma unroll
                            for (int e = 0; e < 4; ++e) q[e] = (unsigned)(__builtin_amdgcn_rcpf(1.0f + __builtin_amdgcn_exp2f(x[e])) * 255.0f + 0.5f);
                            w[bj * 2 + n] = q[0] | (q[1] << 8) | (q[2] << 16) | (q[3] << 24); }
                    *(u32x4*)bo(gp, lg + (unsigned)((ai * 4 + m) * 1024)) = w; }
        } else {
            bf16_t* mp = mg + (size_t)u.pm * 256 * DM + u.pn * 256;
#pragma unroll
            for (int ai = 0; ai < 2; ++ai) {
                u32x4 gw_[4], pw_[4][2];
#pragma unroll
                for (int mm = 0; mm < 4; ++mm) { gw_[mm] = *(const u32x4*)bo((const unsigned char*)gp, lg + (unsigned)((ai * 4 + mm) * 1024));
#pragma unroll
                    for (int bj = 0; bj < 2; ++bj) if (sg > 3) pw_[mm][bj] = *(const u32x4*)bo((const bf16_t*)mp, lb + (unsigned)(ai * 128 + mm * 16) * DM * 2u + bj * 256u); }
#pragma unroll
                for (int mm = 0; mm < 4; ++mm)
#pragma unroll
                    for (int bj = 0; bj < 2; ++bj) { const unsigned o = lb + (unsigned)(ai * 128 + mm * 16) * DM * 2u + bj * 256u; const unsigned g0 = gw_[mm][bj * 2], g1 = gw_[mm][bj * 2 + 1]; constexpr float s = 1.0f / 255.0f;
                        f32x4 v0 = acc[ai][bj][mm][0] * ((f32x4){(float)(g0 & 255u), (float)((g0 >> 8) & 255u), (float)((g0 >> 16) & 255u), (float)(g0 >> 24)} * s);
                        f32x4 v1 = acc[ai][bj][mm][1] * ((f32x4){(float)(g1 & 255u), (float)((g1 >> 8) & 255u), (float)((g1 >> 16) & 255u), (float)(g1 >> 24)} * s);
                        if (sg > 3) { const u32x4 p = pw_[mm][bj]; v0 += (f32x4){bf_lo(p.x), bf_hi(p.x), bf_lo(p.y), bf_hi(p.y)}; v1 += (f32x4){bf_lo(p.z), bf_hi(p.z), bf_lo(p.w), bf_hi(p.w)}; }
                        st_bf16x8(bo(mp, o), v0, v1); }
                asm volatile("" ::: "memory");
            }
        }
    }
};
struct EpiRes {
    unsigned char* ws; int toA; LAS float* red;
    __device__ __forceinline__ void operator()(EPI_ARGS) const {
        bf16_t* xb = (bf16_t*)(ws + WS_XB); float* sso = (float*)(ws + (toA ? WS_SSA : WS_SSB));
        unsigned lrow = (unsigned)(wr * 64 + fr), lcol = (unsigned)(wc * 32 + 8 * fq);
        asm volatile("" : "+v"(lrow), "+v"(lcol));
        const unsigned le = (lrow * DM + lcol) * 2u, lr4 = lrow * 4u + (unsigned)wc;
        bf16_t* xp = xb + (size_t)u.pm * 256 * DM + u.pn * 256;
#pragma unroll
        for (int ai = 0; ai < 2; ++ai) {
            u32x4 bs[4][2];
#pragma unroll
            for (int m = 0; m < 4; ++m)
#pragma unroll
                for (int bj = 0; bj < 2; ++bj) bs[m][bj] = *(const u32x4*)bo((const bf16_t*)xp, le + (unsigned)(ai * 128 + m * 16) * DM * 2u + bj * 256u);
#pragma unroll
            for (int m = 0; m < 4; ++m) { float sq = 0.f;
#pragma unroll
                for (int bj = 0; bj < 2; ++bj) { const u32x4 w = bs[m][bj];
                    const f32x4 x0 = (f32x4){bf_lo(w.x), bf_hi(w.x), bf_lo(w.y), bf_hi(w.y)} + acc[ai][bj][m][0], x1 = (f32x4){bf_lo(w.z), bf_hi(w.z), bf_lo(w.w), bf_hi(w.w)} + acc[ai][bj][m][1];
                    st_bf16x8(bo(xp, le + (unsigned)(ai * 128 + m * 16) * DM * 2u + bj * 256u), x0, x1);
                    sq += (x0[0] * x0[0] + x0[1] * x0[1]) + (x0[2] * x0[2] + x0[3] * x0[3]) + (x1[0] * x1[0] + x1[1] * x1[1]) + (x1[2] * x1[2] + x1[3] * x1[3]); }
                sq += xshfl<16>(sq); sq = sum32(sq);
                if (fq == 0) red[lr4 + (unsigned)(ai * 128 + m * 16) * 4u] = sq; }
            asm volatile("" ::: "memory");
        }
        asm volatile("s_waitcnt lgkmcnt(0)\n\ts_barrier" ::: "memory");
        { const int t = ((wr * 4 + wc) * 4 + fq) * 16 + fr; if (t < 256) { const f32x4 r = *(const LAS f32x4*)(red + t * 4); sso[((size_t)u.pm * 256 + t) * 4 + u.pn] = (r.x + r.y) + (r.z + r.w); } }
        asm volatile("s_waitcnt lgkmcnt(0)\n\ts_barrier" ::: "memory");
    }
};
struct EpiFfn {
    unsigned char* ws;
    __device__ __forceinline__ void operator()(EPI_ARGS) const {
        bf16_t* act = (bf16_t*)(ws + WS_ACT); const float* ss = (const float*)(ws + WS_SSB);
        unsigned lrow = (unsigned)(wr * 64 + fr), lcol = (unsigned)(wc * 32 + 8 * fq);
        asm volatile("" : "+v"(lrow), "+v"(lcol));
        const unsigned lb = (lrow * DFF + lcol) * 2u;
        bf16_t* ap = act + (size_t)u.pm * 256 * DFF + u.pn * 128;
        float rs[2][4]; rstd8(rs, ss, u.pm, lrow);
#pragma unroll
        for (int ai = 0; ai < 2; ++ai)
#pragma unroll
            for (int m = 0; m < 4; ++m) { const float r1 = rs[ai][m], rn = r1 * (-LOG2E); f32x4 v[2];
#pragma unroll
                for (int n = 0; n < 2; ++n) { const f32x4 g = acc[ai][0][m][n], up = acc[ai][1][m][n] * (r1 * r1);
#pragma unroll
                    for (int e = 0; e < 4; ++e) v[n][e] = g[e] * up[e] * __builtin_amdgcn_rcpf(1.0f + __builtin_amdgcn_exp2f(g[e] * rn)); }
                st_bf16x8(bo(ap, lb + (unsigned)(ai * 128 + m * 16) * DFF * 2u), v[0], v[1]); }
    }
};

struct GCfg {
    int mode;
    int N, nseg, lda, ldb, nt, toA;
    const bf16_t* A; const bf16_t* B;
    unsigned char* ws; unsigned char* wb; const float* bgate; LAS float* red;
};
struct ProbAny {
    const GCfg* c;
    __device__ __forceinline__ void seg(const pg8::Unit& u, pg8::Seg& s) const {
        if (c->mode == 1 && u.seg >= 3) {
            const int br = u.seg - 3; const bf16_t* O = (const bf16_t*)(c->ws + WS_QA + (size_t)br * (48 * MiB)); const bf16_t* Wp = (const bf16_t*)(c->wb + (WS_WP - WS_WIN));
            s.A = (const char*)(O + (size_t)u.pm * 256 * BW); s.B = (const char*)(Wp + ((size_t)br * DM + (size_t)u.pn * 256) * BW);
            s.hA = 128u * BW * 2u; s.hB = 128u * BW * 2u; s.lda = BW; s.ldb = BW; s.nt = BW / 64;
        } else {
            const int so = (c->mode == 1) ? u.seg * DM : 0;
            s.A = (const char*)(c->A + (size_t)u.pm * 256 * c->lda); s.B = (const char*)(c->B + ((size_t)so + (size_t)u.pn * 256) * c->ldb);
            s.hA = 128u * (unsigned)c->lda * 2u; s.hB = 128u * (unsigned)c->ldb * 2u; s.lda = c->lda; s.ldb = c->ldb; s.nt = c->nt;
        }
    }
};
struct EpiAny {
    const GCfg* c;
    __device__ __forceinline__ void operator()(EPI_ARGS) const {
        const int m_ = c->mode;
        if (m_ == 0) EpiIn{c->ws}(acc, u, wr, wc, fr, fq);
        else if (m_ == 1) EpiC1{c->ws, c->bgate}(acc, u, wr, wc, fr, fq);
        else if (m_ == 2) EpiRes{c->ws, c->toA, c->red}(acc, u, wr, wc, fr, fq);
        else EpiFfn{c->ws}(acc, u, wr, wc, fr, fq);
    }
};

namespace att {
__device__ __forceinline__ constexpr int crow(int r, int hi) { return (r & 3) + 8 * (r >> 2) + 4 * hi; }
__device__ __forceinline__ float swap_lo(float x, float& hiv) { auto rr = __builtin_amdgcn_permlane32_swap(__float_as_uint(x), __float_as_uint(x), false, false); hiv = __uint_as_float(rr[1]); return __uint_as_float(rr[0]); }
__device__ __forceinline__ s16x4 vtr(const LAS unsigned char* p) { return __builtin_bit_cast(s16x4, __builtin_amdgcn_ds_read_tr16_b64_v4i16((LAS s16x4*)p)); }
__device__ __forceinline__ void load_k(bf16x8 (&kf)[8], const bf16_t* Kh, int j0, int r32, int hi) {
    const bf16_t* p = Kh + (size_t)(j0 >> 5) * 2048 + hi * 256 + r32 * 8;
#pragma unroll
    for (int d0 = 0; d0 < 4; ++d0) { kf[2 * d0] = *(const bf16x8*)(p + d0 * 512); kf[2 * d0 + 1] = *(const bf16x8*)(p + 2048 + d0 * 512); }
}
__device__ __forceinline__ void dma_v(LAS unsigned char* vbuf, const bf16_t* Vh, int j0, int lane) {
    const bf16_t* p = Vh + (size_t)(j0 >> 6) * 4096 + lane * 8;
#pragma unroll
    for (int i = 0; i < 8; ++i) __builtin_amdgcn_global_load_lds((const unsigned*)(p + i * 512), (LAS unsigned*)(vbuf + i * 1024), 16, 0, 0);
}
__device__ __forceinline__ void load_v(u32x4 (&vv)[8], const bf16_t* Vh, int j0, int lane) {
    const bf16_t* p = Vh + (size_t)(j0 + (lane >> 3)) * BW + (lane & 7) * 8;
#pragma unroll
    for (int i = 0; i < 8; ++i) vv[i] = *(const u32x4*)(p + (size_t)(8 * i) * BW);
}
__device__ __forceinline__ void stage_v(LAS unsigned char* vst, const u32x4 (&vv)[8], int lane) {
    const int c = lane & 7;
#pragma unroll
    for (int i = 0; i < 8; ++i) { const int key = 8 * i + (lane >> 3);
        *(LAS u32x4*)(vst + ((c >> 2) * 4 + (key >> 4)) * 1024 + (key & 15) * 64 + (c & 3) * 16) = vv[i]; }
}
__device__ __forceinline__ void qk(f32x16& p0, f32x16& p1, const bf16x8 (&kf)[8], const bf16x8 (&qr)[4]) {
#pragma unroll
    for (int d0 = 0; d0 < 4; ++d0) { p0 = __builtin_amdgcn_mfma_f32_32x32x16_bf16(kf[2 * d0], qr[d0], p0, 0, 0, 0); p1 = __builtin_amdgcn_mfma_f32_32x32x16_bf16(kf[2 * d0 + 1], qr[d0], p1, 0, 0, 0); }
}
__device__ __forceinline__ void pv(f32x16& o0, f32x16& o1, const f32x16& p0, const f32x16& p1, const LAS unsigned char* vst, int lane) {
    const int hi = lane >> 5;
    const LAS unsigned char* vp = vst + ((lane >> 4) & 1) * 32 + (lane & 3) * 8 + (4 * hi + ((lane & 15) >> 2)) * 64;
    u32x4 pw[4];
    pw[0] = (u32x4){cvt_pk_bf16(p0[0], p0[1]), cvt_pk_bf16(p0[2], p0[3]), cvt_pk_bf16(p0[4], p0[5]), cvt_pk_bf16(p0[6], p0[7])};
    pw[1] = (u32x4){cvt_pk_bf16(p0[8], p0[9]), cvt_pk_bf16(p0[10], p0[11]), cvt_pk_bf16(p0[12], p0[13]), cvt_pk_bf16(p0[14], p0[15])};
    pw[2] = (u32x4){cvt_pk_bf16(p1[0], p1[1]), cvt_pk_bf16(p1[2], p1[3]), cvt_pk_bf16(p1[4], p1[5]), cvt_pk_bf16(p1[6], p1[7])};
    pw[3] = (u32x4){cvt_pk_bf16(p1[8], p1[9]), cvt_pk_bf16(p1[10], p1[11]), cvt_pk_bf16(p1[12], p1[13]), cvt_pk_bf16(p1[14], p1[15])};
#pragma unroll
    for (int ks = 0; ks < 4; ++ks) {
        const s16x4 a0 = vtr(vp + ks * 1024), a1 = vtr(vp + ks * 1024 + 512), b0 = vtr(vp + 4096 + ks * 1024), b1 = vtr(vp + 4096 + ks * 1024 + 512);
        const bf16x8 v0 = {a0[0], a0[1], a0[2], a0[3], a1[0], a1[1], a1[2], a1[3]}, v1 = {b0[0], b0[1], b0[2], b0[3], b1[0], b1[1], b1[2], b1[3]};
        const bf16x8 pa = __builtin_bit_cast(bf16x8, pw[ks]);
        o0 = __builtin_amdgcn_mfma_f32_32x32x16_bf16(pa, v0, o0, 0, 0, 0);
        o1 = __builtin_amdgcn_mfma_f32_32x32x16_bf16(pa, v1, o1, 0, 0, 0);
    }
}
__device__ __forceinline__ void store_o(bf16_t* Ow, const f32x16& o0, const f32x16& o1, const float (&rsc)[16], LAS unsigned char* stg, int lane) {
    const int r32 = lane & 31, hi = lane >> 5;
    LAS bf16_t* s = (LAS bf16_t*)stg;
#pragma unroll
    for (int r = 0; r < 16; ++r) { const int orow = crow(r, hi);
        s[orow * 64 + r32] = (bf16_t)(cvt_pk_bf16(o0[r] * rsc[r], 0.f) & 0xffffu); s[orow * 64 + 32 + r32] = (bf16_t)(cvt_pk_bf16(o1[r] * rsc[r], 0.f) & 0xffffu); }
    LDS_WAIT();
#pragma unroll
    for (int i = 0; i < 4; ++i) { const int row = i * 8 + (lane >> 3), ch = lane & 7; const u32x4 v = *(const LAS u32x4*)(stg + row * 128 + ch * 16); *(u32x4*)(Ow + (size_t)row * BW + ch * 8) = v; }
    LDS_WAIT();
}

__device__ __forceinline__ void sb_item(bf16_t* Q, const bf16_t* K, const bf16_t* V, int b, int h, int q0, LAS unsigned char* vst, int lane) {
    asm volatile("" : "+v"(lane));
    const int r32 = lane & 31, hi = lane >> 5;
    const size_t rowbase = (size_t)b * SEQ;
    bf16_t* Qw = Q + (rowbase + q0) * BW + h * HD;
    bf16x8 qr[4];
#pragma unroll
    for (int d0 = 0; d0 < 4; ++d0) qr[d0] = *(const bf16x8*)(Qw + (size_t)r32 * BW + d0 * 16 + hi * 8);
    const bf16_t* Kh = K + (size_t)(b * NH + h) * SEQ * HD; const bf16_t* Vh = V + (size_t)(b * NH + h) * SEQ * HD;
    f32x16 o0 = {}, o1 = {}; float A2 = 0.f;
    const int tq = q0 + r32;
    bf16x8 kf[8]; load_k(kf, Kh, ((q0 + 30) >> 6) * 64, r32, hi); dma_v(vst + (((q0 + 30) >> 6) & 1) * 8192, Vh, ((q0 + 30) >> 6) * 64, lane);
    for (int kt = (q0 + 30) >> 6; kt >= 0; --kt) {
        const int j0 = kt * 64;
        f32x16 p0 = {}, p1 = {};
        qk(p0, p1, kf, qr);
        asm volatile("" : "+v"(p0), "+v"(p1) :: "memory");
        LAS unsigned char* vcur = vst + (kt & 1) * 8192;
        if (kt > 0) { dma_v(vst + ((kt - 1) & 1) * 8192, Vh, j0 - 64, lane); load_k(kf, Kh, j0 - 64, r32, hi); }
        const bool diag = (j0 + 63 >= q0);
        f32x16 l0, l1;
#pragma unroll
        for (int r = 0; r < 16; ++r) {
            { const float z = p0[r]; const float t = __builtin_amdgcn_exp2f(-__builtin_fabsf(z)); float l = -(__builtin_fmaxf(z, 0.f) + __builtin_amdgcn_logf(1.0f + t)); if (diag && (j0 + crow(r, hi) >= tq)) l = 0.f; l0[r] = l; }
            { const float z = p1[r]; const float t = __builtin_amdgcn_exp2f(-__builtin_fabsf(z)); float l = -(__builtin_fmaxf(z, 0.f) + __builtin_amdgcn_logf(1.0f + t)); if (diag && (j0 + 32 + crow(r, hi) >= tq)) l = 0.f; l1[r] = l; }
        }
        float carry = A2;
#pragma unroll
        for (int half = 1; half >= 0; --half) {
            f32x16& l = half ? l1 : l0; f32x16& p = half ? p1 : p0;
            float T[4];
#pragma unroll
            for (int g = 0; g < 4; ++g) { l[4 * g + 2] += l[4 * g + 3]; l[4 * g + 1] += l[4 * g + 2]; l[4 * g] += l[4 * g + 1]; T[g] = l[4 * g]; }
            float Tl[4], Th[4];
#pragma unroll
            for (int g = 0; g < 4; ++g) Tl[g] = swap_lo(T[g], Th[g]);
            float E = carry;
#pragma unroll
            for (int g = 3; g >= 0; --g) { const float eh = E; E += Th[g]; const float el = E; E += Tl[g]; const float off = hi ? eh : el;
                l[4 * g] += off; l[4 * g + 1] += off; l[4 * g + 2] += off; l[4 * g + 3] += off; }
            carry = E;
#pragma unroll
            for (int r = 0; r < 16; ++r) { float w = __builtin_amdgcn_exp2f(p[r] + l[r]); if (diag && (j0 + 32 * half + crow(r, hi) >= tq)) w = 0.f; p[r] = w; }
        }
        A2 = carry;
        if (kt > 0) asm volatile("s_waitcnt vmcnt(16)" ::: "memory"); else asm volatile("s_waitcnt vmcnt(0)" ::: "memory");
        pv(o0, o1, p0, p1, vcur, lane);
        LDS_WAIT();
        if (__all(A2 < -150.2f)) break;
    }
    float one[16];
#pragma unroll
    for (int r = 0; r < 16; ++r) one[r] = 1.0f;
    store_o(Qw, o0, o1, one, vst, lane);
}

constexpr float MOBA_THR = 8.0f;
__device__ __forceinline__ void gate_load(bf16x8 (&qr)[4], bf16x8 (&kr)[4], const bf16_t* Qw, const bf16_t* Kown, int tq0, int lane) {
    asm volatile("" : "+v"(lane));
    const int r32 = lane & 31, hi = lane >> 5;
    const bf16_t* Qrow = Qw + (size_t)r32 * BW + hi * 8;
    const int tk = tq0 + r32; const bf16_t* kp = Kown + (size_t)(tk >> 5) * 2048 + hi * 256 + (tk & 31) * 8;
#pragma unroll
    for (int d0 = 0; d0 < 4; ++d0) { qr[d0] = *(const bf16x8*)(Qrow + d0 * 16); kr[d0] = *(const bf16x8*)(kp + d0 * 512); }
}
__device__ __forceinline__ unsigned moba_gate(const bf16x8 (&qr)[4], const bf16x8 (&kr)[4], int blk, int tq0, float sl2, const LAS float* km, const LAS float* kbn, int lane) {
    asm volatile("" : "+v"(lane));
    const int r32 = lane & 31, hi = lane >> 5;
    unsigned sel = 0u;
    if (blk > 0) {
        f32x16 p = {};
#pragma unroll
        for (int d0 = 0; d0 < 4; ++d0) { const LAS f32x4* kmr = (const LAS f32x4*)(km + r32 * 64); const int c0 = d0 * 4 + hi * 2; const f32x4 a = kmr[c0 ^ (r32 & 15)], c = kmr[(c0 + 1) ^ (r32 & 15)];
            const u32x4 h = {cvt_pk_bf16(a[0], a[1]), cvt_pk_bf16(a[2], a[3]), cvt_pk_bf16(c[0], c[1]), cvt_pk_bf16(c[2], c[3])};
            const u32x4 l = {cvt_pk_bf16(a[0] - bf_lo(h.x), a[1] - bf_hi(h.x)), cvt_pk_bf16(a[2] - bf_lo(h.y), a[3] - bf_hi(h.y)), cvt_pk_bf16(c[0] - bf_lo(h.z), c[1] - bf_hi(h.z)), cvt_pk_bf16(c[2] - bf_lo(h.w), c[3] - bf_hi(h.w))};
            p = __builtin_amdgcn_mfma_f32_32x32x16_bf16(__builtin_bit_cast(bf16x8, l), qr[d0], p, 0, 0, 0);
            p = __builtin_amdgcn_mfma_f32_32x32x16_bf16(__builtin_bit_cast(bf16x8, h), qr[d0], p, 0, 0, 0); }
        float v1 = -INFINITY, v2 = -INFINITY, v3 = -INFINITY; int i1 = -1, i2 = -1, i3 = -1;
#define TOP_INS(v, n) do { const bool b1 = (v) > v1 || ((v) == v1 && (n) < i1), b2 = (v) > v2 || ((v) == v2 && (n) < i2), b3 = (v) > v3 || ((v) == v3 && (n) < i3); \
            if (b3) { if (b2) { v3 = v2; i3 = i2; if (b1) { v2 = v1; i2 = i1; v1 = (v); i1 = (n); } else { v2 = (v); i2 = (n); } } else { v3 = (v); i3 = (n); } } } while (0)
#pragma unroll
        for (int r = 0; r < 16; ++r) { const int n = crow(r, 0) + 4 * hi; const float d = p[r]; if (n < blk) TOP_INS(d, n); }
        { float x0, x1; x0 = swap_lo(v1, x1); const float pv1 = hi ? x0 : x1; x0 = swap_lo(v2, x1); const float pv2 = hi ? x0 : x1; x0 = swap_lo(v3, x1); const float pv3 = hi ? x0 : x1;
          x0 = swap_lo(__int_as_float(i1), x1); const int pi1 = __float_as_int(hi ? x0 : x1); x0 = swap_lo(__int_as_float(i2), x1); const int pi2 = __float_as_int(hi ? x0 : x1); x0 = swap_lo(__int_as_float(i3), x1); const int pi3 = __float_as_int(hi ? x0 : x1);
          TOP_INS(pv1, pi1); TOP_INS(pv2, pi2); TOP_INS(pv3, pi3); }
#undef TOP_INS
        float qn2 = 0.f, zs = 0.f;
#pragma unroll
        for (int d0 = 0; d0 < 4; ++d0) { const u32x4 q = __builtin_bit_cast(u32x4, qr[d0]), x = __builtin_bit_cast(u32x4, kr[d0]);
            const float q0 = bf_lo(q.x), q1 = bf_hi(q.x), q2 = bf_lo(q.y), q3 = bf_hi(q.y), q4 = bf_lo(q.z), q5 = bf_hi(q.z), q6 = bf_lo(q.w), q7 = bf_hi(q.w);
            zs += q0 * bf_lo(x.x) + q1 * bf_hi(x.x) + q2 * bf_lo(x.y) + q3 * bf_hi(x.y) + q4 * bf_lo(x.z) + q5 * bf_hi(x.z) + q6 * bf_lo(x.w) + q7 * bf_hi(x.w);
            qn2 += (q0 * q0 + q1 * q1) + (q2 * q2 + q3 * q3) + (q4 * q4 + q5 * q5) + (q6 * q6 + q7 * q7); }
        { float x1; float x0 = swap_lo(zs, x1); zs = x0 + x1; x0 = swap_lo(qn2, x1); qn2 = x0 + x1; }
        const float qn = sqrtf(qn2) * 1.001f, thr = zs - 151.0f; const int tq = tq0 + r32;
#define KEEP(i_) ((i_) >= 0 && !(qn * kbn[(i_)] - sl2 * (float)(tq - (256 * (i_) + 255)) < thr))
        if (KEEP(i1)) sel |= 1u << i1; if (KEEP(i2)) sel |= 1u << i2; if (KEEP(i3)) sel |= 1u << i3;
#undef KEEP
    }
    return sel;
}
__device__ __forceinline__ void moba_tile(f32x16& o0, f32x16& o1, float& mrow, float& lsum, const bf16x8 (&qr)[4], bf16x8 (&kf)[8], const bf16_t* Kh, const bf16_t* Vh, int j0, int jn, float lb, float sl2, bool diag, int tq,
                                          LAS unsigned char* vst, LAS float* wsf, int lane) {
    const int r32 = lane & 31, hi = lane >> 5;
    f32x16 p0, p1;
#pragma unroll
    for (int r = 0; r < 16; ++r) { p0[r] = lb; p1[r] = lb + 32.0f * sl2; }
    qk(p0, p1, kf, qr);
    asm volatile("" : "+v"(p0), "+v"(p1) :: "memory");
    LAS unsigned char* vcur = vst + ((j0 >> 6) & 1) * 8192;
    if (jn >= 0) { dma_v(vst + ((jn >> 6) & 1) * 8192, Vh, jn, lane); load_k(kf, Kh, jn, r32, hi); }
#pragma unroll
    for (int r = 0; r < 16; ++r) { p0[r] = __builtin_fmaf(sl2, (float)crow(r, 0), p0[r]); p1[r] = __builtin_fmaf(sl2, (float)crow(r, 0), p1[r]); }
    if (diag) {
#pragma unroll
        for (int r = 0; r < 16; ++r) { if (j0 + crow(r, hi) > tq) p0[r] = -INFINITY; if (j0 + 32 + crow(r, hi) > tq) p1[r] = -INFINITY; }
    }
    float rm = __builtin_fmaxf(p0[0], p1[0]);
#pragma unroll
    for (int r = 1; r < 16; ++r) rm = __builtin_fmaxf(rm, __builtin_fmaxf(p0[r], p1[r]));
    { float x1; const float x0 = swap_lo(rm, x1); rm = __builtin_fmaxf(x0, x1); }
    if (__any(rm > mrow + MOBA_THR)) {
        const float mn = __builtin_fmaxf(mrow, rm); const float f = __builtin_amdgcn_exp2f(mrow - mn); mrow = mn; lsum *= f;
        if (hi == 0) wsf[r32] = f;
        LDS_WAIT();
#pragma unroll
        for (int r = 0; r < 16; ++r) { const float fr_ = wsf[crow(r, hi)]; o0[r] *= fr_; o1[r] *= fr_; }
        LDS_WAIT();
    }
    float ps = 0.f;
#pragma unroll
    for (int r = 0; r < 16; ++r) { p0[r] = __builtin_amdgcn_exp2f(p0[r] - mrow); p1[r] = __builtin_amdgcn_exp2f(p1[r] - mrow); ps += p0[r] + p1[r]; }
    lsum += ps;
    if (jn >= 0) asm volatile("s_waitcnt vmcnt(16)" ::: "memory"); else asm volatile("s_waitcnt vmcnt(0)" ::: "memory");
    pv(o0, o1, p0, p1, vcur, lane);
    LDS_WAIT();
}
__device__ __forceinline__ void moba_item(const bf16_t* Q, const bf16_t* K, const bf16_t* V, int b, int h, int blk, int n, int tix, const LAS unsigned char* lists, const LAS unsigned* cnt,
                                          const LAS unsigned* selm, unsigned char* recO, float* recML, LAS unsigned char* vst, LAS float* wsf, LAS unsigned* trow, int lane) {
    asm volatile("" : "+v"(lane));
    const int r32 = lane & 31, hi = lane >> 5; const size_t rowbase = (size_t)b * SEQ; const bool own = (n == blk);
    int q; bool valid; unsigned slot;
    if (own) { q = 32 * tix + r32; valid = true; slot = (unsigned)q * 4u + 3u; }
    else { const int cn = (int)cnt[n]; const int p = 32 * tix + r32; valid = p < cn; q = (int)lists[n * 256 + (valid ? p : cn - 1)];
           slot = (unsigned)q * 4u + (unsigned)__builtin_popcount(selm[q] & ((1u << n) - 1u)); }
    if (hi == 0) trow[r32] = slot | (valid ? 0x80000000u : 0u);
    const int tq = blk * 256 + q;
    const bf16_t* Qrow = Q + (rowbase + tq) * BW + h * HD + hi * 8;
    bf16x8 qr[4];
#pragma unroll
    for (int d0 = 0; d0 < 4; ++d0) qr[d0] = *(const bf16x8*)(Qrow + d0 * 16);
    const bf16_t* Kh = K + (size_t)(b * NH + h) * SEQ * HD; const bf16_t* Vh = V + (size_t)(b * NH + h) * SEQ * HD;
    const float sl2 = __builtin_amdgcn_exp2f(-(float)(h + 1)) * LOG2E;
    f32x16 o0 = {}, o1 = {}; float mrow = -INFINITY, lsum = 0.f;
    const int ntile = own ? (tix >> 1) + 1 : 4;
    bf16x8 kf[8]; load_k(kf, Kh, n * 256, r32, hi); dma_v(vst + ((n * 4) & 1) * 8192, Vh, n * 256, lane);
#pragma unroll 1
    for (int i = 0; i < ntile; ++i) { const int j0 = n * 256 + i * 64;
        moba_tile(o0, o1, mrow, lsum, qr, kf, Kh, Vh, j0, i < ntile - 1 ? j0 + 64 : -1, sl2 * (float)(j0 + 4 * hi - tq), sl2, own && i == ntile - 1, tq, vst, wsf, lane); }
    { float x1; const float x0 = swap_lo(lsum, x1); lsum = x0 + x1; }
    if (hi == 0) { wsf[32 + r32] = lsum; if (valid) *(f32x2*)(recML + 2 * slot) = (f32x2){mrow, lsum}; }
    LDS_WAIT();
    LAS bf16_t* s = (LAS bf16_t*)vst;
#pragma unroll
    for (int r = 0; r < 16; ++r) { const int orow = crow(r, hi); const float rl = __builtin_amdgcn_rcpf(wsf[32 + orow]);
        s[orow * 64 + r32] = (bf16_t)(cvt_pk_bf16(o0[r] * rl, 0.f) & 0xffffu); s[orow * 64 + 32 + r32] = (bf16_t)(cvt_pk_bf16(o1[r] * rl, 0.f) & 0xffffu); }
    LDS_WAIT();
#pragma unroll
    for (int i = 0; i < 4; ++i) { const int row = i * 8 + (lane >> 3), ch = lane & 7; const unsigned tr = trow[row]; const u32x4 v = *(const LAS u32x4*)(vst + row * 128 + ch * 16);
        if (tr & 0x80000000u) *(u32x4*)(recO + (size_t)(tr & 0x7fffffffu) * 128 + ch * 16) = v; }
    LDS_WAIT();
}
__device__ __forceinline__ void moba_merge(bf16_t* Q, int b, int h, int blk, int w, const LAS unsigned* selm, const unsigned char* recO, const float* recML, LAS float* wsf, int lane) {
    asm volatile("" : "+v"(lane));
    const int r32 = lane & 31, hi = lane >> 5; const size_t rowbase = (size_t)b * SEQ; const int q0 = blk * 256 + w * 32;
    const int ql = w * 32 + r32; const int c = __builtin_popcount(selm[ql]);
    f32x2 ml[4];
#pragma unroll
    for (int k = 0; k < 4; ++k) ml[k] = __builtin_nontemporal_load((const f32x2*)(recML + 2 * ((unsigned)ql * 4u + k)));
    u32x4 pw[4][4];
#pragma unroll
    for (int i = 0; i < 4; ++i)
#pragma unroll
        for (int k = 0; k < 4; ++k) pw[i][k] = __builtin_nontemporal_load((const u32x4*)(recO + (size_t)((unsigned)(w * 32 + i * 8 + (lane >> 3)) * 4u + k) * 128 + (lane & 7) * 16));
    float mi[4], li[4]; float mx = -INFINITY;
#pragma unroll
    for (int k = 0; k < 4; ++k) { const bool used = (k == 3 || k < c); mi[k] = used ? ml[k].x : -INFINITY; li[k] = used ? ml[k].y : 0.f; mx = __builtin_fmaxf(mx, mi[k]); }
    float wg[4], L = 0.f;
#pragma unroll
    for (int k = 0; k < 4; ++k) { wg[k] = (k == 3 || k < c) ? __builtin_amdgcn_exp2f(mi[k] - mx) * li[k] : 0.f; L += wg[k]; }
    const float rL = 1.0f / L;
    if (hi == 0) { wsf[r32] = wg[0] * rL; wsf[32 + r32] = wg[1] * rL; wsf[64 + r32] = wg[2] * rL; wsf[96 + r32] = wg[3] * rL; }
    LDS_WAIT();
    bf16_t* Qw = Q + (rowbase + q0) * BW + h * HD;
#pragma unroll
    for (int i = 0; i < 4; ++i) { const int row = i * 8 + (lane >> 3), ch = lane & 7; f32x4 v0 = {0.f, 0.f, 0.f, 0.f}, v1 = {0.f, 0.f, 0.f, 0.f};
#pragma unroll
        for (int k = 0; k < 4; ++k) { const float ak = wsf[32 * k + row];
            if (ak != 0.f) { const u32x4 p = pw[i][k];
                v0 += ak * (f32x4){bf_lo(p.x), bf_hi(p.x), bf_lo(p.y), bf_hi(p.y)}; v1 += ak * (f32x4){bf_lo(p.z), bf_hi(p.z), bf_lo(p.w), bf_hi(p.w)}; } }
        st_bf16x8(Qw + (size_t)row * BW + ch * 8, v0, v1); }
    LDS_WAIT();
}
}

#define XB_TMO      128
#define XB_XCNT(j)  (256  + 64 * (j))
#define XB_XSUB(j)  (1280 + 64 * (j))
#define XB_XGEN(j)  (2304 + 64 * (j))
#define XB_TOP      3328
#define XB_TOPGEN   3392
#define XCD_BAR_WORDS 3456
#define XB_SPIN_CAP (1u << 18)
__device__ __forceinline__ unsigned xb_ld(unsigned* p)              { return __hip_atomic_load(p, __ATOMIC_RELAXED, __HIP_MEMORY_SCOPE_AGENT); }
__device__ __forceinline__ unsigned xb_add(unsigned* p, unsigned v) { return __hip_atomic_fetch_add(p, v, __ATOMIC_RELAXED, __HIP_MEMORY_SCOPE_AGENT); }
__device__ __forceinline__ unsigned xb_xcc_id() { return (unsigned)__builtin_amdgcn_s_getreg((3 << 11) | 20) & 0xFu; }
#define XB_SPIN(cond, bar) do { unsigned _sp = 0; while (cond) { __builtin_amdgcn_s_sleep(1); \
    if ((++_sp & 255u) == 0u) { if (xb_ld(&(bar)[XB_TMO])) break; if (_sp > XB_SPIN_CAP) { atomicAdd(&(bar)[XB_TMO], 1u); break; } } } } while (0)
struct XcdBarrier { unsigned* bar; unsigned x; volatile LAS unsigned* st; };
__device__ __forceinline__ XcdBarrier xcd_barrier_post(unsigned* bar, volatile LAS unsigned* st) {
    XcdBarrier b; b.bar = bar; b.x = xb_xcc_id(); b.st = st;
    if (threadIdx.x == 0) (void)xb_add(&bar[XB_XCNT(b.x)], 1u);
    return b;
}
__device__ __forceinline__ void xcd_barrier_complete(unsigned* bar, unsigned x, unsigned& nloc, unsigned& nx) {
    const unsigned G = gridDim.x * gridDim.y * gridDim.z;
    unsigned sum, cnt, mine, sp = 0u;
    for (;;) {
        sum = 0u; cnt = 0u; mine = 0u;
#pragma unroll
        for (unsigned j = 0; j < 16; ++j) { const unsigned c = xb_ld(&bar[XB_XCNT(j)]); sum += c; cnt += (c > 0u) ? 1u : 0u; mine = (j == x) ? c : mine; }
        if (sum == G) break;
        __builtin_amdgcn_s_sleep(1);
        if ((++sp & 255u) == 0u) { if (xb_ld(&bar[XB_TMO])) break; if (sp > XB_SPIN_CAP) { atomicAdd(&bar[XB_TMO], 1u); break; } }
    }
    nloc = mine > 0u ? mine : 1u; nx = cnt > 0u ? cnt : 1u;
}
__device__ __forceinline__ void xcd_barrier(const XcdBarrier& b, int tid_) {
    asm volatile("s_waitcnt vmcnt(0)" ::: "memory");
    __syncthreads();
    if (tid_ == 0) {
        unsigned* bar = b.bar;
        __builtin_amdgcn_s_waitcnt(0);
        unsigned nloc = b.st[0], nx = b.st[1];
        if (nloc == 0u) { xcd_barrier_complete(bar, b.x, nloc, nx); b.st[0] = nloc; b.st[1] = nx; }
        const unsigned old = xb_add(&bar[XB_XSUB(b.x)], 1u);
        const unsigned gen = old / nloc;
        if (old + 1u == (gen + 1u) * nloc) {
            __builtin_amdgcn_fence(__ATOMIC_RELEASE, "agent");
            asm volatile("s_waitcnt vmcnt(0)" ::: "memory");
            const unsigned og = xb_add(&bar[XB_TOP], 1u);
            const unsigned tg = og / nx;
            if (og + 1u == (tg + 1u) * nx) xb_add(&bar[XB_TOPGEN], 1u);
            else XB_SPIN(xb_ld(&bar[XB_TOPGEN]) == tg, bar);
            __builtin_amdgcn_fence(__ATOMIC_ACQUIRE, "agent");
            xb_add(&bar[XB_XGEN(b.x)], 1u);
            asm volatile("s_waitcnt vmcnt(0)" ::: "memory");
        } else {
            XB_SPIN(xb_ld(&bar[XB_XGEN(b.x)]) == gen, bar);
            __builtin_amdgcn_fence(__ATOMIC_ACQUIRE, "agent");
            asm volatile("s_waitcnt vmcnt(0)" ::: "memory");
        }
    }
    __syncthreads();
}

__device__ __forceinline__ float wave_sum(float v) {
#pragma unroll
    for (int o = 1; o < 64; o <<= 1) v += __shfl_xor(v, o);
    return v;
}
struct TrD { const float* src; const float* gain; bf16_t* dst; int ldw, ldt; };
__device__ __forceinline__ void tr_load(const TrD& d, f32x4 (&v)[8], float (&g)[8], int lane) {
    const int c4 = lane & 7, r0 = lane >> 3;
#pragma unroll
    for (int i = 0; i < 8; ++i) { const int row = 8 * i + r0; v[i] = *(const GAS f32x4*)((const GAS float*)d.src + (size_t)row * d.ldw + 4 * c4); g[i] = d.gain ? ((const GAS float*)d.gain)[row] : 1.0f; }
}
__device__ __forceinline__ void tr_store(const TrD& d, const f32x4 (&v)[8], const float (&g)[8], LAS float* scr, int lane) {
    const int c4 = lane & 7, r0 = lane >> 3;
#pragma unroll
    for (int i = 0; i < 8; ++i) { LAS float* s = scr + (8 * i + r0) * 33 + 4 * c4; s[0] = v[i][0] * g[i]; s[1] = v[i][1] * g[i]; s[2] = v[i][2] * g[i]; s[3] = v[i][3] * g[i]; }
    LDS_WAIT(); asm volatile("" ::: "memory");
    const int c = lane & 7;
#pragma unroll
    for (int j = 0; j < 4; ++j) { const int n = (lane >> 3) + 8 * j; const LAS float* s = scr + (8 * c) * 33 + n;
        u32x4 o; o.x = cvt_pk_bf16(s[0 * 33], s[1 * 33]); o.y = cvt_pk_bf16(s[2 * 33], s[3 * 33]); o.z = cvt_pk_bf16(s[4 * 33], s[5 * 33]); o.w = cvt_pk_bf16(s[6 * 33], s[7 * 33]);
        *(GAS u32x4*)((GAS bf16_t*)d.dst + (size_t)n * d.ldt + 8 * c) = o; }
    LDS_WAIT(); asm volatile("" ::: "memory");
}
constexpr int I_IN = (DM / 64) * (NIN / 32), I_P = (BW / 64) * (DM / 32), I_O = (DM / 64) * (DM / 32), I_G = (DM / 64) * (DFF / 32), I_D = (DFF / 64) * (DM / 32);
constexpr int NITEMS = I_IN + 3 * I_P + I_O + 2 * I_G + I_D;
struct Args { const float* in[14]; float* out; unsigned char* ws; };
__device__ __forceinline__ void tr_decode(int it, TrD& d, const Args& A, int layer, unsigned char* wb) {
    int r = it;
    if (r < I_IN) { const int nblk = NIN / 32, kb = r / nblk, c0 = 32 * (r % nblk); size_t doff;
        if (c0 < 3072) doff = (size_t)c0 * DM * 2;
        else if (c0 < 3584) doff = (size_t)(3072 + 256 * ((c0 - 3072) >> 7) + ((c0 - 3072) & 127)) * DM * 2;
        else if (c0 < 4096) doff = (size_t)(4096 + (c0 - 3584)) * DM * 2;
        else if (c0 < 4608) doff = (size_t)(3072 + 256 * ((c0 - 4096) >> 7) + 128 + ((c0 - 4096) & 127)) * DM * 2;
        else doff = (WS_WG - WS_WIN) + (size_t)(c0 - 4608) * DM * 2;
        d.src = A.in[2] + (size_t)layer * DM * NIN + (size_t)(64 * kb) * NIN + c0; d.gain = A.in[1] + (size_t)layer * DM + 64 * kb; d.dst = (bf16_t*)(wb + doff) + 64 * kb; d.ldw = NIN; d.ldt = DM; return; }
    r -= I_IN;
    if (r < I_P) { const int nblk = DM / 32, kb = r / nblk, c0 = 32 * (r % nblk);
        d.src = A.in[5] + (size_t)layer * BW * DM + (size_t)(64 * kb) * DM + c0; d.gain = nullptr; d.dst = (bf16_t*)(wb + (WS_WP - WS_WIN)) + (size_t)c0 * BW + 64 * kb; d.ldw = DM; d.ldt = BW; return; }
    r -= I_P;
    if (r < I_P) { const int nblk = DM / 32, kb = r / nblk, c0 = 32 * (r % nblk);
        d.src = A.in[6] + (size_t)layer * BW * DM + (size_t)(64 * kb) * DM + c0; d.gain = nullptr; d.dst = (bf16_t*)(wb + (WS_WP - WS_WIN)) + (size_t)DM * BW + (size_t)c0 * BW + 64 * kb; d.ldw = DM; d.ldt = BW; return; }
    r -= I_P;
    if (r < I_P) { const int nblk = DM / 32, kb = r / nblk, c0 = 32 * (r % nblk);
        d.src = A.in[7] + (size_t)layer * BW * DM + (size_t)(64 * kb) * DM + c0; d.gain = nullptr; d.dst = (bf16_t*)(wb + (WS_WP - WS_WIN)) + (size_t)2 * DM * BW + (size_t)c0 * BW + 64 * kb; d.ldw = DM; d.ldt = BW; return; }
    r -= I_P;
    if (r < I_O) { const int nblk = DM / 32, kb = r / nblk, c0 = 32 * (r % nblk);
        d.src = A.in[8] + (size_t)layer * DM * DM + (size_t)(64 * kb) * DM + c0; d.gain = nullptr; d.dst = (bf16_t*)(wb + (WS_WO - WS_WIN)) + (size_t)c0 * DM + 64 * kb; d.ldw = DM; d.ldt = DM; return; }
    r -= I_O;
    if (r < I_G) { const int nblk = DFF / 32, kb = r / nblk, c0 = 32 * (r % nblk);
        d.src = A.in[10] + (size_t)layer * DM * DFF + (size_t)(64 * kb) * DFF + c0; d.gain = A.in[9] + (size_t)layer * DM + 64 * kb; d.dst = (bf16_t*)(wb + (WS_WGU - WS_WIN)) + (size_t)(256 * (c0 >> 7) + (c0 & 127)) * DM + 64 * kb; d.ldw = DFF; d.ldt = DM; return; }
    r -= I_G;
    if (r < I_G) { const int nblk = DFF / 32, kb = r / nblk, c0 = 32 * (r % nblk);
        d.src = A.in[11] + (size_t)layer * DM * DFF + (size_t)(64 * kb) * DFF + c0; d.gain = A.in[9] + (size_t)layer * DM + 64 * kb; d.dst = (bf16_t*)(wb + (WS_WGU - WS_WIN)) + (size_t)(256 * (c0 >> 7) + 128 + (c0 & 127)) * DM + 64 * kb; d.ldw = DFF; d.ldt = DM; return; }
    r -= I_G;
    { const int nblk = DM / 32, kb = r / nblk, c0 = 32 * (r % nblk);
      d.src = A.in[12] + (size_t)layer * DFF * DM + (size_t)(64 * kb) * DM + c0; d.gain = nullptr; d.dst = (bf16_t*)(wb + (WS_WD - WS_WIN)) + (size_t)c0 * DFF + 64 * kb; d.ldw = DM; d.ldt = DFF; }
}


__global__ void __launch_bounds__(NWAVES * 64, 2) hybrid_fwd(Args args) {
    extern __shared__ __attribute__((aligned(16))) unsigned char lds_raw[];
    LAS unsigned char* lds = (LAS unsigned char*)lds_raw;
    volatile LAS unsigned* MISC = (volatile LAS unsigned*)(lds + MISC_OFF);
    const int wave = __builtin_amdgcn_readfirstlane((int)threadIdx.x >> 6);
    const int G = gridDim.x, bx = blockIdx.x, vcu = (G % 8 == 0) ? (bx % 8) * (G / 8) + bx / 8 : bx;
    for (int i = threadIdx.x; i < (LDS_BYTES - LDSCTL_OFF) / 4; i += NWAVES * 64) ((LAS unsigned*)(lds + LDSCTL_OFF))[i] = 0u;
    __syncthreads();
    XcdBarrier bar = xcd_barrier_post((unsigned*)(args.ws + WS_CTL) + CW_BAR, MISC + 8);
    const int gw = vcu * NWAVES + wave, NGW = G * NWAVES;

    for (int pq = 0; pq < DEPTH * 7 + 1; ++pq) {
        const int layer = pq / 7, ph = pq - 7 * layer;
        int tid = wave * 64 + lane_id(); asm volatile("" : "+v"(tid)); const int lane = tid & 63;
        size_t opq = 0; asm volatile("" : "+s"(opq));
        unsigned char* ws = args.ws + opq; const float* x_in = args.in[0] + opq; float* out = args.out + opq;
        float* ssA = (float*)(ws + WS_SSA); float* ssB = (float*)(ws + WS_SSB); float* kmp = (float*)(ws + WS_KM);
        bf16_t* xb = (bf16_t*)(ws + WS_XB);
        bf16_t* QA = (bf16_t*)(ws + WS_QA); bf16_t* KA = (bf16_t*)(ws + WS_KA); bf16_t* VA = (bf16_t*)(ws + WS_VA);
        bf16_t* QS = (bf16_t*)(ws + WS_QS); bf16_t* KS = (bf16_t*)(ws + WS_KS); bf16_t* VS = (bf16_t*)(ws + WS_VS);
        bf16_t* Ub = (bf16_t*)(ws + WS_U); bf16_t* BC = (bf16_t*)(ws + WS_BC); bf16_t* MG = (bf16_t*)(ws + WS_MG); bf16_t* ACT = (bf16_t*)(ws + WS_ACT);

        if (layer == DEPTH) {
            const float* gf = args.in[13];
            for (int m = gw; m < M; m += NGW) {
                const float rs = rstd_row(ssA, m);
                f32x4* xr = (f32x4*)(out + (size_t)m * DM) + lane; const f32x4* gr = (const f32x4*)gf + lane; const u32x2* xs = (const u32x2*)(xb + (size_t)m * DM) + lane;
#pragma unroll
                for (int j = 0; j < 4; ++j) { const u32x2 w = xs[64 * j]; const f32x4 v = {bf_lo(w.x), bf_hi(w.x), bf_lo(w.y), bf_hi(w.y)}, g = gr[64 * j]; xr[64 * j] = v * rs * g; }
            }
            if (xb_ld((unsigned*)(ws + WS_CTL) + CW_BAR + XB_TMO) != 0u && bx == 0) { for (int i = tid; i < 4096; i += NWAVES * 64) out[i] = __builtin_nanf(""); }
            break;
        }
        if (ph == 0) {
            LAS float* scr = (LAS float*)(lds + RING_OFF + wave * 16384);
            {
                constexpr int NIT2 = NITEMS; unsigned char* wb_ = layer == 0 ? ws + WS_WIN : (unsigned char*)out;
#define TR_DEC(i_, d_) tr_decode(i_, d_, args, layer, wb_)
                int it = gw;
                for (; it + NGW < NIT2; it += 2 * NGW) {
                    TrD da, db; f32x4 va[8], vb[8]; float ga[8], gb[8];
                    TR_DEC(it, da); tr_load(da, va, ga, lane);
                    TR_DEC(it + NGW, db); tr_load(db, vb, gb, lane);
                    tr_store(da, va, ga, scr, lane); tr_store(db, vb, gb, scr, lane);
                }
                if (it < NIT2) { TrD da; f32x4 va[8]; float ga[8]; TR_DEC(it, da); tr_load(da, va, ga, lane); tr_store(da, va, ga, scr, lane); }
#undef TR_DEC
            }
            if (layer == 0) {
                for (int m = gw; m < M; m += NGW) {
                    const f32x4* xr = (const f32x4*)(x_in + (size_t)m * DM) + lane; f32x4 v[4]; float s = 0.f;
#pragma unroll
                    for (int j = 0; j < 4; ++j) { v[j] = xr[64 * j]; s += (v[j].x * v[j].x + v[j].y * v[j].y) + (v[j].z * v[j].z + v[j].w * v[j].w); }
                    s = wave_sum(s);
                    u32x2* o8 = (u32x2*)(xb + (size_t)m * DM) + lane;
#pragma unroll
                    for (int j = 0; j < 4; ++j) o8[64 * j] = (u32x2){cvt_pk_bf16(v[j].x, v[j].y), cvt_pk_bf16(v[j].z, v[j].w)};
                    if (lane < 4) ssA[(size_t)m * 4 + lane] = (lane == 0) ? s : 0.f;
                }
            }
        } else if (ph == 2) {
            LAS unsigned char* vst = lds + RING_OFF + wave * 16384;
            LAS float* wsf = (LAS float*)(lds + ATT_OFF + wave * 512);
            LAS float* km = (LAS float*)(lds + ATT_OFF + 4096);
            LAS unsigned* selm = (LAS unsigned*)(lds + ATT_OFF + 12288);
            LAS unsigned* cnt = (LAS unsigned*)(lds + ATT_OFF + 13312);
            LAS float* kbn = (LAS float*)(lds + ATT_OFF + 13312 + 256);
            LAS unsigned* uslot = (LAS unsigned*)(lds + ATT_OFF + 13312 + 512);
            LAS unsigned char* lists = lds + ATT_OFF + 14336;
            LAS unsigned* trow = (LAS unsigned*)(lds + ATT_OFF + 22528 + wave * 128);
            unsigned char* recO = ws + WS_MG + (size_t)vcu * 131072; float* recML = (float*)(ws + WS_X + (size_t)vcu * 8192);
            unsigned* qbase = (unsigned*)(ws + WS_CTL) + 14336 + layer * 512;
            int xq = (int)(bar.x & 7u);
            float* kbmax = (float*)((unsigned*)(ws + WS_CTL) + 8192 + 4096 + layer * 512);
            for (;;) {
                if (wave == 0) {
                    unsigned got = 0xffffffffu;
                    if (lane == 0) { const unsigned u_ = __hip_atomic_fetch_add(qbase + xq * 64, 1u, __ATOMIC_RELAXED, __HIP_MEMORY_SCOPE_AGENT); if (u_ < 224u) got = (unsigned)xq * 256u + u_; }
                    got = (unsigned)__builtin_amdgcn_readfirstlane((int)got);
                    while (got == 0xffffffffu) {
                        const unsigned c_ = lane < 8 ? __hip_atomic_load(qbase + lane * 64, __ATOMIC_RELAXED, __HIP_MEMORY_SCOPE_AGENT) : 224u;
                        const unsigned mk = (unsigned)__ballot(c_ < 224u) & 0xffu;
                        if (mk == 0u) break;
                        const unsigned rot = ((mk >> xq) | (mk << (8 - xq))) & 0xffu;
                        const int j_ = (xq + __builtin_ctz(rot)) & 7;
                        if (lane == 0) { const unsigned u_ = __hip_atomic_fetch_add(qbase + j_ * 64, 1u, __ATOMIC_RELAXED, __HIP_MEMORY_SCOPE_AGENT); if (u_ < 224u) got = (unsigned)j_ * 256u + u_; }
                        got = (unsigned)__builtin_amdgcn_readfirstlane((int)got);
                        xq = j_;
                    }
                    if (lane == 0) *uslot = got;
                }
                __syncthreads();
                const unsigned uq_ = *uslot;
                __syncthreads();
                if (uq_ == 0xffffffffu) break;
                const int xu = (int)(uq_ >> 8), ul = (int)(uq_ & 255u);
                if (ul >= 192) { const unsigned ucv = (unsigned)(xu * 32 + (ul - 192));
                    const float* cw = args.in[4] + (size_t)layer * 3 * BW;
#pragma unroll 1
                    for (int k8 = 0; k8 < 8; ++k8) { const int i = (int)ucv * 4096 + k8 * (NWAVES * 64) + tid;
                        const int t = i >> 6, c = (i & 63) * 8; const int tt = t & (SEQ - 1);
                        const u32x4 u2 = *(const u32x4*)(Ub + (size_t)t * BW + c);
                        u32x4 u1 = {0u, 0u, 0u, 0u}, u0 = {0u, 0u, 0u, 0u};
                        if (tt >= 1) u1 = *(const u32x4*)(Ub + (size_t)(t - 1) * BW + c);
                        if (tt >= 2) u0 = *(const u32x4*)(Ub + (size_t)(t - 2) * BW + c);
                        const u32x4 bw = *(const u32x4*)(BC + (size_t)t * BW + c);
                        float y[8];
#pragma unroll
                        for (int e = 0; e < 4; ++e) {
                            const float w0l = cw[c + 2 * e], w0h = cw[c + 2 * e + 1], w1l = cw[BW + c + 2 * e], w1h = cw[BW + c + 2 * e + 1], w2l = cw[2 * BW + c + 2 * e], w2h = cw[2 * BW + c + 2 * e + 1];
                            y[2 * e] = bf_lo(bw[e]) * (w0l * bf_lo(u0[e]) + w1l * bf_lo(u1[e]) + w2l * bf_lo(u2[e]));
                            y[2 * e + 1] = bf_hi(bw[e]) * (w0h * bf_hi(u0[e]) + w1h * bf_hi(u1[e]) + w2h * bf_hi(u2[e]));
                        }
                        *(u32x4*)(BC + (size_t)t * BW + c) = (u32x4){cvt_pk_bf16(y[0], y[1]), cvt_pk_bf16(y[2], y[3]), cvt_pk_bf16(y[4], y[5]), cvt_pk_bf16(y[6], y[7])}; }
                    continue;
                }
                if (ul < 64) {
                    const int b = xu & 1, h = (ul >> 5) ? (xu >> 1) : 7 - (xu >> 1), bh = b * 8 + h, n = ul & 31;
                    const int key_ = n * 256 + (tid >> 1); const bf16_t* kp = KA + (size_t)(b * NH + h) * SEQ * HD + (size_t)(key_ >> 5) * 2048 + (tid & 1) * 1024 + (key_ & 31) * 8;
                    float sq = 0.f;
#pragma unroll
                    for (int c = 0; c < 4; ++c) { const u32x4 x = *(const u32x4*)(kp + c * 256); const float e0 = bf_lo(x.x), e1 = bf_hi(x.x), e2 = bf_lo(x.y), e3 = bf_hi(x.y), e4 = bf_lo(x.z), e5 = bf_hi(x.z), e6 = bf_lo(x.w), e7 = bf_hi(x.w);
                        sq += (e0 * e0 + e1 * e1) + (e2 * e2 + e3 * e3) + (e4 * e4 + e5 * e5) + (e6 * e6 + e7 * e7); }
                    sq += xshfl<1>(sq);
                    sq = __builtin_fmaxf(sq, xshfl<2>(sq)); sq = __builtin_fmaxf(sq, xshfl<4>(sq)); sq = __builtin_fmaxf(sq, xshfl<8>(sq)); sq = __builtin_fmaxf(sq, xshfl<16>(sq));
                    { float x1; const float x0 = att::swap_lo(sq, x1); sq = __builtin_fmaxf(x0, x1); }
                    if (lane == 0) kbn[wave] = sq;
                    __syncthreads();
                    if (tid == 0) { float m_ = kbn[0];
#pragma unroll
                        for (int w_ = 1; w_ < NWAVES; ++w_) m_ = __builtin_fmaxf(m_, kbn[w_]);
                        __hip_atomic_store((unsigned*)kbmax + bh * 32 + n, __float_as_uint(m_) | 1u, __ATOMIC_RELAXED, __HIP_MEMORY_SCOPE_AGENT); }
                    __syncthreads();
                } else if (ul < 128) {
                    const int b = xu & 1, h = ((ul - 64) >> 5) ? (xu >> 1) : 7 - (xu >> 1), blk = 31 - (ul & 31);
                    unsigned kb_ = 1u; if (tid < 32) kb_ = __hip_atomic_load((unsigned*)kbmax + (b * 8 + h) * 32 + tid, __ATOMIC_RELAXED, __HIP_MEMORY_SCOPE_AGENT);
                    const size_t qrow = (size_t)b * SEQ + blk * 256 + wave * 32;
                    bf16x8 gq[4], gk[4]; att::gate_load(gq, gk, QA + qrow * BW + h * HD, KA + (size_t)(b * NH + h) * SEQ * HD, blk * 256 + wave * 32, lane);
                    for (int i = tid; i < 2048; i += NWAVES * 64) { const int n = i >> 6, d = i & 63; const size_t o = (size_t)((b * 32 + n) * 2) * BW + h * HD + d; km[n * 64 + ((((d >> 2) ^ (n & 15)) << 2) | (d & 3))] = kmp[o] + kmp[o + BW]; }
                    if (tid < 32) {
                        unsigned sp_ = 0; while (kb_ == 0u) { __builtin_amdgcn_s_sleep(2); kb_ = __hip_atomic_load((unsigned*)kbmax + (b * 8 + h) * 32 + tid, __ATOMIC_RELAXED, __HIP_MEMORY_SCOPE_AGENT);
                            if (++sp_ > (1u << 20)) { atomicAdd((unsigned*)(ws + WS_CTL) + CW_BAR + XB_TMO, 1u); break; } }
                        kbn[tid] = sqrtf(__uint_as_float(kb_)) * 1.01f; }
                    __syncthreads();
                    const float sl2 = __builtin_amdgcn_exp2f(-(float)(h + 1)) * LOG2E;
                    const unsigned sel = att::moba_gate(gq, gk, blk, blk * 256 + wave * 32, sl2, km, kbn, lane);
                    if (lane < 32) selm[wave * 32 + lane] = sel;
                    __syncthreads();
                    for (int n = wave; n < blk; n += NWAVES) {
                        unsigned pos = 0;
#pragma unroll
                        for (int c = 0; c < 4; ++c) { const int q = 64 * c + lane; const bool bit = (selm[q] >> n) & 1u; const unsigned long long mk = __ballot(bit);
                            if (bit) lists[n * 256 + pos + __builtin_amdgcn_mbcnt_hi((unsigned)(mk >> 32), __builtin_amdgcn_mbcnt_lo((unsigned)mk, 0u))] = (unsigned char)q;
                            pos += (unsigned)__builtin_popcountll(mk); }
                        if (lane == 0) cnt[n] = pos;
                    }
                    __syncthreads();
                    { int n = blk, t = wave; int nn = 0, tt = 0, idp = 0;
                      for (;;) {
                          att::moba_item(QA, KA, VA, b, h, blk, n, t, lists, cnt, selm, recO, recML, vst, wsf, trow, lane);
                          bool found = false;
                          while (nn < blk) { const int nt_ = ((int)cnt[nn] + 31) >> 5;
                              if (tt < nt_) { const bool mine = (idp & (NWAVES - 1)) == wave; if (mine) { n = nn; t = tt; found = true; } ++tt; ++idp; if (mine) break; }
                              else { ++nn; tt = 0; } }
                          if (!found) break;
                      } }
                    VM_WAIT();
                    __syncthreads();
                    att::moba_merge(QA, b, h, blk, wave, selm, recO, recML, wsf, lane);
                    __syncthreads();
                } else {
                    const int b = xu & 1, h = (xu >> 1) * 2 + ((ul - 128) >> 5), blk = ul & 31;
                    att::sb_item(QS, KS, VS, b, h, blk * 256 + wave * 32, vst, lane);
                }
            }
        } else {
            static_assert(WS_QS - WS_QA == 48 * MiB && WS_BC - WS_QS == 48 * MiB && WS_VA - WS_KA == 16 * MiB && WS_KS - WS_KA == 48 * MiB, "O_a / O_s / O_c 48 MiB apart; gate scratch = K_a | V_a | K_s");
            GCfg c{};
            c.ws = ws; c.wb = layer == 0 ? ws + WS_WIN : (unsigned char*)out; c.bgate = args.in[3] + (size_t)layer * NGATE; c.red = (LAS float*)(lds + LDSCTL_OFF + 1024);
            c.nseg = 1; c.lda = DM; c.ldb = DM; c.nt = DM / 64; c.toA = 0;
            if (ph == 1) { c.mode = 0; c.N = N1; c.A = xb; c.B = (const bf16_t*)c.wb; }
            else if (ph == 3) { c.mode = 1; c.N = DM; c.nseg = 6; c.A = xb; c.B = (const bf16_t*)(c.wb + (WS_WG - WS_WIN)); }
            else if (ph == 4) { c.mode = 2; c.N = DM; c.A = MG; c.B = (const bf16_t*)(c.wb + (WS_WO - WS_WIN)); }
            else if (ph == 5) { c.mode = 3; c.N = NGU; c.A = xb; c.B = (const bf16_t*)(c.wb + (WS_WGU - WS_WIN)); }
            else { c.mode = 2; c.N = DM; c.A = ACT; c.B = (const bf16_t*)(c.wb + (WS_WD - WS_WIN)); c.lda = DFF; c.ldb = DFF; c.nt = DFF / 64; c.toA = 1; }
            ProbAny P{&c}; EpiAny E{&c}; pg8::StaticOrder S; S.init(M, c.N, G, bx, c.nseg);
            pg8::gemm_phase(lds + RING_OFF, P, S, E, wave);
        }
        if (!(ph == 6 && layer + 1 < DEPTH)) xcd_barrier(bar, tid);
    }
}

extern "C" void kernel_launch(void* const* d_in, const int* in_sizes, int n_in, void* d_out, int out_size, void* d_ws, size_t ws_size, hipStream_t stream) {
    static int grid = 0;
    if (grid == 0) {
        if (n_in != 14 || in_sizes[0] != M * DM || out_size != M * DM || ws_size < WS_END) { fprintf(stderr, "kernel_launch: unexpected shapes (n_in %d, in0 %d, out %d, ws %zu)\n", n_in, n_in > 0 ? in_sizes[0] : -1, out_size, ws_size); grid = -1; return; }
        int dev = 0, cus = 0, per_cu = 0;
        if (hipGetDevice(&dev) != hipSuccess || hipDeviceGetAttribute(&cus, hipDeviceAttributeMultiprocessorCount, dev) != hipSuccess) { grid = -1; return; }
        if (hipFuncSetAttribute((const void*)hybrid_fwd, hipFuncAttributeMaxDynamicSharedMemorySize, LDS_BYTES) != hipSuccess) { fprintf(stderr, "kernel_launch: hipFuncSetAttribute failed\n"); grid = -1; return; }
        if (hipOccupancyMaxActiveBlocksPerMultiprocessor(&per_cu, (const void*)hybrid_fwd, NWAVES * 64, LDS_BYTES) != hipSuccess || per_cu < 1) { fprintf(stderr, "kernel_launch: occupancy query says %d blocks/CU\n", per_cu); (void)hipGetLastError(); per_cu = 1; }
        grid = cus;
    }
    if (grid < 0) return;
    if (hipMemsetAsync((char*)d_ws + WS_CTL, 0, CTL_ZERO_BYTES, stream) != hipSuccess) { fprintf(stderr, "kernel_launch: memset failed\n"); return; }
    Args a{};
    for (int i = 0; i < 14; ++i) a.in[i] = (const float*)d_in[i];
    a.out = (float*)d_out; a.ws = (unsigned char*)d_ws;
    void* kargs[] = {&a};
    hipError_t e = hipLaunchCooperativeKernel((const void*)hybrid_fwd, dim3(grid), dim3(NWAVES * 64), kargs, LDS_BYTES, stream);
    if (e != hipSuccess) fprintf(stderr, "kernel_launch: cooperative launch failed: %s (grid %d)\n", hipGetErrorString(e), grid);
}
```

```cpp
#include <hip/hip_runtime.h>
#include <hip/hip_bf16.h>
#include <cstdio>
#include <cstdint>

#define GAS __attribute__((address_space(1)))
#define LAS __attribute__((address_space(3)))
typedef unsigned short bf16_t;
typedef short bf16x8 __attribute__((ext_vector_type(8)));
typedef short s16x4 __attribute__((ext_vector_type(4)));
typedef float f32x2 __attribute__((ext_vector_type(2)));
typedef float f32x4 __attribute__((ext_vector_type(4)));
typedef float f32x16 __attribute__((ext_vector_type(16)));
typedef unsigned u32x2 __attribute__((ext_vector_type(2)));
typedef unsigned u32x4 __attribute__((ext_vector_type(4)));
typedef GAS unsigned gu32;

constexpr int BATCH = 2, SEQ = 8192, DM = 1024, M = BATCH * SEQ, NH = 8, HD = 64, BW = 512, DFF = 2816, DEPTH = 2;
constexpr int NIN = 7680, N1 = 4608, NGATE = 3072, NGU = 2 * DFF;
constexpr float RMS_EPS = 1e-6f;
constexpr float LOG2E = 1.4426950408889634f;
constexpr float C2 = 0.125f * LOG2E;
constexpr int NWAVES = 8;

constexpr size_t MiB = 1u << 20;
constexpr size_t WS_CTL = 0, CTL_ZERO_BYTES = 64 * 1024;
constexpr size_t WS_SSA = 1 * MiB, WS_SSB = 2 * MiB, WS_KM = 3 * MiB;
constexpr size_t WS_WIN = 4 * MiB, WS_WG = 13 * MiB, WS_WP = 19 * MiB, WS_WO = 22 * MiB, WS_WGU = 24 * MiB, WS_WD = 35 * MiB;
constexpr size_t WS_XB = 41 * MiB;
constexpr size_t WS_QA = 73 * MiB, WS_KA = 89 * MiB, WS_VA = 105 * MiB, WS_QS = 121 * MiB, WS_KS = 137 * MiB, WS_VS = 153 * MiB;
constexpr size_t WS_BC = 169 * MiB, WS_U = 185 * MiB, WS_MG = 201 * MiB, WS_X = 233 * MiB;
constexpr size_t WS_ACT = 73 * MiB;
constexpr size_t WS_END = 256 * MiB;
constexpr int CW_BAR = 4096;

constexpr int RING_OFF = 0, RING_BYTES = 131072;
constexpr int ATT_OFF = RING_BYTES, ATT_BYTES = 23552;
constexpr int LDSCTL_OFF = ATT_OFF + ATT_BYTES, MISC_OFF = LDSCTL_OFF + 320;
constexpr int LDS_BYTES = 163840;
static_assert(LDSCTL_OFF + 1024 + 4096 <= LDS_BYTES, "LDS map");

#define LDS_WAIT() asm volatile("s_waitcnt lgkmcnt(0)" ::: "memory")
#define VM_WAIT() asm volatile("s_waitcnt vmcnt(0)" ::: "memory")
#define RLX_AGENT __ATOMIC_RELAXED, __HIP_MEMORY_SCOPE_AGENT

typedef __bf16 bf16x2_t __attribute__((ext_vector_type(2)));
__device__ __forceinline__ unsigned cvt_pk_bf16(float lo, float hi) { const f32x2 v = {lo, hi}; const bf16x2_t b = __builtin_convertvector(v, bf16x2_t); return __builtin_bit_cast(unsigned, b); }
template <int O> __device__ __forceinline__ float xshfl(float x) {
    static_assert(O < 32, "use sum32 for the two 32-lane halves");
    return __int_as_float(__builtin_amdgcn_ds_swizzle(__float_as_int(x), (O << 10) | 0x1f));
}
__device__ __forceinline__ int lane_id() { return (int)__builtin_amdgcn_mbcnt_hi(~0u, __builtin_amdgcn_mbcnt_lo(~0u, 0u)); }
__device__ __forceinline__ float sum32(float x) { auto rr = __builtin_amdgcn_permlane32_swap(__float_as_uint(x), __float_as_uint(x), false, false); return __uint_as_float(rr[0]) + __uint_as_float(rr[1]); }
__device__ __forceinline__ float bf_lo(unsigned w) { return __uint_as_float(w << 16); }
__device__ __forceinline__ float bf_hi(unsigned w) { return __uint_as_float(w & 0xffff0000u); }
__device__ __forceinline__ float rstd_row(const float* ssp, int row) {
    const f32x4 a = *(const f32x4*)(ssp + (size_t)row * 4);
    return rsqrtf(((a.x + a.y) + (a.z + a.w)) * (1.0f / DM) + RMS_EPS);
}

namespace pg8 {
constexpr int BM = 256, BK = 64, HALF = 128, HTB = HALF * BK * 2, STAGE_BYTES = 8 * HTB, NXCD = 8, WGM = 8;
__host__ __device__ __forceinline__ int lds_byte(int r, int c) { const int st = (r >> 4) * 2 + (c >> 5), rr = r & 15, cc = c & 31, ob = rr * 64 + cc * 2; return st * 1024 + (ob ^ (((ob >> 9) & 1) << 5)); }
__host__ __device__ __forceinline__ void stage_rc(int b, int& R, int& C) { const int st = b / 1024, sb = b % 1024, swz = sb ^ (((sb >> 9) & 1) << 5); R = (st >> 1) * 16 + swz / 64; C = (st & 1) * 32 + (swz % 64) / 2; }
__host__ __device__ __forceinline__ int perm32(int rho) { const int n = rho >> 4, i = rho & 15; return 8 * (i >> 2) + 4 * n + (i & 3); }

struct Unit { int pm, pn, seg; };
struct Seg { const char* A; const char* B; unsigned hA, hB; int lda, ldb, nt; };

struct StaticOrder {
    int nM, nN, nwg, G, c, nseg;
    __device__ void init(int M_, int N_, int G_, int c_, int nseg_) { nM = M_ / BM; nN = N_ / BM; nwg = nM * nN; G = G_; c = c_; nseg = nseg_; }
    __device__ bool next(int i, Unit& u) const {
        const int ti = (nseg == 1) ? i : i / nseg; u.seg = i - ti * nseg;
        const long L = (long)ti * G + c; if (L >= nwg) return false;
        int wgid = (int)L; { const int q = nwg / NXCD, r = nwg % NXCD, xcd = wgid % NXCD, off = wgid / NXCD; wgid = (xcd < r ? xcd * (q + 1) : r * (q + 1) + (xcd - r) * q) + off; }
        const int nig = WGM * nN, gid = wgid / nig, fm = gid * WGM, gsz = (nM - fm) < WGM ? (nM - fm) : WGM;
        u.pm = fm + ((wgid % nig) % gsz); u.pn = (wgid % nig) / gsz; return true;
    }
};

template <class Prob, class Epi, class Sched>
__device__ __forceinline__ void gemm_phase(LAS unsigned char* lds, const Prob& P, const Sched& S, const Epi& E, int wave_) {
    int tid = wave_ * 64 + lane_id(); asm volatile("" : "+v"(tid));
    const int wid = wave_, lane = tid & 63, wr = wid >> 2, wc = wid & 3, fr = lane & 15, fq = lane >> 4;
#define PG8_RC(R0, C0, Rb0) int R0, C0; { int t_ = tid; asm volatile("" : "+v"(t_)); stage_rc(t_ * 16, R0, C0); } const int Rb0 = (R0 & ~31) + perm32(R0 & 31)
    const size_t kstep = (size_t)(BK * 2);
    const unsigned ldsw = (unsigned)wid * 1024u;
    const int aoff = lds_byte(wr * 64 + fr, fq * 8), boff = lds_byte(wc * 32 + fr, fq * 8);
#define PG8_SA(b, h) (((b) * 2 + (h)) * HTB)
#define PG8_SB(b, h) ((4 + (b) * 2 + (h)) * HTB)
#define PG8_STAGE(bufoff, gbase, v0, q) do { \
        __builtin_amdgcn_global_load_lds((const unsigned*)((const char*)(gbase) + (v0)), (LAS unsigned*)(lds + (bufoff) + ldsw), 16, 0, 0); \
        __builtin_amdgcn_global_load_lds((const unsigned*)((const char*)(gbase) + (q) + (v0)), (LAS unsigned*)(lds + (bufoff) + ldsw + 8192), 16, 0, 0); } while (0)
#define PG8_LDA(dst, b, h) do { _Pragma("unroll") for (int m = 0; m < 4; ++m) _Pragma("unroll") for (int k = 0; k < 2; ++k) dst[m][k] = *(const LAS bf16x8*)(lds + PG8_SA(b, h) + aoff + m * 2048 + k * 1024); } while (0)
#define PG8_LDB(dst, b, h) do { _Pragma("unroll") for (int n = 0; n < 2; ++n) _Pragma("unroll") for (int k = 0; k < 2; ++k) dst[n][k] = *(const LAS bf16x8*)(lds + PG8_SB(b, h) + boff + n * 2048 + k * 1024); } while (0)
#define PG8_MMA(ai, bj, At, Bt) do { __builtin_amdgcn_s_setprio(1); _Pragma("unroll") for (int m = 0; m < 4; ++m) _Pragma("unroll") for (int n = 0; n < 2; ++n) _Pragma("unroll") for (int k = 0; k < 2; ++k) \
        acc[ai][bj][m][n] = __builtin_amdgcn_mfma_f32_16x16x32_bf16(Bt[n][k], At[m][k], acc[ai][bj][m][n], 0, 0, 0); __builtin_amdgcn_s_setprio(0); } while (0)
#define PG8_WAIT_V(n) asm volatile("s_waitcnt vmcnt(" #n ")" ::: "memory")
#define PG8_WAIT_L(n) asm volatile("s_waitcnt lgkmcnt(" #n ")" ::: "memory")
#define PG8_BAR __builtin_amdgcn_s_barrier()
#define PG8_SCHED __builtin_amdgcn_sched_barrier(0)
    Unit cur, nxt; int ui = 0;
    if (!S.next(0, cur)) return;
    Seg sc, sn; P.seg(cur, sc);
    unsigned vAc0, vBc0; { PG8_RC(R0, C0, Rb0); vAc0 = (unsigned)(R0 * sc.lda + C0) * 2u; vBc0 = (unsigned)(Rb0 * sc.ldb + C0) * 2u; }
    f32x4 acc[2][2][4][2];
#pragma unroll
    for (int a = 0; a < 2; ++a)
#pragma unroll
        for (int b = 0; b < 2; ++b)
#pragma unroll
            for (int m = 0; m < 4; ++m)
#pragma unroll
                for (int n = 0; n < 2; ++n) acc[a][b][m][n] = (f32x4){0.f, 0.f, 0.f, 0.f};
    bf16x8 At[4][2], B0[2][2], B1[2][2];
    const char* cA = sc.A; const char* cB = sc.B;
    PG8_STAGE(PG8_SB(0, 0), cB, vBc0, sc.hB >> 1); PG8_STAGE(PG8_SB(0, 1), cB + sc.hB, vBc0, sc.hB >> 1); PG8_STAGE(PG8_SA(0, 0), cA, vAc0, sc.hA >> 1); PG8_STAGE(PG8_SA(0, 1), cA + sc.hA, vAc0, sc.hA >> 1);
    if (wr == 1) PG8_BAR;
    PG8_WAIT_V(2); PG8_BAR;
    PG8_STAGE(PG8_SB(1, 0), cB + kstep, vBc0, sc.hB >> 1); PG8_STAGE(PG8_SA(1, 0), cA + kstep, vAc0, sc.hA >> 1); PG8_STAGE(PG8_SB(1, 1), cB + sc.hB + kstep, vBc0, sc.hB >> 1);
    PG8_WAIT_V(6); PG8_BAR;
    for (;;) {
        const bool has_next = S.next(ui + 1, nxt);
        if (has_next) P.seg(nxt, sn); else sn = sc;
        unsigned vAn0, vBn0; { PG8_RC(R0, C0, Rb0); vAn0 = (unsigned)(R0 * sn.lda + C0) * 2u; vBn0 = (unsigned)(Rb0 * sn.ldb + C0) * 2u; }
        const char* nA = sn.A; const char* nB = sn.B;
        const int nt = sc.nt;
        for (int t = 0; t < nt; t += 2) {
            const bool last = (t == nt - 2);
            const char* a1 = cA + (size_t)(t + 1) * kstep;
            const char* a2 = last ? nA : cA + (size_t)(t + 2) * kstep; const char* b2 = last ? nB : cB + (size_t)(t + 2) * kstep;
            const char* a3 = a2 + kstep; const char* b3 = b2 + kstep;
            const unsigned hA2 = last ? sn.hA : sc.hA, hB2 = last ? sn.hB : sc.hB;
            const unsigned vA0 = last ? vAn0 : vAc0, vB0 = last ? vBn0 : vBc0, qA = hA2 >> 1, qB = hB2 >> 1;
            PG8_LDB(B0, 0, 0); PG8_LDB(B1, 0, 1); PG8_SCHED; PG8_LDA(At, 0, 0); PG8_STAGE(PG8_SA(1, 1), a1 + sc.hA, vAc0, sc.hA >> 1);
            PG8_WAIT_V(8); PG8_WAIT_L(0); PG8_BAR; PG8_MMA(0, 0, At, B0); PG8_MMA(0, 1, At, B1); PG8_BAR; PG8_SCHED;
            PG8_LDA(At, 0, 1); PG8_STAGE(PG8_SB(0, 0), b2, vB0, qB); PG8_STAGE(PG8_SB(0, 1), b2 + hB2, vB0, qB); PG8_STAGE(PG8_SA(0, 0), a2, vA0, qA);
            PG8_WAIT_V(8); PG8_WAIT_L(0); PG8_BAR; PG8_MMA(1, 0, At, B0); PG8_MMA(1, 1, At, B1); PG8_BAR; PG8_SCHED;
            PG8_LDB(B0, 1, 0); PG8_LDB(B1, 1, 1); PG8_SCHED; PG8_LDA(At, 1, 0); PG8_STAGE(PG8_SA(0, 1), a2 + hA2, vA0, qA);
            PG8_WAIT_V(8); PG8_WAIT_L(0); PG8_BAR; PG8_MMA(0, 0, At, B0); PG8_MMA(0, 1, At, B1); PG8_BAR; PG8_SCHED;
            PG8_LDA(At, 1, 1); PG8_STAGE(PG8_SB(1, 0), b3, vB0, qB); PG8_STAGE(PG8_SB(1, 1), b3 + hB2, vB0, qB); PG8_STAGE(PG8_SA(1, 0), a3, vA0, qA);
            PG8_WAIT_V(8); PG8_WAIT_L(0); PG8_BAR; PG8_MMA(1, 0, At, B0); PG8_MMA(1, 1, At, B1); PG8_BAR; PG8_SCHED;
        }
        if (wr == 0) PG8_BAR;
        { int wr_ = wr, wc_ = wc, t_ = tid;
          asm volatile("" : "+s"(wr_), "+s"(wc_), "+v"(t_)); const int fr_ = t_ & 15, fq_ = (t_ >> 4) & 3;
          E(acc, cur, wr_, wc_, fr_, fq_); }
        if (!has_next) break;
#pragma unroll
        for (int a = 0; a < 2; ++a)
#pragma unroll
            for (int b = 0; b < 2; ++b)
#pragma unroll
                for (int m = 0; m < 4; ++m)
#pragma unroll
                    for (int n = 0; n < 2; ++n) acc[a][b][m][n] = (f32x4){0.f, 0.f, 0.f, 0.f};
        cur = nxt; sc = sn; cA = nA; cB = nB; vAc0 = vAn0; vBc0 = vBn0; ++ui;
        if (wr == 1) PG8_BAR;
    }
    PG8_WAIT_V(0);
    PG8_BAR;
#undef PG8_SA
#undef PG8_SB
#undef PG8_STAGE
#undef PG8_LDA
#undef PG8_LDB
#undef PG8_MMA
#undef PG8_WAIT_V
#undef PG8_WAIT_L
#undef PG8_BAR
#undef PG8_SCHED
#undef PG8_RC
}
}

#define EPI_ARGS const f32x4 (&acc)[2][2][4][2], const pg8::Unit& u, int wr, int wc, int fr, int fq
__device__ __forceinline__ void st_bf16x8(bf16_t* p, f32x4 v0, f32x4 v1) {
    u32x4 w; w.x = cvt_pk_bf16(v0[0], v0[1]); w.y = cvt_pk_bf16(v0[2], v0[3]); w.z = cvt_pk_bf16(v1[0], v1[1]); w.w = cvt_pk_bf16(v1[2], v1[3]);
#ifdef SC1_STORES
    asm volatile("global_store_dwordx4 %0, %1, off sc1\n\ts_nop 1" :: "v"(p), "v"(w) : "memory");
#else
    *(u32x4*)p = w;
#endif
}
template <class T> __device__ __forceinline__ T* bo(T* base, unsigned byte_off) { return (T*)((char*)base + byte_off); }
template <class T> __device__ __forceinline__ const T* bo(const T* base, unsigned byte_off) { return (const T*)((const char*)base + byte_off); }
__device__ __forceinline__ void ld_bf16x8(const bf16_t* p, f32x4& v0, f32x4& v1) {
    const unsigned long long lo = __hip_atomic_load((const unsigned long long*)p, __ATOMIC_RELAXED, __HIP_MEMORY_SCOPE_AGENT), hi = __hip_atomic_load((const unsigned long long*)p + 1, __ATOMIC_RELAXED, __HIP_MEMORY_SCOPE_AGENT);
    const u32x4 w = {(unsigned)lo, (unsigned)(lo >> 32), (unsigned)hi, (unsigned)(hi >> 32)};
    v0 = (f32x4){bf_lo(w.x), bf_hi(w.x), bf_lo(w.y), bf_hi(w.y)}; v1 = (f32x4){bf_lo(w.z), bf_hi(w.z), bf_lo(w.w), bf_hi(w.w)};
}
__device__ __forceinline__ float rstd4(f32x4 a) { return rsqrtf(((a.x + a.y) + (a.z + a.w)) * (1.0f / DM) + RMS_EPS); }
__device__ __forceinline__ void rstd8(float (&rs)[2][4], const float* ss, int pm, unsigned lrow) {
    const float* ssb = ss + (size_t)pm * 256 * 4; unsigned lsb = lrow * 16u; asm volatile("" : "+v"(lsb));
    f32x4 t[2][4];
#pragma unroll
    for (int ai = 0; ai < 2; ++ai)
#pragma unroll
        for (int m = 0; m < 4; ++m) t[ai][m] = *(const f32x4*)bo(ssb, lsb + (unsigned)(ai * 128 + m * 16) * 16u);
#pragma unroll
    for (int ai = 0; ai < 2; ++ai)
#pragma unroll
        for (int m = 0; m < 4; ++m) rs[ai][m] = rstd4(t[ai][m]);
}
struct EpiIn {
    unsigned char* ws;
    __device__ __forceinline__ void operator()(EPI_ARGS) const {
        bf16_t* qkv = (bf16_t*)(ws + WS_QA); bf16_t* ub = (bf16_t*)(ws + WS_U); bf16_t* bc = (bf16_t*)(ws + WS_BC); float* kmp = (float*)(ws + WS_KM); const float* ss = (const float*)(ws + WS_SSA);
        const int pn = u.pn; unsigned lrow = (unsigned)(wr * 64 + fr), lcol = (unsigned)(wc * 32 + 8 * fq);
        asm volatile("" : "+v"(lrow), "+v"(lcol));
        const unsigned lb = (lrow * BW + lcol) * 2u;
        float rs[2][4]; rstd8(rs, ss, u.pm, lrow);
        if (pn < 12 || pn >= 16) {
            const int t = pn >> 1; const float sc = (t == 0 || t == 3) ? C2 : 1.0f;
            bf16_t* base = (pn < 12 ? qkv + (size_t)t * M * BW + (pn & 1) * 256 : bc + (pn - 16) * 256) + (size_t)u.pm * 256 * BW;
            if (t == 1) {
                float* kp = kmp + (size_t)(u.pm * 2 + wr) * BW + (pn & 1) * 256;
#pragma unroll
                for (int bj = 0; bj < 2; ++bj)
#pragma unroll
                    for (int n = 0; n < 2; ++n) { f32x4 s = {0.f, 0.f, 0.f, 0.f};
#pragma unroll
                        for (int ai = 0; ai < 2; ++ai)
#pragma unroll
                            for (int m = 0; m < 4; ++m) s += acc[ai][bj][m][n] * rs[ai][m];
#pragma unroll
                        for (int e = 0; e < 4; ++e) { s[e] += xshfl<1>(s[e]); s[e] += xshfl<2>(s[e]); s[e] += xshfl<4>(s[e]); s[e] += xshfl<8>(s[e]); }
                        if (fr == 0) *(f32x4*)bo(kp, (lcol + (unsigned)(bj * 128 + 4 * n)) * 4u) = s; }
            }
            if (t == 2 || t == 5) {
                bf16_t* vb = qkv + (size_t)t * M * BW + ((size_t)((u.pm >> 5) * 8 + (pn & 1) * 4) * SEQ + (size_t)(u.pm & 31) * 256) * HD;
                const unsigned fr_ = lrow & 15u, wr_ = lrow >> 6, hl = lcol >> 6, dd = lcol & 63u;
#pragma unroll
                for (int ai = 0; ai < 2; ++ai)
#pragma unroll
                    for (int m = 0; m < 4; ++m) { float f = rs[ai][m]; asm volatile("" : "+v"(f));
#pragma unroll
                        for (int bj = 0; bj < 2; ++bj) { const unsigned eo = (unsigned)(bj * 2 + hl) * (SEQ * HD) + ((wr_ + 2 * ai) * 4096 + ((dd >> 5) * 4 + m) * 512 + fr_ * 32 + (dd & 31u));
                            st_bf16x8(bo(vb, eo * 2u), acc[ai][bj][m][0] * f, acc[ai][bj][m][1] * f); } }
            } else if (t == 1 || t == 4) {
                bf16_t* kb = qkv + (size_t)t * M * BW + ((size_t)((u.pm >> 5) * 8 + (pn & 1) * 4) * SEQ + (size_t)(u.pm & 31) * 256) * HD;
                const unsigned fr_ = lrow & 15u, wr_ = lrow >> 6, hl = lcol >> 6, dch = (lcol & 63u) >> 3;
#pragma unroll
                for (int ai = 0; ai < 2; ++ai)
#pragma unroll
                    for (int m = 0; m < 4; ++m) { float f = rs[ai][m]; asm volatile("" : "+v"(f));
#pragma unroll
                        for (int bj = 0; bj < 2; ++bj) { const unsigned eo = (unsigned)(bj * 2 + hl) * (SEQ * HD) + (((wr_ * 2 + ai * 4 + (m >> 1)) * 8 + dch) * 256 + (fr_ + 16u * (m & 1)) * 8);
                            st_bf16x8(bo(kb, eo * 2u), acc[ai][bj][m][0] * f, acc[ai][bj][m][1] * f); } }
            } else {
#pragma unroll
            for (int ai = 0; ai < 2; ++ai)
#pragma unroll
                for (int m = 0; m < 4; ++m) { const float f = rs[ai][m] * sc; const unsigned o = lb + (unsigned)(ai * 128 + m * 16) * BW * 2u;
#pragma unroll
                    for (int bj = 0; bj < 2; ++bj) st_bf16x8(bo(base, o + bj * 256u), acc[ai][bj][m][0] * f, acc[ai][bj][m][1] * f); }
            }
        } else {
            bf16_t* base = ub + (size_t)u.pm * 256 * BW + (pn - 12) * 128;
#pragma unroll
            for (int ai = 0; ai < 2; ++ai)
#pragma unroll
                for (int m = 0; m < 4; ++m) { const float f = rs[ai][m] * rs[ai][m];
                    st_bf16x8(bo(base, lb + (unsigned)(ai * 128 + m * 16) * BW * 2u), acc[ai][0][m][0] * acc[ai][1][m][0] * f, acc[ai][0][m][1] * acc[ai][1][m][1] * f); }
        }
    }
};
struct EpiC1 {
    unsigned char* ws; const float* bgate;
    __device__ __forceinline__ unsigned char* gtile(int s, int pm, int pn) const { return ws + WS_KA + (size_t)(s + (s >> 1)) * (16 * MiB) + (size_t)(pm * 4 + pn) * 65536; }
    __device__ __forceinline__ void operator()(EPI_ARGS) const {
        bf16_t* mg = (bf16_t*)(ws + WS_MG); const float* ss = (const float*)(ws + WS_SSA);
        const int sg = u.seg; unsigned lrow = (unsigned)(wr * 64 + fr), lcol = (unsigned)(wc * 32 + 8 * fq);
        asm volatile("" : "+v"(lrow), "+v"(lcol));
        const unsigned lb = (lrow * DM + lcol) * 2u, lg = (unsigned)((wr * 4 + wc) * 8 * 1024 + (fq * 16 + fr) * 16);
        unsigned char* gp = gtile(sg < 3 ? sg : sg - 3, u.pm, u.pn);
        if (sg < 3) {
            const float* bg = bgate + sg * DM + u.pn * 256;
            f32x4 bv[2][2];
#pragma unroll
            for (int bj = 0; bj < 2; ++bj) { bv[bj][0] = *(const f32x4*)bo(bg, (lcol + bj * 128u) * 4u) * (-LOG2E); bv[bj][1] = *(const f32x4*)bo(bg, (lcol + bj * 128u + 4u) * 4u) * (-LOG2E); }
            float rs[2][4]; rstd8(rs, ss, u.pm, lrow);
#pragma unroll
            for (int ai = 0; ai < 2; ++ai)
#pragma unroll
                for (int m = 0; m < 4; ++m) { const float rn = rs[ai][m] * (-LOG2E); u32x4 w;
#pragma unroll
                    for (int bj = 0; bj < 2; ++bj)
#pragma unroll
                        for (int n = 0; n < 2; ++n) { const f32x4 x = acc[ai][bj][m][n] * rn + bv[bj][n];
                            unsigned q[4];
#pragma unroll
                            for (int e = 0; e < 4; ++e) q[e] = (unsigned)(__builtin_amdgcn_rcpf(1.0f + __builtin_amdgcn_exp2f(x[e])) * 255.0f + 0.5f);
                            w[bj * 2 + n] = q[0] | (q[1] << 8) | (q[2] << 16) | (q[3] << 24); }
                    *(u32x4*)bo(gp, lg + (unsigned)((ai * 4 + m) * 1024)) = w; }
        } else {
            bf16_t* mp = mg + (size_t)u.pm * 256 * DM + u.pn * 256;
#pragma unroll
            for (int ai = 0; ai < 2; ++ai) {
                u32x4 gw_[4], pw_[4][2];
#pragma unroll
                for (int mm = 0; mm < 4; ++mm) { gw_[mm] = *(const u32x4*)bo((const unsigned char*)gp, lg + (unsigned)((ai * 4 + mm) * 1024));
#pragma unroll
                    for (int bj = 0; bj < 2; ++bj) if (sg > 3) pw_[mm][bj] = *(const u32x4*)bo((const bf16_t*)mp, lb + (unsigned)(ai * 128 + mm * 16) * DM * 2u + bj * 256u); }
#pragma unroll
                for (int mm = 0; mm < 4; ++mm)
#pragma unroll
                    for (int bj = 0; bj < 2; ++bj) { const unsigned o = lb + (unsigned)(ai * 128 + mm * 16) * DM * 2u + bj * 256u; const unsigned g0 = gw_[mm][bj * 2], g1 = gw_[mm][bj * 2 + 1]; constexpr float s = 1.0f / 255.0f;
                        f32x4 v0 = acc[ai][bj][mm][0] * ((f32x4){(float)(g0 & 255u), (float)((g0 >> 8) & 255u), (float)((g0 >> 16) & 255u), (float)(g0 >> 24)} * s);
                        f32x4 v1 = acc[ai][bj][mm][1] * ((f32x4){(float)(g1 & 255u), (float)((g1 >> 8) & 255u), (float)((g1 >> 16) & 255u), (float)(g1 >> 24)} * s);
                        if (sg > 3) { const u32x4 p = pw_[mm][bj]; v0 += (f32x4){bf_lo(p.x), bf_hi(p.x), bf_lo(p.y), bf_hi(p.y)}; v1 += (f32x4){bf_lo(p.z), bf_hi(p.z), bf_lo(p.w), bf_hi(p.w)}; }
                        st_bf16x8(bo(mp, o), v0, v1); }
                asm volatile("" ::: "memory");
            }
        }
    }
};
struct EpiRes {
    unsigned char* ws; int toA; LAS float* red;
    __device__ __forceinline__ void operator()(EPI_ARGS) const {
        bf16_t* xb = (bf16_t*)(ws + WS_XB); float* sso = (float*)(ws + (toA ? WS_SSA : WS_SSB));
        unsigned lrow = (unsigned)(wr * 64 + fr), lcol = (unsigned)(wc * 32 + 8 * fq);
        asm volatile("" : "+v"(lrow), "+v"(lcol));
        const unsigned le = (lrow * DM + lcol) * 2u, lr4 = lrow * 4u + (unsigned)wc;
        bf16_t* xp = xb + (size_t)u.pm * 256 * DM + u.pn * 256;
#pragma unroll
        for (int ai = 0; ai < 2; ++ai) {
            u32x4 bs[4][2];
#pragma unroll
            for (int m = 0; m < 4; ++m)
#pragma unroll
                for (int bj = 0; bj < 2; ++bj) bs[m][bj] = *(const u32x4*)bo((const bf16_t*)xp, le + (unsigned)(ai * 128 + m * 16) * DM * 2u + bj * 256u);
#pragma unroll
            for (int m = 0; m < 4; ++m) { float sq = 0.f;
#pragma unroll
                for (int bj = 0; bj < 2; ++bj) { const u32x4 w = bs[m][bj];
                    const f32x4 x0 = (f32x4){bf_lo(w.x), bf_hi(w.x), bf_lo(w.y), bf_hi(w.y)} + acc[ai][bj][m][0], x1 = (f32x4){bf_lo(w.z), bf_hi(w.z), bf_lo(w.w), bf_hi(w.w)} + acc[ai][bj][m][1];
                    st_bf16x8(bo(xp, le + (unsigned)(ai * 128 + m * 16) * DM * 2u + bj * 256u), x0, x1);
                    sq += (x0[0] * x0[0] + x0[1] * x0[1]) + (x0[2] * x0[2] + x0[3] * x0[3]) + (x1[0] * x1[0] + x1[1] * x1[1]) + (x1[2] * x1[2] + x1[3] * x1[3]); }
                sq += xshfl<16>(sq); sq = sum32(sq);
                if (fq == 0) red[lr4 + (unsigned)(ai * 128 + m * 16) * 4u] = sq; }
            asm volatile("" ::: "memory");
        }
        asm volatile("s_waitcnt lgkmcnt(0)\n\ts_barrier" ::: "memory");
        { const int t = ((wr * 4 + wc) * 4 + fq) * 16 + fr; if (t < 256) { const f32x4 r = *(const LAS f32x4*)(red + t * 4); sso[((size_t)u.pm * 256 + t) * 4 + u.pn] = (r.x + r.y) + (r.z + r.w); } }
        asm volatile("s_waitcnt lgkmcnt(0)\n\ts_barrier" ::: "memory");
    }
};
struct EpiFfn {
    unsigned char* ws;
    __device__ __forceinline__ void operator()(EPI_ARGS) const {
        bf16_t* act = (bf16_t*)(ws + WS_ACT); const float* ss = (const float*)(ws + WS_SSB);
        unsigned lrow = (unsigned)(wr * 64 + fr), lcol = (unsigned)(wc * 32 + 8 * fq);
        asm volatile("" : "+v"(lrow), "+v"(lcol));
        const unsigned lb = (lrow * DFF + lcol) * 2u;
        bf16_t* ap = act + (size_t)u.pm * 256 * DFF + u.pn * 128;
        float rs[2][4]; rstd8(rs, ss, u.pm, lrow);
#pragma unroll
        for (int ai = 0; ai < 2; ++ai)
#pragma unroll
            for (int m = 0; m < 4; ++m) { const float r1 = rs[ai][m], rn = r1 * (-LOG2E); f32x4 v[2];
#pragma unroll
                for (int n = 0; n < 2; ++n) { const f32x4 g = acc[ai][0][m][n], up = acc[ai][1][m][n] * (r1 * r1);
#pragma unroll
                    for (int e = 0; e < 4; ++e) v[n][e] = g[e] * up[e] * __builtin_amdgcn_rcpf(1.0f + __builtin_amdgcn_exp2f(g[e] * rn)); }
                st_bf16x8(bo(ap, lb + (unsigned)(ai * 128 + m * 16) * DFF * 2u), v[0], v[1]); }
    }
};

struct GCfg {
    int mode;
    int N, nseg, lda, ldb, nt, toA;
    const bf16_t* A; const bf16_t* B;
    unsigned char* ws; unsigned char* wb; const float* bgate; LAS float* red;
};
struct ProbAny {
    const GCfg* c;
    __device__ __forceinline__ void seg(const pg8::Unit& u, pg8::Seg& s) const {
        if (c->mode == 1 && u.seg >= 3) {
            const int br = u.seg - 3; const bf16_t* O = (const bf16_t*)(c->ws + WS_QA + (size_t)br * (48 * MiB)); const bf16_t* Wp = (const bf16_t*)(c->wb + (WS_WP - WS_WIN));
            s.A = (const char*)(O + (size_t)u.pm * 256 * BW); s.B = (const char*)(Wp + ((size_t)br * DM + (size_t)u.pn * 256) * BW);
            s.hA = 128u * BW * 2u; s.hB = 128u * BW * 2u; s.lda = BW; s.ldb = BW; s.nt = BW / 64;
        } else {
            const int so = (c->mode == 1) ? u.seg * DM : 0;
            s.A = (const char*)(c->A + (size_t)u.pm * 256 * c->lda); s.B = (const char*)(c->B + ((size_t)so + (size_t)u.pn * 256) * c->ldb);
            s.hA = 128u * (unsigned)c->lda * 2u; s.hB = 128u * (unsigned)c->ldb * 2u; s.lda = c->lda; s.ldb = c->ldb; s.nt = c->nt;
        }
    }
};
struct EpiAny {
    const GCfg* c;
    __device__ __forceinline__ void operator()(EPI_ARGS) const {
        const int m_ = c->mode;
        if (m_ == 0) EpiIn{c->ws}(acc, u, wr, wc, fr, fq);
        else if (m_ == 1) EpiC1{c->ws, c->bgate}(acc, u, wr, wc, fr, fq);
        else if (m_ == 2) EpiRes{c->ws, c->toA, c->red}(acc, u, wr, wc, fr, fq);
        else EpiFfn{c->ws}(acc, u, wr, wc, fr, fq);
    }
};

namespace att {
__device__ __forceinline__ constexpr int crow(int r, int hi) { return (r & 3) + 8 * (r >> 2) + 4 * hi; }
__device__ __forceinline__ float swap_lo(float x, float& hiv) { auto rr = __builtin_amdgcn_permlane32_swap(__float_as_uint(x), __float_as_uint(x), false, false); hiv = __uint_as_float(rr[1]); return __uint_as_float(rr[0]); }
__device__ __forceinline__ s16x4 vtr(const LAS unsigned char* p) { return __builtin_bit_cast(s16x4, __builtin_amdgcn_ds_read_tr16_b64_v4i16((LAS s16x4*)p)); }
__device__ __forceinline__ void load_k(bf16x8 (&kf)[8], const bf16_t* Kh, int j0, int r32, int hi) {
    const bf16_t* p = Kh + (size_t)(j0 >> 5) * 2048 + hi * 256 + r32 * 8;
#pragma unroll
    for (int d0 = 0; d0 < 4; ++d0) { kf[2 * d0] = *(const bf16x8*)(p + d0 * 512); kf[2 * d0 + 1] = *(const bf16x8*)(p + 2048 + d0 * 512); }
}
__device__ __forceinline__ void dma_v(LAS unsigned char* vbuf, const bf16_t* Vh, int j0, int lane) {
    const bf16_t* p = Vh + (size_t)(j0 >> 6) * 4096 + lane * 8;
#pragma unroll
    for (int i = 0; i < 8; ++i) __builtin_amdgcn_global_load_lds((const unsigned*)(p + i * 512), (LAS unsigned*)(vbuf + i * 1024), 16, 0, 0);
}
__device__ __forceinline__ void load_v(u32x4 (&vv)[8], const bf16_t* Vh, int j0, int lane) {
    const bf16_t* p = Vh + (size_t)(j0 + (lane >> 3)) * BW + (lane & 7) * 8;
#pragma unroll
    for (int i = 0; i < 8; ++i) vv[i] = *(const u32x4*)(p + (size_t)(8 * i) * BW);
}
__device__ __forceinline__ void stage_v(LAS unsigned char* vst, const u32x4 (&vv)[8], int lane) {
    const int c = lane & 7;
#pragma unroll
    for (int i = 0; i < 8; ++i) { const int key = 8 * i + (lane >> 3);
        *(LAS u32x4*)(vst + ((c >> 2) * 4 + (key >> 4)) * 1024 + (key & 15) * 64 + (c & 3) * 16) = vv[i]; }
}
__device__ __forceinline__ void qk(f32x16& p0, f32x16& p1, const bf16x8 (&kf)[8], const bf16x8 (&qr)[4]) {
#pragma unroll
    for (int d0 = 0; d0 < 4; ++d0) { p0 = __builtin_amdgcn_mfma_f32_32x32x16_bf16(kf[2 * d0], qr[d0], p0, 0, 0, 0); p1 = __builtin_amdgcn_mfma_f32_32x32x16_bf16(kf[2 * d0 + 1], qr[d0], p1, 0, 0, 0); }
}
__device__ __forceinline__ void pv(f32x16& o0, f32x16& o1, const f32x16& p0, const f32x16& p1, const LAS unsigned char* vst, int lane) {
    const int hi = lane >> 5;
    const LAS unsigned char* vp = vst + ((lane >> 4) & 1) * 32 + (lane & 3) * 8 + (4 * hi + ((lane & 15) >> 2)) * 64;
    u32x4 pw[4];
    pw[0] = (u32x4){cvt_pk_bf16(p0[0], p0[1]), cvt_pk_bf16(p0[2], p0[3]), cvt_pk_bf16(p0[4], p0[5]), cvt_pk_bf16(p0[6], p0[7])};
    pw[1] = (u32x4){cvt_pk_bf16(p0[8], p0[9]), cvt_pk_bf16(p0[10], p0[11]), cvt_pk_bf16(p0[12], p0[13]), cvt_pk_bf16(p0[14], p0[15])};
    pw[2] = (u32x4){cvt_pk_bf16(p1[0], p1[1]), cvt_pk_bf16(p1[2], p1[3]), cvt_pk_bf16(p1[4], p1[5]), cvt_pk_bf16(p1[6], p1[7])};
    pw[3] = (u32x4){cvt_pk_bf16(p1[8], p1[9]), cvt_pk_bf16(p1[10], p1[11]), cvt_pk_bf16(p1[12], p1[13]), cvt_pk_bf16(p1[14], p1[15])};
#pragma unroll
    for (int ks = 0; ks < 4; ++ks) {
        const s16x4 a0 = vtr(vp + ks * 1024), a1 = vtr(vp + ks * 1024 + 512), b0 = vtr(vp + 4096 + ks * 1024), b1 = vtr(vp + 4096 + ks * 1024 + 512);
        const bf16x8 v0 = {a0[0], a0[1], a0[2], a0[3], a1[0], a1[1], a1[2], a1[3]}, v1 = {b0[0], b0[1], b0[2], b0[3], b1[0], b1[1], b1[2], b1[3]};
        const bf16x8 pa = __builtin_bit_cast(bf16x8, pw[ks]);
        o0 = __builtin_amdgcn_mfma_f32_32x32x16_bf16(pa, v0, o0, 0, 0, 0);
        o1 = __builtin_amdgcn_mfma_f32_32x32x16_bf16(pa, v1, o1, 0, 0, 0);
    }
}
__device__ __forceinline__ void store_o(bf16_t* Ow, const f32x16& o0, const f32x16& o1, const float (&rsc)[16], LAS unsigned char* stg, int lane) {
    const int r32 = lane & 31, hi = lane >> 5;
    LAS bf16_t* s = (LAS bf16_t*)stg;
#pragma unroll
    for (int r = 0; r < 16; ++r) { const int orow = crow(r, hi);
        s[orow * 64 + r32] = (bf16_t)(cvt_pk_bf16(o0[r] * rsc[r], 0.f) & 0xffffu); s[orow * 64 + 32 + r32] = (bf16_t)(cvt_pk_bf16(o1[r] * rsc[r], 0.f) & 0xffffu); }
    LDS_WAIT();
#pragma unroll
    for (int i = 0; i < 4; ++i) { const int row = i * 8 + (lane >> 3), ch = lane & 7; const u32x4 v = *(const LAS u32x4*)(stg + row * 128 + ch * 16); *(u32x4*)(Ow + (size_t)row * BW + ch * 8) = v; }
    LDS_WAIT();
}

__device__ __forceinline__ void sb_item(bf16_t* Q, const bf16_t* K, const bf16_t* V, int b, int h, int q0, LAS unsigned char* vst, int lane) {
    asm volatile("" : "+v"(lane));
    const int r32 = lane & 31, hi = lane >> 5;
    const size_t rowbase = (size_t)b * SEQ;
    bf16_t* Qw = Q + (rowbase + q0) * BW + h * HD;
    bf16x8 qr[4];
#pragma unroll
    for (int d0 = 0; d0 < 4; ++d0) qr[d0] = *(const bf16x8*)(Qw + (size_t)r32 * BW + d0 * 16 + hi * 8);
    const bf16_t* Kh = K + (size_t)(b * NH + h) * SEQ * HD; const bf16_t* Vh = V + (size_t)(b * NH + h) * SEQ * HD;
    f32x16 o0 = {}, o1 = {}; float A2 = 0.f;
    const int tq = q0 + r32;
    bf16x8 kf[8]; load_k(kf, Kh, ((q0 + 30) >> 6) * 64, r32, hi); dma_v(vst + (((q0 + 30) >> 6) & 1) * 8192, Vh, ((q0 + 30) >> 6) * 64, lane);
    for (int kt = (q0 + 30) >> 6; kt >= 0; --kt) {
        const int j0 = kt * 64;
        f32x16 p0 = {}, p1 = {};
        qk(p0, p1, kf, qr);
        asm volatile("" : "+v"(p0), "+v"(p1) :: "memory");
        LAS unsigned char* vcur = vst + (kt & 1) * 8192;
        if (kt > 0) { dma_v(vst + ((kt - 1) & 1) * 8192, Vh, j0 - 64, lane); load_k(kf, Kh, j0 - 64, r32, hi); }
        const bool diag = (j0 + 63 >= q0);
        f32x16 l0, l1;
#pragma unroll
        for (int r = 0; r < 16; ++r) {
            { const float z = p0[r]; const float t = __builtin_amdgcn_exp2f(-__builtin_fabsf(z)); float l = -(__builtin_fmaxf(z, 0.f) + __builtin_amdgcn_logf(1.0f + t)); if (diag && (j0 + crow(r, hi) >= tq)) l = 0.f; l0[r] = l; }
            { const float z = p1[r]; const float t = __builtin_amdgcn_exp2f(-__builtin_fabsf(z)); float l = -(__builtin_fmaxf(z, 0.f) + __builtin_amdgcn_logf(1.0f + t)); if (diag && (j0 + 32 + crow(r, hi) >= tq)) l = 0.f; l1[r] = l; }
        }
        float carry = A2;
#pragma unroll
        for (int half = 1; half >= 0; --half) {
            f32x16& l = half ? l1 : l0; f32x16& p = half ? p1 : p0;
            float T[4];
#pragma unroll
            for (int g = 0; g < 4; ++g) { l[4 * g + 2] += l[4 * g + 3]; l[4 * g + 1] += l[4 * g + 2]; l[4 * g] += l[4 * g + 1]; T[g] = l[4 * g]; }
            float Tl[4], Th[4];
#pragma unroll
            for (int g = 0; g < 4; ++g) Tl[g] = swap_lo(T[g], Th[g]);
            float E = carry;
#pragma unroll
            for (int g = 3; g >= 0; --g) { const float eh = E; E += Th[g]; const float el = E; E += Tl[g]; const float off = hi ? eh : el;
                l[4 * g] += off; l[4 * g + 1] += off; l[4 * g + 2] += off; l[4 * g + 3] += off; }
            carry = E;
#pragma unroll
            for (int r = 0; r < 16; ++r) { float w = __builtin_amdgcn_exp2f(p[r] + l[r]); if (diag && (j0 + 32 * half + crow(r, hi) >= tq)) w = 0.f; p[r] = w; }
        }
        A2 = carry;
        if (kt > 0) asm volatile("s_waitcnt vmcnt(16)" ::: "memory"); else asm volatile("s_waitcnt vmcnt(0)" ::: "memory");
        pv(o0, o1, p0, p1, vcur, lane);
        LDS_WAIT();
        if (__all(A2 < -150.2f)) break;
    }
    float one[16];
#pragma unroll
    for (int r = 0; r < 16; ++r) one[r] = 1.0f;
    store_o(Qw, o0, o1, one, vst, lane);
}

constexpr float MOBA_THR = 8.0f;
__device__ __forceinline__ void gate_load(bf16x8 (&qr)[4], bf16x8 (&kr)[4], const bf16_t* Qw, const bf16_t* Kown, int tq0, int lane) {
    asm volatile("" : "+v"(lane));
    const int r32 = lane & 31, hi = lane >> 5;
    const bf16_t* Qrow = Qw + (size_t)r32 * BW + hi * 8;
    const int tk = tq0 + r32; const bf16_t* kp = Kown + (size_t)(tk >> 5) * 2048 + hi * 256 + (tk & 31) * 8;
#pragma unroll
    for (int d0 = 0; d0 < 4; ++d0) { qr[d0] = *(const bf16x8*)(Qrow + d0 * 16); kr[d0] = *(const bf16x8*)(kp + d0 * 512); }
}
__device__ __forceinline__ unsigned moba_gate(const bf16x8 (&qr)[4], const bf16x8 (&kr)[4], int blk, int tq0, float sl2, const LAS float* km, const LAS float* kbn, int lane) {
    asm volatile("" : "+v"(lane));
    const int r32 = lane & 31, hi = lane >> 5;
    unsigned sel = 0u;
    if (blk > 0) {
        f32x16 p = {};
#pragma unroll
        for (int d0 = 0; d0 < 4; ++d0) { const LAS f32x4* kmr = (const LAS f32x4*)(km + r32 * 64); const int c0 = d0 * 4 + hi * 2; const f32x4 a = kmr[c0 ^ (r32 & 15)], c = kmr[(c0 + 1) ^ (r32 & 15)];
            const u32x4 h = {cvt_pk_bf16(a[0], a[1]), cvt_pk_bf16(a[2], a[3]), cvt_pk_bf16(c[0], c[1]), cvt_pk_bf16(c[2], c[3])};
            const u32x4 l = {cvt_pk_bf16(a[0] - bf_lo(h.x), a[1] - bf_hi(h.x)), cvt_pk_bf16(a[2] - bf_lo(h.y), a[3] - bf_hi(h.y)), cvt_pk_bf16(c[0] - bf_lo(h.z), c[1] - bf_hi(h.z)), cvt_pk_bf16(c[2] - bf_lo(h.w), c[3] - bf_hi(h.w))};
            p = __builtin_amdgcn_mfma_f32_32x32x16_bf16(__builtin_bit_cast(bf16x8, l), qr[d0], p, 0, 0, 0);
            p = __builtin_amdgcn_mfma_f32_32x32x16_bf16(__builtin_bit_cast(bf16x8, h), qr[d0], p, 0, 0, 0); }
        float v1 = -INFINITY, v2 = -INFINITY, v3 = -INFINITY; int i1 = -1, i2 = -1, i3 = -1;
#define TOP_INS(v, n) do { const bool b1 = (v) > v1 || ((v) == v1 && (n) < i1), b2 = (v) > v2 || ((v) == v2 && (n) < i2), b3 = (v) > v3 || ((v) == v3 && (n) < i3); \
            if (b3) { if (b2) { v3 = v2; i3 = i2; if (b1) { v2 = v1; i2 = i1; v1 = (v); i1 = (n); } else { v2 = (v); i2 = (n); } } else { v3 = (v); i3 = (n); } } } while (0)
#pragma unroll
        for (int r = 0; r < 16; ++r) { const int n = crow(r, 0) + 4 * hi; const float d = p[r]; if (n < blk) TOP_INS(d, n); }
        { float x0, x1; x0 = swap_lo(v1, x1); const float pv1 = hi ? x0 : x1; x0 = swap_lo(v2, x1); const float pv2 = hi ? x0 : x1; x0 = swap_lo(v3, x1); const float pv3 = hi ? x0 : x1;
          x0 = swap_lo(__int_as_float(i1), x1); const int pi1 = __float_as_int(hi ? x0 : x1); x0 = swap_lo(__int_as_float(i2), x1); const int pi2 = __float_as_int(hi ? x0 : x1); x0 = swap_lo(__int_as_float(i3), x1); const int pi3 = __float_as_int(hi ? x0 : x1);
          TOP_INS(pv1, pi1); TOP_INS(pv2, pi2); TOP_INS(pv3, pi3); }
#undef TOP_INS
        float qn2 = 0.f, zs = 0.f;
#pragma unroll
        for (int d0 = 0; d0 < 4; ++d0) { const u32x4 q = __builtin_bit_cast(u32x4, qr[d0]), x = __builtin_bit_cast(u32x4, kr[d0]);
            const float q0 = bf_lo(q.x), q1 = bf_hi(q.x), q2 = bf_lo(q.y), q3 = bf_hi(q.y), q4 = bf_lo(q.z), q5 = bf_hi(q.z), q6 = bf_lo(q.w), q7 = bf_hi(q.w);
            zs += q0 * bf_lo(x.x) + q1 * bf_hi(x.x) + q2 * bf_lo(x.y) + q3 * bf_hi(x.y) + q4 * bf_lo(x.z) + q5 * bf_hi(x.z) + q6 * bf_lo(x.w) + q7 * bf_hi(x.w);
            qn2 += (q0 * q0 + q1 * q1) + (q2 * q2 + q3 * q3) + (q4 * q4 + q5 * q5) + (q6 * q6 + q7 * q7); }
        { float x1; float x0 = swap_lo(zs, x1); zs = x0 + x1; x0 = swap_lo(qn2, x1); qn2 = x0 + x1; }
        const float qn = sqrtf(qn2) * 1.001f, thr = zs - 151.0f; const int tq = tq0 + r32;
#define KEEP(i_) ((i_) >= 0 && !(qn * kbn[(i_)] - sl2 * (float)(tq - (256 * (i_) + 255)) < thr))
        if (KEEP(i1)) sel |= 1u << i1; if (KEEP(i2)) sel |= 1u << i2; if (KEEP(i3)) sel |= 1u << i3;
#undef KEEP
    }
    return sel;
}
__device__ __forceinline__ void moba_tile(f32x16& o0, f32x16& o1, float& mrow, float& lsum, const bf16x8 (&qr)[4], bf16x8 (&kf)[8], const bf16_t* Kh, const bf16_t* Vh, int j0, int jn, float lb, float sl2, bool diag, int tq,
                                          LAS unsigned char* vst, LAS float* wsf, int lane, const float (&bv)[16]) {
    const int r32 = lane & 31, hi = lane >> 5;
    const float mref = (mrow == -INFINITY) ? 0.f : mrow; const float i0 = lb - mref, i1 = i0 + 32.0f * sl2;
    f32x16 p0, p1;
#pragma unroll
    for (int r = 0; r < 16; ++r) { p0[r] = i0 + bv[r]; p1[r] = i1 + bv[r]; }
    qk(p0, p1, kf, qr);
    asm volatile("" : "+v"(p0), "+v"(p1) :: "memory");
    LAS unsigned char* vcur = vst + ((j0 >> 6) & 1) * 8192;
    if (jn >= 0) { dma_v(vst + ((jn >> 6) & 1) * 8192, Vh, jn, lane); load_k(kf, Kh, jn, r32, hi); }
    if (diag) {
#pragma unroll
        for (int r = 0; r < 16; ++r) { if (j0 + crow(r, hi) > tq) p0[r] = -INFINITY; if (j0 + 32 + crow(r, hi) > tq) p1[r] = -INFINITY; }
    }
    float rm = __builtin_fmaxf(p0[0], p1[0]);
#pragma unroll
    for (int r = 1; r < 16; ++r) rm = __builtin_fmaxf(rm, __builtin_fmaxf(p0[r], p1[r]));
    { float x1; const float x0 = swap_lo(rm, x1); rm = __builtin_fmaxf(x0, x1); }
    rm += mref;
    if (__any(rm > mrow + MOBA_THR)) {
        const float mn = __builtin_fmaxf(mrow, rm); const float f = __builtin_amdgcn_exp2f(mrow - mn), dsh = mn - mref; mrow = mn; lsum *= f;
        if (hi == 0) wsf[r32] = f;
        LDS_WAIT();
#pragma unroll
        for (int r = 0; r < 16; ++r) { const float fr_ = wsf[crow(r, hi)]; o0[r] *= fr_; o1[r] *= fr_; p0[r] -= dsh; p1[r] -= dsh; }
        LDS_WAIT();
    }
    float ps = 0.f;
#pragma unroll
    for (int r = 0; r < 16; ++r) { p0[r] = __builtin_amdgcn_exp2f(p0[r]); p1[r] = __builtin_amdgcn_exp2f(p1[r]); ps += p0[r] + p1[r]; }
    lsum += ps;
    if (jn >= 0) asm volatile("s_waitcnt vmcnt(16)" ::: "memory"); else asm volatile("s_waitcnt vmcnt(0)" ::: "memory");
    pv(o0, o1, p0, p1, vcur, lane);
    LDS_WAIT();
}
__device__ __forceinline__ void moba_item(const bf16_t* Q, const bf16_t* K, const bf16_t* V, int b, int h, int blk, int n, int tix, const LAS unsigned char* lists, const LAS unsigned* cnt,
                                          const LAS unsigned* selm, unsigned char* recO, float* recML, LAS unsigned char* vst, LAS float* wsf, LAS unsigned* trow, int lane) {
    asm volatile("" : "+v"(lane));
    const int r32 = lane & 31, hi = lane >> 5; const size_t rowbase = (size_t)b * SEQ; const bool own = (n == blk);
    int q; bool valid; unsigned slot;
    if (own) { q = 32 * tix + r32; valid = true; slot = (unsigned)q * 4u + 3u; }
    else { const int cn = (int)cnt[n]; const int p = 32 * tix + r32; valid = p < cn; q = (int)lists[n * 256 + (valid ? p : cn - 1)];
           slot = (unsigned)q * 4u + (unsigned)__builtin_popcount(selm[q] & ((1u << n) - 1u)); }
    if (hi == 0) trow[r32] = slot | (valid ? 0x80000000u : 0u);
    const int tq = blk * 256 + q;
    const bf16_t* Qrow = Q + (rowbase + tq) * BW + h * HD + hi * 8;
    bf16x8 qr[4];
#pragma unroll
    for (int d0 = 0; d0 < 4; ++d0) qr[d0] = *(const bf16x8*)(Qrow + d0 * 16);
    const bf16_t* Kh = K + (size_t)(b * NH + h) * SEQ * HD; const bf16_t* Vh = V + (size_t)(b * NH + h) * SEQ * HD;
    const float sl2 = __builtin_amdgcn_exp2f(-(float)(h + 1)) * LOG2E;
    f32x16 o0 = {}, o1 = {}; float mrow = -INFINITY, lsum = 0.f;
    float bv[16];
#pragma unroll
    for (int r = 0; r < 16; ++r) bv[r] = sl2 * (float)crow(r, 0);
    const int ntile = own ? (tix >> 1) + 1 : 4;
    bf16x8 kf[8]; load_k(kf, Kh, n * 256, r32, hi); dma_v(vst + ((n * 4) & 1) * 8192, Vh, n * 256, lane);
#pragma unroll 1
    for (int i = 0; i < ntile; ++i) { const int j0 = n * 256 + i * 64;
        moba_tile(o0, o1, mrow, lsum, qr, kf, Kh, Vh, j0, i < ntile - 1 ? j0 + 64 : -1, sl2 * (float)(j0 + 4 * hi - tq), sl2, own && i == ntile - 1, tq, vst, wsf, lane, bv); }
    { float x1; const float x0 = swap_lo(lsum, x1); lsum = x0 + x1; }
    if (hi == 0) { wsf[32 + r32] = lsum; if (valid) *(f32x2*)(recML + 2 * slot) = (f32x2){mrow, lsum}; }
    LDS_WAIT();
    LAS bf16_t* s = (LAS bf16_t*)vst;
#pragma unroll
    for (int r = 0; r < 16; ++r) { const int orow = crow(r, hi); const float rl = __builtin_amdgcn_rcpf(wsf[32 + orow]);
        s[orow * 64 + r32] = (bf16_t)(cvt_pk_bf16(o0[r] * rl, 0.f) & 0xffffu); s[orow * 64 + 32 + r32] = (bf16_t)(cvt_pk_bf16(o1[r] * rl, 0.f) & 0xffffu); }
    LDS_WAIT();
#pragma unroll
    for (int i = 0; i < 4; ++i) { const int row = i * 8 + (lane >> 3), ch = lane & 7; const unsigned tr = trow[row]; const u32x4 v = *(const LAS u32x4*)(vst + row * 128 + ch * 16);
        if (tr & 0x80000000u) *(u32x4*)(recO + (size_t)(tr & 0x7fffffffu) * 128 + ch * 16) = v; }
    LDS_WAIT();
}
__device__ __forceinline__ void moba_merge(bf16_t* Q, int b, int h, int blk, int w, const LAS unsigned* selm, const unsigned char* recO, const float* recML, LAS float* wsf, int lane) {
    asm volatile("" : "+v"(lane));
    const int r32 = lane & 31, hi = lane >> 5; const size_t rowbase = (size_t)b * SEQ; const int q0 = blk * 256 + w * 32;
    const int ql = w * 32 + r32; const int c = __builtin_popcount(selm[ql]);
    f32x2 ml[4];
#pragma unroll
    for (int k = 0; k < 4; ++k) ml[k] = __builtin_nontemporal_load((const f32x2*)(recML + 2 * ((unsigned)ql * 4u + k)));
    u32x4 pw[4][4];
#pragma unroll
    for (int i = 0; i < 4; ++i)
#pragma unroll
        for (int k = 0; k < 4; ++k) pw[i][k] = __builtin_nontemporal_load((const u32x4*)(recO + (size_t)((unsigned)(w * 32 + i * 8 + (lane >> 3)) * 4u + k) * 128 + (lane & 7) * 16));
    float mi[4], li[4]; float mx = -INFINITY;
#pragma unroll
    for (int k = 0; k < 4; ++k) { const bool used = (k == 3 || k < c); mi[k] = used ? ml[k].x : -INFINITY; li[k] = used ? ml[k].y : 0.f; mx = __builtin_fmaxf(mx, mi[k]); }
    float wg[4], L = 0.f;
#pragma unroll
    for (int k = 0; k < 4; ++k) { wg[k] = (k == 3 || k < c) ? __builtin_amdgcn_exp2f(mi[k] - mx) * li[k] : 0.f; L += wg[k]; }
    const float rL = 1.0f / L;
    if (hi == 0) { wsf[r32] = wg[0] * rL; wsf[32 + r32] = wg[1] * rL; wsf[64 + r32] = wg[2] * rL; wsf[96 + r32] = wg[3] * rL; }
    LDS_WAIT();
    bf16_t* Qw = Q + (rowbase + q0) * BW + h * HD;
#pragma unroll
    for (int i = 0; i < 4; ++i) { const int row = i * 8 + (lane >> 3), ch = lane & 7; f32x4 v0 = {0.f, 0.f, 0.f, 0.f}, v1 = {0.f, 0.f, 0.f, 0.f};
#pragma unroll
        for (int k = 0; k < 4; ++k) { const float ak = wsf[32 * k + row];
            if (ak != 0.f) { const u32x4 p = pw[i][k];
                v0 += ak * (f32x4){bf_lo(p.x), bf_hi(p.x), bf_lo(p.y), bf_hi(p.y)}; v1 += ak * (f32x4){bf_lo(p.z), bf_hi(p.z), bf_lo(p.w), bf_hi(p.w)}; } }
        st_bf16x8(Qw + (size_t)row * BW + ch * 8, v0, v1); }
    LDS_WAIT();
}
}

#define XB_TMO      128
#define XB_XCNT(j)  (256  + 64 * (j))
#define XB_XSUB(j)  (1280 + 64 * (j))
#define XB_XGEN(j)  (2304 + 64 * (j))
#define XB_TOP      3328
#define XB_TOPGEN   3392
#define XCD_BAR_WORDS 3456
#define XB_SPIN_CAP (1u << 18)
__device__ __forceinline__ unsigned xb_ld(unsigned* p)              { return __hip_atomic_load(p, __ATOMIC_RELAXED, __HIP_MEMORY_SCOPE_AGENT); }
__device__ __forceinline__ unsigned xb_add(unsigned* p, unsigned v) { return __hip_atomic_fetch_add(p, v, __ATOMIC_RELAXED, __HIP_MEMORY_SCOPE_AGENT); }
__device__ __forceinline__ unsigned xb_xcc_id() { return (unsigned)__builtin_amdgcn_s_getreg((3 << 11) | 20) & 0xFu; }
#define XB_SPIN(cond, bar) do { unsigned _sp = 0; while (cond) { __builtin_amdgcn_s_sleep(1); \
    if ((++_sp & 255u) == 0u) { if (xb_ld(&(bar)[XB_TMO])) break; if (_sp > XB_SPIN_CAP) { atomicAdd(&(bar)[XB_TMO], 1u); break; } } } } while (0)
struct XcdBarrier { unsigned* bar; unsigned x; volatile LAS unsigned* st; };
__device__ __forceinline__ XcdBarrier xcd_barrier_post(unsigned* bar, volatile LAS unsigned* st) {
    XcdBarrier b; b.bar = bar; b.x = xb_xcc_id(); b.st = st;
    if (threadIdx.x == 0) (void)xb_add(&bar[XB_XCNT(b.x)], 1u);
    return b;
}
__device__ __forceinline__ void xcd_barrier_complete(unsigned* bar, unsigned x, unsigned& nloc, unsigned& nx) {
    const unsigned G = gridDim.x * gridDim.y * gridDim.z;
    unsigned sum, cnt, mine, sp = 0u;
    for (;;) {
        sum = 0u; cnt = 0u; mine = 0u;
#pragma unroll
        for (unsigned j = 0; j < 16; ++j) { const unsigned c = xb_ld(&bar[XB_XCNT(j)]); sum += c; cnt += (c > 0u) ? 1u : 0u; mine = (j == x) ? c : mine; }
        if (sum == G) break;
        __builtin_amdgcn_s_sleep(1);
        if ((++sp & 255u) == 0u) { if (xb_ld(&bar[XB_TMO])) break; if (sp > XB_SPIN_CAP) { atomicAdd(&bar[XB_TMO], 1u); break; } }
    }
    nloc = mine > 0u ? mine : 1u; nx = cnt > 0u ? cnt : 1u;
}
__device__ __forceinline__ void xcd_barrier(const XcdBarrier& b, int tid_) {
    asm volatile("s_waitcnt vmcnt(0)" ::: "memory");
    __syncthreads();
    if (tid_ == 0) {
        unsigned* bar = b.bar;
        __builtin_amdgcn_s_waitcnt(0);
        unsigned nloc = b.st[0], nx = b.st[1];
        if (nloc == 0u) { xcd_barrier_complete(bar, b.x, nloc, nx); b.st[0] = nloc; b.st[1] = nx; }
        const unsigned old = xb_add(&bar[XB_XSUB(b.x)], 1u);
        const unsigned gen = old / nloc;
        if (old + 1u == (gen + 1u) * nloc) {
            __builtin_amdgcn_fence(__ATOMIC_RELEASE, "agent");
            asm volatile("s_waitcnt vmcnt(0)" ::: "memory");
            const unsigned og = xb_add(&bar[XB_TOP], 1u);
            const unsigned tg = og / nx;
            if (og + 1u == (tg + 1u) * nx) xb_add(&bar[XB_TOPGEN], 1u);
            else XB_SPIN(xb_ld(&bar[XB_TOPGEN]) == tg, bar);
            __builtin_amdgcn_fence(__ATOMIC_ACQUIRE, "agent");
            xb_add(&bar[XB_XGEN(b.x)], 1u);
            asm volatile("s_waitcnt vmcnt(0)" ::: "memory");
        } else {
            XB_SPIN(xb_ld(&bar[XB_XGEN(b.x)]) == gen, bar);
            __builtin_amdgcn_fence(__ATOMIC_ACQUIRE, "agent");
            asm volatile("s_waitcnt vmcnt(0)" ::: "memory");
        }
    }
    __syncthreads();
}

__device__ __forceinline__ float wave_sum(float v) {
#pragma unroll
    for (int o = 1; o < 64; o <<= 1) v += __shfl_xor(v, o);
    return v;
}
struct TrD { const float* src; const float* gain; bf16_t* dst; int ldw, ldt; };
__device__ __forceinline__ void tr_load(const TrD& d, f32x4 (&v)[8], float (&g)[8], int lane) {
    const int c4 = lane & 7, r0 = lane >> 3;
#pragma unroll
    for (int i = 0; i < 8; ++i) { const int row = 8 * i + r0; v[i] = *(const GAS f32x4*)((const GAS float*)d.src + (size_t)row * d.ldw + 4 * c4); g[i] = d.gain ? ((const GAS float*)d.gain)[row] : 1.0f; }
}
__device__ __forceinline__ void tr_store(const TrD& d, const f32x4 (&v)[8], const float (&g)[8], LAS float* scr, int lane) {
    const int c4 = lane & 7, r0 = lane >> 3;
#pragma unroll
    for (int i = 0; i < 8; ++i) { LAS float* s = scr + (8 * i + r0) * 33 + 4 * c4; s[0] = v[i][0] * g[i]; s[1] = v[i][1] * g[i]; s[2] = v[i][2] * g[i]; s[3] = v[i][3] * g[i]; }
    LDS_WAIT(); asm volatile("" ::: "memory");
    const int c = lane & 7;
#pragma unroll
    for (int j = 0; j < 4; ++j) { const int n = (lane >> 3) + 8 * j; const LAS float* s = scr + (8 * c) * 33 + n;
        u32x4 o; o.x = cvt_pk_bf16(s[0 * 33], s[1 * 33]); o.y = cvt_pk_bf16(s[2 * 33], s[3 * 33]); o.z = cvt_pk_bf16(s[4 * 33], s[5 * 33]); o.w = cvt_pk_bf16(s[6 * 33], s[7 * 33]);
        *(GAS u32x4*)((GAS bf16_t*)d.dst + (size_t)n * d.ldt + 8 * c) = o; }
    LDS_WAIT(); asm volatile("" ::: "memory");
}
constexpr int I_IN = (DM / 64) * (NIN / 32), I_P = (BW / 64) * (DM / 32), I_O = (DM / 64) * (DM / 32), I_G = (DM / 64) * (DFF / 32), I_D = (DFF / 64) * (DM / 32);
constexpr int NITEMS = I_IN + 3 * I_P + I_O + 2 * I_G + I_D;
struct Args { const float* in[14]; float* out; unsigned char* ws; };
__device__ __forceinline__ void tr_decode(int it, TrD& d, const Args& A, int layer, unsigned char* wb) {
    int r = it;
    if (r < I_IN) { const int nblk = NIN / 32, kb = r / nblk, c0 = 32 * (r % nblk); size_t doff;
        if (c0 < 3072) doff = (size_t)c0 * DM * 2;
        else if (c0 < 3584) doff = (size_t)(3072 + 256 * ((c0 - 3072) >> 7) + ((c0 - 3072) & 127)) * DM * 2;
        else if (c0 < 4096) doff = (size_t)(4096 + (c0 - 3584)) * DM * 2;
        else if (c0 < 4608) doff = (size_t)(3072 + 256 * ((c0 - 4096) >> 7) + 128 + ((c0 - 4096) & 127)) * DM * 2;
        else doff = (WS_WG - WS_WIN) + (size_t)(c0 - 4608) * DM * 2;
        d.src = A.in[2] + (size_t)layer * DM * NIN + (size_t)(64 * kb) * NIN + c0; d.gain = A.in[1] + (size_t)layer * DM + 64 * kb; d.dst = (bf16_t*)(wb + doff) + 64 * kb; d.ldw = NIN; d.ldt = DM; return; }
    r -= I_IN;
    if (r < I_P) { const int nblk = DM / 32, kb = r / nblk, c0 = 32 * (r % nblk);
        d.src = A.in[5] + (size_t)layer * BW * DM + (size_t)(64 * kb) * DM + c0; d.gain = nullptr; d.dst = (bf16_t*)(wb + (WS_WP - WS_WIN)) + (size_t)c0 * BW + 64 * kb; d.ldw = DM; d.ldt = BW; return; }
    r -= I_P;
    if (r < I_P) { const int nblk = DM / 32, kb = r / nblk, c0 = 32 * (r % nblk);
        d.src = A.in[6] + (size_t)layer * BW * DM + (size_t)(64 * kb) * DM + c0; d.gain = nullptr; d.dst = (bf16_t*)(wb + (WS_WP - WS_WIN)) + (size_t)DM * BW + (size_t)c0 * BW + 64 * kb; d.ldw = DM; d.ldt = BW; return; }
    r -= I_P;
    if (r < I_P) { const int nblk = DM / 32, kb = r / nblk, c0 = 32 * (r % nblk);
        d.src = A.in[7] + (size_t)layer * BW * DM + (size_t)(64 * kb) * DM + c0; d.gain = nullptr; d.dst = (bf16_t*)(wb + (WS_WP - WS_WIN)) + (size_t)2 * DM * BW + (size_t)c0 * BW + 64 * kb; d.ldw = DM; d.ldt = BW; return; }
    r -= I_P;
    if (r < I_O) { const int nblk = DM / 32, kb = r / nblk, c0 = 32 * (r % nblk);
        d.src = A.in[8] + (size_t)layer * DM * DM + (size_t)(64 * kb) * DM + c0; d.gain = nullptr; d.dst = (bf16_t*)(wb + (WS_WO - WS_WIN)) + (size_t)c0 * DM + 64 * kb; d.ldw = DM; d.ldt = DM; return; }
    r -= I_O;
    if (r < I_G) { const int nblk = DFF / 32, kb = r / nblk, c0 = 32 * (r % nblk);
        d.src = A.in[10] + (size_t)layer * DM * DFF + (size_t)(64 * kb) * DFF + c0; d.gain = A.in[9] + (size_t)layer * DM + 64 * kb; d.dst = (bf16_t*)(wb + (WS_WGU - WS_WIN)) + (size_t)(256 * (c0 >> 7) + (c0 & 127)) * DM + 64 * kb; d.ldw = DFF; d.ldt = DM; return; }
    r -= I_G;
    if (r < I_G) { const int nblk = DFF / 32, kb = r / nblk, c0 = 32 * (r % nblk);
        d.src = A.in[11] + (size_t)layer * DM * DFF + (size_t)(64 * kb) * DFF + c0; d.gain = A.in[9] + (size_t)layer * DM + 64 * kb; d.dst = (bf16_t*)(wb + (WS_WGU - WS_WIN)) + (size_t)(256 * (c0 >> 7) + 128 + (c0 & 127)) * DM + 64 * kb; d.ldw = DFF; d.ldt = DM; return; }
    r -= I_G;
    { const int nblk = DM / 32, kb = r / nblk, c0 = 32 * (r % nblk);
      d.src = A.in[12] + (size_t)layer * DFF * DM + (size_t)(64 * kb) * DM + c0; d.gain = nullptr; d.dst = (bf16_t*)(wb + (WS_WD - WS_WIN)) + (size_t)c0 * DFF + 64 * kb; d.ldw = DM; d.ldt = DFF; }
}


__global__ void __launch_bounds__(NWAVES * 64, 2) hybrid_fwd(Args args) {
    extern __shared__ __attribute__((aligned(16))) unsigned char lds_raw[];
    LAS unsigned char* lds = (LAS unsigned char*)lds_raw;
    volatile LAS unsigned* MISC = (volatile LAS unsigned*)(lds + MISC_OFF);
    const int wave = __builtin_amdgcn_readfirstlane((int)threadIdx.x >> 6);
    const int G = gridDim.x, bx = blockIdx.x, vcu = (G % 8 == 0) ? (bx % 8) * (G / 8) + bx / 8 : bx;
    for (int i = threadIdx.x; i < (LDS_BYTES - LDSCTL_OFF) / 4; i += NWAVES * 64) ((LAS unsigned*)(lds + LDSCTL_OFF))[i] = 0u;
    __syncthreads();
    XcdBarrier bar = xcd_barrier_post((unsigned*)(args.ws + WS_CTL) + CW_BAR, MISC + 8);
    const int gw = vcu * NWAVES + wave, NGW = G * NWAVES;

    for (int pq = 0; pq < DEPTH * 7 + 1; ++pq) {
        const int layer = pq / 7, ph = pq - 7 * layer;
        int tid = wave * 64 + lane_id(); asm volatile("" : "+v"(tid)); const int lane = tid & 63;
        size_t opq = 0; asm volatile("" : "+s"(opq));
        unsigned char* ws = args.ws + opq; const float* x_in = args.in[0] + opq; float* out = args.out + opq;
        float* ssA = (float*)(ws + WS_SSA); float* ssB = (float*)(ws + WS_SSB); float* kmp = (float*)(ws + WS_KM);
        bf16_t* xb = (bf16_t*)(ws + WS_XB);
        bf16_t* QA = (bf16_t*)(ws + WS_QA); bf16_t* KA = (bf16_t*)(ws + WS_KA); bf16_t* VA = (bf16_t*)(ws + WS_VA);
        bf16_t* QS = (bf16_t*)(ws + WS_QS); bf16_t* KS = (bf16_t*)(ws + WS_KS); bf16_t* VS = (bf16_t*)(ws + WS_VS);
        bf16_t* Ub = (bf16_t*)(ws + WS_U); bf16_t* BC = (bf16_t*)(ws + WS_BC); bf16_t* MG = (bf16_t*)(ws + WS_MG); bf16_t* ACT = (bf16_t*)(ws + WS_ACT);

        if (layer == DEPTH) {
            const float* gf = args.in[13];
            for (int m = gw; m < M; m += NGW) {
                const float rs = rstd_row(ssA, m);
                f32x4* xr = (f32x4*)(out + (size_t)m * DM) + lane; const f32x4* gr = (const f32x4*)gf + lane; const u32x2* xs = (const u32x2*)(xb + (size_t)m * DM) + lane;
#pragma unroll
                for (int j = 0; j < 4; ++j) { const u32x2 w = xs[64 * j]; const f32x4 v = {bf_lo(w.x), bf_hi(w.x), bf_lo(w.y), bf_hi(w.y)}, g = gr[64 * j]; xr[64 * j] = v * rs * g; }
            }
            if (xb_ld((unsigned*)(ws + WS_CTL) + CW_BAR + XB_TMO) != 0u && bx == 0) { for (int i = tid; i < 4096; i += NWAVES * 64) out[i] = __builtin_nanf(""); }
            break;
        }
        if (ph == 0) {
            LAS float* scr = (LAS float*)(lds + RING_OFF + wave * 16384);
            {
                constexpr int NIT2 = NITEMS; unsigned char* wb_ = layer == 0 ? ws + WS_WIN : (unsigned char*)out;
#define TR_DEC(i_, d_) tr_decode(i_, d_, args, layer, wb_)
                int it = gw;
                for (; it + NGW < NIT2; it += 2 * NGW) {
                    TrD da, db; f32x4 va[8], vb[8]; float ga[8], gb[8];
                    TR_DEC(it, da); tr_load(da, va, ga, lane);
                    TR_DEC(it + NGW, db); tr_load(db, vb, gb, lane);
                    tr_store(da, va, ga, scr, lane); tr_store(db, vb, gb, scr, lane);
                }
                if (it < NIT2) { TrD da; f32x4 va[8]; float ga[8]; TR_DEC(it, da); tr_load(da, va, ga, lane); tr_store(da, va, ga, scr, lane); }
#undef TR_DEC
            }
            if (layer == 0) {
                for (int m = gw; m < M; m += NGW) {
                    const f32x4* xr = (const f32x4*)(x_in + (size_t)m * DM) + lane; f32x4 v[4]; float s = 0.f;
#pragma unroll
                    for (int j = 0; j < 4; ++j) { v[j] = xr[64 * j]; s += (v[j].x * v[j].x + v[j].y * v[j].y) + (v[j].z * v[j].z + v[j].w * v[j].w); }
                    s = wave_sum(s);
                    u32x2* o8 = (u32x2*)(xb + (size_t)m * DM) + lane;
#pragma unroll
                    for (int j = 0; j < 4; ++j) o8[64 * j] = (u32x2){cvt_pk_bf16(v[j].x, v[j].y), cvt_pk_bf16(v[j].z, v[j].w)};
                    if (lane < 4) ssA[(size_t)m * 4 + lane] = (lane == 0) ? s : 0.f;
                }
            }
        } else if (ph == 2) {
            LAS unsigned char* vst = lds + RING_OFF + wave * 16384;
            LAS float* wsf = (LAS float*)(lds + ATT_OFF + wave * 512);
            LAS float* km = (LAS float*)(lds + ATT_OFF + 4096);
            LAS unsigned* selm = (LAS unsigned*)(lds + ATT_OFF + 12288);
            LAS unsigned* cnt = (LAS unsigned*)(lds + ATT_OFF + 13312);
            LAS float* kbn = (LAS float*)(lds + ATT_OFF + 13312 + 256);
            LAS unsigned* uslot = (LAS unsigned*)(lds + ATT_OFF + 13312 + 512);
            LAS unsigned char* lists = lds + ATT_OFF + 14336;
            LAS unsigned* trow = (LAS unsigned*)(lds + ATT_OFF + 22528 + wave * 128);
            unsigned char* recO = ws + WS_MG + (size_t)vcu * 131072; float* recML = (float*)(ws + WS_X + (size_t)vcu * 8192);
            unsigned* qbase = (unsigned*)(ws + WS_CTL) + 14336 + layer * 512;
            int xq = (int)(bar.x & 7u);
            float* kbmax = (float*)((unsigned*)(ws + WS_CTL) + 8192 + 4096 + layer * 512);
            for (;;) {
                if (wave == 0) {
                    unsigned got = 0xffffffffu;
                    if (lane == 0) { const unsigned u_ = __hip_atomic_fetch_add(qbase + xq * 64, 1u, __ATOMIC_RELAXED, __HIP_MEMORY_SCOPE_AGENT); if (u_ < 224u) got = (unsigned)xq * 256u + u_; }
                    got = (unsigned)__builtin_amdgcn_readfirstlane((int)got);
                    while (got == 0xffffffffu) {
                        const unsigned c_ = lane < 8 ? __hip_atomic_load(qbase + lane * 64, __ATOMIC_RELAXED, __HIP_MEMORY_SCOPE_AGENT) : 224u;
                        const unsigned mk = (unsigned)__ballot(c_ < 224u) & 0xffu;
                        if (mk == 0u) break;
                        const unsigned rot = ((mk >> xq) | (mk << (8 - xq))) & 0xffu;
                        const int j_ = (xq + __builtin_ctz(rot)) & 7;
                        if (lane == 0) { const unsigned u_ = __hip_atomic_fetch_add(qbase + j_ * 64, 1u, __ATOMIC_RELAXED, __HIP_MEMORY_SCOPE_AGENT); if (u_ < 224u) got = (unsigned)j_ * 256u + u_; }
                        got = (unsigned)__builtin_amdgcn_readfirstlane((int)got);
                        xq = j_;
                    }
                    if (lane == 0) *uslot = got;
                }
                __syncthreads();
                const unsigned uq_ = *uslot;
                __syncthreads();
                if (uq_ == 0xffffffffu) break;
                const int xu = (int)(uq_ >> 8), ul = (int)(uq_ & 255u);
                if (ul >= 192) { const unsigned ucv = (unsigned)(xu * 32 + (ul - 192));
                    const float* cw = args.in[4] + (size_t)layer * 3 * BW;
#pragma unroll 1
                    for (int k8 = 0; k8 < 8; ++k8) { const int i = (int)ucv * 4096 + k8 * (NWAVES * 64) + tid;
                        const int t = i >> 6, c = (i & 63) * 8; const int tt = t & (SEQ - 1);
                        const u32x4 u2 = *(const u32x4*)(Ub + (size_t)t * BW + c);
                        u32x4 u1 = {0u, 0u, 0u, 0u}, u0 = {0u, 0u, 0u, 0u};
                        if (tt >= 1) u1 = *(const u32x4*)(Ub + (size_t)(t - 1) * BW + c);
                        if (tt >= 2) u0 = *(const u32x4*)(Ub + (size_t)(t - 2) * BW + c);
                        const u32x4 bw = *(const u32x4*)(BC + (size_t)t * BW + c);
                        float y[8];
#pragma unroll
                        for (int e = 0; e < 4; ++e) {
                            const float w0l = cw[c + 2 * e], w0h = cw[c + 2 * e + 1], w1l = cw[BW + c + 2 * e], w1h = cw[BW + c + 2 * e + 1], w2l = cw[2 * BW + c + 2 * e], w2h = cw[2 * BW + c + 2 * e + 1];
                            y[2 * e] = bf_lo(bw[e]) * (w0l * bf_lo(u0[e]) + w1l * bf_lo(u1[e]) + w2l * bf_lo(u2[e]));
                            y[2 * e + 1] = bf_hi(bw[e]) * (w0h * bf_hi(u0[e]) + w1h * bf_hi(u1[e]) + w2h * bf_hi(u2[e]));
                        }
                        *(u32x4*)(BC + (size_t)t * BW + c) = (u32x4){cvt_pk_bf16(y[0], y[1]), cvt_pk_bf16(y[2], y[3]), cvt_pk_bf16(y[4], y[5]), cvt_pk_bf16(y[6], y[7])}; }
                    continue;
                }
                if (ul < 64) {
                    const int b = xu & 1, h = (ul >> 5) ? (xu >> 1) : 7 - (xu >> 1), bh = b * 8 + h, n = ul & 31;
                    const int key_ = n * 256 + (tid >> 1); const bf16_t* kp = KA + (size_t)(b * NH + h) * SEQ * HD + (size_t)(key_ >> 5) * 2048 + (tid & 1) * 1024 + (key_ & 31) * 8;
                    float sq = 0.f;
#pragma unroll
                    for (int c = 0; c < 4; ++c) { const u32x4 x = *(const u32x4*)(kp + c * 256); const float e0 = bf_lo(x.x), e1 = bf_hi(x.x), e2 = bf_lo(x.y), e3 = bf_hi(x.y), e4 = bf_lo(x.z), e5 = bf_hi(x.z), e6 = bf_lo(x.w), e7 = bf_hi(x.w);
                        sq += (e0 * e0 + e1 * e1) + (e2 * e2 + e3 * e3) + (e4 * e4 + e5 * e5) + (e6 * e6 + e7 * e7); }
                    sq += xshfl<1>(sq);
                    sq = __builtin_fmaxf(sq, xshfl<2>(sq)); sq = __builtin_fmaxf(sq, xshfl<4>(sq)); sq = __builtin_fmaxf(sq, xshfl<8>(sq)); sq = __builtin_fmaxf(sq, xshfl<16>(sq));
                    { float x1; const float x0 = att::swap_lo(sq, x1); sq = __builtin_fmaxf(x0, x1); }
                    if (lane == 0) kbn[wave] = sq;
                    __syncthreads();
                    if (tid == 0) { float m_ = kbn[0];
#pragma unroll
                        for (int w_ = 1; w_ < NWAVES; ++w_) m_ = __builtin_fmaxf(m_, kbn[w_]);
                        __hip_atomic_store((unsigned*)kbmax + bh * 32 + n, __float_as_uint(m_) | 1u, __ATOMIC_RELAXED, __HIP_MEMORY_SCOPE_AGENT); }
                    __syncthreads();
                } else if (ul < 128) {
                    const int b = xu & 1, h = ((ul - 64) >> 5) ? (xu >> 1) : 7 - (xu >> 1), blk = 31 - (ul & 31);
                    unsigned kb_ = 1u; if (tid < 32) kb_ = __hip_atomic_load((unsigned*)kbmax + (b * 8 + h) * 32 + tid, __ATOMIC_RELAXED, __HIP_MEMORY_SCOPE_AGENT);
                    const size_t qrow = (size_t)b * SEQ + blk * 256 + wave * 32;
                    bf16x8 gq[4], gk[4]; att::gate_load(gq, gk, QA + qrow * BW + h * HD, KA + (size_t)(b * NH + h) * SEQ * HD, blk * 256 + wave * 32, lane);
                    for (int i = tid; i < 2048; i += NWAVES * 64) { const int n = i >> 6, d = i & 63; const size_t o = (size_t)((b * 32 + n) * 2) * BW + h * HD + d; km[n * 64 + ((((d >> 2) ^ (n & 15)) << 2) | (d & 3))] = kmp[o] + kmp[o + BW]; }
                    if (tid < 32) {
                        unsigned sp_ = 0; while (kb_ == 0u) { __builtin_amdgcn_s_sleep(2); kb_ = __hip_atomic_load((unsigned*)kbmax + (b * 8 + h) * 32 + tid, __ATOMIC_RELAXED, __HIP_MEMORY_SCOPE_AGENT);
                            if (++sp_ > (1u << 20)) { atomicAdd((unsigned*)(ws + WS_CTL) + CW_BAR + XB_TMO, 1u); break; } }
                        kbn[tid] = sqrtf(__uint_as_float(kb_)) * 1.01f; }
                    __syncthreads();
                    const float sl2 = __builtin_amdgcn_exp2f(-(float)(h + 1)) * LOG2E;
                    const unsigned sel = att::moba_gate(gq, gk, blk, blk * 256 + wave * 32, sl2, km, kbn, lane);
                    if (lane < 32) selm[wave * 32 + lane] = sel;
                    __syncthreads();
                    for (int n = wave; n < blk; n += NWAVES) {
                        unsigned pos = 0;
#pragma unroll
                        for (int c = 0; c < 4; ++c) { const int q = 64 * c + lane; const bool bit = (selm[q] >> n) & 1u; const unsigned long long mk = __ballot(bit);
                            if (bit) lists[n * 256 + pos + __builtin_amdgcn_mbcnt_hi((unsigned)(mk >> 32), __builtin_amdgcn_mbcnt_lo((unsigned)mk, 0u))] = (unsigned char)q;
                            pos += (unsigned)__builtin_popcountll(mk); }
                        if (lane == 0) cnt[n] = pos;
                    }
                    __syncthreads();
                    { int n = blk, t = wave; int nn = 0, tt = 0, idp = 0;
                      for (;;) {
                          att::moba_item(QA, KA, VA, b, h, blk, n, t, lists, cnt, selm, recO, recML, vst, wsf, trow, lane);
                          bool found = false;
                          while (nn < blk) { const int nt_ = ((int)cnt[nn] + 31) >> 5;
                              if (tt < nt_) { const bool mine = (idp & (NWAVES - 1)) == wave; if (mine) { n = nn; t = tt; found = true; } ++tt; ++idp; if (mine) break; }
                              else { ++nn; tt = 0; } }
                          if (!found) break;
                      } }
                    VM_WAIT();
                    __syncthreads();
                    att::moba_merge(QA, b, h, blk, wave, selm, recO, recML, wsf, lane);
                    __syncthreads();
                } else {
                    const int b = xu & 1, h = (xu >> 1) * 2 + ((ul - 128) >> 5), blk = ul & 31;
                    att::sb_item(QS, KS, VS, b, h, blk * 256 + wave * 32, vst, lane);
                }
            }
        } else {
            static_assert(WS_QS - WS_QA == 48 * MiB && WS_BC - WS_QS == 48 * MiB && WS_VA - WS_KA == 16 * MiB && WS_KS - WS_KA == 48 * MiB, "O_a / O_s / O_c 48 MiB apart; gate scratch = K_a | V_a | K_s");
            GCfg c{};
            c.ws = ws; c.wb = layer == 0 ? ws + WS_WIN : (unsigned char*)out; c.bgate = args.in[3] + (size_t)layer * NGATE; c.red = (LAS float*)(lds + LDSCTL_OFF + 1024);
            c.nseg = 1; c.lda = DM; c.ldb = DM; c.nt = DM / 64; c.toA = 0;
            if (ph == 1) { c.mode = 0; c.N = N1; c.A = xb; c.B = (const bf16_t*)c.wb; }
            else if (ph == 3) { c.mode = 1; c.N = DM; c.nseg = 6; c.A = xb; c.B = (const bf16_t*)(c.wb + (WS_WG - WS_WIN)); }
            else if (ph == 4) { c.mode = 2; c.N = DM; c.A = MG; c.B = (const bf16_t*)(c.wb + (WS_WO - WS_WIN)); }
            else if (ph == 5) { c.mode = 3; c.N = NGU; c.A = xb; c.B = (const bf16_t*)(c.wb + (WS_WGU - WS_WIN)); }
            else { c.mode = 2; c.N = DM; c.A = ACT; c.B = (const bf16_t*)(c.wb + (WS_WD - WS_WIN)); c.lda = DFF; c.ldb = DFF; c.nt = DFF / 64; c.toA = 1; }
            ProbAny P{&c}; EpiAny E{&c}; pg8::StaticOrder S; S.init(M, c.N, G, bx, c.nseg);
            pg8::gemm_phase(lds + RING_OFF, P, S, E, wave);
        }
        if (!(ph == 6 && layer + 1 < DEPTH)) xcd_barrier(bar, tid);
    }
}

extern "C" void kernel_launch(void* const* d_in, const int* in_sizes, int n_in, void* d_out, int out_size, void* d_ws, size_t ws_size, hipStream_t stream) {
    static int grid = 0;
    if (grid == 0) {
        if (n_in != 14 || in_sizes[0] != M * DM || out_size != M * DM || ws_size < WS_END) { fprintf(stderr, "kernel_launch: unexpected shapes (n_in %d, in0 %d, out %d, ws %zu)\n", n_in, n_in > 0 ? in_sizes[0] : -1, out_size, ws_size); grid = -1; return; }
        int dev = 0, cus = 0, per_cu = 0;
        if (hipGetDevice(&dev) != hipSuccess || hipDeviceGetAttribute(&cus, hipDeviceAttributeMultiprocessorCount, dev) != hipSuccess) { grid = -1; return; }
        if (hipFuncSetAttribute((const void*)hybrid_fwd, hipFuncAttributeMaxDynamicSharedMemorySize, LDS_BYTES) != hipSuccess) { fprintf(stderr, "kernel_launch: hipFuncSetAttribute failed\n"); grid = -1; return; }
        if (hipOccupancyMaxActiveBlocksPerMultiprocessor(&per_cu, (const void*)hybrid_fwd, NWAVES * 64, LDS_BYTES) != hipSuccess || per_cu < 1) { fprintf(stderr, "kernel_launch: occupancy query says %d blocks/CU\n", per_cu); (void)hipGetLastError(); per_cu = 1; }
        grid = cus;
    }
    if (grid < 0) return;
    if (hipMemsetAsync((char*)d_ws + WS_CTL, 0, CTL_ZERO_BYTES, stream) != hipSuccess) { fprintf(stderr, "kernel_launch: memset failed\n"); return; }
    Args a{};
    for (int i = 0; i < 14; ++i) a.in[i] = (const float*)d_in[i];
    a.out = (float*)d_out; a.ws = (unsigned char*)d_ws;
    void* kargs[] = {&a};
    hipError_t e = hipLaunchCooperativeKernel((const void*)hybrid_fwd, dim3(grid), dim3(NWAVES * 64), kargs, LDS_BYTES, stream);
    if (e != hipSuccess) fprintf(stderr, "kernel_launch: cooperative launch failed: %s (grid %d)\n", hipGetErrorString(e), grid);
}
```

```cpp
#include <hip/hip_runtime.h>
#include <hip/hip_bf16.h>
#include <cstdio>
#include <cstdint>

#define GAS __attribute__((address_space(1)))
#define LAS __attribute__((address_space(3)))
typedef unsigned short bf16_t;
typedef short bf16x8 __attribute__((ext_vector_type(8)));
typedef short s16x4 __attribute__((ext_vector_type(4)));
typedef float f32x2 __attribute__((ext_vector_type(2)));
typedef float f32x4 __attribute__((ext_vector_type(4)));
typedef float f32x16 __attribute__((ext_vector_type(16)));
typedef unsigned u32x2 __attribute__((ext_vector_type(2)));
typedef unsigned u32x4 __attribute__((ext_vector_type(4)));
typedef GAS unsigned gu32;

constexpr int BATCH = 2, SEQ = 8192, DM = 1024, M = BATCH * SEQ, NH = 8, HD = 64, BW = 512, DFF = 2816, DEPTH = 2;
constexpr int NIN = 7680, N1 = 4608, NGATE = 3072, NGU = 2 * DFF;
constexpr float RMS_EPS = 1e-6f;
constexpr float LOG2E = 1.4426950408889634f;
constexpr float C2 = 0.125f * LOG2E;
constexpr int NWAVES = 8;

constexpr size_t MiB = 1u << 20;
constexpr size_t WS_CTL = 0, CTL_ZERO_BYTES = 64 * 1024;
constexpr size_t WS_SSA = 1 * MiB, WS_SSB = 2 * MiB, WS_KM = 3 * MiB;
constexpr size_t WS_WIN = 4 * MiB, WS_WG = 13 * MiB, WS_WP = 19 * MiB, WS_WO = 22 * MiB, WS_WGU = 24 * MiB, WS_WD = 35 * MiB;
constexpr size_t WS_XB = 41 * MiB;
constexpr size_t WS_QA = 73 * MiB, WS_KA = 89 * MiB, WS_VA = 105 * MiB, WS_QS = 121 * MiB, WS_KS = 137 * MiB, WS_VS = 153 * MiB;
constexpr size_t WS_BC = 169 * MiB, WS_U = 185 * MiB, WS_MG = 201 * MiB, WS_X = 233 * MiB;
constexpr size_t WS_ACT = 73 * MiB;
constexpr size_t WS_END = 256 * MiB;
constexpr int CW_BAR = 4096;

constexpr int RING_OFF = 0, RING_BYTES = 131072;
constexpr int ATT_OFF = RING_BYTES, ATT_BYTES = 23552;
constexpr int LDSCTL_OFF = ATT_OFF + ATT_BYTES, MISC_OFF = LDSCTL_OFF + 320;
constexpr int LDS_BYTES = 163840;
static_assert(LDSCTL_OFF + 1024 + 4096 <= LDS_BYTES, "LDS map");

#define LDS_WAIT() asm volatile("s_waitcnt lgkmcnt(0)" ::: "memory")
#define VM_WAIT() asm volatile("s_waitcnt vmcnt(0)" ::: "memory")
#define RLX_AGENT __ATOMIC_RELAXED, __HIP_MEMORY_SCOPE_AGENT

typedef __bf16 bf16x2_t __attribute__((ext_vector_type(2)));
__device__ __forceinline__ unsigned cvt_pk_bf16(float lo, float hi) { const f32x2 v = {lo, hi}; const bf16x2_t b = __builtin_convertvector(v, bf16x2_t); return __builtin_bit_cast(unsigned, b); }
template <int O> __device__ __forceinline__ float xshfl(float x) {
    static_assert(O < 32, "use sum32 for the two 32-lane halves");
    return __int_as_float(__builtin_amdgcn_ds_swizzle(__float_as_int(x), (O << 10) | 0x1f));
}
__device__ __forceinline__ int lane_id() { return (int)__builtin_amdgcn_mbcnt_hi(~0u, __builtin_amdgcn_mbcnt_lo(~0u, 0u)); }
__device__ __forceinline__ float sum32(float x) { auto rr = __builtin_amdgcn_permlane32_swap(__float_as_uint(x), __float_as_uint(x), false, false); return __uint_as_float(rr[0]) + __uint_as_float(rr[1]); }
__device__ __forceinline__ float bf_lo(unsigned w) { return __uint_as_float(w << 16); }
__device__ __forceinline__ float bf_hi(unsigned w) { return __uint_as_float(w & 0xffff0000u); }
__device__ __forceinline__ float rstd_row(const float* ssp, int row) {
    const f32x4 a = *(const f32x4*)(ssp + (size_t)row * 4);
    return rsqrtf(((a.x + a.y) + (a.z + a.w)) * (1.0f / DM) + RMS_EPS);
}

namespace pg8 {
constexpr int BM = 256, BK = 64, HALF = 128, HTB = HALF * BK * 2, STAGE_BYTES = 8 * HTB, NXCD = 8, WGM = 8;
__host__ __device__ __forceinline__ int lds_byte(int r, int c) { const int st = (r >> 4) * 2 + (c >> 5), rr = r & 15, cc = c & 31, ob = rr * 64 + cc * 2; return st * 1024 + (ob ^ (((ob >> 9) & 1) << 5)); }
__host__ __device__ __forceinline__ void stage_rc(int b, int& R, int& C) { const int st = b / 1024, sb = b % 1024, swz = sb ^ (((sb >> 9) & 1) << 5); R = (st >> 1) * 16 + swz / 64; C = (st & 1) * 32 + (swz % 64) / 2; }
__host__ __device__ __forceinline__ int perm32(int rho) { const int n = rho >> 4, i = rho & 15; return 8 * (i >> 2) + 4 * n + (i & 3); }

struct Unit { int pm, pn, seg; };
struct Seg { const char* A; const char* B; unsigned hA, hB; int lda, ldb, nt; };

struct StaticOrder {
    int nM, nN, nwg, G, c, nseg;
    __device__ void init(int M_, int N_, int G_, int c_, int nseg_) { nM = M_ / BM; nN = N_ / BM; nwg = nM * nN; G = G_; c = c_; nseg = nseg_; }
    __device__ bool next(int i, Unit& u) const {
        const int ti = (nseg == 1) ? i : i / nseg; u.seg = i - ti * nseg;
        const long L = (long)ti * G + c; if (L >= nwg) return false;
        int wgid = (int)L; { const int q = nwg / NXCD, r = nwg % NXCD, xcd = wgid % NXCD, off = wgid / NXCD; wgid = (xcd < r ? xcd * (q + 1) : r * (q + 1) + (xcd - r) * q) + off; }
        const int nig = WGM * nN, gid = wgid / nig, fm = gid * WGM, gsz = (nM - fm) < WGM ? (nM - fm) : WGM;
        u.pm = fm + ((wgid % nig) % gsz); u.pn = (wgid % nig) / gsz; return true;
    }
};

template <class Prob, class Epi, class Sched>
__device__ __forceinline__ void gemm_phase(LAS unsigned char* lds, const Prob& P, const Sched& S, const Epi& E, int wave_) {
    int tid = wave_ * 64 + lane_id(); asm volatile("" : "+v"(tid));
    const int wid = wave_, lane = tid & 63, wr = wid >> 2, wc = wid & 3, fr = lane & 15, fq = lane >> 4;
#define PG8_RC(R0, C0, Rb0) int R0, C0; { int t_ = tid; asm volatile("" : "+v"(t_)); stage_rc(t_ * 16, R0, C0); } const int Rb0 = (R0 & ~31) + perm32(R0 & 31)
    const size_t kstep = (size_t)(BK * 2);
    const unsigned ldsw = (unsigned)wid * 1024u;
    const int aoff = lds_byte(wr * 64 + fr, fq * 8), boff = lds_byte(wc * 32 + fr, fq * 8);
#define PG8_SA(b, h) (((b) * 2 + (h)) * HTB)
#define PG8_SB(b, h) ((4 + (b) * 2 + (h)) * HTB)
#define PG8_STAGE(bufoff, gbase, v0, q) do { \
        __builtin_amdgcn_global_load_lds((const unsigned*)((const char*)(gbase) + (v0)), (LAS unsigned*)(lds + (bufoff) + ldsw), 16, 0, 0); \
        __builtin_amdgcn_global_load_lds((const unsigned*)((const char*)(gbase) + (q) + (v0)), (LAS unsigned*)(lds + (bufoff) + ldsw + 8192), 16, 0, 0); } while (0)
#define PG8_LDA(dst, b, h) do { _Pragma("unroll") for (int m = 0; m < 4; ++m) _Pragma("unroll") for (int k = 0; k < 2; ++k) dst[m][k] = *(const LAS bf16x8*)(lds + PG8_SA(b, h) + aoff + m * 2048 + k * 1024); } while (0)
#define PG8_LDB(dst, b, h) do { _Pragma("unroll") for (int n = 0; n < 2; ++n) _Pragma("unroll") for (int k = 0; k < 2; ++k) dst[n][k] = *(const LAS bf16x8*)(lds + PG8_SB(b, h) + boff + n * 2048 + k * 1024); } while (0)
#define PG8_MMA(ai, bj, At, Bt) do { __builtin_amdgcn_s_setprio(1); _Pragma("unroll") for (int m = 0; m < 4; ++m) _Pragma("unroll") for (int n = 0; n < 2; ++n) _Pragma("unroll") for (int k = 0; k < 2; ++k) \
        acc[ai][bj][m][n] = __builtin_amdgcn_mfma_f32_16x16x32_bf16(Bt[n][k], At[m][k], acc[ai][bj][m][n], 0, 0, 0); __builtin_amdgcn_s_setprio(0); } while (0)
#define PG8_WAIT_V(n) asm volatile("s_waitcnt vmcnt(" #n ")" ::: "memory")
#define PG8_WAIT_L(n) asm volatile("s_waitcnt lgkmcnt(" #n ")" ::: "memory")
#define PG8_BAR __builtin_amdgcn_s_barrier()
#define PG8_SCHED __builtin_amdgcn_sched_barrier(0)
    Unit cur, nxt; int ui = 0;
    if (!S.next(0, cur)) return;
    Seg sc, sn; P.seg(cur, sc);
    unsigned vAc0, vBc0; { PG8_RC(R0, C0, Rb0); vAc0 = (unsigned)(R0 * sc.lda + C0) * 2u; vBc0 = (unsigned)(Rb0 * sc.ldb + C0) * 2u; }
    f32x4 acc[2][2][4][2];
#pragma unroll
    for (int a = 0; a < 2; ++a)
#pragma unroll
        for (int b = 0; b < 2; ++b)
#pragma unroll
            for (int m = 0; m < 4; ++m)
#pragma unroll
                for (int n = 0; n < 2; ++n) acc[a][b][m][n] = (f32x4){0.f, 0.f, 0.f, 0.f};
    bf16x8 At[4][2], B0[2][2], B1[2][2];
    const char* cA = sc.A; const char* cB = sc.B;
    PG8_STAGE(PG8_SB(0, 0), cB, vBc0, sc.hB >> 1); PG8_STAGE(PG8_SB(0, 1), cB + sc.hB, vBc0, sc.hB >> 1); PG8_STAGE(PG8_SA(0, 0), cA, vAc0, sc.hA >> 1); PG8_STAGE(PG8_SA(0, 1), cA + sc.hA, vAc0, sc.hA >> 1);
    if (wr == 1) PG8_BAR;
    PG8_WAIT_V(2); PG8_BAR;
    PG8_STAGE(PG8_SB(1, 0), cB + kstep, vBc0, sc.hB >> 1); PG8_STAGE(PG8_SA(1, 0), cA + kstep, vAc0, sc.hA >> 1); PG8_STAGE(PG8_SB(1, 1), cB + sc.hB + kstep, vBc0, sc.hB >> 1);
    PG8_WAIT_V(6); PG8_BAR;
    for (;;) {
        const bool has_next = S.next(ui + 1, nxt);
        if (has_next) P.seg(nxt, sn); else sn = sc;
        unsigned vAn0, vBn0; { PG8_RC(R0, C0, Rb0); vAn0 = (unsigned)(R0 * sn.lda + C0) * 2u; vBn0 = (unsigned)(Rb0 * sn.ldb + C0) * 2u; }
        const char* nA = sn.A; const char* nB = sn.B;
        const int nt = sc.nt;
        for (int t = 0; t < nt; t += 2) {
            const bool last = (t == nt - 2);
            const char* a1 = cA + (size_t)(t + 1) * kstep;
            const char* a2 = last ? nA : cA + (size_t)(t + 2) * kstep; const char* b2 = last ? nB : cB + (size_t)(t + 2) * kstep;
            const char* a3 = a2 + kstep; const char* b3 = b2 + kstep;
            const unsigned hA2 = last ? sn.hA : sc.hA, hB2 = last ? sn.hB : sc.hB;
            const unsigned vA0 = last ? vAn0 : vAc0, vB0 = last ? vBn0 : vBc0, qA = hA2 >> 1, qB = hB2 >> 1;
            PG8_LDB(B0, 0, 0); PG8_LDB(B1, 0, 1); PG8_SCHED; PG8_LDA(At, 0, 0); PG8_STAGE(PG8_SA(1, 1), a1 + sc.hA, vAc0, sc.hA >> 1);
            PG8_WAIT_V(8); PG8_WAIT_L(0); PG8_BAR; PG8_MMA(0, 0, At, B0); PG8_MMA(0, 1, At, B1); PG8_BAR; PG8_SCHED;
            PG8_LDA(At, 0, 1); PG8_STAGE(PG8_SB(0, 0), b2, vB0, qB); PG8_STAGE(PG8_SB(0, 1), b2 + hB2, vB0, qB); PG8_STAGE(PG8_SA(0, 0), a2, vA0, qA);
            PG8_WAIT_V(8); PG8_WAIT_L(0); PG8_BAR; PG8_MMA(1, 0, At, B0); PG8_MMA(1, 1, At, B1); PG8_BAR; PG8_SCHED;
            PG8_LDB(B0, 1, 0); PG8_LDB(B1, 1, 1); PG8_SCHED; PG8_LDA(At, 1, 0); PG8_STAGE(PG8_SA(0, 1), a2 + hA2, vA0, qA);
            PG8_WAIT_V(8); PG8_WAIT_L(0); PG8_BAR; PG8_MMA(0, 0, At, B0); PG8_MMA(0, 1, At, B1); PG8_BAR; PG8_SCHED;
            PG8_LDA(At, 1, 1); PG8_STAGE(PG8_SB(1, 0), b3, vB0, qB); PG8_STAGE(PG8_SB(1, 1), b3 + hB2, vB0, qB); PG8_STAGE(PG8_SA(1, 0), a3, vA0, qA);
            PG8_WAIT_V(8); PG8_WAIT_L(0); PG8_BAR; PG8_MMA(1, 0, At, B0); PG8_MMA(1, 1, At, B1); PG8_BAR; PG8_SCHED;
        }
        if (wr == 0) PG8_BAR;
        { int wr_ = wr, wc_ = wc, t_ = tid;
          asm volatile("" : "+s"(wr_), "+s"(wc_), "+v"(t_)); const int fr_ = t_ & 15, fq_ = (t_ >> 4) & 3;
          E(acc, cur, wr_, wc_, fr_, fq_); }
        if (!has_next) break;
#pragma unroll
        for (int a = 0; a < 2; ++a)
#pragma unroll
            for (int b = 0; b < 2; ++b)
#pragma unroll
                for (int m = 0; m < 4; ++m)
#pragma unroll
                    for (int n = 0; n < 2; ++n) acc[a][b][m][n] = (f32x4){0.f, 0.f, 0.f, 0.f};
        cur = nxt; sc = sn; cA = nA; cB = nB; vAc0 = vAn0; vBc0 = vBn0; ++ui;
        if (wr == 1) PG8_BAR;
    }
    PG8_WAIT_V(0);
    PG8_BAR;
#undef PG8_SA
#undef PG8_SB
#undef PG8_STAGE
#undef PG8_LDA
#undef PG8_LDB
#undef PG8_MMA
#undef PG8_WAIT_V
#undef PG8_WAIT_L
#undef PG8_BAR
#undef PG8_SCHED
#undef PG8_RC
}
}

#define EPI_ARGS const f32x4 (&acc)[2][2][4][2], const pg8::Unit& u, int wr, int wc, int fr, int fq
__device__ __forceinline__ void st_bf16x8(bf16_t* p, f32x4 v0, f32x4 v1) {
    u32x4 w; w.x = cvt_pk_bf16(v0[0], v0[1]); w.y = cvt_pk_bf16(v0[2], v0[3]); w.z = cvt_pk_bf16(v1[0], v1[1]); w.w = cvt_pk_bf16(v1[2], v1[3]);
#ifdef SC1_STORES
    asm volatile("global_store_dwordx4 %0, %1, off sc1\n\ts_nop 1" :: "v"(p), "v"(w) : "memory");
#else
    *(u32x4*)p = w;
#endif
}
template <class T> __device__ __forceinline__ T* bo(T* base, unsigned byte_off) { return (T*)((char*)base + byte_off); }
template <class T> __device__ __forceinline__ const T* bo(const T* base, unsigned byte_off) { return (const T*)((const char*)base + byte_off); }
__device__ __forceinline__ void ld_bf16x8(const bf16_t* p, f32x4& v0, f32x4& v1) {
    const unsigned long long lo = __hip_atomic_load((const unsigned long long*)p, __ATOMIC_RELAXED, __HIP_MEMORY_SCOPE_AGENT), hi = __hip_atomic_load((const unsigned long long*)p + 1, __ATOMIC_RELAXED, __HIP_MEMORY_SCOPE_AGENT);
    const u32x4 w = {(unsigned)lo, (unsigned)(lo >> 32), (unsigned)hi, (unsigned)(hi >> 32)};
    v0 = (f32x4){bf_lo(w.x), bf_hi(w.x), bf_lo(w.y), bf_hi(w.y)}; v1 = (f32x4){bf_lo(w.z), bf_hi(w.z), bf_lo(w.w), bf_hi(w.w)};
}
__device__ __forceinline__ float rstd4(f32x4 a) { return rsqrtf(((a.x + a.y) + (a.z + a.w)) * (1.0f / DM) + RMS_EPS); }
__device__ __forceinline__ void rstd8(float (&rs)[2][4], const float* ss, int pm, unsigned lrow) {
    const float* ssb = ss + (size_t)pm * 256 * 4; unsigned lsb = lrow * 16u; asm volatile("" : "+v"(lsb));
    f32x4 t[2][4];
#pragma unroll
    for (int ai = 0; ai < 2; ++ai)
#pragma unroll
        for (int m = 0; m < 4; ++m) t[ai][m] = *(const f32x4*)bo(ssb, lsb + (unsigned)(ai * 128 + m * 16) * 16u);
#pragma unroll
    for (int ai = 0; ai < 2; ++ai)
#pragma unroll
        for (int m = 0; m < 4; ++m) rs[ai][m] = rstd4(t[ai][m]);
}
struct EpiIn {
    unsigned char* ws;
    __device__ __forceinline__ void operator()(EPI_ARGS) const {
        bf16_t* qkv = (bf16_t*)(ws + WS_QA); bf16_t* ub = (bf16_t*)(ws + WS_U); bf16_t* bc = (bf16_t*)(ws + WS_BC); float* kmp = (float*)(ws + WS_KM); const float* ss = (const float*)(ws + WS_SSA);
        const int pn = u.pn; unsigned lrow = (unsigned)(wr * 64 + fr), lcol = (unsigned)(wc * 32 + 8 * fq);
        asm volatile("" : "+v"(lrow), "+v"(lcol));
        const unsigned lb = (lrow * BW + lcol) * 2u;
        float rs[2][4]; rstd8(rs, ss, u.pm, lrow);
        if (pn < 12 || pn >= 16) {
            const int t = pn >> 1; const float sc = (t == 0 || t == 3) ? C2 : 1.0f;
            bf16_t* base = (pn < 12 ? qkv + (size_t)t * M * BW + (pn & 1) * 256 : bc + (pn - 16) * 256) + (size_t)u.pm * 256 * BW;
            if (t == 1) {
                float* kp = kmp + (size_t)(u.pm * 2 + wr) * BW + (pn & 1) * 256;
#pragma unroll
                for (int bj = 0; bj < 2; ++bj)
#pragma unroll
                    for (int n = 0; n < 2; ++n) { f32x4 s = {0.f, 0.f, 0.f, 0.f};
#pragma unroll
                        for (int ai = 0; ai < 2; ++ai)
#pragma unroll
                            for (int m = 0; m < 4; ++m) s += acc[ai][bj][m][n] * rs[ai][m];
#pragma unroll
                        for (int e = 0; e < 4; ++e) { s[e] += xshfl<1>(s[e]); s[e] += xshfl<2>(s[e]); s[e] += xshfl<4>(s[e]); s[e] += xshfl<8>(s[e]); }
                        if (fr == 0) *(f32x4*)bo(kp, (lcol + (unsigned)(bj * 128 + 4 * n)) * 4u) = s; }
            }
            if (t == 2 || t == 5) {
                bf16_t* vb = qkv + (size_t)t * M * BW + ((size_t)((u.pm >> 5) * 8 + (pn & 1) * 4) * SEQ + (size_t)(u.pm & 31) * 256) * HD;
                const unsigned fr_ = lrow & 15u, wr_ = lrow >> 6, hl = lcol >> 6, dd = lcol & 63u;
#pragma unroll
                for (int ai = 0; ai < 2; ++ai)
#pragma unroll
                    for (int m = 0; m < 4; ++m) { float f = rs[ai][m]; asm volatile("" : "+v"(f));
#pragma unroll
                        for (int bj = 0; bj < 2; ++bj) { const unsigned eo = (unsigned)(bj * 2 + hl) * (SEQ * HD) + ((wr_ + 2 * ai) * 4096 + ((dd >> 5) * 4 + m) * 512 + fr_ * 32 + (dd & 31u));
                            st_bf16x8(bo(vb, eo * 2u), acc[ai][bj][m][0] * f, acc[ai][bj][m][1] * f); } }
            } else if (t == 1 || t == 4) {
                bf16_t* kb = qkv + (size_t)t * M * BW + ((size_t)((u.pm >> 5) * 8 + (pn & 1) * 4) * SEQ + (size_t)(u.pm & 31) * 256) * HD;
                const unsigned fr_ = lrow & 15u, wr_ = lrow >> 6, hl = lcol >> 6, dch = (lcol & 63u) >> 3;
#pragma unroll
                for (int ai = 0; ai < 2; ++ai)
#pragma unroll
                    for (int m = 0; m < 4; ++m) { float f = rs[ai][m]; asm volatile("" : "+v"(f));
#pragma unroll
                        for (int bj = 0; bj < 2; ++bj) { const unsigned eo = (unsigned)(bj * 2 + hl) * (SEQ * HD) + (((wr_ * 2 + ai * 4 + (m >> 1)) * 8 + dch) * 256 + (fr_ + 16u * (m & 1)) * 8);
                            st_bf16x8(bo(kb, eo * 2u), acc[ai][bj][m][0] * f, acc[ai][bj][m][1] * f); } }
            } else {
#pragma unroll
            for (int ai = 0; ai < 2; ++ai)
#pragma unroll
                for (int m = 0; m < 4; ++m) { const float f = rs[ai][m] * sc; const unsigned o = lb + (unsigned)(ai * 128 + m * 16) * BW * 2u;
#pragma unroll
                    for (int bj = 0; bj < 2; ++bj) st_bf16x8(bo(base, o + bj * 256u), acc[ai][bj][m][0] * f, acc[ai][bj][m][1] * f); }
            }
        } else {
            bf16_t* base = ub + (size_t)u.pm * 256 * BW + (pn - 12) * 128;
#pragma unroll
            for (int ai = 0; ai < 2; ++ai)
#pragma unroll
                for (int m = 0; m < 4; ++m) { const float f = rs[ai][m] * rs[ai][m];
                    st_bf16x8(bo(base, lb + (unsigned)(ai * 128 + m * 16) * BW * 2u), acc[ai][0][m][0] * acc[ai][1][m][0] * f, acc[ai][0][m][1] * acc[ai][1][m][1] * f); }
        }
    }
};
struct EpiC1 {
    unsigned char* ws; const float* bgate;
    __device__ __forceinline__ unsigned char* gtile(int s, int pm, int pn) const { return ws + WS_KA + (size_t)(s + (s >> 1)) * (16 * MiB) + (size_t)(pm * 4 + pn) * 65536; }
    __device__ __forceinline__ void operator()(EPI_ARGS) const {
        bf16_t* mg = (bf16_t*)(ws + WS_MG); const float* ss = (const float*)(ws + WS_SSA);
        const int sg = u.seg; unsigned lrow = (unsigned)(wr * 64 + fr), lcol = (unsigned)(wc * 32 + 8 * fq);
        asm volatile("" : "+v"(lrow), "+v"(lcol));
        const unsigned lb = (lrow * DM + lcol) * 2u, lg = (unsigned)((wr * 4 + wc) * 8 * 1024 + (fq * 16 + fr) * 16);
        unsigned char* gp = gtile(sg < 3 ? sg : sg - 3, u.pm, u.pn);
        if (sg < 3) {
            const float* bg = bgate + sg * DM + u.pn * 256;
            f32x4 bv[2][2];
#pragma unroll
            for (int bj = 0; bj < 2; ++bj) { bv[bj][0] = *(const f32x4*)bo(bg, (lcol + bj * 128u) * 4u) * (-LOG2E); bv[bj][1] = *(const f32x4*)bo(bg, (lcol + bj * 128u + 4u) * 4u) * (-LOG2E); }
            float rs[2][4]; rstd8(rs, ss, u.pm, lrow);
#pragma unroll
            for (int ai = 0; ai < 2; ++ai)
#pragma unroll
                for (int m = 0; m < 4; ++m) { const float rn = rs[ai][m] * (-LOG2E); u32x4 w;
#pragma unroll
                    for (int bj = 0; bj < 2; ++bj)
#pragma unroll
                        for (int n = 0; n < 2; ++n) { const f32x4 x = acc[ai][bj][m][n] * rn + bv[bj][n];
                            unsigned q[4];
#pragma unroll
                            for (int e = 0; e < 4; ++e) q[e] = (unsigned)(__builtin_amdgcn_rcpf(1.0f + __builtin_amdgcn_exp2f(x[e])) * 255.0f + 0.5f);
                            w[bj * 2 + n] = q[0] | (q[1] << 8) | (q[2] << 16) | (q[3] << 24); }
                    *(u32x4*)bo(gp, lg + (unsigned)((ai * 4 + m) * 1024)) = w; }
        } else {
            bf16_t* mp = mg + (size_t)u.pm * 256 * DM + u.pn * 256;
#pragma unroll
            for (int ai = 0; ai < 2; ++ai) {
                u32x4 gw_[4], pw_[4][2];
#pragma unroll
                for (int mm = 0; mm < 4; ++mm) { gw_[mm] = *(const u32x4*)bo((const unsigned char*)gp, lg + (unsigned)((ai * 4 + mm) * 1024));
#pragma unroll
                    for (int bj = 0; bj < 2; ++bj) if (sg > 3) pw_[mm][bj] = *(const u32x4*)bo((const bf16_t*)mp, lb + (unsigned)(ai * 128 + mm * 16) * DM * 2u + bj * 256u); }
#pragma unroll
                for (int mm = 0; mm < 4; ++mm)
#pragma unroll
                    for (int bj = 0; bj < 2; ++bj) { const unsigned o = lb + (unsigned)(ai * 128 + mm * 16) * DM * 2u + bj * 256u; const unsigned g0 = gw_[mm][bj * 2], g1 = gw_[mm][bj * 2 + 1]; constexpr float s = 1.0f / 255.0f;
                        f32x4 v0 = acc[ai][bj][mm][0] * ((f32x4){(float)(g0 & 255u), (float)((g0 >> 8) & 255u), (float)((g0 >> 16) & 255u), (float)(g0 >> 24)} * s);
                        f32x4 v1 = acc[ai][bj][mm][1] * ((f32x4){(float)(g1 & 255u), (float)((g1 >> 8) & 255u), (float)((g1 >> 16) & 255u), (float)(g1 >> 24)} * s);
                        if (sg > 3) { const u32x4 p = pw_[mm][bj]; v0 += (f32x4){bf_lo(p.x), bf_hi(p.x), bf_lo(p.y), bf_hi(p.y)}; v1 += (f32x4){bf_lo(p.z), bf_hi(p.z), bf_lo(p.w), bf_hi(p.w)}; }
                        st_bf16x8(bo(mp, o), v0, v1); }
                asm volatile("" ::: "memory");
            }
        }
    }
};
struct EpiRes {
    unsigned char* ws; int toA; LAS float* red;
    __device__ __forceinline__ void operator()(EPI_ARGS) const {
        bf16_t* xb = (bf16_t*)(ws + WS_XB); float* sso = (float*)(ws + (toA ? WS_SSA : WS_SSB));
        unsigned lrow = (unsigned)(wr * 64 + fr), lcol = (unsigned)(wc * 32 + 8 * fq);
        asm volatile("" : "+v"(lrow), "+v"(lcol));
        const unsigned le = (lrow * DM + lcol) * 2u, lr4 = lrow * 4u + (unsigned)wc;
        bf16_t* xp = xb + (size_t)u.pm * 256 * DM + u.pn * 256;
#pragma unroll
        for (int ai = 0; ai < 2; ++ai) {
            u32x4 bs[4][2];
#pragma unroll
            for (int m = 0; m < 4; ++m)
#pragma unroll
                for (int bj = 0; bj < 2; ++bj) bs[m][bj] = *(const u32x4*)bo((const bf16_t*)xp, le + (unsigned)(ai * 128 + m * 16) * DM * 2u + bj * 256u);
#pragma unroll
            for (int m = 0; m < 4; ++m) { float sq = 0.f;
#pragma unroll
                for (int bj = 0; bj < 2; ++bj) { const u32x4 w = bs[m][bj];
                    const f32x4 x0 = (f32x4){bf_lo(w.x), bf_hi(w.x), bf_lo(w.y), bf_hi(w.y)} + acc[ai][bj][m][0], x1 = (f32x4){bf_lo(w.z), bf_hi(w.z), bf_lo(w.w), bf_hi(w.w)} + acc[ai][bj][m][1];
                    st_bf16x8(bo(xp, le + (unsigned)(ai * 128 + m * 16) * DM * 2u + bj * 256u), x0, x1);
                    sq += (x0[0] * x0[0] + x0[1] * x0[1]) + (x0[2] * x0[2] + x0[3] * x0[3]) + (x1[0] * x1[0] + x1[1] * x1[1]) + (x1[2] * x1[2] + x1[3] * x1[3]); }
                sq += xshfl<16>(sq); sq = sum32(sq);
                if (fq == 0) red[lr4 + (unsigned)(ai * 128 + m * 16) * 4u] = sq; }
            asm volatile("" ::: "memory");
        }
        asm volatile("s_waitcnt lgkmcnt(0)\n\ts_barrier" ::: "memory");
        { const int t = ((wr * 4 + wc) * 4 + fq) * 16 + fr; if (t < 256) { const f32x4 r = *(const LAS f32x4*)(red + t * 4); sso[((size_t)u.pm * 256 + t) * 4 + u.pn] = (r.x + r.y) + (r.z + r.w); } }
        asm volatile("s_waitcnt lgkmcnt(0)\n\ts_barrier" ::: "memory");
    }
};
struct EpiFfn {
    unsigned char* ws;
    __device__ __forceinline__ void operator()(EPI_ARGS) const {
        bf16_t* act = (bf16_t*)(ws + WS_ACT); const float* ss = (const float*)(ws + WS_SSB);
        unsigned lrow = (unsigned)(wr * 64 + fr), lcol = (unsigned)(wc * 32 + 8 * fq);
        asm volatile("" : "+v"(lrow), "+v"(lcol));
        const unsigned lb = (lrow * DFF + lcol) * 2u;
        bf16_t* ap = act + (size_t)u.pm * 256 * DFF + u.pn * 128;
        float rs[2][4]; rstd8(rs, ss, u.pm, lrow);
#pragma unroll
        for (int ai = 0; ai < 2; ++ai)
#pragma unroll
            for (int m = 0; m < 4; ++m) { const float r1 = rs[ai][m], rn = r1 * (-LOG2E); f32x4 v[2];
#pragma unroll
                for (int n = 0; n < 2; ++n) { const f32x4 g = acc[ai][0][m][n], up = acc[ai][1][m][n] * (r1 * r1);
#pragma unroll
                    for (int e = 0; e < 4; ++e) v[n][e] = g[e] * up[e] * __builtin_amdgcn_rcpf(1.0f + __builtin_amdgcn_exp2f(g[e] * rn)); }
                st_bf16x8(bo(ap, lb + (unsigned)(ai * 128 + m * 16) * DFF * 2u), v[0], v[1]); }
    }
};

struct GCfg {
    int mode;
    int N, nseg, lda, ldb, nt, toA;
    const bf16_t* A; const bf16_t* B;
    unsigned char* ws; unsigned char* wb; const float* bgate; LAS float* red;
};
struct ProbAny {
    const GCfg* c;
    __device__ __forceinline__ void seg(const pg8::Unit& u, pg8::Seg& s) const {
        if (c->mode == 1 && u.seg >= 3) {
            const int br = u.seg - 3; const bf16_t* O = (const bf16_t*)(c->ws + WS_QA + (size_t)br * (48 * MiB)); const bf16_t* Wp = (const bf16_t*)(c->wb + (WS_WP - WS_WIN));
            s.A = (const char*)(O + (size_t)u.pm * 256 * BW); s.B = (const char*)(Wp + ((size_t)br * DM + (size_t)u.pn * 256) * BW);
            s.hA = 128u * BW * 2u; s.hB = 128u * BW * 2u; s.lda = BW; s.ldb = BW; s.nt = BW / 64;
        } else {
            const int so = (c->mode == 1) ? u.seg * DM : 0;
            s.A = (const char*)(c->A + (size_t)u.pm * 256 * c->lda); s.B = (const char*)(c->B + ((size_t)so + (size_t)u.pn * 256) * c->ldb);
            s.hA = 128u * (unsigned)c->lda * 2u; s.hB = 128u * (unsigned)c->ldb * 2u; s.lda = c->lda; s.ldb = c->ldb; s.nt = c->nt;
        }
    }
};
struct EpiAny {
    const GCfg* c;
    __device__ __forceinline__ void operator()(EPI_ARGS) const {
        const int m_ = c->mode;
        if (m_ == 0) EpiIn{c->ws}(acc, u, wr, wc, fr, fq);
        else if (m_ == 1) EpiC1{c->ws, c->bgate}(acc, u, wr, wc, fr, fq);
        else if (m_ == 2) EpiRes{c->ws, c->toA, c->red}(acc, u, wr, wc, fr, fq);
        else EpiFfn{c->ws}(acc, u, wr, wc, fr, fq);
    }
};

namespace att {
__device__ __forceinline__ constexpr int crow(int r, int hi) { return (r & 3) + 8 * (r >> 2) + 4 * hi; }
__device__ __forceinline__ float swap_lo(float x, float& hiv) { auto rr = __builtin_amdgcn_permlane32_swap(__float_as_uint(x), __float_as_uint(x), false, false); hiv = __uint_as_float(rr[1]); return __uint_as_float(rr[0]); }
__device__ __forceinline__ s16x4 vtr(const LAS unsigned char* p) { return __builtin_bit_cast(s16x4, __builtin_amdgcn_ds_read_tr16_b64_v4i16((LAS s16x4*)p)); }
__device__ __forceinline__ void load_k(bf16x8 (&kf)[8], const bf16_t* Kh, int j0, int r32, int hi) {
    const bf16_t* p = Kh + (size_t)(j0 >> 5) * 2048 + hi * 256 + r32 * 8;
#pragma unroll
    for (int d0 = 0; d0 < 4; ++d0) { kf[2 * d0] = *(const bf16x8*)(p + d0 * 512); kf[2 * d0 + 1] = *(const bf16x8*)(p + 2048 + d0 * 512); }
}
__device__ __forceinline__ void dma_v(LAS unsigned char* vbuf, const bf16_t* Vh, int j0, int lane) {
    const bf16_t* p = Vh + (size_t)(j0 >> 6) * 4096 + lane * 8;
#pragma unroll
    for (int i = 0; i < 8; ++i) __builtin_amdgcn_global_load_lds((const unsigned*)(p + i * 512), (LAS unsigned*)(vbuf + i * 1024), 16, 0, 0);
}
__device__ __forceinline__ void load_v(u32x4 (&vv)[8], const bf16_t* Vh, int j0, int lane) {
    const bf16_t* p = Vh + (size_t)(j0 + (lane >> 3)) * BW + (lane & 7) * 8;
#pragma unroll
    for (int i = 0; i < 8; ++i) vv[i] = *(const u32x4*)(p + (size_t)(8 * i) * BW);
}
__device__ __forceinline__ void stage_v(LAS unsigned char* vst, const u32x4 (&vv)[8], int lane) {
    const int c = lane & 7;
#pragma unroll
    for (int i = 0; i < 8; ++i) { const int key = 8 * i + (lane >> 3);
        *(LAS u32x4*)(vst + ((c >> 2) * 4 + (key >> 4)) * 1024 + (key & 15) * 64 + (c & 3) * 16) = vv[i]; }
}
__device__ __forceinline__ void qk(f32x16& p0, f32x16& p1, const bf16x8 (&kf)[8], const bf16x8 (&qr)[4]) {
#pragma unroll
    for (int d0 = 0; d0 < 4; ++d0) { p0 = __builtin_amdgcn_mfma_f32_32x32x16_bf16(kf[2 * d0], qr[d0], p0, 0, 0, 0); p1 = __builtin_amdgcn_mfma_f32_32x32x16_bf16(kf[2 * d0 + 1], qr[d0], p1, 0, 0, 0); }
}
__device__ __forceinline__ void pv(f32x16& o0, f32x16& o1, const f32x16& p0, const f32x16& p1, const LAS unsigned char* vst, int lane) {
    const int hi = lane >> 5;
    const LAS unsigned char* vp = vst + ((lane >> 4) & 1) * 32 + (lane & 3) * 8 + (4 * hi + ((lane & 15) >> 2)) * 64;
    u32x4 pw[4];
    pw[0] = (u32x4){cvt_pk_bf16(p0[0], p0[1]), cvt_pk_bf16(p0[2], p0[3]), cvt_pk_bf16(p0[4], p0[5]), cvt_pk_bf16(p0[6], p0[7])};
    pw[1] = (u32x4){cvt_pk_bf16(p0[8], p0[9]), cvt_pk_bf16(p0[10], p0[11]), cvt_pk_bf16(p0[12], p0[13]), cvt_pk_bf16(p0[14], p0[15])};
    pw[2] = (u32x4){cvt_pk_bf16(p1[0], p1[1]), cvt_pk_bf16(p1[2], p1[3]), cvt_pk_bf16(p1[4], p1[5]), cvt_pk_bf16(p1[6], p1[7])};
    pw[3] = (u32x4){cvt_pk_bf16(p1[8], p1[9]), cvt_pk_bf16(p1[10], p1[11]), cvt_pk_bf16(p1[12], p1[13]), cvt_pk_bf16(p1[14], p1[15])};
#pragma unroll
    for (int ks = 0; ks < 4; ++ks) {
        const s16x4 a0 = vtr(vp + ks * 1024), a1 = vtr(vp + ks * 1024 + 512), b0 = vtr(vp + 4096 + ks * 1024), b1 = vtr(vp + 4096 + ks * 1024 + 512);
        const bf16x8 v0 = {a0[0], a0[1], a0[2], a0[3], a1[0], a1[1], a1[2], a1[3]}, v1 = {b0[0], b0[1], b0[2], b0[3], b1[0], b1[1], b1[2], b1[3]};
        const bf16x8 pa = __builtin_bit_cast(bf16x8, pw[ks]);
        o0 = __builtin_amdgcn_mfma_f32_32x32x16_bf16(pa, v0, o0, 0, 0, 0);
        o1 = __builtin_amdgcn_mfma_f32_32x32x16_bf16(pa, v1, o1, 0, 0, 0);
    }
}
__device__ __forceinline__ void store_o(bf16_t* Ow, const f32x16& o0, const f32x16& o1, const float (&rsc)[16], LAS unsigned char* stg, int lane) {
    const int r32 = lane & 31, hi = lane >> 5;
    LAS bf16_t* s = (LAS bf16_t*)stg;
#pragma unroll
    for (int r = 0; r < 16; ++r) { const int orow = crow(r, hi);
        s[orow * 64 + r32] = (bf16_t)(cvt_pk_bf16(o0[r] * rsc[r], 0.f) & 0xffffu); s[orow * 64 + 32 + r32] = (bf16_t)(cvt_pk_bf16(o1[r] * rsc[r], 0.f) & 0xffffu); }
    LDS_WAIT();
#pragma unroll
    for (int i = 0; i < 4; ++i) { const int row = i * 8 + (lane >> 3), ch = lane & 7; const u32x4 v = *(const LAS u32x4*)(stg + row * 128 + ch * 16); *(u32x4*)(Ow + (size_t)row * BW + ch * 8) = v; }
    LDS_WAIT();
}

__device__ __forceinline__ void sb_item(bf16_t* Q, const bf16_t* K, const bf16_t* V, int b, int h, int q0, LAS unsigned char* vst, int lane) {
    asm volatile("" : "+v"(lane));
    const int r32 = lane & 31, hi = lane >> 5;
    const size_t rowbase = (size_t)b * SEQ;
    bf16_t* Qw = Q + (rowbase + q0) * BW + h * HD;
    bf16x8 qr[4];
#pragma unroll
    for (int d0 = 0; d0 < 4; ++d0) qr[d0] = *(const bf16x8*)(Qw + (size_t)r32 * BW + d0 * 16 + hi * 8);
    const bf16_t* Kh = K + (size_t)(b * NH + h) * SEQ * HD; const bf16_t* Vh = V + (size_t)(b * NH + h) * SEQ * HD;
    f32x16 o0 = {}, o1 = {}; float A2 = 0.f;
    const int tq = q0 + r32;
    bf16x8 kf[8]; load_k(kf, Kh, ((q0 + 30) >> 6) * 64, r32, hi); dma_v(vst + (((q0 + 30) >> 6) & 1) * 8192, Vh, ((q0 + 30) >> 6) * 64, lane);
    for (int kt = (q0 + 30) >> 6; kt >= 0; --kt) {
        const int j0 = kt * 64;
        f32x16 p0 = {}, p1 = {};
        qk(p0, p1, kf, qr);
        asm volatile("" : "+v"(p0), "+v"(p1) :: "memory");
        LAS unsigned char* vcur = vst + (kt & 1) * 8192;
        if (kt > 0) { dma_v(vst + ((kt - 1) & 1) * 8192, Vh, j0 - 64, lane); load_k(kf, Kh, j0 - 64, r32, hi); }
        const bool diag = (j0 + 63 >= q0);
        f32x16 l0, l1;
#pragma unroll
        for (int r = 0; r < 16; ++r) {
            { const float z = p0[r]; const float t = __builtin_amdgcn_exp2f(-__builtin_fabsf(z)); float l = -(__builtin_fmaxf(z, 0.f) + __builtin_amdgcn_logf(1.0f + t)); if (diag && (j0 + crow(r, hi) >= tq)) l = 0.f; l0[r] = l; }
            { const float z = p1[r]; const float t = __builtin_amdgcn_exp2f(-__builtin_fabsf(z)); float l = -(__builtin_fmaxf(z, 0.f) + __builtin_amdgcn_logf(1.0f + t)); if (diag && (j0 + 32 + crow(r, hi) >= tq)) l = 0.f; l1[r] = l; }
        }
        float carry = A2;
#pragma unroll
        for (int half = 1; half >= 0; --half) {
            f32x16& l = half ? l1 : l0; f32x16& p = half ? p1 : p0;
            float T[4];
#pragma unroll
            for (int g = 0; g < 4; ++g) { l[4 * g + 2] += l[4 * g + 3]; l[4 * g + 1] += l[4 * g + 2]; l[4 * g] += l[4 * g + 1]; T[g] = l[4 * g]; }
            float Tl[4], Th[4];
#pragma unroll
            for (int g = 0; g < 4; ++g) Tl[g] = swap_lo(T[g], Th[g]);
            float E = carry;
#pragma unroll
            for (int g = 3; g >= 0; --g) { const float eh = E; E += Th[g]; const float el = E; E += Tl[g]; const float off = hi ? eh : el;
                l[4 * g] += off; l[4 * g + 1] += off; l[4 * g + 2] += off; l[4 * g + 3] += off; }
            carry = E;
#pragma unroll
            for (int r = 0; r < 16; ++r) { float w = __builtin_amdgcn_exp2f(p[r] + l[r]); if (diag && (j0 + 32 * half + crow(r, hi) >= tq)) w = 0.f; p[r] = w; }
        }
        A2 = carry;
        if (kt > 0) asm volatile("s_waitcnt vmcnt(16)" ::: "memory"); else asm volatile("s_waitcnt vmcnt(0)" ::: "memory");
        pv(o0, o1, p0, p1, vcur, lane);
        LDS_WAIT();
        if (__all(A2 < -150.2f)) break;
    }
    float one[16];
#pragma unroll
    for (int r = 0; r < 16; ++r) one[r] = 1.0f;
    store_o(Qw, o0, o1, one, vst, lane);
}

constexpr float MOBA_THR = 8.0f;
__device__ __forceinline__ void gate_load(bf16x8 (&qr)[4], bf16x8 (&kr)[4], const bf16_t* Qw, const bf16_t* Kown, int tq0, int lane) {
    asm volatile("" : "+v"(lane));
    const int r32 = lane & 31, hi = lane >> 5;
    const bf16_t* Qrow = Qw + (size_t)r32 * BW + hi * 8;
    const int tk = tq0 + r32; const bf16_t* kp = Kown + (size_t)(tk >> 5) * 2048 + hi * 256 + (tk & 31) * 8;
#pragma unroll
    for (int d0 = 0; d0 < 4; ++d0) { qr[d0] = *(const bf16x8*)(Qrow + d0 * 16); kr[d0] = *(const bf16x8*)(kp + d0 * 512); }
}
__device__ __forceinline__ unsigned moba_gate(const bf16x8 (&qr)[4], const bf16x8 (&kr)[4], int blk, int tq0, float sl2, const LAS float* km, const LAS float* kbn, int lane) {
    asm volatile("" : "+v"(lane));
    const int r32 = lane & 31, hi = lane >> 5;
    unsigned sel = 0u;
    if (blk > 0) {
        f32x16 p = {};
#pragma unroll
        for (int d0 = 0; d0 < 4; ++d0) { const LAS f32x4* kmr = (const LAS f32x4*)(km + r32 * 64); const int c0 = d0 * 4 + hi * 2; const f32x4 a = kmr[c0 ^ (r32 & 15)], c = kmr[(c0 + 1) ^ (r32 & 15)];
            const u32x4 h = {cvt_pk_bf16(a[0], a[1]), cvt_pk_bf16(a[2], a[3]), cvt_pk_bf16(c[0], c[1]), cvt_pk_bf16(c[2], c[3])};
            const u32x4 l = {cvt_pk_bf16(a[0] - bf_lo(h.x), a[1] - bf_hi(h.x)), cvt_pk_bf16(a[2] - bf_lo(h.y), a[3] - bf_hi(h.y)), cvt_pk_bf16(c[0] - bf_lo(h.z), c[1] - bf_hi(h.z)), cvt_pk_bf16(c[2] - bf_lo(h.w), c[3] - bf_hi(h.w))};
            p = __builtin_amdgcn_mfma_f32_32x32x16_bf16(__builtin_bit_cast(bf16x8, l), qr[d0], p, 0, 0, 0);
            p = __builtin_amdgcn_mfma_f32_32x32x16_bf16(__builtin_bit_cast(bf16x8, h), qr[d0], p, 0, 0, 0); }
        float v1 = -INFINITY, v2 = -INFINITY, v3 = -INFINITY; int i1 = -1, i2 = -1, i3 = -1;
#define TOP_INS(v, n) do { const bool b1 = (v) > v1 || ((v) == v1 && (n) < i1), b2 = (v) > v2 || ((v) == v2 && (n) < i2), b3 = (v) > v3 || ((v) == v3 && (n) < i3); \
            if (b3) { if (b2) { v3 = v2; i3 = i2; if (b1) { v2 = v1; i2 = i1; v1 = (v); i1 = (n); } else { v2 = (v); i2 = (n); } } else { v3 = (v); i3 = (n); } } } while (0)
#pragma unroll
        for (int r = 0; r < 16; ++r) { const int n = crow(r, 0) + 4 * hi; const float d = p[r]; if (n < blk) TOP_INS(d, n); }
        { float x0, x1; x0 = swap_lo(v1, x1); const float pv1 = hi ? x0 : x1; x0 = swap_lo(v2, x1); const float pv2 = hi ? x0 : x1; x0 = swap_lo(v3, x1); const float pv3 = hi ? x0 : x1;
          x0 = swap_lo(__int_as_float(i1), x1); const int pi1 = __float_as_int(hi ? x0 : x1); x0 = swap_lo(__int_as_float(i2), x1); const int pi2 = __float_as_int(hi ? x0 : x1); x0 = swap_lo(__int_as_float(i3), x1); const int pi3 = __float_as_int(hi ? x0 : x1);
          TOP_INS(pv1, pi1); TOP_INS(pv2, pi2); TOP_INS(pv3, pi3); }
#undef TOP_INS
        float qn2 = 0.f, zs = 0.f;
#pragma unroll
        for (int d0 = 0; d0 < 4; ++d0) { const u32x4 q = __builtin_bit_cast(u32x4, qr[d0]), x = __builtin_bit_cast(u32x4, kr[d0]);
            const float q0 = bf_lo(q.x), q1 = bf_hi(q.x), q2 = bf_lo(q.y), q3 = bf_hi(q.y), q4 = bf_lo(q.z), q5 = bf_hi(q.z), q6 = bf_lo(q.w), q7 = bf_hi(q.w);
            zs += q0 * bf_lo(x.x) + q1 * bf_hi(x.x) + q2 * bf_lo(x.y) + q3 * bf_hi(x.y) + q4 * bf_lo(x.z) + q5 * bf_hi(x.z) + q6 * bf_lo(x.w) + q7 * bf_hi(x.w);
            qn2 += (q0 * q0 + q1 * q1) + (q2 * q2 + q3 * q3) + (q4 * q4 + q5 * q5) + (q6 * q6 + q7 * q7); }
        { float x1; float x0 = swap_lo(zs, x1); zs = x0 + x1; x0 = swap_lo(qn2, x1); qn2 = x0 + x1; }
        const float qn = sqrtf(qn2) * 1.001f, thr = zs - 151.0f; const int tq = tq0 + r32;
#define KEEP(i_) ((i_) >= 0 && !(qn * kbn[(i_)] - sl2 * (float)(tq - (256 * (i_) + 255)) < thr))
        if (KEEP(i1)) sel |= 1u << i1; if (KEEP(i2)) sel |= 1u << i2; if (KEEP(i3)) sel |= 1u << i3;
#undef KEEP
    }
    return sel;
}
__device__ __forceinline__ void moba_tile(f32x16& o0, f32x16& o1, float& mrow, float& lsum, const bf16x8 (&qr)[4], bf16x8 (&kf)[8], const bf16_t* Kh, const bf16_t* Vh, int j0, int jn, float lb, float sl2, bool diag, int tq,
                                          LAS unsigned char* vst, LAS float* wsf, int lane, const float (&bv)[16]) {
    const int r32 = lane & 31, hi = lane >> 5;
    const float mref = (mrow == -INFINITY) ? 0.f : mrow; const float i0 = lb - mref, i1 = i0 + 32.0f * sl2;
    f32x16 p0, p1;
#pragma unroll
    for (int r = 0; r < 16; ++r) { p0[r] = i0 + bv[r]; p1[r] = i1 + bv[r]; }
    qk(p0, p1, kf, qr);
    asm volatile("" : "+v"(p0), "+v"(p1) :: "memory");
    LAS unsigned char* vcur = vst + ((j0 >> 6) & 1) * 8192;
    if (jn >= 0) { dma_v(vst + ((jn >> 6) & 1) * 8192, Vh, jn, lane); load_k(kf, Kh, jn, r32, hi); }
    if (diag) {
#pragma unroll
        for (int r = 0; r < 16; ++r) { if (j0 + crow(r, hi) > tq) p0[r] = -INFINITY; if (j0 + 32 + crow(r, hi) > tq) p1[r] = -INFINITY; }
    }
    float rm = __builtin_fmaxf(p0[0], p1[0]);
#pragma unroll
    for (int r = 1; r < 16; ++r) rm = __builtin_fmaxf(rm, __builtin_fmaxf(p0[r], p1[r]));
    { float x1; const float x0 = swap_lo(rm, x1); rm = __builtin_fmaxf(x0, x1); }
    rm += mref;
    if (__any(rm > mrow + MOBA_THR)) {
        const float mn = __builtin_fmaxf(mrow, rm); const float f = __builtin_amdgcn_exp2f(mrow - mn), dsh = mn - mref; mrow = mn; lsum *= f;
        if (hi == 0) wsf[r32] = f;
        LDS_WAIT();
#pragma unroll
        for (int r = 0; r < 16; ++r) { const float fr_ = wsf[crow(r, hi)]; o0[r] *= fr_; o1[r] *= fr_; p0[r] -= dsh; p1[r] -= dsh; }
        LDS_WAIT();
    }
    float ps = 0.f;
#pragma unroll
    for (int r = 0; r < 16; ++r) { p0[r] = __builtin_amdgcn_exp2f(p0[r]); p1[r] = __builtin_amdgcn_exp2f(p1[r]); ps += p0[r] + p1[r]; }
    lsum += ps;
    if (jn >= 0) asm volatile("s_waitcnt vmcnt(16)" ::: "memory"); else asm volatile("s_waitcnt vmcnt(0)" ::: "memory");
    pv(o0, o1, p0, p1, vcur, lane);
    LDS_WAIT();
}
__device__ __forceinline__ void moba_item(const bf16_t* Q, const bf16_t* K, const bf16_t* V, int b, int h, int blk, int n, int tix, const LAS unsigned char* lists, const LAS unsigned* cnt,
                                          const LAS unsigned* selm, unsigned char* recO, float* recML, LAS unsigned char* vst, LAS float* wsf, LAS unsigned* trow, int lane) {
    asm volatile("" : "+v"(lane));
    const int r32 = lane & 31, hi = lane >> 5; const size_t rowbase = (size_t)b * SEQ; const bool own = (n == blk);
    int q; bool valid; unsigned slot;
    if (own) { q = 32 * tix + r32; valid = true; slot = (unsigned)q * 4u + 3u; }
    else { const int cn = (int)cnt[n]; const int p = 32 * tix + r32; valid = p < cn; q = (int)lists[n * 256 + (valid ? p : cn - 1)];
           slot = (unsigned)q * 4u + (unsigned)__builtin_popcount(selm[q] & ((1u << n) - 1u)); }
    if (hi == 0) trow[r32] = slot | (valid ? 0x80000000u : 0u);
    const int tq = blk * 256 + q;
    const bf16_t* Qrow = Q + (rowbase + tq) * BW + h * HD + hi * 8;
    bf16x8 qr[4];
#pragma unroll
    for (int d0 = 0; d0 < 4; ++d0) qr[d0] = *(const bf16x8*)(Qrow + d0 * 16);
    const bf16_t* Kh = K + (size_t)(b * NH + h) * SEQ * HD; const bf16_t* Vh = V + (size_t)(b * NH + h) * SEQ * HD;
    const float sl2 = __builtin_amdgcn_exp2f(-(float)(h + 1)) * LOG2E;
    f32x16 o0 = {}, o1 = {}; float mrow = -INFINITY, lsum = 0.f;
    float bv[16];
#pragma unroll
    for (int r = 0; r < 16; ++r) bv[r] = sl2 * (float)crow(r, 0);
    const int ntile = own ? (tix >> 1) + 1 : 4;
    bf16x8 kf[8]; load_k(kf, Kh, n * 256, r32, hi); dma_v(vst + ((n * 4) & 1) * 8192, Vh, n * 256, lane);
#pragma unroll 1
    for (int i = 0; i < ntile; ++i) { const int j0 = n * 256 + i * 64;
        moba_tile(o0, o1, mrow, lsum, qr, kf, Kh, Vh, j0, i < ntile - 1 ? j0 + 64 : -1, sl2 * (float)(j0 + 4 * hi - tq), sl2, own && i == ntile - 1, tq, vst, wsf, lane, bv); }
    { float x1; const float x0 = swap_lo(lsum, x1); lsum = x0 + x1; }
    if (hi == 0) { wsf[32 + r32] = lsum; if (valid) *(f32x2*)(recML + 2 * slot) = (f32x2){mrow, lsum}; }
    LDS_WAIT();
    LAS bf16_t* s = (LAS bf16_t*)vst;
#pragma unroll
    for (int r = 0; r < 16; ++r) { const int orow = crow(r, hi); const float rl = __builtin_amdgcn_rcpf(wsf[32 + orow]);
        s[orow * 64 + r32] = (bf16_t)(cvt_pk_bf16(o0[r] * rl, 0.f) & 0xffffu); s[orow * 64 + 32 + r32] = (bf16_t)(cvt_pk_bf16(o1[r] * rl, 0.f) & 0xffffu); }
    LDS_WAIT();
#pragma unroll
    for (int i = 0; i < 4; ++i) { const int row = i * 8 + (lane >> 3), ch = lane & 7; const unsigned tr = trow[row]; const u32x4 v = *(const LAS u32x4*)(vst + row * 128 + ch * 16);
        if (tr & 0x80000000u) *(u32x4*)(recO + (size_t)(tr & 0x7fffffffu) * 128 + ch * 16) = v; }
    LDS_WAIT();
}
__device__ __forceinline__ void moba_merge(bf16_t* Q, int b, int h, int blk, int w, const LAS unsigned* selm, const unsigned char* recO, const float* recML, LAS float* wsf, int lane) {
    asm volatile("" : "+v"(lane));
    const int r32 = lane & 31, hi = lane >> 5; const size_t rowbase = (size_t)b * SEQ; const int q0 = blk * 256 + w * 32;
    const int ql = w * 32 + r32; const int c = __builtin_popcount(selm[ql]);
    f32x2 ml[4];
#pragma unroll
    for (int k = 0; k < 4; ++k) ml[k] = __builtin_nontemporal_load((const f32x2*)(recML + 2 * ((unsigned)ql * 4u + k)));
    u32x4 pw[4][4];
#pragma unroll
    for (int i = 0; i < 4; ++i)
#pragma unroll
        for (int k = 0; k < 4; ++k) pw[i][k] = __builtin_nontemporal_load((const u32x4*)(recO + (size_t)((unsigned)(w * 32 + i * 8 + (lane >> 3)) * 4u + k) * 128 + (lane & 7) * 16));
    float mi[4], li[4]; float mx = -INFINITY;
#pragma unroll
    for (int k = 0; k < 4; ++k) { const bool used = (k == 3 || k < c); mi[k] = used ? ml[k].x : -INFINITY; li[k] = used ? ml[k].y : 0.f; mx = __builtin_fmaxf(mx, mi[k]); }
    float wg[4], L = 0.f;
#pragma unroll
    for (int k = 0; k < 4; ++k) { wg[k] = (k == 3 || k < c) ? __builtin_amdgcn_exp2f(mi[k] - mx) * li[k] : 0.f; L += wg[k]; }
    const float rL = 1.0f / L;
    if (hi == 0) { wsf[r32] = wg[0] * rL; wsf[32 + r32] = wg[1] * rL; wsf[64 + r32] = wg[2] * rL; wsf[96 + r32] = wg[3] * rL; }
    LDS_WAIT();
    bf16_t* Qw = Q + (rowbase + q0) * BW + h * HD;
#pragma unroll
    for (int i = 0; i < 4; ++i) { const int row = i * 8 + (lane >> 3), ch = lane & 7; f32x4 v0 = {0.f, 0.f, 0.f, 0.f}, v1 = {0.f, 0.f, 0.f, 0.f};
#pragma unroll
        for (int k = 0; k < 4; ++k) { const float ak = wsf[32 * k + row];
            if (ak != 0.f) { const u32x4 p = pw[i][k];
                v0 += ak * (f32x4){bf_lo(p.x), bf_hi(p.x), bf_lo(p.y), bf_hi(p.y)}; v1 += ak * (f32x4){bf_lo(p.z), bf_hi(p.z), bf_lo(p.w), bf_hi(p.w)}; } }
        st_bf16x8(Qw + (size_t)row * BW + ch * 8, v0, v1); }
    LDS_WAIT();
}
}

#define XB_TMO      128
#define XB_MAPBAD   192
#define XB_XCNT(j)  (256  + 64 * (j))
#define XB_XSUB(j)  (1280 + 64 * (j))
#define XB_XGEN(j)  (2304 + 64 * (j))
#define XB_TOP      3328
#define XB_TOPGEN   3392
#define XCD_BAR_WORDS 3456
#define XB_SPIN_CAP (1u << 18)
__device__ __forceinline__ unsigned xb_ld(unsigned* p)              { return __hip_atomic_load(p, __ATOMIC_RELAXED, __HIP_MEMORY_SCOPE_AGENT); }
__device__ __forceinline__ unsigned xb_add(unsigned* p, unsigned v) { return __hip_atomic_fetch_add(p, v, __ATOMIC_RELAXED, __HIP_MEMORY_SCOPE_AGENT); }
__device__ __forceinline__ unsigned xb_xcc_id() { return (unsigned)__builtin_amdgcn_s_getreg((3 << 11) | 20) & 0xFu; }
#define XB_SPIN(cond, bar) do { unsigned _sp = 0; while (cond) { __builtin_amdgcn_s_sleep(1); \
    if ((++_sp & 255u) == 0u) { if (xb_ld(&(bar)[XB_TMO])) break; if (_sp > XB_SPIN_CAP) { atomicAdd(&(bar)[XB_TMO], 1u); break; } } } } while (0)
struct XcdBarrier { unsigned* bar; unsigned x; volatile LAS unsigned* st; };
__device__ __forceinline__ XcdBarrier xcd_barrier_post(unsigned* bar, volatile LAS unsigned* st) {
    XcdBarrier b; b.bar = bar; b.x = xb_xcc_id(); b.st = st;
    if (threadIdx.x == 0) { (void)xb_add(&bar[XB_XCNT(b.x)], 1u);
        if (b.x != (blockIdx.x & 7u) || (gridDim.x & 7u) != 0u) atomicOr(&bar[XB_MAPBAD], 1u); }
    return b;
}
__device__ __forceinline__ void xcd_barrier_complete(unsigned* bar, unsigned x, unsigned& nloc, unsigned& nx) {
    const unsigned G = gridDim.x * gridDim.y * gridDim.z;
    unsigned sum, cnt, mine, sp = 0u;
    for (;;) {
        sum = 0u; cnt = 0u; mine = 0u;
#pragma unroll
        for (unsigned j = 0; j < 16; ++j) { const unsigned c = xb_ld(&bar[XB_XCNT(j)]); sum += c; cnt += (c > 0u) ? 1u : 0u; mine = (j == x) ? c : mine; }
        if (sum == G) break;
        __builtin_amdgcn_s_sleep(1);
        if ((++sp & 255u) == 0u) { if (xb_ld(&bar[XB_TMO])) break; if (sp > XB_SPIN_CAP) { atomicAdd(&bar[XB_TMO], 1u); break; } }
    }
    nloc = mine > 0u ? mine : 1u; nx = cnt > 0u ? cnt : 1u;
}
__device__ __forceinline__ void xcd_barrier(const XcdBarrier& b, int tid_, bool xcd_only) {
    asm volatile("s_waitcnt vmcnt(0)" ::: "memory");
    __syncthreads();
    if (tid_ == 0) {
        unsigned* bar = b.bar;
        __builtin_amdgcn_s_waitcnt(0);
        unsigned nloc = b.st[0], nx = b.st[1];
        if (nloc == 0u) { xcd_barrier_complete(bar, b.x, nloc, nx); b.st[0] = nloc; b.st[1] = nx; }
        const unsigned old = xb_add(&bar[XB_XSUB(b.x)], 1u);
        const unsigned gen = old / nloc;
        if (old + 1u == (gen + 1u) * nloc) {
            __builtin_amdgcn_fence(__ATOMIC_RELEASE, "agent");
            asm volatile("s_waitcnt vmcnt(0)" ::: "memory");
            if (!xcd_only) {
                const unsigned og = xb_add(&bar[XB_TOP], 1u);
                const unsigned tg = og / nx;
                if (og + 1u == (tg + 1u) * nx) xb_add(&bar[XB_TOPGEN], 1u);
                else XB_SPIN(xb_ld(&bar[XB_TOPGEN]) == tg, bar);
            }
            __builtin_amdgcn_fence(__ATOMIC_ACQUIRE, "agent");
            xb_add(&bar[XB_XGEN(b.x)], 1u);
            asm volatile("s_waitcnt vmcnt(0)" ::: "memory");
        } else {
            XB_SPIN(xb_ld(&bar[XB_XGEN(b.x)]) == gen, bar);
            __builtin_amdgcn_fence(__ATOMIC_ACQUIRE, "agent");
            asm volatile("s_waitcnt vmcnt(0)" ::: "memory");
        }
    }
    __syncthreads();
}

__device__ __forceinline__ float wave_sum(float v) {
#pragma unroll
    for (int o = 1; o < 64; o <<= 1) v += __shfl_xor(v, o);
    return v;
}
struct TrD { const float* src; const float* gain; bf16_t* dst; int ldw, ldt; };
__device__ __forceinline__ void tr_load(const TrD& d, f32x4 (&v)[8], float (&g)[8], int lane) {
    const int c4 = lane & 7, r0 = lane >> 3;
#pragma unroll
    for (int i = 0; i < 8; ++i) { const int row = 8 * i + r0; v[i] = *(const GAS f32x4*)((const GAS float*)d.src + (size_t)row * d.ldw + 4 * c4); g[i] = d.gain ? ((const GAS float*)d.gain)[row] : 1.0f; }
}
__device__ __forceinline__ void tr_store(const TrD& d, const f32x4 (&v)[8], const float (&g)[8], LAS float* scr, int lane) {
    const int c4 = lane & 7, r0 = lane >> 3;
#pragma unroll
    for (int i = 0; i < 8; ++i) { LAS float* s = scr + (8 * i + r0) * 33 + 4 * c4; s[0] = v[i][0] * g[i]; s[1] = v[i][1] * g[i]; s[2] = v[i][2] * g[i]; s[3] = v[i][3] * g[i]; }
    LDS_WAIT(); asm volatile("" ::: "memory");
    const int c = lane & 7;
#pragma unroll
    for (int j = 0; j < 4; ++j) { const int n = (lane >> 3) + 8 * j; const LAS float* s = scr + (8 * c) * 33 + n;
        u32x4 o; o.x = cvt_pk_bf16(s[0 * 33], s[1 * 33]); o.y = cvt_pk_bf16(s[2 * 33], s[3 * 33]); o.z = cvt_pk_bf16(s[4 * 33], s[5 * 33]); o.w = cvt_pk_bf16(s[6 * 33], s[7 * 33]);
        *(GAS u32x4*)((GAS bf16_t*)d.dst + (size_t)n * d.ldt + 8 * c) = o; }
    LDS_WAIT(); asm volatile("" ::: "memory");
}
constexpr int I_IN = (DM / 64) * (NIN / 32), I_P = (BW / 64) * (DM / 32), I_O = (DM / 64) * (DM / 32), I_G = (DM / 64) * (DFF / 32), I_D = (DFF / 64) * (DM / 32);
constexpr int NITEMS = I_IN + 3 * I_P + I_O + 2 * I_G + I_D;
struct Args { const float* in[14]; float* out; unsigned char* ws; };
__device__ __forceinline__ void tr_decode(int it, TrD& d, const Args& A, int layer, unsigned char* wb) {
    int r = it;
    if (r < I_IN) { const int nblk = NIN / 32, kb = r / nblk, c0 = 32 * (r % nblk); size_t doff;
        if (c0 < 3072) doff = (size_t)c0 * DM * 2;
        else if (c0 < 3584) doff = (size_t)(3072 + 256 * ((c0 - 3072) >> 7) + ((c0 - 3072) & 127)) * DM * 2;
        else if (c0 < 4096) doff = (size_t)(4096 + (c0 - 3584)) * DM * 2;
        else if (c0 < 4608) doff = (size_t)(3072 + 256 * ((c0 - 4096) >> 7) + 128 + ((c0 - 4096) & 127)) * DM * 2;
        else doff = (WS_WG - WS_WIN) + (size_t)(c0 - 4608) * DM * 2;
        d.src = A.in[2] + (size_t)layer * DM * NIN + (size_t)(64 * kb) * NIN + c0; d.gain = A.in[1] + (size_t)layer * DM + 64 * kb; d.dst = (bf16_t*)(wb + doff) + 64 * kb; d.ldw = NIN; d.ldt = DM; return; }
    r -= I_IN;
    if (r < I_P) { const int nblk = DM / 32, kb = r / nblk, c0 = 32 * (r % nblk);
        d.src = A.in[5] + (size_t)layer * BW * DM + (size_t)(64 * kb) * DM + c0; d.gain = nullptr; d.dst = (bf16_t*)(wb + (WS_WP - WS_WIN)) + (size_t)c0 * BW + 64 * kb; d.ldw = DM; d.ldt = BW; return; }
    r -= I_P;
    if (r < I_P) { const int nblk = DM / 32, kb = r / nblk, c0 = 32 * (r % nblk);
        d.src = A.in[6] + (size_t)layer * BW * DM + (size_t)(64 * kb) * DM + c0; d.gain = nullptr; d.dst = (bf16_t*)(wb + (WS_WP - WS_WIN)) + (size_t)DM * BW + (size_t)c0 * BW + 64 * kb; d.ldw = DM; d.ldt = BW; return; }
    r -= I_P;
    if (r < I_P) { const int nblk = DM / 32, kb = r / nblk, c0 = 32 * (r % nblk);
        d.src = A.in[7] + (size_t)layer * BW * DM + (size_t)(64 * kb) * DM + c0; d.gain = nullptr; d.dst = (bf16_t*)(wb + (WS_WP - WS_WIN)) + (size_t)2 * DM * BW + (size_t)c0 * BW + 64 * kb; d.ldw = DM; d.ldt = BW; return; }
    r -= I_P;
    if (r < I_O) { const int nblk = DM / 32, kb = r / nblk, c0 = 32 * (r % nblk);
        d.src = A.in[8] + (size_t)layer * DM * DM + (size_t)(64 * kb) * DM + c0; d.gain = nullptr; d.dst = (bf16_t*)(wb + (WS_WO - WS_WIN)) + (size_t)c0 * DM + 64 * kb; d.ldw = DM; d.ldt = DM; return; }
    r -= I_O;
    if (r < I_G) { const int nblk = DFF / 32, kb = r / nblk, c0 = 32 * (r % nblk);
        d.src = A.in[10] + (size_t)layer * DM * DFF + (size_t)(64 * kb) * DFF + c0; d.gain = A.in[9] + (size_t)layer * DM + 64 * kb; d.dst = (bf16_t*)(wb + (WS_WGU - WS_WIN)) + (size_t)(256 * (c0 >> 7) + (c0 & 127)) * DM + 64 * kb; d.ldw = DFF; d.ldt = DM; return; }
    r -= I_G;
    if (r < I_G) { const int nblk = DFF / 32, kb = r / nblk, c0 = 32 * (r % nblk);
        d.src = A.in[11] + (size_t)layer * DM * DFF + (size_t)(64 * kb) * DFF + c0; d.gain = A.in[9] + (size_t)layer * DM + 64 * kb; d.dst = (bf16_t*)(wb + (WS_WGU - WS_WIN)) + (size_t)(256 * (c0 >> 7) + 128 + (c0 & 127)) * DM + 64 * kb; d.ldw = DFF; d.ldt = DM; return; }
    r -= I_G;
    { const int nblk = DM / 32, kb = r / nblk, c0 = 32 * (r % nblk);
      d.src = A.in[12] + (size_t)layer * DFF * DM + (size_t)(64 * kb) * DM + c0; d.gain = nullptr; d.dst = (bf16_t*)(wb + (WS_WD - WS_WIN)) + (size_t)c0 * DFF + 64 * kb; d.ldw = DM; d.ldt = DFF; }
}


__global__ void __launch_bounds__(NWAVES * 64, 2) hybrid_fwd(Args args) {
    extern __shared__ __attribute__((aligned(16))) unsigned char lds_raw[];
    LAS unsigned char* lds = (LAS unsigned char*)lds_raw;
    volatile LAS unsigned* MISC = (volatile LAS unsigned*)(lds + MISC_OFF);
    const int wave = __builtin_amdgcn_readfirstlane((int)threadIdx.x >> 6);
    const int G = gridDim.x, bx = blockIdx.x, vcu = (G % 8 == 0) ? (bx % 8) * (G / 8) + bx / 8 : bx;
    for (int i = threadIdx.x; i < (LDS_BYTES - LDSCTL_OFF) / 4; i += NWAVES * 64) ((LAS unsigned*)(lds + LDSCTL_OFF))[i] = 0u;
    __syncthreads();
    XcdBarrier bar = xcd_barrier_post((unsigned*)(args.ws + WS_CTL) + CW_BAR, MISC + 8);
    const int gw = vcu * NWAVES + wave, NGW = G * NWAVES;
    bool mapok = false;

    for (int pq = 0; pq < DEPTH * 7 + 1; ++pq) {
        const int layer = pq / 7, ph = pq - 7 * layer;
        int tid = wave * 64 + lane_id(); asm volatile("" : "+v"(tid)); const int lane = tid & 63;
        size_t opq = 0; asm volatile("" : "+s"(opq));
        unsigned char* ws = args.ws + opq; const float* x_in = args.in[0] + opq; float* out = args.out + opq;
        float* ssA = (float*)(ws + WS_SSA); float* ssB = (float*)(ws + WS_SSB); float* kmp = (float*)(ws + WS_KM);
        bf16_t* xb = (bf16_t*)(ws + WS_XB);
        bf16_t* QA = (bf16_t*)(ws + WS_QA); bf16_t* KA = (bf16_t*)(ws + WS_KA); bf16_t* VA = (bf16_t*)(ws + WS_VA);
        bf16_t* QS = (bf16_t*)(ws + WS_QS); bf16_t* KS = (bf16_t*)(ws + WS_KS); bf16_t* VS = (bf16_t*)(ws + WS_VS);
        bf16_t* Ub = (bf16_t*)(ws + WS_U); bf16_t* BC = (bf16_t*)(ws + WS_BC); bf16_t* MG = (bf16_t*)(ws + WS_MG); bf16_t* ACT = (bf16_t*)(ws + WS_ACT);

        if (layer == DEPTH) {
            const float* gf = args.in[13];
            for (int m = gw; m < M; m += NGW) {
                const float rs = rstd_row(ssA, m);
                f32x4* xr = (f32x4*)(out + (size_t)m * DM) + lane; const f32x4* gr = (const f32x4*)gf + lane; const u32x2* xs = (const u32x2*)(xb + (size_t)m * DM) + lane;
#pragma unroll
                for (int j = 0; j < 4; ++j) { const u32x2 w = xs[64 * j]; const f32x4 v = {bf_lo(w.x), bf_hi(w.x), bf_lo(w.y), bf_hi(w.y)}, g = gr[64 * j]; xr[64 * j] = v * rs * g; }
            }
            if (xb_ld((unsigned*)(ws + WS_CTL) + CW_BAR + XB_TMO) != 0u && bx == 0) { for (int i = tid; i < 4096; i += NWAVES * 64) out[i] = __builtin_nanf(""); }
            break;
        }
        if (ph == 0) {
            LAS float* scr = (LAS float*)(lds + RING_OFF + wave * 16384);
            {
                constexpr int NIT2 = NITEMS; unsigned char* wb_ = layer == 0 ? ws + WS_WIN : (unsigned char*)out;
#define TR_DEC(i_, d_) tr_decode(i_, d_, args, layer, wb_)
                int it = gw;
                for (; it + NGW < NIT2; it += 2 * NGW) {
                    TrD da, db; f32x4 va[8], vb[8]; float ga[8], gb[8];
                    TR_DEC(it, da); tr_load(da, va, ga, lane);
                    TR_DEC(it + NGW, db); tr_load(db, vb, gb, lane);
                    tr_store(da, va, ga, scr, lane); tr_store(db, vb, gb, scr, lane);
                }
                if (it < NIT2) { TrD da; f32x4 va[8]; float ga[8]; TR_DEC(it, da); tr_load(da, va, ga, lane); tr_store(da, va, ga, scr, lane); }
#undef TR_DEC
            }
            if (layer == 0) {
                for (int m = gw; m < M; m += NGW) {
                    const f32x4* xr = (const f32x4*)(x_in + (size_t)m * DM) + lane; f32x4 v[4]; float s = 0.f;
#pragma unroll
                    for (int j = 0; j < 4; ++j) { v[j] = xr[64 * j]; s += (v[j].x * v[j].x + v[j].y * v[j].y) + (v[j].z * v[j].z + v[j].w * v[j].w); }
                    s = wave_sum(s);
                    u32x2* o8 = (u32x2*)(xb + (size_t)m * DM) + lane;
#pragma unroll
                    for (int j = 0; j < 4; ++j) o8[64 * j] = (u32x2){cvt_pk_bf16(v[j].x, v[j].y), cvt_pk_bf16(v[j].z, v[j].w)};
                    if (lane < 4) ssA[(size_t)m * 4 + lane] = (lane == 0) ? s : 0.f;
                }
            }
        } else if (ph == 2) {
            LAS unsigned char* vst = lds + RING_OFF + wave * 16384;
            LAS float* wsf = (LAS float*)(lds + ATT_OFF + wave * 512);
            LAS float* km = (LAS float*)(lds + ATT_OFF + 4096);
            LAS unsigned* selm = (LAS unsigned*)(lds + ATT_OFF + 12288);
            LAS unsigned* cnt = (LAS unsigned*)(lds + ATT_OFF + 13312);
            LAS float* kbn = (LAS float*)(lds + ATT_OFF + 13312 + 256);
            LAS unsigned* uslot = (LAS unsigned*)(lds + ATT_OFF + 13312 + 512);
            LAS unsigned char* lists = lds + ATT_OFF + 14336;
            LAS unsigned* trow = (LAS unsigned*)(lds + ATT_OFF + 22528 + wave * 128);
            unsigned char* recO = ws + WS_MG + (size_t)vcu * 131072; float* recML = (float*)(ws + WS_X + (size_t)vcu * 8192);
            unsigned* qbase = (unsigned*)(ws + WS_CTL) + 14336 + layer * 512;
            int xq = (int)(bar.x & 7u);
            float* kbmax = (float*)((unsigned*)(ws + WS_CTL) + 8192 + 4096 + layer * 512);
            for (;;) {
                if (wave == 0) {
                    unsigned got = 0xffffffffu;
                    if (lane == 0) { const unsigned u_ = __hip_atomic_fetch_add(qbase + xq * 64, 1u, __ATOMIC_RELAXED, __HIP_MEMORY_SCOPE_AGENT); if (u_ < 224u) got = (unsigned)xq * 256u + u_; }
                    got = (unsigned)__builtin_amdgcn_readfirstlane((int)got);
                    while (got == 0xffffffffu) {
                        const unsigned c_ = lane < 8 ? __hip_atomic_load(qbase + lane * 64, __ATOMIC_RELAXED, __HIP_MEMORY_SCOPE_AGENT) : 224u;
                        const unsigned mk = (unsigned)__ballot(c_ < 224u) & 0xffu;
                        if (mk == 0u) break;
                        const unsigned rot = ((mk >> xq) | (mk << (8 - xq))) & 0xffu;
                        const int j_ = (xq + __builtin_ctz(rot)) & 7;
                        if (lane == 0) { const unsigned u_ = __hip_atomic_fetch_add(qbase + j_ * 64, 1u, __ATOMIC_RELAXED, __HIP_MEMORY_SCOPE_AGENT); if (u_ < 224u) got = (unsigned)j_ * 256u + u_; }
                        got = (unsigned)__builtin_amdgcn_readfirstlane((int)got);
                        xq = j_;
                    }
                    if (lane == 0) *uslot = got;
                }
                __syncthreads();
                const unsigned uq_ = *uslot;
                __syncthreads();
                if (uq_ == 0xffffffffu) break;
                const int xu = (int)(uq_ >> 8), ul = (int)(uq_ & 255u);
                if (ul >= 192) { const unsigned ucv = (unsigned)(xu * 32 + (ul - 192));
                    const float* cw = args.in[4] + (size_t)layer * 3 * BW;
#pragma unroll 1
                    for (int k8 = 0; k8 < 8; ++k8) { const int i = (int)ucv * 4096 + k8 * (NWAVES * 64) + tid;
                        const int t = i >> 6, c = (i & 63) * 8; const int tt = t & (SEQ - 1);
                        const u32x4 u2 = *(const u32x4*)(Ub + (size_t)t * BW + c);
                        u32x4 u1 = {0u, 0u, 0u, 0u}, u0 = {0u, 0u, 0u, 0u};
                        if (tt >= 1) u1 = *(const u32x4*)(Ub + (size_t)(t - 1) * BW + c);
                        if (tt >= 2) u0 = *(const u32x4*)(Ub + (size_t)(t - 2) * BW + c);
                        const u32x4 bw = *(const u32x4*)(BC + (size_t)t * BW + c);
                        float y[8];
#pragma unroll
                        for (int e = 0; e < 4; ++e) {
                            const float w0l = cw[c + 2 * e], w0h = cw[c + 2 * e + 1], w1l = cw[BW + c + 2 * e], w1h = cw[BW + c + 2 * e + 1], w2l = cw[2 * BW + c + 2 * e], w2h = cw[2 * BW + c + 2 * e + 1];
                            y[2 * e] = bf_lo(bw[e]) * (w0l * bf_lo(u0[e]) + w1l * bf_lo(u1[e]) + w2l * bf_lo(u2[e]));
                            y[2 * e + 1] = bf_hi(bw[e]) * (w0h * bf_hi(u0[e]) + w1h * bf_hi(u1[e]) + w2h * bf_hi(u2[e]));
                        }
                        *(u32x4*)(BC + (size_t)t * BW + c) = (u32x4){cvt_pk_bf16(y[0], y[1]), cvt_pk_bf16(y[2], y[3]), cvt_pk_bf16(y[4], y[5]), cvt_pk_bf16(y[6], y[7])}; }
                    continue;
                }
                if (ul < 64) {
                    const int b = xu & 1, h = (ul >> 5) ? (xu >> 1) : 7 - (xu >> 1), bh = b * 8 + h, n = ul & 31;
                    const int key_ = n * 256 + (tid >> 1); const bf16_t* kp = KA + (size_t)(b * NH + h) * SEQ * HD + (size_t)(key_ >> 5) * 2048 + (tid & 1) * 1024 + (key_ & 31) * 8;
                    float sq = 0.f;
#pragma unroll
                    for (int c = 0; c < 4; ++c) { const u32x4 x = *(const u32x4*)(kp + c * 256); const float e0 = bf_lo(x.x), e1 = bf_hi(x.x), e2 = bf_lo(x.y), e3 = bf_hi(x.y), e4 = bf_lo(x.z), e5 = bf_hi(x.z), e6 = bf_lo(x.w), e7 = bf_hi(x.w);
                        sq += (e0 * e0 + e1 * e1) + (e2 * e2 + e3 * e3) + (e4 * e4 + e5 * e5) + (e6 * e6 + e7 * e7); }
                    sq += xshfl<1>(sq);
                    sq = __builtin_fmaxf(sq, xshfl<2>(sq)); sq = __builtin_fmaxf(sq, xshfl<4>(sq)); sq = __builtin_fmaxf(sq, xshfl<8>(sq)); sq = __builtin_fmaxf(sq, xshfl<16>(sq));
                    { float x1; const float x0 = att::swap_lo(sq, x1); sq = __builtin_fmaxf(x0, x1); }
                    if (lane == 0) kbn[wave] = sq;
                    __syncthreads();
                    if (tid == 0) { float m_ = kbn[0];
#pragma unroll
                        for (int w_ = 1; w_ < NWAVES; ++w_) m_ = __builtin_fmaxf(m_, kbn[w_]);
                        __hip_atomic_store((unsigned*)kbmax + bh * 32 + n, __float_as_uint(m_) | 1u, __ATOMIC_RELAXED, __HIP_MEMORY_SCOPE_AGENT); }
                    __syncthreads();
                } else if (ul < 128) {
                    const int b = xu & 1, h = ((ul - 64) >> 5) ? (xu >> 1) : 7 - (xu >> 1), blk = 31 - (ul & 31);
                    unsigned kb_ = 1u; if (tid < 32) kb_ = __hip_atomic_load((unsigned*)kbmax + (b * 8 + h) * 32 + tid, __ATOMIC_RELAXED, __HIP_MEMORY_SCOPE_AGENT);
                    const size_t qrow = (size_t)b * SEQ + blk * 256 + wave * 32;
                    bf16x8 gq[4], gk[4]; att::gate_load(gq, gk, QA + qrow * BW + h * HD, KA + (size_t)(b * NH + h) * SEQ * HD, blk * 256 + wave * 32, lane);
                    for (int i = tid; i < 2048; i += NWAVES * 64) { const int n = i >> 6, d = i & 63; const size_t o = (size_t)((b * 32 + n) * 2) * BW + h * HD + d; km[n * 64 + ((((d >> 2) ^ (n & 15)) << 2) | (d & 3))] = kmp[o] + kmp[o + BW]; }
                    if (tid < 32) {
                        unsigned sp_ = 0; while (kb_ == 0u) { __builtin_amdgcn_s_sleep(2); kb_ = __hip_atomic_load((unsigned*)kbmax + (b * 8 + h) * 32 + tid, __ATOMIC_RELAXED, __HIP_MEMORY_SCOPE_AGENT);
                            if (++sp_ > (1u << 20)) { atomicAdd((unsigned*)(ws + WS_CTL) + CW_BAR + XB_TMO, 1u); break; } }
                        kbn[tid] = sqrtf(__uint_as_float(kb_)) * 1.01f; }
                    __syncthreads();
                    const float sl2 = __builtin_amdgcn_exp2f(-(float)(h + 1)) * LOG2E;
                    const unsigned sel = att::moba_gate(gq, gk, blk, blk * 256 + wave * 32, sl2, km, kbn, lane);
                    if (lane < 32) selm[wave * 32 + lane] = sel;
                    __syncthreads();
                    for (int n = wave; n < blk; n += NWAVES) {
                        unsigned pos = 0;
#pragma unroll
                        for (int c = 0; c < 4; ++c) { const int q = 64 * c + lane; const bool bit = (selm[q] >> n) & 1u; const unsigned long long mk = __ballot(bit);
                            if (bit) lists[n * 256 + pos + __builtin_amdgcn_mbcnt_hi((unsigned)(mk >> 32), __builtin_amdgcn_mbcnt_lo((unsigned)mk, 0u))] = (unsigned char)q;
                            pos += (unsigned)__builtin_popcountll(mk); }
                        if (lane == 0) cnt[n] = pos;
                    }
                    __syncthreads();
                    { int n = blk, t = wave; int nn = 0, tt = 0, idp = 0;
                      for (;;) {
                          att::moba_item(QA, KA, VA, b, h, blk, n, t, lists, cnt, selm, recO, recML, vst, wsf, trow, lane);
                          bool found = false;
                          while (nn < blk) { const int nt_ = ((int)cnt[nn] + 31) >> 5;
                              if (tt < nt_) { const bool mine = (idp & (NWAVES - 1)) == wave; if (mine) { n = nn; t = tt; found = true; } ++tt; ++idp; if (mine) break; }
                              else { ++nn; tt = 0; } }
                          if (!found) break;
                      } }
                    VM_WAIT();
                    __syncthreads();
                    att::moba_merge(QA, b, h, blk, wave, selm, recO, recML, wsf, lane);
                    __syncthreads();
                } else {
                    const int b = xu & 1, h = (xu >> 1) * 2 + ((ul - 128) >> 5), blk = ul & 31;
                    att::sb_item(QS, KS, VS, b, h, blk * 256 + wave * 32, vst, lane);
                }
            }
        } else {
            static_assert(WS_QS - WS_QA == 48 * MiB && WS_BC - WS_QS == 48 * MiB && WS_VA - WS_KA == 16 * MiB && WS_KS - WS_KA == 48 * MiB, "O_a / O_s / O_c 48 MiB apart; gate scratch = K_a | V_a | K_s");
            GCfg c{};
            c.ws = ws; c.wb = layer == 0 ? ws + WS_WIN : (unsigned char*)out; c.bgate = args.in[3] + (size_t)layer * NGATE; c.red = (LAS float*)(lds + LDSCTL_OFF + 1024);
            c.nseg = 1; c.lda = DM; c.ldb = DM; c.nt = DM / 64; c.toA = 0;
            if (ph == 1) { c.mode = 0; c.N = N1; c.A = xb; c.B = (const bf16_t*)c.wb; }
            else if (ph == 3) { c.mode = 1; c.N = DM; c.nseg = 6; c.A = xb; c.B = (const bf16_t*)(c.wb + (WS_WG - WS_WIN)); }
            else if (ph == 4) { c.mode = 2; c.N = DM; c.A = MG; c.B = (const bf16_t*)(c.wb + (WS_WO - WS_WIN)); }
            else if (ph == 5) { c.mode = 3; c.N = NGU; c.A = xb; c.B = (const bf16_t*)(c.wb + (WS_WGU - WS_WIN)); }
            else { c.mode = 2; c.N = DM; c.A = ACT; c.B = (const bf16_t*)(c.wb + (WS_WD - WS_WIN)); c.lda = DFF; c.ldb = DFF; c.nt = DFF / 64; c.toA = 1; }
            ProbAny P{&c}; EpiAny E{&c}; pg8::StaticOrder S; S.init(M, c.N, G, bx, c.nseg);
            pg8::gemm_phase(lds + RING_OFF, P, S, E, wave);
        }
        if (!(ph == 6 && layer + 1 < DEPTH)) xcd_barrier(bar, tid, mapok && (ph == 3 || ph == 5));
        if (pq == 0) { if (tid == 0) MISC[12] = xb_ld((unsigned*)(ws + WS_CTL) + CW_BAR + XB_MAPBAD); __syncthreads(); mapok = (MISC[12] == 0u); }
    }
}

extern "C" void kernel_launch(void* const* d_in, const int* in_sizes, int n_in, void* d_out, int out_size, void* d_ws, size_t ws_size, hipStream_t stream) {
    static int grid = 0;
    if (grid == 0) {
        if (n_in != 14 || in_sizes[0] != M * DM || out_size != M * DM || ws_size < WS_END) { fprintf(stderr, "kernel_launch: unexpected shapes (n_in %d, in0 %d, out %d, ws %zu)\n", n_in, n_in > 0 ? in_sizes[0] : -1, out_size, ws_size); grid = -1; return; }
        int dev = 0, cus = 0, per_cu = 0;
        if (hipGetDevice(&dev) != hipSuccess || hipDeviceGetAttribute(&cus, hipDeviceAttributeMultiprocessorCount, dev) != hipSuccess) { grid = -1; return; }
        if (hipFuncSetAttribute((const void*)hybrid_fwd, hipFuncAttributeMaxDynamicSharedMemorySize, LDS_BYTES) != hipSuccess) { fprintf(stderr, "kernel_launch: hipFuncSetAttribute failed\n"); grid = -1; return; }
        if (hipOccupancyMaxActiveBlocksPerMultiprocessor(&per_cu, (const void*)hybrid_fwd, NWAVES * 64, LDS_BYTES) != hipSuccess || per_cu < 1) { fprintf(stderr, "kernel_launch: occupancy query says %d blocks/CU\n", per_cu); (void)hipGetLastError(); per_cu = 1; }
        grid = cus;
    }
    if (grid < 0) return;
    if (hipMemsetAsync((char*)d_ws + WS_CTL, 0, CTL_ZERO_BYTES, stream) != hipSuccess) { fprintf(stderr, "kernel_launch: memset failed\n"); return; }
    Args a{};
    for (int i = 0; i < 14; ++i) a.in[i] = (const float*)d_in[i];
    a.out = (float*)d_out; a.ws = (unsigned char*)d_ws;
    void* kargs[] = {&a};
    hipError_t e = hipLaunchCooperativeKernel((const void*)hybrid_fwd, dim3(grid), dim3(NWAVES * 64), kargs, LDS_BYTES, stream);
    if (e != hipSuccess) fprintf(stderr, "kernel_launch: cooperative launch failed: %s (grid %d)\n", hipGetErrorString(e), grid);
}
```

```cpp
#include <hip/hip_runtime.h>
#include <hip/hip_bf16.h>
#include <cstdio>
#include <cstdint>

#define GAS __attribute__((address_space(1)))
#define LAS __attribute__((address_space(3)))
typedef unsigned short bf16_t;
typedef short bf16x8 __attribute__((ext_vector_type(8)));
typedef short s16x4 __attribute__((ext_vector_type(4)));
typedef float f32x2 __attribute__((ext_vector_type(2)));
typedef float f32x4 __attribute__((ext_vector_type(4)));
typedef float f32x16 __attribute__((ext_vector_type(16)));
typedef unsigned u32x2 __attribute__((ext_vector_type(2)));
typedef unsigned u32x4 __attribute__((ext_vector_type(4)));
typedef GAS unsigned gu32;

constexpr int BATCH = 2, SEQ = 8192, DM = 1024, M = BATCH * SEQ, NH = 8, HD = 64, BW = 512, DFF = 2816, DEPTH = 2;
constexpr int NIN = 7680, N1 = 4608, NGATE = 3072, NGU = 2 * DFF;
constexpr float RMS_EPS = 1e-6f;
constexpr float LOG2E = 1.4426950408889634f;
constexpr float C2 = 0.125f * LOG2E;
constexpr int NWAVES = 8;

constexpr size_t MiB = 1u << 20;
constexpr size_t WS_CTL = 0, CTL_ZERO_BYTES = 64 * 1024;
constexpr size_t WS_SSA = 1 * MiB, WS_SSB = 2 * MiB, WS_KM = 3 * MiB;
constexpr size_t WS_WIN = 4 * MiB, WS_WG = 13 * MiB, WS_WP = 19 * MiB, WS_WO = 22 * MiB, WS_WGU = 24 * MiB, WS_WD = 35 * MiB;
constexpr size_t WS_XB = 41 * MiB;
constexpr size_t WS_QA = 73 * MiB, WS_KA = 89 * MiB, WS_VA = 105 * MiB, WS_QS = 121 * MiB, WS_KS = 137 * MiB, WS_VS = 153 * MiB;
constexpr size_t WS_BC = 169 * MiB, WS_U = 185 * MiB, WS_MG = 201 * MiB, WS_X = 233 * MiB;
constexpr size_t WS_ACT = 73 * MiB;
__device__ __forceinline__ size_t act_tile_off(int pm) { return WS_ACT + (size_t)(pm & 7) * (16 * MiB) + (size_t)(pm >> 3) * (2 * MiB); }
constexpr size_t WS_END = 256 * MiB;
constexpr int CW_BAR = 4096;

constexpr int RING_OFF = 0, RING_BYTES = 131072;
constexpr int ATT_OFF = RING_BYTES, ATT_BYTES = 23552;
constexpr int LDSCTL_OFF = ATT_OFF + ATT_BYTES, MISC_OFF = LDSCTL_OFF + 320;
constexpr int LDS_BYTES = 163840;
static_assert(LDSCTL_OFF + 1024 + 4096 <= LDS_BYTES, "LDS map");

#define LDS_WAIT() asm volatile("s_waitcnt lgkmcnt(0)" ::: "memory")
#define VM_WAIT() asm volatile("s_waitcnt vmcnt(0)" ::: "memory")
#define RLX_AGENT __ATOMIC_RELAXED, __HIP_MEMORY_SCOPE_AGENT

typedef __bf16 bf16x2_t __attribute__((ext_vector_type(2)));
__device__ __forceinline__ unsigned cvt_pk_bf16(float lo, float hi) { const f32x2 v = {lo, hi}; const bf16x2_t b = __builtin_convertvector(v, bf16x2_t); return __builtin_bit_cast(unsigned, b); }
template <int O> __device__ __forceinline__ float xshfl(float x) {
    static_assert(O < 32, "use sum32 for the two 32-lane halves");
    return __int_as_float(__builtin_amdgcn_ds_swizzle(__float_as_int(x), (O << 10) | 0x1f));
}
__device__ __forceinline__ int lane_id() { return (int)__builtin_amdgcn_mbcnt_hi(~0u, __builtin_amdgcn_mbcnt_lo(~0u, 0u)); }
__device__ __forceinline__ float sum32(float x) { auto rr = __builtin_amdgcn_permlane32_swap(__float_as_uint(x), __float_as_uint(x), false, false); return __uint_as_float(rr[0]) + __uint_as_float(rr[1]); }
__device__ __forceinline__ float bf_lo(unsigned w) { return __uint_as_float(w << 16); }
__device__ __forceinline__ float bf_hi(unsigned w) { return __uint_as_float(w & 0xffff0000u); }
__device__ __forceinline__ float rstd_row(const float* ssp, int row) {
    const f32x4 a = *(const f32x4*)(ssp + (size_t)row * 4);
    return rsqrtf(((a.x + a.y) + (a.z + a.w)) * (1.0f / DM) + RMS_EPS);
}

namespace pg8 {
constexpr int BM = 256, BK = 64, HALF = 128, HTB = HALF * BK * 2, STAGE_BYTES = 8 * HTB, NXCD = 8, WGM = 8;
__host__ __device__ __forceinline__ int lds_byte(int r, int c) { const int st = (r >> 4) * 2 + (c >> 5), rr = r & 15, cc = c & 31, ob = rr * 64 + cc * 2; return st * 1024 + (ob ^ (((ob >> 9) & 1) << 5)); }
__host__ __device__ __forceinline__ void stage_rc(int b, int& R, int& C) { const int st = b / 1024, sb = b % 1024, swz = sb ^ (((sb >> 9) & 1) << 5); R = (st >> 1) * 16 + swz / 64; C = (st & 1) * 32 + (swz % 64) / 2; }
__host__ __device__ __forceinline__ int perm32(int rho) { const int n = rho >> 4, i = rho & 15; return 8 * (i >> 2) + 4 * n + (i & 3); }

struct Unit { int pm, pn, seg; };
struct Seg { const char* A; const char* B; unsigned hA, hB; int lda, ldb, nt; };

struct StaticOrder {
    int nM, nN, nwg, G, c, nseg;
    __device__ void init(int M_, int N_, int G_, int c_, int nseg_) { nM = M_ / BM; nN = N_ / BM; nwg = nM * nN; G = G_; c = c_; nseg = nseg_; }
    __device__ bool next(int i, Unit& u) const {
        const int ti = (nseg == 1) ? i : i / nseg; u.seg = i - ti * nseg;
        const long L = (long)ti * G + c; if (L >= nwg) return false;
        int wgid = (int)L; { const int q = nwg / NXCD, r = nwg % NXCD, xcd = wgid % NXCD, off = wgid / NXCD; wgid = (xcd < r ? xcd * (q + 1) : r * (q + 1) + (xcd - r) * q) + off; }
        const int nig = WGM * nN, gid = wgid / nig, fm = gid * WGM, gsz = (nM - fm) < WGM ? (nM - fm) : WGM;
        u.pm = fm + ((wgid % nig) % gsz); u.pn = (wgid % nig) / gsz; return true;
    }
};

template <class Prob, class Epi, class Sched>
__device__ __forceinline__ void gemm_phase(LAS unsigned char* lds, const Prob& P, const Sched& S, const Epi& E, int wave_) {
    int tid = wave_ * 64 + lane_id(); asm volatile("" : "+v"(tid));
    const int wid = wave_, lane = tid & 63, wr = wid >> 2, wc = wid & 3, fr = lane & 15, fq = lane >> 4;
#define PG8_RC(R0, C0, Rb0) int R0, C0; { int t_ = tid; asm volatile("" : "+v"(t_)); stage_rc(t_ * 16, R0, C0); } const int Rb0 = (R0 & ~31) + perm32(R0 & 31)
    const size_t kstep = (size_t)(BK * 2);
    const unsigned ldsw = (unsigned)wid * 1024u;
    const int aoff = lds_byte(wr * 64 + fr, fq * 8), boff = lds_byte(wc * 32 + fr, fq * 8);
#define PG8_SA(b, h) (((b) * 2 + (h)) * HTB)
#define PG8_SB(b, h) ((4 + (b) * 2 + (h)) * HTB)
#define PG8_STAGE(bufoff, gbase, v0, q) do { \
        __builtin_amdgcn_global_load_lds((const unsigned*)((const char*)(gbase) + (v0)), (LAS unsigned*)(lds + (bufoff) + ldsw), 16, 0, 0); \
        __builtin_amdgcn_global_load_lds((const unsigned*)((const char*)(gbase) + (q) + (v0)), (LAS unsigned*)(lds + (bufoff) + ldsw + 8192), 16, 0, 0); } while (0)
#define PG8_LDA(dst, b, h) do { _Pragma("unroll") for (int m = 0; m < 4; ++m) _Pragma("unroll") for (int k = 0; k < 2; ++k) dst[m][k] = *(const LAS bf16x8*)(lds + PG8_SA(b, h) + aoff + m * 2048 + k * 1024); } while (0)
#define PG8_LDB(dst, b, h) do { _Pragma("unroll") for (int n = 0; n < 2; ++n) _Pragma("unroll") for (int k = 0; k < 2; ++k) dst[n][k] = *(const LAS bf16x8*)(lds + PG8_SB(b, h) + boff + n * 2048 + k * 1024); } while (0)
#define PG8_MMA(ai, bj, At, Bt) do { __builtin_amdgcn_s_setprio(1); _Pragma("unroll") for (int m = 0; m < 4; ++m) _Pragma("unroll") for (int n = 0; n < 2; ++n) _Pragma("unroll") for (int k = 0; k < 2; ++k) \
        acc[ai][bj][m][n] = __builtin_amdgcn_mfma_f32_16x16x32_bf16(Bt[n][k], At[m][k], acc[ai][bj][m][n], 0, 0, 0); __builtin_amdgcn_s_setprio(0); } while (0)
#define PG8_WAIT_V(n) asm volatile("s_waitcnt vmcnt(" #n ")" ::: "memory")
#define PG8_WAIT_L(n) asm volatile("s_waitcnt lgkmcnt(" #n ")" ::: "memory")
#define PG8_BAR __builtin_amdgcn_s_barrier()
#define PG8_SCHED __builtin_amdgcn_sched_barrier(0)
    Unit cur, nxt; int ui = 0;
    if (!S.next(0, cur)) return;
    Seg sc, sn; P.seg(cur, sc);
    unsigned vAc0, vBc0; { PG8_RC(R0, C0, Rb0); vAc0 = (unsigned)(R0 * sc.lda + C0) * 2u; vBc0 = (unsigned)(Rb0 * sc.ldb + C0) * 2u; }
    f32x4 acc[2][2][4][2];
#pragma unroll
    for (int a = 0; a < 2; ++a)
#pragma unroll
        for (int b = 0; b < 2; ++b)
#pragma unroll
            for (int m = 0; m < 4; ++m)
#pragma unroll
                for (int n = 0; n < 2; ++n) acc[a][b][m][n] = (f32x4){0.f, 0.f, 0.f, 0.f};
    bf16x8 At[4][2], B0[2][2], B1[2][2];
    const char* cA = sc.A; const char* cB = sc.B;
    PG8_STAGE(PG8_SB(0, 0), cB, vBc0, sc.hB >> 1); PG8_STAGE(PG8_SB(0, 1), cB + sc.hB, vBc0, sc.hB >> 1); PG8_STAGE(PG8_SA(0, 0), cA, vAc0, sc.hA >> 1); PG8_STAGE(PG8_SA(0, 1), cA + sc.hA, vAc0, sc.hA >> 1);
    if (wr == 1) PG8_BAR;
    PG8_WAIT_V(2); PG8_BAR;
    PG8_STAGE(PG8_SB(1, 0), cB + kstep, vBc0, sc.hB >> 1); PG8_STAGE(PG8_SA(1, 0), cA + kstep, vAc0, sc.hA >> 1); PG8_STAGE(PG8_SB(1, 1), cB + sc.hB + kstep, vBc0, sc.hB >> 1);
    PG8_WAIT_V(6); PG8_BAR;
    for (;;) {
        const bool has_next = S.next(ui + 1, nxt);
        if (has_next) P.seg(nxt, sn); else sn = sc;
        unsigned vAn0, vBn0; { PG8_RC(R0, C0, Rb0); vAn0 = (unsigned)(R0 * sn.lda + C0) * 2u; vBn0 = (unsigned)(Rb0 * sn.ldb + C0) * 2u; }
        const char* nA = sn.A; const char* nB = sn.B;
        const int nt = sc.nt;
        for (int t = 0; t < nt; t += 2) {
            const bool last = (t == nt - 2);
            const char* a1 = cA + (size_t)(t + 1) * kstep;
            const char* a2 = last ? nA : cA + (size_t)(t + 2) * kstep; const char* b2 = last ? nB : cB + (size_t)(t + 2) * kstep;
            const char* a3 = a2 + kstep; const char* b3 = b2 + kstep;
            const unsigned hA2 = last ? sn.hA : sc.hA, hB2 = last ? sn.hB : sc.hB;
            const unsigned vA0 = last ? vAn0 : vAc0, vB0 = last ? vBn0 : vBc0, qA = hA2 >> 1, qB = hB2 >> 1;
            PG8_LDB(B0, 0, 0); PG8_LDB(B1, 0, 1); PG8_SCHED; PG8_LDA(At, 0, 0); PG8_STAGE(PG8_SA(1, 1), a1 + sc.hA, vAc0, sc.hA >> 1);
            PG8_WAIT_V(8); PG8_WAIT_L(0); PG8_BAR; PG8_MMA(0, 0, At, B0); PG8_MMA(0, 1, At, B1); PG8_BAR; PG8_SCHED;
            PG8_LDA(At, 0, 1); PG8_STAGE(PG8_SB(0, 0), b2, vB0, qB); PG8_STAGE(PG8_SB(0, 1), b2 + hB2, vB0, qB); PG8_STAGE(PG8_SA(0, 0), a2, vA0, qA);
            PG8_WAIT_V(8); PG8_WAIT_L(0); PG8_BAR; PG8_MMA(1, 0, At, B0); PG8_MMA(1, 1, At, B1); PG8_BAR; PG8_SCHED;
            PG8_LDB(B0, 1, 0); PG8_LDB(B1, 1, 1); PG8_SCHED; PG8_LDA(At, 1, 0); PG8_STAGE(PG8_SA(0, 1), a2 + hA2, vA0, qA);
            PG8_WAIT_V(8); PG8_WAIT_L(0); PG8_BAR; PG8_MMA(0, 0, At, B0); PG8_MMA(0, 1, At, B1); PG8_BAR; PG8_SCHED;
            PG8_LDA(At, 1, 1); PG8_STAGE(PG8_SB(1, 0), b3, vB0, qB); PG8_STAGE(PG8_SB(1, 1), b3 + hB2, vB0, qB); PG8_STAGE(PG8_SA(1, 0), a3, vA0, qA);
            PG8_WAIT_V(8); PG8_WAIT_L(0); PG8_BAR; PG8_MMA(1, 0, At, B0); PG8_MMA(1, 1, At, B1); PG8_BAR; PG8_SCHED;
        }
        if (wr == 0) PG8_BAR;
        { int wr_ = wr, wc_ = wc, t_ = tid;
          asm volatile("" : "+s"(wr_), "+s"(wc_), "+v"(t_)); const int fr_ = t_ & 15, fq_ = (t_ >> 4) & 3;
          E(acc, cur, wr_, wc_, fr_, fq_); }
        if (!has_next) break;
#pragma unroll
        for (int a = 0; a < 2; ++a)
#pragma unroll
            for (int b = 0; b < 2; ++b)
#pragma unroll
                for (int m = 0; m < 4; ++m)
#pragma unroll
                    for (int n = 0; n < 2; ++n) acc[a][b][m][n] = (f32x4){0.f, 0.f, 0.f, 0.f};
        cur = nxt; sc = sn; cA = nA; cB = nB; vAc0 = vAn0; vBc0 = vBn0; ++ui;
        if (wr == 1) PG8_BAR;
    }
    PG8_WAIT_V(0);
    PG8_BAR;
#undef PG8_SA
#undef PG8_SB
#undef PG8_STAGE
#undef PG8_LDA
#undef PG8_LDB
#undef PG8_MMA
#undef PG8_WAIT_V
#undef PG8_WAIT_L
#undef PG8_BAR
#undef PG8_SCHED
#undef PG8_RC
}
}

#define EPI_ARGS const f32x4 (&acc)[2][2][4][2], const pg8::Unit& u, int wr, int wc, int fr, int fq
__device__ __forceinline__ void st_bf16x8(bf16_t* p, f32x4 v0, f32x4 v1) {
    u32x4 w; w.x = cvt_pk_bf16(v0[0], v0[1]); w.y = cvt_pk_bf16(v0[2], v0[3]); w.z = cvt_pk_bf16(v1[0], v1[1]); w.w = cvt_pk_bf16(v1[2], v1[3]);
#ifdef SC1_STORES
    asm volatile("global_store_dwordx4 %0, %1, off sc1\n\ts_nop 1" :: "v"(p), "v"(w) : "memory");
#else
    *(u32x4*)p = w;
#endif
}
template <class T> __device__ __forceinline__ T* bo(T* base, unsigned byte_off) { return (T*)((char*)base + byte_off); }
template <class T> __device__ __forceinline__ const T* bo(const T* base, unsigned byte_off) { return (const T*)((const char*)base + byte_off); }
__device__ __forceinline__ void ld_bf16x8(const bf16_t* p, f32x4& v0, f32x4& v1) {
    const unsigned long long lo = __hip_atomic_load((const unsigned long long*)p, __ATOMIC_RELAXED, __HIP_MEMORY_SCOPE_AGENT), hi = __hip_atomic_load((const unsigned long long*)p + 1, __ATOMIC_RELAXED, __HIP_MEMORY_SCOPE_AGENT);
    const u32x4 w = {(unsigned)lo, (unsigned)(lo >> 32), (unsigned)hi, (unsigned)(hi >> 32)};
    v0 = (f32x4){bf_lo(w.x), bf_hi(w.x), bf_lo(w.y), bf_hi(w.y)}; v1 = (f32x4){bf_lo(w.z), bf_hi(w.z), bf_lo(w.w), bf_hi(w.w)};
}
__device__ __forceinline__ float rstd4(f32x4 a) { return rsqrtf(((a.x + a.y) + (a.z + a.w)) * (1.0f / DM) + RMS_EPS); }
__device__ __forceinline__ void rstd8(float (&rs)[2][4], const float* ss, int pm, unsigned lrow) {
    const float* ssb = ss + (size_t)pm * 256 * 4; unsigned lsb = lrow * 16u; asm volatile("" : "+v"(lsb));
    f32x4 t[2][4];
#pragma unroll
    for (int ai = 0; ai < 2; ++ai)
#pragma unroll
        for (int m = 0; m < 4; ++m) t[ai][m] = *(const f32x4*)bo(ssb, lsb + (unsigned)(ai * 128 + m * 16) * 16u);
#pragma unroll
    for (int ai = 0; ai < 2; ++ai)
#pragma unroll
        for (int m = 0; m < 4; ++m) rs[ai][m] = rstd4(t[ai][m]);
}
struct EpiIn {
    unsigned char* ws;
    __device__ __forceinline__ void operator()(EPI_ARGS) const {
        bf16_t* qkv = (bf16_t*)(ws + WS_QA); bf16_t* ub = (bf16_t*)(ws + WS_U); bf16_t* bc = (bf16_t*)(ws + WS_BC); float* kmp = (float*)(ws + WS_KM); const float* ss = (const float*)(ws + WS_SSA);
        const int pn = u.pn; unsigned lrow = (unsigned)(wr * 64 + fr), lcol = (unsigned)(wc * 32 + 8 * fq);
        asm volatile("" : "+v"(lrow), "+v"(lcol));
        const unsigned lb = (lrow * BW + lcol) * 2u;
        float rs[2][4]; rstd8(rs, ss, u.pm, lrow);
        if (pn < 12 || pn >= 16) {
            const int t = pn >> 1; const float sc = (t == 0 || t == 3) ? C2 : 1.0f;
            bf16_t* base = (pn < 12 ? qkv + (size_t)t * M * BW + (pn & 1) * 256 : bc + (pn - 16) * 256) + (size_t)u.pm * 256 * BW;
            if (t == 1) {
                float* kp = kmp + (size_t)(u.pm * 2 + wr) * BW + (pn & 1) * 256;
#pragma unroll
                for (int bj = 0; bj < 2; ++bj)
#pragma unroll
                    for (int n = 0; n < 2; ++n) { f32x4 s = {0.f, 0.f, 0.f, 0.f};
#pragma unroll
                        for (int ai = 0; ai < 2; ++ai)
#pragma unroll
                            for (int m = 0; m < 4; ++m) s += acc[ai][bj][m][n] * rs[ai][m];
#pragma unroll
                        for (int e = 0; e < 4; ++e) { s[e] += xshfl<1>(s[e]); s[e] += xshfl<2>(s[e]); s[e] += xshfl<4>(s[e]); s[e] += xshfl<8>(s[e]); }
                        if (fr == 0) *(f32x4*)bo(kp, (lcol + (unsigned)(bj * 128 + 4 * n)) * 4u) = s; }
            }
            if (t == 2 || t == 5) {
                bf16_t* vb = qkv + (size_t)t * M * BW + ((size_t)((u.pm >> 5) * 8 + (pn & 1) * 4) * SEQ + (size_t)(u.pm & 31) * 256) * HD;
                const unsigned fr_ = lrow & 15u, wr_ = lrow >> 6, hl = lcol >> 6, dd = lcol & 63u;
#pragma unroll
                for (int ai = 0; ai < 2; ++ai)
#pragma unroll
                    for (int m = 0; m < 4; ++m) { float f = rs[ai][m]; asm volatile("" : "+v"(f));
#pragma unroll
                        for (int bj = 0; bj < 2; ++bj) { const unsigned eo = (unsigned)(bj * 2 + hl) * (SEQ * HD) + ((wr_ + 2 * ai) * 4096 + ((dd >> 5) * 4 + m) * 512 + fr_ * 32 + (dd & 31u));
                            st_bf16x8(bo(vb, eo * 2u), acc[ai][bj][m][0] * f, acc[ai][bj][m][1] * f); } }
            } else if (t == 1 || t == 4) {
                bf16_t* kb = qkv + (size_t)t * M * BW + ((size_t)((u.pm >> 5) * 8 + (pn & 1) * 4) * SEQ + (size_t)(u.pm & 31) * 256) * HD;
                const unsigned fr_ = lrow & 15u, wr_ = lrow >> 6, hl = lcol >> 6, dch = (lcol & 63u) >> 3;
#pragma unroll
                for (int ai = 0; ai < 2; ++ai)
#pragma unroll
                    for (int m = 0; m < 4; ++m) { float f = rs[ai][m]; asm volatile("" : "+v"(f));
#pragma unroll
                        for (int bj = 0; bj < 2; ++bj) { const unsigned eo = (unsigned)(bj * 2 + hl) * (SEQ * HD) + (((wr_ * 2 + ai * 4 + (m >> 1)) * 8 + dch) * 256 + (fr_ + 16u * (m & 1)) * 8);
                            st_bf16x8(bo(kb, eo * 2u), acc[ai][bj][m][0] * f, acc[ai][bj][m][1] * f); } }
            } else {
#pragma unroll
            for (int ai = 0; ai < 2; ++ai)
#pragma unroll
                for (int m = 0; m < 4; ++m) { const float f = rs[ai][m] * sc; const unsigned o = lb + (unsigned)(ai * 128 + m * 16) * BW * 2u;
#pragma unroll
                    for (int bj = 0; bj < 2; ++bj) st_bf16x8(bo(base, o + bj * 256u), acc[ai][bj][m][0] * f, acc[ai][bj][m][1] * f); }
            }
        } else {
            bf16_t* base = ub + (size_t)u.pm * 256 * BW + (pn - 12) * 128;
#pragma unroll
            for (int ai = 0; ai < 2; ++ai)
#pragma unroll
                for (int m = 0; m < 4; ++m) { const float f = rs[ai][m] * rs[ai][m];
                    st_bf16x8(bo(base, lb + (unsigned)(ai * 128 + m * 16) * BW * 2u), acc[ai][0][m][0] * acc[ai][1][m][0] * f, acc[ai][0][m][1] * acc[ai][1][m][1] * f); }
        }
    }
};
struct EpiC1 {
    unsigned char* ws; const float* bgate;
    __device__ __forceinline__ unsigned char* gtile(int s, int pm, int pn) const { return ws + WS_KA + (size_t)(s + (s >> 1)) * (16 * MiB) + (size_t)(pm * 4 + pn) * 65536; }
    __device__ __forceinline__ void operator()(EPI_ARGS) const {
        bf16_t* mg = (bf16_t*)(ws + WS_MG); const float* ss = (const float*)(ws + WS_SSA);
        const int sg = u.seg; unsigned lrow = (unsigned)(wr * 64 + fr), lcol = (unsigned)(wc * 32 + 8 * fq);
        asm volatile("" : "+v"(lrow), "+v"(lcol));
        const unsigned lb = (lrow * DM + lcol) * 2u, lg = (unsigned)((wr * 4 + wc) * 8 * 1024 + (fq * 16 + fr) * 16);
        unsigned char* gp = gtile(sg < 3 ? sg : sg - 3, u.pm, u.pn);
        if (sg < 3) {
            const float* bg = bgate + sg * DM + u.pn * 256;
            f32x4 bv[2][2];
#pragma unroll
            for (int bj = 0; bj < 2; ++bj) { bv[bj][0] = *(const f32x4*)bo(bg, (lcol + bj * 128u) * 4u) * (-LOG2E); bv[bj][1] = *(const f32x4*)bo(bg, (lcol + bj * 128u + 4u) * 4u) * (-LOG2E); }
            float rs[2][4]; rstd8(rs, ss, u.pm, lrow);
#pragma unroll
            for (int ai = 0; ai < 2; ++ai)
#pragma unroll
                for (int m = 0; m < 4; ++m) { const float rn = rs[ai][m] * (-LOG2E); u32x4 w;
#pragma unroll
                    for (int bj = 0; bj < 2; ++bj)
#pragma unroll
                        for (int n = 0; n < 2; ++n) { const f32x4 x = acc[ai][bj][m][n] * rn + bv[bj][n];
                            unsigned q[4];
#pragma unroll
                            for (int e = 0; e < 4; ++e) q[e] = (unsigned)(__builtin_amdgcn_rcpf(1.0f + __builtin_amdgcn_exp2f(x[e])) * 255.0f + 0.5f);
                            w[bj * 2 + n] = q[0] | (q[1] << 8) | (q[2] << 16) | (q[3] << 24); }
                    *(u32x4*)bo(gp, lg + (unsigned)((ai * 4 + m) * 1024)) = w; }
        } else {
            bf16_t* mp = mg + (size_t)u.pm * 256 * DM + u.pn * 256;
#pragma unroll
            for (int ai = 0; ai < 2; ++ai) {
                u32x4 gw_[4], pw_[4][2];
#pragma unroll
                for (int mm = 0; mm < 4; ++mm) { gw_[mm] = *(const u32x4*)bo((const unsigned char*)gp, lg + (unsigned)((ai * 4 + mm) * 1024));
#pragma unroll
                    for (int bj = 0; bj < 2; ++bj) if (sg > 3) pw_[mm][bj] = *(const u32x4*)bo((const bf16_t*)mp, lb + (unsigned)(ai * 128 + mm * 16) * DM * 2u + bj * 256u); }
#pragma unroll
                for (int mm = 0; mm < 4; ++mm)
#pragma unroll
                    for (int bj = 0; bj < 2; ++bj) { const unsigned o = lb + (unsigned)(ai * 128 + mm * 16) * DM * 2u + bj * 256u; const unsigned g0 = gw_[mm][bj * 2], g1 = gw_[mm][bj * 2 + 1]; constexpr float s = 1.0f / 255.0f;
                        f32x4 v0 = acc[ai][bj][mm][0] * ((f32x4){(float)(g0 & 255u), (float)((g0 >> 8) & 255u), (float)((g0 >> 16) & 255u), (float)(g0 >> 24)} * s);
                        f32x4 v1 = acc[ai][bj][mm][1] * ((f32x4){(float)(g1 & 255u), (float)((g1 >> 8) & 255u), (float)((g1 >> 16) & 255u), (float)(g1 >> 24)} * s);
                        if (sg > 3) { const u32x4 p = pw_[mm][bj]; v0 += (f32x4){bf_lo(p.x), bf_hi(p.x), bf_lo(p.y), bf_hi(p.y)}; v1 += (f32x4){bf_lo(p.z), bf_hi(p.z), bf_lo(p.w), bf_hi(p.w)}; }
                        st_bf16x8(bo(mp, o), v0, v1); }
                asm volatile("" ::: "memory");
            }
        }
    }
};
struct EpiRes {
    unsigned char* ws; int toA; LAS float* red;
    __device__ __forceinline__ void operator()(EPI_ARGS) const {
        bf16_t* xb = (bf16_t*)(ws + WS_XB); float* sso = (float*)(ws + (toA ? WS_SSA : WS_SSB));
        unsigned lrow = (unsigned)(wr * 64 + fr), lcol = (unsigned)(wc * 32 + 8 * fq);
        asm volatile("" : "+v"(lrow), "+v"(lcol));
        const unsigned le = (lrow * DM + lcol) * 2u, lr4 = lrow * 4u + (unsigned)wc;
        bf16_t* xp = xb + (size_t)u.pm * 256 * DM + u.pn * 256;
#pragma unroll
        for (int ai = 0; ai < 2; ++ai) {
            u32x4 bs[4][2];
#pragma unroll
            for (int m = 0; m < 4; ++m)
#pragma unroll
                for (int bj = 0; bj < 2; ++bj) bs[m][bj] = *(const u32x4*)bo((const bf16_t*)xp, le + (unsigned)(ai * 128 + m * 16) * DM * 2u + bj * 256u);
#pragma unroll
            for (int m = 0; m < 4; ++m) { float sq = 0.f;
#pragma unroll
                for (int bj = 0; bj < 2; ++bj) { const u32x4 w = bs[m][bj];
                    const f32x4 x0 = (f32x4){bf_lo(w.x), bf_hi(w.x), bf_lo(w.y), bf_hi(w.y)} + acc[ai][bj][m][0], x1 = (f32x4){bf_lo(w.z), bf_hi(w.z), bf_lo(w.w), bf_hi(w.w)} + acc[ai][bj][m][1];
                    st_bf16x8(bo(xp, le + (unsigned)(ai * 128 + m * 16) * DM * 2u + bj * 256u), x0, x1);
                    sq += (x0[0] * x0[0] + x0[1] * x0[1]) + (x0[2] * x0[2] + x0[3] * x0[3]) + (x1[0] * x1[0] + x1[1] * x1[1]) + (x1[2] * x1[2] + x1[3] * x1[3]); }
                sq += xshfl<16>(sq); sq = sum32(sq);
                if (fq == 0) red[lr4 + (unsigned)(ai * 128 + m * 16) * 4u] = sq; }
            asm volatile("" ::: "memory");
        }
        asm volatile("s_waitcnt lgkmcnt(0)\n\ts_barrier" ::: "memory");
        { const int t = ((wr * 4 + wc) * 4 + fq) * 16 + fr; if (t < 256) { const f32x4 r = *(const LAS f32x4*)(red + t * 4); sso[((size_t)u.pm * 256 + t) * 4 + u.pn] = (r.x + r.y) + (r.z + r.w); } }
        asm volatile("s_waitcnt lgkmcnt(0)\n\ts_barrier" ::: "memory");
    }
};
struct EpiFfn {
    unsigned char* ws;
    __device__ __forceinline__ void operator()(EPI_ARGS) const {
        const float* ss = (const float*)(ws + WS_SSB);
        unsigned lrow = (unsigned)(wr * 64 + fr), lcol = (unsigned)(wc * 32 + 8 * fq);
        asm volatile("" : "+v"(lrow), "+v"(lcol));
        const unsigned lb = (lrow * DFF + lcol) * 2u;
        bf16_t* ap = (bf16_t*)(ws + act_tile_off(u.pm)) + u.pn * 128;
        float rs[2][4]; rstd8(rs, ss, u.pm, lrow);
#pragma unroll
        for (int ai = 0; ai < 2; ++ai)
#pragma unroll
            for (int m = 0; m < 4; ++m) { const float r1 = rs[ai][m], rn = r1 * (-LOG2E); f32x4 v[2];
#pragma unroll
                for (int n = 0; n < 2; ++n) { const f32x4 g = acc[ai][0][m][n], up = acc[ai][1][m][n] * (r1 * r1);
#pragma unroll
                    for (int e = 0; e < 4; ++e) v[n][e] = g[e] * up[e] * __builtin_amdgcn_rcpf(1.0f + __builtin_amdgcn_exp2f(g[e] * rn)); }
                st_bf16x8(bo(ap, lb + (unsigned)(ai * 128 + m * 16) * DFF * 2u), v[0], v[1]); }
    }
};

struct GCfg {
    int mode;
    int N, nseg, lda, ldb, nt, toA;
    const bf16_t* A; const bf16_t* B;
    unsigned char* ws; unsigned char* wb; const float* bgate; LAS float* red;
};
struct ProbAny {
    const GCfg* c;
    __device__ __forceinline__ void seg(const pg8::Unit& u, pg8::Seg& s) const {
        if (c->mode == 1 && u.seg >= 3) {
            const int br = u.seg - 3; const bf16_t* O = (const bf16_t*)(c->ws + WS_QA + (size_t)br * (48 * MiB)); const bf16_t* Wp = (const bf16_t*)(c->wb + (WS_WP - WS_WIN));
            s.A = (const char*)(O + (size_t)u.pm * 256 * BW); s.B = (const char*)(Wp + ((size_t)br * DM + (size_t)u.pn * 256) * BW);
            s.hA = 128u * BW * 2u; s.hB = 128u * BW * 2u; s.lda = BW; s.ldb = BW; s.nt = BW / 64;
        } else {
            const int so = (c->mode == 1) ? u.seg * DM : 0;
            s.A = (c->mode == 2 && c->toA) ? (const char*)(c->ws + act_tile_off(u.pm)) : (const char*)(c->A + (size_t)u.pm * 256 * c->lda); s.B = (const char*)(c->B + ((size_t)so + (size_t)u.pn * 256) * c->ldb);
            s.hA = 128u * (unsigned)c->lda * 2u; s.hB = 128u * (unsigned)c->ldb * 2u; s.lda = c->lda; s.ldb = c->ldb; s.nt = c->nt;
        }
    }
};
struct EpiAny {
    const GCfg* c;
    __device__ __forceinline__ void operator()(EPI_ARGS) const {
        const int m_ = c->mode;
        if (m_ == 0) EpiIn{c->ws}(acc, u, wr, wc, fr, fq);
        else if (m_ == 1) EpiC1{c->ws, c->bgate}(acc, u, wr, wc, fr, fq);
        else if (m_ == 2) EpiRes{c->ws, c->toA, c->red}(acc, u, wr, wc, fr, fq);
        else EpiFfn{c->ws}(acc, u, wr, wc, fr, fq);
    }
};

namespace att {
__device__ __forceinline__ constexpr int crow(int r, int hi) { return (r & 3) + 8 * (r >> 2) + 4 * hi; }
__device__ __forceinline__ float swap_lo(float x, float& hiv) { auto rr = __builtin_amdgcn_permlane32_swap(__float_as_uint(x), __float_as_uint(x), false, false); hiv = __uint_as_float(rr[1]); return __uint_as_float(rr[0]); }
__device__ __forceinline__ s16x4 vtr(const LAS unsigned char* p) { return __builtin_bit_cast(s16x4, __builtin_amdgcn_ds_read_tr16_b64_v4i16((LAS s16x4*)p)); }
__device__ __forceinline__ void load_k(bf16x8 (&kf)[8], const bf16_t* Kh, int j0, int r32, int hi) {
    const bf16_t* p = Kh + (size_t)(j0 >> 5) * 2048 + hi * 256 + r32 * 8;
#pragma unroll
    for (int d0 = 0; d0 < 4; ++d0) { kf[2 * d0] = *(const bf16x8*)(p + d0 * 512); kf[2 * d0 + 1] = *(const bf16x8*)(p + 2048 + d0 * 512); }
}
__device__ __forceinline__ void dma_v(LAS unsigned char* vbuf, const bf16_t* Vh, int j0, int lane) {
    const bf16_t* p = Vh + (size_t)(j0 >> 6) * 4096 + lane * 8;
#pragma unroll
    for (int i = 0; i < 8; ++i) __builtin_amdgcn_global_load_lds((const unsigned*)(p + i * 512), (LAS unsigned*)(vbuf + i * 1024), 16, 0, 0);
}
__device__ __forceinline__ void load_v(u32x4 (&vv)[8], const bf16_t* Vh, int j0, int lane) {
    const bf16_t* p = Vh + (size_t)(j0 + (lane >> 3)) * BW + (lane & 7) * 8;
#pragma unroll
    for (int i = 0; i < 8; ++i) vv[i] = *(const u32x4*)(p + (size_t)(8 * i) * BW);
}
__device__ __forceinline__ void stage_v(LAS unsigned char* vst, const u32x4 (&vv)[8], int lane) {
    const int c = lane & 7;
#pragma unroll
    for (int i = 0; i < 8; ++i) { const int key = 8 * i + (lane >> 3);
        *(LAS u32x4*)(vst + ((c >> 2) * 4 + (key >> 4)) * 1024 + (key & 15) * 64 + (c & 3) * 16) = vv[i]; }
}
__device__ __forceinline__ void qk(f32x16& p0, f32x16& p1, const bf16x8 (&kf)[8], const bf16x8 (&qr)[4]) {
#pragma unroll
    for (int d0 = 0; d0 < 4; ++d0) { p0 = __builtin_amdgcn_mfma_f32_32x32x16_bf16(kf[2 * d0], qr[d0], p0, 0, 0, 0); p1 = __builtin_amdgcn_mfma_f32_32x32x16_bf16(kf[2 * d0 + 1], qr[d0], p1, 0, 0, 0); }
}
__device__ __forceinline__ void pv(f32x16& o0, f32x16& o1, const f32x16& p0, const f32x16& p1, const LAS unsigned char* vst, int lane) {
    const int hi = lane >> 5;
    const LAS unsigned char* vp = vst + ((lane >> 4) & 1) * 32 + (lane & 3) * 8 + (4 * hi + ((lane & 15) >> 2)) * 64;
    u32x4 pw[4];
    pw[0] = (u32x4){cvt_pk_bf16(p0[0], p0[1]), cvt_pk_bf16(p0[2], p0[3]), cvt_pk_bf16(p0[4], p0[5]), cvt_pk_bf16(p0[6], p0[7])};
    pw[1] = (u32x4){cvt_pk_bf16(p0[8], p0[9]), cvt_pk_bf16(p0[10], p0[11]), cvt_pk_bf16(p0[12], p0[13]), cvt_pk_bf16(p0[14], p0[15])};
    pw[2] = (u32x4){cvt_pk_bf16(p1[0], p1[1]), cvt_pk_bf16(p1[2], p1[3]), cvt_pk_bf16(p1[4], p1[5]), cvt_pk_bf16(p1[6], p1[7])};
    pw[3] = (u32x4){cvt_pk_bf16(p1[8], p1[9]), cvt_pk_bf16(p1[10], p1[11]), cvt_pk_bf16(p1[12], p1[13]), cvt_pk_bf16(p1[14], p1[15])};
#pragma unroll
    for (int ks = 0; ks < 4; ++ks) {
        const s16x4 a0 = vtr(vp + ks * 1024), a1 = vtr(vp + ks * 1024 + 512), b0 = vtr(vp + 4096 + ks * 1024), b1 = vtr(vp + 4096 + ks * 1024 + 512);
        const bf16x8 v0 = {a0[0], a0[1], a0[2], a0[3], a1[0], a1[1], a1[2], a1[3]}, v1 = {b0[0], b0[1], b0[2], b0[3], b1[0], b1[1], b1[2], b1[3]};
        const bf16x8 pa = __builtin_bit_cast(bf16x8, pw[ks]);
        o0 = __builtin_amdgcn_mfma_f32_32x32x16_bf16(pa, v0, o0, 0, 0, 0);
        o1 = __builtin_amdgcn_mfma_f32_32x32x16_bf16(pa, v1, o1, 0, 0, 0);
    }
}
__device__ __forceinline__ void store_o(bf16_t* Ow, const f32x16& o0, const f32x16& o1, const float (&rsc)[16], LAS unsigned char* stg, int lane) {
    const int r32 = lane & 31, hi = lane >> 5;
    LAS bf16_t* s = (LAS bf16_t*)stg;
#pragma unroll
    for (int r = 0; r < 16; ++r) { const int orow = crow(r, hi);
        s[orow * 64 + r32] = (bf16_t)(cvt_pk_bf16(o0[r] * rsc[r], 0.f) & 0xffffu); s[orow * 64 + 32 + r32] = (bf16_t)(cvt_pk_bf16(o1[r] * rsc[r], 0.f) & 0xffffu); }
    LDS_WAIT();
#pragma unroll
    for (int i = 0; i < 4; ++i) { const int row = i * 8 + (lane >> 3), ch = lane & 7; const u32x4 v = *(const LAS u32x4*)(stg + row * 128 + ch * 16); *(u32x4*)(Ow + (size_t)row * BW + ch * 8) = v; }
    LDS_WAIT();
}

__device__ __forceinline__ void sb_item(bf16_t* Q, const bf16_t* K, const bf16_t* V, int b, int h, int q0, LAS unsigned char* vst, int lane) {
    asm volatile("" : "+v"(lane));
    const int r32 = lane & 31, hi = lane >> 5;
    const size_t rowbase = (size_t)b * SEQ;
    bf16_t* Qw = Q + (rowbase + q0) * BW + h * HD;
    bf16x8 qr[4];
#pragma unroll
    for (int d0 = 0; d0 < 4; ++d0) qr[d0] = *(const bf16x8*)(Qw + (size_t)r32 * BW + d0 * 16 + hi * 8);
    const bf16_t* Kh = K + (size_t)(b * NH + h) * SEQ * HD; const bf16_t* Vh = V + (size_t)(b * NH + h) * SEQ * HD;
    f32x16 o0 = {}, o1 = {}; float A2 = 0.f;
    const int tq = q0 + r32;
    bf16x8 kf[8]; load_k(kf, Kh, ((q0 + 30) >> 6) * 64, r32, hi); dma_v(vst + (((q0 + 30) >> 6) & 1) * 8192, Vh, ((q0 + 30) >> 6) * 64, lane);
    for (int kt = (q0 + 30) >> 6; kt >= 0; --kt) {
        const int j0 = kt * 64;
        f32x16 p0 = {}, p1 = {};
        qk(p0, p1, kf, qr);
        asm volatile("" : "+v"(p0), "+v"(p1) :: "memory");
        LAS unsigned char* vcur = vst + (kt & 1) * 8192;
        if (kt > 0) { dma_v(vst + ((kt - 1) & 1) * 8192, Vh, j0 - 64, lane); load_k(kf, Kh, j0 - 64, r32, hi); }
        const bool diag = (j0 + 63 >= q0);
        f32x16 l0, l1;
#pragma unroll
        for (int r = 0; r < 16; ++r) {
            { const float z = p0[r]; const float t = __builtin_amdgcn_exp2f(-__builtin_fabsf(z)); float l = -(__builtin_fmaxf(z, 0.f) + __builtin_amdgcn_logf(1.0f + t)); if (diag && (j0 + crow(r, hi) >= tq)) l = 0.f; l0[r] = l; }
            { const float z = p1[r]; const float t = __builtin_amdgcn_exp2f(-__builtin_fabsf(z)); float l = -(__builtin_fmaxf(z, 0.f) + __builtin_amdgcn_logf(1.0f + t)); if (diag && (j0 + 32 + crow(r, hi) >= tq)) l = 0.f; l1[r] = l; }
        }
        float carry = A2;
#pragma unroll
        for (int half = 1; half >= 0; --half) {
            f32x16& l = half ? l1 : l0; f32x16& p = half ? p1 : p0;
            float T[4];
#pragma unroll
            for (int g = 0; g < 4; ++g) { l[4 * g + 2] += l[4 * g + 3]; l[4 * g + 1] += l[4 * g + 2]; l[4 * g] += l[4 * g + 1]; T[g] = l[4 * g]; }
            float Tl[4], Th[4];
#pragma unroll
            for (int g = 0; g < 4; ++g) Tl[g] = swap_lo(T[g], Th[g]);
            float E = carry;
#pragma unroll
            for (int g = 3; g >= 0; --g) { const float eh = E; E += Th[g]; const float el = E; E += Tl[g]; const float off = hi ? eh : el;
                l[4 * g] += off; l[4 * g + 1] += off; l[4 * g + 2] += off; l[4 * g + 3] += off; }
            carry = E;
#pragma unroll
            for (int r = 0; r < 16; ++r) { float w = __builtin_amdgcn_exp2f(p[r] + l[r]); if (diag && (j0 + 32 * half + crow(r, hi) >= tq)) w = 0.f; p[r] = w; }
        }
        A2 = carry;
        if (kt > 0) asm volatile("s_waitcnt vmcnt(16)" ::: "memory"); else asm volatile("s_waitcnt vmcnt(0)" ::: "memory");
        pv(o0, o1, p0, p1, vcur, lane);
        LDS_WAIT();
        if (__all(A2 < -150.2f)) break;
    }
    float one[16];
#pragma unroll
    for (int r = 0; r < 16; ++r) one[r] = 1.0f;
    store_o(Qw, o0, o1, one, vst, lane);
}

constexpr float MOBA_THR = 8.0f;
__device__ __forceinline__ void gate_load(bf16x8 (&qr)[4], bf16x8 (&kr)[4], const bf16_t* Qw, const bf16_t* Kown, int tq0, int lane) {
    asm volatile("" : "+v"(lane));
    const int r32 = lane & 31, hi = lane >> 5;
    const bf16_t* Qrow = Qw + (size_t)r32 * BW + hi * 8;
    const int tk = tq0 + r32; const bf16_t* kp = Kown + (size_t)(tk >> 5) * 2048 + hi * 256 + (tk & 31) * 8;
#pragma unroll
    for (int d0 = 0; d0 < 4; ++d0) { qr[d0] = *(const bf16x8*)(Qrow + d0 * 16); kr[d0] = *(const bf16x8*)(kp + d0 * 512); }
}
__device__ __forceinline__ unsigned moba_gate(const bf16x8 (&qr)[4], const bf16x8 (&kr)[4], int blk, int tq0, float sl2, const LAS float* km, const LAS float* kbn, int lane) {
    asm volatile("" : "+v"(lane));
    const int r32 = lane & 31, hi = lane >> 5;
    unsigned sel = 0u;
    if (blk > 0) {
        f32x16 p = {};
#pragma unroll
        for (int d0 = 0; d0 < 4; ++d0) { const LAS f32x4* kmr = (const LAS f32x4*)(km + r32 * 64); const int c0 = d0 * 4 + hi * 2; const f32x4 a = kmr[c0 ^ (r32 & 15)], c = kmr[(c0 + 1) ^ (r32 & 15)];
            const u32x4 h = {cvt_pk_bf16(a[0], a[1]), cvt_pk_bf16(a[2], a[3]), cvt_pk_bf16(c[0], c[1]), cvt_pk_bf16(c[2], c[3])};
            const u32x4 l = {cvt_pk_bf16(a[0] - bf_lo(h.x), a[1] - bf_hi(h.x)), cvt_pk_bf16(a[2] - bf_lo(h.y), a[3] - bf_hi(h.y)), cvt_pk_bf16(c[0] - bf_lo(h.z), c[1] - bf_hi(h.z)), cvt_pk_bf16(c[2] - bf_lo(h.w), c[3] - bf_hi(h.w))};
            p = __builtin_amdgcn_mfma_f32_32x32x16_bf16(__builtin_bit_cast(bf16x8, l), qr[d0], p, 0, 0, 0);
            p = __builtin_amdgcn_mfma_f32_32x32x16_bf16(__builtin_bit_cast(bf16x8, h), qr[d0], p, 0, 0, 0); }
        float v1 = -INFINITY, v2 = -INFINITY, v3 = -INFINITY; int i1 = -1, i2 = -1, i3 = -1;
#define TOP_INS(v, n) do { const bool b1 = (v) > v1 || ((v) == v1 && (n) < i1), b2 = (v) > v2 || ((v) == v2 && (n) < i2), b3 = (v) > v3 || ((v) == v3 && (n) < i3); \
            if (b3) { if (b2) { v3 = v2; i3 = i2; if (b1) { v2 = v1; i2 = i1; v1 = (v); i1 = (n); } else { v2 = (v); i2 = (n); } } else { v3 = (v); i3 = (n); } } } while (0)
#pragma unroll
        for (int r = 0; r < 16; ++r) { const int n = crow(r, 0) + 4 * hi; const float d = p[r]; if (n < blk) TOP_INS(d, n); }
        { float x0, x1; x0 = swap_lo(v1, x1); const float pv1 = hi ? x0 : x1; x0 = swap_lo(v2, x1); const float pv2 = hi ? x0 : x1; x0 = swap_lo(v3, x1); const float pv3 = hi ? x0 : x1;
          x0 = swap_lo(__int_as_float(i1), x1); const int pi1 = __float_as_int(hi ? x0 : x1); x0 = swap_lo(__int_as_float(i2), x1); const int pi2 = __float_as_int(hi ? x0 : x1); x0 = swap_lo(__int_as_float(i3), x1); const int pi3 = __float_as_int(hi ? x0 : x1);
          TOP_INS(pv1, pi1); TOP_INS(pv2, pi2); TOP_INS(pv3, pi3); }
#undef TOP_INS
        float qn2 = 0.f, zs = 0.f;
#pragma unroll
        for (int d0 = 0; d0 < 4; ++d0) { const u32x4 q = __builtin_bit_cast(u32x4, qr[d0]), x = __builtin_bit_cast(u32x4, kr[d0]);
            const float q0 = bf_lo(q.x), q1 = bf_hi(q.x), q2 = bf_lo(q.y), q3 = bf_hi(q.y), q4 = bf_lo(q.z), q5 = bf_hi(q.z), q6 = bf_lo(q.w), q7 = bf_hi(q.w);
            zs += q0 * bf_lo(x.x) + q1 * bf_hi(x.x) + q2 * bf_lo(x.y) + q3 * bf_hi(x.y) + q4 * bf_lo(x.z) + q5 * bf_hi(x.z) + q6 * bf_lo(x.w) + q7 * bf_hi(x.w);
            qn2 += (q0 * q0 + q1 * q1) + (q2 * q2 + q3 * q3) + (q4 * q4 + q5 * q5) + (q6 * q6 + q7 * q7); }
        { float x1; float x0 = swap_lo(zs, x1); zs = x0 + x1; x0 = swap_lo(qn2, x1); qn2 = x0 + x1; }
        const float qn = sqrtf(qn2) * 1.001f, thr = zs - 151.0f; const int tq = tq0 + r32;
#define KEEP(i_) ((i_) >= 0 && !(qn * kbn[(i_)] - sl2 * (float)(tq - (256 * (i_) + 255)) < thr))
        if (KEEP(i1)) sel |= 1u << i1; if (KEEP(i2)) sel |= 1u << i2; if (KEEP(i3)) sel |= 1u << i3;
#undef KEEP
    }
    return sel;
}
__device__ __forceinline__ void moba_tile(f32x16& o0, f32x16& o1, float& mrow, float& lsum, const bf16x8 (&qr)[4], bf16x8 (&kf)[8], const bf16_t* Kh, const bf16_t* Vh, int j0, int jn, float lb, float sl2, bool diag, int tq,
                                          LAS unsigned char* vst, LAS float* wsf, int lane, const float (&bv)[16]) {
    const int r32 = lane & 31, hi = lane >> 5;
    const float mref = (mrow == -INFINITY) ? 0.f : mrow; const float i0 = lb - mref, i1 = i0 + 32.0f * sl2;
    f32x16 p0, p1;
#pragma unroll
    for (int r = 0; r < 16; ++r) { p0[r] = i0 + bv[r]; p1[r] = i1 + bv[r]; }
    qk(p0, p1, kf, qr);
    asm volatile("" : "+v"(p0), "+v"(p1) :: "memory");
    LAS unsigned char* vcur = vst + ((j0 >> 6) & 1) * 8192;
    if (jn >= 0) { dma_v(vst + ((jn >> 6) & 1) * 8192, Vh, jn, lane); load_k(kf, Kh, jn, r32, hi); }
    if (diag) {
#pragma unroll
        for (int r = 0; r < 16; ++r) { if (j0 + crow(r, hi) > tq) p0[r] = -INFINITY; if (j0 + 32 + crow(r, hi) > tq) p1[r] = -INFINITY; }
    }
    float rm = __builtin_fmaxf(p0[0], p1[0]);
#pragma unroll
    for (int r = 1; r < 16; ++r) rm = __builtin_fmaxf(rm, __builtin_fmaxf(p0[r], p1[r]));
    { float x1; const float x0 = swap_lo(rm, x1); rm = __builtin_fmaxf(x0, x1); }
    rm += mref;
    if (__any(rm > mrow + MOBA_THR)) {
        const float mn = __builtin_fmaxf(mrow, rm); const float f = __builtin_amdgcn_exp2f(mrow - mn), dsh = mn - mref; mrow = mn; lsum *= f;
        if (hi == 0) wsf[r32] = f;
        LDS_WAIT();
#pragma unroll
        for (int r = 0; r < 16; ++r) { const float fr_ = wsf[crow(r, hi)]; o0[r] *= fr_; o1[r] *= fr_; p0[r] -= dsh; p1[r] -= dsh; }
        LDS_WAIT();
    }
    float ps = 0.f;
#pragma unroll
    for (int r = 0; r < 16; ++r) { p0[r] = __builtin_amdgcn_exp2f(p0[r]); p1[r] = __builtin_amdgcn_exp2f(p1[r]); ps += p0[r] + p1[r]; }
    lsum += ps;
    if (jn >= 0) asm volatile("s_waitcnt vmcnt(16)" ::: "memory"); else asm volatile("s_waitcnt vmcnt(0)" ::: "memory");
    pv(o0, o1, p0, p1, vcur, lane);
    LDS_WAIT();
}
__device__ __forceinline__ void moba_item(const bf16_t* Q, const bf16_t* K, const bf16_t* V, int b, int h, int blk, int n, int tix, const LAS unsigned char* lists, const LAS unsigned* cnt,
                                          const LAS unsigned* selm, unsigned char* recO, float* recML, LAS unsigned char* vst, LAS float* wsf, LAS unsigned* trow, int lane) {
    asm volatile("" : "+v"(lane));
    const int r32 = lane & 31, hi = lane >> 5; const size_t rowbase = (size_t)b * SEQ; const bool own = (n == blk);
    int q; bool valid; unsigned slot;
    if (own) { q = 32 * tix + r32; valid = true; slot = (unsigned)q * 4u + 3u; }
    else { const int cn = (int)cnt[n]; const int p = 32 * tix + r32; valid = p < cn; q = (int)lists[n * 256 + (valid ? p : cn - 1)];
           slot = (unsigned)q * 4u + (unsigned)__builtin_popcount(selm[q] & ((1u << n) - 1u)); }
    if (hi == 0) trow[r32] = slot | (valid ? 0x80000000u : 0u);
    const int tq = blk * 256 + q;
    const bf16_t* Qrow = Q + (rowbase + tq) * BW + h * HD + hi * 8;
    bf16x8 qr[4];
#pragma unroll
    for (int d0 = 0; d0 < 4; ++d0) qr[d0] = *(const bf16x8*)(Qrow + d0 * 16);
    const bf16_t* Kh = K + (size_t)(b * NH + h) * SEQ * HD; const bf16_t* Vh = V + (size_t)(b * NH + h) * SEQ * HD;
    const float sl2 = __builtin_amdgcn_exp2f(-(float)(h + 1)) * LOG2E;
    f32x16 o0 = {}, o1 = {}; float mrow = -INFINITY, lsum = 0.f;
    float bv[16];
#pragma unroll
    for (int r = 0; r < 16; ++r) bv[r] = sl2 * (float)crow(r, 0);
    const int ntile = own ? (tix >> 1) + 1 : 4;
    bf16x8 kf[8]; load_k(kf, Kh, n * 256, r32, hi); dma_v(vst + ((n * 4) & 1) * 8192, Vh, n * 256, lane);
#pragma unroll 1
    for (int i = 0; i < ntile; ++i) { const int j0 = n * 256 + i * 64;
        moba_tile(o0, o1, mrow, lsum, qr, kf, Kh, Vh, j0, i < ntile - 1 ? j0 + 64 : -1, sl2 * (float)(j0 + 4 * hi - tq), sl2, own && i == ntile - 1, tq, vst, wsf, lane, bv); }
    { float x1; const float x0 = swap_lo(lsum, x1); lsum = x0 + x1; }
    if (hi == 0) { wsf[32 + r32] = lsum; if (valid) *(f32x2*)(recML + 2 * slot) = (f32x2){mrow, lsum}; }
    LDS_WAIT();
    LAS bf16_t* s = (LAS bf16_t*)vst;
#pragma unroll
    for (int r = 0; r < 16; ++r) { const int orow = crow(r, hi); const float rl = __builtin_amdgcn_rcpf(wsf[32 + orow]);
        s[orow * 64 + r32] = (bf16_t)(cvt_pk_bf16(o0[r] * rl, 0.f) & 0xffffu); s[orow * 64 + 32 + r32] = (bf16_t)(cvt_pk_bf16(o1[r] * rl, 0.f) & 0xffffu); }
    LDS_WAIT();
#pragma unroll
    for (int i = 0; i < 4; ++i) { const int row = i * 8 + (lane >> 3), ch = lane & 7; const unsigned tr = trow[row]; const u32x4 v = *(const LAS u32x4*)(vst + row * 128 + ch * 16);
        if (tr & 0x80000000u) *(u32x4*)(recO + (size_t)(tr & 0x7fffffffu) * 128 + ch * 16) = v; }
    LDS_WAIT();
}
__device__ __forceinline__ void moba_merge(bf16_t* Q, int b, int h, int blk, int w, const LAS unsigned* selm, const unsigned char* recO, const float* recML, LAS float* wsf, int lane) {
    asm volatile("" : "+v"(lane));
    const int r32 = lane & 31, hi = lane >> 5; const size_t rowbase = (size_t)b * SEQ; const int q0 = blk * 256 + w * 32;
    const int ql = w * 32 + r32; const int c = __builtin_popcount(selm[ql]);
    f32x2 ml[4];
#pragma unroll
    for (int k = 0; k < 4; ++k) ml[k] = __builtin_nontemporal_load((const f32x2*)(recML + 2 * ((unsigned)ql * 4u + k)));
    u32x4 pw[4][4];
#pragma unroll
    for (int i = 0; i < 4; ++i)
#pragma unroll
        for (int k = 0; k < 4; ++k) pw[i][k] = __builtin_nontemporal_load((const u32x4*)(recO + (size_t)((unsigned)(w * 32 + i * 8 + (lane >> 3)) * 4u + k) * 128 + (lane & 7) * 16));
    float mi[4], li[4]; float mx = -INFINITY;
#pragma unroll
    for (int k = 0; k < 4; ++k) { const bool used = (k == 3 || k < c); mi[k] = used ? ml[k].x : -INFINITY; li[k] = used ? ml[k].y : 0.f; mx = __builtin_fmaxf(mx, mi[k]); }
    float wg[4], L = 0.f;
#pragma unroll
    for (int k = 0; k < 4; ++k) { wg[k] = (k == 3 || k < c) ? __builtin_amdgcn_exp2f(mi[k] - mx) * li[k] : 0.f; L += wg[k]; }
    const float rL = 1.0f / L;
    if (hi == 0) { wsf[r32] = wg[0] * rL; wsf[32 + r32] = wg[1] * rL; wsf[64 + r32] = wg[2] * rL; wsf[96 + r32] = wg[3] * rL; }
    LDS_WAIT();
    bf16_t* Qw = Q + (rowbase + q0) * BW + h * HD;
#pragma unroll
    for (int i = 0; i < 4; ++i) { const int row = i * 8 + (lane >> 3), ch = lane & 7; f32x4 v0 = {0.f, 0.f, 0.f, 0.f}, v1 = {0.f, 0.f, 0.f, 0.f};
#pragma unroll
        for (int k = 0; k < 4; ++k) { const float ak = wsf[32 * k + row];
            if (ak != 0.f) { const u32x4 p = pw[i][k];
                v0 += ak * (f32x4){bf_lo(p.x), bf_hi(p.x), bf_lo(p.y), bf_hi(p.y)}; v1 += ak * (f32x4){bf_lo(p.z), bf_hi(p.z), bf_lo(p.w), bf_hi(p.w)}; } }
        st_bf16x8(Qw + (size_t)row * BW + ch * 8, v0, v1); }
    LDS_WAIT();
}
}

#define XB_TMO      128
#define XB_MAPBAD   192
#define XB_XCNT(j)  (256  + 64 * (j))
#define XB_XSUB(j)  (1280 + 64 * (j))
#define XB_XGEN(j)  (2304 + 64 * (j))
#define XB_TOP      3328
#define XB_TOPGEN   3392
#define XCD_BAR_WORDS 3456
#define XB_SPIN_CAP (1u << 18)
__device__ __forceinline__ unsigned xb_ld(unsigned* p)              { return __hip_atomic_load(p, __ATOMIC_RELAXED, __HIP_MEMORY_SCOPE_AGENT); }
__device__ __forceinline__ unsigned xb_add(unsigned* p, unsigned v) { return __hip_atomic_fetch_add(p, v, __ATOMIC_RELAXED, __HIP_MEMORY_SCOPE_AGENT); }
__device__ __forceinline__ unsigned xb_xcc_id() { return (unsigned)__builtin_amdgcn_s_getreg((3 << 11) | 20) & 0xFu; }
#define XB_SPIN(cond, bar) do { unsigned _sp = 0; while (cond) { __builtin_amdgcn_s_sleep(1); \
    if ((++_sp & 255u) == 0u) { if (xb_ld(&(bar)[XB_TMO])) break; if (_sp > XB_SPIN_CAP) { atomicAdd(&(bar)[XB_TMO], 1u); break; } } } } while (0)
struct XcdBarrier { unsigned* bar; unsigned x; volatile LAS unsigned* st; };
__device__ __forceinline__ XcdBarrier xcd_barrier_post(unsigned* bar, volatile LAS unsigned* st) {
    XcdBarrier b; b.bar = bar; b.x = xb_xcc_id(); b.st = st;
    if (threadIdx.x == 0) { (void)xb_add(&bar[XB_XCNT(b.x)], 1u);
        if (b.x != (blockIdx.x & 7u) || (gridDim.x & 7u) != 0u) atomicOr(&bar[XB_MAPBAD], 1u); }
    return b;
}
__device__ __forceinline__ void xcd_barrier_complete(unsigned* bar, unsigned x, unsigned& nloc, unsigned& nx) {
    const unsigned G = gridDim.x * gridDim.y * gridDim.z;
    unsigned sum, cnt, mine, sp = 0u;
    for (;;) {
        sum = 0u; cnt = 0u; mine = 0u;
#pragma unroll
        for (unsigned j = 0; j < 16; ++j) { const unsigned c = xb_ld(&bar[XB_XCNT(j)]); sum += c; cnt += (c > 0u) ? 1u : 0u; mine = (j == x) ? c : mine; }
        if (sum == G) break;
        __builtin_amdgcn_s_sleep(1);
        if ((++sp & 255u) == 0u) { if (xb_ld(&bar[XB_TMO])) break; if (sp > XB_SPIN_CAP) { atomicAdd(&bar[XB_TMO], 1u); break; } }
    }
    nloc = mine > 0u ? mine : 1u; nx = cnt > 0u ? cnt : 1u;
}
__device__ __forceinline__ void xcd_barrier(const XcdBarrier& b, int tid_, bool xcd_only) {
    asm volatile("s_waitcnt vmcnt(0)" ::: "memory");
    __syncthreads();
    if (tid_ == 0) {
        unsigned* bar = b.bar;
        __builtin_amdgcn_s_waitcnt(0);
        unsigned nloc = b.st[0], nx = b.st[1];
        if (nloc == 0u) { xcd_barrier_complete(bar, b.x, nloc, nx); b.st[0] = nloc; b.st[1] = nx; }
        const unsigned old = xb_add(&bar[XB_XSUB(b.x)], 1u);
        const unsigned gen = old / nloc;
        if (old + 1u == (gen + 1u) * nloc) {
            __builtin_amdgcn_fence(__ATOMIC_RELEASE, "agent");
            asm volatile("s_waitcnt vmcnt(0)" ::: "memory");
            if (!xcd_only) {
                const unsigned og = xb_add(&bar[XB_TOP], 1u);
                const unsigned tg = og / nx;
                if (og + 1u == (tg + 1u) * nx) xb_add(&bar[XB_TOPGEN], 1u);
                else XB_SPIN(xb_ld(&bar[XB_TOPGEN]) == tg, bar);
            }
            __builtin_amdgcn_fence(__ATOMIC_ACQUIRE, "agent");
            xb_add(&bar[XB_XGEN(b.x)], 1u);
            asm volatile("s_waitcnt vmcnt(0)" ::: "memory");
        } else {
            XB_SPIN(xb_ld(&bar[XB_XGEN(b.x)]) == gen, bar);
            __builtin_amdgcn_fence(__ATOMIC_ACQUIRE, "agent");
            asm volatile("s_waitcnt vmcnt(0)" ::: "memory");
        }
    }
    __syncthreads();
}

__device__ __forceinline__ float wave_sum(float v) {
#pragma unroll
    for (int o = 1; o < 64; o <<= 1) v += __shfl_xor(v, o);
    return v;
}
struct TrD { const float* src; const float* gain; bf16_t* dst; int ldw, ldt; };
__device__ __forceinline__ void tr_load(const TrD& d, f32x4 (&v)[8], float (&g)[8], int lane) {
    const int c4 = lane & 7, r0 = lane >> 3;
#pragma unroll
    for (int i = 0; i < 8; ++i) { const int row = 8 * i + r0; v[i] = *(const GAS f32x4*)((const GAS float*)d.src + (size_t)row * d.ldw + 4 * c4); g[i] = d.gain ? ((const GAS float*)d.gain)[row] : 1.0f; }
}
__device__ __forceinline__ void tr_store(const TrD& d, const f32x4 (&v)[8], const float (&g)[8], LAS float* scr, int lane) {
    const int c4 = lane & 7, r0 = lane >> 3;
#pragma unroll
    for (int i = 0; i < 8; ++i) { LAS float* s = scr + (8 * i + r0) * 33 + 4 * c4; s[0] = v[i][0] * g[i]; s[1] = v[i][1] * g[i]; s[2] = v[i][2] * g[i]; s[3] = v[i][3] * g[i]; }
    LDS_WAIT(); asm volatile("" ::: "memory");
    const int c = lane & 7;
#pragma unroll
    for (int j = 0; j < 4; ++j) { const int n = (lane >> 3) + 8 * j; const LAS float* s = scr + (8 * c) * 33 + n;
        u32x4 o; o.x = cvt_pk_bf16(s[0 * 33], s[1 * 33]); o.y = cvt_pk_bf16(s[2 * 33], s[3 * 33]); o.z = cvt_pk_bf16(s[4 * 33], s[5 * 33]); o.w = cvt_pk_bf16(s[6 * 33], s[7 * 33]);
        *(GAS u32x4*)((GAS bf16_t*)d.dst + (size_t)n * d.ldt + 8 * c) = o; }
    LDS_WAIT(); asm volatile("" ::: "memory");
}
constexpr int I_IN = (DM / 64) * (NIN / 32), I_P = (BW / 64) * (DM / 32), I_O = (DM / 64) * (DM / 32), I_G = (DM / 64) * (DFF / 32), I_D = (DFF / 64) * (DM / 32);
constexpr int NITEMS = I_IN + 3 * I_P + I_O + 2 * I_G + I_D;
struct Args { const float* in[14]; float* out; unsigned char* ws; };
__device__ __forceinline__ void tr_decode(int it, TrD& d, const Args& A, int layer, unsigned char* wb) {
    int r = it;
    if (r < I_IN) { const int nblk = NIN / 32, kb = r / nblk, c0 = 32 * (r % nblk); size_t doff;
        if (c0 < 3072) doff = (size_t)c0 * DM * 2;
        else if (c0 < 3584) doff = (size_t)(3072 + 256 * ((c0 - 3072) >> 7) + ((c0 - 3072) & 127)) * DM * 2;
        else if (c0 < 4096) doff = (size_t)(4096 + (c0 - 3584)) * DM * 2;
        else if (c0 < 4608) doff = (size_t)(3072 + 256 * ((c0 - 4096) >> 7) + 128 + ((c0 - 4096) & 127)) * DM * 2;
        else doff = (WS_WG - WS_WIN) + (size_t)(c0 - 4608) * DM * 2;
        d.src = A.in[2] + (size_t)layer * DM * NIN + (size_t)(64 * kb) * NIN + c0; d.gain = A.in[1] + (size_t)layer * DM + 64 * kb; d.dst = (bf16_t*)(wb + doff) + 64 * kb; d.ldw = NIN; d.ldt = DM; return; }
    r -= I_IN;
    if (r < I_P) { const int nblk = DM / 32, kb = r / nblk, c0 = 32 * (r % nblk);
        d.src = A.in[5] + (size_t)layer * BW * DM + (size_t)(64 * kb) * DM + c0; d.gain = nullptr; d.dst = (bf16_t*)(wb + (WS_WP - WS_WIN)) + (size_t)c0 * BW + 64 * kb; d.ldw = DM; d.ldt = BW; return; }
    r -= I_P;
    if (r < I_P) { const int nblk = DM / 32, kb = r / nblk, c0 = 32 * (r % nblk);
        d.src = A.in[6] + (size_t)layer * BW * DM + (size_t)(64 * kb) * DM + c0; d.gain = nullptr; d.dst = (bf16_t*)(wb + (WS_WP - WS_WIN)) + (size_t)DM * BW + (size_t)c0 * BW + 64 * kb; d.ldw = DM; d.ldt = BW; return; }
    r -= I_P;
    if (r < I_P) { const int nblk = DM / 32, kb = r / nblk, c0 = 32 * (r % nblk);
        d.src = A.in[7] + (size_t)layer * BW * DM + (size_t)(64 * kb) * DM + c0; d.gain = nullptr; d.dst = (bf16_t*)(wb + (WS_WP - WS_WIN)) + (size_t)2 * DM * BW + (size_t)c0 * BW + 64 * kb; d.ldw = DM; d.ldt = BW; return; }
    r -= I_P;
    if (r < I_O) { const int nblk = DM / 32, kb = r / nblk, c0 = 32 * (r % nblk);
        d.src = A.in[8] + (size_t)layer * DM * DM + (size_t)(64 * kb) * DM + c0; d.gain = nullptr; d.dst = (bf16_t*)(wb + (WS_WO - WS_WIN)) + (size_t)c0 * DM + 64 * kb; d.ldw = DM; d.ldt = DM; return; }
    r -= I_O;
    if (r < I_G) { const int nblk = DFF / 32, kb = r / nblk, c0 = 32 * (r % nblk);
        d.src = A.in[10] + (size_t)layer * DM * DFF + (size_t)(64 * kb) * DFF + c0; d.gain = A.in[9] + (size_t)layer * DM + 64 * kb; d.dst = (bf16_t*)(wb + (WS_WGU - WS_WIN)) + (size_t)(256 * (c0 >> 7) + (c0 & 127)) * DM + 64 * kb; d.ldw = DFF; d.ldt = DM; return; }
    r -= I_G;
    if (r < I_G) { const int nblk = DFF / 32, kb = r / nblk, c0 = 32 * (r % nblk);
        d.src = A.in[11] + (size_t)layer * DM * DFF + (size_t)(64 * kb) * DFF + c0; d.gain = A.in[9] + (size_t)layer * DM + 64 * kb; d.dst = (bf16_t*)(wb + (WS_WGU - WS_WIN)) + (size_t)(256 * (c0 >> 7) + 128 + (c0 & 127)) * DM + 64 * kb; d.ldw = DFF; d.ldt = DM; return; }
    r -= I_G;
    { const int nblk = DM / 32, kb = r / nblk, c0 = 32 * (r % nblk);
      d.src = A.in[12] + (size_t)layer * DFF * DM + (size_t)(64 * kb) * DM + c0; d.gain = nullptr; d.dst = (bf16_t*)(wb + (WS_WD - WS_WIN)) + (size_t)c0 * DFF + 64 * kb; d.ldw = DM; d.ldt = DFF; }
}


__global__ void __launch_bounds__(NWAVES * 64, 2) hybrid_fwd(Args args) {
    extern __shared__ __attribute__((aligned(16))) unsigned char lds_raw[];
    LAS unsigned char* lds = (LAS unsigned char*)lds_raw;
    volatile LAS unsigned* MISC = (volatile LAS unsigned*)(lds + MISC_OFF);
    const int wave = __builtin_amdgcn_readfirstlane((int)threadIdx.x >> 6);
    const int G = gridDim.x, bx = blockIdx.x, vcu = (G % 8 == 0) ? (bx % 8) * (G / 8) + bx / 8 : bx;
    for (int i = threadIdx.x; i < (LDS_BYTES - LDSCTL_OFF) / 4; i += NWAVES * 64) ((LAS unsigned*)(lds + LDSCTL_OFF))[i] = 0u;
    __syncthreads();
    XcdBarrier bar = xcd_barrier_post((unsigned*)(args.ws + WS_CTL) + CW_BAR, MISC + 8);
    const int gw = vcu * NWAVES + wave, NGW = G * NWAVES;
    bool mapok = false;

    for (int pq = 0; pq < DEPTH * 7 + 1; ++pq) {
        const int layer = pq / 7, ph = pq - 7 * layer;
        int tid = wave * 64 + lane_id(); asm volatile("" : "+v"(tid)); const int lane = tid & 63;
        size_t opq = 0; asm volatile("" : "+s"(opq));
        unsigned char* ws = args.ws + opq; const float* x_in = args.in[0] + opq; float* out = args.out + opq;
        float* ssA = (float*)(ws + WS_SSA); float* ssB = (float*)(ws + WS_SSB); float* kmp = (float*)(ws + WS_KM);
        bf16_t* xb = (bf16_t*)(ws + WS_XB);
        bf16_t* QA = (bf16_t*)(ws + WS_QA); bf16_t* KA = (bf16_t*)(ws + WS_KA); bf16_t* VA = (bf16_t*)(ws + WS_VA);
        bf16_t* QS = (bf16_t*)(ws + WS_QS); bf16_t* KS = (bf16_t*)(ws + WS_KS); bf16_t* VS = (bf16_t*)(ws + WS_VS);
        bf16_t* Ub = (bf16_t*)(ws + WS_U); bf16_t* BC = (bf16_t*)(ws + WS_BC); bf16_t* MG = (bf16_t*)(ws + WS_MG); bf16_t* ACT = (bf16_t*)(ws + WS_ACT);

        if (layer == DEPTH) {
            const float* gf = args.in[13];
            for (int m = gw; m < M; m += NGW) {
                const float rs = rstd_row(ssA, m);
                f32x4* xr = (f32x4*)(out + (size_t)m * DM) + lane; const f32x4* gr = (const f32x4*)gf + lane; const u32x2* xs = (const u32x2*)(xb + (size_t)m * DM) + lane;
#pragma unroll
                for (int j = 0; j < 4; ++j) { const u32x2 w = xs[64 * j]; const f32x4 v = {bf_lo(w.x), bf_hi(w.x), bf_lo(w.y), bf_hi(w.y)}, g = gr[64 * j]; xr[64 * j] = v * rs * g; }
            }
            if (xb_ld((unsigned*)(ws + WS_CTL) + CW_BAR + XB_TMO) != 0u && bx == 0) { for (int i = tid; i < 4096; i += NWAVES * 64) out[i] = __builtin_nanf(""); }
            break;
        }
        if (ph == 0) {
            LAS float* scr = (LAS float*)(lds + RING_OFF + wave * 16384);
            {
                constexpr int NIT2 = NITEMS; unsigned char* wb_ = layer == 0 ? ws + WS_WIN : (unsigned char*)out;
#define TR_DEC(i_, d_) tr_decode(i_, d_, args, layer, wb_)
                int it = gw;
                for (; it + NGW < NIT2; it += 2 * NGW) {
                    TrD da, db; f32x4 va[8], vb[8]; float ga[8], gb[8];
                    TR_DEC(it, da); tr_load(da, va, ga, lane);
                    TR_DEC(it + NGW, db); tr_load(db, vb, gb, lane);
                    tr_store(da, va, ga, scr, lane); tr_store(db, vb, gb, scr, lane);
                }
                if (it < NIT2) { TrD da; f32x4 va[8]; float ga[8]; TR_DEC(it, da); tr_load(da, va, ga, lane); tr_store(da, va, ga, scr, lane); }
#undef TR_DEC
            }
            if (layer == 0) {
                for (int m = gw; m < M; m += NGW) {
                    const f32x4* xr = (const f32x4*)(x_in + (size_t)m * DM) + lane; f32x4 v[4]; float s = 0.f;
#pragma unroll
                    for (int j = 0; j < 4; ++j) { v[j] = xr[64 * j]; s += (v[j].x * v[j].x + v[j].y * v[j].y) + (v[j].z * v[j].z + v[j].w * v[j].w); }
                    s = wave_sum(s);
                    u32x2* o8 = (u32x2*)(xb + (size_t)m * DM) + lane;
#pragma unroll
                    for (int j = 0; j < 4; ++j) o8[64 * j] = (u32x2){cvt_pk_bf16(v[j].x, v[j].y), cvt_pk_bf16(v[j].z, v[j].w)};
                    if (lane < 4) ssA[(size_t)m * 4 + lane] = (lane == 0) ? s : 0.f;
                }
            }
        } else if (ph == 2) {
            LAS unsigned char* vst = lds + RING_OFF + wave * 16384;
            LAS float* wsf = (LAS float*)(lds + ATT_OFF + wave * 512);
            LAS float* km = (LAS float*)(lds + ATT_OFF + 4096);
            LAS unsigned* selm = (LAS unsigned*)(lds + ATT_OFF + 12288);
            LAS unsigned* cnt = (LAS unsigned*)(lds + ATT_OFF + 13312);
            LAS float* kbn = (LAS float*)(lds + ATT_OFF + 13312 + 256);
            LAS unsigned* uslot = (LAS unsigned*)(lds + ATT_OFF + 13312 + 512);
            LAS unsigned char* lists = lds + ATT_OFF + 14336;
            LAS unsigned* trow = (LAS unsigned*)(lds + ATT_OFF + 22528 + wave * 128);
            unsigned char* recO = ws + WS_MG + (size_t)vcu * 131072; float* recML = (float*)(ws + WS_X + (size_t)vcu * 8192);
            unsigned* qbase = (unsigned*)(ws + WS_CTL) + 14336 + layer * 512;
            int xq = (int)(bar.x & 7u);
            float* kbmax = (float*)((unsigned*)(ws + WS_CTL) + 8192 + 4096 + layer * 512);
            for (;;) {
                if (wave == 0) {
                    unsigned got = 0xffffffffu;
                    if (lane == 0) { const unsigned u_ = __hip_atomic_fetch_add(qbase + xq * 64, 1u, __ATOMIC_RELAXED, __HIP_MEMORY_SCOPE_AGENT); if (u_ < 224u) got = (unsigned)xq * 256u + u_; }
                    got = (unsigned)__builtin_amdgcn_readfirstlane((int)got);
                    while (got == 0xffffffffu) {
                        const unsigned c_ = lane < 8 ? __hip_atomic_load(qbase + lane * 64, __ATOMIC_RELAXED, __HIP_MEMORY_SCOPE_AGENT) : 224u;
                        const unsigned mk = (unsigned)__ballot(c_ < 224u) & 0xffu;
                        if (mk == 0u) break;
                        const unsigned rot = ((mk >> xq) | (mk << (8 - xq))) & 0xffu;
                        const int j_ = (xq + __builtin_ctz(rot)) & 7;
                        if (lane == 0) { const unsigned u_ = __hip_atomic_fetch_add(qbase + j_ * 64, 1u, __ATOMIC_RELAXED, __HIP_MEMORY_SCOPE_AGENT); if (u_ < 224u) got = (unsigned)j_ * 256u + u_; }
                        got = (unsigned)__builtin_amdgcn_readfirstlane((int)got);
                        xq = j_;
                    }
                    if (lane == 0) *uslot = got;
                }
                __syncthreads();
                const unsigned uq_ = *uslot;
                __syncthreads();
                if (uq_ == 0xffffffffu) break;
                const int xu = (int)(uq_ >> 8), ul = (int)(uq_ & 255u);
                if (ul >= 192) { const unsigned ucv = (unsigned)(xu * 32 + (ul - 192));
                    const float* cw = args.in[4] + (size_t)layer * 3 * BW;
#pragma unroll 1
                    for (int k8 = 0; k8 < 8; ++k8) { const int i = (int)ucv * 4096 + k8 * (NWAVES * 64) + tid;
                        const int t = i >> 6, c = (i & 63) * 8; const int tt = t & (SEQ - 1);
                        const u32x4 u2 = *(const u32x4*)(Ub + (size_t)t * BW + c);
                        u32x4 u1 = {0u, 0u, 0u, 0u}, u0 = {0u, 0u, 0u, 0u};
                        if (tt >= 1) u1 = *(const u32x4*)(Ub + (size_t)(t - 1) * BW + c);
                        if (tt >= 2) u0 = *(const u32x4*)(Ub + (size_t)(t - 2) * BW + c);
                        const u32x4 bw = *(const u32x4*)(BC + (size_t)t * BW + c);
                        float y[8];
#pragma unroll
                        for (int e = 0; e < 4; ++e) {
                            const float w0l = cw[c + 2 * e], w0h = cw[c + 2 * e + 1], w1l = cw[BW + c + 2 * e], w1h = cw[BW + c + 2 * e + 1], w2l = cw[2 * BW + c + 2 * e], w2h = cw[2 * BW + c + 2 * e + 1];
                            y[2 * e] = bf_lo(bw[e]) * (w0l * bf_lo(u0[e]) + w1l * bf_lo(u1[e]) + w2l * bf_lo(u2[e]));
                            y[2 * e + 1] = bf_hi(bw[e]) * (w0h * bf_hi(u0[e]) + w1h * bf_hi(u1[e]) + w2h * bf_hi(u2[e]));
                        }
                        *(u32x4*)(BC + (size_t)t * BW + c) = (u32x4){cvt_pk_bf16(y[0], y[1]), cvt_pk_bf16(y[2], y[3]), cvt_pk_bf16(y[4], y[5]), cvt_pk_bf16(y[6], y[7])}; }
                    continue;
                }
                if (ul < 64) {
                    const int b = xu & 1, h = (ul >> 5) ? (xu >> 1) : 7 - (xu >> 1), bh = b * 8 + h, n = ul & 31;
                    const int key_ = n * 256 + (tid >> 1); const bf16_t* kp = KA + (size_t)(b * NH + h) * SEQ * HD + (size_t)(key_ >> 5) * 2048 + (tid & 1) * 1024 + (key_ & 31) * 8;
                    float sq = 0.f;
#pragma unroll
                    for (int c = 0; c < 4; ++c) { const u32x4 x = *(const u32x4*)(kp + c * 256); const float e0 = bf_lo(x.x), e1 = bf_hi(x.x), e2 = bf_lo(x.y), e3 = bf_hi(x.y), e4 = bf_lo(x.z), e5 = bf_hi(x.z), e6 = bf_lo(x.w), e7 = bf_hi(x.w);
                        sq += (e0 * e0 + e1 * e1) + (e2 * e2 + e3 * e3) + (e4 * e4 + e5 * e5) + (e6 * e6 + e7 * e7); }
                    sq += xshfl<1>(sq);
                    sq = __builtin_fmaxf(sq, xshfl<2>(sq)); sq = __builtin_fmaxf(sq, xshfl<4>(sq)); sq = __builtin_fmaxf(sq, xshfl<8>(sq)); sq = __builtin_fmaxf(sq, xshfl<16>(sq));
                    { float x1; const float x0 = att::swap_lo(sq, x1); sq = __builtin_fmaxf(x0, x1); }
                    if (lane == 0) kbn[wave] = sq;
                    __syncthreads();
                    if (tid == 0) { float m_ = kbn[0];
#pragma unroll
                        for (int w_ = 1; w_ < NWAVES; ++w_) m_ = __builtin_fmaxf(m_, kbn[w_]);
                        __hip_atomic_store((unsigned*)kbmax + bh * 32 + n, __float_as_uint(m_) | 1u, __ATOMIC_RELAXED, __HIP_MEMORY_SCOPE_AGENT); }
                    __syncthreads();
                } else if (ul < 128) {
                    const int b = xu & 1, h = ((ul - 64) >> 5) ? (xu >> 1) : 7 - (xu >> 1), blk = 31 - (ul & 31);
                    unsigned kb_ = 1u; if (tid < 32) kb_ = __hip_atomic_load((unsigned*)kbmax + (b * 8 + h) * 32 + tid, __ATOMIC_RELAXED, __HIP_MEMORY_SCOPE_AGENT);
                    const size_t qrow = (size_t)b * SEQ + blk * 256 + wave * 32;
                    bf16x8 gq[4], gk[4]; att::gate_load(gq, gk, QA + qrow * BW + h * HD, KA + (size_t)(b * NH + h) * SEQ * HD, blk * 256 + wave * 32, lane);
                    for (int i = tid; i < 2048; i += NWAVES * 64) { const int n = i >> 6, d = i & 63; const size_t o = (size_t)((b * 32 + n) * 2) * BW + h * HD + d; km[n * 64 + ((((d >> 2) ^ (n & 15)) << 2) | (d & 3))] = kmp[o] + kmp[o + BW]; }
                    if (tid < 32) {
                        unsigned sp_ = 0; while (kb_ == 0u) { __builtin_amdgcn_s_sleep(2); kb_ = __hip_atomic_load((unsigned*)kbmax + (b * 8 + h) * 32 + tid, __ATOMIC_RELAXED, __HIP_MEMORY_SCOPE_AGENT);
                            if (++sp_ > (1u << 20)) { atomicAdd((unsigned*)(ws + WS_CTL) + CW_BAR + XB_TMO, 1u); break; } }
                        kbn[tid] = sqrtf(__uint_as_float(kb_)) * 1.01f; }
                    __syncthreads();
                    const float sl2 = __builtin_amdgcn_exp2f(-(float)(h + 1)) * LOG2E;
                    const unsigned sel = att::moba_gate(gq, gk, blk, blk * 256 + wave * 32, sl2, km, kbn, lane);
                    if (lane < 32) selm[wave * 32 + lane] = sel;
                    __syncthreads();
                    for (int n = wave; n < blk; n += NWAVES) {
                        unsigned pos = 0;
#pragma unroll
                        for (int c = 0; c < 4; ++c) { const int q = 64 * c + lane; const bool bit = (selm[q] >> n) & 1u; const unsigned long long mk = __ballot(bit);
                            if (bit) lists[n * 256 + pos + __builtin_amdgcn_mbcnt_hi((unsigned)(mk >> 32), __builtin_amdgcn_mbcnt_lo((unsigned)mk, 0u))] = (unsigned char)q;
                            pos += (unsigned)__builtin_popcountll(mk); }
                        if (lane == 0) cnt[n] = pos;
                    }
                    __syncthreads();
                    { int n = blk, t = wave; int nn = 0, tt = 0, idp = 0;
                      for (;;) {
                          att::moba_item(QA, KA, VA, b, h, blk, n, t, lists, cnt, selm, recO, recML, vst, wsf, trow, lane);
                          bool found = false;
                          while (nn < blk) { const int nt_ = ((int)cnt[nn] + 31) >> 5;
                              if (tt < nt_) { const bool mine = (idp & (NWAVES - 1)) == wave; if (mine) { n = nn; t = tt; found = true; } ++tt; ++idp; if (mine) break; }
                              else { ++nn; tt = 0; } }
                          if (!found) break;
                      } }
                    VM_WAIT();
                    __syncthreads();
                    att::moba_merge(QA, b, h, blk, wave, selm, recO, recML, wsf, lane);
                    __syncthreads();
                } else {
                    const int b = xu & 1, h = (xu >> 1) * 2 + ((ul - 128) >> 5), blk = ul & 31;
                    att::sb_item(QS, KS, VS, b, h, blk * 256 + wave * 32, vst, lane);
                }
            }
        } else {
            static_assert(WS_QS - WS_QA == 48 * MiB && WS_BC - WS_QS == 48 * MiB && WS_VA - WS_KA == 16 * MiB && WS_KS - WS_KA == 48 * MiB, "O_a / O_s / O_c 48 MiB apart; gate scratch = K_a | V_a | K_s");
            GCfg c{};
            c.ws = ws; c.wb = layer == 0 ? ws + WS_WIN : (unsigned char*)out; c.bgate = args.in[3] + (size_t)layer * NGATE; c.red = (LAS float*)(lds + LDSCTL_OFF + 1024);
            c.nseg = 1; c.lda = DM; c.ldb = DM; c.nt = DM / 64; c.toA = 0;
            if (ph == 1) { c.mode = 0; c.N = N1; c.A = xb; c.B = (const bf16_t*)c.wb; }
            else if (ph == 3) { c.mode = 1; c.N = DM; c.nseg = 6; c.A = xb; c.B = (const bf16_t*)(c.wb + (WS_WG - WS_WIN)); }
            else if (ph == 4) { c.mode = 2; c.N = DM; c.A = MG; c.B = (const bf16_t*)(c.wb + (WS_WO - WS_WIN)); }
            else if (ph == 5) { c.mode = 3; c.N = NGU; c.A = xb; c.B = (const bf16_t*)(c.wb + (WS_WGU - WS_WIN)); }
            else { c.mode = 2; c.N = DM; c.A = ACT; c.B = (const bf16_t*)(c.wb + (WS_WD - WS_WIN)); c.lda = DFF; c.ldb = DFF; c.nt = DFF / 64; c.toA = 1; }
            ProbAny P{&c}; EpiAny E{&c}; pg8::StaticOrder S; S.init(M, c.N, G, bx, c.nseg);
            pg8::gemm_phase(lds + RING_OFF, P, S, E, wave);
        }
        if (!(ph == 6 && layer + 1 < DEPTH)) xcd_barrier(bar, tid, mapok && (ph == 3 || ph == 4 || ph == 5));
        if (pq == 0) { if (tid == 0) MISC[12] = xb_ld((unsigned*)(ws + WS_CTL) + CW_BAR + XB_MAPBAD); __syncthreads(); mapok = (MISC[12] == 0u); }
    }
}

extern "C" void kernel_launch(void* const* d_in, const int* in_sizes, int n_in, void* d_out, int out_size, void* d_ws, size_t ws_size, hipStream_t stream) {
    static int grid = 0;
    if (grid == 0) {
        if (n_in != 14 || in_sizes[0] != M * DM || out_size != M * DM || ws_size < WS_END) { fprintf(stderr, "kernel_launch: unexpected shapes (n_in %d, in0 %d, out %d, ws %zu)\n", n_in, n_in > 0 ? in_sizes[0] : -1, out_size, ws_size); grid = -1; return; }
        int dev = 0, cus = 0, per_cu = 0;
        if (hipGetDevice(&dev) != hipSuccess || hipDeviceGetAttribute(&cus, hipDeviceAttributeMultiprocessorCount, dev) != hipSuccess) { grid = -1; return; }
        if (hipFuncSetAttribute((const void*)hybrid_fwd, hipFuncAttributeMaxDynamicSharedMemorySize, LDS_BYTES) != hipSuccess) { fprintf(stderr, "kernel_launch: hipFuncSetAttribute failed\n"); grid = -1; return; }
        if (hipOccupancyMaxActiveBlocksPerMultiprocessor(&per_cu, (const void*)hybrid_fwd, NWAVES * 64, LDS_BYTES) != hipSuccess || per_cu < 1) { fprintf(stderr, "kernel_launch: occupancy query says %d blocks/CU\n", per_cu); (void)hipGetLastError(); per_cu = 1; }
        grid = cus;
    }
    if (grid < 0) return;
    if (hipMemsetAsync((char*)d_ws + WS_CTL, 0, CTL_ZERO_BYTES, stream) != hipSuccess) { fprintf(stderr, "kernel_launch: memset failed\n"); return; }
    Args a{};
    for (int i = 0; i < 14; ++i) a.in[i] = (const float*)d_in[i];
    a.out = (float*)d_out; a.ws = (unsigned char*)d_ws;
    void* kargs[] = {&a};
    hipError_t e = hipLaunchCooperativeKernel((const void*)hybrid_fwd, dim3(grid), dim3(NWAVES * 64), kargs, LDS_BYTES, stream);
    if (e != hipSuccess) fprintf(stderr, "kernel_launch: cooperative launch failed: %s (grid %d)\n", hipGetErrorString(e), grid);
}
```

```cpp
#include <hip/hip_runtime.h>
#include <hip/hip_bf16.h>
#include <cstdio>
#include <cstdint>

#define GAS __attribute__((address_space(1)))
#define LAS __attribute__((address_space(3)))
typedef unsigned short bf16_t;
typedef short bf16x8 __attribute__((ext_vector_type(8)));
typedef short s16x4 __attribute__((ext_vector_type(4)));
typedef float f32x2 __attribute__((ext_vector_type(2)));
typedef float f32x4 __attribute__((ext_vector_type(4)));
typedef float f32x16 __attribute__((ext_vector_type(16)));
typedef unsigned u32x2 __attribute__((ext_vector_type(2)));
typedef unsigned u32x4 __attribute__((ext_vector_type(4)));
typedef GAS unsigned gu32;

constexpr int BATCH = 2, SEQ = 8192, DM = 1024, M = BATCH * SEQ, NH = 8, HD = 64, BW = 512, DFF = 2816, DEPTH = 2;
constexpr int NIN = 7680, N1 = 4608, NGATE = 3072, NGU = 2 * DFF;
constexpr float RMS_EPS = 1e-6f;
constexpr float LOG2E = 1.4426950408889634f;
constexpr float C2 = 0.125f * LOG2E;
constexpr int NWAVES = 8;

constexpr size_t MiB = 1u << 20;
constexpr size_t WS_CTL = 0, CTL_ZERO_BYTES = 64 * 1024;
constexpr size_t WS_SSA = 1 * MiB, WS_SSB = 2 * MiB, WS_KM = 3 * MiB;
constexpr size_t WS_WIN = 4 * MiB, WS_WG = 13 * MiB, WS_WP = 19 * MiB, WS_WO = 22 * MiB, WS_WGU = 24 * MiB, WS_WD = 35 * MiB;
constexpr size_t WS_XB = 41 * MiB;
constexpr size_t WS_QA = 73 * MiB, WS_KA = 89 * MiB, WS_VA = 105 * MiB, WS_QS = 121 * MiB, WS_KS = 137 * MiB, WS_VS = 153 * MiB;
constexpr size_t WS_BC = 169 * MiB, WS_U = 185 * MiB, WS_MG = 201 * MiB, WS_X = 233 * MiB;
constexpr size_t WS_ACT = 73 * MiB;
__device__ __forceinline__ size_t act_tile_off(int pm) { return WS_ACT + (size_t)(pm & 7) * (16 * MiB) + (size_t)(pm >> 3) * (2 * MiB); }
constexpr size_t WS_END = 256 * MiB;
constexpr int CW_BAR = 4096;

constexpr int RING_OFF = 0, RING_BYTES = 131072;
constexpr int ATT_OFF = RING_BYTES, ATT_BYTES = 23552;
constexpr int LDSCTL_OFF = ATT_OFF + ATT_BYTES, MISC_OFF = LDSCTL_OFF + 320;
constexpr int LDS_BYTES = 163840;
static_assert(LDSCTL_OFF + 1024 + 4096 <= LDS_BYTES, "LDS map");

#define LDS_WAIT() asm volatile("s_waitcnt lgkmcnt(0)" ::: "memory")
#define VM_WAIT() asm volatile("s_waitcnt vmcnt(0)" ::: "memory")
#define RLX_AGENT __ATOMIC_RELAXED, __HIP_MEMORY_SCOPE_AGENT

typedef __bf16 bf16x2_t __attribute__((ext_vector_type(2)));
__device__ __forceinline__ unsigned cvt_pk_bf16(float lo, float hi) { const f32x2 v = {lo, hi}; const bf16x2_t b = __builtin_convertvector(v, bf16x2_t); return __builtin_bit_cast(unsigned, b); }
template <int O> __device__ __forceinline__ float xshfl(float x) {
    static_assert(O < 32, "use sum32 for the two 32-lane halves");
    return __int_as_float(__builtin_amdgcn_ds_swizzle(__float_as_int(x), (O << 10) | 0x1f));
}
__device__ __forceinline__ int lane_id() { return (int)__builtin_amdgcn_mbcnt_hi(~0u, __builtin_amdgcn_mbcnt_lo(~0u, 0u)); }
__device__ __forceinline__ float sum32(float x) { auto rr = __builtin_amdgcn_permlane32_swap(__float_as_uint(x), __float_as_uint(x), false, false); return __uint_as_float(rr[0]) + __uint_as_float(rr[1]); }
__device__ __forceinline__ float bf_lo(unsigned w) { return __uint_as_float(w << 16); }
__device__ __forceinline__ float bf_hi(unsigned w) { return __uint_as_float(w & 0xffff0000u); }
__device__ __forceinline__ float rstd_row(const float* ssp, int row) {
    const f32x4 a = *(const f32x4*)(ssp + (size_t)row * 4);
    return rsqrtf(((a.x + a.y) + (a.z + a.w)) * (1.0f / DM) + RMS_EPS);
}

namespace pg8 {
constexpr int BM = 256, BK = 64, HALF = 128, HTB = HALF * BK * 2, STAGE_BYTES = 8 * HTB, NXCD = 8, WGM = 8;
__host__ __device__ __forceinline__ int lds_byte(int r, int c) { const int st = (r >> 4) * 2 + (c >> 5), rr = r & 15, cc = c & 31, ob = rr * 64 + cc * 2; return st * 1024 + (ob ^ (((ob >> 9) & 1) << 5)); }
__host__ __device__ __forceinline__ void stage_rc(int b, int& R, int& C) { const int st = b / 1024, sb = b % 1024, swz = sb ^ (((sb >> 9) & 1) << 5); R = (st >> 1) * 16 + swz / 64; C = (st & 1) * 32 + (swz % 64) / 2; }
__host__ __device__ __forceinline__ int perm32(int rho) { const int n = rho >> 4, i = rho & 15; return 8 * (i >> 2) + 4 * n + (i & 3); }

struct Unit { int pm, pn, seg; };
struct Seg { const char* A; const char* B; unsigned hA, hB; int lda, ldb, nt; };

struct StaticOrder {
    int nM, nN, nwg, G, c, nseg;
    __device__ void init(int M_, int N_, int G_, int c_, int nseg_) { nM = M_ / BM; nN = N_ / BM; nwg = nM * nN; G = G_; c = c_; nseg = nseg_; }
    __device__ bool next(int i, Unit& u) const {
        const int ti = (nseg == 1) ? i : i / nseg; u.seg = i - ti * nseg;
        const long L = (long)ti * G + c; if (L >= nwg) return false;
        int wgid = (int)L; { const int q = nwg / NXCD, r = nwg % NXCD, xcd = wgid % NXCD, off = wgid / NXCD; wgid = (xcd < r ? xcd * (q + 1) : r * (q + 1) + (xcd - r) * q) + off; }
        const int nig = WGM * nN, gid = wgid / nig, fm = gid * WGM, gsz = (nM - fm) < WGM ? (nM - fm) : WGM;
        u.pm = fm + ((wgid % nig) % gsz); u.pn = (wgid % nig) / gsz; return true;
    }
};

template <class Prob, class Epi, class Sched>
__device__ __forceinline__ void gemm_phase(LAS unsigned char* lds, const Prob& P, const Sched& S, const Epi& E, int wave_) {
    int tid = wave_ * 64 + lane_id(); asm volatile("" : "+v"(tid));
    const int wid = wave_, lane = tid & 63, wr = wid >> 2, wc = wid & 3, fr = lane & 15, fq = lane >> 4;
#define PG8_RC(R0, C0, Rb0) int R0, C0; { int t_ = tid; asm volatile("" : "+v"(t_)); stage_rc(t_ * 16, R0, C0); } const int Rb0 = (R0 & ~31) + perm32(R0 & 31)
    const size_t kstep = (size_t)(BK * 2);
    const unsigned ldsw = (unsigned)wid * 1024u;
    const int aoff = lds_byte(wr * 64 + fr, fq * 8), boff = lds_byte(wc * 32 + fr, fq * 8);
#define PG8_SA(b, h) (((b) * 2 + (h)) * HTB)
#define PG8_SB(b, h) ((4 + (b) * 2 + (h)) * HTB)
#define PG8_STAGE(bufoff, gbase, v0, q) do { \
        __builtin_amdgcn_global_load_lds((const unsigned*)((const char*)(gbase) + (v0)), (LAS unsigned*)(lds + (bufoff) + ldsw), 16, 0, 0); \
        __builtin_amdgcn_global_load_lds((const unsigned*)((const char*)(gbase) + (q) + (v0)), (LAS unsigned*)(lds + (bufoff) + ldsw + 8192), 16, 0, 0); } while (0)
#define PG8_LDA(dst, b, h) do { _Pragma("unroll") for (int m = 0; m < 4; ++m) _Pragma("unroll") for (int k = 0; k < 2; ++k) dst[m][k] = *(const LAS bf16x8*)(lds + PG8_SA(b, h) + aoff + m * 2048 + k * 1024); } while (0)
#define PG8_LDB(dst, b, h) do { _Pragma("unroll") for (int n = 0; n < 2; ++n) _Pragma("unroll") for (int k = 0; k < 2; ++k) dst[n][k] = *(const LAS bf16x8*)(lds + PG8_SB(b, h) + boff + n * 2048 + k * 1024); } while (0)
#define PG8_MMA(ai, bj, At, Bt) do { __builtin_amdgcn_s_setprio(1); _Pragma("unroll") for (int m = 0; m < 4; ++m) _Pragma("unroll") for (int n = 0; n < 2; ++n) _Pragma("unroll") for (int k = 0; k < 2; ++k) \
        acc[ai][bj][m][n] = __builtin_amdgcn_mfma_f32_16x16x32_bf16(Bt[n][k], At[m][k], acc[ai][bj][m][n], 0, 0, 0); __builtin_amdgcn_s_setprio(0); } while (0)
#define PG8_WAIT_V(n) asm volatile("s_waitcnt vmcnt(" #n ")" ::: "memory")
#define PG8_WAIT_L(n) asm volatile("s_waitcnt lgkmcnt(" #n ")" ::: "memory")
#define PG8_BAR __builtin_amdgcn_s_barrier()
#define PG8_SCHED __builtin_amdgcn_sched_barrier(0)
    Unit cur, nxt; int ui = 0;
    if (!S.next(0, cur)) return;
    Seg sc, sn; P.seg(cur, sc);
    unsigned vAc0, vBc0; { PG8_RC(R0, C0, Rb0); vAc0 = (unsigned)(R0 * sc.lda + C0) * 2u; vBc0 = (unsigned)(Rb0 * sc.ldb + C0) * 2u; }
    f32x4 acc[2][2][4][2];
#pragma unroll
    for (int a = 0; a < 2; ++a)
#pragma unroll
        for (int b = 0; b < 2; ++b)
#pragma unroll
            for (int m = 0; m < 4; ++m)
#pragma unroll
                for (int n = 0; n < 2; ++n) acc[a][b][m][n] = (f32x4){0.f, 0.f, 0.f, 0.f};
    bf16x8 At[4][2], B0[2][2], B1[2][2];
    const char* cA = sc.A; const char* cB = sc.B;
    PG8_STAGE(PG8_SB(0, 0), cB, vBc0, sc.hB >> 1); PG8_STAGE(PG8_SB(0, 1), cB + sc.hB, vBc0, sc.hB >> 1); PG8_STAGE(PG8_SA(0, 0), cA, vAc0, sc.hA >> 1); PG8_STAGE(PG8_SA(0, 1), cA + sc.hA, vAc0, sc.hA >> 1);
    if (wr == 1) PG8_BAR;
    PG8_WAIT_V(2); PG8_BAR;
    PG8_STAGE(PG8_SB(1, 0), cB + kstep, vBc0, sc.hB >> 1); PG8_STAGE(PG8_SA(1, 0), cA + kstep, vAc0, sc.hA >> 1); PG8_STAGE(PG8_SB(1, 1), cB + sc.hB + kstep, vBc0, sc.hB >> 1);
    PG8_WAIT_V(6); PG8_BAR;
    for (;;) {
        const bool has_next = S.next(ui + 1, nxt);
        if (has_next) P.seg(nxt, sn); else sn = sc;
        unsigned vAn0, vBn0; { PG8_RC(R0, C0, Rb0); vAn0 = (unsigned)(R0 * sn.lda + C0) * 2u; vBn0 = (unsigned)(Rb0 * sn.ldb + C0) * 2u; }
        const char* nA = sn.A; const char* nB = sn.B;
        const int nt = sc.nt;
        for (int t = 0; t < nt; t += 2) {
            const bool last = (t == nt - 2);
            const char* a1 = cA + (size_t)(t + 1) * kstep;
            const char* a2 = last ? nA : cA + (size_t)(t + 2) * kstep; const char* b2 = last ? nB : cB + (size_t)(t + 2) * kstep;
            const char* a3 = a2 + kstep; const char* b3 = b2 + kstep;
            const unsigned hA2 = last ? sn.hA : sc.hA, hB2 = last ? sn.hB : sc.hB;
            const unsigned vA0 = last ? vAn0 : vAc0, vB0 = last ? vBn0 : vBc0, qA = hA2 >> 1, qB = hB2 >> 1;
            PG8_LDB(B0, 0, 0); PG8_LDB(B1, 0, 1); PG8_SCHED; PG8_LDA(At, 0, 0); PG8_STAGE(PG8_SA(1, 1), a1 + sc.hA, vAc0, sc.hA >> 1);
            PG8_WAIT_V(8); PG8_WAIT_L(0); PG8_BAR; PG8_MMA(0, 0, At, B0); PG8_MMA(0, 1, At, B1); PG8_BAR; PG8_SCHED;
            PG8_LDA(At, 0, 1); PG8_STAGE(PG8_SB(0, 0), b2, vB0, qB); PG8_STAGE(PG8_SB(0, 1), b2 + hB2, vB0, qB); PG8_STAGE(PG8_SA(0, 0), a2, vA0, qA);
            PG8_WAIT_V(8); PG8_WAIT_L(0); PG8_BAR; PG8_MMA(1, 0, At, B0); PG8_MMA(1, 1, At, B1); PG8_BAR; PG8_SCHED;
            PG8_LDB(B0, 1, 0); PG8_LDB(B1, 1, 1); PG8_SCHED; PG8_LDA(At, 1, 0); PG8_STAGE(PG8_SA(0, 1), a2 + hA2, vA0, qA);
            PG8_WAIT_V(8); PG8_WAIT_L(0); PG8_BAR; PG8_MMA(0, 0, At, B0); PG8_MMA(0, 1, At, B1); PG8_BAR; PG8_SCHED;
            PG8_LDA(At, 1, 1); PG8_STAGE(PG8_SB(1, 0), b3, vB0, qB); PG8_STAGE(PG8_SB(1, 1), b3 + hB2, vB0, qB); PG8_STAGE(PG8_SA(1, 0), a3, vA0, qA);
            PG8_WAIT_V(8); PG8_WAIT_L(0); PG8_BAR; PG8_MMA(1, 0, At, B0); PG8_MMA(1, 1, At, B1); PG8_BAR; PG8_SCHED;
        }
        if (wr == 0) PG8_BAR;
        { int wr_ = wr, wc_ = wc, t_ = tid;
          asm volatile("" : "+s"(wr_), "+s"(wc_), "+v"(t_)); const int fr_ = t_ & 15, fq_ = (t_ >> 4) & 3;
          E(acc, cur, wr_, wc_, fr_, fq_); }
        if (!has_next) break;
#pragma unroll
        for (int a = 0; a < 2; ++a)
#pragma unroll
            for (int b = 0; b < 2; ++b)
#pragma unroll
                for (int m = 0; m < 4; ++m)
#pragma unroll
                    for (int n = 0; n < 2; ++n) acc[a][b][m][n] = (f32x4){0.f, 0.f, 0.f, 0.f};
        cur = nxt; sc = sn; cA = nA; cB = nB; vAc0 = vAn0; vBc0 = vBn0; ++ui;
        if (wr == 1) PG8_BAR;
    }
    PG8_WAIT_V(0);
    PG8_BAR;
#undef PG8_SA
#undef PG8_SB
#undef PG8_STAGE
#undef PG8_LDA
#undef PG8_LDB
#undef PG8_MMA
#undef PG8_WAIT_V
#undef PG8_WAIT_L
#undef PG8_BAR
#undef PG8_SCHED
#undef PG8_RC
}
}

#define EPI_ARGS const f32x4 (&acc)[2][2][4][2], const pg8::Unit& u, int wr, int wc, int fr, int fq
__device__ __forceinline__ void st_bf16x8(bf16_t* p, f32x4 v0, f32x4 v1) {
    u32x4 w; w.x = cvt_pk_bf16(v0[0], v0[1]); w.y = cvt_pk_bf16(v0[2], v0[3]); w.z = cvt_pk_bf16(v1[0], v1[1]); w.w = cvt_pk_bf16(v1[2], v1[3]);
#ifdef SC1_STORES
    asm volatile("global_store_dwordx4 %0, %1, off sc1\n\ts_nop 1" :: "v"(p), "v"(w) : "memory");
#else
    *(u32x4*)p = w;
#endif
}
template <class T> __device__ __forceinline__ T* bo(T* base, unsigned byte_off) { return (T*)((char*)base + byte_off); }
template <class T> __device__ __forceinline__ const T* bo(const T* base, unsigned byte_off) { return (const T*)((const char*)base + byte_off); }
__device__ __forceinline__ void ld_bf16x8(const bf16_t* p, f32x4& v0, f32x4& v1) {
    const unsigned long long lo = __hip_atomic_load((const unsigned long long*)p, __ATOMIC_RELAXED, __HIP_MEMORY_SCOPE_AGENT), hi = __hip_atomic_load((const unsigned long long*)p + 1, __ATOMIC_RELAXED, __HIP_MEMORY_SCOPE_AGENT);
    const u32x4 w = {(unsigned)lo, (unsigned)(lo >> 32), (unsigned)hi, (unsigned)(hi >> 32)};
    v0 = (f32x4){bf_lo(w.x), bf_hi(w.x), bf_lo(w.y), bf_hi(w.y)}; v1 = (f32x4){bf_lo(w.z), bf_hi(w.z), bf_lo(w.w), bf_hi(w.w)};
}
__device__ __forceinline__ float rstd4(f32x4 a) { return rsqrtf(((a.x + a.y) + (a.z + a.w)) * (1.0f / DM) + RMS_EPS); }
__device__ __forceinline__ void rstd8(float (&rs)[2][4], const float* ss, int pm, unsigned lrow, bool rtab, const LAS float* rst) {
    if (rtab) {
#pragma unroll
        for (int ai = 0; ai < 2; ++ai)
#pragma unroll
            for (int m = 0; m < 4; ++m) rs[ai][m] = rst[lrow + (unsigned)(ai * 128 + m * 16)];
        return;
    }
    const float* ssb = ss + (size_t)pm * 256 * 4; unsigned lsb = lrow * 16u; asm volatile("" : "+v"(lsb));
    f32x4 t[2][4];
#pragma unroll
    for (int ai = 0; ai < 2; ++ai)
#pragma unroll
        for (int m = 0; m < 4; ++m) t[ai][m] = *(const f32x4*)bo(ssb, lsb + (unsigned)(ai * 128 + m * 16) * 16u);
#pragma unroll
    for (int ai = 0; ai < 2; ++ai)
#pragma unroll
        for (int m = 0; m < 4; ++m) rs[ai][m] = rstd4(t[ai][m]);
}
struct EpiIn {
    unsigned char* ws; bool rtab; const LAS float* rst;
    __device__ __forceinline__ void operator()(EPI_ARGS) const {
        bf16_t* qkv = (bf16_t*)(ws + WS_QA); bf16_t* ub = (bf16_t*)(ws + WS_U); bf16_t* bc = (bf16_t*)(ws + WS_BC); float* kmp = (float*)(ws + WS_KM); const float* ss = (const float*)(ws + WS_SSA);
        const int pn = u.pn; unsigned lrow = (unsigned)(wr * 64 + fr), lcol = (unsigned)(wc * 32 + 8 * fq);
        asm volatile("" : "+v"(lrow), "+v"(lcol));
        const unsigned lb = (lrow * BW + lcol) * 2u;
        float rs[2][4]; rstd8(rs, ss, u.pm, lrow, rtab, rst);
        if (pn < 12 || pn >= 16) {
            const int t = pn >> 1; const float sc = (t == 0 || t == 3) ? C2 : 1.0f;
            bf16_t* base = (pn < 12 ? qkv + (size_t)t * M * BW + (pn & 1) * 256 : bc + (pn - 16) * 256) + (size_t)u.pm * 256 * BW;
            if (t == 1) {
                float* kp = kmp + (size_t)(u.pm * 2 + wr) * BW + (pn & 1) * 256;
#pragma unroll
                for (int bj = 0; bj < 2; ++bj)
#pragma unroll
                    for (int n = 0; n < 2; ++n) { f32x4 s = {0.f, 0.f, 0.f, 0.f};
#pragma unroll
                        for (int ai = 0; ai < 2; ++ai)
#pragma unroll
                            for (int m = 0; m < 4; ++m) s += acc[ai][bj][m][n] * rs[ai][m];
#pragma unroll
                        for (int e = 0; e < 4; ++e) { s[e] += xshfl<1>(s[e]); s[e] += xshfl<2>(s[e]); s[e] += xshfl<4>(s[e]); s[e] += xshfl<8>(s[e]); }
                        if (fr == 0) *(f32x4*)bo(kp, (lcol + (unsigned)(bj * 128 + 4 * n)) * 4u) = s; }
            }
            if (t == 2 || t == 5) {
                bf16_t* vb = qkv + (size_t)t * M * BW + ((size_t)((u.pm >> 5) * 8 + (pn & 1) * 4) * SEQ + (size_t)(u.pm & 31) * 256) * HD;
                const unsigned fr_ = lrow & 15u, wr_ = lrow >> 6, hl = lcol >> 6, dd = lcol & 63u;
#pragma unroll
                for (int ai = 0; ai < 2; ++ai)
#pragma unroll
                    for (int m = 0; m < 4; ++m) { float f = rs[ai][m]; asm volatile("" : "+v"(f));
#pragma unroll
                        for (int bj = 0; bj < 2; ++bj) { const unsigned eo = (unsigned)(bj * 2 + hl) * (SEQ * HD) + ((wr_ + 2 * ai) * 4096 + ((dd >> 5) * 4 + m) * 512 + fr_ * 32 + (dd & 31u));
                            st_bf16x8(bo(vb, eo * 2u), acc[ai][bj][m][0] * f, acc[ai][bj][m][1] * f); } }
            } else if (t == 1 || t == 4) {
                bf16_t* kb = qkv + (size_t)t * M * BW + ((size_t)((u.pm >> 5) * 8 + (pn & 1) * 4) * SEQ + (size_t)(u.pm & 31) * 256) * HD;
                const unsigned fr_ = lrow & 15u, wr_ = lrow >> 6, hl = lcol >> 6, dch = (lcol & 63u) >> 3;
#pragma unroll
                for (int ai = 0; ai < 2; ++ai)
#pragma unroll
                    for (int m = 0; m < 4; ++m) { float f = rs[ai][m]; asm volatile("" : "+v"(f));
#pragma unroll
                        for (int bj = 0; bj < 2; ++bj) { const unsigned eo = (unsigned)(bj * 2 + hl) * (SEQ * HD) + (((wr_ * 2 + ai * 4 + (m >> 1)) * 8 + dch) * 256 + (fr_ + 16u * (m & 1)) * 8);
                            st_bf16x8(bo(kb, eo * 2u), acc[ai][bj][m][0] * f, acc[ai][bj][m][1] * f); } }
            } else {
#pragma unroll
            for (int ai = 0; ai < 2; ++ai)
#pragma unroll
                for (int m = 0; m < 4; ++m) { const float f = rs[ai][m] * sc; const unsigned o = lb + (unsigned)(ai * 128 + m * 16) * BW * 2u;
#pragma unroll
                    for (int bj = 0; bj < 2; ++bj) st_bf16x8(bo(base, o + bj * 256u), acc[ai][bj][m][0] * f, acc[ai][bj][m][1] * f); }
            }
        } else {
            bf16_t* base = ub + (size_t)u.pm * 256 * BW + (pn - 12) * 128;
#pragma unroll
            for (int ai = 0; ai < 2; ++ai)
#pragma unroll
                for (int m = 0; m < 4; ++m) { const float f = rs[ai][m] * rs[ai][m];
                    st_bf16x8(bo(base, lb + (unsigned)(ai * 128 + m * 16) * BW * 2u), acc[ai][0][m][0] * acc[ai][1][m][0] * f, acc[ai][0][m][1] * acc[ai][1][m][1] * f); }
        }
    }
};
struct EpiC1 {
    unsigned char* ws; const float* bgate; bool rtab; const LAS float* rst;
    __device__ __forceinline__ unsigned char* gtile(int s, int pm, int pn) const { return ws + WS_KA + (size_t)(s + (s >> 1)) * (16 * MiB) + (size_t)(pm * 4 + pn) * 65536; }
    __device__ __forceinline__ void operator()(EPI_ARGS) const {
        bf16_t* mg = (bf16_t*)(ws + WS_MG); const float* ss = (const float*)(ws + WS_SSA);
        const int sg = u.seg; unsigned lrow = (unsigned)(wr * 64 + fr), lcol = (unsigned)(wc * 32 + 8 * fq);
        asm volatile("" : "+v"(lrow), "+v"(lcol));
        const unsigned lb = (lrow * DM + lcol) * 2u, lg = (unsigned)((wr * 4 + wc) * 8 * 1024 + (fq * 16 + fr) * 16);
        unsigned char* gp = gtile(sg < 3 ? sg : sg - 3, u.pm, u.pn);
        if (sg < 3) {
            const float* bg = bgate + sg * DM + u.pn * 256;
            f32x4 bv[2][2];
#pragma unroll
            for (int bj = 0; bj < 2; ++bj) { bv[bj][0] = *(const f32x4*)bo(bg, (lcol + bj * 128u) * 4u) * (-LOG2E); bv[bj][1] = *(const f32x4*)bo(bg, (lcol + bj * 128u + 4u) * 4u) * (-LOG2E); }
            float rs[2][4]; rstd8(rs, ss, u.pm, lrow, rtab, rst);
#pragma unroll
            for (int ai = 0; ai < 2; ++ai)
#pragma unroll
                for (int m = 0; m < 4; ++m) { const float rn = rs[ai][m] * (-LOG2E); u32x4 w;
#pragma unroll
                    for (int bj = 0; bj < 2; ++bj)
#pragma unroll
                        for (int n = 0; n < 2; ++n) { const f32x4 x = acc[ai][bj][m][n] * rn + bv[bj][n];
                            unsigned q[4];
#pragma unroll
                            for (int e = 0; e < 4; ++e) q[e] = (unsigned)(__builtin_amdgcn_rcpf(1.0f + __builtin_amdgcn_exp2f(x[e])) * 255.0f + 0.5f);
                            w[bj * 2 + n] = q[0] | (q[1] << 8) | (q[2] << 16) | (q[3] << 24); }
                    *(u32x4*)bo(gp, lg + (unsigned)((ai * 4 + m) * 1024)) = w; }
        } else {
            bf16_t* mp = mg + (size_t)u.pm * 256 * DM + u.pn * 256;
            u32x4 gwa_[2][4];
#pragma unroll
            for (int ai = 0; ai < 2; ++ai)
#pragma unroll
                for (int mm = 0; mm < 4; ++mm) gwa_[ai][mm] = *(const u32x4*)bo((const unsigned char*)gp, lg + (unsigned)((ai * 4 + mm) * 1024));
#pragma unroll
            for (int ai = 0; ai < 2; ++ai) {
                u32x4 pw_[4][2];
#pragma unroll
                for (int mm = 0; mm < 4; ++mm) {
#pragma unroll
                    for (int bj = 0; bj < 2; ++bj) if (sg > 3) pw_[mm][bj] = *(const u32x4*)bo((const bf16_t*)mp, lb + (unsigned)(ai * 128 + mm * 16) * DM * 2u + bj * 256u); }
#pragma unroll
                for (int mm = 0; mm < 4; ++mm)
#pragma unroll
                    for (int bj = 0; bj < 2; ++bj) { const unsigned o = lb + (unsigned)(ai * 128 + mm * 16) * DM * 2u + bj * 256u; const unsigned g0 = gwa_[ai][mm][bj * 2], g1 = gwa_[ai][mm][bj * 2 + 1]; constexpr float s = 1.0f / 255.0f;
                        f32x4 v0 = acc[ai][bj][mm][0] * ((f32x4){(float)(g0 & 255u), (float)((g0 >> 8) & 255u), (float)((g0 >> 16) & 255u), (float)(g0 >> 24)} * s);
                        f32x4 v1 = acc[ai][bj][mm][1] * ((f32x4){(float)(g1 & 255u), (float)((g1 >> 8) & 255u), (float)((g1 >> 16) & 255u), (float)(g1 >> 24)} * s);
                        if (sg > 3) { const u32x4 p = pw_[mm][bj]; v0 += (f32x4){bf_lo(p.x), bf_hi(p.x), bf_lo(p.y), bf_hi(p.y)}; v1 += (f32x4){bf_lo(p.z), bf_hi(p.z), bf_lo(p.w), bf_hi(p.w)}; }
                        st_bf16x8(bo(mp, o), v0, v1); }
                asm volatile("" ::: "memory");
            }
        }
    }
};
struct EpiRes {
    unsigned char* ws; int toA; LAS float* red;
    __device__ __forceinline__ void operator()(EPI_ARGS) const {
        bf16_t* xb = (bf16_t*)(ws + WS_XB); float* sso = (float*)(ws + (toA ? WS_SSA : WS_SSB));
        unsigned lrow = (unsigned)(wr * 64 + fr), lcol = (unsigned)(wc * 32 + 8 * fq);
        asm volatile("" : "+v"(lrow), "+v"(lcol));
        const unsigned le = (lrow * DM + lcol) * 2u, lr4 = lrow * 4u + (unsigned)wc;
        bf16_t* xp = xb + (size_t)u.pm * 256 * DM + u.pn * 256;
#pragma unroll
        for (int ai = 0; ai < 2; ++ai) {
            u32x4 bs[4][2];
#pragma unroll
            for (int m = 0; m < 4; ++m)
#pragma unroll
                for (int bj = 0; bj < 2; ++bj) bs[m][bj] = *(const u32x4*)bo((const bf16_t*)xp, le + (unsigned)(ai * 128 + m * 16) * DM * 2u + bj * 256u);
#pragma unroll
            for (int m = 0; m < 4; ++m) { float sq = 0.f;
#pragma unroll
                for (int bj = 0; bj < 2; ++bj) { const u32x4 w = bs[m][bj];
                    const f32x4 x0 = (f32x4){bf_lo(w.x), bf_hi(w.x), bf_lo(w.y), bf_hi(w.y)} + acc[ai][bj][m][0], x1 = (f32x4){bf_lo(w.z), bf_hi(w.z), bf_lo(w.w), bf_hi(w.w)} + acc[ai][bj][m][1];
                    st_bf16x8(bo(xp, le + (unsigned)(ai * 128 + m * 16) * DM * 2u + bj * 256u), x0, x1);
                    sq += (x0[0] * x0[0] + x0[1] * x0[1]) + (x0[2] * x0[2] + x0[3] * x0[3]) + (x1[0] * x1[0] + x1[1] * x1[1]) + (x1[2] * x1[2] + x1[3] * x1[3]); }
                sq += xshfl<16>(sq); sq = sum32(sq);
                if (fq == 0) red[lr4 + (unsigned)(ai * 128 + m * 16) * 4u] = sq; }
            asm volatile("" ::: "memory");
        }
        asm volatile("s_waitcnt lgkmcnt(0)\n\ts_barrier" ::: "memory");
        { const int t = ((wr * 4 + wc) * 4 + fq) * 16 + fr; if (t < 256) { const f32x4 r = *(const LAS f32x4*)(red + t * 4); sso[((size_t)u.pm * 256 + t) * 4 + u.pn] = (r.x + r.y) + (r.z + r.w); } }
        asm volatile("s_waitcnt lgkmcnt(0)\n\ts_barrier" ::: "memory");
    }
};
struct EpiFfn {
    unsigned char* ws; bool rtab; const LAS float* rst;
    __device__ __forceinline__ void operator()(EPI_ARGS) const {
        const float* ss = (const float*)(ws + WS_SSB);
        unsigned lrow = (unsigned)(wr * 64 + fr), lcol = (unsigned)(wc * 32 + 8 * fq);
        asm volatile("" : "+v"(lrow), "+v"(lcol));
        const unsigned lb = (lrow * DFF + lcol) * 2u;
        bf16_t* ap = (bf16_t*)(ws + act_tile_off(u.pm)) + u.pn * 128;
        float rs[2][4]; rstd8(rs, ss, u.pm, lrow, rtab, rst);
#pragma unroll
        for (int ai = 0; ai < 2; ++ai)
#pragma unroll
            for (int m = 0; m < 4; ++m) { const float r1 = rs[ai][m], rn = r1 * (-LOG2E); f32x4 v[2];
#pragma unroll
                for (int n = 0; n < 2; ++n) { const f32x4 g = acc[ai][0][m][n], up = acc[ai][1][m][n] * (r1 * r1);
#pragma unroll
                    for (int e = 0; e < 4; ++e) v[n][e] = g[e] * up[e] * __builtin_amdgcn_rcpf(1.0f + __builtin_amdgcn_exp2f(g[e] * rn)); }
                st_bf16x8(bo(ap, lb + (unsigned)(ai * 128 + m * 16) * DFF * 2u), v[0], v[1]); }
    }
};

struct GCfg {
    int mode;
    int N, nseg, lda, ldb, nt, toA;
    const bf16_t* A; const bf16_t* B;
    unsigned char* ws; unsigned char* wb; const float* bgate; LAS float* red; bool rtab;
};
struct ProbAny {
    const GCfg* c;
    __device__ __forceinline__ void seg(const pg8::Unit& u, pg8::Seg& s) const {
        if (c->mode == 1 && u.seg >= 3) {
            const int br = u.seg - 3; const bf16_t* O = (const bf16_t*)(c->ws + WS_QA + (size_t)br * (48 * MiB)); const bf16_t* Wp = (const bf16_t*)(c->wb + (WS_WP - WS_WIN));
            s.A = (const char*)(O + (size_t)u.pm * 256 * BW); s.B = (const char*)(Wp + ((size_t)br * DM + (size_t)u.pn * 256) * BW);
            s.hA = 128u * BW * 2u; s.hB = 128u * BW * 2u; s.lda = BW; s.ldb = BW; s.nt = BW / 64;
        } else {
            const int so = (c->mode == 1) ? u.seg * DM : 0;
            s.A = (c->mode == 2 && c->toA) ? (const char*)(c->ws + act_tile_off(u.pm)) : (const char*)(c->A + (size_t)u.pm * 256 * c->lda); s.B = (const char*)(c->B + ((size_t)so + (size_t)u.pn * 256) * c->ldb);
            s.hA = 128u * (unsigned)c->lda * 2u; s.hB = 128u * (unsigned)c->ldb * 2u; s.lda = c->lda; s.ldb = c->ldb; s.nt = c->nt;
        }
    }
};
struct EpiAny {
    const GCfg* c;
    __device__ __forceinline__ void operator()(EPI_ARGS) const {
        const int m_ = c->mode;
        if (m_ == 0) EpiIn{c->ws, c->rtab, c->red}(acc, u, wr, wc, fr, fq);
        else if (m_ == 1) EpiC1{c->ws, c->bgate, c->rtab, c->red}(acc, u, wr, wc, fr, fq);
        else if (m_ == 2) EpiRes{c->ws, c->toA, c->red}(acc, u, wr, wc, fr, fq);
        else EpiFfn{c->ws, c->rtab, c->red}(acc, u, wr, wc, fr, fq);
    }
};

namespace att {
__device__ __forceinline__ constexpr int crow(int r, int hi) { return (r & 3) + 8 * (r >> 2) + 4 * hi; }
__device__ __forceinline__ float swap_lo(float x, float& hiv) { auto rr = __builtin_amdgcn_permlane32_swap(__float_as_uint(x), __float_as_uint(x), false, false); hiv = __uint_as_float(rr[1]); return __uint_as_float(rr[0]); }
__device__ __forceinline__ s16x4 vtr(const LAS unsigned char* p) { return __builtin_bit_cast(s16x4, __builtin_amdgcn_ds_read_tr16_b64_v4i16((LAS s16x4*)p)); }
__device__ __forceinline__ void load_k(bf16x8 (&kf)[8], const bf16_t* Kh, int j0, int r32, int hi) {
    const bf16_t* p = Kh + (size_t)(j0 >> 5) * 2048 + hi * 256 + r32 * 8;
#pragma unroll
    for (int d0 = 0; d0 < 4; ++d0) { kf[2 * d0] = *(const bf16x8*)(p + d0 * 512); kf[2 * d0 + 1] = *(const bf16x8*)(p + 2048 + d0 * 512); }
}
__device__ __forceinline__ void dma_v(LAS unsigned char* vbuf, const bf16_t* Vh, int j0, int lane) {
    const bf16_t* p = Vh + (size_t)(j0 >> 6) * 4096 + lane * 8;
#pragma unroll
    for (int i = 0; i < 8; ++i) __builtin_amdgcn_global_load_lds((const unsigned*)(p + i * 512), (LAS unsigned*)(vbuf + i * 1024), 16, 0, 0);
}
__device__ __forceinline__ void load_v(u32x4 (&vv)[8], const bf16_t* Vh, int j0, int lane) {
    const bf16_t* p = Vh + (size_t)(j0 + (lane >> 3)) * BW + (lane & 7) * 8;
#pragma unroll
    for (int i = 0; i < 8; ++i) vv[i] = *(const u32x4*)(p + (size_t)(8 * i) * BW);
}
__device__ __forceinline__ void stage_v(LAS unsigned char* vst, const u32x4 (&vv)[8], int lane) {
    const int c = lane & 7;
#pragma unroll
    for (int i = 0; i < 8; ++i) { const int key = 8 * i + (lane >> 3);
        *(LAS u32x4*)(vst + ((c >> 2) * 4 + (key >> 4)) * 1024 + (key & 15) * 64 + (c & 3) * 16) = vv[i]; }
}
__device__ __forceinline__ void qk(f32x16& p0, f32x16& p1, const bf16x8 (&kf)[8], const bf16x8 (&qr)[4]) {
#pragma unroll
    for (int d0 = 0; d0 < 4; ++d0) { p0 = __builtin_amdgcn_mfma_f32_32x32x16_bf16(kf[2 * d0], qr[d0], p0, 0, 0, 0); p1 = __builtin_amdgcn_mfma_f32_32x32x16_bf16(kf[2 * d0 + 1], qr[d0], p1, 0, 0, 0); }
}
__device__ __forceinline__ void pv(f32x16& o0, f32x16& o1, const f32x16& p0, const f32x16& p1, const LAS unsigned char* vst, int lane) {
    const int hi = lane >> 5;
    const LAS unsigned char* vp = vst + ((lane >> 4) & 1) * 32 + (lane & 3) * 8 + (4 * hi + ((lane & 15) >> 2)) * 64;
    u32x4 pw[4];
    pw[0] = (u32x4){cvt_pk_bf16(p0[0], p0[1]), cvt_pk_bf16(p0[2], p0[3]), cvt_pk_bf16(p0[4], p0[5]), cvt_pk_bf16(p0[6], p0[7])};
    pw[1] = (u32x4){cvt_pk_bf16(p0[8], p0[9]), cvt_pk_bf16(p0[10], p0[11]), cvt_pk_bf16(p0[12], p0[13]), cvt_pk_bf16(p0[14], p0[15])};
    pw[2] = (u32x4){cvt_pk_bf16(p1[0], p1[1]), cvt_pk_bf16(p1[2], p1[3]), cvt_pk_bf16(p1[4], p1[5]), cvt_pk_bf16(p1[6], p1[7])};
    pw[3] = (u32x4){cvt_pk_bf16(p1[8], p1[9]), cvt_pk_bf16(p1[10], p1[11]), cvt_pk_bf16(p1[12], p1[13]), cvt_pk_bf16(p1[14], p1[15])};
    const unsigned va = (unsigned)(size_t)vp;
    s16x4 f[16];
#define VTR_(i_, off_) asm volatile("ds_read_b64_tr_b16 %0, %1 offset:" #off_ : "=v"(f[i_]) : "v"(va) : "memory")
    VTR_(0, 0); VTR_(1, 512); VTR_(2, 4096); VTR_(3, 4608); VTR_(4, 1024); VTR_(5, 1536); VTR_(6, 5120); VTR_(7, 5632);
    VTR_(8, 2048); VTR_(9, 2560); VTR_(10, 6144); VTR_(11, 6656); VTR_(12, 3072); VTR_(13, 3584); VTR_(14, 7168); VTR_(15, 7680);
#undef VTR_
    asm volatile("s_waitcnt lgkmcnt(8)" : "+v"(f[0]), "+v"(f[1]), "+v"(f[2]), "+v"(f[3]), "+v"(f[4]), "+v"(f[5]), "+v"(f[6]), "+v"(f[7]) :: "memory");
#pragma unroll
    for (int ks = 0; ks < 4; ++ks) {
        if (ks == 2) asm volatile("s_waitcnt lgkmcnt(0)" : "+v"(f[8]), "+v"(f[9]), "+v"(f[10]), "+v"(f[11]), "+v"(f[12]), "+v"(f[13]), "+v"(f[14]), "+v"(f[15]) :: "memory");
        const s16x4 a0 = f[4 * ks], a1 = f[4 * ks + 1], b0 = f[4 * ks + 2], b1 = f[4 * ks + 3];
        const bf16x8 v0 = {a0[0], a0[1], a0[2], a0[3], a1[0], a1[1], a1[2], a1[3]}, v1 = {b0[0], b0[1], b0[2], b0[3], b1[0], b1[1], b1[2], b1[3]};
        const bf16x8 pa = __builtin_bit_cast(bf16x8, pw[ks]);
        o0 = __builtin_amdgcn_mfma_f32_32x32x16_bf16(pa, v0, o0, 0, 0, 0);
        o1 = __builtin_amdgcn_mfma_f32_32x32x16_bf16(pa, v1, o1, 0, 0, 0);
    }
}
__device__ __forceinline__ void store_o(bf16_t* Ow, const f32x16& o0, const f32x16& o1, const float (&rsc)[16], LAS unsigned char* stg, int lane) {
    const int r32 = lane & 31, hi = lane >> 5;
    LAS bf16_t* s = (LAS bf16_t*)stg;
#pragma unroll
    for (int r = 0; r < 16; ++r) { const int orow = crow(r, hi);
        s[orow * 64 + r32] = (bf16_t)(cvt_pk_bf16(o0[r] * rsc[r], 0.f) & 0xffffu); s[orow * 64 + 32 + r32] = (bf16_t)(cvt_pk_bf16(o1[r] * rsc[r], 0.f) & 0xffffu); }
    LDS_WAIT();
#pragma unroll
    for (int i = 0; i < 4; ++i) { const int row = i * 8 + (lane >> 3), ch = lane & 7; const u32x4 v = *(const LAS u32x4*)(stg + row * 128 + ch * 16); *(u32x4*)(Ow + (size_t)row * BW + ch * 8) = v; }
    LDS_WAIT();
}

__device__ __forceinline__ void sb_item(bf16_t* Q, const bf16_t* K, const bf16_t* V, int b, int h, int q0, LAS unsigned char* vst, int lane) {
    asm volatile("" : "+v"(lane));
    const int r32 = lane & 31, hi = lane >> 5;
    const size_t rowbase = (size_t)b * SEQ;
    bf16_t* Qw = Q + (rowbase + q0) * BW + h * HD;
    bf16x8 qr[4];
#pragma unroll
    for (int d0 = 0; d0 < 4; ++d0) qr[d0] = *(const bf16x8*)(Qw + (size_t)r32 * BW + d0 * 16 + hi * 8);
    const bf16_t* Kh = K + (size_t)(b * NH + h) * SEQ * HD; const bf16_t* Vh = V + (size_t)(b * NH + h) * SEQ * HD;
    f32x16 o0 = {}, o1 = {}; float A2 = 0.f;
    const int tq = q0 + r32;
    bf16x8 kf[8]; load_k(kf, Kh, ((q0 + 30) >> 6) * 64, r32, hi); dma_v(vst + (((q0 + 30) >> 6) & 1) * 8192, Vh, ((q0 + 30) >> 6) * 64, lane);
    for (int kt = (q0 + 30) >> 6; kt >= 0; --kt) {
        const int j0 = kt * 64;
        f32x16 p0 = {}, p1 = {};
        asm volatile("s_waitcnt vmcnt(0)" ::: "memory");
        qk(p0, p1, kf, qr);
        asm volatile("" : "+v"(p0), "+v"(p1) :: "memory");
        LAS unsigned char* vcur = vst + (kt & 1) * 8192;
        if (kt > 0) { dma_v(vst + ((kt - 1) & 1) * 8192, Vh, j0 - 64, lane); load_k(kf, Kh, j0 - 64, r32, hi); }
        const bool diag = (j0 + 63 >= q0);
        f32x16 l0, l1;
#pragma unroll
        for (int r = 0; r < 16; ++r) {
            { const float z = p0[r]; const float t = __builtin_amdgcn_exp2f(-__builtin_fabsf(z)); float l = -(__builtin_fmaxf(z, 0.f) + __builtin_amdgcn_logf(1.0f + t)); if (diag && (j0 + crow(r, hi) >= tq)) l = 0.f; l0[r] = l; }
            { const float z = p1[r]; const float t = __builtin_amdgcn_exp2f(-__builtin_fabsf(z)); float l = -(__builtin_fmaxf(z, 0.f) + __builtin_amdgcn_logf(1.0f + t)); if (diag && (j0 + 32 + crow(r, hi) >= tq)) l = 0.f; l1[r] = l; }
        }
        float carry = A2;
#pragma unroll
        for (int half = 1; half >= 0; --half) {
            f32x16& l = half ? l1 : l0; f32x16& p = half ? p1 : p0;
            float T[4];
#pragma unroll
            for (int g = 0; g < 4; ++g) { l[4 * g + 2] += l[4 * g + 3]; l[4 * g + 1] += l[4 * g + 2]; l[4 * g] += l[4 * g + 1]; T[g] = l[4 * g]; }
            float Tl[4], Th[4];
#pragma unroll
            for (int g = 0; g < 4; ++g) Tl[g] = swap_lo(T[g], Th[g]);
            float E = carry;
#pragma unroll
            for (int g = 3; g >= 0; --g) { const float eh = E; E += Th[g]; const float el = E; E += Tl[g]; const float off = hi ? eh : el;
                l[4 * g] += off; l[4 * g + 1] += off; l[4 * g + 2] += off; l[4 * g + 3] += off; }
            carry = E;
#pragma unroll
            for (int r = 0; r < 16; ++r) { float w = __builtin_amdgcn_exp2f(p[r] + l[r]); if (diag && (j0 + 32 * half + crow(r, hi) >= tq)) w = 0.f; p[r] = w; }
        }
        A2 = carry;

        pv(o0, o1, p0, p1, vcur, lane);
        LDS_WAIT();
        if (__all(A2 < -126.5f)) break;
    }
    float one[16];
#pragma unroll
    for (int r = 0; r < 16; ++r) one[r] = 1.0f;
    asm volatile("s_waitcnt vmcnt(0)" ::: "memory");
    store_o(Qw, o0, o1, one, vst, lane);
}

constexpr float MOBA_THR = 8.0f;
__device__ __forceinline__ void gate_load(bf16x8 (&qr)[4], bf16x8 (&kr)[4], const bf16_t* Qw, const bf16_t* Kown, int tq0, int lane) {
    asm volatile("" : "+v"(lane));
    const int r32 = lane & 31, hi = lane >> 5;
    const bf16_t* Qrow = Qw + (size_t)r32 * BW + hi * 8;
    const int tk = tq0 + r32; const bf16_t* kp = Kown + (size_t)(tk >> 5) * 2048 + hi * 256 + (tk & 31) * 8;
#pragma unroll
    for (int d0 = 0; d0 < 4; ++d0) { qr[d0] = *(const bf16x8*)(Qrow + d0 * 16); kr[d0] = *(const bf16x8*)(kp + d0 * 512); }
}
__device__ __forceinline__ unsigned moba_gate(const bf16x8 (&qr)[4], const bf16x8 (&kr)[4], int blk, int tq0, float sl2, const LAS float* km, const LAS float* kbn, int lane) {
    asm volatile("" : "+v"(lane));
    const int r32 = lane & 31, hi = lane >> 5;
    unsigned sel = 0u;
    if (blk > 0) {
        f32x16 p = {};
#pragma unroll
        for (int d0 = 0; d0 < 4; ++d0) { const LAS f32x4* kmr = (const LAS f32x4*)(km + r32 * 64); const int c0 = d0 * 4 + hi * 2; const f32x4 a = kmr[c0 ^ (r32 & 15)], c = kmr[(c0 + 1) ^ (r32 & 15)];
            const u32x4 h = {cvt_pk_bf16(a[0], a[1]), cvt_pk_bf16(a[2], a[3]), cvt_pk_bf16(c[0], c[1]), cvt_pk_bf16(c[2], c[3])};
            const u32x4 l = {cvt_pk_bf16(a[0] - bf_lo(h.x), a[1] - bf_hi(h.x)), cvt_pk_bf16(a[2] - bf_lo(h.y), a[3] - bf_hi(h.y)), cvt_pk_bf16(c[0] - bf_lo(h.z), c[1] - bf_hi(h.z)), cvt_pk_bf16(c[2] - bf_lo(h.w), c[3] - bf_hi(h.w))};
            p = __builtin_amdgcn_mfma_f32_32x32x16_bf16(__builtin_bit_cast(bf16x8, l), qr[d0], p, 0, 0, 0);
            p = __builtin_amdgcn_mfma_f32_32x32x16_bf16(__builtin_bit_cast(bf16x8, h), qr[d0], p, 0, 0, 0); }
        float v1 = -INFINITY, v2 = -INFINITY, v3 = -INFINITY; int i1 = -1, i2 = -1, i3 = -1;
#define TOP_INS(v, n) do { const bool b1 = (v) > v1 || ((v) == v1 && (n) < i1), b2 = (v) > v2 || ((v) == v2 && (n) < i2), b3 = (v) > v3 || ((v) == v3 && (n) < i3); \
            if (b3) { if (b2) { v3 = v2; i3 = i2; if (b1) { v2 = v1; i2 = i1; v1 = (v); i1 = (n); } else { v2 = (v); i2 = (n); } } else { v3 = (v); i3 = (n); } } } while (0)
#pragma unroll
#define TOP_INS_UP(v, n) do { const bool b1 = (v) > v1, b2 = (v) > v2, b3 = (v) > v3; \
            if (b3) { if (b2) { v3 = v2; i3 = i2; if (b1) { v2 = v1; i2 = i1; v1 = (v); i1 = (n); } else { v2 = (v); i2 = (n); } } else { v3 = (v); i3 = (n); } } } while (0)
        for (int r = 0; r < 16; ++r) { const int n = crow(r, 0) + 4 * hi; const float d = p[r]; if (n < blk) TOP_INS_UP(d, n); }
#undef TOP_INS_UP
        { float x0, x1; x0 = swap_lo(v1, x1); const float pv1 = hi ? x0 : x1; x0 = swap_lo(v2, x1); const float pv2 = hi ? x0 : x1; x0 = swap_lo(v3, x1); const float pv3 = hi ? x0 : x1;
          x0 = swap_lo(__int_as_float(i1), x1); const int pi1 = __float_as_int(hi ? x0 : x1); x0 = swap_lo(__int_as_float(i2), x1); const int pi2 = __float_as_int(hi ? x0 : x1); x0 = swap_lo(__int_as_float(i3), x1); const int pi3 = __float_as_int(hi ? x0 : x1);
          TOP_INS(pv1, pi1); TOP_INS(pv2, pi2); TOP_INS(pv3, pi3); }
#undef TOP_INS
        float qn2 = 0.f, zs = 0.f;
#pragma unroll
        for (int d0 = 0; d0 < 4; ++d0) { const u32x4 q = __builtin_bit_cast(u32x4, qr[d0]), x = __builtin_bit_cast(u32x4, kr[d0]);
            const float q0 = bf_lo(q.x), q1 = bf_hi(q.x), q2 = bf_lo(q.y), q3 = bf_hi(q.y), q4 = bf_lo(q.z), q5 = bf_hi(q.z), q6 = bf_lo(q.w), q7 = bf_hi(q.w);
            zs += q0 * bf_lo(x.x) + q1 * bf_hi(x.x) + q2 * bf_lo(x.y) + q3 * bf_hi(x.y) + q4 * bf_lo(x.z) + q5 * bf_hi(x.z) + q6 * bf_lo(x.w) + q7 * bf_hi(x.w);
            qn2 += (q0 * q0 + q1 * q1) + (q2 * q2 + q3 * q3) + (q4 * q4 + q5 * q5) + (q6 * q6 + q7 * q7); }
        { float x1; float x0 = swap_lo(zs, x1); zs = x0 + x1; x0 = swap_lo(qn2, x1); qn2 = x0 + x1; }
        const float qn = sqrtf(qn2) * 1.001f, thr = zs - 127.5f; const int tq = tq0 + r32;
#define KEEP(i_) ((i_) >= 0 && !(qn * kbn[(i_)] - sl2 * (float)(tq - (256 * (i_) + 255)) < thr))
        if (KEEP(i1)) sel |= 1u << i1; if (KEEP(i2)) sel |= 1u << i2; if (KEEP(i3)) sel |= 1u << i3;
#undef KEEP
    }
    return sel;
}
__device__ __forceinline__ void moba_tile(f32x16& o0, f32x16& o1, float& mrow, float& lsum, const bf16x8 (&qr)[4], bf16x8 (&kf)[8], const bf16_t* Kh, const bf16_t* Vh, int j0, int jn, float lb, float sl2, bool diag, int tq,
                                          LAS unsigned char* vst, LAS float* wsf, int lane, const float (&bv)[16]) {
    const int r32 = lane & 31, hi = lane >> 5;
    const float mref = (mrow == -INFINITY) ? 0.f : mrow; const float i0 = lb - mref, i1 = i0 + 32.0f * sl2;
    f32x16 p0, p1;
#pragma unroll
    for (int r = 0; r < 16; ++r) { p0[r] = i0 + bv[r]; p1[r] = i1 + bv[r]; }
    asm volatile("s_waitcnt vmcnt(0)" ::: "memory");
    qk(p0, p1, kf, qr);
    asm volatile("" : "+v"(p0), "+v"(p1) :: "memory");
    LAS unsigned char* vcur = vst + ((j0 >> 6) & 1) * 8192;
    if (jn >= 0) { dma_v(vst + ((jn >> 6) & 1) * 8192, Vh, jn, lane); load_k(kf, Kh, jn, r32, hi); }
    if (diag) {
#pragma unroll
        for (int r = 0; r < 16; ++r) { if (j0 + crow(r, hi) > tq) p0[r] = -INFINITY; if (j0 + 32 + crow(r, hi) > tq) p1[r] = -INFINITY; }
    }
    float rm = __builtin_fmaxf(p0[0], p1[0]);
#pragma unroll
    for (int r = 1; r < 16; ++r) rm = __builtin_fmaxf(rm, __builtin_fmaxf(p0[r], p1[r]));
    { float x1; const float x0 = swap_lo(rm, x1); rm = __builtin_fmaxf(x0, x1); }
    rm += mref;
    if (__any(rm > mrow + MOBA_THR)) {
        const float mn = __builtin_fmaxf(mrow, rm); const float f = __builtin_amdgcn_exp2f(mrow - mn), dsh = mn - mref; mrow = mn; lsum *= f;
        if (hi == 0) wsf[r32] = f;
        LDS_WAIT();
#pragma unroll
        for (int r = 0; r < 16; ++r) { const float fr_ = wsf[crow(r, hi)]; o0[r] *= fr_; o1[r] *= fr_; p0[r] -= dsh; p1[r] -= dsh; }
        LDS_WAIT();
    }
    f32x2 ps2 = {0.f, 0.f};
#pragma unroll
    for (int r = 0; r < 16; r += 2) { p0[r] = __builtin_amdgcn_exp2f(p0[r]); p0[r + 1] = __builtin_amdgcn_exp2f(p0[r + 1]); p1[r] = __builtin_amdgcn_exp2f(p1[r]); p1[r + 1] = __builtin_amdgcn_exp2f(p1[r + 1]);
        ps2 += (f32x2){p0[r], p0[r + 1]}; ps2 += (f32x2){p1[r], p1[r + 1]}; }
    lsum += ps2.x + ps2.y;

    pv(o0, o1, p0, p1, vcur, lane);
    LDS_WAIT();
}
__device__ __forceinline__ void moba_item(const bf16_t* Q, const bf16_t* K, const bf16_t* V, int b, int h, int blk, int n, int tix, const LAS unsigned char* lists, const LAS unsigned* cnt,
                                          const LAS unsigned* selm, unsigned char* recO, float* recML, LAS unsigned char* vst, LAS float* wsf, LAS unsigned* trow, int lane) {
    asm volatile("" : "+v"(lane));
    const int r32 = lane & 31, hi = lane >> 5; const size_t rowbase = (size_t)b * SEQ; const bool own = (n == blk);
    const bf16_t* Kh = K + (size_t)(b * NH + h) * SEQ * HD; const bf16_t* Vh = V + (size_t)(b * NH + h) * SEQ * HD;
    bf16x8 kf[8]; load_k(kf, Kh, n * 256, r32, hi); dma_v(vst + ((n * 4) & 1) * 8192, Vh, n * 256, lane);
    int q; bool valid; unsigned slot;
    if (own) { q = 32 * tix + r32; valid = true; slot = (unsigned)q * 4u + 3u; }
    else { const int cn = (int)cnt[n]; const int p = 32 * tix + r32; valid = p < cn; q = (int)lists[n * 256 + (valid ? p : cn - 1)];
           slot = (unsigned)q * 4u + (unsigned)__builtin_popcount(selm[q] & ((1u << n) - 1u)); }
    if (hi == 0) trow[r32] = slot | (valid ? 0x80000000u : 0u);
    const int tq = blk * 256 + q;
    const bf16_t* Qrow = Q + (rowbase + tq) * BW + h * HD + hi * 8;
    bf16x8 qr[4];
#pragma unroll
    for (int d0 = 0; d0 < 4; ++d0) qr[d0] = *(const bf16x8*)(Qrow + d0 * 16);
    const float sl2 = __builtin_amdgcn_exp2f(-(float)(h + 1)) * LOG2E;
    f32x16 o0 = {}, o1 = {}; float mrow = -INFINITY, lsum = 0.f;
    float bv[16];
#pragma unroll
    for (int r = 0; r < 16; ++r) bv[r] = sl2 * (float)crow(r, 0);
    const int ntile = own ? (tix >> 1) + 1 : 4;
#pragma unroll 1
    for (int i = 0; i < ntile; ++i) { const int j0 = n * 256 + i * 64;
        moba_tile(o0, o1, mrow, lsum, qr, kf, Kh, Vh, j0, i < ntile - 1 ? j0 + 64 : -1, sl2 * (float)(j0 + 4 * hi - tq), sl2, own && i == ntile - 1, tq, vst, wsf, lane, bv); }
    { float x1; const float x0 = swap_lo(lsum, x1); lsum = x0 + x1; }
    if (hi == 0) { wsf[32 + r32] = lsum; if (valid) *(f32x2*)(recML + 2 * slot) = (f32x2){mrow, lsum}; }
    LDS_WAIT();
    LAS bf16_t* s = (LAS bf16_t*)vst;
#pragma unroll
    for (int r = 0; r < 16; ++r) { const int orow = crow(r, hi); const float rl = __builtin_amdgcn_rcpf(wsf[32 + orow]);
        s[orow * 64 + r32] = (bf16_t)(cvt_pk_bf16(o0[r] * rl, 0.f) & 0xffffu); s[orow * 64 + 32 + r32] = (bf16_t)(cvt_pk_bf16(o1[r] * rl, 0.f) & 0xffffu); }
    LDS_WAIT();
#pragma unroll
    for (int i = 0; i < 4; ++i) { const int row = i * 8 + (lane >> 3), ch = lane & 7; const unsigned tr = trow[row]; const u32x4 v = *(const LAS u32x4*)(vst + row * 128 + ch * 16);
        if (tr & 0x80000000u) *(u32x4*)(recO + (size_t)(tr & 0x7fffffffu) * 128 + ch * 16) = v; }
    LDS_WAIT();
}
__device__ __forceinline__ void moba_merge(bf16_t* Q, int b, int h, int blk, int w, const LAS unsigned* selm, const unsigned char* recO, const float* recML, LAS float* wsf, int lane) {
    asm volatile("" : "+v"(lane));
    const int r32 = lane & 31, hi = lane >> 5; const size_t rowbase = (size_t)b * SEQ; const int q0 = blk * 256 + w * 32;
    const int ql = w * 32 + r32; const int c = __builtin_popcount(selm[ql]);
    f32x2 ml[4];
#pragma unroll
    for (int k = 0; k < 4; ++k) ml[k] = __builtin_nontemporal_load((const f32x2*)(recML + 2 * ((unsigned)ql * 4u + k)));
    u32x4 pw[4][4];
#pragma unroll
    for (int i = 0; i < 4; ++i)
#pragma unroll
        for (int k = 0; k < 4; ++k) pw[i][k] = __builtin_nontemporal_load((const u32x4*)(recO + (size_t)((unsigned)(w * 32 + i * 8 + (lane >> 3)) * 4u + k) * 128 + (lane & 7) * 16));
    float mi[4], li[4]; float mx = -INFINITY;
#pragma unroll
    for (int k = 0; k < 4; ++k) { const bool used = (k == 3 || k < c); mi[k] = used ? ml[k].x : -INFINITY; li[k] = used ? ml[k].y : 0.f; mx = __builtin_fmaxf(mx, mi[k]); }
    float wg[4], L = 0.f;
#pragma unroll
    for (int k = 0; k < 4; ++k) { wg[k] = (k == 3 || k < c) ? __builtin_amdgcn_exp2f(mi[k] - mx) * li[k] : 0.f; L += wg[k]; }
    const float rL = 1.0f / L;
    if (hi == 0) { wsf[r32] = wg[0] * rL; wsf[32 + r32] = wg[1] * rL; wsf[64 + r32] = wg[2] * rL; wsf[96 + r32] = wg[3] * rL; }
    LDS_WAIT();
    bf16_t* Qw = Q + (rowbase + q0) * BW + h * HD;
    float akk[4][4];
#pragma unroll
    for (int i = 0; i < 4; ++i)
#pragma unroll
        for (int k = 0; k < 4; ++k) akk[i][k] = wsf[32 * k + i * 8 + (lane >> 3)];
#pragma unroll
    for (int i = 0; i < 4; ++i) { const int row = i * 8 + (lane >> 3), ch = lane & 7; f32x4 v0 = {0.f, 0.f, 0.f, 0.f}, v1 = {0.f, 0.f, 0.f, 0.f};
#pragma unroll
        for (int k = 0; k < 4; ++k) { const float ak = akk[i][k];
            if (ak != 0.f) { const u32x4 p = pw[i][k];
                v0 += ak * (f32x4){bf_lo(p.x), bf_hi(p.x), bf_lo(p.y), bf_hi(p.y)}; v1 += ak * (f32x4){bf_lo(p.z), bf_hi(p.z), bf_lo(p.w), bf_hi(p.w)}; } }
        st_bf16x8(Qw + (size_t)row * BW + ch * 8, v0, v1); }
    LDS_WAIT();
}
}

#define XB_TMO      128
#define XB_MAPBAD   192
#define XB_MAPTAB   200
#define XB_XCNT(j)  (256  + 64 * (j))
#define XB_XSUB(j)  (1280 + 64 * (j))
#define XB_XGEN(j)  (2304 + 64 * (j))
#define XB_TOP      3328
#define XB_TOPGEN   3392
#define XCD_BAR_WORDS 3456
#define XB_SPIN_CAP (1u << 18)
__device__ __forceinline__ unsigned xb_ld(unsigned* p)              { return __hip_atomic_load(p, __ATOMIC_RELAXED, __HIP_MEMORY_SCOPE_AGENT); }
__device__ __forceinline__ unsigned xb_add(unsigned* p, unsigned v) { return __hip_atomic_fetch_add(p, v, __ATOMIC_RELAXED, __HIP_MEMORY_SCOPE_AGENT); }
__device__ __forceinline__ unsigned xb_xcc_id() { return (unsigned)__builtin_amdgcn_s_getreg((3 << 11) | 20) & 0xFu; }
#define XB_SPIN(cond, bar) do { unsigned _sp = 0; while (cond) { __builtin_amdgcn_s_sleep(1); \
    if ((++_sp & 255u) == 0u) { if (xb_ld(&(bar)[XB_TMO])) break; if (_sp > XB_SPIN_CAP) { atomicAdd(&(bar)[XB_TMO], 1u); break; } } } } while (0)
struct XcdBarrier { unsigned* bar; unsigned x; volatile LAS unsigned* st; };
__device__ __forceinline__ XcdBarrier xcd_barrier_post(unsigned* bar, volatile LAS unsigned* st) {
    XcdBarrier b; b.bar = bar; b.x = xb_xcc_id(); b.st = st;
    if (threadIdx.x == 0) { (void)xb_add(&bar[XB_XCNT(b.x)], 1u);
        if ((gridDim.x & 7u) != 0u) atomicOr(&bar[XB_MAPBAD], 1u);
        else { const unsigned prev = atomicCAS(&bar[XB_MAPTAB + (blockIdx.x & 7u)], 0u, b.x + 1u); if (prev != 0u && prev != b.x + 1u) atomicOr(&bar[XB_MAPBAD], 1u); } }
    return b;
}
__device__ __forceinline__ void xcd_barrier_complete(unsigned* bar, unsigned x, unsigned& nloc, unsigned& nx) {
    const unsigned G = gridDim.x * gridDim.y * gridDim.z;
    unsigned sum, cnt, mine, sp = 0u;
    for (;;) {
        sum = 0u; cnt = 0u; mine = 0u;
#pragma unroll
        for (unsigned j = 0; j < 16; ++j) { const unsigned c = xb_ld(&bar[XB_XCNT(j)]); sum += c; cnt += (c > 0u) ? 1u : 0u; mine = (j == x) ? c : mine; }
        if (sum == G) break;
        __builtin_amdgcn_s_sleep(1);
        if ((++sp & 255u) == 0u) { if (xb_ld(&bar[XB_TMO])) break; if (sp > XB_SPIN_CAP) { atomicAdd(&bar[XB_TMO], 1u); break; } }
    }
    nloc = mine > 0u ? mine : 1u; nx = cnt > 0u ? cnt : 1u;
}
__device__ __forceinline__ void xcd_barrier(const XcdBarrier& b, int tid_, bool xcd_only) {
    asm volatile("s_waitcnt vmcnt(0)" ::: "memory");
    __syncthreads();
    if (tid_ == 0) {
        unsigned* bar = b.bar;
        __builtin_amdgcn_s_waitcnt(0);
        unsigned nloc = b.st[0], nx = b.st[1];
        if (nloc == 0u) { xcd_barrier_complete(bar, b.x, nloc, nx); b.st[0] = nloc; b.st[1] = nx; }
        const unsigned old = xb_add(&bar[XB_XSUB(b.x)], 1u);
        const unsigned gen = old / nloc;
        if (old + 1u == (gen + 1u) * nloc) {
            if (!xcd_only) {
                __builtin_amdgcn_fence(__ATOMIC_RELEASE, "agent"); asm volatile("s_waitcnt vmcnt(0)" ::: "memory");
                const unsigned og = xb_add(&bar[XB_TOP], 1u);
                const unsigned tg = og / nx;
                asm volatile("buffer_inv sc1" ::: "memory");
                if (og + 1u == (tg + 1u) * nx) xb_add(&bar[XB_TOPGEN], 1u);
                else XB_SPIN(xb_ld(&bar[XB_TOPGEN]) == tg, bar);
            } else asm volatile("buffer_inv sc1" ::: "memory");
            xb_add(&bar[XB_XGEN(b.x)], 1u);
            asm volatile("s_waitcnt vmcnt(0)" ::: "memory");
        } else {
            asm volatile("buffer_inv sc1" ::: "memory");
            XB_SPIN(xb_ld(&bar[XB_XGEN(b.x)]) == gen, bar);
            asm volatile("s_waitcnt vmcnt(0)" ::: "memory");
        }
    }
    __syncthreads();
}

__device__ __forceinline__ float wave_sum(float v) {
#pragma unroll
    for (int o = 1; o < 64; o <<= 1) v += __shfl_xor(v, o);
    return v;
}
struct TrD { const float* src; const float* gain; bf16_t* dst; int ldw, ldt; };
__device__ __forceinline__ void tr_load(const TrD& d, f32x4 (&v)[8], float (&g)[8], int lane) {
    const int c4 = lane & 7, r0 = lane >> 3;
#pragma unroll
    for (int i = 0; i < 8; ++i) { const int row = 8 * i + r0; v[i] = __builtin_nontemporal_load((const GAS f32x4*)((const GAS float*)d.src + (size_t)row * d.ldw + 4 * c4)); g[i] = d.gain ? ((const GAS float*)d.gain)[row] : 1.0f; }
}
__device__ __forceinline__ void tr_store(const TrD& d, const f32x4 (&v)[8], const float (&g)[8], LAS float* scr, int lane) {
    const int c4 = lane & 7, r0 = lane >> 3;
#pragma unroll
    for (int i = 0; i < 8; ++i) { LAS float* s = scr + (8 * i + r0) * 33 + 4 * c4; s[0] = v[i][0] * g[i]; s[1] = v[i][1] * g[i]; s[2] = v[i][2] * g[i]; s[3] = v[i][3] * g[i]; }
    LDS_WAIT(); asm volatile("" ::: "memory");
    const int c = lane & 7;
#pragma unroll
    for (int j = 0; j < 4; ++j) { const int n = (lane >> 3) + 8 * j; const LAS float* s = scr + (8 * c) * 33 + n;
        u32x4 o; o.x = cvt_pk_bf16(s[0 * 33], s[1 * 33]); o.y = cvt_pk_bf16(s[2 * 33], s[3 * 33]); o.z = cvt_pk_bf16(s[4 * 33], s[5 * 33]); o.w = cvt_pk_bf16(s[6 * 33], s[7 * 33]);
        *(GAS u32x4*)((GAS bf16_t*)d.dst + (size_t)n * d.ldt + 8 * c) = o; }
    LDS_WAIT(); asm volatile("" ::: "memory");
}
constexpr int I_IN = (DM / 64) * (NIN / 32), I_P = (BW / 64) * (DM / 32), I_O = (DM / 64) * (DM / 32), I_G = (DM / 64) * (DFF / 32), I_D = (DFF / 64) * (DM / 32);
constexpr int NITEMS = I_IN + 3 * I_P + I_O + 2 * I_G + I_D;
struct Args { const float* in[14]; float* out; unsigned char* ws; };
__device__ __forceinline__ void tr_decode(int it, TrD& d, const Args& A, int layer, unsigned char* wb) {
    int r = it;
    if (r < I_IN) { const int nblk = NIN / 32, kb = r / nblk, c0 = 32 * (r % nblk); size_t doff;
        if (c0 < 3072) doff = (size_t)c0 * DM * 2;
        else if (c0 < 3584) doff = (size_t)(3072 + 256 * ((c0 - 3072) >> 7) + ((c0 - 3072) & 127)) * DM * 2;
        else if (c0 < 4096) doff = (size_t)(4096 + (c0 - 3584)) * DM * 2;
        else if (c0 < 4608) doff = (size_t)(3072 + 256 * ((c0 - 4096) >> 7) + 128 + ((c0 - 4096) & 127)) * DM * 2;
        else doff = (WS_WG - WS_WIN) + (size_t)(c0 - 4608) * DM * 2;
        d.src = A.in[2] + (size_t)layer * DM * NIN + (size_t)(64 * kb) * NIN + c0; d.gain = A.in[1] + (size_t)layer * DM + 64 * kb; d.dst = (bf16_t*)(wb + doff) + 64 * kb; d.ldw = NIN; d.ldt = DM; return; }
    r -= I_IN;
    if (r < I_P) { const int nblk = DM / 32, kb = r / nblk, c0 = 32 * (r % nblk);
        d.src = A.in[5] + (size_t)layer * BW * DM + (size_t)(64 * kb) * DM + c0; d.gain = nullptr; d.dst = (bf16_t*)(wb + (WS_WP - WS_WIN)) + (size_t)c0 * BW + 64 * kb; d.ldw = DM; d.ldt = BW; return; }
    r -= I_P;
    if (r < I_P) { const int nblk = DM / 32, kb = r / nblk, c0 = 32 * (r % nblk);
        d.src = A.in[6] + (size_t)layer * BW * DM + (size_t)(64 * kb) * DM + c0; d.gain = nullptr; d.dst = (bf16_t*)(wb + (WS_WP - WS_WIN)) + (size_t)DM * BW + (size_t)c0 * BW + 64 * kb; d.ldw = DM; d.ldt = BW; return; }
    r -= I_P;
    if (r < I_P) { const int nblk = DM / 32, kb = r / nblk, c0 = 32 * (r % nblk);
        d.src = A.in[7] + (size_t)layer * BW * DM + (size_t)(64 * kb) * DM + c0; d.gain = nullptr; d.dst = (bf16_t*)(wb + (WS_WP - WS_WIN)) + (size_t)2 * DM * BW + (size_t)c0 * BW + 64 * kb; d.ldw = DM; d.ldt = BW; return; }
    r -= I_P;
    if (r < I_O) { const int nblk = DM / 32, kb = r / nblk, c0 = 32 * (r % nblk);
        d.src = A.in[8] + (size_t)layer * DM * DM + (size_t)(64 * kb) * DM + c0; d.gain = nullptr; d.dst = (bf16_t*)(wb + (WS_WO - WS_WIN)) + (size_t)c0 * DM + 64 * kb; d.ldw = DM; d.ldt = DM; return; }
    r -= I_O;
    if (r < I_G) { const int nblk = DFF / 32, kb = r / nblk, c0 = 32 * (r % nblk);
        d.src = A.in[10] + (size_t)layer * DM * DFF + (size_t)(64 * kb) * DFF + c0; d.gain = A.in[9] + (size_t)layer * DM + 64 * kb; d.dst = (bf16_t*)(wb + (WS_WGU - WS_WIN)) + (size_t)(256 * (c0 >> 7) + (c0 & 127)) * DM + 64 * kb; d.ldw = DFF; d.ldt = DM; return; }
    r -= I_G;
    if (r < I_G) { const int nblk = DFF / 32, kb = r / nblk, c0 = 32 * (r % nblk);
        d.src = A.in[11] + (size_t)layer * DM * DFF + (size_t)(64 * kb) * DFF + c0; d.gain = A.in[9] + (size_t)layer * DM + 64 * kb; d.dst = (bf16_t*)(wb + (WS_WGU - WS_WIN)) + (size_t)(256 * (c0 >> 7) + 128 + (c0 & 127)) * DM + 64 * kb; d.ldw = DFF; d.ldt = DM; return; }
    r -= I_G;
    { const int nblk = DM / 32, kb = r / nblk, c0 = 32 * (r % nblk);
      d.src = A.in[12] + (size_t)layer * DFF * DM + (size_t)(64 * kb) * DM + c0; d.gain = nullptr; d.dst = (bf16_t*)(wb + (WS_WD - WS_WIN)) + (size_t)c0 * DFF + 64 * kb; d.ldw = DM; d.ldt = DFF; }
}


__global__ void __launch_bounds__(NWAVES * 64, 2) hybrid_fwd(Args args) {
    extern __shared__ __attribute__((aligned(16))) unsigned char lds_raw[];
    LAS unsigned char* lds = (LAS unsigned char*)lds_raw;
    volatile LAS unsigned* MISC = (volatile LAS unsigned*)(lds + MISC_OFF);
    const int wave = __builtin_amdgcn_readfirstlane((int)threadIdx.x >> 6);
    const int G = gridDim.x, bx = blockIdx.x, vcu = (G % 8 == 0) ? (bx % 8) * (G / 8) + bx / 8 : bx;
    for (int i = threadIdx.x; i < (LDS_BYTES - LDSCTL_OFF) / 4; i += NWAVES * 64) ((LAS unsigned*)(lds + LDSCTL_OFF))[i] = 0u;
    __syncthreads();
    XcdBarrier bar = xcd_barrier_post((unsigned*)(args.ws + WS_CTL) + CW_BAR, MISC + 8);
    const int gw = vcu * NWAVES + wave, NGW = G * NWAVES;
    bool mapok = false;

    for (int pq = 0; pq < DEPTH * 7 + 1; ++pq) {
        const int layer = pq / 7, ph = pq - 7 * layer;
        int tid = wave * 64 + lane_id(); asm volatile("" : "+v"(tid)); const int lane = tid & 63;
        size_t opq = 0; asm volatile("" : "+s"(opq));
        unsigned char* ws = args.ws + opq; const float* x_in = args.in[0] + opq; float* out = args.out + opq;
        float* ssA = (float*)(ws + WS_SSA); float* ssB = (float*)(ws + WS_SSB); float* kmp = (float*)(ws + WS_KM);
        bf16_t* xb = (bf16_t*)(ws + WS_XB);
        bf16_t* QA = (bf16_t*)(ws + WS_QA); bf16_t* KA = (bf16_t*)(ws + WS_KA); bf16_t* VA = (bf16_t*)(ws + WS_VA);
        bf16_t* QS = (bf16_t*)(ws + WS_QS); bf16_t* KS = (bf16_t*)(ws + WS_KS); bf16_t* VS = (bf16_t*)(ws + WS_VS);
        bf16_t* Ub = (bf16_t*)(ws + WS_U); bf16_t* BC = (bf16_t*)(ws + WS_BC); bf16_t* MG = (bf16_t*)(ws + WS_MG); bf16_t* ACT = (bf16_t*)(ws + WS_ACT);

        if (layer == DEPTH) {
            const float* gf = args.in[13];
            for (int m = gw; m < M; m += NGW) {
                const float rs = rstd_row(ssA, m);
                f32x4* xr = (f32x4*)(out + (size_t)m * DM) + lane; const f32x4* gr = (const f32x4*)gf + lane; const u32x2* xs = (const u32x2*)(xb + (size_t)m * DM) + lane;
#pragma unroll
                for (int j = 0; j < 4; ++j) { const u32x2 w = __builtin_nontemporal_load(xs + 64 * j); const f32x4 v = {bf_lo(w.x), bf_hi(w.x), bf_lo(w.y), bf_hi(w.y)}, g = gr[64 * j]; __builtin_nontemporal_store(v * rs * g, xr + 64 * j); }
            }
            if (xb_ld((unsigned*)(ws + WS_CTL) + CW_BAR + XB_TMO) != 0u && bx == 0) { for (int i = tid; i < 4096; i += NWAVES * 64) out[i] = __builtin_nanf(""); }
            break;
        }
        if (ph == 0) {
            LAS float* scr = (LAS float*)(lds + RING_OFF + wave * 16384);
            {
                constexpr int NIT2 = NITEMS; unsigned char* wb_ = layer == 0 ? ws + WS_WIN : (unsigned char*)out;
#define TR_DEC(i_, d_) tr_decode(i_, d_, args, layer, wb_)
                int it = gw;
                for (; it + NGW < NIT2; it += 2 * NGW) {
                    TrD da, db; f32x4 va[8], vb[8]; float ga[8], gb[8];
                    TR_DEC(it, da); tr_load(da, va, ga, lane);
                    TR_DEC(it + NGW, db); tr_load(db, vb, gb, lane);
                    tr_store(da, va, ga, scr, lane); tr_store(db, vb, gb, scr, lane);
                }
                if (it < NIT2) { TrD da; f32x4 va[8]; float ga[8]; TR_DEC(it, da); tr_load(da, va, ga, lane); tr_store(da, va, ga, scr, lane); }
#undef TR_DEC
            }
            if (layer == 0) {
                for (int m = gw; m < M; m += NGW) {
                    const f32x4* xr = (const f32x4*)(x_in + (size_t)m * DM) + lane; f32x4 v[4]; float s = 0.f;
#pragma unroll
                    for (int j = 0; j < 4; ++j) { v[j] = __builtin_nontemporal_load(xr + 64 * j); s += (v[j].x * v[j].x + v[j].y * v[j].y) + (v[j].z * v[j].z + v[j].w * v[j].w); }
                    s = wave_sum(s);
                    u32x2* o8 = (u32x2*)(xb + (size_t)m * DM) + lane;
#pragma unroll
                    for (int j = 0; j < 4; ++j) o8[64 * j] = (u32x2){cvt_pk_bf16(v[j].x, v[j].y), cvt_pk_bf16(v[j].z, v[j].w)};
                    if (lane < 4) ssA[(size_t)m * 4 + lane] = (lane == 0) ? s : 0.f;
                }
            }
        } else if (ph == 2) {
            LAS unsigned char* vst = lds + RING_OFF + wave * 16384;
            LAS float* wsf = (LAS float*)(lds + ATT_OFF + wave * 512);
            LAS float* km = (LAS float*)(lds + ATT_OFF + 4096);
            LAS unsigned* selm = (LAS unsigned*)(lds + ATT_OFF + 12288);
            LAS unsigned* cnt = (LAS unsigned*)(lds + ATT_OFF + 13312);
            LAS float* kbn = (LAS float*)(lds + ATT_OFF + 13312 + 256);
            LAS unsigned* uslot = (LAS unsigned*)(lds + ATT_OFF + 13312 + 512);
            LAS unsigned char* lists = lds + ATT_OFF + 14336;
            LAS unsigned* trow = (LAS unsigned*)(lds + ATT_OFF + 22528 + wave * 128);
            unsigned char* recO = ws + WS_MG + (size_t)vcu * 131072; float* recML = (float*)(ws + WS_X + (size_t)vcu * 8192);
            unsigned* qbase = (unsigned*)(ws + WS_CTL) + 14336 + layer * 512;
            int xq = (int)(bar.x & 7u);
            float* kbmax = (float*)((unsigned*)(ws + WS_CTL) + 8192 + 4096 + layer * 512);
            for (;;) {
                if (wave == 0) {
                    unsigned got = 0xffffffffu;
                    if (lane == 0) { const unsigned u_ = __hip_atomic_fetch_add(qbase + xq * 64, 1u, __ATOMIC_RELAXED, __HIP_MEMORY_SCOPE_AGENT); if (u_ < 224u) got = (unsigned)xq * 256u + u_; }
                    got = (unsigned)__builtin_amdgcn_readfirstlane((int)got);
                    while (got == 0xffffffffu) {
                        const unsigned c_ = lane < 8 ? __hip_atomic_load(qbase + lane * 64, __ATOMIC_RELAXED, __HIP_MEMORY_SCOPE_AGENT) : 224u;
                        const unsigned mk = (unsigned)__ballot(c_ < 224u) & 0xffu;
                        if (mk == 0u) break;
                        const unsigned rot = ((mk >> xq) | (mk << (8 - xq))) & 0xffu;
                        const int j_ = (xq + __builtin_ctz(rot)) & 7;
                        if (lane == 0) { const unsigned u_ = __hip_atomic_fetch_add(qbase + j_ * 64, 1u, __ATOMIC_RELAXED, __HIP_MEMORY_SCOPE_AGENT); if (u_ < 224u) got = (unsigned)j_ * 256u + u_; }
                        got = (unsigned)__builtin_amdgcn_readfirstlane((int)got);
                        xq = j_;
                    }
                    if (lane == 0) *uslot = got;
                }
                __syncthreads();
                const unsigned uq_ = *uslot;
                __syncthreads();
                if (uq_ == 0xffffffffu) break;
                const int xu = (int)(uq_ >> 8), ul = (int)(uq_ & 255u);
                if (ul >= 192) { const unsigned ucv = (unsigned)(xu * 32 + (ul - 192));
                    const float* cw = args.in[4] + (size_t)layer * 3 * BW;
                    const int c = (tid & 63) * 8;
                    f32x4 wt[3][2];
#pragma unroll
                    for (int j = 0; j < 3; ++j) { wt[j][0] = *(const f32x4*)(cw + j * BW + c); wt[j][1] = *(const f32x4*)(cw + j * BW + c + 4); }
#pragma unroll 1
                    for (int k8 = 0; k8 < 8; k8 += 2) {
                        int t_[2]; u32x4 u2_[2], u1_[2], u0_[2], bw_[2];
#pragma unroll
                        for (int s_ = 0; s_ < 2; ++s_) { const int i = (int)ucv * 4096 + (k8 + s_) * (NWAVES * 64) + tid; const int t = i >> 6; const int tt = t & (SEQ - 1); t_[s_] = t;
                            u2_[s_] = *(const u32x4*)(Ub + (size_t)t * BW + c);
                            u1_[s_] = (u32x4){0u, 0u, 0u, 0u}; u0_[s_] = (u32x4){0u, 0u, 0u, 0u};
                            if (tt >= 1) u1_[s_] = *(const u32x4*)(Ub + (size_t)(t - 1) * BW + c);
                            if (tt >= 2) u0_[s_] = *(const u32x4*)(Ub + (size_t)(t - 2) * BW + c);
                            bw_[s_] = *(const u32x4*)(BC + (size_t)t * BW + c); }
#pragma unroll
                        for (int s_ = 0; s_ < 2; ++s_) { const u32x4 u2 = u2_[s_], u1 = u1_[s_], u0 = u0_[s_], bw = bw_[s_];
                            float y[8];
#pragma unroll
                            for (int e = 0; e < 4; ++e) {
                                const float w0l = wt[0][e >> 1][2 * (e & 1)], w0h = wt[0][e >> 1][2 * (e & 1) + 1], w1l = wt[1][e >> 1][2 * (e & 1)], w1h = wt[1][e >> 1][2 * (e & 1) + 1], w2l = wt[2][e >> 1][2 * (e & 1)], w2h = wt[2][e >> 1][2 * (e & 1) + 1];
                                y[2 * e] = bf_lo(bw[e]) * (w0l * bf_lo(u0[e]) + w1l * bf_lo(u1[e]) + w2l * bf_lo(u2[e]));
                                y[2 * e + 1] = bf_hi(bw[e]) * (w0h * bf_hi(u0[e]) + w1h * bf_hi(u1[e]) + w2h * bf_hi(u2[e]));
                            }
                            *(u32x4*)(BC + (size_t)t_[s_] * BW + c) = (u32x4){cvt_pk_bf16(y[0], y[1]), cvt_pk_bf16(y[2], y[3]), cvt_pk_bf16(y[4], y[5]), cvt_pk_bf16(y[6], y[7])}; }
                    }
                    continue;
                }
                if (ul < 64) {
                    const int b = xu & 1, h = (ul >> 5) ? (xu >> 1) : 7 - (xu >> 1), bh = b * 8 + h, n = ul & 31;
                    const int key_ = n * 256 + (tid >> 1); const bf16_t* kp = KA + (size_t)(b * NH + h) * SEQ * HD + (size_t)(key_ >> 5) * 2048 + (tid & 1) * 1024 + (key_ & 31) * 8;
                    float sq = 0.f;
#pragma unroll
                    for (int c = 0; c < 4; ++c) { const u32x4 x = *(const u32x4*)(kp + c * 256); const float e0 = bf_lo(x.x), e1 = bf_hi(x.x), e2 = bf_lo(x.y), e3 = bf_hi(x.y), e4 = bf_lo(x.z), e5 = bf_hi(x.z), e6 = bf_lo(x.w), e7 = bf_hi(x.w);
                        sq += (e0 * e0 + e1 * e1) + (e2 * e2 + e3 * e3) + (e4 * e4 + e5 * e5) + (e6 * e6 + e7 * e7); }
                    sq += xshfl<1>(sq);
                    sq = __builtin_fmaxf(sq, xshfl<2>(sq)); sq = __builtin_fmaxf(sq, xshfl<4>(sq)); sq = __builtin_fmaxf(sq, xshfl<8>(sq)); sq = __builtin_fmaxf(sq, xshfl<16>(sq));
                    { float x1; const float x0 = att::swap_lo(sq, x1); sq = __builtin_fmaxf(x0, x1); }
                    if (lane == 0) kbn[wave] = sq;
                    __syncthreads();
                    if (tid == 0) { float m_ = kbn[0];
#pragma unroll
                        for (int w_ = 1; w_ < NWAVES; ++w_) m_ = __builtin_fmaxf(m_, kbn[w_]);
                        __hip_atomic_store((unsigned*)kbmax + bh * 32 + n, __float_as_uint(m_) | 1u, __ATOMIC_RELAXED, __HIP_MEMORY_SCOPE_AGENT); }
                    __syncthreads();
                } else if (ul < 128) {
                    const int b = xu & 1, h = ((ul - 64) >> 5) ? (xu >> 1) : 7 - (xu >> 1), blk = 31 - (ul & 31);
                    unsigned kb_ = 1u; if (tid < 32) kb_ = __hip_atomic_load((unsigned*)kbmax + (b * 8 + h) * 32 + tid, __ATOMIC_RELAXED, __HIP_MEMORY_SCOPE_AGENT);
                    const size_t qrow = (size_t)b * SEQ + blk * 256 + wave * 32;
                    bf16x8 gq[4], gk[4]; att::gate_load(gq, gk, QA + qrow * BW + h * HD, KA + (size_t)(b * NH + h) * SEQ * HD, blk * 256 + wave * 32, lane);
                    { float ka_[4], kb_[4];
#pragma unroll
                      for (int j = 0; j < 4; ++j) { const int i = tid + j * (NWAVES * 64), n = i >> 6, d = i & 63; const size_t o = (size_t)((b * 32 + n) * 2) * BW + h * HD + d; ka_[j] = kmp[o]; kb_[j] = kmp[o + BW]; }
#pragma unroll
                      for (int j = 0; j < 4; ++j) { const int i = tid + j * (NWAVES * 64), n = i >> 6, d = i & 63; km[n * 64 + ((((d >> 2) ^ (n & 15)) << 2) | (d & 3))] = ka_[j] + kb_[j]; } }
                    if (tid < 32) {
                        unsigned sp_ = 0; while (kb_ == 0u) { __builtin_amdgcn_s_sleep(2); kb_ = __hip_atomic_load((unsigned*)kbmax + (b * 8 + h) * 32 + tid, __ATOMIC_RELAXED, __HIP_MEMORY_SCOPE_AGENT);
                            if (++sp_ > (1u << 20)) { atomicAdd((unsigned*)(ws + WS_CTL) + CW_BAR + XB_TMO, 1u); break; } }
                        kbn[tid] = sqrtf(__uint_as_float(kb_)) * 1.01f; }
                    __syncthreads();
                    const float sl2 = __builtin_amdgcn_exp2f(-(float)(h + 1)) * LOG2E;
                    const unsigned sel = att::moba_gate(gq, gk, blk, blk * 256 + wave * 32, sl2, km, kbn, lane);
                    if (lane < 32) selm[wave * 32 + lane] = sel;
                    __syncthreads();
                    for (int n = wave; n < blk; n += NWAVES) {
                        unsigned pos = 0;
#pragma unroll
                        for (int c = 0; c < 4; ++c) { const int q = 64 * c + lane; const bool bit = (selm[q] >> n) & 1u; const unsigned long long mk = __ballot(bit);
                            if (bit) lists[n * 256 + pos + __builtin_amdgcn_mbcnt_hi((unsigned)(mk >> 32), __builtin_amdgcn_mbcnt_lo((unsigned)mk, 0u))] = (unsigned char)q;
                            pos += (unsigned)__builtin_popcountll(mk); }
                        if (lane == 0) cnt[n] = pos;
                    }
                    __syncthreads();
                    { int n = blk, t = wave; int nn = 0, tt = 0, idp = 0;
                      const int cntv = (lane < 32) ? (int)cnt[lane] : 0;
                      for (;;) {
                          att::moba_item(QA, KA, VA, b, h, blk, n, t, lists, cnt, selm, recO, recML, vst, wsf, trow, lane);
                          bool found = false;
                          while (nn < blk) { const int nt_ = (__builtin_amdgcn_readlane(cntv, nn) + 31) >> 5;
                              if (tt < nt_) { const bool mine = (idp & (NWAVES - 1)) == wave; if (mine) { n = nn; t = tt; found = true; } ++tt; ++idp; if (mine) break; }
                              else { ++nn; tt = 0; } }
                          if (!found) break;
                      } }
                    VM_WAIT();
                    __syncthreads();
                    att::moba_merge(QA, b, h, blk, wave, selm, recO, recML, wsf, lane);
                    __syncthreads();
                } else {
                    const int b = xu & 1, h = (xu >> 1) * 2 + ((ul - 128) >> 5), blk = ul & 31;
                    att::sb_item(QS, KS, VS, b, h, blk * 256 + wave * 32, vst, lane);
                }
            }
        } else {
            static_assert(WS_QS - WS_QA == 48 * MiB && WS_BC - WS_QS == 48 * MiB && WS_VA - WS_KA == 16 * MiB && WS_KS - WS_KA == 48 * MiB, "O_a / O_s / O_c 48 MiB apart; gate scratch = K_a | V_a | K_s");
            GCfg c{};
            c.ws = ws; c.wb = layer == 0 ? ws + WS_WIN : (unsigned char*)out; c.bgate = args.in[3] + (size_t)layer * NGATE; c.red = (LAS float*)(lds + LDSCTL_OFF + 1024);
            c.nseg = 1; c.lda = DM; c.ldb = DM; c.nt = DM / 64; c.toA = 0;
            if (ph == 1) { c.mode = 0; c.N = N1; c.A = xb; c.B = (const bf16_t*)c.wb; }
            else if (ph == 3) { c.mode = 1; c.N = DM; c.nseg = 6; c.A = xb; c.B = (const bf16_t*)(c.wb + (WS_WG - WS_WIN)); }
            else if (ph == 4) { c.mode = 2; c.N = DM; c.A = MG; c.B = (const bf16_t*)(c.wb + (WS_WO - WS_WIN)); }
            else if (ph == 5) { c.mode = 3; c.N = NGU; c.A = xb; c.B = (const bf16_t*)(c.wb + (WS_WGU - WS_WIN)); }
            else { c.mode = 2; c.N = DM; c.A = ACT; c.B = (const bf16_t*)(c.wb + (WS_WD - WS_WIN)); c.lda = DFF; c.ldb = DFF; c.nt = DFF / 64; c.toA = 1; }
            ProbAny P{&c}; EpiAny E{&c}; pg8::StaticOrder S; S.init(M, c.N, G, bx, c.nseg);
            c.rtab = (G == 256) && (ph == 1 || ph == 3 || ph == 5);
            if (c.rtab) { pg8::Unit u0; if (S.next(0, u0) && tid < 256) c.red[tid] = rstd_row(ph == 5 ? ssB : ssA, u0.pm * 256 + tid); __syncthreads(); }
            pg8::gemm_phase(lds + RING_OFF, P, S, E, wave);
        }
        if (!(ph == 6 && layer + 1 < DEPTH)) xcd_barrier(bar, tid, mapok && (ph == 3 || ph == 4 || ph == 5));
        if (pq == 0) { if (tid == 0) MISC[12] = xb_ld((unsigned*)(ws + WS_CTL) + CW_BAR + XB_MAPBAD); __syncthreads(); mapok = (MISC[12] == 0u); }
    }
}

extern "C" void kernel_launch(void* const* d_in, const int* in_sizes, int n_in, void* d_out, int out_size, void* d_ws, size_t ws_size, hipStream_t stream) {
    static int grid = 0;
    if (grid == 0) {
        if (n_in != 14 || in_sizes[0] != M * DM || out_size != M * DM || ws_size < WS_END) { fprintf(stderr, "kernel_launch: unexpected shapes (n_in %d, in0 %d, out %d, ws %zu)\n", n_in, n_in > 0 ? in_sizes[0] : -1, out_size, ws_size); grid = -1; return; }
        int dev = 0, cus = 0, per_cu = 0;
        if (hipGetDevice(&dev) != hipSuccess || hipDeviceGetAttribute(&cus, hipDeviceAttributeMultiprocessorCount, dev) != hipSuccess) { grid = -1; return; }
        if (hipFuncSetAttribute((const void*)hybrid_fwd, hipFuncAttributeMaxDynamicSharedMemorySize, LDS_BYTES) != hipSuccess) { fprintf(stderr, "kernel_launch: hipFuncSetAttribute failed\n"); grid = -1; return; }
        if (hipOccupancyMaxActiveBlocksPerMultiprocessor(&per_cu, (const void*)hybrid_fwd, NWAVES * 64, LDS_BYTES) != hipSuccess || per_cu < 1) { fprintf(stderr, "kernel_launch: occupancy query says %d blocks/CU\n", per_cu); (void)hipGetLastError(); per_cu = 1; }
        grid = cus;
    }
    if (grid < 0) return;
    if (hipMemsetAsync((char*)d_ws + WS_CTL, 0, CTL_ZERO_BYTES, stream) != hipSuccess) { fprintf(stderr, "kernel_launch: memset failed\n"); return; }
    Args a{};
    for (int i = 0; i < 14; ++i) a.in[i] = (const float*)d_in[i];
    a.out = (float*)d_out; a.ws = (unsigned char*)d_ws;
    void* kargs[] = {&a};
    hipError_t e = hipLaunchCooperativeKernel((const void*)hybrid_fwd, dim3(grid), dim3(NWAVES * 64), kargs, LDS_BYTES, stream);
    if (e != hipSuccess) fprintf(stderr, "kernel_launch: cooperative launch failed: %s (grid %d)\n", hipGetErrorString(e), grid);
}
```
